# Optimizing an MI355X kernel written in HIP

```python
import jax, jax.numpy as jnp
from jax import lax
import numpy as np

D_MODEL = 1024
BATCH = 8
SEQ = 4096
DEPTH = 2

GRID_W = 64
CTX_LEN = 256
HEAD_DIM = 64
SWA_HEADS = 6
SWA_KV_HEADS = 2
WINDOW = 128
GLB_HEADS = 6
GLB_KV_HEADS = 2
MLA_HEADS = 4
MLA_NOPE_DIM = 64
MLA_ROPE_DIM = 32
MLA_V_DIM = 64
MLA_Q_RANK = 256
MLA_KV_RANK = 128
MIX_WIDTH = (SWA_HEADS + GLB_HEADS) * HEAD_DIM + MLA_HEADS * MLA_V_DIM
BLOCK = 128
ROPE_THETA = 10000.0
N_EXPERTS = 16
N_GROUPS = 4
EXPERTS_PER_GROUP = N_EXPERTS // N_GROUPS
TOPK_GROUPS = 1
GROUP_SCORE_TOPK = 2
TOP_K = 2
D_EXPERT = 512
D_SHARED = 512
MOE_BLOCK = 128
EPS = 1e-6
NEG_INF = -1e30

IN_SPLIT_SIZES = (SWA_HEADS * HEAD_DIM, SWA_KV_HEADS * HEAD_DIM, SWA_KV_HEADS * HEAD_DIM,
                  GLB_HEADS * HEAD_DIM, GLB_KV_HEADS * HEAD_DIM, GLB_KV_HEADS * HEAD_DIM,
                  MLA_Q_RANK, MLA_KV_RANK, MLA_ROPE_DIM)
IN_WIDTH = sum(IN_SPLIT_SIZES)
IN_SPLIT_POINTS = tuple(int(p) for p in np.cumsum(IN_SPLIT_SIZES)[:-1])

kernel_name = "hymba_hybrid_dit_mla_swa_axial_moe"


def rmsnorm(x, g):
    xf = x.astype(jnp.float32)
    y = xf * lax.rsqrt(jnp.mean(xf * xf, axis=-1, keepdims=True) + EPS)
    return (y * g.astype(jnp.float32)).astype(x.dtype)


def modulate(h, shift, scale):
    return h * (1 + scale) + shift


def swiglu(h, w_gate, w_up, w_down):
    return (jax.nn.silu(h @ w_gate) * (h @ w_up)) @ w_down


def axial_rope(x, rows, cols):
    d = x.shape[-1]
    half = d // 2
    nf = half // 2
    inv = ROPE_THETA ** (-jnp.arange(nf, dtype=jnp.float32) / nf)
    bshape = (1, x.shape[1]) + (1,) * (x.ndim - 3) + (nf,)

    def rotate(xa, pos):
        ang = pos.astype(jnp.float32)[:, None] * inv
        cos = jnp.cos(ang).reshape(bshape)
        sin = jnp.sin(ang).reshape(bshape)
        x1 = xa[..., :nf].astype(jnp.float32)
        x2 = xa[..., nf:].astype(jnp.float32)
        return jnp.concatenate([x1 * cos - x2 * sin, x2 * cos + x1 * sin], axis=-1)

    return jnp.concatenate([rotate(x[..., :half], rows), rotate(x[..., half:], cols)], axis=-1).astype(x.dtype)


def attend(q, k, v, scale, mask=None, sink=None):
    s = jnp.einsum("...qhgd,...khd->...hgqk", q, k).astype(jnp.float32) * scale
    if mask is not None:
        s = jnp.where(mask, s, NEG_INF)
    if sink is not None:
        sink_logit = sink.astype(jnp.float32).reshape(s.shape[-4], s.shape[-3], 1, 1)
        sink_logit = jnp.broadcast_to(sink_logit, s.shape[:-1] + (1,))
        p = jax.nn.softmax(jnp.concatenate([s, sink_logit], axis=-1), axis=-1)[..., :-1]
    else:
        p = jax.nn.softmax(s, axis=-1)
    return jnp.einsum("...hgqk,...khd->...qhgd", p.astype(v.dtype), v)


def window_attention(q, k, v, k_ctx, v_ctx, sink):
    bsz, seq = q.shape[:2]
    nb = seq // BLOCK
    n_ctx = k_ctx.shape[1]
    halo = ((0, 0), (BLOCK, BLOCK), (0, 0), (0, 0))
    k_pad = jnp.pad(k, halo)
    v_pad = jnp.pad(v, halo)
    q_blocks = jnp.moveaxis(q.reshape((bsz, nb, BLOCK) + q.shape[2:]), 1, 0)
    offs_q = jnp.arange(BLOCK)
    offs_k = jnp.arange(3 * BLOCK) - BLOCK
    ctx_ok = jnp.ones((BLOCK, n_ctx), dtype=bool)
    scale = HEAD_DIM ** -0.5

    def one_block(args):
        q_blk, i = args
        start = i * BLOCK
        k_loc = lax.dynamic_slice_in_dim(k_pad, start, 3 * BLOCK, axis=1)
        v_loc = lax.dynamic_slice_in_dim(v_pad, start, 3 * BLOCK, axis=1)
        q_pos = start + offs_q
        k_pos = start + offs_k
        loc_ok = ((jnp.abs(q_pos[:, None] - k_pos[None, :]) <= WINDOW)
                  & (k_pos >= 0)[None, :] & (k_pos < seq)[None, :])
        mask = jnp.concatenate([ctx_ok, loc_ok], axis=1)
        return attend(q_blk, jnp.concatenate([k_ctx, k_loc], axis=1),
                      jnp.concatenate([v_ctx, v_loc], axis=1), scale, mask, sink)

    out = lax.map(one_block, (q_blocks, jnp.arange(nb)))
    return jnp.moveaxis(out, 0, 1).reshape(bsz, seq, -1)


def block_sweep_attention(q, k, v, scale):
    bsz, seq = q.shape[:2]
    nb = seq // BLOCK
    q_blocks = jnp.moveaxis(q.reshape((bsz, nb, BLOCK) + q.shape[2:]), 1, 0)
    out = lax.map(lambda q_blk: attend(q_blk, k, v, scale), q_blocks)
    return jnp.moveaxis(out, 0, 1).reshape(bsz, seq, -1)


def mixer_inputs(h, w_in, glb_q_gain, glb_k_gain, mla_q_gain, mla_w_uq, mla_kv_gain, mla_w_ukv):
    bsz, n = h.shape[:2]
    sq, sk, sv, gq, gk, gv, mq_lat, mkv_lat, mk_rope = jnp.split(h @ w_in, IN_SPLIT_POINTS, axis=-1)
    swa = (sq.reshape(bsz, n, SWA_KV_HEADS, SWA_HEADS // SWA_KV_HEADS, HEAD_DIM),
           sk.reshape(bsz, n, SWA_KV_HEADS, HEAD_DIM),
           sv.reshape(bsz, n, SWA_KV_HEADS, HEAD_DIM))
    glb = (rmsnorm(gq.reshape(bsz, n, GLB_KV_HEADS, GLB_HEADS // GLB_KV_HEADS, HEAD_DIM), glb_q_gain),
           rmsnorm(gk.reshape(bsz, n, GLB_KV_HEADS, HEAD_DIM), glb_k_gain),
           gv.reshape(bsz, n, GLB_KV_HEADS, HEAD_DIM))
    mq = (rmsnorm(mq_lat, mla_q_gain) @ mla_w_uq).reshape(bsz, n, MLA_HEADS, 1, MLA_NOPE_DIM + MLA_ROPE_DIM)
    mkv = (rmsnorm(mkv_lat, mla_kv_gain) @ mla_w_ukv).reshape(bsz, n, MLA_HEADS, MLA_NOPE_DIM + MLA_V_DIM)
    mla = (mq[..., :MLA_NOPE_DIM], mq[..., MLA_NOPE_DIM:],
           mkv[..., :MLA_NOPE_DIM], mk_rope.reshape(bsz, n, 1, MLA_ROPE_DIM), mkv[..., MLA_NOPE_DIM:])
    return swa, glb, mla


def mla_queries(q_nope, q_rope):
    return jnp.concatenate([q_nope, q_rope], axis=-1)


def mla_keys(k_nope, k_rope):
    k_rope = jnp.broadcast_to(k_rope, k_nope.shape[:-1] + (MLA_ROPE_DIM,))
    return jnp.concatenate([k_nope, k_rope], axis=-1)


def routed_experts(h, idx, gate_w, w_gate, w_up, w_down):
    n_tok, d = h.shape
    n_assign = n_tok * TOP_K
    flat_e = idx.reshape(-1)
    order = jnp.argsort(flat_e)
    sorted_e = flat_e[order]
    counts = jnp.bincount(flat_e, length=N_EXPERTS)
    padded = (counts + MOE_BLOCK - 1) // MOE_BLOCK * MOE_BLOCK
    pad_end = jnp.cumsum(padded)
    pad_start = pad_end - padded
    start = jnp.cumsum(counts) - counts
    dest = pad_start[sorted_e] + jnp.arange(n_assign) - start[sorted_e]
    n_blocks = -(-n_assign // MOE_BLOCK) + N_EXPERTS
    src_tok = order // TOP_K
    slot_tok = jnp.full((n_blocks * MOE_BLOCK,), n_tok, jnp.int32).at[dest].set(src_tok)
    h_slots = jnp.concatenate([h, jnp.zeros((1, d), h.dtype)], axis=0)[slot_tok]
    block_e = jnp.minimum(jnp.searchsorted(pad_end, jnp.arange(n_blocks) * MOE_BLOCK, side="right"),
                          N_EXPERTS - 1)

    def expert_block(args):
        hb, e = args
        return swiglu(hb, w_gate[e], w_up[e], w_down[e])

    y = lax.map(expert_block, (h_slots.reshape(n_blocks, MOE_BLOCK, d), block_e)).reshape(-1, d)
    contrib = y[dest] * gate_w.reshape(-1)[order][:, None].astype(y.dtype)
    return jax.ops.segment_sum(contrib, src_tok, num_segments=n_tok)


def moe_ffn(h, router_w, router_bias, w_gate, w_up, w_down, sw_gate, sw_up, sw_down):
    n_tok = h.shape[0]
    scores = jax.nn.sigmoid((h @ router_w).astype(jnp.float32))
    biased = scores + router_bias.astype(jnp.float32)
    grp_score = lax.top_k(biased.reshape(n_tok, N_GROUPS, EXPERTS_PER_GROUP), GROUP_SCORE_TOPK)[0].sum(-1)
    _, grp_idx = lax.top_k(grp_score, TOPK_GROUPS)
    grp_sel = jnp.any(grp_idx[..., None] == jnp.arange(N_GROUPS), axis=-2)
    expert_ok = jnp.repeat(grp_sel, EXPERTS_PER_GROUP, axis=-1)
    _, idx = lax.top_k(jnp.where(expert_ok, biased, NEG_INF), TOP_K)
    w = jnp.take_along_axis(scores, idx, axis=-1)
    w = w / jnp.sum(w, axis=-1, keepdims=True)
    return routed_experts(h, idx, w, w_gate, w_up, w_down) + swiglu(h, sw_gate, sw_up, sw_down)


def setup_inputs(seed: int = 0) -> dict:
    key = jax.random.key(seed)
    ks = jax.random.split(key, 26)
    L, D, E = DEPTH, D_MODEL, N_EXPERTS

    def nrm(k, shape, s):
        return jax.random.normal(k, shape, jnp.float32) * s

    return {
        "x": nrm(ks[0], (BATCH, SEQ, D), 1.0),
        "c": nrm(ks[1], (BATCH, D), 1.0),
        "ctx": nrm(ks[2], (BATCH, CTX_LEN, D), 1.0),
        "c_ctx": nrm(ks[3], (D,), 1.0),
        "w_mod": nrm(ks[4], (L, D, 6 * D), 0.5 * D ** -0.5),
        "b_mod": nrm(ks[5], (L, 6 * D), 0.02),
        "norm_mix_g": 1.0 + nrm(ks[6], (L, D), 0.1),
        "norm_ffn_g": 1.0 + nrm(ks[7], (L, D), 0.1),
        "w_in": nrm(ks[8], (L, D, IN_WIDTH), D ** -0.5),
        "w_out": nrm(ks[9], (L, MIX_WIDTH, D), MIX_WIDTH ** -0.5),
        "swa_sink": nrm(ks[10], (L, SWA_HEADS), 0.5),
        "glb_q_gain": 1.0 + nrm(ks[11], (L, HEAD_DIM), 0.1),
        "glb_k_gain": 1.0 + nrm(ks[12], (L, HEAD_DIM), 0.1),
        "mla_q_gain": 1.0 + nrm(ks[13], (L, MLA_Q_RANK), 0.1),
        "mla_w_uq": nrm(ks[14], (L, MLA_Q_RANK, MLA_HEADS * (MLA_NOPE_DIM + MLA_ROPE_DIM)), MLA_Q_RANK ** -0.5),
        "mla_kv_gain": 1.0 + nrm(ks[15], (L, MLA_KV_RANK), 0.1),
        "mla_w_ukv": nrm(ks[16], (L, MLA_KV_RANK, MLA_HEADS * (MLA_NOPE_DIM + MLA_V_DIM)), MLA_KV_RANK ** -0.5),
        "router_w": nrm(ks[17], (D, E), D ** -0.5),
        "router_bias": nrm(ks[18], (E,), 0.01),
        "exp_w_gate": nrm(ks[19], (L, E, D, D_EXPERT), D ** -0.5),
        "exp_w_up": nrm(ks[20], (L, E, D, D_EXPERT), D ** -0.5),
        "exp_w_down": nrm(ks[21], (L, E, D_EXPERT, D), D_EXPERT ** -0.5),
        "shr_w_gate": nrm(ks[22], (L, D, D_SHARED), D ** -0.5),
        "shr_w_up": nrm(ks[23], (L, D, D_SHARED), D ** -0.5),
        "shr_w_down": nrm(ks[24], (L, D_SHARED, D), D_SHARED ** -0.5),
        "final_norm_g": 1.0 + nrm(ks[25], (D,), 0.1),
    }


def reference(x, c, ctx, c_ctx, w_mod, b_mod, norm_mix_g, norm_ffn_g, w_in, w_out, swa_sink,
              glb_q_gain, glb_k_gain, mla_q_gain, mla_w_uq, mla_kv_gain, mla_w_ukv,
              router_w, router_bias, exp_w_gate, exp_w_up, exp_w_down,
              shr_w_gate, shr_w_up, shr_w_down, final_norm_g):
    bsz, seq, d = x.shape
    n_ctx = ctx.shape[1]
    rows_n = seq // GRID_W
    rows = jnp.repeat(jnp.arange(rows_n), GRID_W)
    cols = jnp.tile(jnp.arange(GRID_W), rows_n)
    hd_scale = HEAD_DIM ** -0.5
    mla_scale = (MLA_NOPE_DIM + MLA_ROPE_DIM) ** -0.5

    for l in range(DEPTH):
        last = l == DEPTH - 1
        mod_x = jnp.split((jax.nn.silu(c) @ w_mod[l] + b_mod[l])[:, None, :], 6, axis=-1)
        mod_c = jnp.split(jax.nn.silu(c_ctx) @ w_mod[l] + b_mod[l], 6, axis=-1)
        mix_params = (w_in[l], glb_q_gain[l], glb_k_gain[l], mla_q_gain[l], mla_w_uq[l],
                      mla_kv_gain[l], mla_w_ukv[l])

        h = modulate(rmsnorm(x, norm_mix_g[l]), mod_x[0], mod_x[1])
        hc = modulate(rmsnorm(ctx, norm_mix_g[l]), mod_c[0], mod_c[1])
        (sq, sk, sv), (gq, gk, gv), (mqn, mqr, mkn, mkr, mv) = mixer_inputs(h, *mix_params)
        (csq, csk, csv), (cgq, cgk, cgv), (cmqn, cmqr, cmkn, cmkr, cmv) = mixer_inputs(hc, *mix_params)
        cmk = mla_keys(cmkn, cmkr)

        y_swa = window_attention(axial_rope(sq, rows, cols), axial_rope(sk, rows, cols), sv,
                                 csk, csv, swa_sink[l])
        y_glb = block_sweep_attention(axial_rope(gq, rows, cols),
                                      jnp.concatenate([cgk, axial_rope(gk, rows, cols)], axis=1),
                                      jnp.concatenate([cgv, gv], axis=1), hd_scale)
        y_mla = block_sweep_attention(mla_queries(mqn, axial_rope(mqr, rows, cols)),
                                      jnp.concatenate([cmk, mla_keys(mkn, axial_rope(mkr, rows, cols))], axis=1),
                                      jnp.concatenate([cmv, mv], axis=1), mla_scale)
        x = x + mod_x[2] * (jnp.concatenate([y_swa, y_glb, y_mla], axis=-1) @ w_out[l])

        h = modulate(rmsnorm(x, norm_ffn_g[l]), mod_x[3], mod_x[4]).reshape(-1, d)
        moe_params = (router_w, router_bias, exp_w_gate[l], exp_w_up[l], exp_w_down[l],
                      shr_w_gate[l], shr_w_up[l], shr_w_down[l])
        if last:
            f = moe_ffn(h, *moe_params)
        else:
            yc = jnp.concatenate([
                attend(csq, csk, csv, hd_scale, sink=swa_sink[l]).reshape(bsz, n_ctx, -1),
                attend(cgq, cgk, cgv, hd_scale).reshape(bsz, n_ctx, -1),
                attend(mla_queries(cmqn, cmqr), cmk, cmv, mla_scale).reshape(bsz, n_ctx, -1)], axis=-1)
            ctx = ctx + mod_c[2] * (yc @ w_out[l])
            hc = modulate(rmsnorm(ctx, norm_ffn_g[l]), mod_c[3], mod_c[4]).reshape(-1, d)
            f_all = moe_ffn(jnp.concatenate([h, hc], axis=0), *moe_params)
            f = f_all[: bsz * seq]
            ctx = ctx + mod_c[5] * f_all[bsz * seq:].reshape(ctx.shape)
        x = x + mod_x[5] * f.reshape(x.shape)

    return rmsnorm(x, final_norm_g)
```

```cpp
#include <hip/hip_runtime.h>
#include <stdint.h>
#include <stddef.h>

typedef unsigned short u16;
#define DI __device__ __forceinline__

constexpr int B_ = 8, S_ = 4096, D_ = 1024, C_ = 256;
constexpr int NL = B_ * S_, NC = B_ * C_, NT = NL + NC;
constexpr int INW = 1696;
constexpr int NE = 16;
constexpr int MAXSLOT = NT * 2 + NE * 128;
constexpr float EPS = 1e-6f;

DI float bf2f(u16 v) { return __uint_as_float(((unsigned)v) << 16); }
DI u16 f2bf(float f) { unsigned u = __float_as_uint(f); u += 0x7fffu + ((u >> 16) & 1u); return (u16)(u >> 16); }
DI float bflo(unsigned u) { return __uint_as_float(u << 16); }
DI float bfhi(unsigned u) { return __uint_as_float(u & 0xffff0000u); }

DI float wave_sum(float v) {
#pragma unroll
  for (int o = 32; o > 0; o >>= 1) v += __shfl_xor(v, o);
  return v;
}

constexpr size_t al256(size_t x) { return (x + 255) & ~(size_t)255; }
constexpr size_t OFF_CTXR = 0;
constexpr size_t OFF_MOD = OFF_CTXR + al256((size_t)NC * D_ * 4);
constexpr size_t OFF_H = OFF_MOD + al256((size_t)2 * 9 * 6144 * 4);
constexpr size_t OFF_CNT = OFF_H + al256((size_t)NT * D_ * 2);
constexpr size_t OFF_TOKE = OFF_CNT + 8192;
constexpr size_t OFF_TOKW = OFF_TOKE + al256((size_t)NT * 2 * 4);
constexpr size_t OFF_TOKP = OFF_TOKW + al256((size_t)NT * 2 * 4);
constexpr size_t OFF_TOKS = OFF_TOKP + al256((size_t)NT * 2 * 4);
constexpr size_t OFF_SLOTT = OFF_TOKS + al256((size_t)NT * 2 * 4);
constexpr size_t OFF_SLOTW = OFF_SLOTT + al256((size_t)MAXSLOT * 4);
constexpr size_t OFF_BIG = OFF_SLOTW + al256((size_t)MAXSLOT * 4);
constexpr size_t OFF_SWQ = OFF_BIG;
constexpr size_t OFF_SWK = OFF_SWQ + (size_t)NT * 384 * 2;
constexpr size_t OFF_SWV = OFF_SWK + (size_t)NT * 128 * 2;
constexpr size_t OFF_GLQ = OFF_SWV + (size_t)NT * 128 * 2;
constexpr size_t OFF_GLK = OFF_GLQ + (size_t)NT * 384 * 2;
constexpr size_t OFF_GLV = OFF_GLK + (size_t)NT * 128 * 2;
constexpr size_t OFF_MLQ = OFF_GLV + (size_t)NT * 128 * 2;
constexpr size_t OFF_MLK = OFF_MLQ + (size_t)NT * 384 * 2;
constexpr size_t OFF_MLKR = OFF_MLK + (size_t)NT * 256 * 2;
constexpr size_t OFF_MLV = OFF_MLKR + (size_t)NT * 32 * 2;
constexpr size_t OFF_QLAT = OFF_MLV + (size_t)NT * 256 * 2;
constexpr size_t OFF_KVLAT = OFF_QLAT + (size_t)NT * 256 * 2;
constexpr size_t OFF_P = OFF_KVLAT + (size_t)NT * 128 * 2;
constexpr size_t OFF_MQT = OFF_P;
constexpr size_t OFF_MKVT = OFF_MQT + (size_t)NT * 384 * 4;
constexpr size_t OFF_Y = OFF_MKVT + (size_t)NT * 512 * 4;
constexpr size_t END_A = OFF_P + (size_t)NT * INW * 4;
static_assert(OFF_Y + (size_t)NT * 1024 * 2 <= END_A, "Y must fit in P region");
constexpr size_t OFF_ACT = OFF_BIG;
constexpr size_t OFF_ACTS = OFF_ACT + (size_t)MAXSLOT * 512 * 2;
constexpr size_t OFF_YEXP = OFF_ACTS + (size_t)NT * 512 * 2;
constexpr size_t OFF_YSH = OFF_YEXP + (size_t)MAXSLOT * 1024 * 2;
constexpr size_t END_B = OFF_YSH + (size_t)NT * 1024 * 2;
static_assert(END_B <= END_A, "view B must fit in view A");
static_assert(END_A <= (size_t)536870912, "workspace too large");

__global__ __launch_bounds__(256) void k_mod(const float* __restrict__ c, const float* __restrict__ c_ctx, const float* __restrict__ w_mod,
                                             const float* __restrict__ b_mod, float* __restrict__ MOD) {
  __shared__ float sc[9 * 1024];
  const int l = blockIdx.y;
  for (int i = threadIdx.x; i < 9 * 1024; i += 256) {
    int r = i >> 10, k = i & 1023;
    float v = r < 8 ? c[r * 1024 + k] : c_ctx[k];
    sc[i] = v / (1.f + __expf(-v));
  }
  __syncthreads();
  const int j = blockIdx.x * 256 + threadIdx.x;
  float acc[9];
#pragma unroll
  for (int r = 0; r < 9; ++r) acc[r] = 0.f;
  const float* w = w_mod + (size_t)l * 1024 * 6144 + j;
  for (int k = 0; k < 1024; ++k) {
    float wv = w[(size_t)k * 6144];
#pragma unroll
    for (int r = 0; r < 9; ++r) acc[r] += sc[r * 1024 + k] * wv;
  }
#pragma unroll
  for (int r = 0; r < 9; ++r) MOD[(size_t)(l * 9 + r) * 6144 + j] = acc[r] + b_mod[l * 6144 + j];
}

template <int FFN>
__global__ __launch_bounds__(256) void k_norm(const float* __restrict__ XR, const float* __restrict__ CTXR, const float* __restrict__ g,
                                              const float* __restrict__ MODl, u16* __restrict__ H, const float* __restrict__ router_w,
                                              const float* __restrict__ router_b, int* __restrict__ cnt, int* __restrict__ tok_e,
                                              float* __restrict__ tok_w, int* __restrict__ tok_p) {
  __shared__ float red[4];
  __shared__ float rl[4][16];
  __shared__ float slog[16], sbs[16];
  const int row = blockIdx.x, tid = threadIdx.x, lane = tid & 63, wid = tid >> 6;
  const float* xr = row < NL ? XR + (size_t)row * 1024 : CTXR + (size_t)(row - NL) * 1024;
  const int mr = row < NL ? row / S_ : 8;
  const float* md = MODl + (size_t)mr * 6144 + (FFN ? 3 * 1024 : 0);
  const float4 v = *(const float4*)(xr + tid * 4);
  float ss = v.x * v.x + v.y * v.y + v.z * v.z + v.w * v.w;
  ss = wave_sum(ss);
  if (lane == 0) red[wid] = ss;
  __syncthreads();
  ss = red[0] + red[1] + red[2] + red[3];
  const float rstd = rsqrtf(ss * (1.f / 1024.f) + EPS);
  const float4 gg = *(const float4*)(g + tid * 4);
  const float4 sh = *(const float4*)(md + tid * 4);
  const float4 scl = *(const float4*)(md + 1024 + tid * 4);
  float h0 = v.x * rstd * gg.x * (1.f + scl.x) + sh.x;
  float h1 = v.y * rstd * gg.y * (1.f + scl.y) + sh.y;
  float h2 = v.z * rstd * gg.z * (1.f + scl.z) + sh.z;
  float h3 = v.w * rstd * gg.w * (1.f + scl.w) + sh.w;
  uint2 o;
  o.x = (unsigned)f2bf(h0) | ((unsigned)f2bf(h1) << 16);
  o.y = (unsigned)f2bf(h2) | ((unsigned)f2bf(h3) << 16);
  *(uint2*)(H + (size_t)row * 1024 + tid * 4) = o;
  if (FFN) {
    float p[16];
    const float4* rw = (const float4*)(router_w + (size_t)tid * 4 * 16);
#pragma unroll
    for (int q = 0; q < 4; ++q) {
      float4 a = rw[q], b = rw[4 + q], c2 = rw[8 + q], d = rw[12 + q];
      p[q * 4 + 0] = h0 * a.x + h1 * b.x + h2 * c2.x + h3 * d.x;
      p[q * 4 + 1] = h0 * a.y + h1 * b.y + h2 * c2.y + h3 * d.y;
      p[q * 4 + 2] = h0 * a.z + h1 * b.z + h2 * c2.z + h3 * d.z;
      p[q * 4 + 3] = h0 * a.w + h1 * b.w + h2 * c2.w + h3 * d.w;
    }
#pragma unroll
    for (int e = 0; e < 16; ++e) {
      float s = wave_sum(p[e]);
      if (lane == 0) rl[wid][e] = s;
    }
    __syncthreads();
    if (tid < 16) {
      float lg = rl[0][tid] + rl[1][tid] + rl[2][tid] + rl[3][tid];
      float s = 1.f / (1.f + expf(-lg));
      slog[tid] = s;
      sbs[tid] = s + router_b[tid];
    }
    __syncthreads();
    if (tid == 0) {
      int bg = 0; float bgs = -1e30f;
      for (int gI = 0; gI < 4; ++gI) {
        float m1 = -1e30f, m2 = -1e30f;
        for (int e = 0; e < 4; ++e) { float x = sbs[gI * 4 + e]; if (x > m1) { m2 = m1; m1 = x; } else if (x > m2) m2 = x; }
        float gs = m1 + m2;
        if (gs > bgs) { bgs = gs; bg = gI; }
      }
      int i0 = -1, i1 = -1; float v0 = -1e30f, v1 = -1e30f;
      for (int e = 0; e < 4; ++e) { float x = sbs[bg * 4 + e]; if (x > v0) { v0 = x; i0 = bg * 4 + e; } }
      for (int e = 0; e < 4; ++e) { int ee = bg * 4 + e; if (ee == i0) continue; float x = sbs[ee]; if (x > v1) { v1 = x; i1 = ee; } }
      float w0 = slog[i0], w1 = slog[i1];
      float inv = 1.f / (w0 + w1);
      tok_e[row * 2] = i0; tok_e[row * 2 + 1] = i1;
      tok_w[row * 2] = w0 * inv; tok_w[row * 2 + 1] = w1 * inv;
      tok_p[row * 2] = atomicAdd(&cnt[i0], 1);
      tok_p[row * 2 + 1] = atomicAdd(&cnt[i1], 1);
    }
  }
}

__global__ void k_scan(int* __restrict__ cnt) {
  if (threadIdx.x == 0) {
    int ps = 0;
    for (int e = 0; e < NE; ++e) {
      cnt[16 + e] = ps;
      int pc = (cnt[e] + 127) / 128 * 128;
      for (int t = ps / 128; t < (ps + pc) / 128; ++t) cnt[64 + t] = e;
      ps += pc;
    }
    cnt[32] = ps; cnt[33] = ps;
  }
}
__global__ void k_slot_init(const int* __restrict__ cnt, int* __restrict__ slot_tok, float* __restrict__ slot_w) {
  int s = blockIdx.x * 256 + threadIdx.x;
  if (s >= MAXSLOT) return;
  slot_tok[s] = -1; slot_w[s] = 0.f;
}
__global__ void k_slot_fill(const int* __restrict__ cnt, const int* __restrict__ tok_e, const float* __restrict__ tok_w, const int* __restrict__ tok_p,
                            int* __restrict__ tok_s, int* __restrict__ slot_tok, float* __restrict__ slot_w, int ntok) {
  int i = blockIdx.x * 256 + threadIdx.x;
  if (i >= ntok * 2) return;
  int e = tok_e[i];
  int s = cnt[16 + e] + tok_p[i];
  tok_s[i] = s; slot_tok[s] = i >> 1; slot_w[s] = tok_w[i];
}

struct ARows { const u16* base; int ld; int pad; DI const u16* operator()(int r) const { return base + (size_t)r * ld; } };
struct AGather { const u16* base; const int* slot_tok; int ld; int pad; DI const u16* operator()(int r) const { int t = slot_tok[r]; return t < 0 ? nullptr : base + (size_t)t * ld; } };
struct BFixed { const float* p0; const float* p1; int ldb; int pad; DI const float* b0(int) const { return p0; } DI const float* b1(int) const { return p1; } };
struct BExpert { const float* p0; const float* p1; const int* tile_e; size_t stride; int ldb; int pad; DI const float* b0(int tm) const { return p0 + tile_e[tm >> 7] * stride; } DI const float* b1(int tm) const { return p1 + tile_e[tm >> 7] * stride; } };

struct EpiF32 { float* C; int ldc; int pad; DI void operator()(int r, int c, float v, float) const { C[(size_t)r * ldc + c] = v; } };
struct EpiSwiglu { u16* O; int ld; int pad; DI void operator()(int r, int c, float g, float u) const { O[(size_t)r * ld + c] = f2bf(g / (1.f + __expf(-g)) * u); } };
struct EpiResid { float* XR; float* CTXR; const float* MODl; int chunk; int pad; DI void operator()(int r, int c, float v, float) const {
  float* x = r < NL ? XR + (size_t)r * 1024 : CTXR + (size_t)(r - NL) * 1024; int mr = r < NL ? r / S_ : 8; x[c] += MODl[(size_t)mr * 6144 + chunk * 1024 + c] * v; } };
struct EpiScaleBf { u16* O; const float* sw; int ld; int pad; DI void operator()(int r, int c, float v, float) const { O[(size_t)r * ld + c] = f2bf(v * sw[r]); } };
struct EpiBf { u16* O; int ld; int pad; DI void operator()(int r, int c, float v, float) const { O[(size_t)r * ld + c] = f2bf(v); } };

template <int DUAL, class AF, class BF, class EPI>
__global__ __launch_bounds__(256) void k_gemm(const int* __restrict__ Mdev, int M, int N, int K, int padarg, AF af, BF bf, EPI epi) {
  __shared__ float As[16][68];
  __shared__ float Bs[DUAL + 1][16][68];
  const int tm = blockIdx.y * 64, tn = blockIdx.x * 64;
  if (Mdev) M = *Mdev;
  if (tm >= M) return;
  const int tid = threadIdx.x, tx = tid & 15, ty = tid >> 4;
  const float* Bp0 = bf.b0(tm);
  const float* Bp1 = DUAL ? bf.b1(tm) : nullptr;
  const int ldb = bf.ldb;
  float acc[4][4], acc2[4][4];
#pragma unroll
  for (int i = 0; i < 4; ++i)
#pragma unroll
    for (int j = 0; j < 4; ++j) { acc[i][j] = 0.f; acc2[i][j] = 0.f; }
  const int ar = tid >> 2, ak = (tid & 3) * 4;
  const u16* arow = (tm + ar < M) ? af(tm + ar) : nullptr;
  const int bk = tid >> 4, bn = (tid & 15) * 4;
  const bool bok = (tn + bn) < N;
  for (int k0 = 0; k0 < K; k0 += 16) {
    float a0 = 0.f, a1 = 0.f, a2 = 0.f, a3 = 0.f;
    if (arow) { uint2 u = *(const uint2*)(arow + k0 + ak); a0 = bflo(u.x); a1 = bfhi(u.x); a2 = bflo(u.y); a3 = bfhi(u.y); }
    As[ak + 0][ar] = a0; As[ak + 1][ar] = a1; As[ak + 2][ar] = a2; As[ak + 3][ar] = a3;
    float4 b = make_float4(0.f, 0.f, 0.f, 0.f);
    if (bok) b = *(const float4*)(Bp0 + (size_t)(k0 + bk) * ldb + tn + bn);
    *(float4*)&Bs[0][bk][bn] = b;
    if (DUAL) {
      float4 b2 = make_float4(0.f, 0.f, 0.f, 0.f);
      if (bok) b2 = *(const float4*)(Bp1 + (size_t)(k0 + bk) * ldb + tn + bn);
      *(float4*)&Bs[DUAL][bk][bn] = b2;
    }
    __syncthreads();
#pragma unroll
    for (int kk = 0; kk < 16; ++kk) {
      const float4 a = *(const float4*)&As[kk][ty * 4];
      const float4 bb = *(const float4*)&Bs[0][kk][tx * 4];
      const float av[4] = {a.x, a.y, a.z, a.w};
      const float bv[4] = {bb.x, bb.y, bb.z, bb.w};
#pragma unroll
      for (int i = 0; i < 4; ++i)
#pragma unroll
        for (int j = 0; j < 4; ++j) acc[i][j] += av[i] * bv[j];
      if (DUAL) {
        const float4 b2 = *(const float4*)&Bs[DUAL][kk][tx * 4];
        const float bv2[4] = {b2.x, b2.y, b2.z, b2.w};
#pragma unroll
        for (int i = 0; i < 4; ++i)
#pragma unroll
          for (int j = 0; j < 4; ++j) acc2[i][j] += av[i] * bv2[j];
      }
    }
    __syncthreads();
  }
#pragma unroll
  for (int i = 0; i < 4; ++i)
#pragma unroll
    for (int j = 0; j < 4; ++j) {
      int r = tm + ty * 4 + i, c = tn + tx * 4 + j;
      if (r < M && c < N) epi(r, c, acc[i][j], acc2[i][j]);
    }
}

DI void sincos_pos(float pos, float invf, float& sn, float& cs) {
  float rev = pos * invf * 0.15915494309189535f;
  rev -= rintf(rev);
  sn = __builtin_amdgcn_sinf(rev); cs = __builtin_amdgcn_cosf(rev);
}
DI float rope64(float v, int lane, int prow, int pcol) {
  const int i = lane & 15;
  const float invf = __builtin_amdgcn_exp2f(-(float)i * (13.287712379549449f / 16.f));
  float sn, cs; sincos_pos((float)(lane < 32 ? prow : pcol), invf, sn, cs);
  const float partner = __shfl_xor(v, 16);
  return (lane & 16) ? v * cs + partner * sn : v * cs - partner * sn;
}
DI float rope32(float v, int lane, int prow, int pcol) {
  const int i = lane & 7;
  const float invf = __builtin_amdgcn_exp2f(-(float)i * (13.287712379549449f / 8.f));
  float sn, cs; sincos_pos((float)((lane & 31) < 16 ? prow : pcol), invf, sn, cs);
  const float partner = __shfl_xor(v, 8);
  return (lane & 8) ? v * cs + partner * sn : v * cs - partner * sn;
}

struct QkvBufs { u16 *swq, *swk, *swv, *glq, *glk, *glv, *mlq, *mlk, *mlkr, *mlv, *qlat, *kvlat; };

__global__ __launch_bounds__(256) void k_qkv_post(const float* __restrict__ P, QkvBufs qb, const float* __restrict__ gqg, const float* __restrict__ gkg,
                                                  const float* __restrict__ mqg, const float* __restrict__ mkvg) {
  __shared__ float red[8];
  const int row = blockIdx.x, tid = threadIdx.x, lane = tid & 63, wid = tid >> 6;
  const float* p = P + (size_t)row * INW;
  const bool lat = row < NL;
  const int t = row & (S_ - 1), prow = t >> 6, pcol = t & 63;
  float vq = p[1280 + tid];
  float vkv = tid < 128 ? p[1536 + tid] : 0.f;
  float sq = wave_sum(vq * vq), skv = wave_sum(vkv * vkv);
  if (lane == 0) { red[wid] = sq; red[4 + wid] = skv; }
  __syncthreads();
  const float rq = rsqrtf((red[0] + red[1] + red[2] + red[3]) * (1.f / 256.f) + EPS);
  const float rkv = rsqrtf((red[4] + red[5]) * (1.f / 128.f) + EPS);
  qb.qlat[(size_t)row * 256 + tid] = f2bf(vq * rq * mqg[tid]);
  if (tid < 128) qb.kvlat[(size_t)row * 128 + tid] = f2bf(vkv * rkv * mkvg[tid]);
  for (int u = wid; u < 20; u += 4) {
    float v = p[u * 64 + lane];
    if (u < 6) { if (lat) v = rope64(v, lane, prow, pcol); qb.swq[(size_t)row * 384 + u * 64 + lane] = f2bf(v); }
    else if (u < 8) { if (lat) v = rope64(v, lane, prow, pcol); qb.swk[(size_t)row * 128 + (u - 6) * 64 + lane] = f2bf(v); }
    else if (u < 10) { qb.swv[(size_t)row * 128 + (u - 8) * 64 + lane] = f2bf(v); }
    else if (u < 16) { float r = rsqrtf(wave_sum(v * v) * (1.f / 64.f) + EPS); v = v * r * gqg[lane]; if (lat) v = rope64(v, lane, prow, pcol); qb.glq[(size_t)row * 384 + (u - 10) * 64 + lane] = f2bf(v); }
    else if (u < 18) { float r = rsqrtf(wave_sum(v * v) * (1.f / 64.f) + EPS); v = v * r * gkg[lane]; if (lat) v = rope64(v, lane, prow, pcol); qb.glk[(size_t)row * 128 + (u - 16) * 64 + lane] = f2bf(v); }
    else { qb.glv[(size_t)row * 128 + (u - 18) * 64 + lane] = f2bf(v); }
  }
  if (wid == 3) {
    float v = p[1664 + (lane & 31)];
    if (lat) v = rope32(v, lane, prow, pcol);
    if (lane < 32) qb.mlkr[(size_t)row * 32 + lane] = f2bf(v);
  }
}

__global__ __launch_bounds__(256) void k_mla_post(const float* __restrict__ MQT, const float* __restrict__ MKVT, QkvBufs qb) {
  const int row = blockIdx.x, tid = threadIdx.x, lane = tid & 63, h = tid >> 6;
  const bool lat = row < NL;
  const int t = row & (S_ - 1), prow = t >> 6, pcol = t & 63;
  const float* q = MQT + (size_t)row * 384 + h * 96;
  qb.mlq[(size_t)row * 384 + h * 96 + lane] = f2bf(q[lane]);
  float v = q[64 + (lane & 31)];
  if (lat) v = rope32(v, lane, prow, pcol);
  if (lane < 32) qb.mlq[(size_t)row * 384 + h * 96 + 64 + lane] = f2bf(v);
  const float* kv = MKVT + (size_t)row * 512 + h * 128;
  qb.mlk[(size_t)row * 256 + h * 64 + lane] = f2bf(kv[lane]);
  qb.mlv[(size_t)row * 256 + h * 64 + lane] = f2bf(kv[64 + lane]);
}

struct AttnArgs {
  const u16* Q; const u16* K; const u16* K2; const u16* V; u16* Y; const float* sink;
  int ldq, ldk, ldk2, ldv, ldy, ycol, G, window, q_is_ctx; float scale;
};
static_assert(sizeof(AttnArgs) == 88, "no padding");
template <int DK1, int DK2>
__global__ __launch_bounds__(64) void k_attn(AttnArgs a) {
  const int qt = blockIdx.x * 64 + threadIdx.x, b = blockIdx.y, h = blockIdx.z, kvh = h / a.G;
  const int qrow = a.q_is_ctx ? NL + b * C_ + qt : b * S_ + qt;
  float q[DK1 + DK2];
  {
    const uint4* qp = (const uint4*)(a.Q + (size_t)qrow * a.ldq + h * (DK1 + DK2));
#pragma unroll
    for (int i = 0; i < (DK1 + DK2) / 8; ++i) {
      uint4 u = qp[i];
      q[i * 8 + 0] = bflo(u.x) * a.scale; q[i * 8 + 1] = bfhi(u.x) * a.scale; q[i * 8 + 2] = bflo(u.y) * a.scale; q[i * 8 + 3] = bfhi(u.y) * a.scale;
      q[i * 8 + 4] = bflo(u.z) * a.scale; q[i * 8 + 5] = bfhi(u.z) * a.scale; q[i * 8 + 6] = bflo(u.w) * a.scale; q[i * 8 + 7] = bfhi(u.w) * a.scale;
    }
  }
  float m, l, o[64];
  if (a.sink) { m = a.sink[h]; l = 1.f; } else { m = -1e30f; l = 0.f; }
#pragma unroll
  for (int d = 0; d < 64; ++d) o[d] = 0.f;
  const int nseg = a.q_is_ctx ? 1 : 2;
  for (int seg = 0; seg < nseg; ++seg) {
    int lo, hi, rbase; bool masked = false;
    if (seg == 0) { lo = 0; hi = C_; rbase = NL + b * C_; }
    else {
      lo = 0; hi = S_; rbase = b * S_;
      if (a.window) { int t0 = blockIdx.x * 64; lo = t0 - a.window; if (lo < 0) lo = 0; hi = t0 + 64 + a.window; if (hi > S_) hi = S_; masked = true; }
    }
    for (int s = lo; s < hi; s += 4) {
      float sc[4];
#pragma unroll
      for (int i = 0; i < 4; ++i) {
        const uint4* kp = (const uint4*)(a.K + (size_t)(rbase + s + i) * a.ldk + kvh * DK1);
        float dot = 0.f;
#pragma unroll
        for (int c = 0; c < DK1 / 8; ++c) {
          uint4 u = kp[c];
          dot += q[c * 8 + 0] * bflo(u.x) + q[c * 8 + 1] * bfhi(u.x) + q[c * 8 + 2] * bflo(u.y) + q[c * 8 + 3] * bfhi(u.y)
               + q[c * 8 + 4] * bflo(u.z) + q[c * 8 + 5] * bfhi(u.z) + q[c * 8 + 6] * bflo(u.w) + q[c * 8 + 7] * bfhi(u.w);
        }
        if (DK2 > 0) {
          const uint4* kp2 = (const uint4*)(a.K2 + (size_t)(rbase + s + i) * a.ldk2);
#pragma unroll
          for (int c = 0; c < DK2 / 8; ++c) {
            uint4 u = kp2[c];
            dot += q[DK1 + c * 8 + 0] * bflo(u.x) + q[DK1 + c * 8 + 1] * bfhi(u.x) + q[DK1 + c * 8 + 2] * bflo(u.y) + q[DK1 + c * 8 + 3] * bfhi(u.y)
                 + q[DK1 + c * 8 + 4] * bflo(u.z) + q[DK1 + c * 8 + 5] * bfhi(u.z) + q[DK1 + c * 8 + 6] * bflo(u.w) + q[DK1 + c * 8 + 7] * bfhi(u.w);
          }
        }
        if (masked) { int dlt = qt - (s + i); if (dlt < 0) dlt = -dlt; if (dlt > a.window) dot = -1e30f; }
        sc[i] = dot;
      }
      float mx = fmaxf(fmaxf(fmaxf(sc[0], sc[1]), fmaxf(sc[2], sc[3])), m);
      const float alpha = __expf(m - mx);
      float pr[4];
#pragma unroll
      for (int i = 0; i < 4; ++i) pr[i] = __expf(sc[i] - mx);
      l = l * alpha + (pr[0] + pr[1]) + (pr[2] + pr[3]);
      m = mx;
#pragma unroll
      for (int d = 0; d < 64; ++d) o[d] *= alpha;
#pragma unroll
      for (int i = 0; i < 4; ++i) {
        const uint4* vp = (const uint4*)(a.V + (size_t)(rbase + s + i) * a.ldv + kvh * 64);
#pragma unroll
        for (int c = 0; c < 8; ++c) {
          uint4 u = vp[c];
          o[c * 8 + 0] += pr[i] * bflo(u.x); o[c * 8 + 1] += pr[i] * bfhi(u.x); o[c * 8 + 2] += pr[i] * bflo(u.y); o[c * 8 + 3] += pr[i] * bfhi(u.y);
          o[c * 8 + 4] += pr[i] * bflo(u.z); o[c * 8 + 5] += pr[i] * bfhi(u.z); o[c * 8 + 6] += pr[i] * bflo(u.w); o[c * 8 + 7] += pr[i] * bfhi(u.w);
        }
      }
    }
  }
  const float inv = 1.f / l;
  uint4* yp = (uint4*)(a.Y + (size_t)qrow * a.ldy + a.ycol + h * 64);
#pragma unroll
  for (int c = 0; c < 8; ++c) {
    uint4 u;
    u.x = (unsigned)f2bf(o[c * 8 + 0] * inv) | ((unsigned)f2bf(o[c * 8 + 1] * inv) << 16);
    u.y = (unsigned)f2bf(o[c * 8 + 2] * inv) | ((unsigned)f2bf(o[c * 8 + 3] * inv) << 16);
    u.z = (unsigned)f2bf(o[c * 8 + 4] * inv) | ((unsigned)f2bf(o[c * 8 + 5] * inv) << 16);
    u.w = (unsigned)f2bf(o[c * 8 + 6] * inv) | ((unsigned)f2bf(o[c * 8 + 7] * inv) << 16);
    yp[c] = u;
  }
}

__global__ __launch_bounds__(256) void k_combine(float* __restrict__ XR, float* __restrict__ CTXR, const float* __restrict__ MODl, const int* __restrict__ tok_s,
                                                 const u16* __restrict__ YEXP, const u16* __restrict__ YSH) {
  const int row = blockIdx.x, tid = threadIdx.x;
  float* x = row < NL ? XR + (size_t)row * 1024 : CTXR + (size_t)(row - NL) * 1024;
  const int mr = row < NL ? row / S_ : 8;
  const float* gate = MODl + (size_t)mr * 6144 + 5 * 1024;
  const int s0 = tok_s[row * 2], s1 = tok_s[row * 2 + 1];
  const uint2 a = *(const uint2*)(YEXP + (size_t)s0 * 1024 + tid * 4);
  const uint2 b = *(const uint2*)(YEXP + (size_t)s1 * 1024 + tid * 4);
  const uint2 c = *(const uint2*)(YSH + (size_t)row * 1024 + tid * 4);
  float4 xv = *(float4*)(x + tid * 4);
  const float4 g = *(const float4*)(gate + tid * 4);
  xv.x += g.x * (bflo(a.x) + bflo(b.x) + bflo(c.x));
  xv.y += g.y * (bfhi(a.x) + bfhi(b.x) + bfhi(c.x));
  xv.z += g.z * (bflo(a.y) + bflo(b.y) + bflo(c.y));
  xv.w += g.w * (bfhi(a.y) + bfhi(b.y) + bfhi(c.y));
  *(float4*)(x + tid * 4) = xv;
}

__global__ __launch_bounds__(256) void k_final(float* __restrict__ XR, const float* __restrict__ g) {
  __shared__ float red[4];
  const int row = blockIdx.x, tid = threadIdx.x, lane = tid & 63, wid = tid >> 6;
  float* x = XR + (size_t)row * 1024;
  float4 v = *(float4*)(x + tid * 4);
  float ss = wave_sum(v.x * v.x + v.y * v.y + v.z * v.z + v.w * v.w);
  if (lane == 0) red[wid] = ss;
  __syncthreads();
  const float rstd = rsqrtf((red[0] + red[1] + red[2] + red[3]) * (1.f / 1024.f) + EPS);
  const float4 gg = *(const float4*)(g + tid * 4);
  v.x *= rstd * gg.x; v.y *= rstd * gg.y; v.z *= rstd * gg.z; v.w *= rstd * gg.w;
  *(float4*)(x + tid * 4) = v;
}

extern "C" void kernel_launch(void* const* d_in, const int* in_sizes, int n_in, void* d_out, int out_size, void* d_ws, size_t ws_size, hipStream_t stream) {
  const float* x = (const float*)d_in[0];
  const float* c = (const float*)d_in[1];
  const float* ctx = (const float*)d_in[2];
  const float* c_ctx = (const float*)d_in[3];
  const float* w_mod = (const float*)d_in[4];
  const float* b_mod = (const float*)d_in[5];
  const float* norm_mix_g = (const float*)d_in[6];
  const float* norm_ffn_g = (const float*)d_in[7];
  const float* w_in = (const float*)d_in[8];
  const float* w_out = (const float*)d_in[9];
  const float* swa_sink = (const float*)d_in[10];
  const float* glb_q_gain = (const float*)d_in[11];
  const float* glb_k_gain = (const float*)d_in[12];
  const float* mla_q_gain = (const float*)d_in[13];
  const float* mla_w_uq = (const float*)d_in[14];
  const float* mla_kv_gain = (const float*)d_in[15];
  const float* mla_w_ukv = (const float*)d_in[16];
  const float* router_w = (const float*)d_in[17];
  const float* router_bias = (const float*)d_in[18];
  const float* exp_w_gate = (const float*)d_in[19];
  const float* exp_w_up = (const float*)d_in[20];
  const float* exp_w_down = (const float*)d_in[21];
  const float* shr_w_gate = (const float*)d_in[22];
  const float* shr_w_up = (const float*)d_in[23];
  const float* shr_w_down = (const float*)d_in[24];
  const float* final_norm_g = (const float*)d_in[25];

  char* ws = (char*)d_ws;
  float* XR = (float*)d_out;
  float* CTXR = (float*)(ws + OFF_CTXR);
  float* MOD = (float*)(ws + OFF_MOD);
  u16* H = (u16*)(ws + OFF_H);
  int* CNT = (int*)(ws + OFF_CNT);
  int* TOKE = (int*)(ws + OFF_TOKE);
  float* TOKW = (float*)(ws + OFF_TOKW);
  int* TOKP = (int*)(ws + OFF_TOKP);
  int* TOKS = (int*)(ws + OFF_TOKS);
  int* SLOTT = (int*)(ws + OFF_SLOTT);
  float* SLOTW = (float*)(ws + OFF_SLOTW);
  QkvBufs qb;
  qb.swq = (u16*)(ws + OFF_SWQ); qb.swk = (u16*)(ws + OFF_SWK); qb.swv = (u16*)(ws + OFF_SWV);
  qb.glq = (u16*)(ws + OFF_GLQ); qb.glk = (u16*)(ws + OFF_GLK); qb.glv = (u16*)(ws + OFF_GLV);
  qb.mlq = (u16*)(ws + OFF_MLQ); qb.mlk = (u16*)(ws + OFF_MLK); qb.mlkr = (u16*)(ws + OFF_MLKR); qb.mlv = (u16*)(ws + OFF_MLV);
  qb.qlat = (u16*)(ws + OFF_QLAT); qb.kvlat = (u16*)(ws + OFF_KVLAT);
  float* P = (float*)(ws + OFF_P);
  float* MQT = (float*)(ws + OFF_MQT);
  float* MKVT = (float*)(ws + OFF_MKVT);
  u16* Y = (u16*)(ws + OFF_Y);
  u16* ACT = (u16*)(ws + OFF_ACT);
  u16* ACTS = (u16*)(ws + OFF_ACTS);
  u16* YEXP = (u16*)(ws + OFF_YEXP);
  u16* YSH = (u16*)(ws + OFF_YSH);

  (void)hipMemcpyAsync(XR, x, (size_t)NL * D_ * 4, hipMemcpyDeviceToDevice, stream);
  (void)hipMemcpyAsync(CTXR, ctx, (size_t)NC * D_ * 4, hipMemcpyDeviceToDevice, stream);
  k_mod<<<dim3(24, 2), 256, 0, stream>>>(c, c_ctx, w_mod, b_mod, MOD);

  for (int l = 0; l < 2; ++l) {
    const bool last = (l == 1);
    const float* MODl = MOD + (size_t)l * 9 * 6144;
    const int Mall = NT;
    const int Mres = last ? NL : NT;
    k_norm<0><<<NT, 256, 0, stream>>>(XR, CTXR, norm_mix_g + l * 1024, MODl, H, nullptr, nullptr, nullptr, nullptr, nullptr, nullptr);
    k_gemm<0><<<dim3((INW + 63) / 64, (Mall + 63) / 64), 256, 0, stream>>>(nullptr, Mall, INW, 1024, 0, ARows{H, 1024, 0}, BFixed{w_in + (size_t)l * 1024 * INW, nullptr, INW, 0}, EpiF32{P, INW, 0});
    k_qkv_post<<<NT, 256, 0, stream>>>(P, qb, glb_q_gain + l * 64, glb_k_gain + l * 64, mla_q_gain + l * 256, mla_kv_gain + l * 128);
    k_gemm<0><<<dim3(384 / 64, (Mall + 63) / 64), 256, 0, stream>>>(nullptr, Mall, 384, 256, 0, ARows{qb.qlat, 256, 0}, BFixed{mla_w_uq + (size_t)l * 256 * 384, nullptr, 384, 0}, EpiF32{MQT, 384, 0});
    k_gemm<0><<<dim3(512 / 64, (Mall + 63) / 64), 256, 0, stream>>>(nullptr, Mall, 512, 128, 0, ARows{qb.kvlat, 128, 0}, BFixed{mla_w_ukv + (size_t)l * 128 * 512, nullptr, 512, 0}, EpiF32{MKVT, 512, 0});
    k_mla_post<<<NT, 256, 0, stream>>>(MQT, MKVT, qb);
    {
      AttnArgs a{};
      a.Q = qb.swq; a.ldq = 384; a.K = qb.swk; a.ldk = 128; a.K2 = nullptr; a.ldk2 = 0; a.V = qb.swv; a.ldv = 128; a.Y = Y; a.ldy = 1024; a.ycol = 0;
      a.sink = swa_sink + l * 6; a.G = 3; a.scale = 0.125f; a.window = 128; a.q_is_ctx = 0;
      k_attn<64, 0><<<dim3(S_ / 64, B_, 6), 64, 0, stream>>>(a);
      if (!last) { a.q_is_ctx = 1; a.window = 0; k_attn<64, 0><<<dim3(C_ / 64, B_, 6), 64, 0, stream>>>(a); }
      AttnArgs g{};
      g.Q = qb.glq; g.ldq = 384; g.K = qb.glk; g.ldk = 128; g.K2 = nullptr; g.ldk2 = 0; g.V = qb.glv; g.ldv = 128; g.Y = Y; g.ldy = 1024; g.ycol = 384;
      g.sink = nullptr; g.G = 3; g.scale = 0.125f; g.window = 0; g.q_is_ctx = 0;
      k_attn<64, 0><<<dim3(S_ / 64, B_, 6), 64, 0, stream>>>(g);
      if (!last) { g.q_is_ctx = 1; k_attn<64, 0><<<dim3(C_ / 64, B_, 6), 64, 0, stream>>>(g); }
      AttnArgs m{};
      m.Q = qb.mlq; m.ldq = 384; m.K = qb.mlk; m.ldk = 256; m.K2 = qb.mlkr; m.ldk2 = 32; m.V = qb.mlv; m.ldv = 256; m.Y = Y; m.ldy = 1024; m.ycol = 768;
      m.sink = nullptr; m.G = 1; m.scale = 0.10206207261596575f; m.window = 0; m.q_is_ctx = 0;
      k_attn<64, 32><<<dim3(S_ / 64, B_, 4), 64, 0, stream>>>(m);
      if (!last) { m.q_is_ctx = 1; k_attn<64, 32><<<dim3(C_ / 64, B_, 4), 64, 0, stream>>>(m); }
    }
    k_gemm<0><<<dim3(1024 / 64, (Mres + 63) / 64), 256, 0, stream>>>(nullptr, Mres, 1024, 1024, 0, ARows{Y, 1024, 0}, BFixed{w_out + (size_t)l * 1024 * 1024, nullptr, 1024, 0}, EpiResid{XR, CTXR, MODl, 2, 0});
    (void)hipMemsetAsync(CNT, 0, 8192, stream);
    k_norm<1><<<Mres, 256, 0, stream>>>(XR, CTXR, norm_ffn_g + l * 1024, MODl, H, router_w, router_bias, CNT, TOKE, TOKW, TOKP);
    k_scan<<<1, 64, 0, stream>>>(CNT);
    k_slot_init<<<(MAXSLOT + 255) / 256, 256, 0, stream>>>(CNT, SLOTT, SLOTW);
    k_slot_fill<<<(Mres * 2 + 255) / 256, 256, 0, stream>>>(CNT, TOKE, TOKW, TOKP, TOKS, SLOTT, SLOTW, Mres);
    k_gemm<1><<<dim3(512 / 64, MAXSLOT / 64), 256, 0, stream>>>(CNT + 33, MAXSLOT, 512, 1024, 0, AGather{H, SLOTT, 1024, 0},
        BExpert{exp_w_gate + (size_t)l * NE * 1024 * 512, exp_w_up + (size_t)l * NE * 1024 * 512, CNT + 64, (size_t)1024 * 512, 512, 0}, EpiSwiglu{ACT, 512, 0});
    k_gemm<0><<<dim3(1024 / 64, MAXSLOT / 64), 256, 0, stream>>>(CNT + 33, MAXSLOT, 1024, 512, 0, ARows{ACT, 512, 0},
        BExpert{exp_w_down + (size_t)l * NE * 512 * 1024, nullptr, CNT + 64, (size_t)512 * 1024, 1024, 0}, EpiScaleBf{YEXP, SLOTW, 1024, 0});
    k_gemm<1><<<dim3(512 / 64, (Mres + 63) / 64), 256, 0, stream>>>(nullptr, Mres, 512, 1024, 0, ARows{H, 1024, 0},
        BFixed{shr_w_gate + (size_t)l * 1024 * 512, shr_w_up + (size_t)l * 1024 * 512, 512, 0}, EpiSwiglu{ACTS, 512, 0});
    k_gemm<0><<<dim3(1024 / 64, (Mres + 63) / 64), 256, 0, stream>>>(nullptr, Mres, 1024, 512, 0, ARows{ACTS, 512, 0},
        BFixed{shr_w_down + (size_t)l * 512 * 1024, nullptr, 1024, 0}, EpiBf{YSH, 1024, 0});
    k_combine<<<Mres, 256, 0, stream>>>(XR, CTXR, MODl, TOKS, YEXP, YSH);
  }
  k_final<<<NL, 256, 0, stream>>>(XR, final_norm_g);
}
```

```cpp
#include <hip/hip_runtime.h>
#include <stdint.h>
#include <stddef.h>

typedef unsigned short u16;
typedef short bf16x8 __attribute__((ext_vector_type(8)));
typedef float f32x4 __attribute__((ext_vector_type(4)));
typedef float f32x2_t __attribute__((ext_vector_type(2)));
typedef __bf16 bf16x2_t __attribute__((ext_vector_type(2)));
#define DI __device__ __forceinline__
#define LAS __attribute__((address_space(3)))

constexpr int B_ = 8, S_ = 4096, D_ = 1024, C_ = 256;
constexpr int NL = B_ * S_, NC = B_ * C_, NT = NL + NC;
constexpr int INW = 1696, INWP = 1792;
constexpr int NE = 16;
constexpr int MAXSLOT = NT * 2 + NE * 128;
constexpr float EPS = 1e-6f;
constexpr int NTHR = 256;
constexpr int GRID = 512;

DI float bf2f(u16 v) { return __uint_as_float(((unsigned)v) << 16); }
DI float bflo(unsigned u) { return __uint_as_float(u << 16); }
DI float bfhi(unsigned u) { return __uint_as_float(u & 0xffff0000u); }
DI unsigned cvtpk(float lo, float hi) { f32x2_t v = {lo, hi}; bf16x2_t b = __builtin_convertvector(v, bf16x2_t); return __builtin_bit_cast(unsigned, b); }
DI float wave_sum(float v) {
#pragma unroll
  for (int o = 32; o > 0; o >>= 1) v += __shfl_xor(v, o);
  return v;
}
DI float silu(float g) { return g / (1.f + __expf(-g)); }

constexpr size_t al256(size_t x) { return (x + 255) & ~(size_t)255; }
constexpr size_t OFF_CTRL = 0;
constexpr size_t CTRL_BYTES = 65536;
constexpr size_t OFF_CTXR = OFF_CTRL + CTRL_BYTES;
constexpr size_t OFF_MOD = OFF_CTXR + al256((size_t)NC * D_ * 4);
constexpr size_t OFF_TOKE = OFF_MOD + al256((size_t)2 * 9 * 6144 * 4);
constexpr size_t OFF_TOKW = OFF_TOKE + al256((size_t)NT * 2 * 4);
constexpr size_t OFF_TOKP = OFF_TOKW + al256((size_t)NT * 2 * 4);
constexpr size_t OFF_LIST = OFF_TOKP + al256((size_t)NT * 2 * 4);
constexpr size_t OFF_WIN = OFF_LIST + al256((size_t)NE * NT * 4);
constexpr size_t OFF_WO = OFF_WIN + (size_t)2 * INWP * 1024 * 2;
constexpr size_t OFF_WUQ = OFF_WO + (size_t)2 * 1024 * 1024 * 2;
constexpr size_t OFF_WUKV = OFF_WUQ + (size_t)2 * 384 * 256 * 2;
constexpr size_t OFF_WGU = OFF_WUKV + (size_t)2 * 512 * 128 * 2;
constexpr size_t OFF_WD = OFF_WGU + (size_t)2 * 16 * 1024 * 1024 * 2;
constexpr size_t OFF_SGU = OFF_WD + (size_t)2 * 16 * 1024 * 512 * 2;
constexpr size_t OFF_SD = OFF_SGU + (size_t)2 * 1024 * 1024 * 2;
constexpr size_t OFF_H = OFF_SD + (size_t)2 * 1024 * 512 * 2;
constexpr size_t OFF_BIG = OFF_H + (size_t)NT * 1024 * 2;
constexpr size_t OFF_SWQ = OFF_BIG;
constexpr size_t OFF_SWK = OFF_SWQ + (size_t)NT * 384 * 2;
constexpr size_t OFF_SWV = OFF_SWK + (size_t)NT * 128 * 2;
constexpr size_t OFF_GLQ = OFF_SWV + (size_t)NT * 128 * 2;
constexpr size_t OFF_GLK = OFF_GLQ + (size_t)NT * 384 * 2;
constexpr size_t OFF_GLV = OFF_GLK + (size_t)NT * 128 * 2;
constexpr size_t OFF_MLQ = OFF_GLV + (size_t)NT * 128 * 2;
constexpr size_t OFF_MLK = OFF_MLQ + (size_t)NT * 384 * 2;
constexpr size_t OFF_MLKR = OFF_MLK + (size_t)NT * 256 * 2;
constexpr size_t OFF_MLV = OFF_MLKR + (size_t)NT * 32 * 2;
constexpr size_t OFF_QLAT = OFF_MLV + (size_t)NT * 256 * 2;
constexpr size_t OFF_KVLAT = OFF_QLAT + (size_t)NT * 256 * 2;
constexpr size_t OFF_Y = OFF_KVLAT + (size_t)NT * 128 * 2;
constexpr size_t END_A = OFF_Y + (size_t)NT * 1024 * 2;
constexpr size_t OFF_ACT = OFF_BIG;
constexpr size_t OFF_ACTS = OFF_ACT + (size_t)MAXSLOT * 512 * 2;
constexpr size_t OFF_YEXP = OFF_ACTS + (size_t)NT * 512 * 2;
constexpr size_t END_B = OFF_YEXP + (size_t)MAXSLOT * 1024 * 2;
constexpr size_t OFF_YSH = OFF_H;
constexpr size_t WS_NEED = END_A > END_B ? END_A : END_B;
static_assert(WS_NEED <= (size_t)536870912, "workspace too large");

constexpr int CW_CTR = 0;
constexpr int CW_CNT = 64;

struct Params {
  const float *x, *c, *ctx, *c_ctx, *w_mod, *b_mod, *norm_mix_g, *norm_ffn_g, *w_in, *w_out, *swa_sink, *glb_q_gain, *glb_k_gain,
      *mla_q_gain, *mla_w_uq, *mla_kv_gain, *mla_w_ukv, *router_w, *router_bias, *exp_w_gate, *exp_w_up, *exp_w_down, *shr_w_gate,
      *shr_w_up, *shr_w_down, *final_norm_g;
  float* out;
  char* ws;
};

constexpr int LDS_MISC = 65536;
constexpr int LDS_BYTES = 65536 + 4096;

DI int next_unit(unsigned* ctr, LAS char* lds) {
  volatile LAS int* slot = (volatile LAS int*)(lds + LDS_MISC + 2560);
  __syncthreads();
  if (threadIdx.x == 0) *slot = (int)atomicAdd(ctr, 1u);
  __syncthreads();
  return *slot;
}

DI void cvt_job(const float* __restrict__ src, int ld, int N, int k0, int n0, u16* __restrict__ dst, int K, int mode  , LAS char* lds) {
  LAS float* T = (LAS float*)lds;
  const int tid = threadIdx.x;
  __syncthreads();
  {
    const int kk = tid >> 2, nq = (tid & 3) * 32;
    const float* s = src + (size_t)(k0 + kk) * ld + n0 + nq;
#pragma unroll
    for (int i = 0; i < 8; ++i) {
      float4 v = make_float4(0.f, 0.f, 0.f, 0.f);
      if (n0 + nq + i * 4 < N) v = *(const float4*)(s + i * 4);
      LAS float* t = T + kk * 129 + nq + i * 4;
      t[0] = v.x; t[1] = v.y; t[2] = v.z; t[3] = v.w;
    }
  }
  __syncthreads();
#pragma unroll
  for (int i = 0; i < 4; ++i) {
    const int chn = tid + i * 256;
    const int n = chn >> 3, kc = (chn & 7) * 8;
    if (n0 + n < N) {
      const LAS float* t = T + kc * 129 + n;
      uint4 o;
      o.x = cvtpk(t[0], t[129]); o.y = cvtpk(t[2 * 129], t[3 * 129]); o.z = cvtpk(t[4 * 129], t[5 * 129]); o.w = cvtpk(t[6 * 129], t[7 * 129]);
      const int gn = n0 + n;
      int drow = gn;
      if (mode) drow = (gn >> 5) * 64 + (gn & 31) + (mode == 2 ? 32 : 0);
      *(uint4*)(dst + (size_t)drow * K + k0 + kc) = o;
    }
  }
}

DI void mod_job(const Params& p, int l, int j0, LAS char* lds) {
  LAS float* sc = (LAS float*)lds;
  LAS float* red = (LAS float*)(lds + 36864);
  const int tid = threadIdx.x;
  __syncthreads();
  for (int i = tid; i < 9 * 1024; i += NTHR) {
    int r = i >> 10, k = i & 1023;
    float v = r < 8 ? p.c[r * 1024 + k] : p.c_ctx[k];
    sc[i] = v / (1.f + __expf(-v));
  }
  __syncthreads();
  const int col = tid & 63, kg = tid >> 6;
  float acc[9];
#pragma unroll
  for (int r = 0; r < 9; ++r) acc[r] = 0.f;
  const float* w = p.w_mod + (size_t)l * 1024 * 6144 + (size_t)(kg * 256) * 6144 + j0 + col;
  for (int k = 0; k < 256; ++k) {
    float wv = w[(size_t)k * 6144];
#pragma unroll
    for (int r = 0; r < 9; ++r) acc[r] += sc[r * 1024 + kg * 256 + k] * wv;
  }
#pragma unroll
  for (int r = 0; r < 9; ++r) red[(kg * 9 + r) * 64 + col] = acc[r];
  __syncthreads();
  float* MOD = (float*)(p.ws + OFF_MOD);
  for (int i = tid; i < 9 * 64; i += NTHR) {
    int r = i >> 6, cc = i & 63;
    float s = red[(0 * 9 + r) * 64 + cc] + red[(1 * 9 + r) * 64 + cc] + red[(2 * 9 + r) * 64 + cc] + red[(3 * 9 + r) * 64 + cc];
    MOD[(size_t)(l * 9 + r) * 6144 + j0 + cc] = s + p.b_mod[l * 6144 + j0 + cc];
  }
}

constexpr int J_WIN = 16 * 14, J_WO = 16 * 8, J_UQ = 4 * 3, J_UKV = 2 * 4, J_EG = 16 * 4, J_ED = 8 * 8;
constexpr int J_DENSE = J_WIN + J_WO + J_UQ + J_UKV;
constexpr int J_EXP = 16 * (2 * J_EG + J_ED);
constexpr int J_SHR = 2 * J_EG + J_ED;
constexpr int J_LAYER = J_DENSE + J_EXP + J_SHR;
constexpr int J_MOD = 2 * 96;
constexpr int J_TOTAL = 2 * J_LAYER + J_MOD;

DI void p0_prologue(const Params& p, LAS char* lds) {
  char* ws = p.ws;
  for (int job = blockIdx.x; job < J_TOTAL; job += gridDim.x) {
    if (job < J_MOD) { mod_job(p, job / 96, (job % 96) * 64, lds); continue; }
    int r = job - J_MOD;
    const int l = r / J_LAYER; r -= l * J_LAYER;
    if (r < J_WIN) { cvt_job(p.w_in + (size_t)l * 1024 * INW, INW, INW, (r / 14) * 64, (r % 14) * 128, (u16*)(ws + OFF_WIN) + (size_t)l * INWP * 1024, 1024, 0, lds); continue; } r -= J_WIN;
    if (r < J_WO) { cvt_job(p.w_out + (size_t)l * 1024 * 1024, 1024, 1024, (r / 8) * 64, (r % 8) * 128, (u16*)(ws + OFF_WO) + (size_t)l * 1024 * 1024, 1024, 0, lds); continue; } r -= J_WO;
    if (r < J_UQ) { cvt_job(p.mla_w_uq + (size_t)l * 256 * 384, 384, 384, (r / 3) * 64, (r % 3) * 128, (u16*)(ws + OFF_WUQ) + (size_t)l * 384 * 256, 256, 0, lds); continue; } r -= J_UQ;
    if (r < J_UKV) { cvt_job(p.mla_w_ukv + (size_t)l * 128 * 512, 512, 512, (r / 4) * 64, (r % 4) * 128, (u16*)(ws + OFF_WUKV) + (size_t)l * 512 * 128, 128, 0, lds); continue; } r -= J_UKV;
    if (r < J_EXP) {
      const int e = r / (2 * J_EG + J_ED); int q = r % (2 * J_EG + J_ED);
      const size_t le = (size_t)l * NE + e;
      if (q < J_EG) { cvt_job(p.exp_w_gate + le * 1024 * 512, 512, 512, (q / 4) * 64, (q % 4) * 128, (u16*)(ws + OFF_WGU) + le * 1024 * 1024, 1024, 1, lds); continue; } q -= J_EG;
      if (q < J_EG) { cvt_job(p.exp_w_up + le * 1024 * 512, 512, 512, (q / 4) * 64, (q % 4) * 128, (u16*)(ws + OFF_WGU) + le * 1024 * 1024, 1024, 2, lds); continue; } q -= J_EG;
      cvt_job(p.exp_w_down + le * 512 * 1024, 1024, 1024, (q / 8) * 64, (q % 8) * 128, (u16*)(ws + OFF_WD) + le * 1024 * 512, 512, 0, lds); continue;
    }
    r -= J_EXP;
    if (r < J_EG) { cvt_job(p.shr_w_gate + (size_t)l * 1024 * 512, 512, 512, (r / 4) * 64, (r % 4) * 128, (u16*)(ws + OFF_SGU) + (size_t)l * 1024 * 1024, 1024, 1, lds); continue; } r -= J_EG;
    if (r < J_EG) { cvt_job(p.shr_w_up + (size_t)l * 1024 * 512, 512, 512, (r / 4) * 64, (r % 4) * 128, (u16*)(ws + OFF_SGU) + (size_t)l * 1024 * 1024, 1024, 2, lds); continue; } r -= J_EG;
    cvt_job(p.shr_w_down + (size_t)l * 512 * 1024, 1024, 1024, (r / 8) * 64, (r % 8) * 128, (u16*)(ws + OFF_SD) + (size_t)l * 1024 * 512, 512, 0, lds);
  }
}

DI const float* xrow_ptr(const Params& p, int layer_src  , int row) {
  if (layer_src == 0) return row < NL ? p.x + (size_t)row * 1024 : p.ctx + (size_t)(row - NL) * 1024;
  return row < NL ? p.out + (size_t)row * 1024 : (const float*)(p.ws + OFF_CTXR) + (size_t)(row - NL) * 1024;
}
DI float* xrow_out(const Params& p, int row) {
  return row < NL ? p.out + (size_t)row * 1024 : (float*)(p.ws + OFF_CTXR) + (size_t)(row - NL) * 1024;
}

DI void norm_mod_row(f32x4 (&v)[4], const float* __restrict__ g, const float* __restrict__ md  , int lane) {
  float ss = 0.f;
#pragma unroll
  for (int i = 0; i < 4; ++i) ss += v[i].x * v[i].x + v[i].y * v[i].y + v[i].z * v[i].z + v[i].w * v[i].w;
  ss = wave_sum(ss);
  const float rstd = rsqrtf(ss * (1.f / 1024.f) + EPS);
#pragma unroll
  for (int i = 0; i < 4; ++i) {
    const f32x4 gg = *(const f32x4*)(g + lane * 4 + i * 256);
    const f32x4 sh = *(const f32x4*)(md + lane * 4 + i * 256);
    const f32x4 sc = *(const f32x4*)(md + 1024 + lane * 4 + i * 256);
    v[i] = v[i] * rstd * gg * (sc + 1.f) + sh;
  }
}
DI void store_h_row(const f32x4 (&v)[4], u16* __restrict__ hrow, int lane) {
#pragma unroll
  for (int i = 0; i < 4; ++i) {
    uint2 o; o.x = cvtpk(v[i].x, v[i].y); o.y = cvtpk(v[i].z, v[i].w);
    *(uint2*)(hrow + lane * 4 + i * 256) = o;
  }
}

DI void p1_norm_mix(const Params& p, int layer) {
  const int lane = threadIdx.x & 63, gw = blockIdx.x * 4 + (threadIdx.x >> 6), ngw = gridDim.x * 4;
  const float* MODl = (const float*)(p.ws + OFF_MOD) + (size_t)layer * 9 * 6144;
  u16* H = (u16*)(p.ws + OFF_H);
  for (int row = gw; row < NT; row += ngw) {
    const float* xr = xrow_ptr(p, layer, row);
    f32x4 v[4];
#pragma unroll
    for (int i = 0; i < 4; ++i) v[i] = *(const f32x4*)(xr + lane * 4 + i * 256);
    const int mr = row < NL ? row / S_ : 8;
    norm_mod_row(v, p.norm_mix_g + layer * 1024, MODl + (size_t)mr * 6144, lane);
    store_h_row(v, H + (size_t)row * 1024, lane);
  }
}

DI void route_row(const Params& p, int layer, int row, const f32x4 (&v)[4], LAS char* lds, int lane, int wid) {
  const LAS f32x4* R = (const LAS f32x4*)lds;
  float pl[16];
#pragma unroll
  for (int e = 0; e < 16; ++e) pl[e] = 0.f;
#pragma unroll
  for (int i = 0; i < 4; ++i) {
    const int kq = i * 64 + lane;
#pragma unroll
    for (int kk = 0; kk < 4; ++kk) {
      const float hv = v[i][kk];
#pragma unroll
      for (int q = 0; q < 4; ++q) {
        const f32x4 w = R[(kk * 4 + q) * 256 + kq];
        pl[q * 4 + 0] += hv * w.x; pl[q * 4 + 1] += hv * w.y; pl[q * 4 + 2] += hv * w.z; pl[q * 4 + 3] += hv * w.w;
      }
    }
  }
#pragma unroll
  for (int e = 0; e < 16; ++e) pl[e] = wave_sum(pl[e]);
  volatile LAS float* sg = (volatile LAS float*)(lds + LDS_MISC + 3072) + wid * 32;
  if (lane == 0) {
#pragma unroll
    for (int e = 0; e < 16; ++e) { float s = 1.f / (1.f + expf(-pl[e])); sg[e] = s; sg[16 + e] = s + p.router_bias[e]; }
    int bg = 0; float bgs = -1e30f;
    for (int gI = 0; gI < 4; ++gI) {
      float m1 = -1e30f, m2 = -1e30f;
      for (int e = 0; e < 4; ++e) { float x = sg[16 + gI * 4 + e]; if (x > m1) { m2 = m1; m1 = x; } else if (x > m2) m2 = x; }
      float gs = m1 + m2;
      if (gs > bgs) { bgs = gs; bg = gI; }
    }
    int i0 = bg * 4, i1 = bg * 4; float v0 = -1e30f, v1 = -1e30f;
    for (int e = 0; e < 4; ++e) { float x = sg[16 + bg * 4 + e]; if (x > v0) { v0 = x; i0 = bg * 4 + e; } }
    for (int e = 0; e < 4; ++e) { int ee = bg * 4 + e; if (ee == i0) continue; float x = sg[16 + ee]; if (x > v1) { v1 = x; i1 = ee; } }
    const float w0 = sg[i0], w1 = sg[i1], inv = 1.f / (w0 + w1);
    unsigned* cnt = (unsigned*)(p.ws + OFF_CTRL) + CW_CNT + layer * 16;
    int* tok_e = (int*)(p.ws + OFF_TOKE); float* tok_w = (float*)(p.ws + OFF_TOKW); int* tok_p = (int*)(p.ws + OFF_TOKP);
    int* list = (int*)(p.ws + OFF_LIST);
    const int p0 = (int)atomicAdd(&cnt[i0], 1u), p1 = (int)atomicAdd(&cnt[i1], 1u);
    tok_e[row * 2] = i0; tok_e[row * 2 + 1] = i1;
    tok_w[row * 2] = w0 * inv; tok_w[row * 2 + 1] = w1 * inv;
    tok_p[row * 2] = p0; tok_p[row * 2 + 1] = p1;
    list[(size_t)i0 * NT + p0] = row; list[(size_t)i1 * NT + p1] = row;
  }
}

DI void load_router_lds(const Params& p, LAS char* lds) {
  LAS f32x4* R = (LAS f32x4*)lds;
  __syncthreads();
  for (int g = threadIdx.x; g < 4096; g += NTHR) {
    const int k = g >> 2, q = g & 3;
    R[((k & 3) * 4 + q) * 256 + (k >> 2)] = *(const f32x4*)(p.router_w + (size_t)g * 4);
  }
  __syncthreads();
}

DI void p5_norm_ffn(const Params& p, int layer, int nrows, LAS char* lds) {
  load_router_lds(p, lds);
  const int lane = threadIdx.x & 63, wid = threadIdx.x >> 6, gw = blockIdx.x * 4 + wid, ngw = gridDim.x * 4;
  const float* MODl = (const float*)(p.ws + OFF_MOD) + (size_t)layer * 9 * 6144;
  u16* H = (u16*)(p.ws + OFF_H);
  for (int row = gw; row < nrows; row += ngw) {
    const float* xr = xrow_ptr(p, 1, row);
    f32x4 v[4];
#pragma unroll
    for (int i = 0; i < 4; ++i) v[i] = *(const f32x4*)(xr + lane * 4 + i * 256);
    const int mr = row < NL ? row / S_ : 8;
    norm_mod_row(v, p.norm_ffn_g + layer * 1024, MODl + (size_t)mr * 6144 + 3 * 1024, lane);
    store_h_row(v, H + (size_t)row * 1024, lane);
    route_row(p, layer, row, v, lds, lane, wid);
  }
}

DI void seg_scan(const Params& p, int layer, int (&tb)[NE + 1]) {
  const unsigned* cnt = (const unsigned*)(p.ws + OFF_CTRL) + CW_CNT + layer * 16;
  int acc = 0;
#pragma unroll
  for (int e = 0; e < NE; ++e) { tb[e] = acc; acc += ((int)cnt[e] + 127) >> 7; }
  tb[NE] = acc;
}

DI void p8_combine(const Params& p, int layer, int nrows) {
  const int lane = threadIdx.x & 63, gw = blockIdx.x * 4 + (threadIdx.x >> 6), ngw = gridDim.x * 4;
  const float* MODl = (const float*)(p.ws + OFF_MOD) + (size_t)layer * 9 * 6144;
  const float* MODn = (const float*)(p.ws + OFF_MOD) + (size_t)(layer + 1) * 9 * 6144;
  u16* H = (u16*)(p.ws + OFF_H);
  const u16* YSH = (const u16*)(p.ws + OFF_YSH);
  const u16* YEXP = (const u16*)(p.ws + OFF_YEXP);
  const int* tok_e = (const int*)(p.ws + OFF_TOKE); const float* tok_w = (const float*)(p.ws + OFF_TOKW); const int* tok_p = (const int*)(p.ws + OFF_TOKP);
  int tb[NE + 1]; seg_scan(p, layer, tb);
  for (int row = gw; row < nrows; row += ngw) {
    const int e0 = tok_e[row * 2], e1 = tok_e[row * 2 + 1];
    int ps0 = 0, ps1 = 0;
#pragma unroll
    for (int e = 0; e < NE; ++e) { if (e == e0) ps0 = tb[e]; if (e == e1) ps1 = tb[e]; }
    const size_t s0 = (size_t)ps0 * 128 + tok_p[row * 2], s1 = (size_t)ps1 * 128 + tok_p[row * 2 + 1];
    const float w0 = tok_w[row * 2], w1 = tok_w[row * 2 + 1];
    float* xr = xrow_out(p, row);
    const int mr = row < NL ? row / S_ : 8;
    const float* gate = MODl + (size_t)mr * 6144 + 5 * 1024;
    f32x4 v[4];
#pragma unroll
    for (int i = 0; i < 4; ++i) {
      const int cidx = lane * 4 + i * 256;
      const uint2 a = *(const uint2*)(YEXP + s0 * 1024 + cidx);
      const uint2 b = *(const uint2*)(YEXP + s1 * 1024 + cidx);
      const uint2 c = *(const uint2*)(YSH + (size_t)row * 1024 + cidx);
      const f32x4 g = *(const f32x4*)(gate + cidx);
      f32x4 x = *(const f32x4*)(xr + cidx);
      x.x += g.x * (w0 * bflo(a.x) + w1 * bflo(b.x) + bflo(c.x));
      x.y += g.y * (w0 * bfhi(a.x) + w1 * bfhi(b.x) + bfhi(c.x));
      x.z += g.z * (w0 * bflo(a.y) + w1 * bflo(b.y) + bflo(c.y));
      x.w += g.w * (w0 * bfhi(a.y) + w1 * bfhi(b.y) + bfhi(c.y));
      v[i] = x;
    }
    if (layer == 0) {
#pragma unroll
      for (int i = 0; i < 4; ++i) *(f32x4*)(xr + lane * 4 + i * 256) = v[i];
      norm_mod_row(v, p.norm_mix_g + 1024, MODn + (size_t)mr * 6144, lane);
      store_h_row(v, H + (size_t)row * 1024, lane);
    } else {
      float ss = 0.f;
#pragma unroll
      for (int i = 0; i < 4; ++i) ss += v[i].x * v[i].x + v[i].y * v[i].y + v[i].z * v[i].z + v[i].w * v[i].w;
      ss = wave_sum(ss);
      const float rstd = rsqrtf(ss * (1.f / 1024.f) + EPS);
#pragma unroll
      for (int i = 0; i < 4; ++i) {
        const f32x4 gg = *(const f32x4*)(p.final_norm_g + lane * 4 + i * 256);
        *(f32x4*)(xr + lane * 4 + i * 256) = v[i] * rstd * gg;
      }
    }
  }
}

DI void glds16(const u16* g, LAS char* l) {
  __builtin_amdgcn_global_load_lds((const void*)g, (LAS void*)l, 16, 0, 0);
}
DI void gemm_tile(LAS char* lds, const u16* a0, const u16* a1, const u16* b0, const u16* b1, int nk, f32x4 (&acc)[4][4]) {
  const int tid = threadIdx.x, lane = tid & 63, wid = tid >> 6, wr = wid >> 1, wc = wid & 1, fr = lane & 15, fq = lane >> 4;
  const int cx = (fq ^ ((0 - (fr >> 2)) & 3)) * 16;
  const int aoff = (wr * 64 + fr) * 64 + cx;
  const int boff = 16384 + (wc * 64 + fr) * 64 + cx;
#pragma unroll
  for (int m = 0; m < 4; ++m)
#pragma unroll
    for (int n = 0; n < 4; ++n) acc[m][n] = (f32x4){0.f, 0.f, 0.f, 0.f};
  LAS char* ldst = lds + tid * 16;
#define GT_ISSUE(kt, s) do { const int _ko = (kt) * 64; LAS char* _d = ldst + (s) * 32768; \
    glds16(a0 + _ko, _d); glds16(a1 + _ko, _d + 4096); glds16(a0 + _ko + 32, _d + 8192); glds16(a1 + _ko + 32, _d + 12288); \
    glds16(b0 + _ko, _d + 16384); glds16(b1 + _ko, _d + 20480); glds16(b0 + _ko + 32, _d + 24576); glds16(b1 + _ko + 32, _d + 28672); } while (0)
  GT_ISSUE(0, 0);
#pragma unroll 1
  for (int kt = 0; kt < nk; ++kt) {
    asm volatile("s_waitcnt vmcnt(0)" ::: "memory");
    __syncthreads();
    if (kt + 1 < nk) GT_ISSUE(kt + 1, (kt + 1) & 1);
    const LAS char* sb = lds + (kt & 1) * 32768;
#pragma unroll
    for (int h = 0; h < 2; ++h) {
      bf16x8 af[4], bfr[4];
#pragma unroll
      for (int m = 0; m < 4; ++m) af[m] = *(const LAS bf16x8*)(sb + h * 8192 + aoff + m * 1024);
#pragma unroll
      for (int n = 0; n < 4; ++n) bfr[n] = *(const LAS bf16x8*)(sb + h * 8192 + boff + n * 1024);
#pragma unroll
      for (int m = 0; m < 4; ++m)
#pragma unroll
        for (int n = 0; n < 4; ++n) acc[m][n] = __builtin_amdgcn_mfma_f32_16x16x32_bf16(bfr[n], af[m], acc[m][n], 0, 0, 0);
    }
  }
#undef GT_ISSUE
  __syncthreads();
}
DI int gt_chunk(int tid) { return (((tid & 3) ^ ((0 - ((tid >> 4) & 3)) & 3))) * 8; }
DI int gt_row0(int tid) { return tid >> 2; }
DI int opaque(int v) { asm volatile("" : "+v"(v)); return v; }

DI void sincos_rev(float pos, float invf, float& sn, float& cs) {
  float rev = pos * invf * 0.15915494309189535f;
  rev -= rintf(rev);
  sn = __builtin_amdgcn_sinf(rev); cs = __builtin_amdgcn_cosf(rev);
}
DI void st_bf4(u16* dst, const f32x4& v) { uint2 o; o.x = cvtpk(v[0], v[1]); o.y = cvtpk(v[2], v[3]); *(uint2*)dst = o; }

DI void epi_inproj(const Params& p, int layer, f32x4 (&acc)[4][4], int m0, int seg, int wr, int fr, int fq, LAS float* rowss_slot) {
  char* ws = p.ws;
  const bool lat = m0 < NL;
  const int rbase = m0 + wr * 64 + fr;
  u16* dst; int ld, cb; int kind;
  if (seg < 6) { dst = (u16*)(ws + OFF_SWQ); ld = 384; cb = seg * 64; kind = 1; }
  else if (seg < 8) { dst = (u16*)(ws + OFF_SWK); ld = 128; cb = (seg - 6) * 64; kind = 1; }
  else if (seg < 10) { dst = (u16*)(ws + OFF_SWV); ld = 128; cb = (seg - 8) * 64; kind = 0; }
  else if (seg < 16) { dst = (u16*)(ws + OFF_GLQ); ld = 384; cb = (seg - 10) * 64; kind = 2; }
  else if (seg < 18) { dst = (u16*)(ws + OFF_GLK); ld = 128; cb = (seg - 16) * 64; kind = 3; }
  else if (seg < 20) { dst = (u16*)(ws + OFF_GLV); ld = 128; cb = (seg - 18) * 64; kind = 0; }
  else if (seg < 24) { dst = (u16*)(ws + OFF_QLAT); ld = 256; cb = (seg - 20) * 64; kind = 4; }
  else if (seg < 26) { dst = (u16*)(ws + OFF_KVLAT); ld = 128; cb = (seg - 24) * 64; kind = 5; }
  else if (seg == 26) { dst = (u16*)(ws + OFF_MLKR); ld = 32; cb = 0; kind = 6; }
  else return;
  if (kind == 2 || kind == 3) {
    const float* gain = (kind == 2 ? p.glb_q_gain : p.glb_k_gain) + layer * 64;
    f32x4 gv[4];
#pragma unroll
    for (int n = 0; n < 4; ++n) gv[n] = *(const f32x4*)(gain + n * 16 + fq * 4);
#pragma unroll
    for (int m = 0; m < 4; ++m) {
      float ss = 0.f;
#pragma unroll
      for (int n = 0; n < 4; ++n) ss += acc[m][n][0] * acc[m][n][0] + acc[m][n][1] * acc[m][n][1] + acc[m][n][2] * acc[m][n][2] + acc[m][n][3] * acc[m][n][3];
      ss += __shfl_xor(ss, 16); ss += __shfl_xor(ss, 32);
      const float r = rsqrtf(ss * (1.f / 64.f) + EPS);
#pragma unroll
      for (int n = 0; n < 4; ++n) acc[m][n] = acc[m][n] * r * gv[n];
    }
  }
  if (kind == 4 || kind == 5) {
    const float* gain = (kind == 4 ? p.mla_q_gain + layer * 256 : p.mla_kv_gain + layer * 128) + cb;
    f32x4 gv[4];
#pragma unroll
    for (int n = 0; n < 4; ++n) gv[n] = *(const f32x4*)(gain + n * 16 + fq * 4);
#pragma unroll
    for (int m = 0; m < 4; ++m) {
      float ss = 0.f;
#pragma unroll
      for (int n = 0; n < 4; ++n) ss += acc[m][n][0] * acc[m][n][0] + acc[m][n][1] * acc[m][n][1] + acc[m][n][2] * acc[m][n][2] + acc[m][n][3] * acc[m][n][3];
      ss += __shfl_xor(ss, 16); ss += __shfl_xor(ss, 32);
      if (fq == 0) rowss_slot[wr * 64 + m * 16 + fr] = ss;
#pragma unroll
      for (int n = 0; n < 4; ++n) acc[m][n] = acc[m][n] * gv[n];
    }
  }
  if (lat && (kind == 1 || kind == 2 || kind == 3)) {
    float invf[4];
#pragma unroll
    for (int j = 0; j < 4; ++j) invf[j] = __builtin_amdgcn_exp2f(-(float)(fq * 4 + j) * (13.287712379549449f / 16.f));
#pragma unroll
    for (int m = 0; m < 4; ++m) {
      const int t = (rbase + m * 16) & (S_ - 1);
      const float prow = (float)(t >> 6), pcol = (float)(t & 63);
#pragma unroll
      for (int j = 0; j < 4; ++j) {
        float sr, cr, sc, cc;
        sincos_rev(prow, invf[j], sr, cr); sincos_rev(pcol, invf[j], sc, cc);
        float x1 = acc[m][0][j], x2 = acc[m][1][j];
        acc[m][0][j] = x1 * cr - x2 * sr; acc[m][1][j] = x2 * cr + x1 * sr;
        x1 = acc[m][2][j]; x2 = acc[m][3][j];
        acc[m][2][j] = x1 * cc - x2 * sc; acc[m][3][j] = x2 * cc + x1 * sc;
      }
    }
  }
  if (kind == 6) {
    if (lat) {
      float invf[4];
#pragma unroll
      for (int j = 0; j < 4; ++j) invf[j] = __builtin_amdgcn_exp2f(-(float)((fq & 1) * 4 + j) * (13.287712379549449f / 8.f));
#pragma unroll
      for (int m = 0; m < 4; ++m) {
        const int t = (rbase + m * 16) & (S_ - 1);
#pragma unroll
        for (int n = 0; n < 2; ++n) {
          const float pos = n == 0 ? (float)(t >> 6) : (float)(t & 63);
#pragma unroll
          for (int j = 0; j < 4; ++j) {
            float sn, cs; sincos_rev(pos, invf[j], sn, cs);
            const float v = acc[m][n][j], pr = __shfl_xor(v, 32);
            acc[m][n][j] = (fq & 2) ? v * cs + pr * sn : v * cs - pr * sn;
          }
        }
      }
    }
#pragma unroll
    for (int m = 0; m < 4; ++m)
#pragma unroll
      for (int n = 0; n < 2; ++n) st_bf4(dst + (size_t)(rbase + m * 16) * ld + n * 16 + fq * 4, acc[m][n]);
    return;
  }
#pragma unroll
  for (int m = 0; m < 4; ++m)
#pragma unroll
    for (int n = 0; n < 4; ++n) st_bf4(dst + (size_t)(rbase + m * 16) * ld + cb + n * 16 + fq * 4, acc[m][n]);
}

DI void p2_inproj(const Params& p, int layer, LAS char* lds) {
  char* ws = p.ws;
  unsigned* ctr = (unsigned*)(ws + OFF_CTRL) + CW_CTR + layer * 16 + 2;
  const u16* H = (const u16*)(ws + OFF_H);
  const u16* WinT = (const u16*)(ws + OFF_WIN) + (size_t)layer * INWP * 1024;
  const u16* WuqT = (const u16*)(ws + OFF_WUQ) + (size_t)layer * 384 * 256;
  const u16* WukvT = (const u16*)(ws + OFF_WUKV) + (size_t)layer * 512 * 128;
  const int tid = threadIdx.x, lane = tid & 63, wid = tid >> 6, wr = wid >> 1, wc = wid & 1;
  LAS float* rowss = (LAS float*)(lds + LDS_MISC);
  LAS float* rstd = (LAS float*)(lds + LDS_MISC + 2048);
  const int nunits = (NT / 128) * 12;
  f32x4 acc[4][4];
  for (;;) {
    const int u = next_unit(ctr, lds);
    if (u >= nunits) break;
    const int tid_o = opaque(tid), lane_o = tid_o & 63;
    const int fr = lane_o & 15, fq = lane_o >> 4, ch = gt_chunk(tid_o), r0 = gt_row0(tid_o);
    const int rt = u / 12, k = u % 12, m0 = rt * 128;
    const u16* a0 = H + (size_t)(m0 + r0) * 1024 + ch;
    const u16* a1 = a0 + (size_t)64 * 1024;
    if (k < 10) {
      const u16* b0 = WinT + (size_t)(k * 128 + r0) * 1024 + ch;
      gemm_tile(lds, a0, a1, b0, b0 + (size_t)64 * 1024, 16, acc);
      epi_inproj(p, layer, acc, m0, k * 2 + wc, wr, fr, fq, rowss);
    } else if (k == 10) {
#pragma unroll 1
      for (int t = 0; t < 2; ++t) {
        const u16* b0 = WinT + (size_t)(1280 + t * 128 + r0) * 1024 + ch;
        gemm_tile(lds, a0, a1, b0, b0 + (size_t)64 * 1024, 16, acc);
        epi_inproj(p, layer, acc, m0, 20 + t * 2 + wc, wr, fr, fq, rowss + (t * 2 + wc) * 128);
      }
      __syncthreads();
      if (tid < 128) rstd[tid] = rsqrtf((rowss[tid] + rowss[128 + tid] + rowss[256 + tid] + rowss[384 + tid]) * (1.f / 256.f) + EPS);
      __syncthreads();
      const u16* QL = (const u16*)(ws + OFF_QLAT);
      const u16* qa0 = QL + (size_t)(m0 + r0) * 256 + ch;
      const u16* qa1 = qa0 + (size_t)64 * 256;
      u16* MLQ = (u16*)(ws + OFF_MLQ);
      const bool lat = m0 < NL;
#pragma unroll 1
      for (int t = 0; t < 3; ++t) {
        const u16* b0 = WuqT + (size_t)(t * 128 + r0) * 256 + ch;
        gemm_tile(lds, qa0, qa1, b0, b0 + (size_t)64 * 256, 4, acc);
        const int c0 = t * 128 + wc * 64;
        float invf[4];
#pragma unroll
        for (int j = 0; j < 4; ++j) invf[j] = __builtin_amdgcn_exp2f(-(float)((fq & 1) * 4 + j) * (13.287712379549449f / 8.f));
#pragma unroll
        for (int m = 0; m < 4; ++m) {
          const int rl = wr * 64 + m * 16 + fr;
          const float rs = rstd[rl];
          const int tpos = (m0 + rl) & (S_ - 1);
#pragma unroll
          for (int n = 0; n < 4; ++n) {
            acc[m][n] = acc[m][n] * rs;
            const int w96 = (c0 + n * 16) % 96;
            if (lat && w96 >= 64) {
              const float pos = (w96 == 64) ? (float)(tpos >> 6) : (float)(tpos & 63);
#pragma unroll
              for (int j = 0; j < 4; ++j) {
                float sn, cs; sincos_rev(pos, invf[j], sn, cs);
                const float v = acc[m][n][j], pr = __shfl_xor(v, 32);
                acc[m][n][j] = (fq & 2) ? v * cs + pr * sn : v * cs - pr * sn;
              }
            }
            st_bf4(MLQ + (size_t)(m0 + rl) * 384 + c0 + n * 16 + fq * 4, acc[m][n]);
          }
        }
      }
    } else {
      {
        const u16* b0 = WinT + (size_t)(1536 + r0) * 1024 + ch;
        gemm_tile(lds, a0, a1, b0, b0 + (size_t)64 * 1024, 16, acc);
        epi_inproj(p, layer, acc, m0, 24 + wc, wr, fr, fq, rowss + wc * 128);
        const u16* b2 = WinT + (size_t)(1664 + r0) * 1024 + ch;
        gemm_tile(lds, a0, a1, b2, b2 + (size_t)64 * 1024, 16, acc);
        epi_inproj(p, layer, acc, m0, 26 + wc, wr, fr, fq, rowss);
      }
      __syncthreads();
      if (tid < 128) rstd[tid] = rsqrtf((rowss[tid] + rowss[128 + tid]) * (1.f / 128.f) + EPS);
      __syncthreads();
      const u16* KL = (const u16*)(ws + OFF_KVLAT);
      const u16* ka0 = KL + (size_t)(m0 + r0) * 128 + ch;
      const u16* ka1 = ka0 + (size_t)64 * 128;
#pragma unroll 1
      for (int t = 0; t < 4; ++t) {
        const u16* b0 = WukvT + (size_t)(t * 128 + r0) * 128 + ch;
        gemm_tile(lds, ka0, ka1, b0, b0 + (size_t)64 * 128, 2, acc);
        u16* dst = (u16*)(ws + (wc == 0 ? OFF_MLK : OFF_MLV));
#pragma unroll
        for (int m = 0; m < 4; ++m) {
          const int rl = wr * 64 + m * 16 + fr;
          const float rs = rstd[rl];
#pragma unroll
          for (int n = 0; n < 4; ++n) { acc[m][n] = acc[m][n] * rs; st_bf4(dst + (size_t)(m0 + rl) * 256 + t * 64 + n * 16 + fq * 4, acc[m][n]); }
        }
      }
    }
  }
}

DI void p4_outproj(const Params& p, int layer, int nrows, LAS char* lds) {
  char* ws = p.ws;
  unsigned* ctr = (unsigned*)(ws + OFF_CTRL) + CW_CTR + layer * 16 + 4;
  const u16* Y = (const u16*)(ws + OFF_Y);
  const u16* WoT = (const u16*)(ws + OFF_WO) + (size_t)layer * 1024 * 1024;
  const float* MODl = (const float*)(ws + OFF_MOD) + (size_t)layer * 9 * 6144;
  const int tid = threadIdx.x, wid = tid >> 6, wr = wid >> 1, wc = wid & 1;
  const int nunits = (nrows / 128) * 8;
  f32x4 acc[4][4];
  for (;;) {
    const int u = next_unit(ctr, lds);
    if (u >= nunits) break;
    const int tid_o = opaque(tid), lane_o = tid_o & 63;
    const int fr = lane_o & 15, fq = lane_o >> 4, ch = gt_chunk(tid_o), r0 = gt_row0(tid_o);
    const int rt = u >> 3, ct = u & 7, m0 = rt * 128;
    const u16* a0 = Y + (size_t)(m0 + r0) * 1024 + ch;
    const u16* b0 = WoT + (size_t)(ct * 128 + r0) * 1024 + ch;
    gemm_tile(lds, a0, a0 + (size_t)64 * 1024, b0, b0 + (size_t)64 * 1024, 16, acc);
    const int mr = m0 < NL ? m0 / S_ : 8;
    const float* gate = MODl + (size_t)mr * 6144 + 2 * 1024 + ct * 128 + wc * 64 + fq * 4;
#pragma unroll
    for (int m = 0; m < 4; ++m) {
      const int row = m0 + wr * 64 + m * 16 + fr;
      const float* xs = xrow_ptr(p, layer, row) + ct * 128 + wc * 64 + fq * 4;
      float* xd = xrow_out(p, row) + ct * 128 + wc * 64 + fq * 4;
#pragma unroll
      for (int n = 0; n < 4; ++n) {
        const f32x4 g = *(const f32x4*)(gate + n * 16);
        const f32x4 xv = *(const f32x4*)(xs + n * 16);
        *(f32x4*)(xd + n * 16) = xv + g * acc[m][n];
      }
    }
  }
}

DI void p6_gateup(const Params& p, int layer, int nrows, LAS char* lds) {
  char* ws = p.ws;
  unsigned* ctr = (unsigned*)(ws + OFF_CTRL) + CW_CTR + layer * 16 + 6;
  const unsigned* cnt = (const unsigned*)(ws + OFF_CTRL) + CW_CNT + layer * 16;
  const u16* H = (const u16*)(ws + OFF_H);
  const int* list = (const int*)(ws + OFF_LIST);
  const u16* WguT = (const u16*)(ws + OFF_WGU) + (size_t)layer * NE * 1024 * 1024;
  const u16* SguT = (const u16*)(ws + OFF_SGU) + (size_t)layer * 1024 * 1024;
  u16* ACT = (u16*)(ws + OFF_ACT); u16* ACTS = (u16*)(ws + OFF_ACTS);
  const int tid = threadIdx.x, wid = tid >> 6, wr = wid >> 1, wc = wid & 1;
  int tb[NE + 1]; seg_scan(p, layer, tb);
  const int R = tb[NE];
  const int nunits = (R + nrows / 128) * 8;
  f32x4 acc[4][4];
  for (;;) {
    const int u = next_unit(ctr, lds);
    if (u >= nunits) break;
    const int tid_o = opaque(tid), lane_o = tid_o & 63;
    const int fr = lane_o & 15, fq = lane_o >> 4, ch = gt_chunk(tid_o), r0 = gt_row0(tid_o);
    const int rt = u >> 3, ct = u & 7;
    const u16 *a0, *a1, *b0; u16* dst; size_t orow;
    if (rt < R) {
      int e = 0, tbe = 0;
#pragma unroll
      for (int q = 1; q < NE; ++q) if (rt >= tb[q]) { e = q; tbe = tb[q]; }
      const int i = rt - tbe, ce = (int)cnt[e];
      const int i0 = i * 128 + r0, i1 = i0 + 64;
      const int t0 = i0 < ce ? list[(size_t)e * NT + i0] : 0, t1 = i1 < ce ? list[(size_t)e * NT + i1] : 0;
      a0 = H + (size_t)t0 * 1024 + ch; a1 = H + (size_t)t1 * 1024 + ch;
      b0 = WguT + ((size_t)e * 1024 + ct * 128 + r0) * 1024 + ch;
      dst = ACT; orow = (size_t)rt * 128;
    } else {
      const int m0 = (rt - R) * 128;
      a0 = H + (size_t)(m0 + r0) * 1024 + ch; a1 = a0 + (size_t)64 * 1024;
      b0 = SguT + (size_t)(ct * 128 + r0) * 1024 + ch;
      dst = ACTS; orow = (size_t)m0;
    }
    gemm_tile(lds, a0, a1, b0, b0 + (size_t)64 * 1024, 16, acc);
#pragma unroll
    for (int m = 0; m < 4; ++m) {
      u16* o = dst + (orow + wr * 64 + m * 16 + fr) * 512 + ct * 64 + wc * 32 + fq * 4;
#pragma unroll
      for (int n = 0; n < 2; ++n) {
        f32x4 r;
#pragma unroll
        for (int j = 0; j < 4; ++j) r[j] = silu(acc[m][n][j]) * acc[m][n + 2][j];
        st_bf4(o + n * 16, r);
      }
    }
  }
}

DI void p7_down(const Params& p, int layer, int nrows, LAS char* lds) {
  char* ws = p.ws;
  unsigned* ctr = (unsigned*)(ws + OFF_CTRL) + CW_CTR + layer * 16 + 7;
  const u16* WdT = (const u16*)(ws + OFF_WD) + (size_t)layer * NE * 1024 * 512;
  const u16* SdT = (const u16*)(ws + OFF_SD) + (size_t)layer * 1024 * 512;
  const u16* ACT = (const u16*)(ws + OFF_ACT); const u16* ACTS = (const u16*)(ws + OFF_ACTS);
  u16* YEXP = (u16*)(ws + OFF_YEXP); u16* YSH = (u16*)(ws + OFF_YSH);
  const int tid = threadIdx.x, wid = tid >> 6, wr = wid >> 1, wc = wid & 1;
  int tb[NE + 1]; seg_scan(p, layer, tb);
  const int R = tb[NE];
  const int nunits = (R + nrows / 128) * 8;
  f32x4 acc[4][4];
  for (;;) {
    const int u = next_unit(ctr, lds);
    if (u >= nunits) break;
    const int tid_o = opaque(tid), lane_o = tid_o & 63;
    const int fr = lane_o & 15, fq = lane_o >> 4, ch = gt_chunk(tid_o), r0 = gt_row0(tid_o);
    const int rt = u >> 3, ct = u & 7;
    const u16 *a0, *b0; u16* dst; size_t orow;
    if (rt < R) {
      int e = 0;
#pragma unroll
      for (int q = 1; q < NE; ++q) if (rt >= tb[q]) e = q;
      a0 = ACT + ((size_t)rt * 128 + r0) * 512 + ch;
      b0 = WdT + ((size_t)e * 1024 + ct * 128 + r0) * 512 + ch;
      dst = YEXP; orow = (size_t)rt * 128;
    } else {
      const int m0 = (rt - R) * 128;
      a0 = ACTS + (size_t)(m0 + r0) * 512 + ch;
      b0 = SdT + (size_t)(ct * 128 + r0) * 512 + ch;
      dst = YSH; orow = (size_t)m0;
    }
    gemm_tile(lds, a0, a0 + (size_t)64 * 512, b0, b0 + (size_t)64 * 512, 8, acc);
#pragma unroll
    for (int m = 0; m < 4; ++m) {
      u16* o = dst + (orow + wr * 64 + m * 16 + fr) * 1024 + ct * 128 + wc * 64 + fq * 4;
#pragma unroll
      for (int n = 0; n < 4; ++n) st_bf4(o + n * 16, acc[m][n]);
    }
  }
}

struct AttnArgs {
  const u16* Q; const u16* K; const u16* K2; const u16* V; u16* Y; const float* sink;
  int ldq, ldk, ldk2, ldv, ldy, ycol, G, window, q_is_ctx; float scale;
};
static_assert(sizeof(AttnArgs) == 88, "no padding");
template <int DK1, int DK2>
__global__ __launch_bounds__(64) void k_attn(AttnArgs a) {
  const int qt = blockIdx.x * 64 + threadIdx.x, b = blockIdx.y, h = blockIdx.z, kvh = h / a.G;
  const int qrow = a.q_is_ctx ? NL + b * C_ + qt : b * S_ + qt;
  float q[DK1 + DK2];
  {
    const uint4* qp = (const uint4*)(a.Q + (size_t)qrow * a.ldq + h * (DK1 + DK2));
#pragma unroll
    for (int i = 0; i < (DK1 + DK2) / 8; ++i) {
      uint4 u = qp[i];
      q[i * 8 + 0] = bflo(u.x) * a.scale; q[i * 8 + 1] = bfhi(u.x) * a.scale; q[i * 8 + 2] = bflo(u.y) * a.scale; q[i * 8 + 3] = bfhi(u.y) * a.scale;
      q[i * 8 + 4] = bflo(u.z) * a.scale; q[i * 8 + 5] = bfhi(u.z) * a.scale; q[i * 8 + 6] = bflo(u.w) * a.scale; q[i * 8 + 7] = bfhi(u.w) * a.scale;
    }
  }
  float m, l, o[64];
  if (a.sink) { m = a.sink[h]; l = 1.f; } else { m = -1e30f; l = 0.f; }
#pragma unroll
  for (int d = 0; d < 64; ++d) o[d] = 0.f;
  const int nseg = a.q_is_ctx ? 1 : 2;
  for (int seg = 0; seg < nseg; ++seg) {
    int lo, hi, rbase; bool masked = false;
    if (seg == 0) { lo = 0; hi = C_; rbase = NL + b * C_; }
    else {
      lo = 0; hi = S_; rbase = b * S_;
      if (a.window) { int t0 = blockIdx.x * 64; lo = t0 - a.window; if (lo < 0) lo = 0; hi = t0 + 64 + a.window; if (hi > S_) hi = S_; masked = true; }
    }
    for (int s = lo; s < hi; s += 4) {
      float sc[4];
#pragma unroll
      for (int i = 0; i < 4; ++i) {
        const uint4* kp = (const uint4*)(a.K + (size_t)(rbase + s + i) * a.ldk + kvh * DK1);
        float dot = 0.f;
#pragma unroll
        for (int c = 0; c < DK1 / 8; ++c) {
          uint4 u = kp[c];
          dot += q[c * 8 + 0] * bflo(u.x) + q[c * 8 + 1] * bfhi(u.x) + q[c * 8 + 2] * bflo(u.y) + q[c * 8 + 3] * bfhi(u.y)
               + q[c * 8 + 4] * bflo(u.z) + q[c * 8 + 5] * bfhi(u.z) + q[c * 8 + 6] * bflo(u.w) + q[c * 8 + 7] * bfhi(u.w);
        }
        if (DK2 > 0) {
          const uint4* kp2 = (const uint4*)(a.K2 + (size_t)(rbase + s + i) * a.ldk2);
#pragma unroll
          for (int c = 0; c < DK2 / 8; ++c) {
            uint4 u = kp2[c];
            dot += q[DK1 + c * 8 + 0] * bflo(u.x) + q[DK1 + c * 8 + 1] * bfhi(u.x) + q[DK1 + c * 8 + 2] * bflo(u.y) + q[DK1 + c * 8 + 3] * bfhi(u.y)
                 + q[DK1 + c * 8 + 4] * bflo(u.z) + q[DK1 + c * 8 + 5] * bfhi(u.z) + q[DK1 + c * 8 + 6] * bflo(u.w) + q[DK1 + c * 8 + 7] * bfhi(u.w);
          }
        }
        if (masked) { int dlt = qt - (s + i); if (dlt < 0) dlt = -dlt; if (dlt > a.window) dot = -1e30f; }
        sc[i] = dot;
      }
      float mx = fmaxf(fmaxf(fmaxf(sc[0], sc[1]), fmaxf(sc[2], sc[3])), m);
      const float alpha = __expf(m - mx);
      float pr[4];
#pragma unroll
      for (int i = 0; i < 4; ++i) pr[i] = __expf(sc[i] - mx);
      l = l * alpha + (pr[0] + pr[1]) + (pr[2] + pr[3]);
      m = mx;
#pragma unroll
      for (int d = 0; d < 64; ++d) o[d] *= alpha;
#pragma unroll
      for (int i = 0; i < 4; ++i) {
        const uint4* vp = (const uint4*)(a.V + (size_t)(rbase + s + i) * a.ldv + kvh * 64);
#pragma unroll
        for (int c = 0; c < 8; ++c) {
          uint4 u = vp[c];
          o[c * 8 + 0] += pr[i] * bflo(u.x); o[c * 8 + 1] += pr[i] * bfhi(u.x); o[c * 8 + 2] += pr[i] * bflo(u.y); o[c * 8 + 3] += pr[i] * bfhi(u.y);
          o[c * 8 + 4] += pr[i] * bflo(u.z); o[c * 8 + 5] += pr[i] * bfhi(u.z); o[c * 8 + 6] += pr[i] * bflo(u.w); o[c * 8 + 7] += pr[i] * bfhi(u.w);
        }
      }
    }
  }
  const float inv = 1.f / l;
  uint4* yp = (uint4*)(a.Y + (size_t)qrow * a.ldy + a.ycol + h * 64);
#pragma unroll
  for (int c = 0; c < 8; ++c) {
    uint4 u;
    u.x = cvtpk(o[c * 8 + 0] * inv, o[c * 8 + 1] * inv); u.y = cvtpk(o[c * 8 + 2] * inv, o[c * 8 + 3] * inv);
    u.z = cvtpk(o[c * 8 + 4] * inv, o[c * 8 + 5] * inv); u.w = cvtpk(o[c * 8 + 6] * inv, o[c * 8 + 7] * inv);
    yp[c] = u;
  }
}

template <int PH>
__global__ __launch_bounds__(NTHR, 2) void k_phase(Params p, int layer, int nrows) {
  extern __shared__ __attribute__((aligned(16))) unsigned char smem[];
  LAS char* lds = (LAS char*)smem;
  if (PH == 0) p0_prologue(p, lds);
  if (PH == 1) p1_norm_mix(p, layer);
  if (PH == 2) p2_inproj(p, layer, lds);
  if (PH == 4) p4_outproj(p, layer, nrows, lds);
  if (PH == 5) p5_norm_ffn(p, layer, nrows, lds);
  if (PH == 6) p6_gateup(p, layer, nrows, lds);
  if (PH == 7) p7_down(p, layer, nrows, lds);
  if (PH == 8) p8_combine(p, layer, nrows);
}

extern "C" void kernel_launch(void* const* d_in, const int* in_sizes, int n_in, void* d_out, int out_size, void* d_ws, size_t ws_size, hipStream_t stream) {
  Params p{};
  p.x = (const float*)d_in[0]; p.c = (const float*)d_in[1]; p.ctx = (const float*)d_in[2]; p.c_ctx = (const float*)d_in[3];
  p.w_mod = (const float*)d_in[4]; p.b_mod = (const float*)d_in[5]; p.norm_mix_g = (const float*)d_in[6]; p.norm_ffn_g = (const float*)d_in[7];
  p.w_in = (const float*)d_in[8]; p.w_out = (const float*)d_in[9]; p.swa_sink = (const float*)d_in[10]; p.glb_q_gain = (const float*)d_in[11];
  p.glb_k_gain = (const float*)d_in[12]; p.mla_q_gain = (const float*)d_in[13]; p.mla_w_uq = (const float*)d_in[14]; p.mla_kv_gain = (const float*)d_in[15];
  p.mla_w_ukv = (const float*)d_in[16]; p.router_w = (const float*)d_in[17]; p.router_bias = (const float*)d_in[18]; p.exp_w_gate = (const float*)d_in[19];
  p.exp_w_up = (const float*)d_in[20]; p.exp_w_down = (const float*)d_in[21]; p.shr_w_gate = (const float*)d_in[22]; p.shr_w_up = (const float*)d_in[23];
  p.shr_w_down = (const float*)d_in[24]; p.final_norm_g = (const float*)d_in[25];
  p.out = (float*)d_out; p.ws = (char*)d_ws;
  char* ws = (char*)d_ws;

  static bool attr_done = false;
  if (!attr_done) {
    (void)hipFuncSetAttribute((const void*)k_phase<0>, hipFuncAttributeMaxDynamicSharedMemorySize, LDS_BYTES);
    (void)hipFuncSetAttribute((const void*)k_phase<1>, hipFuncAttributeMaxDynamicSharedMemorySize, LDS_BYTES);
    (void)hipFuncSetAttribute((const void*)k_phase<2>, hipFuncAttributeMaxDynamicSharedMemorySize, LDS_BYTES);
    (void)hipFuncSetAttribute((const void*)k_phase<4>, hipFuncAttributeMaxDynamicSharedMemorySize, LDS_BYTES);
    (void)hipFuncSetAttribute((const void*)k_phase<5>, hipFuncAttributeMaxDynamicSharedMemorySize, LDS_BYTES);
    (void)hipFuncSetAttribute((const void*)k_phase<6>, hipFuncAttributeMaxDynamicSharedMemorySize, LDS_BYTES);
    (void)hipFuncSetAttribute((const void*)k_phase<7>, hipFuncAttributeMaxDynamicSharedMemorySize, LDS_BYTES);
    (void)hipFuncSetAttribute((const void*)k_phase<8>, hipFuncAttributeMaxDynamicSharedMemorySize, LDS_BYTES);
    attr_done = true;
  }

  (void)hipMemsetAsync(ws + OFF_CTRL, 0, CTRL_BYTES, stream);
  k_phase<0><<<GRID, NTHR, LDS_BYTES, stream>>>(p, 0, 0);
  k_phase<1><<<GRID, NTHR, LDS_BYTES, stream>>>(p, 0, NT);
  for (int l = 0; l < 2; ++l) {
    const bool last = (l == 1);
    const int Mres = last ? NL : NT;
    k_phase<2><<<GRID, NTHR, LDS_BYTES, stream>>>(p, l, NT);
    {
      AttnArgs a{};
      a.Q = (const u16*)(ws + OFF_SWQ); a.ldq = 384; a.K = (const u16*)(ws + OFF_SWK); a.ldk = 128; a.K2 = nullptr; a.ldk2 = 0; a.V = (const u16*)(ws + OFF_SWV); a.ldv = 128;
      a.Y = (u16*)(ws + OFF_Y); a.ldy = 1024; a.ycol = 0; a.sink = p.swa_sink + l * 6; a.G = 3; a.scale = 0.125f; a.window = 128; a.q_is_ctx = 0;
      k_attn<64, 0><<<dim3(S_ / 64, B_, 6), 64, 0, stream>>>(a);
      if (!last) { a.q_is_ctx = 1; a.window = 0; k_attn<64, 0><<<dim3(C_ / 64, B_, 6), 64, 0, stream>>>(a); }
      AttnArgs g{};
      g.Q = (const u16*)(ws + OFF_GLQ); g.ldq = 384; g.K = (const u16*)(ws + OFF_GLK); g.ldk = 128; g.K2 = nullptr; g.ldk2 = 0; g.V = (const u16*)(ws + OFF_GLV); g.ldv = 128;
      g.Y = (u16*)(ws + OFF_Y); g.ldy = 1024; g.ycol = 384; g.sink = nullptr; g.G = 3; g.scale = 0.125f; g.window = 0; g.q_is_ctx = 0;
      k_attn<64, 0><<<dim3(S_ / 64, B_, 6), 64, 0, stream>>>(g);
      if (!last) { g.q_is_ctx = 1; k_attn<64, 0><<<dim3(C_ / 64, B_, 6), 64, 0, stream>>>(g); }
      AttnArgs m{};
      m.Q = (const u16*)(ws + OFF_MLQ); m.ldq = 384; m.K = (const u16*)(ws + OFF_MLK); m.ldk = 256; m.K2 = (const u16*)(ws + OFF_MLKR); m.ldk2 = 32; m.V = (const u16*)(ws + OFF_MLV); m.ldv = 256;
      m.Y = (u16*)(ws + OFF_Y); m.ldy = 1024; m.ycol = 768; m.sink = nullptr; m.G = 1; m.scale = 0.10206207261596575f; m.window = 0; m.q_is_ctx = 0;
      k_attn<64, 32><<<dim3(S_ / 64, B_, 4), 64, 0, stream>>>(m);
      if (!last) { m.q_is_ctx = 1; k_attn<64, 32><<<dim3(C_ / 64, B_, 4), 64, 0, stream>>>(m); }
    }
    k_phase<4><<<GRID, NTHR, LDS_BYTES, stream>>>(p, l, Mres);
    k_phase<5><<<GRID, NTHR, LDS_BYTES, stream>>>(p, l, Mres);
    k_phase<6><<<GRID, NTHR, LDS_BYTES, stream>>>(p, l, Mres);
    k_phase<7><<<GRID, NTHR, LDS_BYTES, stream>>>(p, l, Mres);
    k_phase<8><<<GRID, NTHR, LDS_BYTES, stream>>>(p, l, Mres);
  }
}
```

```cpp
#include <hip/hip_runtime.h>
#include <stdint.h>
#include <stddef.h>

typedef unsigned short u16;
typedef short bf16x8 __attribute__((ext_vector_type(8)));
typedef float f32x4 __attribute__((ext_vector_type(4)));
typedef float f32x2_t __attribute__((ext_vector_type(2)));
typedef __bf16 bf16x2_t __attribute__((ext_vector_type(2)));
#define DI __device__ __forceinline__
#define LAS __attribute__((address_space(3)))

constexpr int B_ = 8, S_ = 4096, D_ = 1024, C_ = 256;
constexpr int NL = B_ * S_, NC = B_ * C_, NT = NL + NC;
constexpr int INW = 1696, INWP = 1792;
constexpr int NE = 16;
constexpr int MAXSLOT = NT * 2 + NE * 128;
constexpr float EPS = 1e-6f;
constexpr int NTHR = 256;
constexpr int GRID = 512;

DI float bf2f(u16 v) { return __uint_as_float(((unsigned)v) << 16); }
DI float bflo(unsigned u) { return __uint_as_float(u << 16); }
DI float bfhi(unsigned u) { return __uint_as_float(u & 0xffff0000u); }
DI unsigned cvtpk(float lo, float hi) { f32x2_t v = {lo, hi}; bf16x2_t b = __builtin_convertvector(v, bf16x2_t); return __builtin_bit_cast(unsigned, b); }
DI float wave_sum(float v) {
#pragma unroll
  for (int o = 32; o > 0; o >>= 1) v += __shfl_xor(v, o);
  return v;
}
DI float silu(float g) { return g / (1.f + __expf(-g)); }

constexpr size_t al256(size_t x) { return (x + 255) & ~(size_t)255; }
constexpr size_t OFF_CTRL = 0;
constexpr size_t CTRL_BYTES = 65536;
constexpr size_t OFF_CTXR = OFF_CTRL + CTRL_BYTES;
constexpr size_t OFF_MOD = OFF_CTXR + al256((size_t)NC * D_ * 4);
constexpr size_t OFF_TOKE = OFF_MOD + al256((size_t)2 * 9 * 6144 * 4);
constexpr size_t OFF_TOKW = OFF_TOKE + al256((size_t)NT * 2 * 4);
constexpr size_t OFF_TOKP = OFF_TOKW + al256((size_t)NT * 2 * 4);
constexpr size_t OFF_LIST = OFF_TOKP + al256((size_t)NT * 2 * 4);
constexpr size_t OFF_WIN = OFF_LIST + al256((size_t)NE * NT * 4);
constexpr size_t OFF_WO = OFF_WIN + (size_t)2 * INWP * 1024 * 2;
constexpr size_t OFF_WUQ = OFF_WO + (size_t)2 * 1024 * 1024 * 2;
constexpr size_t OFF_WUKV = OFF_WUQ + (size_t)2 * 384 * 256 * 2;
constexpr size_t OFF_WGU = OFF_WUKV + (size_t)2 * 512 * 128 * 2;
constexpr size_t OFF_WD = OFF_WGU + (size_t)2 * 16 * 1024 * 1024 * 2;
constexpr size_t OFF_SGU = OFF_WD + (size_t)2 * 16 * 1024 * 512 * 2;
constexpr size_t OFF_SD = OFF_SGU + (size_t)2 * 1024 * 1024 * 2;
constexpr size_t OFF_H = OFF_SD + (size_t)2 * 1024 * 512 * 2;
constexpr size_t OFF_BIG = OFF_H + (size_t)NT * 1024 * 2;
constexpr size_t OFF_SWQ = OFF_BIG;
constexpr size_t OFF_SWK = OFF_SWQ + (size_t)NT * 384 * 2;
constexpr size_t OFF_SWV = OFF_SWK + (size_t)NT * 128 * 2;
constexpr size_t OFF_GLQ = OFF_SWV + (size_t)NT * 128 * 2;
constexpr size_t OFF_GLK = OFF_GLQ + (size_t)NT * 384 * 2;
constexpr size_t OFF_GLV = OFF_GLK + (size_t)NT * 128 * 2;
constexpr size_t OFF_MLQ = OFF_GLV + (size_t)NT * 128 * 2;
constexpr size_t OFF_MLK = OFF_MLQ + (size_t)NT * 384 * 2;
constexpr size_t OFF_MLKR = OFF_MLK + (size_t)NT * 256 * 2;
constexpr size_t OFF_MLV = OFF_MLKR + (size_t)NT * 32 * 2;
constexpr size_t OFF_QLAT = OFF_MLV + (size_t)NT * 256 * 2;
constexpr size_t OFF_KVLAT = OFF_QLAT + (size_t)NT * 256 * 2;
constexpr size_t OFF_Y = OFF_KVLAT + (size_t)NT * 128 * 2;
constexpr size_t END_A = OFF_Y + (size_t)NT * 1024 * 2;
constexpr size_t OFF_ACT = OFF_BIG;
constexpr size_t OFF_ACTS = OFF_ACT + (size_t)MAXSLOT * 512 * 2;
constexpr size_t OFF_YEXP = OFF_ACTS + (size_t)NT * 512 * 2;
constexpr size_t END_B = OFF_YEXP + (size_t)MAXSLOT * 1024 * 2;
constexpr size_t OFF_YSH = OFF_H;
constexpr size_t WS_NEED = END_A > END_B ? END_A : END_B;
static_assert(WS_NEED <= (size_t)536870912, "workspace too large");

constexpr int CW_CTR = 0;
constexpr int CW_CNT = 64;

struct Params {
  const float *x, *c, *ctx, *c_ctx, *w_mod, *b_mod, *norm_mix_g, *norm_ffn_g, *w_in, *w_out, *swa_sink, *glb_q_gain, *glb_k_gain,
      *mla_q_gain, *mla_w_uq, *mla_kv_gain, *mla_w_ukv, *router_w, *router_bias, *exp_w_gate, *exp_w_up, *exp_w_down, *shr_w_gate,
      *shr_w_up, *shr_w_down, *final_norm_g;
  float* out;
  char* ws;
};

constexpr int LDS_MISC = 65536;
constexpr int LDS_BYTES = 65536 + 4096;

DI int next_unit(unsigned* ctr, LAS char* lds) {
  volatile LAS int* slot = (volatile LAS int*)(lds + LDS_MISC + 2560);
  __syncthreads();
  if (threadIdx.x == 0) *slot = (int)atomicAdd(ctr, 1u);
  __syncthreads();
  return *slot;
}

DI void cvt_job(const float* __restrict__ src, int ld, int N, int k0, int n0, u16* __restrict__ dst, int K, int mode  , LAS char* lds) {
  LAS float* T = (LAS float*)lds;
  const int tid = threadIdx.x;
  __syncthreads();
  {
    const int kk = tid >> 2, nq = (tid & 3) * 32;
    const float* s = src + (size_t)(k0 + kk) * ld + n0 + nq;
#pragma unroll
    for (int i = 0; i < 8; ++i) {
      float4 v = make_float4(0.f, 0.f, 0.f, 0.f);
      if (n0 + nq + i * 4 < N) v = *(const float4*)(s + i * 4);
      LAS float* t = T + kk * 129 + nq + i * 4;
      t[0] = v.x; t[1] = v.y; t[2] = v.z; t[3] = v.w;
    }
  }
  __syncthreads();
#pragma unroll
  for (int i = 0; i < 4; ++i) {
    const int chn = tid + i * 256;
    const int n = chn >> 3, kc = (chn & 7) * 8;
    if (n0 + n < N) {
      const LAS float* t = T + kc * 129 + n;
      uint4 o;
      o.x = cvtpk(t[0], t[129]); o.y = cvtpk(t[2 * 129], t[3 * 129]); o.z = cvtpk(t[4 * 129], t[5 * 129]); o.w = cvtpk(t[6 * 129], t[7 * 129]);
      const int gn = n0 + n;
      int drow = gn;
      if (mode) drow = (gn >> 5) * 64 + (gn & 31) + (mode == 2 ? 32 : 0);
      *(uint4*)(dst + (size_t)drow * K + k0 + kc) = o;
    }
  }
}

DI void mod_job(const Params& p, int l, int j0, LAS char* lds) {
  LAS float* sc = (LAS float*)lds;
  LAS float* red = (LAS float*)(lds + 36864);
  const int tid = threadIdx.x;
  __syncthreads();
  for (int i = tid; i < 9 * 1024; i += NTHR) {
    int r = i >> 10, k = i & 1023;
    float v = r < 8 ? p.c[r * 1024 + k] : p.c_ctx[k];
    sc[i] = v / (1.f + __expf(-v));
  }
  __syncthreads();
  const int col = tid & 63, kg = tid >> 6;
  float acc[9];
#pragma unroll
  for (int r = 0; r < 9; ++r) acc[r] = 0.f;
  const float* w = p.w_mod + (size_t)l * 1024 * 6144 + (size_t)(kg * 256) * 6144 + j0 + col;
  for (int k = 0; k < 256; ++k) {
    float wv = w[(size_t)k * 6144];
#pragma unroll
    for (int r = 0; r < 9; ++r) acc[r] += sc[r * 1024 + kg * 256 + k] * wv;
  }
#pragma unroll
  for (int r = 0; r < 9; ++r) red[(kg * 9 + r) * 64 + col] = acc[r];
  __syncthreads();
  float* MOD = (float*)(p.ws + OFF_MOD);
  for (int i = tid; i < 9 * 64; i += NTHR) {
    int r = i >> 6, cc = i & 63;
    float s = red[(0 * 9 + r) * 64 + cc] + red[(1 * 9 + r) * 64 + cc] + red[(2 * 9 + r) * 64 + cc] + red[(3 * 9 + r) * 64 + cc];
    MOD[(size_t)(l * 9 + r) * 6144 + j0 + cc] = s + p.b_mod[l * 6144 + j0 + cc];
  }
}

constexpr int J_WIN = 16 * 14, J_WO = 16 * 8, J_UQ = 4 * 3, J_UKV = 2 * 4, J_EG = 16 * 4, J_ED = 8 * 8;
constexpr int J_DENSE = J_WIN + J_WO + J_UQ + J_UKV;
constexpr int J_EXP = 16 * (2 * J_EG + J_ED);
constexpr int J_SHR = 2 * J_EG + J_ED;
constexpr int J_LAYER = J_DENSE + J_EXP + J_SHR;
constexpr int J_MOD = 2 * 96;
constexpr int J_TOTAL = 2 * J_LAYER + J_MOD;

DI void p0_prologue(const Params& p, LAS char* lds) {
  char* ws = p.ws;
  for (int job = blockIdx.x; job < J_TOTAL; job += gridDim.x) {
    if (job < J_MOD) { mod_job(p, job / 96, (job % 96) * 64, lds); continue; }
    int r = job - J_MOD;
    const int l = r / J_LAYER; r -= l * J_LAYER;
    if (r < J_WIN) { cvt_job(p.w_in + (size_t)l * 1024 * INW, INW, INW, (r / 14) * 64, (r % 14) * 128, (u16*)(ws + OFF_WIN) + (size_t)l * INWP * 1024, 1024, 0, lds); continue; } r -= J_WIN;
    if (r < J_WO) { cvt_job(p.w_out + (size_t)l * 1024 * 1024, 1024, 1024, (r / 8) * 64, (r % 8) * 128, (u16*)(ws + OFF_WO) + (size_t)l * 1024 * 1024, 1024, 0, lds); continue; } r -= J_WO;
    if (r < J_UQ) { cvt_job(p.mla_w_uq + (size_t)l * 256 * 384, 384, 384, (r / 3) * 64, (r % 3) * 128, (u16*)(ws + OFF_WUQ) + (size_t)l * 384 * 256, 256, 0, lds); continue; } r -= J_UQ;
    if (r < J_UKV) { cvt_job(p.mla_w_ukv + (size_t)l * 128 * 512, 512, 512, (r / 4) * 64, (r % 4) * 128, (u16*)(ws + OFF_WUKV) + (size_t)l * 512 * 128, 128, 0, lds); continue; } r -= J_UKV;
    if (r < J_EXP) {
      const int e = r / (2 * J_EG + J_ED); int q = r % (2 * J_EG + J_ED);
      const size_t le = (size_t)l * NE + e;
      if (q < J_EG) { cvt_job(p.exp_w_gate + le * 1024 * 512, 512, 512, (q / 4) * 64, (q % 4) * 128, (u16*)(ws + OFF_WGU) + le * 1024 * 1024, 1024, 1, lds); continue; } q -= J_EG;
      if (q < J_EG) { cvt_job(p.exp_w_up + le * 1024 * 512, 512, 512, (q / 4) * 64, (q % 4) * 128, (u16*)(ws + OFF_WGU) + le * 1024 * 1024, 1024, 2, lds); continue; } q -= J_EG;
      cvt_job(p.exp_w_down + le * 512 * 1024, 1024, 1024, (q / 8) * 64, (q % 8) * 128, (u16*)(ws + OFF_WD) + le * 1024 * 512, 512, 0, lds); continue;
    }
    r -= J_EXP;
    if (r < J_EG) { cvt_job(p.shr_w_gate + (size_t)l * 1024 * 512, 512, 512, (r / 4) * 64, (r % 4) * 128, (u16*)(ws + OFF_SGU) + (size_t)l * 1024 * 1024, 1024, 1, lds); continue; } r -= J_EG;
    if (r < J_EG) { cvt_job(p.shr_w_up + (size_t)l * 1024 * 512, 512, 512, (r / 4) * 64, (r % 4) * 128, (u16*)(ws + OFF_SGU) + (size_t)l * 1024 * 1024, 1024, 2, lds); continue; } r -= J_EG;
    cvt_job(p.shr_w_down + (size_t)l * 512 * 1024, 1024, 1024, (r / 8) * 64, (r % 8) * 128, (u16*)(ws + OFF_SD) + (size_t)l * 1024 * 512, 512, 0, lds);
  }
}

DI const float* xrow_ptr(const Params& p, int layer_src  , int row) {
  if (layer_src == 0) return row < NL ? p.x + (size_t)row * 1024 : p.ctx + (size_t)(row - NL) * 1024;
  return row < NL ? p.out + (size_t)row * 1024 : (const float*)(p.ws + OFF_CTXR) + (size_t)(row - NL) * 1024;
}
DI float* xrow_out(const Params& p, int row) {
  return row < NL ? p.out + (size_t)row * 1024 : (float*)(p.ws + OFF_CTXR) + (size_t)(row - NL) * 1024;
}

DI void norm_mod_row(f32x4 (&v)[4], const float* __restrict__ g, const float* __restrict__ md  , int lane) {
  float ss = 0.f;
#pragma unroll
  for (int i = 0; i < 4; ++i) ss += v[i].x * v[i].x + v[i].y * v[i].y + v[i].z * v[i].z + v[i].w * v[i].w;
  ss = wave_sum(ss);
  const float rstd = rsqrtf(ss * (1.f / 1024.f) + EPS);
#pragma unroll
  for (int i = 0; i < 4; ++i) {
    const f32x4 gg = *(const f32x4*)(g + lane * 4 + i * 256);
    const f32x4 sh = *(const f32x4*)(md + lane * 4 + i * 256);
    const f32x4 sc = *(const f32x4*)(md + 1024 + lane * 4 + i * 256);
    v[i] = v[i] * rstd * gg * (sc + 1.f) + sh;
  }
}
DI void store_h_row(const f32x4 (&v)[4], u16* __restrict__ hrow, int lane) {
#pragma unroll
  for (int i = 0; i < 4; ++i) {
    uint2 o; o.x = cvtpk(v[i].x, v[i].y); o.y = cvtpk(v[i].z, v[i].w);
    *(uint2*)(hrow + lane * 4 + i * 256) = o;
  }
}

DI void p1_norm_mix(const Params& p, int layer) {
  const int lane = threadIdx.x & 63, gw = blockIdx.x * 4 + (threadIdx.x >> 6), ngw = gridDim.x * 4;
  const float* MODl = (const float*)(p.ws + OFF_MOD) + (size_t)layer * 9 * 6144;
  u16* H = (u16*)(p.ws + OFF_H);
  for (int row = gw; row < NT; row += ngw) {
    const float* xr = xrow_ptr(p, layer, row);
    f32x4 v[4];
#pragma unroll
    for (int i = 0; i < 4; ++i) v[i] = *(const f32x4*)(xr + lane * 4 + i * 256);
    const int mr = row < NL ? row / S_ : 8;
    norm_mod_row(v, p.norm_mix_g + layer * 1024, MODl + (size_t)mr * 6144, lane);
    store_h_row(v, H + (size_t)row * 1024, lane);
  }
}

DI void route_row(const Params& p, int layer, int row, const f32x4 (&v)[4], LAS char* lds, int lane, int wid) {
  const LAS f32x4* R = (const LAS f32x4*)lds;
  float pl[16];
#pragma unroll
  for (int e = 0; e < 16; ++e) pl[e] = 0.f;
#pragma unroll
  for (int i = 0; i < 4; ++i) {
    const int kq = i * 64 + lane;
#pragma unroll
    for (int kk = 0; kk < 4; ++kk) {
      const float hv = v[i][kk];
#pragma unroll
      for (int q = 0; q < 4; ++q) {
        const f32x4 w = R[(kk * 4 + q) * 256 + kq];
        pl[q * 4 + 0] += hv * w.x; pl[q * 4 + 1] += hv * w.y; pl[q * 4 + 2] += hv * w.z; pl[q * 4 + 3] += hv * w.w;
      }
    }
  }
#pragma unroll
  for (int e = 0; e < 16; ++e) pl[e] = wave_sum(pl[e]);
  volatile LAS float* sg = (volatile LAS float*)(lds + LDS_MISC + 3072) + wid * 32;
  if (lane == 0) {
#pragma unroll
    for (int e = 0; e < 16; ++e) { float s = 1.f / (1.f + expf(-pl[e])); sg[e] = s; sg[16 + e] = s + p.router_bias[e]; }
    int bg = 0; float bgs = -1e30f;
    for (int gI = 0; gI < 4; ++gI) {
      float m1 = -1e30f, m2 = -1e30f;
      for (int e = 0; e < 4; ++e) { float x = sg[16 + gI * 4 + e]; if (x > m1) { m2 = m1; m1 = x; } else if (x > m2) m2 = x; }
      float gs = m1 + m2;
      if (gs > bgs) { bgs = gs; bg = gI; }
    }
    int i0 = bg * 4, i1 = bg * 4; float v0 = -1e30f, v1 = -1e30f;
    for (int e = 0; e < 4; ++e) { float x = sg[16 + bg * 4 + e]; if (x > v0) { v0 = x; i0 = bg * 4 + e; } }
    for (int e = 0; e < 4; ++e) { int ee = bg * 4 + e; if (ee == i0) continue; float x = sg[16 + ee]; if (x > v1) { v1 = x; i1 = ee; } }
    const float w0 = sg[i0], w1 = sg[i1], inv = 1.f / (w0 + w1);
    unsigned* cnt = (unsigned*)(p.ws + OFF_CTRL) + CW_CNT + layer * 16;
    int* tok_e = (int*)(p.ws + OFF_TOKE); float* tok_w = (float*)(p.ws + OFF_TOKW); int* tok_p = (int*)(p.ws + OFF_TOKP);
    int* list = (int*)(p.ws + OFF_LIST);
    const int p0 = (int)atomicAdd(&cnt[i0], 1u), p1 = (int)atomicAdd(&cnt[i1], 1u);
    tok_e[row * 2] = i0; tok_e[row * 2 + 1] = i1;
    tok_w[row * 2] = w0 * inv; tok_w[row * 2 + 1] = w1 * inv;
    tok_p[row * 2] = p0; tok_p[row * 2 + 1] = p1;
    list[(size_t)i0 * NT + p0] = row; list[(size_t)i1 * NT + p1] = row;
  }
}

DI void load_router_lds(const Params& p, LAS char* lds) {
  LAS f32x4* R = (LAS f32x4*)lds;
  __syncthreads();
  for (int g = threadIdx.x; g < 4096; g += NTHR) {
    const int k = g >> 2, q = g & 3;
    R[((k & 3) * 4 + q) * 256 + (k >> 2)] = *(const f32x4*)(p.router_w + (size_t)g * 4);
  }
  __syncthreads();
}

DI void p5_norm_ffn(const Params& p, int layer, int nrows, LAS char* lds) {
  load_router_lds(p, lds);
  const int lane = threadIdx.x & 63, wid = threadIdx.x >> 6, gw = blockIdx.x * 4 + wid, ngw = gridDim.x * 4;
  const float* MODl = (const float*)(p.ws + OFF_MOD) + (size_t)layer * 9 * 6144;
  u16* H = (u16*)(p.ws + OFF_H);
  for (int row = gw; row < nrows; row += ngw) {
    const float* xr = xrow_ptr(p, 1, row);
    f32x4 v[4];
#pragma unroll
    for (int i = 0; i < 4; ++i) v[i] = *(const f32x4*)(xr + lane * 4 + i * 256);
    const int mr = row < NL ? row / S_ : 8;
    norm_mod_row(v, p.norm_ffn_g + layer * 1024, MODl + (size_t)mr * 6144 + 3 * 1024, lane);
    store_h_row(v, H + (size_t)row * 1024, lane);
    route_row(p, layer, row, v, lds, lane, wid);
  }
}

DI void seg_scan(const Params& p, int layer, int (&tb)[NE + 1]) {
  const unsigned* cnt = (const unsigned*)(p.ws + OFF_CTRL) + CW_CNT + layer * 16;
  int acc = 0;
#pragma unroll
  for (int e = 0; e < NE; ++e) { tb[e] = acc; acc += ((int)cnt[e] + 127) >> 7; }
  tb[NE] = acc;
}

DI void p8_combine(const Params& p, int layer, int nrows) {
  const int lane = threadIdx.x & 63, gw = blockIdx.x * 4 + (threadIdx.x >> 6), ngw = gridDim.x * 4;
  const float* MODl = (const float*)(p.ws + OFF_MOD) + (size_t)layer * 9 * 6144;
  const float* MODn = (const float*)(p.ws + OFF_MOD) + (size_t)(layer + 1) * 9 * 6144;
  u16* H = (u16*)(p.ws + OFF_H);
  const u16* YSH = (const u16*)(p.ws + OFF_YSH);
  const u16* YEXP = (const u16*)(p.ws + OFF_YEXP);
  const int* tok_e = (const int*)(p.ws + OFF_TOKE); const float* tok_w = (const float*)(p.ws + OFF_TOKW); const int* tok_p = (const int*)(p.ws + OFF_TOKP);
  int tb[NE + 1]; seg_scan(p, layer, tb);
  for (int row = gw; row < nrows; row += ngw) {
    const int e0 = tok_e[row * 2], e1 = tok_e[row * 2 + 1];
    int ps0 = 0, ps1 = 0;
#pragma unroll
    for (int e = 0; e < NE; ++e) { if (e == e0) ps0 = tb[e]; if (e == e1) ps1 = tb[e]; }
    const size_t s0 = (size_t)ps0 * 128 + tok_p[row * 2], s1 = (size_t)ps1 * 128 + tok_p[row * 2 + 1];
    const float w0 = tok_w[row * 2], w1 = tok_w[row * 2 + 1];
    float* xr = xrow_out(p, row);
    const int mr = row < NL ? row / S_ : 8;
    const float* gate = MODl + (size_t)mr * 6144 + 5 * 1024;
    f32x4 v[4];
#pragma unroll
    for (int i = 0; i < 4; ++i) {
      const int cidx = lane * 4 + i * 256;
      const uint2 a = *(const uint2*)(YEXP + s0 * 1024 + cidx);
      const uint2 b = *(const uint2*)(YEXP + s1 * 1024 + cidx);
      const uint2 c = *(const uint2*)(YSH + (size_t)row * 1024 + cidx);
      const f32x4 g = *(const f32x4*)(gate + cidx);
      f32x4 x = *(const f32x4*)(xr + cidx);
      x.x += g.x * (w0 * bflo(a.x) + w1 * bflo(b.x) + bflo(c.x));
      x.y += g.y * (w0 * bfhi(a.x) + w1 * bfhi(b.x) + bfhi(c.x));
      x.z += g.z * (w0 * bflo(a.y) + w1 * bflo(b.y) + bflo(c.y));
      x.w += g.w * (w0 * bfhi(a.y) + w1 * bfhi(b.y) + bfhi(c.y));
      v[i] = x;
    }
    if (layer == 0) {
#pragma unroll
      for (int i = 0; i < 4; ++i) *(f32x4*)(xr + lane * 4 + i * 256) = v[i];
      norm_mod_row(v, p.norm_mix_g + 1024, MODn + (size_t)mr * 6144, lane);
      store_h_row(v, H + (size_t)row * 1024, lane);
    } else {
      float ss = 0.f;
#pragma unroll
      for (int i = 0; i < 4; ++i) ss += v[i].x * v[i].x + v[i].y * v[i].y + v[i].z * v[i].z + v[i].w * v[i].w;
      ss = wave_sum(ss);
      const float rstd = rsqrtf(ss * (1.f / 1024.f) + EPS);
#pragma unroll
      for (int i = 0; i < 4; ++i) {
        const f32x4 gg = *(const f32x4*)(p.final_norm_g + lane * 4 + i * 256);
        *(f32x4*)(xr + lane * 4 + i * 256) = v[i] * rstd * gg;
      }
    }
  }
}

DI void glds16(const u16* g, LAS char* l) {
  __builtin_amdgcn_global_load_lds((const void*)g, (LAS void*)l, 16, 0, 0);
}
DI void gemm_tile(LAS char* lds, const u16* a0, const u16* a1, const u16* b0, const u16* b1, int nk, f32x4 (&acc)[4][4]) {
  const int tid = threadIdx.x, lane = tid & 63, wid = tid >> 6, wr = wid >> 1, wc = wid & 1, fr = lane & 15, fq = lane >> 4;
  const int cx = (fq ^ ((0 - (fr >> 2)) & 3)) * 16;
  const int aoff = (wr * 64 + fr) * 64 + cx;
  const int boff = 16384 + (wc * 64 + fr) * 64 + cx;
#pragma unroll
  for (int m = 0; m < 4; ++m)
#pragma unroll
    for (int n = 0; n < 4; ++n) acc[m][n] = (f32x4){0.f, 0.f, 0.f, 0.f};
  LAS char* ldst = lds + tid * 16;
#define GT_ISSUE(kt, s) do { const int _ko = (kt) * 64; LAS char* _d = ldst + (s) * 32768; \
    glds16(a0 + _ko, _d); glds16(a1 + _ko, _d + 4096); glds16(a0 + _ko + 32, _d + 8192); glds16(a1 + _ko + 32, _d + 12288); \
    glds16(b0 + _ko, _d + 16384); glds16(b1 + _ko, _d + 20480); glds16(b0 + _ko + 32, _d + 24576); glds16(b1 + _ko + 32, _d + 28672); } while (0)
  GT_ISSUE(0, 0);
#pragma unroll 1
  for (int kt = 0; kt < nk; ++kt) {
    asm volatile("s_waitcnt vmcnt(0)" ::: "memory");
    __syncthreads();
    if (kt + 1 < nk) GT_ISSUE(kt + 1, (kt + 1) & 1);
    const LAS char* sb = lds + (kt & 1) * 32768;
#pragma unroll
    for (int h = 0; h < 2; ++h) {
      bf16x8 af[4], bfr[4];
#pragma unroll
      for (int m = 0; m < 4; ++m) af[m] = *(const LAS bf16x8*)(sb + h * 8192 + aoff + m * 1024);
#pragma unroll
      for (int n = 0; n < 4; ++n) bfr[n] = *(const LAS bf16x8*)(sb + h * 8192 + boff + n * 1024);
#pragma unroll
      for (int m = 0; m < 4; ++m)
#pragma unroll
        for (int n = 0; n < 4; ++n) acc[m][n] = __builtin_amdgcn_mfma_f32_16x16x32_bf16(bfr[n], af[m], acc[m][n], 0, 0, 0);
    }
  }
#undef GT_ISSUE
  __syncthreads();
}
DI int gt_chunk(int tid) { return (((tid & 3) ^ ((0 - ((tid >> 4) & 3)) & 3))) * 8; }
DI int gt_row0(int tid) { return tid >> 2; }
DI int opaque(int v) { asm volatile("" : "+v"(v)); return v; }

DI void sincos_rev(float pos, float invf, float& sn, float& cs) {
  float rev = pos * invf * 0.15915494309189535f;
  rev -= rintf(rev);
  sn = __builtin_amdgcn_sinf(rev); cs = __builtin_amdgcn_cosf(rev);
}
DI void st_bf4(u16* dst, const f32x4& v) { uint2 o; o.x = cvtpk(v[0], v[1]); o.y = cvtpk(v[2], v[3]); *(uint2*)dst = o; }

DI void epi_inproj(const Params& p, int layer, f32x4 (&acc)[4][4], int m0, int seg, int wr, int fr, int fq, LAS float* rowss_slot) {
  char* ws = p.ws;
  const bool lat = m0 < NL;
  const int rbase = m0 + wr * 64 + fr;
  u16* dst; int ld, cb; int kind;
  if (seg < 6) { dst = (u16*)(ws + OFF_SWQ); ld = 384; cb = seg * 64; kind = 1; }
  else if (seg < 8) { dst = (u16*)(ws + OFF_SWK); ld = 128; cb = (seg - 6) * 64; kind = 1; }
  else if (seg < 10) { dst = (u16*)(ws + OFF_SWV); ld = 128; cb = (seg - 8) * 64; kind = 0; }
  else if (seg < 16) { dst = (u16*)(ws + OFF_GLQ); ld = 384; cb = (seg - 10) * 64; kind = 2; }
  else if (seg < 18) { dst = (u16*)(ws + OFF_GLK); ld = 128; cb = (seg - 16) * 64; kind = 3; }
  else if (seg < 20) { dst = (u16*)(ws + OFF_GLV); ld = 128; cb = (seg - 18) * 64; kind = 0; }
  else if (seg < 24) { dst = (u16*)(ws + OFF_QLAT); ld = 256; cb = (seg - 20) * 64; kind = 4; }
  else if (seg < 26) { dst = (u16*)(ws + OFF_KVLAT); ld = 128; cb = (seg - 24) * 64; kind = 5; }
  else if (seg == 26) { dst = (u16*)(ws + OFF_MLKR); ld = 32; cb = 0; kind = 6; }
  else return;
  if (kind == 2 || kind == 3) {
    const float* gain = (kind == 2 ? p.glb_q_gain : p.glb_k_gain) + layer * 64;
    f32x4 gv[4];
#pragma unroll
    for (int n = 0; n < 4; ++n) gv[n] = *(const f32x4*)(gain + n * 16 + fq * 4);
#pragma unroll
    for (int m = 0; m < 4; ++m) {
      float ss = 0.f;
#pragma unroll
      for (int n = 0; n < 4; ++n) ss += acc[m][n][0] * acc[m][n][0] + acc[m][n][1] * acc[m][n][1] + acc[m][n][2] * acc[m][n][2] + acc[m][n][3] * acc[m][n][3];
      ss += __shfl_xor(ss, 16); ss += __shfl_xor(ss, 32);
      const float r = rsqrtf(ss * (1.f / 64.f) + EPS);
#pragma unroll
      for (int n = 0; n < 4; ++n) acc[m][n] = acc[m][n] * r * gv[n];
    }
  }
  if (kind == 4 || kind == 5) {
    const float* gain = (kind == 4 ? p.mla_q_gain + layer * 256 : p.mla_kv_gain + layer * 128) + cb;
    f32x4 gv[4];
#pragma unroll
    for (int n = 0; n < 4; ++n) gv[n] = *(const f32x4*)(gain + n * 16 + fq * 4);
#pragma unroll
    for (int m = 0; m < 4; ++m) {
      float ss = 0.f;
#pragma unroll
      for (int n = 0; n < 4; ++n) ss += acc[m][n][0] * acc[m][n][0] + acc[m][n][1] * acc[m][n][1] + acc[m][n][2] * acc[m][n][2] + acc[m][n][3] * acc[m][n][3];
      ss += __shfl_xor(ss, 16); ss += __shfl_xor(ss, 32);
      if (fq == 0) rowss_slot[wr * 64 + m * 16 + fr] = ss;
#pragma unroll
      for (int n = 0; n < 4; ++n) acc[m][n] = acc[m][n] * gv[n];
    }
  }
  if (lat && (kind == 1 || kind == 2 || kind == 3)) {
    float invf[4];
#pragma unroll
    for (int j = 0; j < 4; ++j) invf[j] = __builtin_amdgcn_exp2f(-(float)(fq * 4 + j) * (13.287712379549449f / 16.f));
#pragma unroll
    for (int m = 0; m < 4; ++m) {
      const int t = (rbase + m * 16) & (S_ - 1);
      const float prow = (float)(t >> 6), pcol = (float)(t & 63);
#pragma unroll
      for (int j = 0; j < 4; ++j) {
        float sr, cr, sc, cc;
        sincos_rev(prow, invf[j], sr, cr); sincos_rev(pcol, invf[j], sc, cc);
        float x1 = acc[m][0][j], x2 = acc[m][1][j];
        acc[m][0][j] = x1 * cr - x2 * sr; acc[m][1][j] = x2 * cr + x1 * sr;
        x1 = acc[m][2][j]; x2 = acc[m][3][j];
        acc[m][2][j] = x1 * cc - x2 * sc; acc[m][3][j] = x2 * cc + x1 * sc;
      }
    }
  }
  if (kind == 6) {
    if (lat) {
      float invf[4];
#pragma unroll
      for (int j = 0; j < 4; ++j) invf[j] = __builtin_amdgcn_exp2f(-(float)((fq & 1) * 4 + j) * (13.287712379549449f / 8.f));
#pragma unroll
      for (int m = 0; m < 4; ++m) {
        const int t = (rbase + m * 16) & (S_ - 1);
#pragma unroll
        for (int n = 0; n < 2; ++n) {
          const float pos = n == 0 ? (float)(t >> 6) : (float)(t & 63);
#pragma unroll
          for (int j = 0; j < 4; ++j) {
            float sn, cs; sincos_rev(pos, invf[j], sn, cs);
            const float v = acc[m][n][j], pr = __shfl_xor(v, 32);
            acc[m][n][j] = (fq & 2) ? v * cs + pr * sn : v * cs - pr * sn;
          }
        }
      }
    }
#pragma unroll
    for (int m = 0; m < 4; ++m)
#pragma unroll
      for (int n = 0; n < 2; ++n) st_bf4(dst + (size_t)(rbase + m * 16) * ld + n * 16 + fq * 4, acc[m][n]);
    return;
  }
#pragma unroll
  for (int m = 0; m < 4; ++m)
#pragma unroll
    for (int n = 0; n < 4; ++n) st_bf4(dst + (size_t)(rbase + m * 16) * ld + cb + n * 16 + fq * 4, acc[m][n]);
}

DI void p2_inproj(const Params& p, int layer, LAS char* lds) {
  char* ws = p.ws;
  unsigned* ctr = (unsigned*)(ws + OFF_CTRL) + CW_CTR + layer * 16 + 2;
  const u16* H = (const u16*)(ws + OFF_H);
  const u16* WinT = (const u16*)(ws + OFF_WIN) + (size_t)layer * INWP * 1024;
  const u16* WuqT = (const u16*)(ws + OFF_WUQ) + (size_t)layer * 384 * 256;
  const u16* WukvT = (const u16*)(ws + OFF_WUKV) + (size_t)layer * 512 * 128;
  const int tid = threadIdx.x, lane = tid & 63, wid = tid >> 6, wr = wid >> 1, wc = wid & 1;
  LAS float* rowss = (LAS float*)(lds + LDS_MISC);
  LAS float* rstd = (LAS float*)(lds + LDS_MISC + 2048);
  const int nunits = (NT / 128) * 12;
  f32x4 acc[4][4];
  for (;;) {
    const int u = next_unit(ctr, lds);
    if (u >= nunits) break;
    const int tid_o = opaque(tid), lane_o = tid_o & 63;
    const int fr = lane_o & 15, fq = lane_o >> 4, ch = gt_chunk(tid_o), r0 = gt_row0(tid_o);
    const int rt = u / 12, k = u % 12, m0 = rt * 128;
    const u16* a0 = H + (size_t)(m0 + r0) * 1024 + ch;
    const u16* a1 = a0 + (size_t)64 * 1024;
    if (k < 10) {
      const u16* b0 = WinT + (size_t)(k * 128 + r0) * 1024 + ch;
      gemm_tile(lds, a0, a1, b0, b0 + (size_t)64 * 1024, 16, acc);
      epi_inproj(p, layer, acc, m0, k * 2 + wc, wr, fr, fq, rowss);
    } else if (k == 10) {
#pragma unroll 1
      for (int t = 0; t < 2; ++t) {
        const u16* b0 = WinT + (size_t)(1280 + t * 128 + r0) * 1024 + ch;
        gemm_tile(lds, a0, a1, b0, b0 + (size_t)64 * 1024, 16, acc);
        epi_inproj(p, layer, acc, m0, 20 + t * 2 + wc, wr, fr, fq, rowss + (t * 2 + wc) * 128);
      }
      __syncthreads();
      if (tid < 128) rstd[tid] = rsqrtf((rowss[tid] + rowss[128 + tid] + rowss[256 + tid] + rowss[384 + tid]) * (1.f / 256.f) + EPS);
      __syncthreads();
      const u16* QL = (const u16*)(ws + OFF_QLAT);
      const u16* qa0 = QL + (size_t)(m0 + r0) * 256 + ch;
      const u16* qa1 = qa0 + (size_t)64 * 256;
      u16* MLQ = (u16*)(ws + OFF_MLQ);
      const bool lat = m0 < NL;
#pragma unroll 1
      for (int t = 0; t < 3; ++t) {
        const u16* b0 = WuqT + (size_t)(t * 128 + r0) * 256 + ch;
        gemm_tile(lds, qa0, qa1, b0, b0 + (size_t)64 * 256, 4, acc);
        const int c0 = t * 128 + wc * 64;
        float invf[4];
#pragma unroll
        for (int j = 0; j < 4; ++j) invf[j] = __builtin_amdgcn_exp2f(-(float)((fq & 1) * 4 + j) * (13.287712379549449f / 8.f));
#pragma unroll
        for (int m = 0; m < 4; ++m) {
          const int rl = wr * 64 + m * 16 + fr;
          const float rs = rstd[rl];
          const int tpos = (m0 + rl) & (S_ - 1);
#pragma unroll
          for (int n = 0; n < 4; ++n) {
            acc[m][n] = acc[m][n] * rs;
            const int w96 = (c0 + n * 16) % 96;
            if (lat && w96 >= 64) {
              const float pos = (w96 == 64) ? (float)(tpos >> 6) : (float)(tpos & 63);
#pragma unroll
              for (int j = 0; j < 4; ++j) {
                float sn, cs; sincos_rev(pos, invf[j], sn, cs);
                const float v = acc[m][n][j], pr = __shfl_xor(v, 32);
                acc[m][n][j] = (fq & 2) ? v * cs + pr * sn : v * cs - pr * sn;
              }
            }
            st_bf4(MLQ + (size_t)(m0 + rl) * 384 + c0 + n * 16 + fq * 4, acc[m][n]);
          }
        }
      }
    } else {
      {
        const u16* b0 = WinT + (size_t)(1536 + r0) * 1024 + ch;
        gemm_tile(lds, a0, a1, b0, b0 + (size_t)64 * 1024, 16, acc);
        epi_inproj(p, layer, acc, m0, 24 + wc, wr, fr, fq, rowss + wc * 128);
        const u16* b2 = WinT + (size_t)(1664 + r0) * 1024 + ch;
        gemm_tile(lds, a0, a1, b2, b2 + (size_t)64 * 1024, 16, acc);
        epi_inproj(p, layer, acc, m0, 26 + wc, wr, fr, fq, rowss);
      }
      __syncthreads();
      if (tid < 128) rstd[tid] = rsqrtf((rowss[tid] + rowss[128 + tid]) * (1.f / 128.f) + EPS);
      __syncthreads();
      const u16* KL = (const u16*)(ws + OFF_KVLAT);
      const u16* ka0 = KL + (size_t)(m0 + r0) * 128 + ch;
      const u16* ka1 = ka0 + (size_t)64 * 128;
#pragma unroll 1
      for (int t = 0; t < 4; ++t) {
        const u16* b0 = WukvT + (size_t)(t * 128 + r0) * 128 + ch;
        gemm_tile(lds, ka0, ka1, b0, b0 + (size_t)64 * 128, 2, acc);
        u16* dst = (u16*)(ws + (wc == 0 ? OFF_MLK : OFF_MLV));
#pragma unroll
        for (int m = 0; m < 4; ++m) {
          const int rl = wr * 64 + m * 16 + fr;
          const float rs = rstd[rl];
#pragma unroll
          for (int n = 0; n < 4; ++n) { acc[m][n] = acc[m][n] * rs; st_bf4(dst + (size_t)(m0 + rl) * 256 + t * 64 + n * 16 + fq * 4, acc[m][n]); }
        }
      }
    }
  }
}

DI void p4_outproj(const Params& p, int layer, int nrows, LAS char* lds) {
  char* ws = p.ws;
  unsigned* ctr = (unsigned*)(ws + OFF_CTRL) + CW_CTR + layer * 16 + 4;
  const u16* Y = (const u16*)(ws + OFF_Y);
  const u16* WoT = (const u16*)(ws + OFF_WO) + (size_t)layer * 1024 * 1024;
  const float* MODl = (const float*)(ws + OFF_MOD) + (size_t)layer * 9 * 6144;
  const int tid = threadIdx.x, wid = tid >> 6, wr = wid >> 1, wc = wid & 1;
  const int nunits = (nrows / 128) * 8;
  f32x4 acc[4][4];
  for (;;) {
    const int u = next_unit(ctr, lds);
    if (u >= nunits) break;
    const int tid_o = opaque(tid), lane_o = tid_o & 63;
    const int fr = lane_o & 15, fq = lane_o >> 4, ch = gt_chunk(tid_o), r0 = gt_row0(tid_o);
    const int rt = u >> 3, ct = u & 7, m0 = rt * 128;
    const u16* a0 = Y + (size_t)(m0 + r0) * 1024 + ch;
    const u16* b0 = WoT + (size_t)(ct * 128 + r0) * 1024 + ch;
    gemm_tile(lds, a0, a0 + (size_t)64 * 1024, b0, b0 + (size_t)64 * 1024, 16, acc);
    const int mr = m0 < NL ? m0 / S_ : 8;
    const float* gate = MODl + (size_t)mr * 6144 + 2 * 1024 + ct * 128 + wc * 64 + fq * 4;
#pragma unroll
    for (int m = 0; m < 4; ++m) {
      const int row = m0 + wr * 64 + m * 16 + fr;
      const float* xs = xrow_ptr(p, layer, row) + ct * 128 + wc * 64 + fq * 4;
      float* xd = xrow_out(p, row) + ct * 128 + wc * 64 + fq * 4;
#pragma unroll
      for (int n = 0; n < 4; ++n) {
        const f32x4 g = *(const f32x4*)(gate + n * 16);
        const f32x4 xv = *(const f32x4*)(xs + n * 16);
        *(f32x4*)(xd + n * 16) = xv + g * acc[m][n];
      }
    }
  }
}

DI void p6_gateup(const Params& p, int layer, int nrows, LAS char* lds) {
  char* ws = p.ws;
  unsigned* ctr = (unsigned*)(ws + OFF_CTRL) + CW_CTR + layer * 16 + 6;
  const unsigned* cnt = (const unsigned*)(ws + OFF_CTRL) + CW_CNT + layer * 16;
  const u16* H = (const u16*)(ws + OFF_H);
  const int* list = (const int*)(ws + OFF_LIST);
  const u16* WguT = (const u16*)(ws + OFF_WGU) + (size_t)layer * NE * 1024 * 1024;
  const u16* SguT = (const u16*)(ws + OFF_SGU) + (size_t)layer * 1024 * 1024;
  u16* ACT = (u16*)(ws + OFF_ACT); u16* ACTS = (u16*)(ws + OFF_ACTS);
  const int tid = threadIdx.x, wid = tid >> 6, wr = wid >> 1, wc = wid & 1;
  int tb[NE + 1]; seg_scan(p, layer, tb);
  const int R = tb[NE];
  const int nunits = (R + nrows / 128) * 8;
  f32x4 acc[4][4];
  for (;;) {
    const int u = next_unit(ctr, lds);
    if (u >= nunits) break;
    const int tid_o = opaque(tid), lane_o = tid_o & 63;
    const int fr = lane_o & 15, fq = lane_o >> 4, ch = gt_chunk(tid_o), r0 = gt_row0(tid_o);
    const int rt = u >> 3, ct = u & 7;
    const u16 *a0, *a1, *b0; u16* dst; size_t orow;
    if (rt < R) {
      int e = 0, tbe = 0;
#pragma unroll
      for (int q = 1; q < NE; ++q) if (rt >= tb[q]) { e = q; tbe = tb[q]; }
      const int i = rt - tbe, ce = (int)cnt[e];
      const int i0 = i * 128 + r0, i1 = i0 + 64;
      const int t0 = i0 < ce ? list[(size_t)e * NT + i0] : 0, t1 = i1 < ce ? list[(size_t)e * NT + i1] : 0;
      a0 = H + (size_t)t0 * 1024 + ch; a1 = H + (size_t)t1 * 1024 + ch;
      b0 = WguT + ((size_t)e * 1024 + ct * 128 + r0) * 1024 + ch;
      dst = ACT; orow = (size_t)rt * 128;
    } else {
      const int m0 = (rt - R) * 128;
      a0 = H + (size_t)(m0 + r0) * 1024 + ch; a1 = a0 + (size_t)64 * 1024;
      b0 = SguT + (size_t)(ct * 128 + r0) * 1024 + ch;
      dst = ACTS; orow = (size_t)m0;
    }
    gemm_tile(lds, a0, a1, b0, b0 + (size_t)64 * 1024, 16, acc);
#pragma unroll
    for (int m = 0; m < 4; ++m) {
      u16* o = dst + (orow + wr * 64 + m * 16 + fr) * 512 + ct * 64 + wc * 32 + fq * 4;
#pragma unroll
      for (int n = 0; n < 2; ++n) {
        f32x4 r;
#pragma unroll
        for (int j = 0; j < 4; ++j) r[j] = silu(acc[m][n][j]) * acc[m][n + 2][j];
        st_bf4(o + n * 16, r);
      }
    }
  }
}

DI void p7_down(const Params& p, int layer, int nrows, LAS char* lds) {
  char* ws = p.ws;
  unsigned* ctr = (unsigned*)(ws + OFF_CTRL) + CW_CTR + layer * 16 + 7;
  const u16* WdT = (const u16*)(ws + OFF_WD) + (size_t)layer * NE * 1024 * 512;
  const u16* SdT = (const u16*)(ws + OFF_SD) + (size_t)layer * 1024 * 512;
  const u16* ACT = (const u16*)(ws + OFF_ACT); const u16* ACTS = (const u16*)(ws + OFF_ACTS);
  u16* YEXP = (u16*)(ws + OFF_YEXP); u16* YSH = (u16*)(ws + OFF_YSH);
  const int tid = threadIdx.x, wid = tid >> 6, wr = wid >> 1, wc = wid & 1;
  int tb[NE + 1]; seg_scan(p, layer, tb);
  const int R = tb[NE];
  const int nunits = (R + nrows / 128) * 8;
  f32x4 acc[4][4];
  for (;;) {
    const int u = next_unit(ctr, lds);
    if (u >= nunits) break;
    const int tid_o = opaque(tid), lane_o = tid_o & 63;
    const int fr = lane_o & 15, fq = lane_o >> 4, ch = gt_chunk(tid_o), r0 = gt_row0(tid_o);
    const int rt = u >> 3, ct = u & 7;
    const u16 *a0, *b0; u16* dst; size_t orow;
    if (rt < R) {
      int e = 0;
#pragma unroll
      for (int q = 1; q < NE; ++q) if (rt >= tb[q]) e = q;
      a0 = ACT + ((size_t)rt * 128 + r0) * 512 + ch;
      b0 = WdT + ((size_t)e * 1024 + ct * 128 + r0) * 512 + ch;
      dst = YEXP; orow = (size_t)rt * 128;
    } else {
      const int m0 = (rt - R) * 128;
      a0 = ACTS + (size_t)(m0 + r0) * 512 + ch;
      b0 = SdT + (size_t)(ct * 128 + r0) * 512 + ch;
      dst = YSH; orow = (size_t)m0;
    }
    gemm_tile(lds, a0, a0 + (size_t)64 * 512, b0, b0 + (size_t)64 * 512, 8, acc);
#pragma unroll
    for (int m = 0; m < 4; ++m) {
      u16* o = dst + (orow + wr * 64 + m * 16 + fr) * 1024 + ct * 128 + wc * 64 + fq * 4;
#pragma unroll
      for (int n = 0; n < 4; ++n) st_bf4(o + n * 16, acc[m][n]);
    }
  }
}


typedef float f32x16 __attribute__((ext_vector_type(16)));
typedef short s16x4 __attribute__((ext_vector_type(4)));
DI s16x4 tr_read(const LAS char* a) { return __builtin_bit_cast(s16x4, __builtin_amdgcn_ds_read_tr16_b64_v4i16((LAS s16x4*)a)); }
DI float half_max(float m) { auto rr = __builtin_amdgcn_permlane32_swap(__float_as_uint(m), __float_as_uint(m), false, false); return fmaxf(__uint_as_float(rr[0]), __uint_as_float(rr[1])); }
DI float half_sum(float m) { auto rr = __builtin_amdgcn_permlane32_swap(__float_as_uint(m), __float_as_uint(m), false, false); return __uint_as_float(rr[0]) + __uint_as_float(rr[1]); }
DI bf16x8 pack8(const f32x16& x, int s8) {
  typedef unsigned u32x4 __attribute__((ext_vector_type(4)));
  u32x4 r;
  r[0] = cvtpk(x[s8 + 0], x[s8 + 1]); r[1] = cvtpk(x[s8 + 2], x[s8 + 3]); r[2] = cvtpk(x[s8 + 4], x[s8 + 5]); r[3] = cvtpk(x[s8 + 6], x[s8 + 7]);
  return __builtin_bit_cast(bf16x8, r);
}
constexpr int AT_STAGE = 20480;

template <bool MLA>
DI void attn_unit(const Params& p, int layer, int kind, int isctx, int b, int h, int qb, LAS char* lds) {
  char* ws = p.ws;
  const int tid = opaque((int)threadIdx.x), lane = tid & 63, wid = tid >> 6, r32 = lane & 31, hi = lane >> 5;
  const u16 *Qg, *Kg, *Vg; int ldq, ldk, qoff, koff, ycol; float cs;
  if (MLA) { Qg = (const u16*)(ws + OFF_MLQ); Kg = (const u16*)(ws + OFF_MLK); Vg = (const u16*)(ws + OFF_MLV); ldq = 384; ldk = 256; qoff = h * 96; koff = h * 64; ycol = 768 + h * 64; cs = 0.10206207261596575f * 1.4426950408889634f; }
  else if (kind == 1) { Qg = (const u16*)(ws + OFF_GLQ); Kg = (const u16*)(ws + OFF_GLK); Vg = (const u16*)(ws + OFF_GLV); ldq = 384; ldk = 128; qoff = h * 64; koff = (h / 3) * 64; ycol = 384 + h * 64; cs = 0.125f * 1.4426950408889634f; }
  else { Qg = (const u16*)(ws + OFF_SWQ); Kg = (const u16*)(ws + OFF_SWK); Vg = (const u16*)(ws + OFF_SWV); ldq = 384; ldk = 128; qoff = h * 64; koff = (h / 3) * 64; ycol = h * 64; cs = 0.125f * 1.4426950408889634f; }
  const u16* Rg = (const u16*)(ws + OFF_MLKR);
  const int q0 = qb * 128;
  const int qrow0 = (isctx ? NL + b * C_ : b * S_) + q0;
  const int qw = q0 + wid * 32;
  int lat_first = 0, nlat = 0;
  if (!isctx) { if (kind == 0) { lat_first = 2 * qb - 2; if (lat_first < 0) lat_first = 0; int lat_last = 2 * qb + 3; if (lat_last > 63) lat_last = 63; nlat = lat_last - lat_first + 1; } else nlat = 64; }
  const int T = 4 + nlat;
  constexpr int NQ = MLA ? 6 : 4;
  bf16x8 qf[NQ];
  {
    const u16* qp = Qg + (size_t)(qrow0 + wid * 32 + r32) * ldq + qoff + hi * 8;
#pragma unroll
    for (int d0 = 0; d0 < NQ; ++d0) qf[d0] = *(const bf16x8*)(qp + d0 * 16);
  }
  int kaddr[4];
#pragma unroll
  for (int d0 = 0; d0 < 4; ++d0) kaddr[d0] = r32 * 128 + (((d0 * 2 + hi) ^ ((r32 >> 1) & 7)) * 16);
  int kraddr[2];
#pragma unroll
  for (int e = 0; e < 2; ++e) kraddr[e] = 16384 + r32 * 64 + (((e * 2 + hi) ^ ((r32 >> 3) & 3)) * 16);
  int vbo[2];
  {
    const int i16 = lane & 15, sw = (lane >> 3) & 1;
    const int x = ((lane >> 4) & 1) * 32 + (lane & 3) * 8;
    const int rowpart = ((i16 >> 2) + 4 * hi) * 128;
    vbo[0] = 8192 + rowpart + x + (sw * 64);
    vbo[1] = 8192 + rowpart + x + ((1 - sw) * 64);
  }
  const int skey = tid >> 3;
  const int kch = ((tid & 7) ^ ((tid >> 4) & 7)) * 8;
  const int vch = ((tid & 7) ^ (((tid >> 4) & 1) << 2)) * 8;
  const int rkey = tid >> 2, rch = ((tid & 3) ^ ((tid >> 5) & 3)) * 8;
  LAS char* ldst = lds + tid * 16;
#define AT_ISSUE(j, st) do { const int _j = (j); const int _kr = _j < 4 ? NL + b * C_ + 64 * _j : b * S_ + 64 * (lat_first + _j - 4); \
    LAS char* _d = ldst + (st) * AT_STAGE; \
    const u16* _k = Kg + (size_t)(_kr + skey) * ldk + koff + kch; glds16(_k, _d); glds16(_k + (size_t)32 * ldk, _d + 4096); \
    const u16* _v = Vg + (size_t)(_kr + skey) * ldk + koff + vch; glds16(_v, _d + 8192); glds16(_v + (size_t)32 * ldk, _d + 8192 + 4096); \
    if (MLA) glds16(Rg + (size_t)(_kr + rkey) * 32 + rch, _d + 16384); } while (0)
  float m_run, l_run;
  if (kind == 0) { m_run = p.swa_sink[layer * 6 + h] * 8.0f; l_run = hi == 0 ? 1.f : 0.f; }
  else { m_run = -1e30f; l_run = 0.f; }
  f32x16 o[2];
#pragma unroll
  for (int i = 0; i < 16; ++i) { o[0][i] = 0.f; o[1][i] = 0.f; }
  AT_ISSUE(0, 0);
#pragma unroll 1
  for (int j = 0; j < T; ++j) {
    asm volatile("s_waitcnt vmcnt(0)" ::: "memory");
    __syncthreads();
    if (j + 1 < T) AT_ISSUE(j + 1, (j + 1) & 1);
    const int pos0 = 64 * (lat_first + j - 4);
    bool skip = false, domask = false;
    if (kind == 0 && j >= 4) {
      if (pos0 + 63 < qw - 128 || pos0 > qw + 31 + 128) skip = true;
      else if (qw + 31 - pos0 > 128 || pos0 + 63 - qw > 128) domask = true;
    }
    if (!skip) {
      const LAS char* sb = lds + (j & 1) * AT_STAGE;
      f32x16 p0, p1;
#pragma unroll
      for (int i = 0; i < 16; ++i) { p0[i] = 0.f; p1[i] = 0.f; }
#pragma unroll
      for (int d0 = 0; d0 < 4; ++d0) {
        const bf16x8 k0 = *(const LAS bf16x8*)(sb + kaddr[d0]);
        const bf16x8 k1 = *(const LAS bf16x8*)(sb + kaddr[d0] + 4096);
        p0 = __builtin_amdgcn_mfma_f32_32x32x16_bf16(k0, qf[d0], p0, 0, 0, 0);
        p1 = __builtin_amdgcn_mfma_f32_32x32x16_bf16(k1, qf[d0], p1, 0, 0, 0);
      }
      if (MLA) {
#pragma unroll
        for (int e = 0; e < 2; ++e) {
          const bf16x8 k0 = *(const LAS bf16x8*)(sb + kraddr[e]);
          const bf16x8 k1 = *(const LAS bf16x8*)(sb + kraddr[e] + 2048);
          p0 = __builtin_amdgcn_mfma_f32_32x32x16_bf16(k0, qf[MLA ? 4 + e : 0], p0, 0, 0, 0);
          p1 = __builtin_amdgcn_mfma_f32_32x32x16_bf16(k1, qf[MLA ? 4 + e : 0], p1, 0, 0, 0);
        }
      }
      if (domask) {
        const int dq = qw + r32 - pos0 - 4 * hi + 128;
#pragma unroll
        for (int r = 0; r < 16; ++r) {
          const int cr = (r & 3) + 8 * (r >> 2);
          if ((unsigned)(dq - cr) > 256u) p0[r] = -1e30f;
          if ((unsigned)(dq - cr - 32) > 256u) p1[r] = -1e30f;
        }
      }
      float mx = fmaxf(p0[0], p1[0]);
#pragma unroll
      for (int r = 1; r < 16; ++r) mx = fmaxf(mx, fmaxf(p0[r], p1[r]));
      mx = half_max(mx);
      const float m_new = fmaxf(m_run, mx);
      if (__ballot(m_new > m_run) != 0ull) {
        const float alpha = __builtin_amdgcn_exp2f((m_run - m_new) * cs);
        l_run *= alpha;
#pragma unroll
        for (int i = 0; i < 16; ++i) { o[0][i] *= alpha; o[1][i] *= alpha; }
        m_run = m_new;
      }
      const float nmc = -m_run * cs;
      float ls = 0.f;
#pragma unroll
      for (int r = 0; r < 16; ++r) {
        p0[r] = __builtin_amdgcn_exp2f(__builtin_fmaf(p0[r], cs, nmc));
        p1[r] = __builtin_amdgcn_exp2f(__builtin_fmaf(p1[r], cs, nmc));
        ls += p0[r] + p1[r];
      }
      l_run += ls;
      bf16x8 pa[4];
      pa[0] = pack8(p0, 0); pa[1] = pack8(p0, 8); pa[2] = pack8(p1, 0); pa[3] = pack8(p1, 8);
#pragma unroll
      for (int db = 0; db < 2; ++db) {
#pragma unroll
        for (int ts = 0; ts < 4; ++ts) {
          const LAS char* va = sb + vbo[db] + ts * 2048;
          const s16x4 lo = tr_read(va), hh = tr_read(va + 1024);
          const bf16x8 vf = __builtin_shufflevector(lo, hh, 0, 1, 2, 3, 4, 5, 6, 7);
          o[db] = __builtin_amdgcn_mfma_f32_32x32x16_bf16(vf, pa[ts], o[db], 0, 0, 0);
        }
      }
    }
  }
#undef AT_ISSUE
  const float inv = 1.f / half_sum(l_run);
  u16* yp = (u16*)(ws + OFF_Y) + (size_t)(qrow0 + wid * 32 + r32) * 1024 + ycol + 4 * hi;
#pragma unroll
  for (int db = 0; db < 2; ++db)
#pragma unroll
    for (int g = 0; g < 4; ++g) {
      uint2 w; w.x = cvtpk(o[db][4 * g] * inv, o[db][4 * g + 1] * inv); w.y = cvtpk(o[db][4 * g + 2] * inv, o[db][4 * g + 3] * inv);
      *(uint2*)(yp + db * 32 + 8 * g) = w;
    }
}

DI void p3_attention(const Params& p, int layer, LAS char* lds) {
  unsigned* ctr = (unsigned*)(p.ws + OFF_CTRL) + CW_CTR + layer * 16 + 3;
  const int nunits = 4096 + (layer == 0 ? 256 : 0);
  for (;;) {
    const int u = next_unit(ctr, lds);
    if (u >= nunits) break;
    if (u < 1024) { attn_unit<true>(p, layer, 2, 0, u >> 7, (u >> 5) & 3, u & 31, lds); }
    else if (u < 2560) { const int v = u - 1024; attn_unit<false>(p, layer, 1, 0, v / 192, (v % 192) >> 5, v & 31, lds); }
    else if (u < 4096) { const int v = u - 2560; attn_unit<false>(p, layer, 0, 0, v / 192, (v % 192) >> 5, v & 31, lds); }
    else {
      const int w = u - 4096;
      if (w < 64) attn_unit<true>(p, layer, 2, 1, w >> 3, (w >> 1) & 3, w & 1, lds);
      else if (w < 160) { const int v = w - 64; attn_unit<false>(p, layer, 1, 1, v / 12, (v % 12) >> 1, v & 1, lds); }
      else { const int v = w - 160; attn_unit<false>(p, layer, 0, 1, v / 12, (v % 12) >> 1, v & 1, lds); }
    }
  }
}

struct AttnArgs {
  const u16* Q; const u16* K; const u16* K2; const u16* V; u16* Y; const float* sink;
  int ldq, ldk, ldk2, ldv, ldy, ycol, G, window, q_is_ctx; float scale;
};
static_assert(sizeof(AttnArgs) == 88, "no padding");
template <int DK1, int DK2>
__global__ __launch_bounds__(64) void k_attn(AttnArgs a) {
  const int qt = blockIdx.x * 64 + threadIdx.x, b = blockIdx.y, h = blockIdx.z, kvh = h / a.G;
  const int qrow = a.q_is_ctx ? NL + b * C_ + qt : b * S_ + qt;
  float q[DK1 + DK2];
  {
    const uint4* qp = (const uint4*)(a.Q + (size_t)qrow * a.ldq + h * (DK1 + DK2));
#pragma unroll
    for (int i = 0; i < (DK1 + DK2) / 8; ++i) {
      uint4 u = qp[i];
      q[i * 8 + 0] = bflo(u.x) * a.scale; q[i * 8 + 1] = bfhi(u.x) * a.scale; q[i * 8 + 2] = bflo(u.y) * a.scale; q[i * 8 + 3] = bfhi(u.y) * a.scale;
      q[i * 8 + 4] = bflo(u.z) * a.scale; q[i * 8 + 5] = bfhi(u.z) * a.scale; q[i * 8 + 6] = bflo(u.w) * a.scale; q[i * 8 + 7] = bfhi(u.w) * a.scale;
    }
  }
  float m, l, o[64];
  if (a.sink) { m = a.sink[h]; l = 1.f; } else { m = -1e30f; l = 0.f; }
#pragma unroll
  for (int d = 0; d < 64; ++d) o[d] = 0.f;
  const int nseg = a.q_is_ctx ? 1 : 2;
  for (int seg = 0; seg < nseg; ++seg) {
    int lo, hi, rbase; bool masked = false;
    if (seg == 0) { lo = 0; hi = C_; rbase = NL + b * C_; }
    else {
      lo = 0; hi = S_; rbase = b * S_;
      if (a.window) { int t0 = blockIdx.x * 64; lo = t0 - a.window; if (lo < 0) lo = 0; hi = t0 + 64 + a.window; if (hi > S_) hi = S_; masked = true; }
    }
    for (int s = lo; s < hi; s += 4) {
      float sc[4];
#pragma unroll
      for (int i = 0; i < 4; ++i) {
        const uint4* kp = (const uint4*)(a.K + (size_t)(rbase + s + i) * a.ldk + kvh * DK1);
        float dot = 0.f;
#pragma unroll
        for (int c = 0; c < DK1 / 8; ++c) {
          uint4 u = kp[c];
          dot += q[c * 8 + 0] * bflo(u.x) + q[c * 8 + 1] * bfhi(u.x) + q[c * 8 + 2] * bflo(u.y) + q[c * 8 + 3] * bfhi(u.y)
               + q[c * 8 + 4] * bflo(u.z) + q[c * 8 + 5] * bfhi(u.z) + q[c * 8 + 6] * bflo(u.w) + q[c * 8 + 7] * bfhi(u.w);
        }
        if (DK2 > 0) {
          const uint4* kp2 = (const uint4*)(a.K2 + (size_t)(rbase + s + i) * a.ldk2);
#pragma unroll
          for (int c = 0; c < DK2 / 8; ++c) {
            uint4 u = kp2[c];
            dot += q[DK1 + c * 8 + 0] * bflo(u.x) + q[DK1 + c * 8 + 1] * bfhi(u.x) + q[DK1 + c * 8 + 2] * bflo(u.y) + q[DK1 + c * 8 + 3] * bfhi(u.y)
                 + q[DK1 + c * 8 + 4] * bflo(u.z) + q[DK1 + c * 8 + 5] * bfhi(u.z) + q[DK1 + c * 8 + 6] * bflo(u.w) + q[DK1 + c * 8 + 7] * bfhi(u.w);
          }
        }
        if (masked) { int dlt = qt - (s + i); if (dlt < 0) dlt = -dlt; if (dlt > a.window) dot = -1e30f; }
        sc[i] = dot;
      }
      float mx = fmaxf(fmaxf(fmaxf(sc[0], sc[1]), fmaxf(sc[2], sc[3])), m);
      const float alpha = __expf(m - mx);
      float pr[4];
#pragma unroll
      for (int i = 0; i < 4; ++i) pr[i] = __expf(sc[i] - mx);
      l = l * alpha + (pr[0] + pr[1]) + (pr[2] + pr[3]);
      m = mx;
#pragma unroll
      for (int d = 0; d < 64; ++d) o[d] *= alpha;
#pragma unroll
      for (int i = 0; i < 4; ++i) {
        const uint4* vp = (const uint4*)(a.V + (size_t)(rbase + s + i) * a.ldv + kvh * 64);
#pragma unroll
        for (int c = 0; c < 8; ++c) {
          uint4 u = vp[c];
          o[c * 8 + 0] += pr[i] * bflo(u.x); o[c * 8 + 1] += pr[i] * bfhi(u.x); o[c * 8 + 2] += pr[i] * bflo(u.y); o[c * 8 + 3] += pr[i] * bfhi(u.y);
          o[c * 8 + 4] += pr[i] * bflo(u.z); o[c * 8 + 5] += pr[i] * bfhi(u.z); o[c * 8 + 6] += pr[i] * bflo(u.w); o[c * 8 + 7] += pr[i] * bfhi(u.w);
        }
      }
    }
  }
  const float inv = 1.f / l;
  uint4* yp = (uint4*)(a.Y + (size_t)qrow * a.ldy + a.ycol + h * 64);
#pragma unroll
  for (int c = 0; c < 8; ++c) {
    uint4 u;
    u.x = cvtpk(o[c * 8 + 0] * inv, o[c * 8 + 1] * inv); u.y = cvtpk(o[c * 8 + 2] * inv, o[c * 8 + 3] * inv);
    u.z = cvtpk(o[c * 8 + 4] * inv, o[c * 8 + 5] * inv); u.w = cvtpk(o[c * 8 + 6] * inv, o[c * 8 + 7] * inv);
    yp[c] = u;
  }
}

template <int PH>
__global__ __launch_bounds__(NTHR, 2) void k_phase(Params p, int layer, int nrows) {
  extern __shared__ __attribute__((aligned(16))) unsigned char smem[];
  LAS char* lds = (LAS char*)smem;
  if (PH == 0) p0_prologue(p, lds);
  if (PH == 1) p1_norm_mix(p, layer);
  if (PH == 2) p2_inproj(p, layer, lds);
  if (PH == 3) p3_attention(p, layer, lds);
  if (PH == 4) p4_outproj(p, layer, nrows, lds);
  if (PH == 5) p5_norm_ffn(p, layer, nrows, lds);
  if (PH == 6) p6_gateup(p, layer, nrows, lds);
  if (PH == 7) p7_down(p, layer, nrows, lds);
  if (PH == 8) p8_combine(p, layer, nrows);
}

extern "C" void kernel_launch(void* const* d_in, const int* in_sizes, int n_in, void* d_out, int out_size, void* d_ws, size_t ws_size, hipStream_t stream) {
  Params p{};
  p.x = (const float*)d_in[0]; p.c = (const float*)d_in[1]; p.ctx = (const float*)d_in[2]; p.c_ctx = (const float*)d_in[3];
  p.w_mod = (const float*)d_in[4]; p.b_mod = (const float*)d_in[5]; p.norm_mix_g = (const float*)d_in[6]; p.norm_ffn_g = (const float*)d_in[7];
  p.w_in = (const float*)d_in[8]; p.w_out = (const float*)d_in[9]; p.swa_sink = (const float*)d_in[10]; p.glb_q_gain = (const float*)d_in[11];
  p.glb_k_gain = (const float*)d_in[12]; p.mla_q_gain = (const float*)d_in[13]; p.mla_w_uq = (const float*)d_in[14]; p.mla_kv_gain = (const float*)d_in[15];
  p.mla_w_ukv = (const float*)d_in[16]; p.router_w = (const float*)d_in[17]; p.router_bias = (const float*)d_in[18]; p.exp_w_gate = (const float*)d_in[19];
  p.exp_w_up = (const float*)d_in[20]; p.exp_w_down = (const float*)d_in[21]; p.shr_w_gate = (const float*)d_in[22]; p.shr_w_up = (const float*)d_in[23];
  p.shr_w_down = (const float*)d_in[24]; p.final_norm_g = (const float*)d_in[25];
  p.out = (float*)d_out; p.ws = (char*)d_ws;
  char* ws = (char*)d_ws;

  static bool attr_done = false;
  if (!attr_done) {
    (void)hipFuncSetAttribute((const void*)k_phase<0>, hipFuncAttributeMaxDynamicSharedMemorySize, LDS_BYTES);
    (void)hipFuncSetAttribute((const void*)k_phase<1>, hipFuncAttributeMaxDynamicSharedMemorySize, LDS_BYTES);
    (void)hipFuncSetAttribute((const void*)k_phase<2>, hipFuncAttributeMaxDynamicSharedMemorySize, LDS_BYTES);
    (void)hipFuncSetAttribute((const void*)k_phase<3>, hipFuncAttributeMaxDynamicSharedMemorySize, LDS_BYTES);
    (void)hipFuncSetAttribute((const void*)k_phase<4>, hipFuncAttributeMaxDynamicSharedMemorySize, LDS_BYTES);
    (void)hipFuncSetAttribute((const void*)k_phase<5>, hipFuncAttributeMaxDynamicSharedMemorySize, LDS_BYTES);
    (void)hipFuncSetAttribute((const void*)k_phase<6>, hipFuncAttributeMaxDynamicSharedMemorySize, LDS_BYTES);
    (void)hipFuncSetAttribute((const void*)k_phase<7>, hipFuncAttributeMaxDynamicSharedMemorySize, LDS_BYTES);
    (void)hipFuncSetAttribute((const void*)k_phase<8>, hipFuncAttributeMaxDynamicSharedMemorySize, LDS_BYTES);
    attr_done = true;
  }

  (void)hipMemsetAsync(ws + OFF_CTRL, 0, CTRL_BYTES, stream);
  k_phase<0><<<GRID, NTHR, LDS_BYTES, stream>>>(p, 0, 0);
  k_phase<1><<<GRID, NTHR, LDS_BYTES, stream>>>(p, 0, NT);
  for (int l = 0; l < 2; ++l) {
    const bool last = (l == 1);
    const int Mres = last ? NL : NT;
    k_phase<2><<<GRID, NTHR, LDS_BYTES, stream>>>(p, l, NT);
    k_phase<3><<<GRID, NTHR, LDS_BYTES, stream>>>(p, l, NT);
    k_phase<4><<<GRID, NTHR, LDS_BYTES, stream>>>(p, l, Mres);
    k_phase<5><<<GRID, NTHR, LDS_BYTES, stream>>>(p, l, Mres);
    k_phase<6><<<GRID, NTHR, LDS_BYTES, stream>>>(p, l, Mres);
    k_phase<7><<<GRID, NTHR, LDS_BYTES, stream>>>(p, l, Mres);
    k_phase<8><<<GRID, NTHR, LDS_BYTES, stream>>>(p, l, Mres);
  }
}
```

```cpp
#include <hip/hip_runtime.h>
#include <hip/hip_cooperative_groups.h>
#include <cstdio>
#include <stdint.h>
#include <stddef.h>

typedef unsigned short u16;
typedef short bf16x8 __attribute__((ext_vector_type(8)));
typedef float f32x4 __attribute__((ext_vector_type(4)));
typedef float f32x2_t __attribute__((ext_vector_type(2)));
typedef __bf16 bf16x2_t __attribute__((ext_vector_type(2)));
#define DI __device__ __forceinline__
#define LAS __attribute__((address_space(3)))

constexpr int B_ = 8, S_ = 4096, D_ = 1024, C_ = 256;
constexpr int NL = B_ * S_, NC = B_ * C_, NT = NL + NC;
constexpr int INW = 1696, INWP = 1792;
constexpr int NE = 16;
constexpr int MAXSLOT = NT * 2 + NE * 128;
constexpr float EPS = 1e-6f;
constexpr int NTHR = 256;
constexpr int GRID = 512;

DI float bf2f(u16 v) { return __uint_as_float(((unsigned)v) << 16); }
DI float bflo(unsigned u) { return __uint_as_float(u << 16); }
DI float bfhi(unsigned u) { return __uint_as_float(u & 0xffff0000u); }
DI unsigned cvtpk(float lo, float hi) { f32x2_t v = {lo, hi}; bf16x2_t b = __builtin_convertvector(v, bf16x2_t); return __builtin_bit_cast(unsigned, b); }
DI float wave_sum(float v) {
#pragma unroll
  for (int o = 32; o > 0; o >>= 1) v += __shfl_xor(v, o);
  return v;
}
DI float silu(float g) { return g / (1.f + __expf(-g)); }

constexpr size_t al256(size_t x) { return (x + 255) & ~(size_t)255; }
constexpr size_t OFF_CTRL = 0;
constexpr size_t CTRL_BYTES = 65536;
constexpr size_t OFF_CTXR = OFF_CTRL + CTRL_BYTES;
constexpr size_t OFF_MOD = OFF_CTXR + al256((size_t)NC * D_ * 4);
constexpr size_t OFF_TOKE = OFF_MOD + al256((size_t)2 * 9 * 6144 * 4);
constexpr size_t OFF_TOKW = OFF_TOKE + al256((size_t)NT * 2 * 4);
constexpr size_t OFF_TOKP = OFF_TOKW + al256((size_t)NT * 2 * 4);
constexpr size_t OFF_LIST = OFF_TOKP + al256((size_t)NT * 2 * 4);
constexpr size_t OFF_WIN = OFF_LIST + al256((size_t)NE * NT * 4);
constexpr size_t OFF_WO = OFF_WIN + (size_t)2 * INWP * 1024 * 2;
constexpr size_t OFF_WUQ = OFF_WO + (size_t)2 * 1024 * 1024 * 2;
constexpr size_t OFF_WUKV = OFF_WUQ + (size_t)2 * 384 * 256 * 2;
constexpr size_t OFF_WGU = OFF_WUKV + (size_t)2 * 512 * 128 * 2;
constexpr size_t OFF_WD = OFF_WGU + (size_t)2 * 16 * 1024 * 1024 * 2;
constexpr size_t OFF_SGU = OFF_WD + (size_t)2 * 16 * 1024 * 512 * 2;
constexpr size_t OFF_SD = OFF_SGU + (size_t)2 * 1024 * 1024 * 2;
constexpr size_t OFF_H = OFF_SD + (size_t)2 * 1024 * 512 * 2;
constexpr size_t OFF_BIG = OFF_H + (size_t)NT * 1024 * 2;
constexpr size_t OFF_SWQ = OFF_BIG;
constexpr size_t OFF_SWK = OFF_SWQ + (size_t)NT * 384 * 2;
constexpr size_t OFF_SWV = OFF_SWK + (size_t)NT * 128 * 2;
constexpr size_t OFF_GLQ = OFF_SWV + (size_t)NT * 128 * 2;
constexpr size_t OFF_GLK = OFF_GLQ + (size_t)NT * 384 * 2;
constexpr size_t OFF_GLV = OFF_GLK + (size_t)NT * 128 * 2;
constexpr size_t OFF_MLQ = OFF_GLV + (size_t)NT * 128 * 2;
constexpr size_t OFF_MLK = OFF_MLQ + (size_t)NT * 384 * 2;
constexpr size_t OFF_MLKR = OFF_MLK + (size_t)NT * 256 * 2;
constexpr size_t OFF_MLV = OFF_MLKR + (size_t)NT * 32 * 2;
constexpr size_t OFF_QLAT = OFF_MLV + (size_t)NT * 256 * 2;
constexpr size_t OFF_KVLAT = OFF_QLAT + (size_t)NT * 256 * 2;
constexpr size_t OFF_Y = OFF_KVLAT + (size_t)NT * 128 * 2;
constexpr size_t END_A = OFF_Y + (size_t)NT * 1024 * 2;
constexpr size_t OFF_ACT = OFF_BIG;
constexpr size_t OFF_ACTS = OFF_ACT + (size_t)MAXSLOT * 512 * 2;
constexpr size_t OFF_YEXP = OFF_ACTS + (size_t)NT * 512 * 2;
constexpr size_t END_B = OFF_YEXP + (size_t)MAXSLOT * 1024 * 2;
constexpr size_t OFF_YSH = OFF_H;
constexpr size_t WS_NEED = END_A > END_B ? END_A : END_B;
static_assert(WS_NEED <= (size_t)536870912, "workspace too large");

constexpr int CW_CTR = 0;
constexpr int CW_CNT = 64;

struct Params {
  const float *x, *c, *ctx, *c_ctx, *w_mod, *b_mod, *norm_mix_g, *norm_ffn_g, *w_in, *w_out, *swa_sink, *glb_q_gain, *glb_k_gain,
      *mla_q_gain, *mla_w_uq, *mla_kv_gain, *mla_w_ukv, *router_w, *router_bias, *exp_w_gate, *exp_w_up, *exp_w_down, *shr_w_gate,
      *shr_w_up, *shr_w_down, *final_norm_g;
  float* out;
  char* ws;
  int never; int pad;
};

constexpr int LDS_MISC = 65536;
constexpr int LDS_BYTES = 65536 + 4096;

DI int next_unit(unsigned* ctr, LAS char* lds) {
  volatile LAS int* slot = (volatile LAS int*)(lds + LDS_MISC + 2560);
  __syncthreads();
  if (threadIdx.x == 0) *slot = (int)atomicAdd(ctr, 1u);
  __syncthreads();
  return *slot;
}

DI void cvt_job(const float* __restrict__ src, int ld, int N, int k0, int n0, u16* __restrict__ dst, int K, int mode  , LAS char* lds) {
  LAS float* T = (LAS float*)lds;
  const int tid = threadIdx.x;
  __syncthreads();
  {
    const int kk = tid >> 2, nq = (tid & 3) * 32;
    const float* s = src + (size_t)(k0 + kk) * ld + n0 + nq;
#pragma unroll
    for (int i = 0; i < 8; ++i) {
      float4 v = make_float4(0.f, 0.f, 0.f, 0.f);
      if (n0 + nq + i * 4 < N) v = *(const float4*)(s + i * 4);
      LAS float* t = T + kk * 129 + nq + i * 4;
      t[0] = v.x; t[1] = v.y; t[2] = v.z; t[3] = v.w;
    }
  }
  __syncthreads();
#pragma unroll
  for (int i = 0; i < 4; ++i) {
    const int chn = tid + i * 256;
    const int n = chn >> 3, kc = (chn & 7) * 8;
    if (n0 + n < N) {
      const LAS float* t = T + kc * 129 + n;
      uint4 o;
      o.x = cvtpk(t[0], t[129]); o.y = cvtpk(t[2 * 129], t[3 * 129]); o.z = cvtpk(t[4 * 129], t[5 * 129]); o.w = cvtpk(t[6 * 129], t[7 * 129]);
      const int gn = n0 + n;
      int drow = gn;
      if (mode) drow = (gn >> 5) * 64 + (gn & 31) + (mode == 2 ? 32 : 0);
      *(uint4*)(dst + (size_t)drow * K + k0 + kc) = o;
    }
  }
}

DI void mod_job(const Params& p, int l, int j0, LAS char* lds) {
  LAS float* sc = (LAS float*)lds;
  LAS float* red = (LAS float*)(lds + 36864);
  const int tid = threadIdx.x;
  __syncthreads();
  for (int i = tid; i < 9 * 1024; i += NTHR) {
    int r = i >> 10, k = i & 1023;
    float v = r < 8 ? p.c[r * 1024 + k] : p.c_ctx[k];
    sc[i] = v / (1.f + __expf(-v));
  }
  __syncthreads();
  const int col = tid & 63, kg = tid >> 6;
  float acc[9];
#pragma unroll
  for (int r = 0; r < 9; ++r) acc[r] = 0.f;
  const float* w = p.w_mod + (size_t)l * 1024 * 6144 + (size_t)(kg * 256) * 6144 + j0 + col;
  for (int k = 0; k < 256; ++k) {
    float wv = w[(size_t)k * 6144];
#pragma unroll
    for (int r = 0; r < 9; ++r) acc[r] += sc[r * 1024 + kg * 256 + k] * wv;
  }
#pragma unroll
  for (int r = 0; r < 9; ++r) red[(kg * 9 + r) * 64 + col] = acc[r];
  __syncthreads();
  float* MOD = (float*)(p.ws + OFF_MOD);
  for (int i = tid; i < 9 * 64; i += NTHR) {
    int r = i >> 6, cc = i & 63;
    float s = red[(0 * 9 + r) * 64 + cc] + red[(1 * 9 + r) * 64 + cc] + red[(2 * 9 + r) * 64 + cc] + red[(3 * 9 + r) * 64 + cc];
    MOD[(size_t)(l * 9 + r) * 6144 + j0 + cc] = s + p.b_mod[l * 6144 + j0 + cc];
  }
}

constexpr int J_WIN = 16 * 14, J_WO = 16 * 8, J_UQ = 4 * 3, J_UKV = 2 * 4, J_EG = 16 * 4, J_ED = 8 * 8;
constexpr int J_DENSE = J_WIN + J_WO + J_UQ + J_UKV;
constexpr int J_EXP = 16 * (2 * J_EG + J_ED);
constexpr int J_SHR = 2 * J_EG + J_ED;
constexpr int J_LAYER = J_DENSE + J_EXP + J_SHR;
constexpr int J_MOD = 2 * 96;
constexpr int J_TOTAL = 2 * J_LAYER + J_MOD;

DI void p0_prologue(const Params& p, LAS char* lds) {
  char* ws = p.ws;
  for (int job = blockIdx.x; job < J_TOTAL; job += gridDim.x) {
    if (job < J_MOD) { mod_job(p, job / 96, (job % 96) * 64, lds); continue; }
    int r = job - J_MOD;
    const int l = r / J_LAYER; r -= l * J_LAYER;
    if (r < J_WIN) { cvt_job(p.w_in + (size_t)l * 1024 * INW, INW, INW, (r / 14) * 64, (r % 14) * 128, (u16*)(ws + OFF_WIN) + (size_t)l * INWP * 1024, 1024, 0, lds); continue; } r -= J_WIN;
    if (r < J_WO) { cvt_job(p.w_out + (size_t)l * 1024 * 1024, 1024, 1024, (r / 8) * 64, (r % 8) * 128, (u16*)(ws + OFF_WO) + (size_t)l * 1024 * 1024, 1024, 0, lds); continue; } r -= J_WO;
    if (r < J_UQ) { cvt_job(p.mla_w_uq + (size_t)l * 256 * 384, 384, 384, (r / 3) * 64, (r % 3) * 128, (u16*)(ws + OFF_WUQ) + (size_t)l * 384 * 256, 256, 0, lds); continue; } r -= J_UQ;
    if (r < J_UKV) { cvt_job(p.mla_w_ukv + (size_t)l * 128 * 512, 512, 512, (r / 4) * 64, (r % 4) * 128, (u16*)(ws + OFF_WUKV) + (size_t)l * 512 * 128, 128, 0, lds); continue; } r -= J_UKV;
    if (r < J_EXP) {
      const int e = r / (2 * J_EG + J_ED); int q = r % (2 * J_EG + J_ED);
      const size_t le = (size_t)l * NE + e;
      if (q < J_EG) { cvt_job(p.exp_w_gate + le * 1024 * 512, 512, 512, (q / 4) * 64, (q % 4) * 128, (u16*)(ws + OFF_WGU) + le * 1024 * 1024, 1024, 1, lds); continue; } q -= J_EG;
      if (q < J_EG) { cvt_job(p.exp_w_up + le * 1024 * 512, 512, 512, (q / 4) * 64, (q % 4) * 128, (u16*)(ws + OFF_WGU) + le * 1024 * 1024, 1024, 2, lds); continue; } q -= J_EG;
      cvt_job(p.exp_w_down + le * 512 * 1024, 1024, 1024, (q / 8) * 64, (q % 8) * 128, (u16*)(ws + OFF_WD) + le * 1024 * 512, 512, 0, lds); continue;
    }
    r -= J_EXP;
    if (r < J_EG) { cvt_job(p.shr_w_gate + (size_t)l * 1024 * 512, 512, 512, (r / 4) * 64, (r % 4) * 128, (u16*)(ws + OFF_SGU) + (size_t)l * 1024 * 1024, 1024, 1, lds); continue; } r -= J_EG;
    if (r < J_EG) { cvt_job(p.shr_w_up + (size_t)l * 1024 * 512, 512, 512, (r / 4) * 64, (r % 4) * 128, (u16*)(ws + OFF_SGU) + (size_t)l * 1024 * 1024, 1024, 2, lds); continue; } r -= J_EG;
    cvt_job(p.shr_w_down + (size_t)l * 512 * 1024, 1024, 1024, (r / 8) * 64, (r % 8) * 128, (u16*)(ws + OFF_SD) + (size_t)l * 1024 * 512, 512, 0, lds);
  }
}

DI const float* xrow_ptr(const Params& p, int layer_src  , int row) {
  if (layer_src == 0) return row < NL ? p.x + (size_t)row * 1024 : p.ctx + (size_t)(row - NL) * 1024;
  return row < NL ? p.out + (size_t)row * 1024 : (const float*)(p.ws + OFF_CTXR) + (size_t)(row - NL) * 1024;
}
DI float* xrow_out(const Params& p, int row) {
  return row < NL ? p.out + (size_t)row * 1024 : (float*)(p.ws + OFF_CTXR) + (size_t)(row - NL) * 1024;
}

DI void norm_mod_row(f32x4 (&v)[4], const float* __restrict__ g, const float* __restrict__ md  , int lane) {
  float ss = 0.f;
#pragma unroll
  for (int i = 0; i < 4; ++i) ss += v[i].x * v[i].x + v[i].y * v[i].y + v[i].z * v[i].z + v[i].w * v[i].w;
  ss = wave_sum(ss);
  const float rstd = rsqrtf(ss * (1.f / 1024.f) + EPS);
#pragma unroll
  for (int i = 0; i < 4; ++i) {
    const f32x4 gg = *(const f32x4*)(g + lane * 4 + i * 256);
    const f32x4 sh = *(const f32x4*)(md + lane * 4 + i * 256);
    const f32x4 sc = *(const f32x4*)(md + 1024 + lane * 4 + i * 256);
    v[i] = v[i] * rstd * gg * (sc + 1.f) + sh;
  }
}
DI void store_h_row(const f32x4 (&v)[4], u16* __restrict__ hrow, int lane) {
#pragma unroll
  for (int i = 0; i < 4; ++i) {
    uint2 o; o.x = cvtpk(v[i].x, v[i].y); o.y = cvtpk(v[i].z, v[i].w);
    *(uint2*)(hrow + lane * 4 + i * 256) = o;
  }
}

DI void p1_norm_mix(const Params& p, int layer) {
  const int lane = threadIdx.x & 63, gw = blockIdx.x * 4 + (threadIdx.x >> 6), ngw = gridDim.x * 4;
  const float* MODl = (const float*)(p.ws + OFF_MOD) + (size_t)layer * 9 * 6144;
  u16* H = (u16*)(p.ws + OFF_H);
  for (int row = gw; row < NT; row += ngw) {
    const float* xr = xrow_ptr(p, layer, row);
    f32x4 v[4];
#pragma unroll
    for (int i = 0; i < 4; ++i) v[i] = *(const f32x4*)(xr + lane * 4 + i * 256);
    const int mr = row < NL ? row / S_ : 8;
    norm_mod_row(v, p.norm_mix_g + layer * 1024, MODl + (size_t)mr * 6144, lane);
    store_h_row(v, H + (size_t)row * 1024, lane);
  }
}

DI void route_row(const Params& p, int layer, int row, const f32x4 (&v)[4], LAS char* lds, int lane, int wid) {
  const LAS f32x4* R = (const LAS f32x4*)lds;
  float pl[16];
#pragma unroll
  for (int e = 0; e < 16; ++e) pl[e] = 0.f;
#pragma unroll
  for (int i = 0; i < 4; ++i) {
    const int kq = i * 64 + lane;
#pragma unroll
    for (int kk = 0; kk < 4; ++kk) {
      const float hv = v[i][kk];
#pragma unroll
      for (int q = 0; q < 4; ++q) {
        const f32x4 w = R[(kk * 4 + q) * 256 + kq];
        pl[q * 4 + 0] += hv * w.x; pl[q * 4 + 1] += hv * w.y; pl[q * 4 + 2] += hv * w.z; pl[q * 4 + 3] += hv * w.w;
      }
    }
  }
#pragma unroll
  for (int e = 0; e < 16; ++e) pl[e] = wave_sum(pl[e]);
  volatile LAS float* sg = (volatile LAS float*)(lds + LDS_MISC + 3072) + wid * 32;
  if (lane == 0) {
#pragma unroll
    for (int e = 0; e < 16; ++e) { float s = 1.f / (1.f + expf(-pl[e])); sg[e] = s; sg[16 + e] = s + p.router_bias[e]; }
    int bg = 0; float bgs = -1e30f;
    for (int gI = 0; gI < 4; ++gI) {
      float m1 = -1e30f, m2 = -1e30f;
      for (int e = 0; e < 4; ++e) { float x = sg[16 + gI * 4 + e]; if (x > m1) { m2 = m1; m1 = x; } else if (x > m2) m2 = x; }
      float gs = m1 + m2;
      if (gs > bgs) { bgs = gs; bg = gI; }
    }
    int i0 = bg * 4, i1 = bg * 4; float v0 = -1e30f, v1 = -1e30f;
    for (int e = 0; e < 4; ++e) { float x = sg[16 + bg * 4 + e]; if (x > v0) { v0 = x; i0 = bg * 4 + e; } }
    for (int e = 0; e < 4; ++e) { int ee = bg * 4 + e; if (ee == i0) continue; float x = sg[16 + ee]; if (x > v1) { v1 = x; i1 = ee; } }
    const float w0 = sg[i0], w1 = sg[i1], inv = 1.f / (w0 + w1);
    unsigned* cnt = (unsigned*)(p.ws + OFF_CTRL) + CW_CNT + layer * 16;
    int* tok_e = (int*)(p.ws + OFF_TOKE); float* tok_w = (float*)(p.ws + OFF_TOKW); int* tok_p = (int*)(p.ws + OFF_TOKP);
    int* list = (int*)(p.ws + OFF_LIST);
    const int p0 = (int)atomicAdd(&cnt[i0], 1u), p1 = (int)atomicAdd(&cnt[i1], 1u);
    tok_e[row * 2] = i0; tok_e[row * 2 + 1] = i1;
    tok_w[row * 2] = w0 * inv; tok_w[row * 2 + 1] = w1 * inv;
    tok_p[row * 2] = p0; tok_p[row * 2 + 1] = p1;
    list[(size_t)i0 * NT + p0] = row; list[(size_t)i1 * NT + p1] = row;
  }
}

DI void load_router_lds(const Params& p, LAS char* lds) {
  LAS f32x4* R = (LAS f32x4*)lds;
  __syncthreads();
  for (int g = threadIdx.x; g < 4096; g += NTHR) {
    const int k = g >> 2, q = g & 3;
    R[((k & 3) * 4 + q) * 256 + (k >> 2)] = *(const f32x4*)(p.router_w + (size_t)g * 4);
  }
  __syncthreads();
}

DI void p5_norm_ffn(const Params& p, int layer, int nrows, LAS char* lds) {
  load_router_lds(p, lds);
  const int lane = threadIdx.x & 63, wid = threadIdx.x >> 6, gw = blockIdx.x * 4 + wid, ngw = gridDim.x * 4;
  const float* MODl = (const float*)(p.ws + OFF_MOD) + (size_t)layer * 9 * 6144;
  u16* H = (u16*)(p.ws + OFF_H);
  for (int row = gw; row < nrows; row += ngw) {
    const float* xr = xrow_ptr(p, 1, row);
    f32x4 v[4];
#pragma unroll
    for (int i = 0; i < 4; ++i) v[i] = *(const f32x4*)(xr + lane * 4 + i * 256);
    const int mr = row < NL ? row / S_ : 8;
    norm_mod_row(v, p.norm_ffn_g + layer * 1024, MODl + (size_t)mr * 6144 + 3 * 1024, lane);
    store_h_row(v, H + (size_t)row * 1024, lane);
    route_row(p, layer, row, v, lds, lane, wid);
  }
}

DI void seg_scan(const Params& p, int layer, int (&tb)[NE + 1]) {
  const unsigned* cnt = (const unsigned*)(p.ws + OFF_CTRL) + CW_CNT + layer * 16;
  int acc = 0;
#pragma unroll
  for (int e = 0; e < NE; ++e) { tb[e] = acc; acc += ((int)cnt[e] + 127) >> 7; }
  tb[NE] = acc;
}

DI void p8_combine(const Params& p, int layer, int nrows) {
  const int lane = threadIdx.x & 63, gw = blockIdx.x * 4 + (threadIdx.x >> 6), ngw = gridDim.x * 4;
  const float* MODl = (const float*)(p.ws + OFF_MOD) + (size_t)layer * 9 * 6144;
  const float* MODn = (const float*)(p.ws + OFF_MOD) + (size_t)(layer + 1) * 9 * 6144;
  u16* H = (u16*)(p.ws + OFF_H);
  const u16* YSH = (const u16*)(p.ws + OFF_YSH);
  const u16* YEXP = (const u16*)(p.ws + OFF_YEXP);
  const int* tok_e = (const int*)(p.ws + OFF_TOKE); const float* tok_w = (const float*)(p.ws + OFF_TOKW); const int* tok_p = (const int*)(p.ws + OFF_TOKP);
  int tb[NE + 1]; seg_scan(p, layer, tb);
  for (int row = gw; row < nrows; row += ngw) {
    const int e0 = tok_e[row * 2], e1 = tok_e[row * 2 + 1];
    int ps0 = 0, ps1 = 0;
#pragma unroll
    for (int e = 0; e < NE; ++e) { if (e == e0) ps0 = tb[e]; if (e == e1) ps1 = tb[e]; }
    const size_t s0 = (size_t)ps0 * 128 + tok_p[row * 2], s1 = (size_t)ps1 * 128 + tok_p[row * 2 + 1];
    const float w0 = tok_w[row * 2], w1 = tok_w[row * 2 + 1];
    float* xr = xrow_out(p, row);
    const int mr = row < NL ? row / S_ : 8;
    const float* gate = MODl + (size_t)mr * 6144 + 5 * 1024;
    f32x4 v[4];
#pragma unroll
    for (int i = 0; i < 4; ++i) {
      const int cidx = lane * 4 + i * 256;
      const uint2 a = *(const uint2*)(YEXP + s0 * 1024 + cidx);
      const uint2 b = *(const uint2*)(YEXP + s1 * 1024 + cidx);
      const uint2 c = *(const uint2*)(YSH + (size_t)row * 1024 + cidx);
      const f32x4 g = *(const f32x4*)(gate + cidx);
      f32x4 x = *(const f32x4*)(xr + cidx);
      x.x += g.x * (w0 * bflo(a.x) + w1 * bflo(b.x) + bflo(c.x));
      x.y += g.y * (w0 * bfhi(a.x) + w1 * bfhi(b.x) + bfhi(c.x));
      x.z += g.z * (w0 * bflo(a.y) + w1 * bflo(b.y) + bflo(c.y));
      x.w += g.w * (w0 * bfhi(a.y) + w1 * bfhi(b.y) + bfhi(c.y));
      v[i] = x;
    }
    if (layer == 0) {
#pragma unroll
      for (int i = 0; i < 4; ++i) *(f32x4*)(xr + lane * 4 + i * 256) = v[i];
      norm_mod_row(v, p.norm_mix_g + 1024, MODn + (size_t)mr * 6144, lane);
      store_h_row(v, H + (size_t)row * 1024, lane);
    } else {
      float ss = 0.f;
#pragma unroll
      for (int i = 0; i < 4; ++i) ss += v[i].x * v[i].x + v[i].y * v[i].y + v[i].z * v[i].z + v[i].w * v[i].w;
      ss = wave_sum(ss);
      const float rstd = rsqrtf(ss * (1.f / 1024.f) + EPS);
#pragma unroll
      for (int i = 0; i < 4; ++i) {
        const f32x4 gg = *(const f32x4*)(p.final_norm_g + lane * 4 + i * 256);
        *(f32x4*)(xr + lane * 4 + i * 256) = v[i] * rstd * gg;
      }
    }
  }
}

DI void glds16(const u16* g, LAS char* l) {
  __builtin_amdgcn_global_load_lds((const void*)g, (LAS void*)l, 16, 0, 0);
}
DI void gemm_tile(LAS char* lds, const u16* a0, const u16* a1, const u16* b0, const u16* b1, int nk, f32x4 (&acc)[4][4]) {
  const int tid = threadIdx.x, lane = tid & 63, wid = tid >> 6, wr = wid >> 1, wc = wid & 1, fr = lane & 15, fq = lane >> 4;
  const int cx = (fq ^ ((0 - (fr >> 2)) & 3)) * 16;
  const int aoff = (wr * 64 + fr) * 64 + cx;
  const int boff = 16384 + (wc * 64 + fr) * 64 + cx;
#pragma unroll
  for (int m = 0; m < 4; ++m)
#pragma unroll
    for (int n = 0; n < 4; ++n) acc[m][n] = (f32x4){0.f, 0.f, 0.f, 0.f};
  LAS char* ldst = lds + tid * 16;
#define GT_ISSUE(kt, s) do { const int _ko = (kt) * 64; LAS char* _d = ldst + (s) * 32768; \
    glds16(a0 + _ko, _d); glds16(a1 + _ko, _d + 4096); glds16(a0 + _ko + 32, _d + 8192); glds16(a1 + _ko + 32, _d + 12288); \
    glds16(b0 + _ko, _d + 16384); glds16(b1 + _ko, _d + 20480); glds16(b0 + _ko + 32, _d + 24576); glds16(b1 + _ko + 32, _d + 28672); } while (0)
  GT_ISSUE(0, 0);
#pragma unroll 1
  for (int kt = 0; kt < nk; ++kt) {
    asm volatile("s_waitcnt vmcnt(0)" ::: "memory");
    __syncthreads();
    if (kt + 1 < nk) GT_ISSUE(kt + 1, (kt + 1) & 1);
    const LAS char* sb = lds + (kt & 1) * 32768;
#pragma unroll
    for (int h = 0; h < 2; ++h) {
      bf16x8 af[4], bfr[4];
#pragma unroll
      for (int m = 0; m < 4; ++m) af[m] = *(const LAS bf16x8*)(sb + h * 8192 + aoff + m * 1024);
#pragma unroll
      for (int n = 0; n < 4; ++n) bfr[n] = *(const LAS bf16x8*)(sb + h * 8192 + boff + n * 1024);
#pragma unroll
      for (int m = 0; m < 4; ++m)
#pragma unroll
        for (int n = 0; n < 4; ++n) acc[m][n] = __builtin_amdgcn_mfma_f32_16x16x32_bf16(bfr[n], af[m], acc[m][n], 0, 0, 0);
    }
  }
#undef GT_ISSUE
  __syncthreads();
}
DI int gt_chunk(int tid) { return (((tid & 3) ^ ((0 - ((tid >> 4) & 3)) & 3))) * 8; }
DI int gt_row0(int tid) { return tid >> 2; }
DI int opaque(int v) { asm volatile("" : "+v"(v)); return v; }

DI void sincos_rev(float pos, float invf, float& sn, float& cs) {
  float rev = pos * invf * 0.15915494309189535f;
  rev -= rintf(rev);
  sn = __builtin_amdgcn_sinf(rev); cs = __builtin_amdgcn_cosf(rev);
}
DI void st_bf4(u16* dst, const f32x4& v) { uint2 o; o.x = cvtpk(v[0], v[1]); o.y = cvtpk(v[2], v[3]); *(uint2*)dst = o; }

DI void epi_inproj(const Params& p, int layer, f32x4 (&acc)[4][4], int m0, int seg, int wr, int fr, int fq, LAS float* rowss_slot) {
  char* ws = p.ws;
  const bool lat = m0 < NL;
  const int rbase = m0 + wr * 64 + fr;
  u16* dst; int ld, cb; int kind;
  if (seg < 6) { dst = (u16*)(ws + OFF_SWQ); ld = 384; cb = seg * 64; kind = 1; }
  else if (seg < 8) { dst = (u16*)(ws + OFF_SWK); ld = 128; cb = (seg - 6) * 64; kind = 1; }
  else if (seg < 10) { dst = (u16*)(ws + OFF_SWV); ld = 128; cb = (seg - 8) * 64; kind = 0; }
  else if (seg < 16) { dst = (u16*)(ws + OFF_GLQ); ld = 384; cb = (seg - 10) * 64; kind = 2; }
  else if (seg < 18) { dst = (u16*)(ws + OFF_GLK); ld = 128; cb = (seg - 16) * 64; kind = 3; }
  else if (seg < 20) { dst = (u16*)(ws + OFF_GLV); ld = 128; cb = (seg - 18) * 64; kind = 0; }
  else if (seg < 24) { dst = (u16*)(ws + OFF_QLAT); ld = 256; cb = (seg - 20) * 64; kind = 4; }
  else if (seg < 26) { dst = (u16*)(ws + OFF_KVLAT); ld = 128; cb = (seg - 24) * 64; kind = 5; }
  else if (seg == 26) { dst = (u16*)(ws + OFF_MLKR); ld = 32; cb = 0; kind = 6; }
  else return;
  if (kind == 2 || kind == 3) {
    const float* gain = (kind == 2 ? p.glb_q_gain : p.glb_k_gain) + layer * 64;
    f32x4 gv[4];
#pragma unroll
    for (int n = 0; n < 4; ++n) gv[n] = *(const f32x4*)(gain + n * 16 + fq * 4);
#pragma unroll
    for (int m = 0; m < 4; ++m) {
      float ss = 0.f;
#pragma unroll
      for (int n = 0; n < 4; ++n) ss += acc[m][n][0] * acc[m][n][0] + acc[m][n][1] * acc[m][n][1] + acc[m][n][2] * acc[m][n][2] + acc[m][n][3] * acc[m][n][3];
      ss += __shfl_xor(ss, 16); ss += __shfl_xor(ss, 32);
      const float r = rsqrtf(ss * (1.f / 64.f) + EPS);
#pragma unroll
      for (int n = 0; n < 4; ++n) acc[m][n] = acc[m][n] * r * gv[n];
    }
  }
  if (kind == 4 || kind == 5) {
    const float* gain = (kind == 4 ? p.mla_q_gain + layer * 256 : p.mla_kv_gain + layer * 128) + cb;
    f32x4 gv[4];
#pragma unroll
    for (int n = 0; n < 4; ++n) gv[n] = *(const f32x4*)(gain + n * 16 + fq * 4);
#pragma unroll
    for (int m = 0; m < 4; ++m) {
      float ss = 0.f;
#pragma unroll
      for (int n = 0; n < 4; ++n) ss += acc[m][n][0] * acc[m][n][0] + acc[m][n][1] * acc[m][n][1] + acc[m][n][2] * acc[m][n][2] + acc[m][n][3] * acc[m][n][3];
      ss += __shfl_xor(ss, 16); ss += __shfl_xor(ss, 32);
      if (fq == 0) rowss_slot[wr * 64 + m * 16 + fr] = ss;
#pragma unroll
      for (int n = 0; n < 4; ++n) acc[m][n] = acc[m][n] * gv[n];
    }
  }
  if (lat && (kind == 1 || kind == 2 || kind == 3)) {
    float invf[4];
#pragma unroll
    for (int j = 0; j < 4; ++j) invf[j] = __builtin_amdgcn_exp2f(-(float)(fq * 4 + j) * (13.287712379549449f / 16.f));
#pragma unroll
    for (int m = 0; m < 4; ++m) {
      const int t = (rbase + m * 16) & (S_ - 1);
      const float prow = (float)(t >> 6), pcol = (float)(t & 63);
#pragma unroll
      for (int j = 0; j < 4; ++j) {
        float sr, cr, sc, cc;
        sincos_rev(prow, invf[j], sr, cr); sincos_rev(pcol, invf[j], sc, cc);
        float x1 = acc[m][0][j], x2 = acc[m][1][j];
        acc[m][0][j] = x1 * cr - x2 * sr; acc[m][1][j] = x2 * cr + x1 * sr;
        x1 = acc[m][2][j]; x2 = acc[m][3][j];
        acc[m][2][j] = x1 * cc - x2 * sc; acc[m][3][j] = x2 * cc + x1 * sc;
      }
    }
  }
  if (kind == 6) {
    if (lat) {
      float invf[4];
#pragma unroll
      for (int j = 0; j < 4; ++j) invf[j] = __builtin_amdgcn_exp2f(-(float)((fq & 1) * 4 + j) * (13.287712379549449f / 8.f));
#pragma unroll
      for (int m = 0; m < 4; ++m) {
        const int t = (rbase + m * 16) & (S_ - 1);
#pragma unroll
        for (int n = 0; n < 2; ++n) {
          const float pos = n == 0 ? (float)(t >> 6) : (float)(t & 63);
#pragma unroll
          for (int j = 0; j < 4; ++j) {
            float sn, cs; sincos_rev(pos, invf[j], sn, cs);
            const float v = acc[m][n][j], pr = __shfl_xor(v, 32);
            acc[m][n][j] = (fq & 2) ? v * cs + pr * sn : v * cs - pr * sn;
          }
        }
      }
    }
#pragma unroll
    for (int m = 0; m < 4; ++m)
#pragma unroll
      for (int n = 0; n < 2; ++n) st_bf4(dst + (size_t)(rbase + m * 16) * ld + n * 16 + fq * 4, acc[m][n]);
    return;
  }
#pragma unroll
  for (int m = 0; m < 4; ++m)
#pragma unroll
    for (int n = 0; n < 4; ++n) st_bf4(dst + (size_t)(rbase + m * 16) * ld + cb + n * 16 + fq * 4, acc[m][n]);
}

DI void p2_inproj(const Params& p, int layer, LAS char* lds) {
  char* ws = p.ws;
  unsigned* ctr = (unsigned*)(ws + OFF_CTRL) + CW_CTR + layer * 16 + 2;
  const u16* H = (const u16*)(ws + OFF_H);
  const u16* WinT = (const u16*)(ws + OFF_WIN) + (size_t)layer * INWP * 1024;
  const u16* WuqT = (const u16*)(ws + OFF_WUQ) + (size_t)layer * 384 * 256;
  const u16* WukvT = (const u16*)(ws + OFF_WUKV) + (size_t)layer * 512 * 128;
  const int tid = threadIdx.x, lane = tid & 63, wid = tid >> 6, wr = wid >> 1, wc = wid & 1;
  LAS float* rowss = (LAS float*)(lds + LDS_MISC);
  LAS float* rstd = (LAS float*)(lds + LDS_MISC + 2048);
  const int nunits = (NT / 128) * 12;
  f32x4 acc[4][4];
  for (;;) {
    const int u = next_unit(ctr, lds);
    if (u >= nunits) break;
    const int tid_o = opaque(tid), lane_o = tid_o & 63;
    const int fr = lane_o & 15, fq = lane_o >> 4, ch = gt_chunk(tid_o), r0 = gt_row0(tid_o);
    const int rt = u / 12, k = u % 12, m0 = rt * 128;
    const u16* a0 = H + (size_t)(m0 + r0) * 1024 + ch;
    const u16* a1 = a0 + (size_t)64 * 1024;
    if (k < 10) {
      const u16* b0 = WinT + (size_t)(k * 128 + r0) * 1024 + ch;
      gemm_tile(lds, a0, a1, b0, b0 + (size_t)64 * 1024, 16, acc);
      epi_inproj(p, layer, acc, m0, k * 2 + wc, wr, fr, fq, rowss);
    } else if (k == 10) {
#pragma unroll 1
      for (int t = 0; t < 2; ++t) {
        const u16* b0 = WinT + (size_t)(1280 + t * 128 + r0) * 1024 + ch;
        gemm_tile(lds, a0, a1, b0, b0 + (size_t)64 * 1024, 16, acc);
        epi_inproj(p, layer, acc, m0, 20 + t * 2 + wc, wr, fr, fq, rowss + (t * 2 + wc) * 128);
      }
      __syncthreads();
      if (tid < 128) rstd[tid] = rsqrtf((rowss[tid] + rowss[128 + tid] + rowss[256 + tid] + rowss[384 + tid]) * (1.f / 256.f) + EPS);
      __syncthreads();
      const u16* QL = (const u16*)(ws + OFF_QLAT);
      const u16* qa0 = QL + (size_t)(m0 + r0) * 256 + ch;
      const u16* qa1 = qa0 + (size_t)64 * 256;
      u16* MLQ = (u16*)(ws + OFF_MLQ);
      const bool lat = m0 < NL;
#pragma unroll 1
      for (int t = 0; t < 3; ++t) {
        const u16* b0 = WuqT + (size_t)(t * 128 + r0) * 256 + ch;
        gemm_tile(lds, qa0, qa1, b0, b0 + (size_t)64 * 256, 4, acc);
        const int c0 = t * 128 + wc * 64;
        float invf[4];
#pragma unroll
        for (int j = 0; j < 4; ++j) invf[j] = __builtin_amdgcn_exp2f(-(float)((fq & 1) * 4 + j) * (13.287712379549449f / 8.f));
#pragma unroll
        for (int m = 0; m < 4; ++m) {
          const int rl = wr * 64 + m * 16 + fr;
          const float rs = rstd[rl];
          const int tpos = (m0 + rl) & (S_ - 1);
#pragma unroll
          for (int n = 0; n < 4; ++n) {
            acc[m][n] = acc[m][n] * rs;
            const int w96 = (c0 + n * 16) % 96;
            if (lat && w96 >= 64) {
              const float pos = (w96 == 64) ? (float)(tpos >> 6) : (float)(tpos & 63);
#pragma unroll
              for (int j = 0; j < 4; ++j) {
                float sn, cs; sincos_rev(pos, invf[j], sn, cs);
                const float v = acc[m][n][j], pr = __shfl_xor(v, 32);
                acc[m][n][j] = (fq & 2) ? v * cs + pr * sn : v * cs - pr * sn;
              }
            }
            st_bf4(MLQ + (size_t)(m0 + rl) * 384 + c0 + n * 16 + fq * 4, acc[m][n]);
          }
        }
      }
    } else {
      {
        const u16* b0 = WinT + (size_t)(1536 + r0) * 1024 + ch;
        gemm_tile(lds, a0, a1, b0, b0 + (size_t)64 * 1024, 16, acc);
        epi_inproj(p, layer, acc, m0, 24 + wc, wr, fr, fq, rowss + wc * 128);
        const u16* b2 = WinT + (size_t)(1664 + r0) * 1024 + ch;
        gemm_tile(lds, a0, a1, b2, b2 + (size_t)64 * 1024, 16, acc);
        epi_inproj(p, layer, acc, m0, 26 + wc, wr, fr, fq, rowss);
      }
      __syncthreads();
      if (tid < 128) rstd[tid] = rsqrtf((rowss[tid] + rowss[128 + tid]) * (1.f / 128.f) + EPS);
      __syncthreads();
      const u16* KL = (const u16*)(ws + OFF_KVLAT);
      const u16* ka0 = KL + (size_t)(m0 + r0) * 128 + ch;
      const u16* ka1 = ka0 + (size_t)64 * 128;
#pragma unroll 1
      for (int t = 0; t < 4; ++t) {
        const u16* b0 = WukvT + (size_t)(t * 128 + r0) * 128 + ch;
        gemm_tile(lds, ka0, ka1, b0, b0 + (size_t)64 * 128, 2, acc);
        u16* dst = (u16*)(ws + (wc == 0 ? OFF_MLK : OFF_MLV));
#pragma unroll
        for (int m = 0; m < 4; ++m) {
          const int rl = wr * 64 + m * 16 + fr;
          const float rs = rstd[rl];
#pragma unroll
          for (int n = 0; n < 4; ++n) { acc[m][n] = acc[m][n] * rs; st_bf4(dst + (size_t)(m0 + rl) * 256 + t * 64 + n * 16 + fq * 4, acc[m][n]); }
        }
      }
    }
  }
}

DI void p4_outproj(const Params& p, int layer, int nrows, LAS char* lds) {
  char* ws = p.ws;
  unsigned* ctr = (unsigned*)(ws + OFF_CTRL) + CW_CTR + layer * 16 + 4;
  const u16* Y = (const u16*)(ws + OFF_Y);
  const u16* WoT = (const u16*)(ws + OFF_WO) + (size_t)layer * 1024 * 1024;
  const float* MODl = (const float*)(ws + OFF_MOD) + (size_t)layer * 9 * 6144;
  const int tid = threadIdx.x, wid = tid >> 6, wr = wid >> 1, wc = wid & 1;
  const int nunits = (nrows / 128) * 8;
  f32x4 acc[4][4];
  for (;;) {
    const int u = next_unit(ctr, lds);
    if (u >= nunits) break;
    const int tid_o = opaque(tid), lane_o = tid_o & 63;
    const int fr = lane_o & 15, fq = lane_o >> 4, ch = gt_chunk(tid_o), r0 = gt_row0(tid_o);
    const int rt = u >> 3, ct = u & 7, m0 = rt * 128;
    const u16* a0 = Y + (size_t)(m0 + r0) * 1024 + ch;
    const u16* b0 = WoT + (size_t)(ct * 128 + r0) * 1024 + ch;
    gemm_tile(lds, a0, a0 + (size_t)64 * 1024, b0, b0 + (size_t)64 * 1024, 16, acc);
    const int mr = m0 < NL ? m0 / S_ : 8;
    const float* gate = MODl + (size_t)mr * 6144 + 2 * 1024 + ct * 128 + wc * 64 + fq * 4;
#pragma unroll
    for (int m = 0; m < 4; ++m) {
      const int row = m0 + wr * 64 + m * 16 + fr;
      const float* xs = xrow_ptr(p, layer, row) + ct * 128 + wc * 64 + fq * 4;
      float* xd = xrow_out(p, row) + ct * 128 + wc * 64 + fq * 4;
#pragma unroll
      for (int n = 0; n < 4; ++n) {
        const f32x4 g = *(const f32x4*)(gate + n * 16);
        const f32x4 xv = *(const f32x4*)(xs + n * 16);
        *(f32x4*)(xd + n * 16) = xv + g * acc[m][n];
      }
    }
  }
}

DI void p6_gateup(const Params& p, int layer, int nrows, LAS char* lds) {
  char* ws = p.ws;
  unsigned* ctr = (unsigned*)(ws + OFF_CTRL) + CW_CTR + layer * 16 + 6;
  const unsigned* cnt = (const unsigned*)(ws + OFF_CTRL) + CW_CNT + layer * 16;
  const u16* H = (const u16*)(ws + OFF_H);
  const int* list = (const int*)(ws + OFF_LIST);
  const u16* WguT = (const u16*)(ws + OFF_WGU) + (size_t)layer * NE * 1024 * 1024;
  const u16* SguT = (const u16*)(ws + OFF_SGU) + (size_t)layer * 1024 * 1024;
  u16* ACT = (u16*)(ws + OFF_ACT); u16* ACTS = (u16*)(ws + OFF_ACTS);
  const int tid = threadIdx.x, wid = tid >> 6, wr = wid >> 1, wc = wid & 1;
  int tb[NE + 1]; seg_scan(p, layer, tb);
  const int R = tb[NE];
  const int nunits = (R + nrows / 128) * 8;
  f32x4 acc[4][4];
  for (;;) {
    const int u = next_unit(ctr, lds);
    if (u >= nunits) break;
    const int tid_o = opaque(tid), lane_o = tid_o & 63;
    const int fr = lane_o & 15, fq = lane_o >> 4, ch = gt_chunk(tid_o), r0 = gt_row0(tid_o);
    const int rt = u >> 3, ct = u & 7;
    const u16 *a0, *a1, *b0; u16* dst; size_t orow;
    if (rt < R) {
      int e = 0, tbe = 0;
#pragma unroll
      for (int q = 1; q < NE; ++q) if (rt >= tb[q]) { e = q; tbe = tb[q]; }
      const int i = rt - tbe, ce = (int)cnt[e];
      const int i0 = i * 128 + r0, i1 = i0 + 64;
      const int t0 = i0 < ce ? list[(size_t)e * NT + i0] : 0, t1 = i1 < ce ? list[(size_t)e * NT + i1] : 0;
      a0 = H + (size_t)t0 * 1024 + ch; a1 = H + (size_t)t1 * 1024 + ch;
      b0 = WguT + ((size_t)e * 1024 + ct * 128 + r0) * 1024 + ch;
      dst = ACT; orow = (size_t)rt * 128;
    } else {
      const int m0 = (rt - R) * 128;
      a0 = H + (size_t)(m0 + r0) * 1024 + ch; a1 = a0 + (size_t)64 * 1024;
      b0 = SguT + (size_t)(ct * 128 + r0) * 1024 + ch;
      dst = ACTS; orow = (size_t)m0;
    }
    gemm_tile(lds, a0, a1, b0, b0 + (size_t)64 * 1024, 16, acc);
#pragma unroll
    for (int m = 0; m < 4; ++m) {
      u16* o = dst + (orow + wr * 64 + m * 16 + fr) * 512 + ct * 64 + wc * 32 + fq * 4;
#pragma unroll
      for (int n = 0; n < 2; ++n) {
        f32x4 r;
#pragma unroll
        for (int j = 0; j < 4; ++j) r[j] = silu(acc[m][n][j]) * acc[m][n + 2][j];
        st_bf4(o + n * 16, r);
      }
    }
  }
}

DI void p7_down(const Params& p, int layer, int nrows, LAS char* lds) {
  char* ws = p.ws;
  unsigned* ctr = (unsigned*)(ws + OFF_CTRL) + CW_CTR + layer * 16 + 7;
  const u16* WdT = (const u16*)(ws + OFF_WD) + (size_t)layer * NE * 1024 * 512;
  const u16* SdT = (const u16*)(ws + OFF_SD) + (size_t)layer * 1024 * 512;
  const u16* ACT = (const u16*)(ws + OFF_ACT); const u16* ACTS = (const u16*)(ws + OFF_ACTS);
  u16* YEXP = (u16*)(ws + OFF_YEXP); u16* YSH = (u16*)(ws + OFF_YSH);
  const int tid = threadIdx.x, wid = tid >> 6, wr = wid >> 1, wc = wid & 1;
  int tb[NE + 1]; seg_scan(p, layer, tb);
  const int R = tb[NE];
  const int nunits = (R + nrows / 128) * 8;
  f32x4 acc[4][4];
  for (;;) {
    const int u = next_unit(ctr, lds);
    if (u >= nunits) break;
    const int tid_o = opaque(tid), lane_o = tid_o & 63;
    const int fr = lane_o & 15, fq = lane_o >> 4, ch = gt_chunk(tid_o), r0 = gt_row0(tid_o);
    const int rt = u >> 3, ct = u & 7;
    const u16 *a0, *b0; u16* dst; size_t orow;
    if (rt < R) {
      int e = 0;
#pragma unroll
      for (int q = 1; q < NE; ++q) if (rt >= tb[q]) e = q;
      a0 = ACT + ((size_t)rt * 128 + r0) * 512 + ch;
      b0 = WdT + ((size_t)e * 1024 + ct * 128 + r0) * 512 + ch;
      dst = YEXP; orow = (size_t)rt * 128;
    } else {
      const int m0 = (rt - R) * 128;
      a0 = ACTS + (size_t)(m0 + r0) * 512 + ch;
      b0 = SdT + (size_t)(ct * 128 + r0) * 512 + ch;
      dst = YSH; orow = (size_t)m0;
    }
    gemm_tile(lds, a0, a0 + (size_t)64 * 512, b0, b0 + (size_t)64 * 512, 8, acc);
#pragma unroll
    for (int m = 0; m < 4; ++m) {
      u16* o = dst + (orow + wr * 64 + m * 16 + fr) * 1024 + ct * 128 + wc * 64 + fq * 4;
#pragma unroll
      for (int n = 0; n < 4; ++n) st_bf4(o + n * 16, acc[m][n]);
    }
  }
}


typedef float f32x16 __attribute__((ext_vector_type(16)));
typedef short s16x4 __attribute__((ext_vector_type(4)));
DI s16x4 tr_read(const LAS char* a) { return __builtin_bit_cast(s16x4, __builtin_amdgcn_ds_read_tr16_b64_v4i16((LAS s16x4*)a)); }
DI float half_max(float m) { auto rr = __builtin_amdgcn_permlane32_swap(__float_as_uint(m), __float_as_uint(m), false, false); return fmaxf(__uint_as_float(rr[0]), __uint_as_float(rr[1])); }
DI float half_sum(float m) { auto rr = __builtin_amdgcn_permlane32_swap(__float_as_uint(m), __float_as_uint(m), false, false); return __uint_as_float(rr[0]) + __uint_as_float(rr[1]); }
DI bf16x8 pack8(const f32x16& x, int s8) {
  typedef unsigned u32x4 __attribute__((ext_vector_type(4)));
  u32x4 r;
  r[0] = cvtpk(x[s8 + 0], x[s8 + 1]); r[1] = cvtpk(x[s8 + 2], x[s8 + 3]); r[2] = cvtpk(x[s8 + 4], x[s8 + 5]); r[3] = cvtpk(x[s8 + 6], x[s8 + 7]);
  return __builtin_bit_cast(bf16x8, r);
}
constexpr int AT_STAGE = 20480;

template <bool MLA>
DI void attn_unit(const Params& p, int layer, int kind, int isctx, int b, int h, int qb, LAS char* lds) {
  char* ws = p.ws;
  const int tid = opaque((int)threadIdx.x), lane = tid & 63, wid = tid >> 6, r32 = lane & 31, hi = lane >> 5;
  const u16 *Qg, *Kg, *Vg; int ldq, ldk, qoff, koff, ycol; float cs;
  if (MLA) { Qg = (const u16*)(ws + OFF_MLQ); Kg = (const u16*)(ws + OFF_MLK); Vg = (const u16*)(ws + OFF_MLV); ldq = 384; ldk = 256; qoff = h * 96; koff = h * 64; ycol = 768 + h * 64; cs = 0.10206207261596575f * 1.4426950408889634f; }
  else if (kind == 1) { Qg = (const u16*)(ws + OFF_GLQ); Kg = (const u16*)(ws + OFF_GLK); Vg = (const u16*)(ws + OFF_GLV); ldq = 384; ldk = 128; qoff = h * 64; koff = (h / 3) * 64; ycol = 384 + h * 64; cs = 0.125f * 1.4426950408889634f; }
  else { Qg = (const u16*)(ws + OFF_SWQ); Kg = (const u16*)(ws + OFF_SWK); Vg = (const u16*)(ws + OFF_SWV); ldq = 384; ldk = 128; qoff = h * 64; koff = (h / 3) * 64; ycol = h * 64; cs = 0.125f * 1.4426950408889634f; }
  const u16* Rg = (const u16*)(ws + OFF_MLKR);
  const int q0 = qb * 128;
  const int qrow0 = (isctx ? NL + b * C_ : b * S_) + q0;
  const int qw = q0 + wid * 32;
  int lat_first = 0, nlat = 0;
  if (!isctx) { if (kind == 0) { lat_first = 2 * qb - 2; if (lat_first < 0) lat_first = 0; int lat_last = 2 * qb + 3; if (lat_last > 63) lat_last = 63; nlat = lat_last - lat_first + 1; } else nlat = 64; }
  const int T = 4 + nlat;
  constexpr int NQ = MLA ? 6 : 4;
  bf16x8 qf[NQ];
  {
    const u16* qp = Qg + (size_t)(qrow0 + wid * 32 + r32) * ldq + qoff + hi * 8;
#pragma unroll
    for (int d0 = 0; d0 < NQ; ++d0) qf[d0] = *(const bf16x8*)(qp + d0 * 16);
  }
  int kaddr[4];
#pragma unroll
  for (int d0 = 0; d0 < 4; ++d0) kaddr[d0] = r32 * 128 + (((d0 * 2 + hi) ^ ((r32 >> 1) & 7)) * 16);
  int kraddr[2];
#pragma unroll
  for (int e = 0; e < 2; ++e) kraddr[e] = 16384 + r32 * 64 + (((e * 2 + hi) ^ ((r32 >> 3) & 3)) * 16);
  int vbo[2];
  {
    const int i16 = lane & 15, sw = (lane >> 3) & 1;
    const int x = ((lane >> 4) & 1) * 32 + (lane & 3) * 8;
    const int rowpart = ((i16 >> 2) + 4 * hi) * 128;
    vbo[0] = 8192 + rowpart + x + (sw * 64);
    vbo[1] = 8192 + rowpart + x + ((1 - sw) * 64);
  }
  const int skey = tid >> 3;
  const int kch = ((tid & 7) ^ ((tid >> 4) & 7)) * 8;
  const int vch = ((tid & 7) ^ (((tid >> 4) & 1) << 2)) * 8;
  const int rkey = tid >> 2, rch = ((tid & 3) ^ ((tid >> 5) & 3)) * 8;
  LAS char* ldst = lds + tid * 16;
#define AT_ISSUE(j, st) do { const int _j = (j); const int _kr = _j < 4 ? NL + b * C_ + 64 * _j : b * S_ + 64 * (lat_first + _j - 4); \
    LAS char* _d = ldst + (st) * AT_STAGE; \
    const u16* _k = Kg + (size_t)(_kr + skey) * ldk + koff + kch; glds16(_k, _d); glds16(_k + (size_t)32 * ldk, _d + 4096); \
    const u16* _v = Vg + (size_t)(_kr + skey) * ldk + koff + vch; glds16(_v, _d + 8192); glds16(_v + (size_t)32 * ldk, _d + 8192 + 4096); \
    if (MLA) glds16(Rg + (size_t)(_kr + rkey) * 32 + rch, _d + 16384); } while (0)
  float m_run, l_run;
  if (kind == 0) { m_run = p.swa_sink[layer * 6 + h] * 8.0f; l_run = hi == 0 ? 1.f : 0.f; }
  else { m_run = -1e30f; l_run = 0.f; }
  f32x16 o[2];
#pragma unroll
  for (int i = 0; i < 16; ++i) { o[0][i] = 0.f; o[1][i] = 0.f; }
  AT_ISSUE(0, 0);
#pragma unroll 1
  for (int j = 0; j < T; ++j) {
    asm volatile("s_waitcnt vmcnt(0)" ::: "memory");
    __syncthreads();
    if (j + 1 < T) AT_ISSUE(j + 1, (j + 1) & 1);
    const int pos0 = 64 * (lat_first + j - 4);
    bool skip = false, domask = false;
    if (kind == 0 && j >= 4) {
      if (pos0 + 63 < qw - 128 || pos0 > qw + 31 + 128) skip = true;
      else if (qw + 31 - pos0 > 128 || pos0 + 63 - qw > 128) domask = true;
    }
    if (!skip) {
      const LAS char* sb = lds + (j & 1) * AT_STAGE;
      f32x16 p0, p1;
#pragma unroll
      for (int i = 0; i < 16; ++i) { p0[i] = 0.f; p1[i] = 0.f; }
#pragma unroll
      for (int d0 = 0; d0 < 4; ++d0) {
        const bf16x8 k0 = *(const LAS bf16x8*)(sb + kaddr[d0]);
        const bf16x8 k1 = *(const LAS bf16x8*)(sb + kaddr[d0] + 4096);
        p0 = __builtin_amdgcn_mfma_f32_32x32x16_bf16(k0, qf[d0], p0, 0, 0, 0);
        p1 = __builtin_amdgcn_mfma_f32_32x32x16_bf16(k1, qf[d0], p1, 0, 0, 0);
      }
      if (MLA) {
#pragma unroll
        for (int e = 0; e < 2; ++e) {
          const bf16x8 k0 = *(const LAS bf16x8*)(sb + kraddr[e]);
          const bf16x8 k1 = *(const LAS bf16x8*)(sb + kraddr[e] + 2048);
          p0 = __builtin_amdgcn_mfma_f32_32x32x16_bf16(k0, qf[MLA ? 4 + e : 0], p0, 0, 0, 0);
          p1 = __builtin_amdgcn_mfma_f32_32x32x16_bf16(k1, qf[MLA ? 4 + e : 0], p1, 0, 0, 0);
        }
      }
      if (domask) {
        const int dq = qw + r32 - pos0 - 4 * hi + 128;
#pragma unroll
        for (int r = 0; r < 16; ++r) {
          const int cr = (r & 3) + 8 * (r >> 2);
          if ((unsigned)(dq - cr) > 256u) p0[r] = -1e30f;
          if ((unsigned)(dq - cr - 32) > 256u) p1[r] = -1e30f;
        }
      }
      float mx = fmaxf(p0[0], p1[0]);
#pragma unroll
      for (int r = 1; r < 16; ++r) mx = fmaxf(mx, fmaxf(p0[r], p1[r]));
      mx = half_max(mx);
      const float m_new = fmaxf(m_run, mx);
      if (__ballot(m_new > m_run) != 0ull) {
        const float alpha = __builtin_amdgcn_exp2f((m_run - m_new) * cs);
        l_run *= alpha;
#pragma unroll
        for (int i = 0; i < 16; ++i) { o[0][i] *= alpha; o[1][i] *= alpha; }
        m_run = m_new;
      }
      const float nmc = -m_run * cs;
      float ls = 0.f;
#pragma unroll
      for (int r = 0; r < 16; ++r) {
        p0[r] = __builtin_amdgcn_exp2f(__builtin_fmaf(p0[r], cs, nmc));
        p1[r] = __builtin_amdgcn_exp2f(__builtin_fmaf(p1[r], cs, nmc));
        ls += p0[r] + p1[r];
      }
      l_run += ls;
      bf16x8 pa[4];
      pa[0] = pack8(p0, 0); pa[1] = pack8(p0, 8); pa[2] = pack8(p1, 0); pa[3] = pack8(p1, 8);
#pragma unroll
      for (int db = 0; db < 2; ++db) {
#pragma unroll
        for (int ts = 0; ts < 4; ++ts) {
          const LAS char* va = sb + vbo[db] + ts * 2048;
          const s16x4 lo = tr_read(va), hh = tr_read(va + 1024);
          const bf16x8 vf = __builtin_shufflevector(lo, hh, 0, 1, 2, 3, 4, 5, 6, 7);
          o[db] = __builtin_amdgcn_mfma_f32_32x32x16_bf16(vf, pa[ts], o[db], 0, 0, 0);
        }
      }
    }
  }
#undef AT_ISSUE
  const float inv = 1.f / half_sum(l_run);
  u16* yp = (u16*)(ws + OFF_Y) + (size_t)(qrow0 + wid * 32 + r32) * 1024 + ycol + 4 * hi;
#pragma unroll
  for (int db = 0; db < 2; ++db)
#pragma unroll
    for (int g = 0; g < 4; ++g) {
      uint2 w; w.x = cvtpk(o[db][4 * g] * inv, o[db][4 * g + 1] * inv); w.y = cvtpk(o[db][4 * g + 2] * inv, o[db][4 * g + 3] * inv);
      *(uint2*)(yp + db * 32 + 8 * g) = w;
    }
}

DI void p3_attention(const Params& p, int layer, LAS char* lds) {
  unsigned* ctr = (unsigned*)(p.ws + OFF_CTRL) + CW_CTR + layer * 16 + 3;
  const int nunits = 4096 + (layer == 0 ? 256 : 0);
  for (;;) {
    const int u = next_unit(ctr, lds);
    if (u >= nunits) break;
    if (u < 1024) { attn_unit<true>(p, layer, 2, 0, u >> 7, (u >> 5) & 3, u & 31, lds); }
    else if (u < 2560) { const int v = u - 1024; attn_unit<false>(p, layer, 1, 0, v / 192, (v % 192) >> 5, v & 31, lds); }
    else if (u < 4096) { const int v = u - 2560; attn_unit<false>(p, layer, 0, 0, v / 192, (v % 192) >> 5, v & 31, lds); }
    else {
      const int w = u - 4096;
      if (w < 64) attn_unit<true>(p, layer, 2, 1, w >> 3, (w >> 1) & 3, w & 1, lds);
      else if (w < 160) { const int v = w - 64; attn_unit<false>(p, layer, 1, 1, v / 12, (v % 12) >> 1, v & 1, lds); }
      else { const int v = w - 160; attn_unit<false>(p, layer, 0, 1, v / 12, (v % 12) >> 1, v & 1, lds); }
    }
  }
}

struct AttnArgs {
  const u16* Q; const u16* K; const u16* K2; const u16* V; u16* Y; const float* sink;
  int ldq, ldk, ldk2, ldv, ldy, ycol, G, window, q_is_ctx; float scale;
};
static_assert(sizeof(AttnArgs) == 88, "no padding");
template <int DK1, int DK2>
__global__ __launch_bounds__(64) void k_attn(AttnArgs a) {
  const int qt = blockIdx.x * 64 + threadIdx.x, b = blockIdx.y, h = blockIdx.z, kvh = h / a.G;
  const int qrow = a.q_is_ctx ? NL + b * C_ + qt : b * S_ + qt;
  float q[DK1 + DK2];
  {
    const uint4* qp = (const uint4*)(a.Q + (size_t)qrow * a.ldq + h * (DK1 + DK2));
#pragma unroll
    for (int i = 0; i < (DK1 + DK2) / 8; ++i) {
      uint4 u = qp[i];
      q[i * 8 + 0] = bflo(u.x) * a.scale; q[i * 8 + 1] = bfhi(u.x) * a.scale; q[i * 8 + 2] = bflo(u.y) * a.scale; q[i * 8 + 3] = bfhi(u.y) * a.scale;
      q[i * 8 + 4] = bflo(u.z) * a.scale; q[i * 8 + 5] = bfhi(u.z) * a.scale; q[i * 8 + 6] = bflo(u.w) * a.scale; q[i * 8 + 7] = bfhi(u.w) * a.scale;
    }
  }
  float m, l, o[64];
  if (a.sink) { m = a.sink[h]; l = 1.f; } else { m = -1e30f; l = 0.f; }
#pragma unroll
  for (int d = 0; d < 64; ++d) o[d] = 0.f;
  const int nseg = a.q_is_ctx ? 1 : 2;
  for (int seg = 0; seg < nseg; ++seg) {
    int lo, hi, rbase; bool masked = false;
    if (seg == 0) { lo = 0; hi = C_; rbase = NL + b * C_; }
    else {
      lo = 0; hi = S_; rbase = b * S_;
      if (a.window) { int t0 = blockIdx.x * 64; lo = t0 - a.window; if (lo < 0) lo = 0; hi = t0 + 64 + a.window; if (hi > S_) hi = S_; masked = true; }
    }
    for (int s = lo; s < hi; s += 4) {
      float sc[4];
#pragma unroll
      for (int i = 0; i < 4; ++i) {
        const uint4* kp = (const uint4*)(a.K + (size_t)(rbase + s + i) * a.ldk + kvh * DK1);
        float dot = 0.f;
#pragma unroll
        for (int c = 0; c < DK1 / 8; ++c) {
          uint4 u = kp[c];
          dot += q[c * 8 + 0] * bflo(u.x) + q[c * 8 + 1] * bfhi(u.x) + q[c * 8 + 2] * bflo(u.y) + q[c * 8 + 3] * bfhi(u.y)
               + q[c * 8 + 4] * bflo(u.z) + q[c * 8 + 5] * bfhi(u.z) + q[c * 8 + 6] * bflo(u.w) + q[c * 8 + 7] * bfhi(u.w);
        }
        if (DK2 > 0) {
          const uint4* kp2 = (const uint4*)(a.K2 + (size_t)(rbase + s + i) * a.ldk2);
#pragma unroll
          for (int c = 0; c < DK2 / 8; ++c) {
            uint4 u = kp2[c];
            dot += q[DK1 + c * 8 + 0] * bflo(u.x) + q[DK1 + c * 8 + 1] * bfhi(u.x) + q[DK1 + c * 8 + 2] * bflo(u.y) + q[DK1 + c * 8 + 3] * bfhi(u.y)
                 + q[DK1 + c * 8 + 4] * bflo(u.z) + q[DK1 + c * 8 + 5] * bfhi(u.z) + q[DK1 + c * 8 + 6] * bflo(u.w) + q[DK1 + c * 8 + 7] * bfhi(u.w);
          }
        }
        if (masked) { int dlt = qt - (s + i); if (dlt < 0) dlt = -dlt; if (dlt > a.window) dot = -1e30f; }
        sc[i] = dot;
      }
      float mx = fmaxf(fmaxf(fmaxf(sc[0], sc[1]), fmaxf(sc[2], sc[3])), m);
      const float alpha = __expf(m - mx);
      float pr[4];
#pragma unroll
      for (int i = 0; i < 4; ++i) pr[i] = __expf(sc[i] - mx);
      l = l * alpha + (pr[0] + pr[1]) + (pr[2] + pr[3]);
      m = mx;
#pragma unroll
      for (int d = 0; d < 64; ++d) o[d] *= alpha;
#pragma unroll
      for (int i = 0; i < 4; ++i) {
        const uint4* vp = (const uint4*)(a.V + (size_t)(rbase + s + i) * a.ldv + kvh * 64);
#pragma unroll
        for (int c = 0; c < 8; ++c) {
          uint4 u = vp[c];
          o[c * 8 + 0] += pr[i] * bflo(u.x); o[c * 8 + 1] += pr[i] * bfhi(u.x); o[c * 8 + 2] += pr[i] * bflo(u.y); o[c * 8 + 3] += pr[i] * bfhi(u.y);
          o[c * 8 + 4] += pr[i] * bflo(u.z); o[c * 8 + 5] += pr[i] * bfhi(u.z); o[c * 8 + 6] += pr[i] * bflo(u.w); o[c * 8 + 7] += pr[i] * bfhi(u.w);
        }
      }
    }
  }
  const float inv = 1.f / l;
  uint4* yp = (uint4*)(a.Y + (size_t)qrow * a.ldy + a.ycol + h * 64);
#pragma unroll
  for (int c = 0; c < 8; ++c) {
    uint4 u;
    u.x = cvtpk(o[c * 8 + 0] * inv, o[c * 8 + 1] * inv); u.y = cvtpk(o[c * 8 + 2] * inv, o[c * 8 + 3] * inv);
    u.z = cvtpk(o[c * 8 + 4] * inv, o[c * 8 + 5] * inv); u.w = cvtpk(o[c * 8 + 6] * inv, o[c * 8 + 7] * inv);
    yp[c] = u;
  }
}


constexpr int CW_BAR = 1024;
#define XB_TMO      128
#define XB_XCNT(j)  (256  + 64 * (j))
#define XB_XSUB(j)  (1280 + 64 * (j))
#define XB_XGEN(j)  (2304 + 64 * (j))
#define XB_TOP      3328
#define XB_TOPGEN   3392
#define XCD_BAR_WORDS 3456
#define XB_SPIN_CAP (1u << 22)
DI unsigned xb_ld(unsigned* p) { return __hip_atomic_load(p, __ATOMIC_RELAXED, __HIP_MEMORY_SCOPE_AGENT); }
DI unsigned xb_add(unsigned* p, unsigned v) { return __hip_atomic_fetch_add(p, v, __ATOMIC_RELAXED, __HIP_MEMORY_SCOPE_AGENT); }
DI unsigned xb_xcc_id() { return (unsigned)__builtin_amdgcn_s_getreg((3 << 11) | 20) & 0xFu; }
#define XB_SPIN(cond, bar) do { unsigned _sp = 0; while (cond) { __builtin_amdgcn_s_sleep(1); \
    if ((++_sp & 255u) == 0u) { if (xb_ld(&(bar)[XB_TMO])) break; if (_sp > XB_SPIN_CAP) { atomicAdd(&(bar)[XB_TMO], 1u); break; } } } } while (0)
struct XcdBarrier { unsigned* bar; unsigned x; volatile LAS unsigned* st; };
DI XcdBarrier xcd_barrier_post(unsigned* bar, volatile LAS unsigned* st) {
  XcdBarrier b; b.bar = bar; b.x = xb_xcc_id(); b.st = st;
  if (threadIdx.x == 0) (void)xb_add(&bar[XB_XCNT(b.x)], 1u);
  return b;
}
DI void xcd_barrier_complete(unsigned* bar, unsigned x, unsigned& nloc, unsigned& nx) {
  const unsigned G = gridDim.x * gridDim.y * gridDim.z;
  unsigned sum, cnt, mine, sp = 0u;
  for (;;) {
    sum = 0u; cnt = 0u; mine = 0u;
#pragma unroll
    for (unsigned j = 0; j < 16; ++j) { const unsigned c = xb_ld(&bar[XB_XCNT(j)]); sum += c; cnt += (c > 0u) ? 1u : 0u; mine = (j == x) ? c : mine; }
    if (sum == G) break;
    __builtin_amdgcn_s_sleep(1);
    if ((++sp & 255u) == 0u) { if (xb_ld(&bar[XB_TMO])) break; if (sp > XB_SPIN_CAP) { atomicAdd(&bar[XB_TMO], 1u); break; } }
  }
  nloc = mine > 0u ? mine : 1u; nx = cnt > 0u ? cnt : 1u;
}
DI void xcd_barrier(const XcdBarrier& b) {
  asm volatile("s_waitcnt vmcnt(0)" ::: "memory");
  __syncthreads();
  if (threadIdx.x == 0) {
    unsigned* bar = b.bar;
    __builtin_amdgcn_s_waitcnt(0);
    unsigned nloc = b.st[0], nx = b.st[1];
    if (nloc == 0u) { xcd_barrier_complete(bar, b.x, nloc, nx); b.st[0] = nloc; b.st[1] = nx; }
    const unsigned old = xb_add(&bar[XB_XSUB(b.x)], 1u);
    const unsigned gen = old / nloc;
    if (old + 1u == (gen + 1u) * nloc) {
      __builtin_amdgcn_fence(__ATOMIC_RELEASE, "agent");
      asm volatile("s_waitcnt vmcnt(0)" ::: "memory");
      const unsigned og = xb_add(&bar[XB_TOP], 1u);
      const unsigned tg = og / nx;
      if (og + 1u == (tg + 1u) * nx) xb_add(&bar[XB_TOPGEN], 1u);
      else XB_SPIN(xb_ld(&bar[XB_TOPGEN]) == tg, bar);
      __builtin_amdgcn_fence(__ATOMIC_ACQUIRE, "agent");
      xb_add(&bar[XB_XGEN(b.x)], 1u);
      asm volatile("s_waitcnt vmcnt(0)" ::: "memory");
    } else {
      XB_SPIN(xb_ld(&bar[XB_XGEN(b.x)]) == gen, bar);
      __builtin_amdgcn_fence(__ATOMIC_ACQUIRE, "agent");
      asm volatile("s_waitcnt vmcnt(0)" ::: "memory");
    }
  }
  __syncthreads();
}

__global__ __launch_bounds__(NTHR, 2) void k_mega(Params p) {
  extern __shared__ __attribute__((aligned(16))) unsigned char smem[];
  LAS char* lds = (LAS char*)smem;
  if (p.never) cooperative_groups::this_grid().sync();
  volatile LAS unsigned* st = (volatile LAS unsigned*)(lds + LDS_MISC + 3584);
  if (threadIdx.x < 4) st[threadIdx.x] = 0u;
  __syncthreads();
  XcdBarrier bar = xcd_barrier_post((unsigned*)(p.ws + OFF_CTRL) + CW_BAR, st);
  p0_prologue(p, lds);
  xcd_barrier(bar);
  p1_norm_mix(p, 0);
  xcd_barrier(bar);
#pragma unroll 1
  for (int l = 0; l < 2; ++l) {
    const int nrows = l == 0 ? NT : NL;
    p2_inproj(p, l, lds);
    xcd_barrier(bar);
    p3_attention(p, l, lds);
    xcd_barrier(bar);
    p4_outproj(p, l, nrows, lds);
    xcd_barrier(bar);
    p5_norm_ffn(p, l, nrows, lds);
    xcd_barrier(bar);
    p6_gateup(p, l, nrows, lds);
    xcd_barrier(bar);
    p7_down(p, l, nrows, lds);
    xcd_barrier(bar);
    p8_combine(p, l, nrows);
    if (l == 0) xcd_barrier(bar);
  }
}

template <int PH>
__global__ __launch_bounds__(NTHR, 2) void k_phase(Params p, int layer, int nrows) {
  extern __shared__ __attribute__((aligned(16))) unsigned char smem[];
  LAS char* lds = (LAS char*)smem;
  if (PH == 0) p0_prologue(p, lds);
  if (PH == 1) p1_norm_mix(p, layer);
  if (PH == 2) p2_inproj(p, layer, lds);
  if (PH == 3) p3_attention(p, layer, lds);
  if (PH == 4) p4_outproj(p, layer, nrows, lds);
  if (PH == 5) p5_norm_ffn(p, layer, nrows, lds);
  if (PH == 6) p6_gateup(p, layer, nrows, lds);
  if (PH == 7) p7_down(p, layer, nrows, lds);
  if (PH == 8) p8_combine(p, layer, nrows);
}

extern "C" void kernel_launch(void* const* d_in, const int* in_sizes, int n_in, void* d_out, int out_size, void* d_ws, size_t ws_size, hipStream_t stream) {
  Params p{};
  p.x = (const float*)d_in[0]; p.c = (const float*)d_in[1]; p.ctx = (const float*)d_in[2]; p.c_ctx = (const float*)d_in[3];
  p.w_mod = (const float*)d_in[4]; p.b_mod = (const float*)d_in[5]; p.norm_mix_g = (const float*)d_in[6]; p.norm_ffn_g = (const float*)d_in[7];
  p.w_in = (const float*)d_in[8]; p.w_out = (const float*)d_in[9]; p.swa_sink = (const float*)d_in[10]; p.glb_q_gain = (const float*)d_in[11];
  p.glb_k_gain = (const float*)d_in[12]; p.mla_q_gain = (const float*)d_in[13]; p.mla_w_uq = (const float*)d_in[14]; p.mla_kv_gain = (const float*)d_in[15];
  p.mla_w_ukv = (const float*)d_in[16]; p.router_w = (const float*)d_in[17]; p.router_bias = (const float*)d_in[18]; p.exp_w_gate = (const float*)d_in[19];
  p.exp_w_up = (const float*)d_in[20]; p.exp_w_down = (const float*)d_in[21]; p.shr_w_gate = (const float*)d_in[22]; p.shr_w_up = (const float*)d_in[23];
  p.shr_w_down = (const float*)d_in[24]; p.final_norm_g = (const float*)d_in[25];
  p.out = (float*)d_out; p.ws = (char*)d_ws;
  char* ws = (char*)d_ws;

#ifndef MEGA
#define MEGA 1
#endif
#if MEGA
  static int grid_blocks = 0;
  if (!grid_blocks) {
    (void)hipFuncSetAttribute((const void*)k_mega, hipFuncAttributeMaxDynamicSharedMemorySize, LDS_BYTES);
    int dev = 0, cus = 0, per_cu = 0;
    (void)hipGetDevice(&dev);
    (void)hipDeviceGetAttribute(&cus, hipDeviceAttributeMultiprocessorCount, dev);
    (void)hipOccupancyMaxActiveBlocksPerMultiprocessor(&per_cu, (const void*)k_mega, NTHR, LDS_BYTES);
    if (per_cu > 2) per_cu = 2;
    if (per_cu < 1) per_cu = 1;
    grid_blocks = cus * per_cu;
  }
  (void)hipMemsetAsync(ws + OFF_CTRL, 0, CTRL_BYTES, stream);
  void* args[] = {&p};
  hipError_t e = hipLaunchCooperativeKernel((const void*)k_mega, dim3(grid_blocks), dim3(NTHR), args, LDS_BYTES, stream);
  if (e != hipSuccess) fprintf(stderr, "cooperative launch failed: %s (grid %d)\n", hipGetErrorString(e), grid_blocks);
#else
  static bool attr_done = false;
  if (!attr_done) {
    (void)hipFuncSetAttribute((const void*)k_phase<0>, hipFuncAttributeMaxDynamicSharedMemorySize, LDS_BYTES);
    (void)hipFuncSetAttribute((const void*)k_phase<1>, hipFuncAttributeMaxDynamicSharedMemorySize, LDS_BYTES);
    (void)hipFuncSetAttribute((const void*)k_phase<2>, hipFuncAttributeMaxDynamicSharedMemorySize, LDS_BYTES);
    (void)hipFuncSetAttribute((const void*)k_phase<3>, hipFuncAttributeMaxDynamicSharedMemorySize, LDS_BYTES);
    (void)hipFuncSetAttribute((const void*)k_phase<4>, hipFuncAttributeMaxDynamicSharedMemorySize, LDS_BYTES);
    (void)hipFuncSetAttribute((const void*)k_phase<5>, hipFuncAttributeMaxDynamicSharedMemorySize, LDS_BYTES);
    (void)hipFuncSetAttribute((const void*)k_phase<6>, hipFuncAttributeMaxDynamicSharedMemorySize, LDS_BYTES);
    (void)hipFuncSetAttribute((const void*)k_phase<7>, hipFuncAttributeMaxDynamicSharedMemorySize, LDS_BYTES);
    (void)hipFuncSetAttribute((const void*)k_phase<8>, hipFuncAttributeMaxDynamicSharedMemorySize, LDS_BYTES);
    attr_done = true;
  }

  (void)hipMemsetAsync(ws + OFF_CTRL, 0, CTRL_BYTES, stream);
  k_phase<0><<<GRID, NTHR, LDS_BYTES, stream>>>(p, 0, 0);
  k_phase<1><<<GRID, NTHR, LDS_BYTES, stream>>>(p, 0, NT);
  for (int l = 0; l < 2; ++l) {
    const bool last = (l == 1);
    const int Mres = last ? NL : NT;
    k_phase<2><<<GRID, NTHR, LDS_BYTES, stream>>>(p, l, NT);
    k_phase<3><<<GRID, NTHR, LDS_BYTES, stream>>>(p, l, NT);
    k_phase<4><<<GRID, NTHR, LDS_BYTES, stream>>>(p, l, Mres);
    k_phase<5><<<GRID, NTHR, LDS_BYTES, stream>>>(p, l, Mres);
    k_phase<6><<<GRID, NTHR, LDS_BYTES, stream>>>(p, l, Mres);
    k_phase<7><<<GRID, NTHR, LDS_BYTES, stream>>>(p, l, Mres);
    k_phase<8><<<GRID, NTHR, LDS_BYTES, stream>>>(p, l, Mres);
  }
#endif
}
```

```cpp
#include <hip/hip_runtime.h>
#include <hip/hip_cooperative_groups.h>
#include <cstdio>
#include <stdint.h>
#include <stddef.h>

typedef unsigned short u16;
typedef short bf16x8 __attribute__((ext_vector_type(8)));
typedef float f32x4 __attribute__((ext_vector_type(4)));
typedef float f32x2_t __attribute__((ext_vector_type(2)));
typedef __bf16 bf16x2_t __attribute__((ext_vector_type(2)));
typedef unsigned u32x2_t __attribute__((ext_vector_type(2)));
typedef unsigned u32x4_t __attribute__((ext_vector_type(4)));
#define DI __device__ __forceinline__
#define LAS __attribute__((address_space(3)))

constexpr int B_ = 8, S_ = 4096, D_ = 1024, C_ = 256;
constexpr int NL = B_ * S_, NC = B_ * C_, NT = NL + NC;
constexpr int INW = 1696, INWP = 1792;
constexpr int NE = 16;
constexpr int MAXSLOT = NT * 2 + NE * 128;
constexpr float EPS = 1e-6f;
constexpr int NTHR = 256;
constexpr int GRID = 512;

DI float bf2f(u16 v) { return __uint_as_float(((unsigned)v) << 16); }
DI float bflo(unsigned u) { return __uint_as_float(u << 16); }
DI float bfhi(unsigned u) { return __uint_as_float(u & 0xffff0000u); }
DI unsigned cvtpk(float lo, float hi) { f32x2_t v = {lo, hi}; bf16x2_t b = __builtin_convertvector(v, bf16x2_t); return __builtin_bit_cast(unsigned, b); }
template <int CTRL> DI float dpp_mov(float v) { return __int_as_float(__builtin_amdgcn_update_dpp(0, __float_as_int(v), CTRL, 0xf, 0xf, false)); }
DI float wave_sum(float v) {
  v += dpp_mov<0xB1>(v);
  v += dpp_mov<0x4E>(v);
  v += dpp_mov<0x141>(v);
  v += dpp_mov<0x140>(v);
  { auto rr = __builtin_amdgcn_permlane16_swap(__float_as_uint(v), __float_as_uint(v), false, false); v = __uint_as_float(rr[0]) + __uint_as_float(rr[1]); }
  { auto rr = __builtin_amdgcn_permlane32_swap(__float_as_uint(v), __float_as_uint(v), false, false); v = __uint_as_float(rr[0]) + __uint_as_float(rr[1]); }
  return v;
}
DI float silu(float g) { return g / (1.f + __expf(-g)); }
DI int opaque(int v) { asm volatile("" : "+v"(v)); return v; }

constexpr size_t al256(size_t x) { return (x + 255) & ~(size_t)255; }
constexpr size_t OFF_CTRL = 0;
constexpr size_t CTRL_BYTES = 65536;
constexpr size_t OFF_CTXR = OFF_CTRL + CTRL_BYTES;
constexpr size_t OFF_MOD = OFF_CTXR + al256((size_t)NC * D_ * 4);
constexpr size_t OFF_TOKE = OFF_MOD + al256((size_t)2 * 9 * 6144 * 4);
constexpr size_t OFF_TOKW = OFF_TOKE + al256((size_t)NT * 2 * 4);
constexpr size_t OFF_TOKP = OFF_TOKW + al256((size_t)NT * 2 * 4);
constexpr size_t OFF_LIST = OFF_TOKP + al256((size_t)NT * 2 * 4);
constexpr size_t OFF_WIN = OFF_LIST + al256((size_t)NE * NT * 4);
constexpr size_t OFF_WO = OFF_WIN + (size_t)2 * INWP * 1024 * 2;
constexpr size_t OFF_WUQ = OFF_WO + (size_t)2 * 1024 * 1024 * 2;
constexpr size_t OFF_WUKV = OFF_WUQ + (size_t)2 * 384 * 256 * 2;
constexpr size_t OFF_WGU = OFF_WUKV + (size_t)2 * 512 * 128 * 2;
constexpr size_t OFF_WD = OFF_WGU + (size_t)2 * 16 * 1024 * 1024 * 2;
constexpr size_t OFF_SGU = OFF_WD + (size_t)2 * 16 * 1024 * 512 * 2;
constexpr size_t OFF_SD = OFF_SGU + (size_t)2 * 1024 * 1024 * 2;
constexpr size_t OFF_H = OFF_SD + (size_t)2 * 1024 * 512 * 2;
constexpr size_t OFF_BIG = OFF_H + (size_t)NT * 1024 * 2;
constexpr size_t OFF_SWQ = OFF_BIG;
constexpr size_t OFF_SWK = OFF_SWQ + (size_t)NT * 384 * 2;
constexpr size_t OFF_SWV = OFF_SWK + (size_t)NT * 128 * 2;
constexpr size_t OFF_GLQ = OFF_SWV + (size_t)NT * 128 * 2;
constexpr size_t OFF_GLK = OFF_GLQ + (size_t)NT * 384 * 2;
constexpr size_t OFF_GLV = OFF_GLK + (size_t)NT * 128 * 2;
constexpr size_t OFF_MLQ = OFF_GLV + (size_t)NT * 128 * 2;
constexpr size_t OFF_MLK = OFF_MLQ + (size_t)NT * 384 * 2;
constexpr size_t OFF_MLKR = OFF_MLK + (size_t)NT * 256 * 2;
constexpr size_t OFF_MLV = OFF_MLKR + (size_t)NT * 32 * 2;
constexpr size_t OFF_QLAT = OFF_MLV + (size_t)NT * 256 * 2;
constexpr size_t OFF_KVLAT = OFF_QLAT + (size_t)NT * 256 * 2;
constexpr size_t OFF_Y = OFF_KVLAT + (size_t)NT * 128 * 2;
constexpr size_t END_A = OFF_Y + (size_t)NT * 1024 * 2;
constexpr size_t OFF_ACT = OFF_BIG;
constexpr size_t OFF_ACTS = OFF_ACT + (size_t)MAXSLOT * 512 * 2;
constexpr size_t OFF_YEXP = OFF_ACTS + (size_t)NT * 512 * 2;
constexpr size_t END_B = OFF_YEXP + (size_t)MAXSLOT * 1024 * 2;
constexpr size_t OFF_YSH = OFF_H;
constexpr size_t OFF_DELTA = OFF_SWQ;
static_assert(OFF_DELTA + (size_t)NT * 1024 * 2 <= OFF_MLQ, "DELTA must fit below MLQ");
constexpr size_t WS_NEED = END_A > END_B ? END_A : END_B;
static_assert(WS_NEED <= (size_t)536870912, "workspace too large");

constexpr int CW_CTR = 0;
constexpr int CW_CNT = 8192;
constexpr int CW_Q = 10240;

struct Params {
  const float *x, *c, *ctx, *c_ctx, *w_mod, *b_mod, *norm_mix_g, *norm_ffn_g, *w_in, *w_out, *swa_sink, *glb_q_gain, *glb_k_gain,
      *mla_q_gain, *mla_w_uq, *mla_kv_gain, *mla_w_ukv, *router_w, *router_bias, *exp_w_gate, *exp_w_up, *exp_w_down, *shr_w_gate,
      *shr_w_up, *shr_w_down, *final_norm_g;
  float* out;
  char* ws;
  int never; int pad;
};

constexpr int LDS_MISC = 65536;
constexpr int LDS_BYTES = 65536 + 8192;

DI int next_unit(unsigned* ctr, LAS char* lds) {
  volatile LAS int* slot = (volatile LAS int*)(lds + LDS_MISC + 2560);
  __syncthreads();
  if (threadIdx.x == 0) *slot = (int)atomicAdd(ctr, 1u);
  __syncthreads();
  return *slot;
}

DI unsigned xcc_id_() { return (unsigned)__builtin_amdgcn_s_getreg((3 << 11) | 20) & 0x7u; }
DI int next_unit_xcd(unsigned* ctr8, int per_queue, LAS char* lds) {
  volatile LAS int* slot = (volatile LAS int*)(lds + LDS_MISC + 2560);
  __syncthreads();
  if (threadIdx.x == 0) {
    const int q0 = (int)xcc_id_();
    int res = -1;
    for (int i = 0; i < 8; ++i) {
      const int q = (q0 + i) & 7;
      const int v = (int)atomicAdd(&ctr8[q * 64], 1u);
      if (v < per_queue) { res = q * per_queue + v; break; }
    }
    *slot = res;
  }
  __syncthreads();
  return *slot;
}
DI void cvt_job(const float* __restrict__ src, int ld, int N, int k0, int n0, u16* __restrict__ dst, int K, int mode  , LAS char* lds) {
  LAS float* T = (LAS float*)lds;
  const int tid = threadIdx.x;
  __syncthreads();
  {
    const int kk = tid >> 2, nq = (tid & 3) * 32;
    const float* s = src + (size_t)(k0 + kk) * ld + n0 + nq;
#pragma unroll
    for (int i = 0; i < 8; ++i) {
      float4 v = make_float4(0.f, 0.f, 0.f, 0.f);
      if (n0 + nq + i * 4 < N) v = *(const float4*)(s + i * 4);
      LAS float* t = T + kk * 129 + nq + i * 4;
      t[0] = v.x; t[1] = v.y; t[2] = v.z; t[3] = v.w;
    }
  }
  __syncthreads();
#pragma unroll
  for (int i = 0; i < 4; ++i) {
    const int chn = tid + i * 256;
    const int n = chn >> 3, kc = (chn & 7) * 8;
    if (n0 + n < N) {
      const LAS float* t = T + kc * 129 + n;
      uint4 o;
      o.x = cvtpk(t[0], t[129]); o.y = cvtpk(t[2 * 129], t[3 * 129]); o.z = cvtpk(t[4 * 129], t[5 * 129]); o.w = cvtpk(t[6 * 129], t[7 * 129]);
      const int gn = n0 + n;
      int drow = gn;
      if (mode) drow = (gn >> 5) * 64 + (gn & 31) + (mode == 2 ? 32 : 0);
      *(uint4*)(dst + (size_t)drow * K + k0 + kc) = o;
    }
  }
}

DI void mod_job(const Params& p, int l, int j0, LAS char* lds) {
  LAS float* sc = (LAS float*)lds;
  LAS float* red = (LAS float*)(lds + 36864);
  const int tid = threadIdx.x;
  __syncthreads();
  for (int i = tid; i < 9 * 1024; i += NTHR) {
    int r = i >> 10, k = i & 1023;
    float v = r < 8 ? p.c[r * 1024 + k] : p.c_ctx[k];
    sc[i] = v / (1.f + __expf(-v));
  }
  __syncthreads();
  const int col = tid & 31, kg = tid >> 5;
  float acc[9];
#pragma unroll
  for (int r = 0; r < 9; ++r) acc[r] = 0.f;
  const float* w = p.w_mod + (size_t)l * 1024 * 6144 + (size_t)(kg * 128) * 6144 + j0 + col;
#pragma unroll 1
  for (int k0 = 0; k0 < 128; k0 += 16) {
    float wv[16];
#pragma unroll
    for (int u = 0; u < 16; ++u) wv[u] = w[(size_t)(k0 + u) * 6144];
#pragma unroll
    for (int u = 0; u < 16; ++u)
#pragma unroll
      for (int r = 0; r < 9; ++r) acc[r] += sc[r * 1024 + kg * 128 + k0 + u] * wv[u];
  }
#pragma unroll
  for (int r = 0; r < 9; ++r) red[(kg * 9 + r) * 32 + col] = acc[r];
  __syncthreads();
  float* MOD = (float*)(p.ws + OFF_MOD);
  for (int i = tid; i < 9 * 32; i += NTHR) {
    int r = i >> 5, cc = i & 31;
    float sum = 0.f;
#pragma unroll
    for (int g = 0; g < 8; ++g) sum += red[(g * 9 + r) * 32 + cc];
    MOD[(size_t)(l * 9 + r) * 6144 + j0 + cc] = sum + p.b_mod[l * 6144 + j0 + cc];
  }
}

constexpr int J_WIN = 16 * 14, J_WO = 16 * 8, J_UQ = 4 * 3, J_UKV = 2 * 4, J_EG = 16 * 4, J_ED = 8 * 8;
constexpr int J_DENSE = J_WIN + J_WO + J_UQ + J_UKV;
constexpr int J_EXP = 16 * (2 * J_EG + J_ED);
constexpr int J_SHR = 2 * J_EG + J_ED;
constexpr int J_LAYER = J_DENSE + J_EXP + J_SHR;
constexpr int J_MOD = 2 * 192;
constexpr int J_TOTAL = 2 * J_LAYER + J_MOD;

DI void p0_prologue(const Params& p, LAS char* lds) {
  char* ws = p.ws;
  for (int job = blockIdx.x; job < J_TOTAL; job += gridDim.x) {
    if (job < J_MOD) { mod_job(p, job / 192, (job % 192) * 32, lds); continue; }
    int r = job - J_MOD;
    const int l = r / J_LAYER; r -= l * J_LAYER;
    if (r < J_WIN) { cvt_job(p.w_in + (size_t)l * 1024 * INW, INW, INW, (r / 14) * 64, (r % 14) * 128, (u16*)(ws + OFF_WIN) + (size_t)l * INWP * 1024, 1024, 0, lds); continue; } r -= J_WIN;
    if (r < J_WO) { cvt_job(p.w_out + (size_t)l * 1024 * 1024, 1024, 1024, (r / 8) * 64, (r % 8) * 128, (u16*)(ws + OFF_WO) + (size_t)l * 1024 * 1024, 1024, 0, lds); continue; } r -= J_WO;
    if (r < J_UQ) { cvt_job(p.mla_w_uq + (size_t)l * 256 * 384, 384, 384, (r / 3) * 64, (r % 3) * 128, (u16*)(ws + OFF_WUQ) + (size_t)l * 384 * 256, 256, 0, lds); continue; } r -= J_UQ;
    if (r < J_UKV) { cvt_job(p.mla_w_ukv + (size_t)l * 128 * 512, 512, 512, (r / 4) * 64, (r % 4) * 128, (u16*)(ws + OFF_WUKV) + (size_t)l * 512 * 128, 128, 0, lds); continue; } r -= J_UKV;
    if (r < J_EXP) {
      const int e = r / (2 * J_EG + J_ED); int q = r % (2 * J_EG + J_ED);
      const size_t le = (size_t)l * NE + e;
      if (q < J_EG) { cvt_job(p.exp_w_gate + le * 1024 * 512, 512, 512, (q / 4) * 64, (q % 4) * 128, (u16*)(ws + OFF_WGU) + le * 1024 * 1024, 1024, 1, lds); continue; } q -= J_EG;
      if (q < J_EG) { cvt_job(p.exp_w_up + le * 1024 * 512, 512, 512, (q / 4) * 64, (q % 4) * 128, (u16*)(ws + OFF_WGU) + le * 1024 * 1024, 1024, 2, lds); continue; } q -= J_EG;
      cvt_job(p.exp_w_down + le * 512 * 1024, 1024, 1024, (q / 8) * 64, (q % 8) * 128, (u16*)(ws + OFF_WD) + le * 1024 * 512, 512, 0, lds); continue;
    }
    r -= J_EXP;
    if (r < J_EG) { cvt_job(p.shr_w_gate + (size_t)l * 1024 * 512, 512, 512, (r / 4) * 64, (r % 4) * 128, (u16*)(ws + OFF_SGU) + (size_t)l * 1024 * 1024, 1024, 1, lds); continue; } r -= J_EG;
    if (r < J_EG) { cvt_job(p.shr_w_up + (size_t)l * 1024 * 512, 512, 512, (r / 4) * 64, (r % 4) * 128, (u16*)(ws + OFF_SGU) + (size_t)l * 1024 * 1024, 1024, 2, lds); continue; } r -= J_EG;
    cvt_job(p.shr_w_down + (size_t)l * 512 * 1024, 1024, 1024, (r / 8) * 64, (r % 8) * 128, (u16*)(ws + OFF_SD) + (size_t)l * 1024 * 512, 512, 0, lds);
  }
}

DI const float* xrow_ptr(const Params& p, int layer_src  , int row) {
  if (layer_src == 0) return row < NL ? p.x + (size_t)row * 1024 : p.ctx + (size_t)(row - NL) * 1024;
  return row < NL ? p.out + (size_t)row * 1024 : (const float*)(p.ws + OFF_CTXR) + (size_t)(row - NL) * 1024;
}
DI float* xrow_out(const Params& p, int row) {
  return row < NL ? p.out + (size_t)row * 1024 : (float*)(p.ws + OFF_CTXR) + (size_t)(row - NL) * 1024;
}

DI void norm_mod_row(f32x4 (&v)[4], const float* __restrict__ g, const float* __restrict__ md  , int lane) {
  float ss = 0.f;
#pragma unroll
  for (int i = 0; i < 4; ++i) ss += v[i].x * v[i].x + v[i].y * v[i].y + v[i].z * v[i].z + v[i].w * v[i].w;
  ss = wave_sum(ss);
  const float rstd = rsqrtf(ss * (1.f / 1024.f) + EPS);
#pragma unroll
  for (int i = 0; i < 4; ++i) {
    const f32x4 gg = *(const f32x4*)(g + lane * 4 + i * 256);
    const f32x4 sh = *(const f32x4*)(md + lane * 4 + i * 256);
    const f32x4 sc = *(const f32x4*)(md + 1024 + lane * 4 + i * 256);
    v[i] = v[i] * rstd * gg * (sc + 1.f) + sh;
  }
}
DI void store_h_row(const f32x4 (&v)[4], u16* __restrict__ hrow, int lane) {
#pragma unroll
  for (int i = 0; i < 4; ++i) {
    uint2 o; o.x = cvtpk(v[i].x, v[i].y); o.y = cvtpk(v[i].z, v[i].w);
    *(uint2*)(hrow + lane * 4 + i * 256) = o;
  }
}

DI void p1_norm_mix(const Params& p, int layer) {
  const int tid_ = opaque((int)threadIdx.x); const int lane = tid_ & 63, gw = blockIdx.x * 4 + (tid_ >> 6), ngw = gridDim.x * 4;
  const float* MODl = (const float*)(p.ws + OFF_MOD) + (size_t)layer * 9 * 6144;
  u16* H = (u16*)(p.ws + OFF_H);
  f32x4 vn[4];
  int row = gw;
  if (row < NT) { const float* xr = xrow_ptr(p, layer, row);
#pragma unroll
    for (int i = 0; i < 4; ++i) vn[i] = __builtin_nontemporal_load((const f32x4*)(xr + lane * 4 + i * 256)); }
  while (row < NT) {
    f32x4 v[4];
#pragma unroll
    for (int i = 0; i < 4; ++i) v[i] = vn[i];
    const int rown = row + ngw;
    if (rown < NT) { const float* xr = xrow_ptr(p, layer, rown);
#pragma unroll
      for (int i = 0; i < 4; ++i) vn[i] = __builtin_nontemporal_load((const f32x4*)(xr + lane * 4 + i * 256)); }
    const int mr = row < NL ? row / S_ : 8;
    norm_mod_row(v, p.norm_mix_g + layer * 1024, MODl + (size_t)mr * 6144, lane);
    store_h_row(v, H + (size_t)row * 1024, lane);
    row = rown;
  }
}

DI float max2nd4(float a, float b, float c, float d, float& m1) {
  const float ab = fmaxf(a, b), cd = fmaxf(c, d);
  m1 = fmaxf(ab, cd);
  return fmaxf(fmaxf(fminf(a, b), fminf(c, d)), fminf(ab, cd));
}
template <int CTRL> DI float dppz(float v) { return __int_as_float(__builtin_amdgcn_update_dpp(0, __float_as_int(v), CTRL, 0xf, 0xf, true)); }
DI float lane_xor4(float v, bool b2) { const float a = dppz<0x114>(v), b = dppz<0x104>(v); return b2 ? a : b; }
DI float lane_xor8(float v, bool b3) { const float a = dppz<0x118>(v), b = dppz<0x108>(v); return b3 ? a : b; }
DI bool beats(float a, int ia, float b, int ib) { return a > b || (a == b && ia < ib); }
DI void route_row(float bias_lane, const f32x4 (&v)[4], LAS char* lds, int lane, int& i0, int& i1, float& w0, float& w1) {
  const LAS f32x4* R = (const LAS f32x4*)lds;
  f32x4 pl4[4];
#pragma unroll
  for (int q = 0; q < 4; ++q) pl4[q] = (f32x4){0.f, 0.f, 0.f, 0.f};
#pragma unroll
  for (int i = 0; i < 4; ++i) {
    const int kq = i * 64 + lane;
    f32x4 wq[16];
#pragma unroll
    for (int j = 0; j < 16; ++j) wq[j] = R[j * 256 + kq];
    __builtin_amdgcn_sched_barrier(0);
#pragma unroll
    for (int kk = 0; kk < 4; ++kk) {
      const float hv = v[i][kk];
      const f32x4 hv4 = (f32x4){hv, hv, hv, hv};
#pragma unroll
      for (int q = 0; q < 4; ++q) pl4[q] = __builtin_elementwise_fma(hv4, wq[kk * 4 + q], pl4[q]);
    }
    __builtin_amdgcn_sched_barrier(0);
  }
  float pl[16];
#pragma unroll
  for (int q = 0; q < 4; ++q) { pl[q * 4 + 0] = pl4[q][0]; pl[q * 4 + 1] = pl4[q][1]; pl[q * 4 + 2] = pl4[q][2]; pl[q * 4 + 3] = pl4[q][3]; }
  const bool b0 = (lane & 1) != 0, b1 = (lane & 2) != 0, b2 = (lane & 4) != 0, b3 = (lane & 8) != 0;
  float r8[8], r4[4], r2[2];
#pragma unroll
  for (int i = 0; i < 8; ++i) { const float keep = b0 ? pl[i + 8] : pl[i], send = b0 ? pl[i] : pl[i + 8]; r8[i] = keep + dppz<0xB1>(send); }
#pragma unroll
  for (int i = 0; i < 4; ++i) { const float keep = b1 ? r8[i + 4] : r8[i], send = b1 ? r8[i] : r8[i + 4]; r4[i] = keep + dppz<0x4E>(send); }
#pragma unroll
  for (int i = 0; i < 2; ++i) { const float keep = b2 ? r4[i + 2] : r4[i], send = b2 ? r4[i] : r4[i + 2]; r2[i] = keep + lane_xor4(send, b2); }
  float lg;
  { const float keep = b3 ? r2[1] : r2[0], send = b3 ? r2[0] : r2[1]; lg = keep + lane_xor8(send, b3); }
  { auto rr = __builtin_amdgcn_permlane16_swap(__float_as_uint(lg), __float_as_uint(lg), false, false); lg = __uint_as_float(rr[0]) + __uint_as_float(rr[1]); }
  { auto rr = __builtin_amdgcn_permlane32_swap(__float_as_uint(lg), __float_as_uint(lg), false, false); lg = __uint_as_float(rr[0]) + __uint_as_float(rr[1]); }
  const float sg = __builtin_amdgcn_rcpf(1.f + __builtin_amdgcn_exp2f(-1.4426950408889634f * lg));
  const float bv = sg + bias_lane;
  const float m1v = lane_xor4(bv, b2), m2v = lane_xor8(bv, b3), m3v = lane_xor8(m1v, b3);
  float mtop; const float m2nd = max2nd4(bv, m1v, m2v, m3v, mtop);
  const float gs = mtop + m2nd;
  const float gA = dppz<0xB1>(gs), gB = dppz<0x4E>(gs), gC = dppz<0x1B>(gs);
  const int g = (b0 ? 2 : 0) + (b1 ? 1 : 0);
  const bool win = beats(gs, g, gA, g ^ 2) && beats(gs, g, gB, g ^ 1) && beats(gs, g, gC, g ^ 3);
  const int el = (b2 ? 2 : 0) + (b3 ? 1 : 0);
  const int rank = (beats(m1v, el ^ 2, bv, el) ? 1 : 0) + (beats(m2v, el ^ 1, bv, el) ? 1 : 0) + (beats(m3v, el ^ 3, bv, el) ? 1 : 0);
  const unsigned long long k0 = __ballot(win && rank == 0), k1 = __ballot(win && rank == 1);
  const int L0 = __builtin_ctzll(k0 | (1ull << 63)), L1 = __builtin_ctzll(k1 | (1ull << 63));
  const float s0 = __int_as_float(__builtin_amdgcn_readlane(__float_as_int(sg), L0));
  const float s1 = __int_as_float(__builtin_amdgcn_readlane(__float_as_int(sg), L1));
  i0 = 8 * (L0 & 1) + 4 * ((L0 >> 1) & 1) + 2 * ((L0 >> 2) & 1) + ((L0 >> 3) & 1);
  i1 = 8 * (L1 & 1) + 4 * ((L1 >> 1) & 1) + 2 * ((L1 >> 2) & 1) + ((L1 >> 3) & 1);
  const float inv = 1.f / (s0 + s1);
  w0 = s0 * inv; w1 = s1 * inv;
}

DI void load_router_lds(const Params& p, LAS char* lds) {
  LAS f32x4* R = (LAS f32x4*)lds;
  __syncthreads();
  for (int g = threadIdx.x; g < 4096; g += NTHR) {
    const int k = g >> 2, q = g & 3;
    R[((k & 3) * 4 + q) * 256 + (k >> 2)] = *(const f32x4*)(p.router_w + (size_t)g * 4);
  }
  __syncthreads();
}

constexpr int CNT_STRIDE = 64;
DI void p5_norm_ffn(const Params& p, int layer, int nrows, LAS char* lds) {
  load_router_lds(p, lds);
  const int tid = opaque((int)threadIdx.x), lane = tid & 63, wid = tid >> 6, gw = blockIdx.x * 4 + wid, ngw = gridDim.x * 4;
  const float* MODl = (const float*)(p.ws + OFF_MOD) + (size_t)layer * 9 * 6144;
  u16* H = (u16*)(p.ws + OFF_H);
  volatile LAS int* lcnt = (volatile LAS int*)(lds + LDS_MISC + 3072);
  volatile LAS int* lbase = lcnt + 16;
  volatile LAS int* stash = (volatile LAS int*)(lds + LDS_MISC + 4096) + wid * 160;
  int* tok_e = (int*)(p.ws + OFF_TOKE); float* tok_w = (float*)(p.ws + OFF_TOKW); int* tok_p = (int*)(p.ws + OFF_TOKP);
  int* list = (int*)(p.ws + OFF_LIST);
  unsigned* cnt = (unsigned*)(p.ws + OFF_CTRL) + CW_CNT + layer * 16 * CNT_STRIDE;
  if (tid < 16) lcnt[tid] = 0;
  __syncthreads();
  const float bias = p.router_bias[8 * (lane & 1) + 4 * ((lane >> 1) & 1) + 2 * ((lane >> 2) & 1) + ((lane >> 3) & 1)];
  int nst = 0;
  f32x4 vn[4]; u32x2_t dn[4];
  const u16* DELTA = (const u16*)(p.ws + OFF_DELTA);
  if (gw < nrows) { const float* xr0 = xrow_ptr(p, layer, gw);
#pragma unroll
    for (int i = 0; i < 4; ++i) { vn[i] = __builtin_nontemporal_load((const f32x4*)(xr0 + lane * 4 + i * 256)); dn[i] = __builtin_nontemporal_load((const u32x2_t*)(DELTA + (size_t)gw * 1024 + lane * 4 + i * 256)); } }
  for (int row = gw; row < nrows; row += ngw) {
    f32x4 v[4];
#pragma unroll
    for (int i = 0; i < 4; ++i) { v[i] = vn[i]; v[i][0] += bflo(dn[i][0]); v[i][1] += bfhi(dn[i][0]); v[i][2] += bflo(dn[i][1]); v[i][3] += bfhi(dn[i][1]); }
    if (row + ngw < nrows) { const float* xrn = xrow_ptr(p, layer, row + ngw);
#pragma unroll
      for (int i = 0; i < 4; ++i) { vn[i] = __builtin_nontemporal_load((const f32x4*)(xrn + lane * 4 + i * 256)); dn[i] = __builtin_nontemporal_load((const u32x2_t*)(DELTA + (size_t)(row + ngw) * 1024 + lane * 4 + i * 256)); } }
    { float* xw = xrow_out(p, row);
#pragma unroll
      for (int i = 0; i < 4; ++i) *(f32x4*)(xw + lane * 4 + i * 256) = v[i]; }
    const int mr = row < NL ? row / S_ : 8;
    norm_mod_row(v, p.norm_ffn_g + layer * 1024, MODl + (size_t)mr * 6144 + 3 * 1024, lane);
    store_h_row(v, H + (size_t)row * 1024, lane);
    int i0, i1; float w0, w1;
    route_row(bias, v, lds, lane, i0, i1, w0, w1);
    if (lane == 0) {
      const int lp0 = __hip_atomic_fetch_add((LAS int*)&lcnt[i0], 1, __ATOMIC_RELAXED, __HIP_MEMORY_SCOPE_WORKGROUP);
      const int lp1 = __hip_atomic_fetch_add((LAS int*)&lcnt[i1], 1, __ATOMIC_RELAXED, __HIP_MEMORY_SCOPE_WORKGROUP);
      tok_e[row * 2] = i0; tok_e[row * 2 + 1] = i1;
      tok_w[row * 2] = w0; tok_w[row * 2 + 1] = w1;
      stash[nst * 4 + 0] = i0; stash[nst * 4 + 1] = lp0; stash[nst * 4 + 2] = i1; stash[nst * 4 + 3] = lp1;
    }
    ++nst;
  }
  __syncthreads();
  if (tid < 16) { const int c = lcnt[tid]; lbase[tid] = c > 0 ? (int)atomicAdd(&cnt[tid * CNT_STRIDE], (unsigned)c) : 0; }
  __syncthreads();
  if (lane == 0) {
    int k = 0;
    for (int row = gw; row < nrows; row += ngw, ++k) {
      const int e0 = stash[k * 4 + 0], e1 = stash[k * 4 + 2];
      const int p0 = lbase[e0] + stash[k * 4 + 1], p1 = lbase[e1] + stash[k * 4 + 3];
      tok_p[row * 2] = p0; tok_p[row * 2 + 1] = p1;
      list[(size_t)e0 * NT + p0] = row; list[(size_t)e1 * NT + p1] = row;
    }
  }
}

DI void seg_scan(const Params& p, int layer, int (&tb)[NE + 1]) {
  const unsigned* cnt = (const unsigned*)(p.ws + OFF_CTRL) + CW_CNT + layer * 16 * CNT_STRIDE;
  int acc = 0;
#pragma unroll
  for (int e = 0; e < NE; ++e) { tb[e] = acc; acc += ((int)cnt[e * CNT_STRIDE] + 127) >> 7; }
  tb[NE] = acc;
}

DI void p8_combine(const Params& p, int layer, int nrows) {
  const int tid_ = opaque((int)threadIdx.x); const int lane = tid_ & 63, gw = blockIdx.x * 4 + (tid_ >> 6), ngw = gridDim.x * 4;
  const float* MODl = (const float*)(p.ws + OFF_MOD) + (size_t)layer * 9 * 6144;
  const float* MODn = (const float*)(p.ws + OFF_MOD) + (size_t)(layer + 1) * 9 * 6144;
  u16* H = (u16*)(p.ws + OFF_H);
  const u16* YSH = (const u16*)(p.ws + OFF_YSH);
  const u16* YEXP = (const u16*)(p.ws + OFF_YEXP);
  const int* tok_e = (const int*)(p.ws + OFF_TOKE); const float* tok_w = (const float*)(p.ws + OFF_TOKW); const int* tok_p = (const int*)(p.ws + OFF_TOKP);
  int tb[NE + 1]; seg_scan(p, layer, tb);
  int me0 = 0, me1 = 0, mp0 = 0, mp1 = 0; float mw0 = 0.f, mw1 = 0.f;
  u32x2_t an[4], bn[4], cn[4]; f32x4 xn[4]; float nw0 = 0.f, nw1 = 0.f;
#define P8_META(r) do { me0 = tok_e[(r) * 2]; me1 = tok_e[(r) * 2 + 1]; mp0 = tok_p[(r) * 2]; mp1 = tok_p[(r) * 2 + 1]; mw0 = tok_w[(r) * 2]; mw1 = tok_w[(r) * 2 + 1]; } while (0)
#define P8_DATA(r) do { int ps0 = 0, ps1 = 0; _Pragma("unroll") for (int e = 0; e < NE; ++e) { if (e == me0) ps0 = tb[e]; if (e == me1) ps1 = tb[e]; } \
    const size_t s0 = (size_t)ps0 * 128 + mp0, s1 = (size_t)ps1 * 128 + mp1; nw0 = mw0; nw1 = mw1; const float* xrn = xrow_out(p, (r)); \
    _Pragma("unroll") for (int i = 0; i < 4; ++i) { const int cidx = lane * 4 + i * 256; \
      an[i] = __builtin_nontemporal_load((const u32x2_t*)(YEXP + s0 * 1024 + cidx)); bn[i] = __builtin_nontemporal_load((const u32x2_t*)(YEXP + s1 * 1024 + cidx)); \
      cn[i] = __builtin_nontemporal_load((const u32x2_t*)(YSH + (size_t)(r) * 1024 + cidx)); xn[i] = __builtin_nontemporal_load((const f32x4*)(xrn + cidx)); } } while (0)
  if (gw < nrows) { P8_META(gw); P8_DATA(gw); }
  if (gw + ngw < nrows) P8_META(gw + ngw);
  for (int row = gw; row < nrows; row += ngw) {
    u32x2_t a[4], b[4], c[4]; f32x4 v[4];
#pragma unroll
    for (int i = 0; i < 4; ++i) { a[i] = an[i]; b[i] = bn[i]; c[i] = cn[i]; v[i] = xn[i]; }
    const float w0 = nw0, w1 = nw1;
    if (row + ngw < nrows) P8_DATA(row + ngw);
    if (row + 2 * ngw < nrows) P8_META(row + 2 * ngw);
    float* xr = xrow_out(p, row);
    const int mr = row < NL ? row / S_ : 8;
    const float* gate = MODl + (size_t)mr * 6144 + 5 * 1024;
#pragma unroll
    for (int i = 0; i < 4; ++i) {
      const int cidx = lane * 4 + i * 256;
      const f32x4 g = *(const f32x4*)(gate + cidx);
      f32x4 x = v[i];
      x.x += g.x * (w0 * bflo(a[i][0]) + w1 * bflo(b[i][0]) + bflo(c[i][0]));
      x.y += g.y * (w0 * bfhi(a[i][0]) + w1 * bfhi(b[i][0]) + bfhi(c[i][0]));
      x.z += g.z * (w0 * bflo(a[i][1]) + w1 * bflo(b[i][1]) + bflo(c[i][1]));
      x.w += g.w * (w0 * bfhi(a[i][1]) + w1 * bfhi(b[i][1]) + bfhi(c[i][1]));
      v[i] = x;
    }
    if (layer == 0) {
#pragma unroll
      for (int i = 0; i < 4; ++i) __builtin_nontemporal_store(v[i], (f32x4*)(xr + lane * 4 + i * 256));
      norm_mod_row(v, p.norm_mix_g + 1024, MODn + (size_t)mr * 6144, lane);
      store_h_row(v, H + (size_t)row * 1024, lane);
    } else {
      float ss = 0.f;
#pragma unroll
      for (int i = 0; i < 4; ++i) ss += v[i].x * v[i].x + v[i].y * v[i].y + v[i].z * v[i].z + v[i].w * v[i].w;
      ss = wave_sum(ss);
      const float rstd = rsqrtf(ss * (1.f / 1024.f) + EPS);
#pragma unroll
      for (int i = 0; i < 4; ++i) {
        const f32x4 gg = *(const f32x4*)(p.final_norm_g + lane * 4 + i * 256);
        __builtin_nontemporal_store(v[i] * rstd * gg, (f32x4*)(xr + lane * 4 + i * 256));
      }
    }
  }
#undef P8_META
#undef P8_DATA
}

DI void glds16(const u16* g, LAS char* l) {
  __builtin_amdgcn_global_load_lds((const void*)g, (LAS void*)l, 16, 0, 0);
}
struct TilePtrs { const u16 *a0, *a1, *b0, *b1; };
#define GT_ISSUE_P(T, kt, s) do { const int _ko = (kt) * 64; LAS char* _d = ldst + (s) * 32768; \
    glds16((T).a0 + _ko, _d); glds16((T).a1 + _ko, _d + 4096); glds16((T).a0 + _ko + 32, _d + 8192); glds16((T).a1 + _ko + 32, _d + 12288); \
    glds16((T).b0 + _ko, _d + 16384); glds16((T).b1 + _ko, _d + 20480); glds16((T).b0 + _ko + 32, _d + 24576); glds16((T).b1 + _ko + 32, _d + 28672); } while (0)
template <bool HOIST = true>
DI void gemm_tile_s(LAS char* lds, const TilePtrs& cur, bool issued, const TilePtrs& nxt, bool has_next, int nk, f32x4 (&acc)[4][4]) {
  const int tid = opaque((int)threadIdx.x), lane = tid & 63, wid = tid >> 6, wr = wid >> 1, wc = wid & 1, fr = lane & 15, fq = lane >> 4;
  const int cx = (fq ^ ((0 - (fr >> 2)) & 3)) * 16;
  const int aoff = (wr * 64 + fr) * 64 + cx;
  const int boff = 16384 + (wc * 64 + fr) * 64 + cx;
#pragma unroll
  for (int m = 0; m < 4; ++m)
#pragma unroll
    for (int n = 0; n < 4; ++n) acc[m][n] = (f32x4){0.f, 0.f, 0.f, 0.f};
  LAS char* ldst = lds + tid * 16;
  if (!issued) GT_ISSUE_P(cur, 0, 0);
#pragma unroll 1
  for (int kt = 0; kt < nk; ++kt) {
    asm volatile("s_waitcnt vmcnt(0)" ::: "memory");
    __syncthreads();
    if (kt + 1 < nk) GT_ISSUE_P(cur, kt + 1, (kt + 1) & 1);
    else if (has_next) GT_ISSUE_P(nxt, 0, 0);
    const LAS char* sb = lds + (kt & 1) * 32768;
    if (!HOIST) {
#pragma unroll
      for (int h = 0; h < 2; ++h) {
        bf16x8 af1[4], bf1[4];
#pragma unroll
        for (int m = 0; m < 4; ++m) af1[m] = *(const LAS bf16x8*)(sb + h * 8192 + aoff + m * 1024);
#pragma unroll
        for (int n = 0; n < 4; ++n) bf1[n] = *(const LAS bf16x8*)(sb + h * 8192 + boff + n * 1024);
#pragma unroll
        for (int m = 0; m < 4; ++m)
#pragma unroll
          for (int n = 0; n < 4; ++n) acc[m][n] = __builtin_amdgcn_mfma_f32_16x16x32_bf16(bf1[n], af1[m], acc[m][n], 0, 0, 0);
      }
      continue;
    }
    bf16x8 af[2][4], bfr[2][4];
    const unsigned aad = (unsigned)(size_t)(sb + aoff), bad = (unsigned)(size_t)(sb + boff);
#define GT_LDR(dst, ad, off) asm volatile("ds_read_b128 %0, %1 offset:%c2" : "=v"(dst) : "v"(ad), "i"(off))
    GT_LDR(af[0][0], aad, 0); GT_LDR(af[0][1], aad, 1024); GT_LDR(af[0][2], aad, 2048); GT_LDR(af[0][3], aad, 3072);
    GT_LDR(bfr[0][0], bad, 0); GT_LDR(bfr[0][1], bad, 1024); GT_LDR(bfr[0][2], bad, 2048); GT_LDR(bfr[0][3], bad, 3072);
    GT_LDR(af[1][0], aad, 8192); GT_LDR(af[1][1], aad, 8192 + 1024); GT_LDR(af[1][2], aad, 8192 + 2048); GT_LDR(af[1][3], aad, 8192 + 3072);
    GT_LDR(bfr[1][0], bad, 8192); GT_LDR(bfr[1][1], bad, 8192 + 1024); GT_LDR(bfr[1][2], bad, 8192 + 2048); GT_LDR(bfr[1][3], bad, 8192 + 3072);
#undef GT_LDR
    asm volatile("s_waitcnt lgkmcnt(8)" : "+v"(af[0][0]), "+v"(af[0][1]), "+v"(af[0][2]), "+v"(af[0][3]), "+v"(bfr[0][0]), "+v"(bfr[0][1]), "+v"(bfr[0][2]), "+v"(bfr[0][3]) :: "memory");
    __builtin_amdgcn_sched_barrier(0);
#pragma unroll
    for (int m = 0; m < 4; ++m)
#pragma unroll
      for (int n = 0; n < 4; ++n) acc[m][n] = __builtin_amdgcn_mfma_f32_16x16x32_bf16(bfr[0][n], af[0][m], acc[m][n], 0, 0, 0);
    __builtin_amdgcn_sched_barrier(0);
    asm volatile("s_waitcnt lgkmcnt(0)" : "+v"(af[1][0]), "+v"(af[1][1]), "+v"(af[1][2]), "+v"(af[1][3]), "+v"(bfr[1][0]), "+v"(bfr[1][1]), "+v"(bfr[1][2]), "+v"(bfr[1][3]) :: "memory");
    __builtin_amdgcn_sched_barrier(0);
#pragma unroll
    for (int m = 0; m < 4; ++m)
#pragma unroll
      for (int n = 0; n < 4; ++n) acc[m][n] = __builtin_amdgcn_mfma_f32_16x16x32_bf16(bfr[1][n], af[1][m], acc[m][n], 0, 0, 0);
    __builtin_amdgcn_sched_barrier(0);
  }
}
DI void gemm_tile(LAS char* lds, const u16* a0, const u16* a1, const u16* b0, const u16* b1, int nk, f32x4 (&acc)[4][4]) {
  TilePtrs t; t.a0 = a0; t.a1 = a1; t.b0 = b0; t.b1 = b1;
  gemm_tile_s<false>(lds, t, false, t, false, nk, acc);
  __syncthreads();
}
DI int gt_chunk(int tid) { return (((tid & 3) ^ ((0 - ((tid >> 4) & 3)) & 3))) * 8; }
DI int gt_row0(int tid) { return tid >> 2; }

DI void sincos_rev(float pos, float invf, float& sn, float& cs) {
  float rev = pos * invf * 0.15915494309189535f;
  rev -= rintf(rev);
  sn = __builtin_amdgcn_sinf(rev); cs = __builtin_amdgcn_cosf(rev);
}
DI void st_bf4(u16* dst, const f32x4& v) { uint2 o; o.x = cvtpk(v[0], v[1]); o.y = cvtpk(v[2], v[3]); *(uint2*)dst = o; }


DI void stage_put4(LAS char* st, int row, int c8, const f32x4& v) {
  u32x2_t o; o[0] = cvtpk(v[0], v[1]); o[1] = cvtpk(v[2], v[3]);
  *(LAS u32x2_t*)(st + row * 128 + ((c8 ^ (row & 15)) * 8)) = o;
}
DI u32x4_t stage_get16(const LAS char* st, int row, int u) {
  u32x4_t v = *(const LAS u32x4_t*)(st + row * 128 + ((u ^ ((row >> 1) & 7)) * 16));
  if (row & 1) v = __builtin_shufflevector(v, v, 2, 3, 0, 1);
  return v;
}
template <int NC>
DI void stage_flush(const LAS char* st, u16* dst, size_t ld, int lane) {
  constexpr int UPR = NC / 8;
  constexpr int RPI = 64 / UPR;
#pragma unroll
  for (int i = 0; i < 64 / RPI; ++i) {
    const int row = i * RPI + lane / UPR, u = lane % UPR;
    const u32x4_t v = stage_get16(st, row, u);
    *(u32x4_t*)(dst + (size_t)row * ld + u * 8) = v;
  }
}

DI void epi_inproj(const Params& p, int layer, f32x4 (&acc)[4][4], int m0, int seg, int wr, int fr, int fq, LAS float* rowss_slot, LAS char* stg, int lane) {
  char* ws = p.ws;
  const bool lat = m0 < NL;
  const int rbase = m0 + wr * 64 + fr;
  u16* dst; int ld, cb; int kind;
  if (seg < 6) { dst = (u16*)(ws + OFF_SWQ); ld = 384; cb = seg * 64; kind = 1; }
  else if (seg < 8) { dst = (u16*)(ws + OFF_SWK); ld = 128; cb = (seg - 6) * 64; kind = 1; }
  else if (seg < 10) { dst = (u16*)(ws + OFF_SWV); ld = 128; cb = (seg - 8) * 64; kind = 0; }
  else if (seg < 16) { dst = (u16*)(ws + OFF_GLQ); ld = 384; cb = (seg - 10) * 64; kind = 2; }
  else if (seg < 18) { dst = (u16*)(ws + OFF_GLK); ld = 128; cb = (seg - 16) * 64; kind = 3; }
  else if (seg < 20) { dst = (u16*)(ws + OFF_GLV); ld = 128; cb = (seg - 18) * 64; kind = 0; }
  else if (seg < 24) { dst = (u16*)(ws + OFF_QLAT); ld = 256; cb = (seg - 20) * 64; kind = 4; }
  else if (seg < 26) { dst = (u16*)(ws + OFF_KVLAT); ld = 128; cb = (seg - 24) * 64; kind = 5; }
  else if (seg == 26) { dst = (u16*)(ws + OFF_MLKR); ld = 32; cb = 0; kind = 6; }
  else return;
  if (kind == 2 || kind == 3) {
    const float* gain = (kind == 2 ? p.glb_q_gain : p.glb_k_gain) + layer * 64;
    f32x4 gv[4];
#pragma unroll
    for (int n = 0; n < 4; ++n) gv[n] = *(const f32x4*)(gain + n * 16 + fq * 4);
#pragma unroll
    for (int m = 0; m < 4; ++m) {
      float ss = 0.f;
#pragma unroll
      for (int n = 0; n < 4; ++n) ss += acc[m][n][0] * acc[m][n][0] + acc[m][n][1] * acc[m][n][1] + acc[m][n][2] * acc[m][n][2] + acc[m][n][3] * acc[m][n][3];
      ss += __shfl_xor(ss, 16); ss += __shfl_xor(ss, 32);
      const float r = rsqrtf(ss * (1.f / 64.f) + EPS);
#pragma unroll
      for (int n = 0; n < 4; ++n) acc[m][n] = acc[m][n] * r * gv[n];
    }
  }
  if (kind == 4 || kind == 5) {
    const float* gain = (kind == 4 ? p.mla_q_gain + layer * 256 : p.mla_kv_gain + layer * 128) + cb;
    f32x4 gv[4];
#pragma unroll
    for (int n = 0; n < 4; ++n) gv[n] = *(const f32x4*)(gain + n * 16 + fq * 4);
#pragma unroll
    for (int m = 0; m < 4; ++m) {
      float ss = 0.f;
#pragma unroll
      for (int n = 0; n < 4; ++n) ss += acc[m][n][0] * acc[m][n][0] + acc[m][n][1] * acc[m][n][1] + acc[m][n][2] * acc[m][n][2] + acc[m][n][3] * acc[m][n][3];
      ss += __shfl_xor(ss, 16); ss += __shfl_xor(ss, 32);
      if (fq == 0) rowss_slot[wr * 64 + m * 16 + fr] = ss;
#pragma unroll
      for (int n = 0; n < 4; ++n) acc[m][n] = acc[m][n] * gv[n];
    }
  }
  if (lat && (kind == 1 || kind == 2 || kind == 3)) {
    float invf[4];
#pragma unroll
    for (int j = 0; j < 4; ++j) invf[j] = __builtin_amdgcn_exp2f(-(float)(fq * 4 + j) * (13.287712379549449f / 16.f));
#pragma unroll
    for (int m = 0; m < 4; ++m) {
      const int t = (rbase + m * 16) & (S_ - 1);
      const float prow = (float)(t >> 6), pcol = (float)(t & 63);
#pragma unroll
      for (int j = 0; j < 4; ++j) {
        float sr, cr, sc, cc;
        sincos_rev(prow, invf[j], sr, cr); sincos_rev(pcol, invf[j], sc, cc);
        float x1 = acc[m][0][j], x2 = acc[m][1][j];
        acc[m][0][j] = x1 * cr - x2 * sr; acc[m][1][j] = x2 * cr + x1 * sr;
        x1 = acc[m][2][j]; x2 = acc[m][3][j];
        acc[m][2][j] = x1 * cc - x2 * sc; acc[m][3][j] = x2 * cc + x1 * sc;
      }
    }
  }
  if (kind == 6) {
    if (lat) {
      float invf[4];
#pragma unroll
      for (int j = 0; j < 4; ++j) invf[j] = __builtin_amdgcn_exp2f(-(float)((fq & 1) * 4 + j) * (13.287712379549449f / 8.f));
#pragma unroll
      for (int m = 0; m < 4; ++m) {
        const int t = (rbase + m * 16) & (S_ - 1);
#pragma unroll
        for (int n = 0; n < 2; ++n) {
          const float pos = n == 0 ? (float)(t >> 6) : (float)(t & 63);
#pragma unroll
          for (int j = 0; j < 4; ++j) {
            float sn, cs; sincos_rev(pos, invf[j], sn, cs);
            const float v = acc[m][n][j], pr = __shfl_xor(v, 32);
            acc[m][n][j] = (fq & 2) ? v * cs + pr * sn : v * cs - pr * sn;
          }
        }
      }
    }
#pragma unroll
    for (int m = 0; m < 4; ++m)
#pragma unroll
      for (int n = 0; n < 2; ++n) stage_put4(stg, m * 16 + fr, n * 4 + fq, acc[m][n]);
    stage_flush<32>(stg, dst + (size_t)(m0 + wr * 64) * ld, ld, lane);
    return;
  }
#pragma unroll
  for (int m = 0; m < 4; ++m)
#pragma unroll
    for (int n = 0; n < 4; ++n) stage_put4(stg, m * 16 + fr, n * 4 + fq, acc[m][n]);
  stage_flush<64>(stg, dst + (size_t)(m0 + wr * 64) * ld + cb, ld, lane);
}

DI void p2_inproj(const Params& p, int layer, LAS char* lds, int cs = 0) {
  char* ws = p.ws;
  unsigned* ctr = (unsigned*)(ws + OFF_CTRL) + CW_CTR + layer * 16 + 2 + cs;
  const u16* H = (const u16*)(ws + OFF_H);
  const u16* WinT = (const u16*)(ws + OFF_WIN) + (size_t)layer * INWP * 1024;
  const u16* WuqT = (const u16*)(ws + OFF_WUQ) + (size_t)layer * 384 * 256;
  const u16* WukvT = (const u16*)(ws + OFF_WUKV) + (size_t)layer * 512 * 128;
  const int tid = opaque((int)threadIdx.x), lane = tid & 63, wid = tid >> 6, wr = wid >> 1, wc = wid & 1;
  LAS float* rowss = (LAS float*)(lds + LDS_MISC);
  LAS float* rstd = (LAS float*)(lds + LDS_MISC + 2048);
  unsigned* ctr8 = (unsigned*)(ws + OFF_CTRL) + CW_Q + (layer * 2 + 1) * 512;
  f32x4 acc[4][4];
  for (;;) {
    const int u = next_unit_xcd(ctr8, (NT / 128 / 8) * 12, lds);
    if (u < 0) break;
    const int tid_o = opaque(tid), lane_o = tid_o & 63;
    const int fr = lane_o & 15, fq = lane_o >> 4, ch = gt_chunk(tid_o), r0 = gt_row0(tid_o);
    const int qx = u / 408, v = u % 408;
    int rt, k;
    if (v < 34) { rt = qx * 34 + v; k = 10; } else if (v < 68) { rt = qx * 34 + v - 34; k = 11; } else { rt = qx * 34 + (v - 68) / 10; k = (v - 68) % 10; }
    const int m0 = rt * 128;
    const u16* a0 = H + (size_t)(m0 + r0) * 1024 + ch;
    const u16* a1 = a0 + (size_t)64 * 1024;
    if (k < 10) {
      const u16* b0 = WinT + (size_t)(k * 128 + r0) * 1024 + ch;
      gemm_tile(lds, a0, a1, b0, b0 + (size_t)64 * 1024, 16, acc);
      epi_inproj(p, layer, acc, m0, k * 2 + wc, wr, fr, fq, rowss, lds + 32768 + wid * 8192, lane_o);
    } else if (k == 10) {
#pragma unroll 1
      for (int t = 0; t < 2; ++t) {
        const u16* b0 = WinT + (size_t)(1280 + t * 128 + r0) * 1024 + ch;
        gemm_tile(lds, a0, a1, b0, b0 + (size_t)64 * 1024, 16, acc);
        epi_inproj(p, layer, acc, m0, 20 + t * 2 + wc, wr, fr, fq, rowss + (t * 2 + wc) * 128, lds + 32768 + wid * 8192, lane_o);
      }
      __syncthreads();
      if (tid < 128) rstd[tid] = rsqrtf((rowss[tid] + rowss[128 + tid] + rowss[256 + tid] + rowss[384 + tid]) * (1.f / 256.f) + EPS);
      __syncthreads();
      const u16* QL = (const u16*)(ws + OFF_QLAT);
      const u16* qa0 = QL + (size_t)(m0 + r0) * 256 + ch;
      const u16* qa1 = qa0 + (size_t)64 * 256;
      u16* MLQ = (u16*)(ws + OFF_MLQ);
      const bool lat = m0 < NL;
#pragma unroll 1
      for (int t = 0; t < 3; ++t) {
        const u16* b0 = WuqT + (size_t)(t * 128 + r0) * 256 + ch;
        gemm_tile(lds, qa0, qa1, b0, b0 + (size_t)64 * 256, 4, acc);
        const int c0 = t * 128 + wc * 64;
        float invf[4];
#pragma unroll
        for (int j = 0; j < 4; ++j) invf[j] = __builtin_amdgcn_exp2f(-(float)((fq & 1) * 4 + j) * (13.287712379549449f / 8.f));
#pragma unroll
        for (int m = 0; m < 4; ++m) {
          const int rl = wr * 64 + m * 16 + fr;
          const float rs = rstd[rl];
          const int tpos = (m0 + rl) & (S_ - 1);
#pragma unroll
          for (int n = 0; n < 4; ++n) {
            acc[m][n] = acc[m][n] * rs;
            const int w96 = (c0 + n * 16) % 96;
            if (lat && w96 >= 64) {
              const float pos = (w96 == 64) ? (float)(tpos >> 6) : (float)(tpos & 63);
#pragma unroll
              for (int j = 0; j < 4; ++j) {
                float sn, cs; sincos_rev(pos, invf[j], sn, cs);
                const float v = acc[m][n][j], pr = __shfl_xor(v, 32);
                acc[m][n][j] = (fq & 2) ? v * cs + pr * sn : v * cs - pr * sn;
              }
            }
            stage_put4(lds + 32768 + wid * 8192, m * 16 + fr, n * 4 + fq, acc[m][n]);
          }
        }
        stage_flush<64>(lds + 32768 + wid * 8192, MLQ + (size_t)(m0 + wr * 64) * 384 + c0, 384, lane_o);
      }
    } else {
      {
        const u16* b0 = WinT + (size_t)(1536 + r0) * 1024 + ch;
        gemm_tile(lds, a0, a1, b0, b0 + (size_t)64 * 1024, 16, acc);
        epi_inproj(p, layer, acc, m0, 24 + wc, wr, fr, fq, rowss + wc * 128, lds + 32768 + wid * 8192, lane_o);
        const u16* b2 = WinT + (size_t)(1664 + r0) * 1024 + ch;
        gemm_tile(lds, a0, a1, b2, b2 + (size_t)64 * 1024, 16, acc);
        epi_inproj(p, layer, acc, m0, 26 + wc, wr, fr, fq, rowss, lds + 32768 + wid * 8192, lane_o);
      }
      __syncthreads();
      if (tid < 128) rstd[tid] = rsqrtf((rowss[tid] + rowss[128 + tid]) * (1.f / 128.f) + EPS);
      __syncthreads();
      const u16* KL = (const u16*)(ws + OFF_KVLAT);
      const u16* ka0 = KL + (size_t)(m0 + r0) * 128 + ch;
      const u16* ka1 = ka0 + (size_t)64 * 128;
#pragma unroll 1
      for (int t = 0; t < 4; ++t) {
        const u16* b0 = WukvT + (size_t)(t * 128 + r0) * 128 + ch;
        gemm_tile(lds, ka0, ka1, b0, b0 + (size_t)64 * 128, 2, acc);
        u16* dst = (u16*)(ws + (wc == 0 ? OFF_MLK : OFF_MLV));
#pragma unroll
        for (int m = 0; m < 4; ++m) {
          const int rl = wr * 64 + m * 16 + fr;
          const float rs = rstd[rl];
#pragma unroll
          for (int n = 0; n < 4; ++n) { acc[m][n] = acc[m][n] * rs; stage_put4(lds + 32768 + wid * 8192, m * 16 + fr, n * 4 + fq, acc[m][n]); }
        }
        stage_flush<64>(lds + 32768 + wid * 8192, dst + (size_t)(m0 + wr * 64) * 256 + t * 64, 256, lane_o);
      }
    }
  }
}

DI void p4_outproj(const Params& p, int layer, int nrows, LAS char* lds, int cs = 0) {
  char* ws = p.ws;
  const u16* Y = (const u16*)(ws + OFF_Y);
  const u16* WoT = (const u16*)(ws + OFF_WO) + (size_t)layer * 1024 * 1024;
  const float* MODl = (const float*)(ws + OFF_MOD) + (size_t)layer * 9 * 6144;
  const int tid = opaque((int)threadIdx.x), wid = tid >> 6, wr = wid >> 1, wc = wid & 1;
  const int nunits = (nrows / 128) * 8;
  f32x4 acc[4][4];
  __syncthreads();
  TilePtrs cur, nxt;
  int u = (int)((blockIdx.x & 7) * (gridDim.x >> 3) + (blockIdx.x >> 3));
#define P4_DESC(T, uu) do { const int _t = opaque(tid); const int _ch = gt_chunk(_t), _r0 = gt_row0(_t); const int _rt = (uu) >> 3, _ct = (uu) & 7; \
    (T).a0 = Y + (size_t)(_rt * 128 + _r0) * 1024 + _ch; (T).a1 = (T).a0 + (size_t)64 * 1024; \
    (T).b0 = WoT + (size_t)(_ct * 128 + _r0) * 1024 + _ch; (T).b1 = (T).b0 + (size_t)64 * 1024; } while (0)
  bool issued = false;
  if (u < nunits) P4_DESC(cur, u);
  while (u < nunits) {
    const int un = u + gridDim.x;
    const bool hn = un < nunits;
    if (hn) P4_DESC(nxt, un); else nxt = cur;
    gemm_tile_s(lds, cur, issued, nxt, hn, 16, acc);
    issued = hn;
    const int tid_o = opaque(tid), lane_o = tid_o & 63;
    const int fr = lane_o & 15, fq = lane_o >> 4;
    const int rt = u >> 3, ct = u & 7, m0 = rt * 128;
    const int mr = m0 < NL ? m0 / S_ : 8;
    const float* gate = MODl + (size_t)mr * 6144 + 2 * 1024 + ct * 128 + wc * 64 + fq * 4;
    __syncthreads();
    LAS char* stg = lds + 32768 + wid * 8192;
#pragma unroll
    for (int n = 0; n < 4; ++n) {
      const f32x4 g = *(const f32x4*)(gate + n * 16);
#pragma unroll
      for (int m = 0; m < 4; ++m) stage_put4(stg, m * 16 + fr, n * 4 + fq, g * acc[m][n]);
    }
    stage_flush<64>(stg, (u16*)(ws + OFF_DELTA) + (size_t)(m0 + wr * 64) * 1024 + ct * 128 + wc * 64, 1024, lane_o);
    cur = nxt; u = un;
  }
#undef P4_DESC
  __syncthreads();
}

DI void p6_gateup(const Params& p, int layer, int nrows, LAS char* lds, int cs = 0) {
  char* ws = p.ws;
  const unsigned* cnt = (const unsigned*)(ws + OFF_CTRL) + CW_CNT + layer * 16 * CNT_STRIDE;
  const u16* H = (const u16*)(ws + OFF_H);
  const int* list = (const int*)(ws + OFF_LIST);
  const u16* WguT = (const u16*)(ws + OFF_WGU) + (size_t)layer * NE * 1024 * 1024;
  const u16* SguT = (const u16*)(ws + OFF_SGU) + (size_t)layer * 1024 * 1024;
  u16* ACT = (u16*)(ws + OFF_ACT); u16* ACTS = (u16*)(ws + OFF_ACTS);
  const int tid = opaque((int)threadIdx.x), wid = tid >> 6, wr = wid >> 1, wc = wid & 1;
  int tb[NE + 1]; seg_scan(p, layer, tb);
  const int R = tb[NE];
  const int nunits = (R + nrows / 128) * 8;
  f32x4 acc[4][4];
  __syncthreads();
  TilePtrs cur, nxt;
#define P6_DESC(T, uu) do { const int _t = opaque(tid); const int _ch = gt_chunk(_t), _r0 = gt_row0(_t); const int _rt = (uu) >> 3, _ct = (uu) & 7; \
    if (_rt < R) { int _e = 0, _tbe = 0; _Pragma("unroll") for (int q = 1; q < NE; ++q) if (_rt >= tb[q]) { _e = q; _tbe = tb[q]; } \
      const int _i = _rt - _tbe, _ce = (int)cnt[_e * CNT_STRIDE]; const int _i0 = _i * 128 + _r0, _i1 = _i0 + 64; \
      const int _t0 = _i0 < _ce ? list[(size_t)_e * NT + _i0] : 0, _t1 = _i1 < _ce ? list[(size_t)_e * NT + _i1] : 0; \
      (T).a0 = H + (size_t)_t0 * 1024 + _ch; (T).a1 = H + (size_t)_t1 * 1024 + _ch; \
      (T).b0 = WguT + ((size_t)_e * 1024 + _ct * 128 + _r0) * 1024 + _ch; } \
    else { const int _m0 = (_rt - R) * 128; (T).a0 = H + (size_t)(_m0 + _r0) * 1024 + _ch; (T).a1 = (T).a0 + (size_t)64 * 1024; \
      (T).b0 = SguT + (size_t)(_ct * 128 + _r0) * 1024 + _ch; } \
    (T).b1 = (T).b0 + (size_t)64 * 1024; } while (0)
  int u = (int)((blockIdx.x & 7) * (gridDim.x >> 3) + (blockIdx.x >> 3));
  bool issued = false;
  if (u < nunits) P6_DESC(cur, u);
  while (u < nunits) {
    const int un = u + gridDim.x;
    const bool hn = un < nunits;
    if (hn) P6_DESC(nxt, un); else nxt = cur;
    gemm_tile_s(lds, cur, issued, nxt, hn, 16, acc);
    issued = hn;
    const int tid_o = opaque(tid), lane_o = tid_o & 63;
    const int fr = lane_o & 15, fq = lane_o >> 4;
    const int rt = u >> 3, ct = u & 7;
    u16* dst; size_t orow;
    if (rt < R) { dst = ACT; orow = (size_t)rt * 128; } else { dst = ACTS; orow = (size_t)(rt - R) * 128; }
    __syncthreads();
    LAS char* stg = lds + 32768 + wid * 8192;
#pragma unroll
    for (int m = 0; m < 4; ++m)
#pragma unroll
      for (int n = 0; n < 2; ++n) {
        f32x4 r;
#pragma unroll
        for (int j = 0; j < 4; ++j) r[j] = silu(acc[m][n][j]) * acc[m][n + 2][j];
        stage_put4(stg, m * 16 + fr, n * 4 + fq, r);
      }
    stage_flush<32>(stg, dst + (orow + wr * 64) * 512 + ct * 64 + wc * 32, 512, lane_o);
    cur = nxt; u = un;
  }
#undef P6_DESC
  __syncthreads();
}

DI void p7_down(const Params& p, int layer, int nrows, LAS char* lds, int cs = 0) {
  char* ws = p.ws;
  const u16* WdT = (const u16*)(ws + OFF_WD) + (size_t)layer * NE * 1024 * 512;
  const u16* SdT = (const u16*)(ws + OFF_SD) + (size_t)layer * 1024 * 512;
  const u16* ACT = (const u16*)(ws + OFF_ACT); const u16* ACTS = (const u16*)(ws + OFF_ACTS);
  u16* YEXP = (u16*)(ws + OFF_YEXP); u16* YSH = (u16*)(ws + OFF_YSH);
  const int tid = opaque((int)threadIdx.x), wid = tid >> 6, wr = wid >> 1, wc = wid & 1;
  int tb[NE + 1]; seg_scan(p, layer, tb);
  const int R = tb[NE];
  const int nunits = (R + nrows / 128) * 8;
  f32x4 acc[4][4];
  __syncthreads();
  TilePtrs cur, nxt;
#define P7_DESC(T, uu) do { const int _t = opaque(tid); const int _ch = gt_chunk(_t), _r0 = gt_row0(_t); const int _rt = (uu) >> 3, _ct = (uu) & 7; \
    if (_rt < R) { int _e = 0; _Pragma("unroll") for (int q = 1; q < NE; ++q) if (_rt >= tb[q]) _e = q; \
      (T).a0 = ACT + ((size_t)_rt * 128 + _r0) * 512 + _ch; (T).b0 = WdT + ((size_t)_e * 1024 + _ct * 128 + _r0) * 512 + _ch; } \
    else { const int _m0 = (_rt - R) * 128; (T).a0 = ACTS + (size_t)(_m0 + _r0) * 512 + _ch; (T).b0 = SdT + (size_t)(_ct * 128 + _r0) * 512 + _ch; } \
    (T).a1 = (T).a0 + (size_t)64 * 512; (T).b1 = (T).b0 + (size_t)64 * 512; } while (0)
  int u = (int)((blockIdx.x & 7) * (gridDim.x >> 3) + (blockIdx.x >> 3));
  bool issued = false;
  if (u < nunits) P7_DESC(cur, u);
  while (u < nunits) {
    const int un = u + gridDim.x;
    const bool hn = un < nunits;
    if (hn) P7_DESC(nxt, un); else nxt = cur;
    gemm_tile_s(lds, cur, issued, nxt, hn, 8, acc);
    issued = hn;
    const int tid_o = opaque(tid), lane_o = tid_o & 63;
    const int fr = lane_o & 15, fq = lane_o >> 4;
    const int rt = u >> 3, ct = u & 7;
    u16* dst; size_t orow;
    if (rt < R) { dst = YEXP; orow = (size_t)rt * 128; } else { dst = YSH; orow = (size_t)(rt - R) * 128; }
    __syncthreads();
    LAS char* stg = lds + 32768 + wid * 8192;
#pragma unroll
    for (int m = 0; m < 4; ++m)
#pragma unroll
      for (int n = 0; n < 4; ++n) stage_put4(stg, m * 16 + fr, n * 4 + fq, acc[m][n]);
    stage_flush<64>(stg, dst + (orow + wr * 64) * 1024 + ct * 128 + wc * 64, 1024, lane_o);
    cur = nxt; u = un;
  }
#undef P7_DESC
  __syncthreads();
}

typedef float f32x16 __attribute__((ext_vector_type(16)));
typedef short s16x4 __attribute__((ext_vector_type(4)));
DI s16x4 tr_read(const LAS char* a) { return __builtin_bit_cast(s16x4, __builtin_amdgcn_ds_read_tr16_b64_v4i16((LAS s16x4*)a)); }
DI float half_max(float m) { auto rr = __builtin_amdgcn_permlane32_swap(__float_as_uint(m), __float_as_uint(m), false, false); return fmaxf(__uint_as_float(rr[0]), __uint_as_float(rr[1])); }
DI float half_sum(float m) { auto rr = __builtin_amdgcn_permlane32_swap(__float_as_uint(m), __float_as_uint(m), false, false); return __uint_as_float(rr[0]) + __uint_as_float(rr[1]); }
DI bf16x8 pack8(const f32x16& x, int s8) {
  typedef unsigned u32x4 __attribute__((ext_vector_type(4)));
  u32x4 r;
  r[0] = cvtpk(x[s8 + 0], x[s8 + 1]); r[1] = cvtpk(x[s8 + 2], x[s8 + 3]); r[2] = cvtpk(x[s8 + 4], x[s8 + 5]); r[3] = cvtpk(x[s8 + 6], x[s8 + 7]);
  return __builtin_bit_cast(bf16x8, r);
}
constexpr int AT_STAGE = 20480;

DI float max3f(float a, float b, float c) { float r; asm("v_max3_f32 %0, %1, %2, %3" : "=v"(r) : "v"(a), "v"(b), "v"(c)); return r; }
template <bool MLA, bool SWA>
DI void attn_unit(const Params& p, int layer, int isctx, int b, int h, int qb, LAS char* lds) {
  char* ws = p.ws;
  const int tid = opaque((int)threadIdx.x), lane = tid & 63, wid = tid >> 6, r32 = lane & 31, hi = lane >> 5;
  const u16 *Qg, *Kg, *Vg; int ldq, ldk, qoff, koff, ycol; float cs;
  if (MLA) { Qg = (const u16*)(ws + OFF_MLQ); Kg = (const u16*)(ws + OFF_MLK); Vg = (const u16*)(ws + OFF_MLV); ldq = 384; ldk = 256; qoff = h * 96; koff = h * 64; ycol = 768 + h * 64; cs = 0.10206207261596575f * 1.4426950408889634f; }
  else if (!SWA) { Qg = (const u16*)(ws + OFF_GLQ); Kg = (const u16*)(ws + OFF_GLK); Vg = (const u16*)(ws + OFF_GLV); ldq = 384; ldk = 128; qoff = h * 64; koff = (h / 3) * 64; ycol = 384 + h * 64; cs = 0.125f * 1.4426950408889634f; }
  else { Qg = (const u16*)(ws + OFF_SWQ); Kg = (const u16*)(ws + OFF_SWK); Vg = (const u16*)(ws + OFF_SWV); ldq = 384; ldk = 128; qoff = h * 64; koff = (h / 3) * 64; ycol = h * 64; cs = 0.125f * 1.4426950408889634f; }
  const u16* Rg = (const u16*)(ws + OFF_MLKR);
  const int q0 = qb * 128;
  const int qrow0 = (isctx ? NL + b * C_ : b * S_) + q0;
  const int qw = q0 + wid * 32;
  int lat_first = 0, nlat = 0;
  if (!isctx) { if (SWA) { lat_first = 2 * qb - 2; if (lat_first < 0) lat_first = 0; int lat_last = 2 * qb + 3; if (lat_last > 63) lat_last = 63; nlat = lat_last - lat_first + 1; } else nlat = 64; }
  const int T = 4 + nlat;
  constexpr int NQ = MLA ? 6 : 4;
  bf16x8 qf[NQ];
  {
    const u16* qp = Qg + (size_t)(qrow0 + wid * 32 + r32) * ldq + qoff + hi * 8;
#pragma unroll
    for (int d0 = 0; d0 < NQ; ++d0) {
      const u32x4_t raw = *(const u32x4_t*)(qp + d0 * 16);
      u32x4_t sc;
#pragma unroll
      for (int i = 0; i < 4; ++i) sc[i] = cvtpk(bflo(raw[i]) * cs, bfhi(raw[i]) * cs);
      qf[d0] = __builtin_bit_cast(bf16x8, sc);
    }
  }
  int kaddr[4];
#pragma unroll
  for (int d0 = 0; d0 < 4; ++d0) kaddr[d0] = r32 * 128 + (((d0 * 2 + hi) ^ ((r32 >> 1) & 7)) * 16);
  int kraddr[2];
#pragma unroll
  for (int e = 0; e < 2; ++e) kraddr[e] = 16384 + r32 * 64 + (((e * 2 + hi) ^ ((r32 >> 3) & 3)) * 16);
  int vbo[2];
  {
    const int i16 = lane & 15, sw = (lane >> 3) & 1;
    const int x = ((lane >> 4) & 1) * 32 + (lane & 3) * 8;
    const int rowpart = ((i16 >> 2) + 4 * hi) * 128;
    vbo[0] = 8192 + rowpart + x + (sw * 64);
    vbo[1] = 8192 + rowpart + x + ((1 - sw) * 64);
  }
  const int skey = tid >> 3;
  const int kch = ((tid & 7) ^ ((tid >> 4) & 7)) * 8;
  const int vch = ((tid & 7) ^ (((tid >> 4) & 1) << 2)) * 8;
  const int rkey = tid >> 2, rch = ((tid & 3) ^ ((tid >> 5) & 3)) * 8;
  LAS char* ldst = lds + tid * 16;
#define AT_ISSUE(j, st) do { const int _j = (j); const int _kr = _j < 4 ? NL + b * C_ + 64 * _j : b * S_ + 64 * (lat_first + _j - 4); \
    LAS char* _d = ldst + (st) * AT_STAGE; \
    const u16* _k = Kg + (size_t)(_kr + skey) * ldk + koff + kch; glds16(_k, _d); glds16(_k + (size_t)32 * ldk, _d + 4096); \
    const u16* _v = Vg + (size_t)(_kr + skey) * ldk + koff + vch; glds16(_v, _d + 8192); glds16(_v + (size_t)32 * ldk, _d + 8192 + 4096); \
    if (MLA) glds16(Rg + (size_t)(_kr + rkey) * 32 + rch, _d + 16384); } while (0)
#define AT_QK(sb, P0, P1) do { \
    bf16x8 kk0[MLA ? 6 : 4], kk1[MLA ? 6 : 4]; \
    _Pragma("unroll") for (int d0 = 0; d0 < 4; ++d0) { kk0[d0] = *(const LAS bf16x8*)((sb) + kaddr[d0]); kk1[d0] = *(const LAS bf16x8*)((sb) + kaddr[d0] + 4096); } \
    if (MLA) { _Pragma("unroll") for (int e = 0; e < 2; ++e) { kk0[MLA ? 4 + e : 0] = *(const LAS bf16x8*)((sb) + kraddr[e]); kk1[MLA ? 4 + e : 0] = *(const LAS bf16x8*)((sb) + kraddr[e] + 2048); } } \
    __builtin_amdgcn_sched_barrier(0);     \
    P0 = __builtin_amdgcn_mfma_f32_32x32x16_bf16(kk0[0], qf[0], negm, 0, 0, 0); P1 = __builtin_amdgcn_mfma_f32_32x32x16_bf16(kk1[0], qf[0], negm, 0, 0, 0); \
    _Pragma("unroll") for (int d0 = 1; d0 < (MLA ? 6 : 4); ++d0) { \
      P0 = __builtin_amdgcn_mfma_f32_32x32x16_bf16(kk0[d0], qf[d0], P0, 0, 0, 0); P1 = __builtin_amdgcn_mfma_f32_32x32x16_bf16(kk1[d0], qf[d0], P1, 0, 0, 0); } \
  } while (0)
#define AT_WSTATE(jj, pos0v, st) do { st = 0; pos0v = 64 * (lat_first + (jj) - 4); if (SWA && (jj) >= 4) { \
      if (pos0v + 63 < qw - 128 || pos0v > qw + 31 + 128) st = 2; else if (qw + 31 - pos0v > 128 || pos0v + 63 - qw > 128) st = 1; } } while (0)
#define AT_SOFTMAX(P0, P1, PA, wst, pos0v, FIRST) do { \
    if (SWA && wst == 1) { const int dq = qw + r32 - pos0v - 4 * hi + 128; \
      _Pragma("unroll") for (int r = 0; r < 16; ++r) { const int cr = (r & 3) + 8 * (r >> 2); \
        if ((unsigned)(dq - cr) > 256u) P0[r] = -1e30f; if ((unsigned)(dq - cr - 32) > 256u) P1[r] = -1e30f; } } \
    asm volatile("s_nop 15\n\ts_nop 15" : "+v"(P0), "+v"(P1));     \
    float mx = max3f(P0[0], P0[1], P1[0]); mx = max3f(mx, P1[1], P0[2]); \
    _Pragma("unroll") for (int r = 3; r < 16; r += 2) { mx = max3f(mx, P0[r], P0[(r + 1) & 15]); } \
    _Pragma("unroll") for (int r = 2; r < 16; r += 2) { mx = max3f(mx, P1[r], P1[r + 1]); } \
    mx = half_max(mx); \
    if ((FIRST) || __ballot(mx > 8.0f) != 0ull) { \
      const float delta = (FIRST) ? mx : fmaxf(mx, 0.f); \
      const float al = __builtin_amdgcn_exp2f(-delta); \
      m_run += delta; \
      _Pragma("unroll") for (int i = 0; i < 16; ++i) { o[0][i] *= al; o[1][i] *= al; P0[i] -= delta; P1[i] -= delta; negm[i] = -m_run; } \
      osum[0] *= al; \
    } \
    _Pragma("unroll") for (int r = 0; r < 16; ++r) { P0[r] = __builtin_amdgcn_exp2f(P0[r]); P1[r] = __builtin_amdgcn_exp2f(P1[r]); } \
    PA[0] = pack8(P0, 0); PA[1] = pack8(P0, 8); PA[2] = pack8(P1, 0); PA[3] = pack8(P1, 8); \
  } while (0)
#define AT_PV(sb, PA) do { \
    bf16x8 vf[2][4]; \
    _Pragma("unroll") for (int db = 0; db < 2; ++db) { _Pragma("unroll") for (int ts = 0; ts < 4; ++ts) { \
      const LAS char* va = (sb) + vbo[db] + ts * 2048; const s16x4 lo = tr_read(va), hh = tr_read(va + 1024); \
      vf[db][ts] = __builtin_shufflevector(lo, hh, 0, 1, 2, 3, 4, 5, 6, 7); } } \
    __builtin_amdgcn_sched_barrier(0);     \
    _Pragma("unroll") for (int ts = 0; ts < 4; ++ts) osum = __builtin_amdgcn_mfma_f32_32x32x16_bf16(ones, PA[ts], osum, 0, 0, 0); \
    _Pragma("unroll") for (int db = 0; db < 2; ++db) { _Pragma("unroll") for (int ts = 0; ts < 4; ++ts) \
      o[db] = __builtin_amdgcn_mfma_f32_32x32x16_bf16(vf[db][ts], PA[ts], o[db], 0, 0, 0); } } while (0)

  float m_run = SWA ? p.swa_sink[layer * 6 + h] * 1.4426950408889634f : 0.f;
  f32x16 o[2], osum, negm;
#pragma unroll
  for (int i = 0; i < 16; ++i) { o[0][i] = 0.f; o[1][i] = 0.f; osum[i] = SWA ? 1.f : 0.f; negm[i] = -m_run; }
  bf16x8 ones;
#pragma unroll
  for (int i = 0; i < 8; ++i) ones[i] = (short)0x3F80;
  bf16x8 pa[4];
  f32x16 s0, s1;
  AT_ISSUE(0, 0);
  asm volatile("s_waitcnt vmcnt(0)" ::: "memory");
  __syncthreads();
  AT_ISSUE(1, 1);
  AT_QK(lds, s0, s1);
  { int wst = 0, pos0v = 0; AT_SOFTMAX(s0, s1, pa, wst, pos0v, !SWA); }
  bool cur_skip = false;
#pragma unroll 1
  for (int j = 0; j < T - 1; ++j) {
    asm volatile("s_waitcnt vmcnt(0)" ::: "memory");
    __syncthreads();
    const int st_cur = j % 3, st_nxt = (j + 1) % 3;
    if (j + 2 < T) AT_ISSUE(j + 2, (j + 2) % 3);
    const LAS char* sbn = lds + st_nxt * AT_STAGE;
    const LAS char* sbc = lds + st_cur * AT_STAGE;
    int wst, pos0v; AT_WSTATE(j + 1, pos0v, wst);
    if (!SWA || wst != 2) AT_QK(sbn, s0, s1);
    if (!SWA || !cur_skip) AT_PV(sbc, pa);
    if (!SWA || wst != 2) {
      bf16x8 pn[4];
      AT_SOFTMAX(s0, s1, pn, wst, pos0v, false);
      pa[0] = pn[0]; pa[1] = pn[1]; pa[2] = pn[2]; pa[3] = pn[3];
      cur_skip = false;
    } else cur_skip = true;
  }
  if (!SWA || !cur_skip) { const LAS char* sbc = lds + ((T - 1) % 3) * AT_STAGE; AT_PV(sbc, pa); }
#undef AT_ISSUE
#undef AT_QK
#undef AT_WSTATE
#undef AT_SOFTMAX
#undef AT_PV
  const float inv = 1.f / osum[0];
  u16* yp = (u16*)(ws + OFF_Y) + (size_t)(qrow0 + wid * 32 + r32) * 1024 + ycol + 4 * hi;
#pragma unroll
  for (int db = 0; db < 2; ++db)
#pragma unroll
    for (int g = 0; g < 4; ++g) {
      uint2 w; w.x = cvtpk(o[db][4 * g] * inv, o[db][4 * g + 1] * inv); w.y = cvtpk(o[db][4 * g + 2] * inv, o[db][4 * g + 3] * inv);
      *(uint2*)(yp + db * 32 + 8 * g) = w;
    }
  __syncthreads();
}

DI void p3_attention(const Params& p, int layer, LAS char* lds, int cs = 0) {
  unsigned* ctr8 = (unsigned*)(p.ws + OFF_CTRL) + CW_Q + (layer * 2 + 0) * 512;
  const int per_q = 512 + (layer == 0 ? 32 : 0);
  for (;;) {
    const int u = next_unit_xcd(ctr8, per_q, lds);
    if (u < 0) break;
    const int b = u / per_q, v = u % per_q;
    if (v < 128) { attn_unit<true, false>(p, layer, 0, b, v >> 5, v & 31, lds); }
    else if (v < 320) { const int w = v - 128; attn_unit<false, false>(p, layer, 0, b, w >> 5, w & 31, lds); }
    else if (v < 512) { const int w = v - 320; attn_unit<false, true>(p, layer, 0, b, w >> 5, w & 31, lds); }
    else {
      const int w = v - 512;
      if (w < 8) attn_unit<true, false>(p, layer, 1, b, w >> 1, w & 1, lds);
      else if (w < 20) { const int x = w - 8; attn_unit<false, false>(p, layer, 1, b, x >> 1, x & 1, lds); }
      else { const int x = w - 20; attn_unit<false, true>(p, layer, 1, b, x >> 1, x & 1, lds); }
    }
  }
}

struct AttnArgs {
  const u16* Q; const u16* K; const u16* K2; const u16* V; u16* Y; const float* sink;
  int ldq, ldk, ldk2, ldv, ldy, ycol, G, window, q_is_ctx; float scale;
};
static_assert(sizeof(AttnArgs) == 88, "no padding");
template <int DK1, int DK2>
__global__ __launch_bounds__(64) void k_attn(AttnArgs a) {
  const int qt = blockIdx.x * 64 + threadIdx.x, b = blockIdx.y, h = blockIdx.z, kvh = h / a.G;
  const int qrow = a.q_is_ctx ? NL + b * C_ + qt : b * S_ + qt;
  float q[DK1 + DK2];
  {
    const uint4* qp = (const uint4*)(a.Q + (size_t)qrow * a.ldq + h * (DK1 + DK2));
#pragma unroll
    for (int i = 0; i < (DK1 + DK2) / 8; ++i) {
      uint4 u = qp[i];
      q[i * 8 + 0] = bflo(u.x) * a.scale; q[i * 8 + 1] = bfhi(u.x) * a.scale; q[i * 8 + 2] = bflo(u.y) * a.scale; q[i * 8 + 3] = bfhi(u.y) * a.scale;
      q[i * 8 + 4] = bflo(u.z) * a.scale; q[i * 8 + 5] = bfhi(u.z) * a.scale; q[i * 8 + 6] = bflo(u.w) * a.scale; q[i * 8 + 7] = bfhi(u.w) * a.scale;
    }
  }
  float m, l, o[64];
  if (a.sink) { m = a.sink[h]; l = 1.f; } else { m = -1e30f; l = 0.f; }
#pragma unroll
  for (int d = 0; d < 64; ++d) o[d] = 0.f;
  const int nseg = a.q_is_ctx ? 1 : 2;
  for (int seg = 0; seg < nseg; ++seg) {
    int lo, hi, rbase; bool masked = false;
    if (seg == 0) { lo = 0; hi = C_; rbase = NL + b * C_; }
    else {
      lo = 0; hi = S_; rbase = b * S_;
      if (a.window) { int t0 = blockIdx.x * 64; lo = t0 - a.window; if (lo < 0) lo = 0; hi = t0 + 64 + a.window; if (hi > S_) hi = S_; masked = true; }
    }
    for (int s = lo; s < hi; s += 4) {
      float sc[4];
#pragma unroll
      for (int i = 0; i < 4; ++i) {
        const uint4* kp = (const uint4*)(a.K + (size_t)(rbase + s + i) * a.ldk + kvh * DK1);
        float dot = 0.f;
#pragma unroll
        for (int c = 0; c < DK1 / 8; ++c) {
          uint4 u = kp[c];
          dot += q[c * 8 + 0] * bflo(u.x) + q[c * 8 + 1] * bfhi(u.x) + q[c * 8 + 2] * bflo(u.y) + q[c * 8 + 3] * bfhi(u.y)
               + q[c * 8 + 4] * bflo(u.z) + q[c * 8 + 5] * bfhi(u.z) + q[c * 8 + 6] * bflo(u.w) + q[c * 8 + 7] * bfhi(u.w);
        }
        if (DK2 > 0) {
          const uint4* kp2 = (const uint4*)(a.K2 + (size_t)(rbase + s + i) * a.ldk2);
#pragma unroll
          for (int c = 0; c < DK2 / 8; ++c) {
            uint4 u = kp2[c];
            dot += q[DK1 + c * 8 + 0] * bflo(u.x) + q[DK1 + c * 8 + 1] * bfhi(u.x) + q[DK1 + c * 8 + 2] * bflo(u.y) + q[DK1 + c * 8 + 3] * bfhi(u.y)
                 + q[DK1 + c * 8 + 4] * bflo(u.z) + q[DK1 + c * 8 + 5] * bfhi(u.z) + q[DK1 + c * 8 + 6] * bflo(u.w) + q[DK1 + c * 8 + 7] * bfhi(u.w);
          }
        }
        if (masked) { int dlt = qt - (s + i); if (dlt < 0) dlt = -dlt; if (dlt > a.window) dot = -1e30f; }
        sc[i] = dot;
      }
      float mx = fmaxf(fmaxf(fmaxf(sc[0], sc[1]), fmaxf(sc[2], sc[3])), m);
      const float alpha = __expf(m - mx);
      float pr[4];
#pragma unroll
      for (int i = 0; i < 4; ++i) pr[i] = __expf(sc[i] - mx);
      l = l * alpha + (pr[0] + pr[1]) + (pr[2] + pr[3]);
      m = mx;
#pragma unroll
      for (int d = 0; d < 64; ++d) o[d] *= alpha;
#pragma unroll
      for (int i = 0; i < 4; ++i) {
        const uint4* vp = (const uint4*)(a.V + (size_t)(rbase + s + i) * a.ldv + kvh * 64);
#pragma unroll
        for (int c = 0; c < 8; ++c) {
          uint4 u = vp[c];
          o[c * 8 + 0] += pr[i] * bflo(u.x); o[c * 8 + 1] += pr[i] * bfhi(u.x); o[c * 8 + 2] += pr[i] * bflo(u.y); o[c * 8 + 3] += pr[i] * bfhi(u.y);
          o[c * 8 + 4] += pr[i] * bflo(u.z); o[c * 8 + 5] += pr[i] * bfhi(u.z); o[c * 8 + 6] += pr[i] * bflo(u.w); o[c * 8 + 7] += pr[i] * bfhi(u.w);
        }
      }
    }
  }
  const float inv = 1.f / l;
  uint4* yp = (uint4*)(a.Y + (size_t)qrow * a.ldy + a.ycol + h * 64);
#pragma unroll
  for (int c = 0; c < 8; ++c) {
    uint4 u;
    u.x = cvtpk(o[c * 8 + 0] * inv, o[c * 8 + 1] * inv); u.y = cvtpk(o[c * 8 + 2] * inv, o[c * 8 + 3] * inv);
    u.z = cvtpk(o[c * 8 + 4] * inv, o[c * 8 + 5] * inv); u.w = cvtpk(o[c * 8 + 6] * inv, o[c * 8 + 7] * inv);
    yp[c] = u;
  }
}


constexpr int CW_BAR = 1024;
#define XB_TMO      128
#define XB_XCNT(j)  (256  + 64 * (j))
#define XB_XSUB(j)  (1280 + 64 * (j))
#define XB_XGEN(j)  (2304 + 64 * (j))
#define XB_TOP      3328
#define XB_TOPGEN   3392
#define XCD_BAR_WORDS 3456
#define XB_SPIN_CAP (1u << 22)
DI unsigned xb_ld(unsigned* p) { return __hip_atomic_load(p, __ATOMIC_RELAXED, __HIP_MEMORY_SCOPE_AGENT); }
DI unsigned xb_add(unsigned* p, unsigned v) { return __hip_atomic_fetch_add(p, v, __ATOMIC_RELAXED, __HIP_MEMORY_SCOPE_AGENT); }
DI unsigned xb_xcc_id() { return (unsigned)__builtin_amdgcn_s_getreg((3 << 11) | 20) & 0xFu; }
#define XB_SPIN(cond, bar) do { unsigned _sp = 0; while (cond) { __builtin_amdgcn_s_sleep(1); \
    if ((++_sp & 255u) == 0u) { if (xb_ld(&(bar)[XB_TMO])) break; if (_sp > XB_SPIN_CAP) { atomicAdd(&(bar)[XB_TMO], 1u); break; } } } } while (0)
struct XcdBarrier { unsigned* bar; unsigned x; volatile LAS unsigned* st; };
DI XcdBarrier xcd_barrier_post(unsigned* bar, volatile LAS unsigned* st) {
  XcdBarrier b; b.bar = bar; b.x = xb_xcc_id(); b.st = st;
  if (threadIdx.x == 0) (void)xb_add(&bar[XB_XCNT(b.x)], 1u);
  return b;
}
DI void xcd_barrier_complete(unsigned* bar, unsigned x, unsigned& nloc, unsigned& nx) {
  const unsigned G = gridDim.x * gridDim.y * gridDim.z;
  unsigned sum, cnt, mine, sp = 0u;
  for (;;) {
    sum = 0u; cnt = 0u; mine = 0u;
#pragma unroll
    for (unsigned j = 0; j < 16; ++j) { const unsigned c = xb_ld(&bar[XB_XCNT(j)]); sum += c; cnt += (c > 0u) ? 1u : 0u; mine = (j == x) ? c : mine; }
    if (sum == G) break;
    __builtin_amdgcn_s_sleep(1);
    if ((++sp & 255u) == 0u) { if (xb_ld(&bar[XB_TMO])) break; if (sp > XB_SPIN_CAP) { atomicAdd(&bar[XB_TMO], 1u); break; } }
  }
  nloc = mine > 0u ? mine : 1u; nx = cnt > 0u ? cnt : 1u;
}
DI void xcd_barrier(const XcdBarrier& b) {
  asm volatile("s_waitcnt vmcnt(0)" ::: "memory");
  __syncthreads();
  if (threadIdx.x == 0) {
    unsigned* bar = b.bar;
    __builtin_amdgcn_s_waitcnt(0);
    unsigned nloc = b.st[0], nx = b.st[1];
    if (nloc == 0u) { xcd_barrier_complete(bar, b.x, nloc, nx); b.st[0] = nloc; b.st[1] = nx; }
    const unsigned old = xb_add(&bar[XB_XSUB(b.x)], 1u);
    const unsigned gen = old / nloc;
    if (old + 1u == (gen + 1u) * nloc) {
      __builtin_amdgcn_fence(__ATOMIC_RELEASE, "agent");
      asm volatile("s_waitcnt vmcnt(0)" ::: "memory");
      const unsigned og = xb_add(&bar[XB_TOP], 1u);
      const unsigned tg = og / nx;
      if (og + 1u == (tg + 1u) * nx) xb_add(&bar[XB_TOPGEN], 1u);
      else XB_SPIN(xb_ld(&bar[XB_TOPGEN]) == tg, bar);
      __builtin_amdgcn_fence(__ATOMIC_ACQUIRE, "agent");
      xb_add(&bar[XB_XGEN(b.x)], 1u);
      asm volatile("s_waitcnt vmcnt(0)" ::: "memory");
    } else {
      XB_SPIN(xb_ld(&bar[XB_XGEN(b.x)]) == gen, bar);
      __builtin_amdgcn_fence(__ATOMIC_ACQUIRE, "agent");
      asm volatile("s_waitcnt vmcnt(0)" ::: "memory");
    }
  }
  __syncthreads();
}

__global__ __launch_bounds__(NTHR, 2) void k_mega(Params p) {
  extern __shared__ __attribute__((aligned(16))) unsigned char smem[];
  LAS char* lds = (LAS char*)smem;
  if (p.never) cooperative_groups::this_grid().sync();
  volatile LAS unsigned* st = (volatile LAS unsigned*)(lds + LDS_MISC + 3584);
  if (threadIdx.x < 4) st[threadIdx.x] = 0u;
  __syncthreads();
  XcdBarrier bar = xcd_barrier_post((unsigned*)(p.ws + OFF_CTRL) + CW_BAR, st);
#ifdef PROBE_SEG
  unsigned long long t_acc = 0ull, t_s = 0ull;
#define SEG_BEGIN(id) do { if ((id) == PROBE_SEG && blockIdx.x == 0 && threadIdx.x == 0) t_s = __builtin_amdgcn_s_memrealtime(); } while (0)
#define SEG_END(id) do { if ((id) == PROBE_SEG && blockIdx.x == 0 && threadIdx.x == 0) t_acc += __builtin_amdgcn_s_memrealtime() - t_s; } while (0)
#else
#define SEG_BEGIN(id) do {} while (0)
#define SEG_END(id) do {} while (0)
#endif
  SEG_BEGIN(0); p0_prologue(p, lds); xcd_barrier(bar); SEG_END(0);
  SEG_BEGIN(1); p1_norm_mix(p, 0); xcd_barrier(bar); SEG_END(1);
#pragma unroll 1
  for (int l = 0; l < 2; ++l) {
    const int nrows = l == 0 ? NT : NL;
    SEG_BEGIN(2 + 10 * l); p2_inproj(p, l, lds); xcd_barrier(bar); SEG_END(2 + 10 * l);
    SEG_BEGIN(3 + 10 * l); p3_attention(p, l, lds); xcd_barrier(bar); SEG_END(3 + 10 * l);
    SEG_BEGIN(4 + 10 * l); p4_outproj(p, l, nrows, lds); xcd_barrier(bar); SEG_END(4 + 10 * l);
    SEG_BEGIN(5 + 10 * l); p5_norm_ffn(p, l, nrows, lds); xcd_barrier(bar); SEG_END(5 + 10 * l);
    SEG_BEGIN(6 + 10 * l); p6_gateup(p, l, nrows, lds); xcd_barrier(bar); SEG_END(6 + 10 * l);
    SEG_BEGIN(7 + 10 * l); p7_down(p, l, nrows, lds); xcd_barrier(bar); SEG_END(7 + 10 * l);
    SEG_BEGIN(8 + 10 * l); p8_combine(p, l, nrows); if (l == 0) xcd_barrier(bar); SEG_END(8 + 10 * l);
  }
#ifdef PROBE_SEG
  if (blockIdx.x == 0 && threadIdx.x == 0) {
    const unsigned long long t0 = __builtin_amdgcn_s_memrealtime();
    while (__builtin_amdgcn_s_memrealtime() - t0 < 9ull * t_acc) __builtin_amdgcn_s_sleep(8);
  }
#endif
}

template <int PH>
__global__ __launch_bounds__(NTHR, 2) void k_phase(Params p, int layer, int nrows) {
  extern __shared__ __attribute__((aligned(16))) unsigned char smem[];
  LAS char* lds = (LAS char*)smem;
  if (PH == 0) p0_prologue(p, lds);
  if (PH == 1) p1_norm_mix(p, layer);
  if (PH == 2) p2_inproj(p, layer, lds);
  if (PH == 3) p3_attention(p, layer, lds);
  if (PH == 4) p4_outproj(p, layer, nrows, lds);
  if (PH == 5) p5_norm_ffn(p, layer, nrows, lds);
  if (PH == 6) p6_gateup(p, layer, nrows, lds);
  if (PH == 7) p7_down(p, layer, nrows, lds);
  if (PH == 8) p8_combine(p, layer, nrows);
}

extern "C" void kernel_launch(void* const* d_in, const int* in_sizes, int n_in, void* d_out, int out_size, void* d_ws, size_t ws_size, hipStream_t stream) {
  Params p{};
  p.x = (const float*)d_in[0]; p.c = (const float*)d_in[1]; p.ctx = (const float*)d_in[2]; p.c_ctx = (const float*)d_in[3];
  p.w_mod = (const float*)d_in[4]; p.b_mod = (const float*)d_in[5]; p.norm_mix_g = (const float*)d_in[6]; p.norm_ffn_g = (const float*)d_in[7];
  p.w_in = (const float*)d_in[8]; p.w_out = (const float*)d_in[9]; p.swa_sink = (const float*)d_in[10]; p.glb_q_gain = (const float*)d_in[11];
  p.glb_k_gain = (const float*)d_in[12]; p.mla_q_gain = (const float*)d_in[13]; p.mla_w_uq = (const float*)d_in[14]; p.mla_kv_gain = (const float*)d_in[15];
  p.mla_w_ukv = (const float*)d_in[16]; p.router_w = (const float*)d_in[17]; p.router_bias = (const float*)d_in[18]; p.exp_w_gate = (const float*)d_in[19];
  p.exp_w_up = (const float*)d_in[20]; p.exp_w_down = (const float*)d_in[21]; p.shr_w_gate = (const float*)d_in[22]; p.shr_w_up = (const float*)d_in[23];
  p.shr_w_down = (const float*)d_in[24]; p.final_norm_g = (const float*)d_in[25];
  p.out = (float*)d_out; p.ws = (char*)d_ws;
  char* ws = (char*)d_ws;

#ifndef MEGA
#define MEGA 1
#endif
#if MEGA
  static int grid_blocks = 0;
  if (!grid_blocks) {
    (void)hipFuncSetAttribute((const void*)k_mega, hipFuncAttributeMaxDynamicSharedMemorySize, LDS_BYTES);
    int dev = 0, cus = 0, per_cu = 0;
    (void)hipGetDevice(&dev);
    (void)hipDeviceGetAttribute(&cus, hipDeviceAttributeMultiprocessorCount, dev);
    (void)hipOccupancyMaxActiveBlocksPerMultiprocessor(&per_cu, (const void*)k_mega, NTHR, LDS_BYTES);
    if (per_cu > 2) per_cu = 2;
    if (per_cu < 1) per_cu = 1;
    grid_blocks = cus * per_cu;
  }
  (void)hipMemsetAsync(ws + OFF_CTRL, 0, CTRL_BYTES, stream);
  void* args[] = {&p};
  hipError_t e = hipLaunchCooperativeKernel((const void*)k_mega, dim3(grid_blocks), dim3(NTHR), args, LDS_BYTES, stream);
  if (e != hipSuccess) fprintf(stderr, "cooperative launch failed: %s (grid %d)\n", hipGetErrorString(e), grid_blocks);
#else
  static bool attr_done = false;
  if (!attr_done) {
    (void)hipFuncSetAttribute((const void*)k_phase<0>, hipFuncAttributeMaxDynamicSharedMemorySize, LDS_BYTES);
    (void)hipFuncSetAttribute((const void*)k_phase<1>, hipFuncAttributeMaxDynamicSharedMemorySize, LDS_BYTES);
    (void)hipFuncSetAttribute((const void*)k_phase<2>, hipFuncAttributeMaxDynamicSharedMemorySize, LDS_BYTES);
    (void)hipFuncSetAttribute((const void*)k_phase<3>, hipFuncAttributeMaxDynamicSharedMemorySize, LDS_BYTES);
    (void)hipFuncSetAttribute((const void*)k_phase<4>, hipFuncAttributeMaxDynamicSharedMemorySize, LDS_BYTES);
    (void)hipFuncSetAttribute((const void*)k_phase<5>, hipFuncAttributeMaxDynamicSharedMemorySize, LDS_BYTES);
    (void)hipFuncSetAttribute((const void*)k_phase<6>, hipFuncAttributeMaxDynamicSharedMemorySize, LDS_BYTES);
    (void)hipFuncSetAttribute((const void*)k_phase<7>, hipFuncAttributeMaxDynamicSharedMemorySize, LDS_BYTES);
    (void)hipFuncSetAttribute((const void*)k_phase<8>, hipFuncAttributeMaxDynamicSharedMemorySize, LDS_BYTES);
    attr_done = true;
  }

  (void)hipMemsetAsync(ws + OFF_CTRL, 0, CTRL_BYTES, stream);
  k_phase<0><<<GRID, NTHR, LDS_BYTES, stream>>>(p, 0, 0);
  k_phase<1><<<GRID, NTHR, LDS_BYTES, stream>>>(p, 0, NT);
  for (int l = 0; l < 2; ++l) {
    const bool last = (l == 1);
    const int Mres = last ? NL : NT;
    k_phase<2><<<GRID, NTHR, LDS_BYTES, stream>>>(p, l, NT);
    k_phase<3><<<GRID, NTHR, LDS_BYTES, stream>>>(p, l, NT);
    k_phase<4><<<GRID, NTHR, LDS_BYTES, stream>>>(p, l, Mres);
    k_phase<5><<<GRID, NTHR, LDS_BYTES, stream>>>(p, l, Mres);
    k_phase<6><<<GRID, NTHR, LDS_BYTES, stream>>>(p, l, Mres);
    k_phase<7><<<GRID, NTHR, LDS_BYTES, stream>>>(p, l, Mres);
    k_phase<8><<<GRID, NTHR, LDS_BYTES, stream>>>(p, l, Mres);
  }
#endif
}
```

```cpp
#include <hip/hip_runtime.h>
#include <hip/hip_cooperative_groups.h>
#include <cstdio>
#include <stdint.h>
#include <stddef.h>

typedef unsigned short u16;
typedef short bf16x8 __attribute__((ext_vector_type(8)));
typedef float f32x4 __attribute__((ext_vector_type(4)));
typedef float f32x2_t __attribute__((ext_vector_type(2)));
typedef __bf16 bf16x2_t __attribute__((ext_vector_type(2)));
typedef unsigned u32x2_t __attribute__((ext_vector_type(2)));
typedef unsigned u32x4_t __attribute__((ext_vector_type(4)));
#define DI __device__ __forceinline__
#define LAS __attribute__((address_space(3)))

constexpr int B_ = 8, S_ = 4096, D_ = 1024, C_ = 256;
constexpr int NL = B_ * S_, NC = B_ * C_, NT = NL + NC;
constexpr int INW = 1696, INWP = 1792;
constexpr int NE = 16;
constexpr int MAXSLOT = NT * 2 + NE * 128;
constexpr float EPS = 1e-6f;
constexpr int NTHR = 256;
constexpr int GRID = 512;

DI float bf2f(u16 v) { return __uint_as_float(((unsigned)v) << 16); }
DI float bflo(unsigned u) { return __uint_as_float(u << 16); }
DI float bfhi(unsigned u) { return __uint_as_float(u & 0xffff0000u); }
DI unsigned cvtpk(float lo, float hi) { f32x2_t v = {lo, hi}; bf16x2_t b = __builtin_convertvector(v, bf16x2_t); return __builtin_bit_cast(unsigned, b); }
template <int CTRL> DI float dpp_mov(float v) { return __int_as_float(__builtin_amdgcn_update_dpp(0, __float_as_int(v), CTRL, 0xf, 0xf, false)); }
DI float wave_sum(float v) {
  v += dpp_mov<0xB1>(v);
  v += dpp_mov<0x4E>(v);
  v += dpp_mov<0x141>(v);
  v += dpp_mov<0x140>(v);
  { auto rr = __builtin_amdgcn_permlane16_swap(__float_as_uint(v), __float_as_uint(v), false, false); v = __uint_as_float(rr[0]) + __uint_as_float(rr[1]); }
  { auto rr = __builtin_amdgcn_permlane32_swap(__float_as_uint(v), __float_as_uint(v), false, false); v = __uint_as_float(rr[0]) + __uint_as_float(rr[1]); }
  return v;
}
DI float silu(float g) { return g / (1.f + __expf(-g)); }
DI int opaque(int v) { asm volatile("" : "+v"(v)); return v; }

constexpr size_t al256(size_t x) { return (x + 255) & ~(size_t)255; }
constexpr size_t OFF_CTRL = 0;
constexpr size_t CTRL_BYTES = 65536;
constexpr size_t OFF_CTXR = OFF_CTRL + CTRL_BYTES;
constexpr size_t OFF_MOD = OFF_CTXR + al256((size_t)NC * D_ * 4);
constexpr size_t OFF_TOKE = OFF_MOD + al256((size_t)2 * 9 * 6144 * 4);
constexpr size_t OFF_TOKW = OFF_TOKE + al256((size_t)NT * 2 * 4);
constexpr size_t OFF_TOKP = OFF_TOKW + al256((size_t)NT * 2 * 4);
constexpr size_t OFF_LIST = OFF_TOKP + al256((size_t)NT * 2 * 4);
constexpr size_t OFF_WIN = OFF_LIST + al256((size_t)NE * NT * 4);
constexpr size_t OFF_WO = OFF_WIN + (size_t)2 * INWP * 1024 * 2;
constexpr size_t OFF_WUQ = OFF_WO + (size_t)2 * 1024 * 1024 * 2;
constexpr size_t OFF_WUKV = OFF_WUQ + (size_t)2 * 384 * 256 * 2;
constexpr size_t OFF_WGU = OFF_WUKV + (size_t)2 * 512 * 128 * 2;
constexpr size_t OFF_WD = OFF_WGU + (size_t)2 * 16 * 1024 * 1024 * 2;
constexpr size_t OFF_SGU = OFF_WD + (size_t)2 * 16 * 1024 * 512 * 2;
constexpr size_t OFF_SD = OFF_SGU + (size_t)2 * 1024 * 1024 * 2;
constexpr size_t OFF_H = OFF_SD + (size_t)2 * 1024 * 512 * 2;
constexpr size_t OFF_BIG = OFF_H + (size_t)NT * 1024 * 2;
constexpr size_t OFF_SWQ = OFF_BIG;
constexpr size_t OFF_SWK = OFF_SWQ + (size_t)NT * 384 * 2;
constexpr size_t OFF_SWV = OFF_SWK + (size_t)NT * 128 * 2;
constexpr size_t OFF_GLQ = OFF_SWV + (size_t)NT * 128 * 2;
constexpr size_t OFF_GLK = OFF_GLQ + (size_t)NT * 384 * 2;
constexpr size_t OFF_GLV = OFF_GLK + (size_t)NT * 128 * 2;
constexpr size_t OFF_MLQ = OFF_GLV + (size_t)NT * 128 * 2;
constexpr size_t OFF_MLK = OFF_MLQ + (size_t)NT * 384 * 2;
constexpr size_t OFF_MLKR = OFF_MLK + (size_t)NT * 256 * 2;
constexpr size_t OFF_MLV = OFF_MLKR + (size_t)NT * 32 * 2;
constexpr size_t OFF_QLAT = OFF_MLV + (size_t)NT * 256 * 2;
constexpr size_t OFF_KVLAT = OFF_QLAT + (size_t)NT * 256 * 2;
constexpr size_t OFF_Y = OFF_KVLAT + (size_t)NT * 128 * 2;
constexpr size_t END_A = OFF_Y + (size_t)NT * 1024 * 2;
constexpr size_t OFF_ACT = OFF_BIG;
constexpr size_t OFF_ACTS = OFF_ACT + (size_t)MAXSLOT * 512 * 2;
constexpr size_t OFF_YEXP = OFF_ACTS + (size_t)NT * 512 * 2;
constexpr size_t END_B = OFF_YEXP + (size_t)MAXSLOT * 1024 * 2;
constexpr size_t OFF_YSH = OFF_H;
constexpr size_t OFF_DELTA = OFF_SWQ;
static_assert(OFF_DELTA + (size_t)NT * 1024 * 2 <= OFF_MLQ, "DELTA must fit below MLQ");
constexpr size_t WS_NEED = END_A > END_B ? END_A : END_B;
static_assert(WS_NEED <= (size_t)536870912, "workspace too large");

constexpr int CW_CTR = 0;
constexpr int CW_CNT = 8192;
constexpr int CW_Q = 10240;

struct Params {
  const float *x, *c, *ctx, *c_ctx, *w_mod, *b_mod, *norm_mix_g, *norm_ffn_g, *w_in, *w_out, *swa_sink, *glb_q_gain, *glb_k_gain,
      *mla_q_gain, *mla_w_uq, *mla_kv_gain, *mla_w_ukv, *router_w, *router_bias, *exp_w_gate, *exp_w_up, *exp_w_down, *shr_w_gate,
      *shr_w_up, *shr_w_down, *final_norm_g;
  float* out;
  char* ws;
  int never; int pad;
};

constexpr int LDS_MISC = 65536;
constexpr int LDS_BYTES = 65536 + 8192;

DI int next_unit(unsigned* ctr, LAS char* lds) {
  volatile LAS int* slot = (volatile LAS int*)(lds + LDS_MISC + 2560);
  __syncthreads();
  if (threadIdx.x == 0) *slot = (int)atomicAdd(ctr, 1u);
  __syncthreads();
  return *slot;
}

DI unsigned xcc_id_() { return (unsigned)__builtin_amdgcn_s_getreg((3 << 11) | 20) & 0x7u; }
DI int next_unit_xcd(unsigned* ctr8, int per_queue, LAS char* lds) {
  volatile LAS int* slot = (volatile LAS int*)(lds + LDS_MISC + 2560);
  __syncthreads();
  if (threadIdx.x == 0) {
    const int q0 = (int)xcc_id_();
    int res = -1;
    for (int i = 0; i < 8; ++i) {
      const int q = (q0 + i) & 7;
      const int v = (int)atomicAdd(&ctr8[q * 64], 1u);
      if (v < per_queue) { res = q * per_queue + v; break; }
    }
    *slot = res;
  }
  __syncthreads();
  return *slot;
}
DI void cvt_job(const float* __restrict__ src, int ld, int N, int k0, int n0, u16* __restrict__ dst, int K, int mode  , LAS char* lds) {
  LAS float* T = (LAS float*)lds;
  const int tid = threadIdx.x;
  __syncthreads();
  {
    const int kk = tid >> 2, nq = (tid & 3) * 32;
    const float* s = src + (size_t)(k0 + kk) * ld + n0 + nq;
#pragma unroll
    for (int i = 0; i < 8; ++i) {
      float4 v = make_float4(0.f, 0.f, 0.f, 0.f);
      if (n0 + nq + i * 4 < N) v = *(const float4*)(s + i * 4);
      LAS float* t = T + kk * 129 + nq + i * 4;
      t[0] = v.x; t[1] = v.y; t[2] = v.z; t[3] = v.w;
    }
  }
  __syncthreads();
#pragma unroll
  for (int i = 0; i < 4; ++i) {
    const int chn = tid + i * 256;
    const int n = chn >> 3, kc = (chn & 7) * 8;
    if (n0 + n < N) {
      const LAS float* t = T + kc * 129 + n;
      uint4 o;
      o.x = cvtpk(t[0], t[129]); o.y = cvtpk(t[2 * 129], t[3 * 129]); o.z = cvtpk(t[4 * 129], t[5 * 129]); o.w = cvtpk(t[6 * 129], t[7 * 129]);
      const int gn = n0 + n;
      int drow = gn;
      if (mode) drow = (gn >> 5) * 64 + (gn & 31) + (mode == 2 ? 32 : 0);
      *(uint4*)(dst + (size_t)drow * K + k0 + kc) = o;
    }
  }
}

DI void mod_job(const Params& p, int l, int j0, LAS char* lds) {
  LAS float* sc = (LAS float*)lds;
  LAS float* red = (LAS float*)(lds + 36864);
  const int tid = threadIdx.x;
  __syncthreads();
  for (int i = tid; i < 9 * 1024; i += NTHR) {
    int r = i >> 10, k = i & 1023;
    float v = r < 8 ? p.c[r * 1024 + k] : p.c_ctx[k];
    sc[i] = v / (1.f + __expf(-v));
  }
  __syncthreads();
  const int col = tid & 31, kg = tid >> 5;
  float acc[9];
#pragma unroll
  for (int r = 0; r < 9; ++r) acc[r] = 0.f;
  const float* w = p.w_mod + (size_t)l * 1024 * 6144 + (size_t)(kg * 128) * 6144 + j0 + col;
#pragma unroll 1
  for (int k0 = 0; k0 < 128; k0 += 16) {
    float wv[16];
#pragma unroll
    for (int u = 0; u < 16; ++u) wv[u] = w[(size_t)(k0 + u) * 6144];
#pragma unroll
    for (int u = 0; u < 16; ++u)
#pragma unroll
      for (int r = 0; r < 9; ++r) acc[r] += sc[r * 1024 + kg * 128 + k0 + u] * wv[u];
  }
#pragma unroll
  for (int r = 0; r < 9; ++r) red[(kg * 9 + r) * 32 + col] = acc[r];
  __syncthreads();
  float* MOD = (float*)(p.ws + OFF_MOD);
  for (int i = tid; i < 9 * 32; i += NTHR) {
    int r = i >> 5, cc = i & 31;
    float sum = 0.f;
#pragma unroll
    for (int g = 0; g < 8; ++g) sum += red[(g * 9 + r) * 32 + cc];
    MOD[(size_t)(l * 9 + r) * 6144 + j0 + cc] = sum + p.b_mod[l * 6144 + j0 + cc];
  }
}

constexpr int J_WIN = 16 * 14, J_WO = 16 * 8, J_UQ = 4 * 3, J_UKV = 2 * 4, J_EG = 16 * 4, J_ED = 8 * 8;
constexpr int J_DENSE = J_WIN + J_WO + J_UQ + J_UKV;
constexpr int J_EXP = 16 * (2 * J_EG + J_ED);
constexpr int J_SHR = 2 * J_EG + J_ED;
constexpr int J_LAYER = J_DENSE + J_EXP + J_SHR;
constexpr int J_MOD = 2 * 192;
constexpr int J_TOTAL = 2 * J_LAYER + J_MOD;

DI void p0_prologue(const Params& p, LAS char* lds) {
  char* ws = p.ws;
  for (int job = blockIdx.x; job < J_TOTAL; job += gridDim.x) {
    if (job < J_MOD) { mod_job(p, job / 192, (job % 192) * 32, lds); continue; }
    int r = job - J_MOD;
    const int l = r / J_LAYER; r -= l * J_LAYER;
    if (r < J_WIN) { cvt_job(p.w_in + (size_t)l * 1024 * INW, INW, INW, (r / 14) * 64, (r % 14) * 128, (u16*)(ws + OFF_WIN) + (size_t)l * INWP * 1024, 1024, 0, lds); continue; } r -= J_WIN;
    if (r < J_WO) { cvt_job(p.w_out + (size_t)l * 1024 * 1024, 1024, 1024, (r / 8) * 64, (r % 8) * 128, (u16*)(ws + OFF_WO) + (size_t)l * 1024 * 1024, 1024, 0, lds); continue; } r -= J_WO;
    if (r < J_UQ) { cvt_job(p.mla_w_uq + (size_t)l * 256 * 384, 384, 384, (r / 3) * 64, (r % 3) * 128, (u16*)(ws + OFF_WUQ) + (size_t)l * 384 * 256, 256, 0, lds); continue; } r -= J_UQ;
    if (r < J_UKV) { cvt_job(p.mla_w_ukv + (size_t)l * 128 * 512, 512, 512, (r / 4) * 64, (r % 4) * 128, (u16*)(ws + OFF_WUKV) + (size_t)l * 512 * 128, 128, 0, lds); continue; } r -= J_UKV;
    if (r < J_EXP) {
      const int e = r / (2 * J_EG + J_ED); int q = r % (2 * J_EG + J_ED);
      const size_t le = (size_t)l * NE + e;
      if (q < J_EG) { cvt_job(p.exp_w_gate + le * 1024 * 512, 512, 512, (q / 4) * 64, (q % 4) * 128, (u16*)(ws + OFF_WGU) + le * 1024 * 1024, 1024, 1, lds); continue; } q -= J_EG;
      if (q < J_EG) { cvt_job(p.exp_w_up + le * 1024 * 512, 512, 512, (q / 4) * 64, (q % 4) * 128, (u16*)(ws + OFF_WGU) + le * 1024 * 1024, 1024, 2, lds); continue; } q -= J_EG;
      cvt_job(p.exp_w_down + le * 512 * 1024, 1024, 1024, (q / 8) * 64, (q % 8) * 128, (u16*)(ws + OFF_WD) + le * 1024 * 512, 512, 0, lds); continue;
    }
    r -= J_EXP;
    if (r < J_EG) { cvt_job(p.shr_w_gate + (size_t)l * 1024 * 512, 512, 512, (r / 4) * 64, (r % 4) * 128, (u16*)(ws + OFF_SGU) + (size_t)l * 1024 * 1024, 1024, 1, lds); continue; } r -= J_EG;
    if (r < J_EG) { cvt_job(p.shr_w_up + (size_t)l * 1024 * 512, 512, 512, (r / 4) * 64, (r % 4) * 128, (u16*)(ws + OFF_SGU) + (size_t)l * 1024 * 1024, 1024, 2, lds); continue; } r -= J_EG;
    cvt_job(p.shr_w_down + (size_t)l * 512 * 1024, 1024, 1024, (r / 8) * 64, (r % 8) * 128, (u16*)(ws + OFF_SD) + (size_t)l * 1024 * 512, 512, 0, lds);
  }
}

DI const float* xrow_ptr(const Params& p, int layer_src  , int row) {
  if (layer_src == 0) return row < NL ? p.x + (size_t)row * 1024 : p.ctx + (size_t)(row - NL) * 1024;
  return row < NL ? p.out + (size_t)row * 1024 : (const float*)(p.ws + OFF_CTXR) + (size_t)(row - NL) * 1024;
}
DI float* xrow_out(const Params& p, int row) {
  return row < NL ? p.out + (size_t)row * 1024 : (float*)(p.ws + OFF_CTXR) + (size_t)(row - NL) * 1024;
}

DI void norm_mod_row(f32x4 (&v)[4], const float* __restrict__ g, const float* __restrict__ md  , int lane) {
  float ss = 0.f;
#pragma unroll
  for (int i = 0; i < 4; ++i) ss += v[i].x * v[i].x + v[i].y * v[i].y + v[i].z * v[i].z + v[i].w * v[i].w;
  ss = wave_sum(ss);
  const float rstd = rsqrtf(ss * (1.f / 1024.f) + EPS);
#pragma unroll
  for (int i = 0; i < 4; ++i) {
    const f32x4 gg = *(const f32x4*)(g + lane * 4 + i * 256);
    const f32x4 sh = *(const f32x4*)(md + lane * 4 + i * 256);
    const f32x4 sc = *(const f32x4*)(md + 1024 + lane * 4 + i * 256);
    v[i] = v[i] * rstd * gg * (sc + 1.f) + sh;
  }
}
DI void store_h_row(const f32x4 (&v)[4], u16* __restrict__ hrow, int lane) {
#pragma unroll
  for (int i = 0; i < 4; ++i) {
    uint2 o; o.x = cvtpk(v[i].x, v[i].y); o.y = cvtpk(v[i].z, v[i].w);
    *(uint2*)(hrow + lane * 4 + i * 256) = o;
  }
}

DI void p1_norm_mix(const Params& p, int layer) {
  const int tid_ = opaque((int)threadIdx.x); const int lane = tid_ & 63, gw = blockIdx.x * 4 + (tid_ >> 6), ngw = gridDim.x * 4;
  const float* MODl = (const float*)(p.ws + OFF_MOD) + (size_t)layer * 9 * 6144;
  u16* H = (u16*)(p.ws + OFF_H);
  f32x4 vn[4];
  int row = gw;
  if (row < NT) { const float* xr = xrow_ptr(p, layer, row);
#pragma unroll
    for (int i = 0; i < 4; ++i) vn[i] = __builtin_nontemporal_load((const f32x4*)(xr + lane * 4 + i * 256)); }
  while (row < NT) {
    f32x4 v[4];
#pragma unroll
    for (int i = 0; i < 4; ++i) v[i] = vn[i];
    const int rown = row + ngw;
    if (rown < NT) { const float* xr = xrow_ptr(p, layer, rown);
#pragma unroll
      for (int i = 0; i < 4; ++i) vn[i] = __builtin_nontemporal_load((const f32x4*)(xr + lane * 4 + i * 256)); }
    const int mr = row < NL ? row / S_ : 8;
    norm_mod_row(v, p.norm_mix_g + layer * 1024, MODl + (size_t)mr * 6144, lane);
    store_h_row(v, H + (size_t)row * 1024, lane);
    row = rown;
  }
}

DI float max2nd4(float a, float b, float c, float d, float& m1) {
  const float ab = fmaxf(a, b), cd = fmaxf(c, d);
  m1 = fmaxf(ab, cd);
  return fmaxf(fmaxf(fminf(a, b), fminf(c, d)), fminf(ab, cd));
}
template <int CTRL> DI float dppz(float v) { return __int_as_float(__builtin_amdgcn_update_dpp(0, __float_as_int(v), CTRL, 0xf, 0xf, true)); }
DI float lane_xor4(float v, bool b2) { const float a = dppz<0x114>(v), b = dppz<0x104>(v); return b2 ? a : b; }
DI float lane_xor8(float v, bool b3) { const float a = dppz<0x118>(v), b = dppz<0x108>(v); return b3 ? a : b; }
DI bool beats(float a, int ia, float b, int ib) { return a > b || (a == b && ia < ib); }
DI void route_row(float bias_lane, const f32x4 (&v)[4], LAS char* lds, int lane, int& i0, int& i1, float& w0, float& w1) {
  const LAS f32x4* R = (const LAS f32x4*)lds;
  f32x4 pl4[4];
#pragma unroll
  for (int q = 0; q < 4; ++q) pl4[q] = (f32x4){0.f, 0.f, 0.f, 0.f};
#pragma unroll
  for (int i = 0; i < 4; ++i) {
    const int kq = i * 64 + lane;
    f32x4 wq[16];
#pragma unroll
    for (int j = 0; j < 16; ++j) wq[j] = R[j * 256 + kq];
    __builtin_amdgcn_sched_barrier(0);
#pragma unroll
    for (int kk = 0; kk < 4; ++kk) {
      const float hv = v[i][kk];
      const f32x4 hv4 = (f32x4){hv, hv, hv, hv};
#pragma unroll
      for (int q = 0; q < 4; ++q) pl4[q] = __builtin_elementwise_fma(hv4, wq[kk * 4 + q], pl4[q]);
    }
    __builtin_amdgcn_sched_barrier(0);
  }
  float pl[16];
#pragma unroll
  for (int q = 0; q < 4; ++q) { pl[q * 4 + 0] = pl4[q][0]; pl[q * 4 + 1] = pl4[q][1]; pl[q * 4 + 2] = pl4[q][2]; pl[q * 4 + 3] = pl4[q][3]; }
  const bool b0 = (lane & 1) != 0, b1 = (lane & 2) != 0, b2 = (lane & 4) != 0, b3 = (lane & 8) != 0;
  float r8[8], r4[4], r2[2];
#pragma unroll
  for (int i = 0; i < 8; ++i) { const float keep = b0 ? pl[i + 8] : pl[i], send = b0 ? pl[i] : pl[i + 8]; r8[i] = keep + dppz<0xB1>(send); }
#pragma unroll
  for (int i = 0; i < 4; ++i) { const float keep = b1 ? r8[i + 4] : r8[i], send = b1 ? r8[i] : r8[i + 4]; r4[i] = keep + dppz<0x4E>(send); }
#pragma unroll
  for (int i = 0; i < 2; ++i) { const float keep = b2 ? r4[i + 2] : r4[i], send = b2 ? r4[i] : r4[i + 2]; r2[i] = keep + lane_xor4(send, b2); }
  float lg;
  { const float keep = b3 ? r2[1] : r2[0], send = b3 ? r2[0] : r2[1]; lg = keep + lane_xor8(send, b3); }
  { auto rr = __builtin_amdgcn_permlane16_swap(__float_as_uint(lg), __float_as_uint(lg), false, false); lg = __uint_as_float(rr[0]) + __uint_as_float(rr[1]); }
  { auto rr = __builtin_amdgcn_permlane32_swap(__float_as_uint(lg), __float_as_uint(lg), false, false); lg = __uint_as_float(rr[0]) + __uint_as_float(rr[1]); }
  const float sg = __builtin_amdgcn_rcpf(1.f + __builtin_amdgcn_exp2f(-1.4426950408889634f * lg));
  const float bv = sg + bias_lane;
  const float m1v = lane_xor4(bv, b2), m2v = lane_xor8(bv, b3), m3v = lane_xor8(m1v, b3);
  float mtop; const float m2nd = max2nd4(bv, m1v, m2v, m3v, mtop);
  const float gs = mtop + m2nd;
  const float gA = dppz<0xB1>(gs), gB = dppz<0x4E>(gs), gC = dppz<0x1B>(gs);
  const int g = (b0 ? 2 : 0) + (b1 ? 1 : 0);
  const bool win = beats(gs, g, gA, g ^ 2) && beats(gs, g, gB, g ^ 1) && beats(gs, g, gC, g ^ 3);
  const int el = (b2 ? 2 : 0) + (b3 ? 1 : 0);
  const int rank = (beats(m1v, el ^ 2, bv, el) ? 1 : 0) + (beats(m2v, el ^ 1, bv, el) ? 1 : 0) + (beats(m3v, el ^ 3, bv, el) ? 1 : 0);
  const unsigned long long k0 = __ballot(win && rank == 0), k1 = __ballot(win && rank == 1);
  const int L0 = __builtin_ctzll(k0 | (1ull << 63)), L1 = __builtin_ctzll(k1 | (1ull << 63));
  const float s0 = __int_as_float(__builtin_amdgcn_readlane(__float_as_int(sg), L0));
  const float s1 = __int_as_float(__builtin_amdgcn_readlane(__float_as_int(sg), L1));
  i0 = 8 * (L0 & 1) + 4 * ((L0 >> 1) & 1) + 2 * ((L0 >> 2) & 1) + ((L0 >> 3) & 1);
  i1 = 8 * (L1 & 1) + 4 * ((L1 >> 1) & 1) + 2 * ((L1 >> 2) & 1) + ((L1 >> 3) & 1);
  const float inv = 1.f / (s0 + s1);
  w0 = s0 * inv; w1 = s1 * inv;
}

DI void load_router_lds(const Params& p, LAS char* lds) {
  LAS f32x4* R = (LAS f32x4*)lds;
  __syncthreads();
  for (int g = threadIdx.x; g < 4096; g += NTHR) {
    const int k = g >> 2, q = g & 3;
    R[((k & 3) * 4 + q) * 256 + (k >> 2)] = *(const f32x4*)(p.router_w + (size_t)g * 4);
  }
  __syncthreads();
}

constexpr int CNT_STRIDE = 64;
DI void p5_norm_ffn(const Params& p, int layer, int nrows, LAS char* lds) {
  load_router_lds(p, lds);
  const int tid = opaque((int)threadIdx.x), lane = tid & 63, wid = tid >> 6, gw = blockIdx.x * 4 + wid, ngw = gridDim.x * 4;
  const float* MODl = (const float*)(p.ws + OFF_MOD) + (size_t)layer * 9 * 6144;
  u16* H = (u16*)(p.ws + OFF_H);
  volatile LAS int* lcnt = (volatile LAS int*)(lds + LDS_MISC + 3072);
  volatile LAS int* lbase = lcnt + 16;
  volatile LAS int* stash = (volatile LAS int*)(lds + LDS_MISC + 4096) + wid * 160;
  int* tok_e = (int*)(p.ws + OFF_TOKE); float* tok_w = (float*)(p.ws + OFF_TOKW); int* tok_p = (int*)(p.ws + OFF_TOKP);
  int* list = (int*)(p.ws + OFF_LIST);
  unsigned* cnt = (unsigned*)(p.ws + OFF_CTRL) + CW_CNT + layer * 16 * CNT_STRIDE;
  if (tid < 16) lcnt[tid] = 0;
  __syncthreads();
  const float bias = p.router_bias[8 * (lane & 1) + 4 * ((lane >> 1) & 1) + 2 * ((lane >> 2) & 1) + ((lane >> 3) & 1)];
  int nst = 0;
  f32x4 vn[4]; u32x2_t dn[4];
  const u16* DELTA = (const u16*)(p.ws + OFF_DELTA);
  if (gw < nrows) { const float* xr0 = xrow_ptr(p, layer, gw);
#pragma unroll
    for (int i = 0; i < 4; ++i) { vn[i] = __builtin_nontemporal_load((const f32x4*)(xr0 + lane * 4 + i * 256)); dn[i] = __builtin_nontemporal_load((const u32x2_t*)(DELTA + (size_t)gw * 1024 + lane * 4 + i * 256)); } }
  for (int row = gw; row < nrows; row += ngw) {
    f32x4 v[4];
#pragma unroll
    for (int i = 0; i < 4; ++i) { v[i] = vn[i]; v[i][0] += bflo(dn[i][0]); v[i][1] += bfhi(dn[i][0]); v[i][2] += bflo(dn[i][1]); v[i][3] += bfhi(dn[i][1]); }
    if (row + ngw < nrows) { const float* xrn = xrow_ptr(p, layer, row + ngw);
#pragma unroll
      for (int i = 0; i < 4; ++i) { vn[i] = __builtin_nontemporal_load((const f32x4*)(xrn + lane * 4 + i * 256)); dn[i] = __builtin_nontemporal_load((const u32x2_t*)(DELTA + (size_t)(row + ngw) * 1024 + lane * 4 + i * 256)); } }
    { float* xw = xrow_out(p, row);
#pragma unroll
      for (int i = 0; i < 4; ++i) *(f32x4*)(xw + lane * 4 + i * 256) = v[i]; }
    const int mr = row < NL ? row / S_ : 8;
    norm_mod_row(v, p.norm_ffn_g + layer * 1024, MODl + (size_t)mr * 6144 + 3 * 1024, lane);
    store_h_row(v, H + (size_t)row * 1024, lane);
    int i0, i1; float w0, w1;
    route_row(bias, v, lds, lane, i0, i1, w0, w1);
    if (lane == 0) {
      const int lp0 = __hip_atomic_fetch_add((LAS int*)&lcnt[i0], 1, __ATOMIC_RELAXED, __HIP_MEMORY_SCOPE_WORKGROUP);
      const int lp1 = __hip_atomic_fetch_add((LAS int*)&lcnt[i1], 1, __ATOMIC_RELAXED, __HIP_MEMORY_SCOPE_WORKGROUP);
      tok_e[row * 2] = i0; tok_e[row * 2 + 1] = i1;
      tok_w[row * 2] = w0; tok_w[row * 2 + 1] = w1;
      stash[nst * 4 + 0] = i0; stash[nst * 4 + 1] = lp0; stash[nst * 4 + 2] = i1; stash[nst * 4 + 3] = lp1;
    }
    ++nst;
  }
  __syncthreads();
  if (tid < 16) { const int c = lcnt[tid]; lbase[tid] = c > 0 ? (int)atomicAdd(&cnt[tid * CNT_STRIDE], (unsigned)c) : 0; }
  __syncthreads();
  if (lane == 0) {
    int k = 0;
    for (int row = gw; row < nrows; row += ngw, ++k) {
      const int e0 = stash[k * 4 + 0], e1 = stash[k * 4 + 2];
      const int p0 = lbase[e0] + stash[k * 4 + 1], p1 = lbase[e1] + stash[k * 4 + 3];
      tok_p[row * 2] = p0; tok_p[row * 2 + 1] = p1;
      list[(size_t)e0 * NT + p0] = row; list[(size_t)e1 * NT + p1] = row;
    }
  }
}

DI void seg_scan(const Params& p, int layer, int (&tb)[NE + 1]) {
  const unsigned* cnt = (const unsigned*)(p.ws + OFF_CTRL) + CW_CNT + layer * 16 * CNT_STRIDE;
  int acc = 0;
#pragma unroll
  for (int e = 0; e < NE; ++e) { tb[e] = acc; acc += ((int)cnt[e * CNT_STRIDE] + 127) >> 7; }
  tb[NE] = acc;
}

DI void p8_combine(const Params& p, int layer, int nrows) {
  const int tid_ = opaque((int)threadIdx.x); const int lane = tid_ & 63, gw = blockIdx.x * 4 + (tid_ >> 6), ngw = gridDim.x * 4;
  const float* MODl = (const float*)(p.ws + OFF_MOD) + (size_t)layer * 9 * 6144;
  const float* MODn = (const float*)(p.ws + OFF_MOD) + (size_t)(layer + 1) * 9 * 6144;
  u16* H = (u16*)(p.ws + OFF_H);
  const u16* YSH = (const u16*)(p.ws + OFF_YSH);
  const u16* YEXP = (const u16*)(p.ws + OFF_YEXP);
  const int* tok_e = (const int*)(p.ws + OFF_TOKE); const float* tok_w = (const float*)(p.ws + OFF_TOKW); const int* tok_p = (const int*)(p.ws + OFF_TOKP);
  int tb[NE + 1]; seg_scan(p, layer, tb);
  int me0 = 0, me1 = 0, mp0 = 0, mp1 = 0; float mw0 = 0.f, mw1 = 0.f;
  u32x2_t an[4], bn[4], cn[4]; f32x4 xn[4]; float nw0 = 0.f, nw1 = 0.f;
#define P8_META(r) do { me0 = tok_e[(r) * 2]; me1 = tok_e[(r) * 2 + 1]; mp0 = tok_p[(r) * 2]; mp1 = tok_p[(r) * 2 + 1]; mw0 = tok_w[(r) * 2]; mw1 = tok_w[(r) * 2 + 1]; } while (0)
#define P8_DATA(r) do { int ps0 = 0, ps1 = 0; _Pragma("unroll") for (int e = 0; e < NE; ++e) { if (e == me0) ps0 = tb[e]; if (e == me1) ps1 = tb[e]; } \
    const size_t s0 = (size_t)ps0 * 128 + mp0, s1 = (size_t)ps1 * 128 + mp1; nw0 = mw0; nw1 = mw1; const float* xrn = xrow_out(p, (r)); \
    _Pragma("unroll") for (int i = 0; i < 4; ++i) { const int cidx = lane * 4 + i * 256; \
      an[i] = __builtin_nontemporal_load((const u32x2_t*)(YEXP + s0 * 1024 + cidx)); bn[i] = __builtin_nontemporal_load((const u32x2_t*)(YEXP + s1 * 1024 + cidx)); \
      cn[i] = __builtin_nontemporal_load((const u32x2_t*)(YSH + (size_t)(r) * 1024 + cidx)); xn[i] = __builtin_nontemporal_load((const f32x4*)(xrn + cidx)); } } while (0)
  if (gw < nrows) { P8_META(gw); P8_DATA(gw); }
  if (gw + ngw < nrows) P8_META(gw + ngw);
  for (int row = gw; row < nrows; row += ngw) {
    u32x2_t a[4], b[4], c[4]; f32x4 v[4];
#pragma unroll
    for (int i = 0; i < 4; ++i) { a[i] = an[i]; b[i] = bn[i]; c[i] = cn[i]; v[i] = xn[i]; }
    const float w0 = nw0, w1 = nw1;
    if (row + ngw < nrows) P8_DATA(row + ngw);
    if (row + 2 * ngw < nrows) P8_META(row + 2 * ngw);
    float* xr = xrow_out(p, row);
    const int mr = row < NL ? row / S_ : 8;
    const float* gate = MODl + (size_t)mr * 6144 + 5 * 1024;
#pragma unroll
    for (int i = 0; i < 4; ++i) {
      const int cidx = lane * 4 + i * 256;
      const f32x4 g = *(const f32x4*)(gate + cidx);
      f32x4 x = v[i];
      x.x += g.x * (w0 * bflo(a[i][0]) + w1 * bflo(b[i][0]) + bflo(c[i][0]));
      x.y += g.y * (w0 * bfhi(a[i][0]) + w1 * bfhi(b[i][0]) + bfhi(c[i][0]));
      x.z += g.z * (w0 * bflo(a[i][1]) + w1 * bflo(b[i][1]) + bflo(c[i][1]));
      x.w += g.w * (w0 * bfhi(a[i][1]) + w1 * bfhi(b[i][1]) + bfhi(c[i][1]));
      v[i] = x;
    }
    if (layer == 0) {
#pragma unroll
      for (int i = 0; i < 4; ++i) __builtin_nontemporal_store(v[i], (f32x4*)(xr + lane * 4 + i * 256));
      norm_mod_row(v, p.norm_mix_g + 1024, MODn + (size_t)mr * 6144, lane);
      store_h_row(v, H + (size_t)row * 1024, lane);
    } else {
      float ss = 0.f;
#pragma unroll
      for (int i = 0; i < 4; ++i) ss += v[i].x * v[i].x + v[i].y * v[i].y + v[i].z * v[i].z + v[i].w * v[i].w;
      ss = wave_sum(ss);
      const float rstd = rsqrtf(ss * (1.f / 1024.f) + EPS);
#pragma unroll
      for (int i = 0; i < 4; ++i) {
        const f32x4 gg = *(const f32x4*)(p.final_norm_g + lane * 4 + i * 256);
        __builtin_nontemporal_store(v[i] * rstd * gg, (f32x4*)(xr + lane * 4 + i * 256));
      }
    }
  }
#undef P8_META
#undef P8_DATA
}

DI void glds16(const u16* g, LAS char* l) {
  __builtin_amdgcn_global_load_lds((const void*)g, (LAS void*)l, 16, 0, 0);
}
struct TilePtrs { const u16 *a0, *a1, *b0, *b1; };
#define GT_ISSUE_P(T, kt, s) do { const int _ko = (kt) * 64; LAS char* _d = ldst + (s) * 32768; \
    glds16((T).a0 + _ko, _d); glds16((T).a1 + _ko, _d + 4096); glds16((T).a0 + _ko + 32, _d + 8192); glds16((T).a1 + _ko + 32, _d + 12288); \
    glds16((T).b0 + _ko, _d + 16384); glds16((T).b1 + _ko, _d + 20480); glds16((T).b0 + _ko + 32, _d + 24576); glds16((T).b1 + _ko + 32, _d + 28672); } while (0)
template <bool HOIST = true>
DI void gemm_tile_s(LAS char* lds, const TilePtrs& cur, bool issued, const TilePtrs& nxt, bool has_next, int nk, f32x4 (&acc)[4][4]) {
  const int tid = opaque((int)threadIdx.x), lane = tid & 63, wid = tid >> 6, wr = wid >> 1, wc = wid & 1, fr = lane & 15, fq = lane >> 4;
  const int cx = (fq ^ ((0 - (fr >> 2)) & 3)) * 16;
  const int aoff = (wr * 64 + fr) * 64 + cx;
  const int boff = 16384 + (wc * 64 + fr) * 64 + cx;
#pragma unroll
  for (int m = 0; m < 4; ++m)
#pragma unroll
    for (int n = 0; n < 4; ++n) acc[m][n] = (f32x4){0.f, 0.f, 0.f, 0.f};
  LAS char* ldst = lds + tid * 16;
  if (!issued) GT_ISSUE_P(cur, 0, 0);
#pragma unroll 1
  for (int kt = 0; kt < nk; ++kt) {
    asm volatile("s_waitcnt vmcnt(0)" ::: "memory");
    __syncthreads();
    if (kt + 1 < nk) GT_ISSUE_P(cur, kt + 1, (kt + 1) & 1);
    else if (has_next) GT_ISSUE_P(nxt, 0, 0);
    const LAS char* sb = lds + (kt & 1) * 32768;
    if (!HOIST) {
#pragma unroll
      for (int h = 0; h < 2; ++h) {
        bf16x8 af1[4], bf1[4];
#pragma unroll
        for (int m = 0; m < 4; ++m) af1[m] = *(const LAS bf16x8*)(sb + h * 8192 + aoff + m * 1024);
#pragma unroll
        for (int n = 0; n < 4; ++n) bf1[n] = *(const LAS bf16x8*)(sb + h * 8192 + boff + n * 1024);
#pragma unroll
        for (int m = 0; m < 4; ++m)
#pragma unroll
          for (int n = 0; n < 4; ++n) acc[m][n] = __builtin_amdgcn_mfma_f32_16x16x32_bf16(bf1[n], af1[m], acc[m][n], 0, 0, 0);
      }
      continue;
    }
    bf16x8 af[2][4], bfr[2][4];
    const unsigned aad = (unsigned)(size_t)(sb + aoff), bad = (unsigned)(size_t)(sb + boff);
#define GT_LDR(dst, ad, off) asm volatile("ds_read_b128 %0, %1 offset:%c2" : "=v"(dst) : "v"(ad), "i"(off))
    GT_LDR(af[0][0], aad, 0); GT_LDR(af[0][1], aad, 1024); GT_LDR(af[0][2], aad, 2048); GT_LDR(af[0][3], aad, 3072);
    GT_LDR(bfr[0][0], bad, 0); GT_LDR(bfr[0][1], bad, 1024); GT_LDR(bfr[0][2], bad, 2048); GT_LDR(bfr[0][3], bad, 3072);
    GT_LDR(af[1][0], aad, 8192); GT_LDR(af[1][1], aad, 8192 + 1024); GT_LDR(af[1][2], aad, 8192 + 2048); GT_LDR(af[1][3], aad, 8192 + 3072);
    GT_LDR(bfr[1][0], bad, 8192); GT_LDR(bfr[1][1], bad, 8192 + 1024); GT_LDR(bfr[1][2], bad, 8192 + 2048); GT_LDR(bfr[1][3], bad, 8192 + 3072);
#undef GT_LDR
    asm volatile("s_waitcnt lgkmcnt(8)" : "+v"(af[0][0]), "+v"(af[0][1]), "+v"(af[0][2]), "+v"(af[0][3]), "+v"(bfr[0][0]), "+v"(bfr[0][1]), "+v"(bfr[0][2]), "+v"(bfr[0][3]) :: "memory");
    __builtin_amdgcn_sched_barrier(0);
#pragma unroll
    for (int m = 0; m < 4; ++m)
#pragma unroll
      for (int n = 0; n < 4; ++n) acc[m][n] = __builtin_amdgcn_mfma_f32_16x16x32_bf16(bfr[0][n], af[0][m], acc[m][n], 0, 0, 0);
    __builtin_amdgcn_sched_barrier(0);
    asm volatile("s_waitcnt lgkmcnt(0)" : "+v"(af[1][0]), "+v"(af[1][1]), "+v"(af[1][2]), "+v"(af[1][3]), "+v"(bfr[1][0]), "+v"(bfr[1][1]), "+v"(bfr[1][2]), "+v"(bfr[1][3]) :: "memory");
    __builtin_amdgcn_sched_barrier(0);
#pragma unroll
    for (int m = 0; m < 4; ++m)
#pragma unroll
      for (int n = 0; n < 4; ++n) acc[m][n] = __builtin_amdgcn_mfma_f32_16x16x32_bf16(bfr[1][n], af[1][m], acc[m][n], 0, 0, 0);
    __builtin_amdgcn_sched_barrier(0);
  }
}
DI void gemm_tile(LAS char* lds, const u16* a0, const u16* a1, const u16* b0, const u16* b1, int nk, f32x4 (&acc)[4][4]) {
  TilePtrs t; t.a0 = a0; t.a1 = a1; t.b0 = b0; t.b1 = b1;
  gemm_tile_s<false>(lds, t, false, t, false, nk, acc);
  __syncthreads();
}
DI int gt_chunk(int tid) { return (((tid & 3) ^ ((0 - ((tid >> 4) & 3)) & 3))) * 8; }
DI int gt_row0(int tid) { return tid >> 2; }

DI void sincos_rev(float pos, float invf, float& sn, float& cs) {
  float rev = pos * invf * 0.15915494309189535f;
  rev -= rintf(rev);
  sn = __builtin_amdgcn_sinf(rev); cs = __builtin_amdgcn_cosf(rev);
}
DI void st_bf4(u16* dst, const f32x4& v) { uint2 o; o.x = cvtpk(v[0], v[1]); o.y = cvtpk(v[2], v[3]); *(uint2*)dst = o; }


DI void stage_put4(LAS char* st, int row, int c8, const f32x4& v) {
  u32x2_t o; o[0] = cvtpk(v[0], v[1]); o[1] = cvtpk(v[2], v[3]);
  *(LAS u32x2_t*)(st + row * 128 + ((c8 ^ (row & 15)) * 8)) = o;
}
DI u32x4_t stage_get16(const LAS char* st, int row, int u) {
  u32x4_t v = *(const LAS u32x4_t*)(st + row * 128 + ((u ^ ((row >> 1) & 7)) * 16));
  if (row & 1) v = __builtin_shufflevector(v, v, 2, 3, 0, 1);
  return v;
}
template <int NC>
DI void stage_flush(const LAS char* st, u16* dst, size_t ld, int lane) {
  constexpr int UPR = NC / 8;
  constexpr int RPI = 64 / UPR;
#pragma unroll
  for (int i = 0; i < 64 / RPI; ++i) {
    const int row = i * RPI + lane / UPR, u = lane % UPR;
    const u32x4_t v = stage_get16(st, row, u);
    *(u32x4_t*)(dst + (size_t)row * ld + u * 8) = v;
  }
}

DI void epi_inproj(const Params& p, int layer, f32x4 (&acc)[4][4], int m0, int seg, int wr, int fr, int fq, LAS float* rowss_slot, LAS char* stg, int lane) {
  char* ws = p.ws;
  const bool lat = m0 < NL;
  const int rbase = m0 + wr * 64 + fr;
  u16* dst; int ld, cb; int kind;
  if (seg < 6) { dst = (u16*)(ws + OFF_SWQ); ld = 384; cb = seg * 64; kind = 1; }
  else if (seg < 8) { dst = (u16*)(ws + OFF_SWK); ld = 128; cb = (seg - 6) * 64; kind = 1; }
  else if (seg < 10) { dst = (u16*)(ws + OFF_SWV); ld = 128; cb = (seg - 8) * 64; kind = 0; }
  else if (seg < 16) { dst = (u16*)(ws + OFF_GLQ); ld = 384; cb = (seg - 10) * 64; kind = 2; }
  else if (seg < 18) { dst = (u16*)(ws + OFF_GLK); ld = 128; cb = (seg - 16) * 64; kind = 3; }
  else if (seg < 20) { dst = (u16*)(ws + OFF_GLV); ld = 128; cb = (seg - 18) * 64; kind = 0; }
  else if (seg < 24) { dst = (u16*)(ws + OFF_QLAT); ld = 256; cb = (seg - 20) * 64; kind = 4; }
  else if (seg < 26) { dst = (u16*)(ws + OFF_KVLAT); ld = 128; cb = (seg - 24) * 64; kind = 5; }
  else if (seg == 26) { dst = (u16*)(ws + OFF_MLKR); ld = 32; cb = 0; kind = 6; }
  else return;
  if (kind == 2 || kind == 3) {
    const float* gain = (kind == 2 ? p.glb_q_gain : p.glb_k_gain) + layer * 64;
    f32x4 gv[4];
#pragma unroll
    for (int n = 0; n < 4; ++n) gv[n] = *(const f32x4*)(gain + n * 16 + fq * 4);
#pragma unroll
    for (int m = 0; m < 4; ++m) {
      float ss = 0.f;
#pragma unroll
      for (int n = 0; n < 4; ++n) ss += acc[m][n][0] * acc[m][n][0] + acc[m][n][1] * acc[m][n][1] + acc[m][n][2] * acc[m][n][2] + acc[m][n][3] * acc[m][n][3];
      ss += __shfl_xor(ss, 16); ss += __shfl_xor(ss, 32);
      const float r = rsqrtf(ss * (1.f / 64.f) + EPS);
#pragma unroll
      for (int n = 0; n < 4; ++n) acc[m][n] = acc[m][n] * r * gv[n];
    }
  }
  if (kind == 4 || kind == 5) {
    const float* gain = (kind == 4 ? p.mla_q_gain + layer * 256 : p.mla_kv_gain + layer * 128) + cb;
    f32x4 gv[4];
#pragma unroll
    for (int n = 0; n < 4; ++n) gv[n] = *(const f32x4*)(gain + n * 16 + fq * 4);
#pragma unroll
    for (int m = 0; m < 4; ++m) {
      float ss = 0.f;
#pragma unroll
      for (int n = 0; n < 4; ++n) ss += acc[m][n][0] * acc[m][n][0] + acc[m][n][1] * acc[m][n][1] + acc[m][n][2] * acc[m][n][2] + acc[m][n][3] * acc[m][n][3];
      ss += __shfl_xor(ss, 16); ss += __shfl_xor(ss, 32);
      if (fq == 0) rowss_slot[wr * 64 + m * 16 + fr] = ss;
#pragma unroll
      for (int n = 0; n < 4; ++n) acc[m][n] = acc[m][n] * gv[n];
    }
  }
  if (lat && (kind == 1 || kind == 2 || kind == 3)) {
    float invf[4];
#pragma unroll
    for (int j = 0; j < 4; ++j) invf[j] = __builtin_amdgcn_exp2f(-(float)(fq * 4 + j) * (13.287712379549449f / 16.f));
#pragma unroll
    for (int m = 0; m < 4; ++m) {
      const int t = (rbase + m * 16) & (S_ - 1);
      const float prow = (float)(t >> 6), pcol = (float)(t & 63);
#pragma unroll
      for (int j = 0; j < 4; ++j) {
        float sr, cr, sc, cc;
        sincos_rev(prow, invf[j], sr, cr); sincos_rev(pcol, invf[j], sc, cc);
        float x1 = acc[m][0][j], x2 = acc[m][1][j];
        acc[m][0][j] = x1 * cr - x2 * sr; acc[m][1][j] = x2 * cr + x1 * sr;
        x1 = acc[m][2][j]; x2 = acc[m][3][j];
        acc[m][2][j] = x1 * cc - x2 * sc; acc[m][3][j] = x2 * cc + x1 * sc;
      }
    }
  }
  if (kind == 6) {
    if (lat) {
      float invf[4];
#pragma unroll
      for (int j = 0; j < 4; ++j) invf[j] = __builtin_amdgcn_exp2f(-(float)((fq & 1) * 4 + j) * (13.287712379549449f / 8.f));
#pragma unroll
      for (int m = 0; m < 4; ++m) {
        const int t = (rbase + m * 16) & (S_ - 1);
#pragma unroll
        for (int n = 0; n < 2; ++n) {
          const float pos = n == 0 ? (float)(t >> 6) : (float)(t & 63);
#pragma unroll
          for (int j = 0; j < 4; ++j) {
            float sn, cs; sincos_rev(pos, invf[j], sn, cs);
            const float v = acc[m][n][j], pr = __shfl_xor(v, 32);
            acc[m][n][j] = (fq & 2) ? v * cs + pr * sn : v * cs - pr * sn;
          }
        }
      }
    }
#pragma unroll
    for (int m = 0; m < 4; ++m)
#pragma unroll
      for (int n = 0; n < 2; ++n) stage_put4(stg, m * 16 + fr, n * 4 + fq, acc[m][n]);
    stage_flush<32>(stg, dst + (size_t)(m0 + wr * 64) * ld, ld, lane);
    return;
  }
#pragma unroll
  for (int m = 0; m < 4; ++m)
#pragma unroll
    for (int n = 0; n < 4; ++n) stage_put4(stg, m * 16 + fr, n * 4 + fq, acc[m][n]);
  stage_flush<64>(stg, dst + (size_t)(m0 + wr * 64) * ld + cb, ld, lane);
}

DI void p2_inproj(const Params& p, int layer, LAS char* lds, int cs = 0) {
  char* ws = p.ws;
  unsigned* ctr = (unsigned*)(ws + OFF_CTRL) + CW_CTR + layer * 16 + 2 + cs;
  const u16* H = (const u16*)(ws + OFF_H);
  const u16* WinT = (const u16*)(ws + OFF_WIN) + (size_t)layer * INWP * 1024;
  const u16* WuqT = (const u16*)(ws + OFF_WUQ) + (size_t)layer * 384 * 256;
  const u16* WukvT = (const u16*)(ws + OFF_WUKV) + (size_t)layer * 512 * 128;
  const int tid = opaque((int)threadIdx.x), lane = tid & 63, wid = tid >> 6, wr = wid >> 1, wc = wid & 1;
  LAS float* rowss = (LAS float*)(lds + LDS_MISC);
  LAS float* rstd = (LAS float*)(lds + LDS_MISC + 2048);
  unsigned* ctr8 = (unsigned*)(ws + OFF_CTRL) + CW_Q + (layer * 2 + 1) * 512;
  f32x4 acc[4][4];
  for (;;) {
    const int u = next_unit_xcd(ctr8, (NT / 128 / 8) * 12, lds);
    if (u < 0) break;
    const int tid_o = opaque(tid), lane_o = tid_o & 63;
    const int fr = lane_o & 15, fq = lane_o >> 4, ch = gt_chunk(tid_o), r0 = gt_row0(tid_o);
    const int qx = u / 408, v = u % 408;
    int rt, k;
    if (v < 34) { rt = qx * 34 + v; k = 10; } else if (v < 68) { rt = qx * 34 + v - 34; k = 11; } else { rt = qx * 34 + (v - 68) / 10; k = (v - 68) % 10; }
    const int m0 = rt * 128;
    const u16* a0 = H + (size_t)(m0 + r0) * 1024 + ch;
    const u16* a1 = a0 + (size_t)64 * 1024;
    if (k < 10) {
      const u16* b0 = WinT + (size_t)(k * 128 + r0) * 1024 + ch;
      gemm_tile(lds, a0, a1, b0, b0 + (size_t)64 * 1024, 16, acc);
      epi_inproj(p, layer, acc, m0, k * 2 + wc, wr, fr, fq, rowss, lds + 32768 + wid * 8192, lane_o);
    } else if (k == 10) {
#pragma unroll 1
      for (int t = 0; t < 2; ++t) {
        const u16* b0 = WinT + (size_t)(1280 + t * 128 + r0) * 1024 + ch;
        gemm_tile(lds, a0, a1, b0, b0 + (size_t)64 * 1024, 16, acc);
        epi_inproj(p, layer, acc, m0, 20 + t * 2 + wc, wr, fr, fq, rowss + (t * 2 + wc) * 128, lds + 32768 + wid * 8192, lane_o);
      }
      __syncthreads();
      if (tid < 128) rstd[tid] = rsqrtf((rowss[tid] + rowss[128 + tid] + rowss[256 + tid] + rowss[384 + tid]) * (1.f / 256.f) + EPS);
      __syncthreads();
      const u16* QL = (const u16*)(ws + OFF_QLAT);
      const u16* qa0 = QL + (size_t)(m0 + r0) * 256 + ch;
      const u16* qa1 = qa0 + (size_t)64 * 256;
      u16* MLQ = (u16*)(ws + OFF_MLQ);
      const bool lat = m0 < NL;
#pragma unroll 1
      for (int t = 0; t < 3; ++t) {
        const u16* b0 = WuqT + (size_t)(t * 128 + r0) * 256 + ch;
        gemm_tile(lds, qa0, qa1, b0, b0 + (size_t)64 * 256, 4, acc);
        const int c0 = t * 128 + wc * 64;
        float invf[4];
#pragma unroll
        for (int j = 0; j < 4; ++j) invf[j] = __builtin_amdgcn_exp2f(-(float)((fq & 1) * 4 + j) * (13.287712379549449f / 8.f));
#pragma unroll
        for (int m = 0; m < 4; ++m) {
          const int rl = wr * 64 + m * 16 + fr;
          const float rs = rstd[rl];
          const int tpos = (m0 + rl) & (S_ - 1);
#pragma unroll
          for (int n = 0; n < 4; ++n) {
            acc[m][n] = acc[m][n] * rs;
            const int w96 = (c0 + n * 16) % 96;
            if (lat && w96 >= 64) {
              const float pos = (w96 == 64) ? (float)(tpos >> 6) : (float)(tpos & 63);
#pragma unroll
              for (int j = 0; j < 4; ++j) {
                float sn, cs; sincos_rev(pos, invf[j], sn, cs);
                const float v = acc[m][n][j], pr = __shfl_xor(v, 32);
                acc[m][n][j] = (fq & 2) ? v * cs + pr * sn : v * cs - pr * sn;
              }
            }
            stage_put4(lds + 32768 + wid * 8192, m * 16 + fr, n * 4 + fq, acc[m][n]);
          }
        }
        stage_flush<64>(lds + 32768 + wid * 8192, MLQ + (size_t)(m0 + wr * 64) * 384 + c0, 384, lane_o);
      }
    } else {
      {
        const u16* b0 = WinT + (size_t)(1536 + r0) * 1024 + ch;
        gemm_tile(lds, a0, a1, b0, b0 + (size_t)64 * 1024, 16, acc);
        epi_inproj(p, layer, acc, m0, 24 + wc, wr, fr, fq, rowss + wc * 128, lds + 32768 + wid * 8192, lane_o);
        const u16* b2 = WinT + (size_t)(1664 + r0) * 1024 + ch;
        gemm_tile(lds, a0, a1, b2, b2 + (size_t)64 * 1024, 16, acc);
        epi_inproj(p, layer, acc, m0, 26 + wc, wr, fr, fq, rowss, lds + 32768 + wid * 8192, lane_o);
      }
      __syncthreads();
      if (tid < 128) rstd[tid] = rsqrtf((rowss[tid] + rowss[128 + tid]) * (1.f / 128.f) + EPS);
      __syncthreads();
      const u16* KL = (const u16*)(ws + OFF_KVLAT);
      const u16* ka0 = KL + (size_t)(m0 + r0) * 128 + ch;
      const u16* ka1 = ka0 + (size_t)64 * 128;
#pragma unroll 1
      for (int t = 0; t < 4; ++t) {
        const u16* b0 = WukvT + (size_t)(t * 128 + r0) * 128 + ch;
        gemm_tile(lds, ka0, ka1, b0, b0 + (size_t)64 * 128, 2, acc);
        u16* dst = (u16*)(ws + (wc == 0 ? OFF_MLK : OFF_MLV));
#pragma unroll
        for (int m = 0; m < 4; ++m) {
          const int rl = wr * 64 + m * 16 + fr;
          const float rs = rstd[rl];
#pragma unroll
          for (int n = 0; n < 4; ++n) { acc[m][n] = acc[m][n] * rs; stage_put4(lds + 32768 + wid * 8192, m * 16 + fr, n * 4 + fq, acc[m][n]); }
        }
        stage_flush<64>(lds + 32768 + wid * 8192, dst + (size_t)(m0 + wr * 64) * 256 + t * 64, 256, lane_o);
      }
    }
  }
}

DI void p4_outproj(const Params& p, int layer, int nrows, LAS char* lds, int cs = 0) {
  char* ws = p.ws;
  const u16* Y = (const u16*)(ws + OFF_Y);
  const u16* WoT = (const u16*)(ws + OFF_WO) + (size_t)layer * 1024 * 1024;
  const float* MODl = (const float*)(ws + OFF_MOD) + (size_t)layer * 9 * 6144;
  const int tid = opaque((int)threadIdx.x), wid = tid >> 6, wr = wid >> 1, wc = wid & 1;
  const int nunits = (nrows / 128) * 8;
  f32x4 acc[4][4];
  __syncthreads();
  TilePtrs cur, nxt;
  int u = (int)((blockIdx.x & 7) * (gridDim.x >> 3) + (blockIdx.x >> 3));
#define P4_DESC(T, uu) do { const int _t = opaque(tid); const int _ch = gt_chunk(_t), _r0 = gt_row0(_t); const int _rt = (uu) >> 3, _ct = (uu) & 7; \
    (T).a0 = Y + (size_t)(_rt * 128 + _r0) * 1024 + _ch; (T).a1 = (T).a0 + (size_t)64 * 1024; \
    (T).b0 = WoT + (size_t)(_ct * 128 + _r0) * 1024 + _ch; (T).b1 = (T).b0 + (size_t)64 * 1024; } while (0)
  bool issued = false;
  if (u < nunits) P4_DESC(cur, u);
  while (u < nunits) {
    const int un = u + gridDim.x;
    const bool hn = un < nunits;
    if (hn) P4_DESC(nxt, un); else nxt = cur;
    gemm_tile_s(lds, cur, issued, nxt, hn, 16, acc);
    issued = hn;
    const int tid_o = opaque(tid), lane_o = tid_o & 63;
    const int fr = lane_o & 15, fq = lane_o >> 4;
    const int rt = u >> 3, ct = u & 7, m0 = rt * 128;
    const int mr = m0 < NL ? m0 / S_ : 8;
    const float* gate = MODl + (size_t)mr * 6144 + 2 * 1024 + ct * 128 + wc * 64 + fq * 4;
    __syncthreads();
    LAS char* stg = lds + 32768 + wid * 8192;
#pragma unroll
    for (int n = 0; n < 4; ++n) {
      const f32x4 g = *(const f32x4*)(gate + n * 16);
#pragma unroll
      for (int m = 0; m < 4; ++m) stage_put4(stg, m * 16 + fr, n * 4 + fq, g * acc[m][n]);
    }
    stage_flush<64>(stg, (u16*)(ws + OFF_DELTA) + (size_t)(m0 + wr * 64) * 1024 + ct * 128 + wc * 64, 1024, lane_o);
    cur = nxt; u = un;
  }
#undef P4_DESC
  __syncthreads();
}

DI void p6_gateup(const Params& p, int layer, int nrows, LAS char* lds, int cs = 0) {
  char* ws = p.ws;
  const unsigned* cnt = (const unsigned*)(ws + OFF_CTRL) + CW_CNT + layer * 16 * CNT_STRIDE;
  const u16* H = (const u16*)(ws + OFF_H);
  const int* list = (const int*)(ws + OFF_LIST);
  const u16* WguT = (const u16*)(ws + OFF_WGU) + (size_t)layer * NE * 1024 * 1024;
  const u16* SguT = (const u16*)(ws + OFF_SGU) + (size_t)layer * 1024 * 1024;
  u16* ACT = (u16*)(ws + OFF_ACT); u16* ACTS = (u16*)(ws + OFF_ACTS);
  const int tid = opaque((int)threadIdx.x), wid = tid >> 6, wr = wid >> 1, wc = wid & 1;
  int tb[NE + 1]; seg_scan(p, layer, tb);
  const int R = tb[NE];
  const int nunits = (R + nrows / 128) * 8;
  f32x4 acc[4][4];
  __syncthreads();
  TilePtrs cur, nxt;
#define P6_DESC(T, uu) do { const int _t = opaque(tid); const int _ch = gt_chunk(_t), _r0 = gt_row0(_t); const int _rt = (uu) >> 3, _ct = (uu) & 7; \
    if (_rt < R) { int _e = 0, _tbe = 0; _Pragma("unroll") for (int q = 1; q < NE; ++q) if (_rt >= tb[q]) { _e = q; _tbe = tb[q]; } \
      const int _i = _rt - _tbe, _ce = (int)cnt[_e * CNT_STRIDE]; const int _i0 = _i * 128 + _r0, _i1 = _i0 + 64; \
      const int _t0 = _i0 < _ce ? list[(size_t)_e * NT + _i0] : 0, _t1 = _i1 < _ce ? list[(size_t)_e * NT + _i1] : 0; \
      (T).a0 = H + (size_t)_t0 * 1024 + _ch; (T).a1 = H + (size_t)_t1 * 1024 + _ch; \
      (T).b0 = WguT + ((size_t)_e * 1024 + _ct * 128 + _r0) * 1024 + _ch; } \
    else { const int _m0 = (_rt - R) * 128; (T).a0 = H + (size_t)(_m0 + _r0) * 1024 + _ch; (T).a1 = (T).a0 + (size_t)64 * 1024; \
      (T).b0 = SguT + (size_t)(_ct * 128 + _r0) * 1024 + _ch; } \
    (T).b1 = (T).b0 + (size_t)64 * 1024; } while (0)
  int u = (int)((blockIdx.x & 7) * (gridDim.x >> 3) + (blockIdx.x >> 3));
  bool issued = false;
  if (u < nunits) P6_DESC(cur, u);
  while (u < nunits) {
    const int un = u + gridDim.x;
    const bool hn = un < nunits;
    if (hn) P6_DESC(nxt, un); else nxt = cur;
    gemm_tile_s(lds, cur, issued, nxt, hn, 16, acc);
    issued = hn;
    const int tid_o = opaque(tid), lane_o = tid_o & 63;
    const int fr = lane_o & 15, fq = lane_o >> 4;
    const int rt = u >> 3, ct = u & 7;
    u16* dst; size_t orow;
    if (rt < R) { dst = ACT; orow = (size_t)rt * 128; } else { dst = ACTS; orow = (size_t)(rt - R) * 128; }
    __syncthreads();
    LAS char* stg = lds + 32768 + wid * 8192;
#pragma unroll
    for (int m = 0; m < 4; ++m)
#pragma unroll
      for (int n = 0; n < 2; ++n) {
        f32x4 r;
#pragma unroll
        for (int j = 0; j < 4; ++j) r[j] = silu(acc[m][n][j]) * acc[m][n + 2][j];
        stage_put4(stg, m * 16 + fr, n * 4 + fq, r);
      }
    stage_flush<32>(stg, dst + (orow + wr * 64) * 512 + ct * 64 + wc * 32, 512, lane_o);
    cur = nxt; u = un;
  }
#undef P6_DESC
  __syncthreads();
}

DI void p7_down(const Params& p, int layer, int nrows, LAS char* lds, int cs = 0) {
  char* ws = p.ws;
  const u16* WdT = (const u16*)(ws + OFF_WD) + (size_t)layer * NE * 1024 * 512;
  const u16* SdT = (const u16*)(ws + OFF_SD) + (size_t)layer * 1024 * 512;
  const u16* ACT = (const u16*)(ws + OFF_ACT); const u16* ACTS = (const u16*)(ws + OFF_ACTS);
  u16* YEXP = (u16*)(ws + OFF_YEXP); u16* YSH = (u16*)(ws + OFF_YSH);
  const int tid = opaque((int)threadIdx.x), wid = tid >> 6, wr = wid >> 1, wc = wid & 1;
  int tb[NE + 1]; seg_scan(p, layer, tb);
  const int R = tb[NE];
  const int nunits = (R + nrows / 128) * 8;
  f32x4 acc[4][4];
  __syncthreads();
  TilePtrs cur, nxt;
#define P7_DESC(T, uu) do { const int _t = opaque(tid); const int _ch = gt_chunk(_t), _r0 = gt_row0(_t); const int _rt = (uu) >> 3, _ct = (uu) & 7; \
    if (_rt < R) { int _e = 0; _Pragma("unroll") for (int q = 1; q < NE; ++q) if (_rt >= tb[q]) _e = q; \
      (T).a0 = ACT + ((size_t)_rt * 128 + _r0) * 512 + _ch; (T).b0 = WdT + ((size_t)_e * 1024 + _ct * 128 + _r0) * 512 + _ch; } \
    else { const int _m0 = (_rt - R) * 128; (T).a0 = ACTS + (size_t)(_m0 + _r0) * 512 + _ch; (T).b0 = SdT + (size_t)(_ct * 128 + _r0) * 512 + _ch; } \
    (T).a1 = (T).a0 + (size_t)64 * 512; (T).b1 = (T).b0 + (size_t)64 * 512; } while (0)
  int u = (int)((blockIdx.x & 7) * (gridDim.x >> 3) + (blockIdx.x >> 3));
  bool issued = false;
  if (u < nunits) P7_DESC(cur, u);
  while (u < nunits) {
    const int un = u + gridDim.x;
    const bool hn = un < nunits;
    if (hn) P7_DESC(nxt, un); else nxt = cur;
    gemm_tile_s(lds, cur, issued, nxt, hn, 8, acc);
    issued = hn;
    const int tid_o = opaque(tid), lane_o = tid_o & 63;
    const int fr = lane_o & 15, fq = lane_o >> 4;
    const int rt = u >> 3, ct = u & 7;
    u16* dst; size_t orow;
    if (rt < R) { dst = YEXP; orow = (size_t)rt * 128; } else { dst = YSH; orow = (size_t)(rt - R) * 128; }
    __syncthreads();
    LAS char* stg = lds + 32768 + wid * 8192;
#pragma unroll
    for (int m = 0; m < 4; ++m)
#pragma unroll
      for (int n = 0; n < 4; ++n) stage_put4(stg, m * 16 + fr, n * 4 + fq, acc[m][n]);
    stage_flush<64>(stg, dst + (orow + wr * 64) * 1024 + ct * 128 + wc * 64, 1024, lane_o);
    cur = nxt; u = un;
  }
#undef P7_DESC
  __syncthreads();
}

typedef float f32x16 __attribute__((ext_vector_type(16)));
typedef short s16x4 __attribute__((ext_vector_type(4)));
DI s16x4 tr_read(const LAS char* a) { return __builtin_bit_cast(s16x4, __builtin_amdgcn_ds_read_tr16_b64_v4i16((LAS s16x4*)a)); }
DI float half_max(float m) { auto rr = __builtin_amdgcn_permlane32_swap(__float_as_uint(m), __float_as_uint(m), false, false); return fmaxf(__uint_as_float(rr[0]), __uint_as_float(rr[1])); }
DI float half_sum(float m) { auto rr = __builtin_amdgcn_permlane32_swap(__float_as_uint(m), __float_as_uint(m), false, false); return __uint_as_float(rr[0]) + __uint_as_float(rr[1]); }
DI bf16x8 pack8(const f32x16& x, int s8) {
  typedef unsigned u32x4 __attribute__((ext_vector_type(4)));
  u32x4 r;
  r[0] = cvtpk(x[s8 + 0], x[s8 + 1]); r[1] = cvtpk(x[s8 + 2], x[s8 + 3]); r[2] = cvtpk(x[s8 + 4], x[s8 + 5]); r[3] = cvtpk(x[s8 + 6], x[s8 + 7]);
  return __builtin_bit_cast(bf16x8, r);
}
constexpr int AT_STAGE = 20480;

DI float max3f(float a, float b, float c) { float r; asm("v_max3_f32 %0, %1, %2, %3" : "=v"(r) : "v"(a), "v"(b), "v"(c)); return r; }
template <bool MLA, bool SWA>
DI void attn_unit(const Params& p, int layer, int isctx, int b, int h, int qb, LAS char* lds) {
  char* ws = p.ws;
  const int tid = opaque((int)threadIdx.x), lane = tid & 63, wid = tid >> 6, r32 = lane & 31, hi = lane >> 5;
  const u16 *Qg, *Kg, *Vg; int ldq, ldk, qoff, koff, ycol; float cs;
  if (MLA) { Qg = (const u16*)(ws + OFF_MLQ); Kg = (const u16*)(ws + OFF_MLK); Vg = (const u16*)(ws + OFF_MLV); ldq = 384; ldk = 256; qoff = h * 96; koff = h * 64; ycol = 768 + h * 64; cs = 0.10206207261596575f * 1.4426950408889634f; }
  else if (!SWA) { Qg = (const u16*)(ws + OFF_GLQ); Kg = (const u16*)(ws + OFF_GLK); Vg = (const u16*)(ws + OFF_GLV); ldq = 384; ldk = 128; qoff = h * 64; koff = (h / 3) * 64; ycol = 384 + h * 64; cs = 0.125f * 1.4426950408889634f; }
  else { Qg = (const u16*)(ws + OFF_SWQ); Kg = (const u16*)(ws + OFF_SWK); Vg = (const u16*)(ws + OFF_SWV); ldq = 384; ldk = 128; qoff = h * 64; koff = (h / 3) * 64; ycol = h * 64; cs = 0.125f * 1.4426950408889634f; }
  const u16* Rg = (const u16*)(ws + OFF_MLKR);
  const int q0 = qb * 128;
  const int qrow0 = (isctx ? NL + b * C_ : b * S_) + q0;
  const int qw = q0 + wid * 32;
  int lat_first = 0, nlat = 0;
  if (!isctx) { if (SWA) { lat_first = 2 * qb - 2; if (lat_first < 0) lat_first = 0; int lat_last = 2 * qb + 3; if (lat_last > 63) lat_last = 63; nlat = lat_last - lat_first + 1; } else nlat = 64; }
  const int T = 4 + nlat;
  constexpr int NQ = MLA ? 6 : 4;
  bf16x8 qf[NQ];
  {
    const u16* qp = Qg + (size_t)(qrow0 + wid * 32 + r32) * ldq + qoff + hi * 8;
#pragma unroll
    for (int d0 = 0; d0 < NQ; ++d0) {
      const u32x4_t raw = *(const u32x4_t*)(qp + d0 * 16);
      u32x4_t sc;
#pragma unroll
      for (int i = 0; i < 4; ++i) sc[i] = cvtpk(bflo(raw[i]) * cs, bfhi(raw[i]) * cs);
      qf[d0] = __builtin_bit_cast(bf16x8, sc);
    }
  }
  int kaddr[4];
#pragma unroll
  for (int d0 = 0; d0 < 4; ++d0) kaddr[d0] = r32 * 128 + (((d0 * 2 + hi) ^ ((r32 >> 1) & 7)) * 16);
  int kraddr[2];
#pragma unroll
  for (int e = 0; e < 2; ++e) kraddr[e] = 16384 + r32 * 64 + (((e * 2 + hi) ^ ((r32 >> 3) & 3)) * 16);
  int vbo[2];
  {
    const int i16 = lane & 15, sw = (lane >> 3) & 1;
    const int x = ((lane >> 4) & 1) * 32 + (lane & 3) * 8;
    const int rowpart = ((i16 >> 2) + 4 * hi) * 128;
    vbo[0] = 8192 + rowpart + x + (sw * 64);
    vbo[1] = 8192 + rowpart + x + ((1 - sw) * 64);
  }
  const int skey = tid >> 3;
  const int kch = ((tid & 7) ^ ((tid >> 4) & 7)) * 8;
  const int vch = ((tid & 7) ^ (((tid >> 4) & 1) << 2)) * 8;
  const int rkey = tid >> 2, rch = ((tid & 3) ^ ((tid >> 5) & 3)) * 8;
  LAS char* ldst = lds + tid * 16;
#define AT_ISSUE(j, st) do { const int _j = (j); const int _kr = _j < 4 ? NL + b * C_ + 64 * _j : b * S_ + 64 * (lat_first + _j - 4); \
    LAS char* _d = ldst + (st) * AT_STAGE; \
    const u16* _k = Kg + (size_t)(_kr + skey) * ldk + koff + kch; glds16(_k, _d); glds16(_k + (size_t)32 * ldk, _d + 4096); \
    const u16* _v = Vg + (size_t)(_kr + skey) * ldk + koff + vch; glds16(_v, _d + 8192); glds16(_v + (size_t)32 * ldk, _d + 8192 + 4096); \
    if (MLA) glds16(Rg + (size_t)(_kr + rkey) * 32 + rch, _d + 16384); } while (0)
#define AT_QK(sb, P0, P1) do { \
    bf16x8 kk0[MLA ? 6 : 4], kk1[MLA ? 6 : 4]; \
    _Pragma("unroll") for (int d0 = 0; d0 < 4; ++d0) { kk0[d0] = *(const LAS bf16x8*)((sb) + kaddr[d0]); kk1[d0] = *(const LAS bf16x8*)((sb) + kaddr[d0] + 4096); } \
    if (MLA) { _Pragma("unroll") for (int e = 0; e < 2; ++e) { kk0[MLA ? 4 + e : 0] = *(const LAS bf16x8*)((sb) + kraddr[e]); kk1[MLA ? 4 + e : 0] = *(const LAS bf16x8*)((sb) + kraddr[e] + 2048); } } \
    __builtin_amdgcn_sched_barrier(0);     \
    P0 = __builtin_amdgcn_mfma_f32_32x32x16_bf16(kk0[0], qf[0], negm, 0, 0, 0); P1 = __builtin_amdgcn_mfma_f32_32x32x16_bf16(kk1[0], qf[0], negm, 0, 0, 0); \
    _Pragma("unroll") for (int d0 = 1; d0 < (MLA ? 6 : 4); ++d0) { \
      P0 = __builtin_amdgcn_mfma_f32_32x32x16_bf16(kk0[d0], qf[d0], P0, 0, 0, 0); P1 = __builtin_amdgcn_mfma_f32_32x32x16_bf16(kk1[d0], qf[d0], P1, 0, 0, 0); } \
  } while (0)
#define AT_WSTATE(jj, pos0v, st) do { st = 0; pos0v = 64 * (lat_first + (jj) - 4); if (SWA && (jj) >= 4) { \
      if (pos0v + 63 < qw - 128 || pos0v > qw + 31 + 128) st = 2; else if (qw + 31 - pos0v > 128 || pos0v + 63 - qw > 128) st = 1; } } while (0)
#define AT_SOFTMAX(P0, P1, PA, wst, pos0v, FIRST) do { \
    if (SWA && wst == 1) { const int dq = qw + r32 - pos0v - 4 * hi + 128; \
      _Pragma("unroll") for (int r = 0; r < 16; ++r) { const int cr = (r & 3) + 8 * (r >> 2); \
        if ((unsigned)(dq - cr) > 256u) P0[r] = -1e30f; if ((unsigned)(dq - cr - 32) > 256u) P1[r] = -1e30f; } } \
    asm volatile("s_nop 15\n\ts_nop 15" : "+v"(P0), "+v"(P1));     \
    float mx = max3f(P0[0], P0[1], P1[0]); mx = max3f(mx, P1[1], P0[2]); \
    _Pragma("unroll") for (int r = 3; r < 16; r += 2) { mx = max3f(mx, P0[r], P0[(r + 1) & 15]); } \
    _Pragma("unroll") for (int r = 2; r < 16; r += 2) { mx = max3f(mx, P1[r], P1[r + 1]); } \
    mx = half_max(mx); \
    if ((FIRST) || __ballot(mx > 8.0f) != 0ull) { \
      const float delta = (FIRST) ? mx : fmaxf(mx, 0.f); \
      const float al = __builtin_amdgcn_exp2f(-delta); \
      m_run += delta; \
      _Pragma("unroll") for (int i = 0; i < 16; ++i) { o[0][i] *= al; o[1][i] *= al; P0[i] -= delta; P1[i] -= delta; negm[i] = -m_run; } \
      osum[0] *= al; \
    } \
    _Pragma("unroll") for (int r = 0; r < 16; ++r) { P0[r] = __builtin_amdgcn_exp2f(P0[r]); P1[r] = __builtin_amdgcn_exp2f(P1[r]); } \
    PA[0] = pack8(P0, 0); PA[1] = pack8(P0, 8); PA[2] = pack8(P1, 0); PA[3] = pack8(P1, 8); \
  } while (0)
#define AT_PV(sb, PA) do { \
    bf16x8 vf[2][4]; \
    _Pragma("unroll") for (int db = 0; db < 2; ++db) { _Pragma("unroll") for (int ts = 0; ts < 4; ++ts) { \
      const LAS char* va = (sb) + vbo[db] + ts * 2048; const s16x4 lo = tr_read(va), hh = tr_read(va + 1024); \
      vf[db][ts] = __builtin_shufflevector(lo, hh, 0, 1, 2, 3, 4, 5, 6, 7); } } \
    __builtin_amdgcn_sched_barrier(0);     \
    _Pragma("unroll") for (int ts = 0; ts < 4; ++ts) osum = __builtin_amdgcn_mfma_f32_32x32x16_bf16(ones, PA[ts], osum, 0, 0, 0); \
    _Pragma("unroll") for (int db = 0; db < 2; ++db) { _Pragma("unroll") for (int ts = 0; ts < 4; ++ts) \
      o[db] = __builtin_amdgcn_mfma_f32_32x32x16_bf16(vf[db][ts], PA[ts], o[db], 0, 0, 0); } } while (0)

  float m_run = SWA ? p.swa_sink[layer * 6 + h] * 1.4426950408889634f : 0.f;
  f32x16 o[2], osum, negm;
#pragma unroll
  for (int i = 0; i < 16; ++i) { o[0][i] = 0.f; o[1][i] = 0.f; osum[i] = SWA ? 1.f : 0.f; negm[i] = -m_run; }
  bf16x8 ones;
#pragma unroll
  for (int i = 0; i < 8; ++i) ones[i] = (short)0x3F80;
  bf16x8 pa[4];
  f32x16 s0, s1;
  AT_ISSUE(0, 0);
  asm volatile("s_waitcnt vmcnt(0)" ::: "memory");
  __syncthreads();
  AT_ISSUE(1, 1);
  AT_QK(lds, s0, s1);
  { int wst = 0, pos0v = 0; AT_SOFTMAX(s0, s1, pa, wst, pos0v, !SWA); }
  bool cur_skip = false;
#pragma unroll 1
  for (int j = 0; j < T - 1; ++j) {
    asm volatile("s_waitcnt vmcnt(0)" ::: "memory");
    __syncthreads();
    const int st_cur = j % 3, st_nxt = (j + 1) % 3;
    if (j + 2 < T) AT_ISSUE(j + 2, (j + 2) % 3);
    const LAS char* sbn = lds + st_nxt * AT_STAGE;
    const LAS char* sbc = lds + st_cur * AT_STAGE;
    int wst, pos0v; AT_WSTATE(j + 1, pos0v, wst);
    if (!SWA || wst != 2) AT_QK(sbn, s0, s1);
    if (!SWA || !cur_skip) AT_PV(sbc, pa);
    if (!SWA || wst != 2) {
      bf16x8 pn[4];
      AT_SOFTMAX(s0, s1, pn, wst, pos0v, false);
      pa[0] = pn[0]; pa[1] = pn[1]; pa[2] = pn[2]; pa[3] = pn[3];
      cur_skip = false;
    } else cur_skip = true;
  }
  if (!SWA || !cur_skip) { const LAS char* sbc = lds + ((T - 1) % 3) * AT_STAGE; AT_PV(sbc, pa); }
#undef AT_ISSUE
#undef AT_QK
#undef AT_WSTATE
#undef AT_SOFTMAX
#undef AT_PV
  const float inv = 1.f / osum[0];
  u16* yp = (u16*)(ws + OFF_Y) + (size_t)(qrow0 + wid * 32 + r32) * 1024 + ycol + 4 * hi;
#pragma unroll
  for (int db = 0; db < 2; ++db)
#pragma unroll
    for (int g = 0; g < 4; ++g) {
      uint2 w; w.x = cvtpk(o[db][4 * g] * inv, o[db][4 * g + 1] * inv); w.y = cvtpk(o[db][4 * g + 2] * inv, o[db][4 * g + 3] * inv);
      *(uint2*)(yp + db * 32 + 8 * g) = w;
    }
  __syncthreads();
}


typedef float f32x4v __attribute__((ext_vector_type(4)));
#define MFMA16(a, b, c) __builtin_amdgcn_mfma_f32_16x16x32_bf16((a), (b), (c), 0, 0, 0)
DI float quad_max_x(float m) {
  { auto rr = __builtin_amdgcn_permlane16_swap(__float_as_uint(m), __float_as_uint(m), false, false); m = fmaxf(__uint_as_float(rr[0]), __uint_as_float(rr[1])); }
  { auto rr = __builtin_amdgcn_permlane32_swap(__float_as_uint(m), __float_as_uint(m), false, false); m = fmaxf(__uint_as_float(rr[0]), __uint_as_float(rr[1])); }
  return m;
}
template <bool MLA, bool SWA>
DI void attn_unit16(const Params& p, int layer, int isctx, int b, int h, int qb, LAS char* lds) {
  char* ws = p.ws;
  const int tid = opaque((int)threadIdx.x), lane = tid & 63, wid = tid >> 6, c16 = lane & 15, g = lane >> 4;
  const u16 *Qg, *Kg, *Vg; int ldq, ldk, qoff, koff, ycol; float cs;
  if (MLA) { Qg = (const u16*)(ws + OFF_MLQ); Kg = (const u16*)(ws + OFF_MLK); Vg = (const u16*)(ws + OFF_MLV); ldq = 384; ldk = 256; qoff = h * 96; koff = h * 64; ycol = 768 + h * 64; cs = 0.10206207261596575f * 1.4426950408889634f; }
  else if (!SWA) { Qg = (const u16*)(ws + OFF_GLQ); Kg = (const u16*)(ws + OFF_GLK); Vg = (const u16*)(ws + OFF_GLV); ldq = 384; ldk = 128; qoff = h * 64; koff = (h / 3) * 64; ycol = 384 + h * 64; cs = 0.125f * 1.4426950408889634f; }
  else { Qg = (const u16*)(ws + OFF_SWQ); Kg = (const u16*)(ws + OFF_SWK); Vg = (const u16*)(ws + OFF_SWV); ldq = 384; ldk = 128; qoff = h * 64; koff = (h / 3) * 64; ycol = h * 64; cs = 0.125f * 1.4426950408889634f; }
  const u16* Rg = (const u16*)(ws + OFF_MLKR);
  const int q0 = qb * 128;
  const int qrow0 = (isctx ? NL + b * C_ : b * S_) + q0;
  const int qw = q0 + wid * 32;
  int lat_first = 0, nlat = 0;
  if (!isctx) { if (SWA) { lat_first = 2 * qb - 2; if (lat_first < 0) lat_first = 0; int lat_last = 2 * qb + 3; if (lat_last > 63) lat_last = 63; nlat = lat_last - lat_first + 1; } else nlat = 64; }
  const int T = 4 + nlat;
  constexpr int NS = MLA ? 3 : 2;
  bf16x8 qf[2][NS];
#pragma unroll
  for (int bq = 0; bq < 2; ++bq) {
    const u16* qp = Qg + (size_t)(qrow0 + wid * 32 + bq * 16 + c16) * ldq + qoff + g * 8;
#pragma unroll
    for (int s = 0; s < NS; ++s) {
      const u32x4_t raw = *(const u32x4_t*)(qp + s * 32);
      u32x4_t sc;
#pragma unroll
      for (int i = 0; i < 4; ++i) sc[i] = cvtpk(bflo(raw[i]) * cs, bfhi(raw[i]) * cs);
      qf[bq][s] = __builtin_bit_cast(bf16x8, sc);
    }
  }
  int kaddr[2];
#pragma unroll
  for (int s = 0; s < 2; ++s) kaddr[s] = c16 * 128 + (((4 * s + g) ^ ((c16 >> 1) & 7)) * 16);
  const int kraddr = 16384 + c16 * 64 + ((g ^ ((0 - (c16 >> 2)) & 3)) * 16);
  int vbo[4];
#pragma unroll
  for (int d = 0; d < 4; ++d) vbo[d] = 8192 + (4 * g + (c16 >> 2)) * 128 + ((d ^ ((lane >> 3) & 3)) * 32) + (lane & 3) * 8;
  const int skey = tid >> 3;
  const int kch = ((tid & 7) ^ ((tid >> 4) & 7)) * 8;
  const int vch = ((tid & 7) ^ (((tid >> 4) & 3) << 1)) * 8;
  const int rkey = tid >> 2, rch = ((tid & 3) ^ ((0 - (tid >> 4)) & 3)) * 8;
  LAS char* ldst = lds + tid * 16;
#define A6_ISSUE(j, st) do { const int _j = (j); const int _kr = _j < 4 ? NL + b * C_ + 64 * _j : b * S_ + 64 * (lat_first + _j - 4); \
    LAS char* _d = ldst + (st) * AT_STAGE; \
    const u16* _k = Kg + (size_t)(_kr + skey) * ldk + koff + kch; glds16(_k, _d); glds16(_k + (size_t)32 * ldk, _d + 4096); \
    const u16* _v = Vg + (size_t)(_kr + skey) * ldk + koff + vch; glds16(_v, _d + 8192); glds16(_v + (size_t)32 * ldk, _d + 8192 + 4096); \
    if (MLA) glds16(Rg + (size_t)(_kr + rkey) * 32 + rch, _d + 16384); } while (0)
#define A6_QK(sb) do { \
    bf16x8 kk[4][NS]; \
    _Pragma("unroll") for (int a = 0; a < 4; ++a) { kk[a][0] = *(const LAS bf16x8*)((sb) + kaddr[0] + a * 2048); kk[a][1] = *(const LAS bf16x8*)((sb) + kaddr[1] + a * 2048); \
      if (MLA) kk[a][MLA ? 2 : 0] = *(const LAS bf16x8*)((sb) + kraddr + a * 1024); } \
    __builtin_amdgcn_sched_barrier(0); \
    _Pragma("unroll") for (int a = 0; a < 4; ++a) { _Pragma("unroll") for (int bq = 0; bq < 2; ++bq) { \
      S[a][bq] = MFMA16(kk[a][0], qf[bq][0], negm[bq]); \
      _Pragma("unroll") for (int s = 1; s < NS; ++s) S[a][bq] = MFMA16(kk[a][s], qf[bq][s], S[a][bq]); } } \
  } while (0)
#define A6_WSTATE(jj, pos0v, st) do { st = 0; pos0v = 64 * (lat_first + (jj) - 4); if (SWA && (jj) >= 4) { \
      if (pos0v + 63 < qw - 128 || pos0v > qw + 31 + 128) st = 2; else if (qw + 31 - pos0v > 128 || pos0v + 63 - qw > 128) st = 1; } } while (0)
#define A6_SOFTMAX(PA, wst, pos0v, FIRST) do { \
    if (SWA && wst == 1) { _Pragma("unroll") for (int bq = 0; bq < 2; ++bq) { const int dq = qw + 16 * bq + c16 - pos0v - 4 * g + 128; \
      _Pragma("unroll") for (int a = 0; a < 4; ++a) { _Pragma("unroll") for (int r = 0; r < 4; ++r) { if ((unsigned)(dq - (16 * a + r)) > 256u) S[a][bq][r] = -1e30f; } } } } \
    asm volatile("s_nop 15\n\ts_nop 15" : "+v"(S[0][0]), "+v"(S[0][1]), "+v"(S[1][0]), "+v"(S[1][1]), "+v"(S[2][0]), "+v"(S[2][1]), "+v"(S[3][0]), "+v"(S[3][1])); \
    float mx[2]; \
    _Pragma("unroll") for (int bq = 0; bq < 2; ++bq) { \
      float m_ = max3f(S[0][bq][0], S[0][bq][1], S[0][bq][2]); m_ = max3f(m_, S[0][bq][3], S[1][bq][0]); \
      m_ = max3f(m_, S[1][bq][1], S[1][bq][2]); m_ = max3f(m_, S[1][bq][3], S[2][bq][0]); m_ = max3f(m_, S[2][bq][1], S[2][bq][2]); \
      m_ = max3f(m_, S[2][bq][3], S[3][bq][0]); m_ = max3f(m_, S[3][bq][1], S[3][bq][2]); m_ = fmaxf(m_, S[3][bq][3]); \
      mx[bq] = quad_max_x(m_); } \
    if ((FIRST) || __ballot(fmaxf(mx[0], mx[1]) > 8.0f) != 0ull) { \
      _Pragma("unroll") for (int bq = 0; bq < 2; ++bq) { \
        const float delta = (FIRST) ? mx[bq] : fmaxf(mx[bq], 0.f); \
        const float al = __builtin_amdgcn_exp2f(-delta); \
        m_run[bq] += delta; \
        _Pragma("unroll") for (int a = 0; a < 4; ++a) { S[a][bq] = S[a][bq] - delta; o[a][bq] = o[a][bq] * al; } \
        negm[bq] = (f32x4v){-m_run[bq], -m_run[bq], -m_run[bq], -m_run[bq]}; \
        osum[bq] = osum[bq] * al; } \
    } \
    _Pragma("unroll") for (int a = 0; a < 4; ++a) { _Pragma("unroll") for (int bq = 0; bq < 2; ++bq) { _Pragma("unroll") for (int r = 0; r < 4; ++r) S[a][bq][r] = __builtin_amdgcn_exp2f(S[a][bq][r]); } } \
    _Pragma("unroll") for (int ks = 0; ks < 2; ++ks) { _Pragma("unroll") for (int bq = 0; bq < 2; ++bq) { u32x4_t w_; \
      w_[0] = cvtpk(S[2 * ks][bq][0], S[2 * ks][bq][1]); w_[1] = cvtpk(S[2 * ks][bq][2], S[2 * ks][bq][3]); \
      w_[2] = cvtpk(S[2 * ks + 1][bq][0], S[2 * ks + 1][bq][1]); w_[3] = cvtpk(S[2 * ks + 1][bq][2], S[2 * ks + 1][bq][3]); \
      PA[ks][bq] = __builtin_bit_cast(bf16x8, w_); } } \
  } while (0)
#define A6_PV(sb, PA) do { \
    bf16x8 vf[2][4]; \
    _Pragma("unroll") for (int ks = 0; ks < 2; ++ks) { _Pragma("unroll") for (int d = 0; d < 4; ++d) { \
      const LAS char* va = (sb) + vbo[d] + ks * 4096; const s16x4 lo = tr_read(va), hh = tr_read(va + 2048); \
      vf[ks][d] = __builtin_shufflevector(lo, hh, 0, 1, 2, 3, 4, 5, 6, 7); } } \
    __builtin_amdgcn_sched_barrier(0); \
    _Pragma("unroll") for (int ks = 0; ks < 2; ++ks) { _Pragma("unroll") for (int bq = 0; bq < 2; ++bq) osum[bq] = MFMA16(ones, PA[ks][bq], osum[bq]); } \
    _Pragma("unroll") for (int d = 0; d < 4; ++d) { _Pragma("unroll") for (int bq = 0; bq < 2; ++bq) { _Pragma("unroll") for (int ks = 0; ks < 2; ++ks) \
      o[d][bq] = MFMA16(vf[ks][d], PA[ks][bq], o[d][bq]); } } } while (0)

  float m_run[2];
  m_run[0] = m_run[1] = SWA ? p.swa_sink[layer * 6 + h] * 1.4426950408889634f : 0.f;
  f32x4v S[4][2], o[4][2], osum[2], negm[2];
#pragma unroll
  for (int bq = 0; bq < 2; ++bq) {
    const float i1 = SWA ? 1.f : 0.f;
    osum[bq] = (f32x4v){i1, i1, i1, i1}; negm[bq] = (f32x4v){-m_run[bq], -m_run[bq], -m_run[bq], -m_run[bq]};
#pragma unroll
    for (int d = 0; d < 4; ++d) o[d][bq] = (f32x4v){0.f, 0.f, 0.f, 0.f};
  }
  bf16x8 ones;
#pragma unroll
  for (int i = 0; i < 8; ++i) ones[i] = (short)0x3F80;
  bf16x8 pa[2][2];
  A6_ISSUE(0, 0);
  asm volatile("s_waitcnt vmcnt(0)" ::: "memory");
  __syncthreads();
  A6_ISSUE(1, 1);
  A6_QK(lds);
  { int wst = 0, pos0v = 0; A6_SOFTMAX(pa, wst, pos0v, !SWA); }
  bool cur_skip = false;
#pragma unroll 1
  for (int j = 0; j < T - 1; ++j) {
    asm volatile("s_waitcnt vmcnt(0)" ::: "memory");
    __syncthreads();
    if (j + 2 < T) A6_ISSUE(j + 2, (j + 2) % 3);
    const LAS char* sbn = lds + ((j + 1) % 3) * AT_STAGE;
    const LAS char* sbc = lds + (j % 3) * AT_STAGE;
    int wst, pos0v; A6_WSTATE(j + 1, pos0v, wst);
    if (!SWA || wst != 2) A6_QK(sbn);
    if (!SWA || !cur_skip) A6_PV(sbc, pa);
    if (!SWA || wst != 2) {
      bf16x8 pn[2][2];
      A6_SOFTMAX(pn, wst, pos0v, false);
      pa[0][0] = pn[0][0]; pa[0][1] = pn[0][1]; pa[1][0] = pn[1][0]; pa[1][1] = pn[1][1];
      cur_skip = false;
    } else cur_skip = true;
  }
  if (!SWA || !cur_skip) { const LAS char* sbc = lds + ((T - 1) % 3) * AT_STAGE; A6_PV(sbc, pa); }
#undef A6_ISSUE
#undef A6_QK
#undef A6_WSTATE
#undef A6_SOFTMAX
#undef A6_PV
#pragma unroll
  for (int bq = 0; bq < 2; ++bq) {
    const float inv = 1.f / osum[bq][0];
    u16* yp = (u16*)(ws + OFF_Y) + (size_t)(qrow0 + wid * 32 + bq * 16 + c16) * 1024 + ycol + 4 * g;
#pragma unroll
    for (int d = 0; d < 4; ++d) {
      u32x2_t w; w[0] = cvtpk(o[d][bq][0] * inv, o[d][bq][1] * inv); w[1] = cvtpk(o[d][bq][2] * inv, o[d][bq][3] * inv);
      *(u32x2_t*)(yp + d * 16) = w;
    }
  }
  __syncthreads();
}

DI void p3_attention(const Params& p, int layer, LAS char* lds, int cs = 0) {
  unsigned* ctr8 = (unsigned*)(p.ws + OFF_CTRL) + CW_Q + (layer * 2 + 0) * 512;
  const int per_q = 512 + (layer == 0 ? 32 : 0);
  for (;;) {
    const int u = next_unit_xcd(ctr8, per_q, lds);
    if (u < 0) break;
    const int b = u / per_q, v = u % per_q;
    if (v < 128) { attn_unit16<true, false>(p, layer, 0, b, v >> 5, v & 31, lds); }
    else if (v < 320) { const int w = v - 128; attn_unit16<false, false>(p, layer, 0, b, w >> 5, w & 31, lds); }
    else if (v < 512) { const int w = v - 320; attn_unit16<false, true>(p, layer, 0, b, w >> 5, w & 31, lds); }
    else {
      const int w = v - 512;
      if (w < 8) attn_unit16<true, false>(p, layer, 1, b, w >> 1, w & 1, lds);
      else if (w < 20) { const int x = w - 8; attn_unit16<false, false>(p, layer, 1, b, x >> 1, x & 1, lds); }
      else { const int x = w - 20; attn_unit16<false, true>(p, layer, 1, b, x >> 1, x & 1, lds); }
    }
  }
}

struct AttnArgs {
  const u16* Q; const u16* K; const u16* K2; const u16* V; u16* Y; const float* sink;
  int ldq, ldk, ldk2, ldv, ldy, ycol, G, window, q_is_ctx; float scale;
};
static_assert(sizeof(AttnArgs) == 88, "no padding");
template <int DK1, int DK2>
__global__ __launch_bounds__(64) void k_attn(AttnArgs a) {
  const int qt = blockIdx.x * 64 + threadIdx.x, b = blockIdx.y, h = blockIdx.z, kvh = h / a.G;
  const int qrow = a.q_is_ctx ? NL + b * C_ + qt : b * S_ + qt;
  float q[DK1 + DK2];
  {
    const uint4* qp = (const uint4*)(a.Q + (size_t)qrow * a.ldq + h * (DK1 + DK2));
#pragma unroll
    for (int i = 0; i < (DK1 + DK2) / 8; ++i) {
      uint4 u = qp[i];
      q[i * 8 + 0] = bflo(u.x) * a.scale; q[i * 8 + 1] = bfhi(u.x) * a.scale; q[i * 8 + 2] = bflo(u.y) * a.scale; q[i * 8 + 3] = bfhi(u.y) * a.scale;
      q[i * 8 + 4] = bflo(u.z) * a.scale; q[i * 8 + 5] = bfhi(u.z) * a.scale; q[i * 8 + 6] = bflo(u.w) * a.scale; q[i * 8 + 7] = bfhi(u.w) * a.scale;
    }
  }
  float m, l, o[64];
  if (a.sink) { m = a.sink[h]; l = 1.f; } else { m = -1e30f; l = 0.f; }
#pragma unroll
  for (int d = 0; d < 64; ++d) o[d] = 0.f;
  const int nseg = a.q_is_ctx ? 1 : 2;
  for (int seg = 0; seg < nseg; ++seg) {
    int lo, hi, rbase; bool masked = false;
    if (seg == 0) { lo = 0; hi = C_; rbase = NL + b * C_; }
    else {
      lo = 0; hi = S_; rbase = b * S_;
      if (a.window) { int t0 = blockIdx.x * 64; lo = t0 - a.window; if (lo < 0) lo = 0; hi = t0 + 64 + a.window; if (hi > S_) hi = S_; masked = true; }
    }
    for (int s = lo; s < hi; s += 4) {
      float sc[4];
#pragma unroll
      for (int i = 0; i < 4; ++i) {
        const uint4* kp = (const uint4*)(a.K + (size_t)(rbase + s + i) * a.ldk + kvh * DK1);
        float dot = 0.f;
#pragma unroll
        for (int c = 0; c < DK1 / 8; ++c) {
          uint4 u = kp[c];
          dot += q[c * 8 + 0] * bflo(u.x) + q[c * 8 + 1] * bfhi(u.x) + q[c * 8 + 2] * bflo(u.y) + q[c * 8 + 3] * bfhi(u.y)
               + q[c * 8 + 4] * bflo(u.z) + q[c * 8 + 5] * bfhi(u.z) + q[c * 8 + 6] * bflo(u.w) + q[c * 8 + 7] * bfhi(u.w);
        }
        if (DK2 > 0) {
          const uint4* kp2 = (const uint4*)(a.K2 + (size_t)(rbase + s + i) * a.ldk2);
#pragma unroll
          for (int c = 0; c < DK2 / 8; ++c) {
            uint4 u = kp2[c];
            dot += q[DK1 + c * 8 + 0] * bflo(u.x) + q[DK1 + c * 8 + 1] * bfhi(u.x) + q[DK1 + c * 8 + 2] * bflo(u.y) + q[DK1 + c * 8 + 3] * bfhi(u.y)
                 + q[DK1 + c * 8 + 4] * bflo(u.z) + q[DK1 + c * 8 + 5] * bfhi(u.z) + q[DK1 + c * 8 + 6] * bflo(u.w) + q[DK1 + c * 8 + 7] * bfhi(u.w);
          }
        }
        if (masked) { int dlt = qt - (s + i); if (dlt < 0) dlt = -dlt; if (dlt > a.window) dot = -1e30f; }
        sc[i] = dot;
      }
      float mx = fmaxf(fmaxf(fmaxf(sc[0], sc[1]), fmaxf(sc[2], sc[3])), m);
      const float alpha = __expf(m - mx);
      float pr[4];
#pragma unroll
      for (int i = 0; i < 4; ++i) pr[i] = __expf(sc[i] - mx);
      l = l * alpha + (pr[0] + pr[1]) + (pr[2] + pr[3]);
      m = mx;
#pragma unroll
      for (int d = 0; d < 64; ++d) o[d] *= alpha;
#pragma unroll
      for (int i = 0; i < 4; ++i) {
        const uint4* vp = (const uint4*)(a.V + (size_t)(rbase + s + i) * a.ldv + kvh * 64);
#pragma unroll
        for (int c = 0; c < 8; ++c) {
          uint4 u = vp[c];
          o[c * 8 + 0] += pr[i] * bflo(u.x); o[c * 8 + 1] += pr[i] * bfhi(u.x); o[c * 8 + 2] += pr[i] * bflo(u.y); o[c * 8 + 3] += pr[i] * bfhi(u.y);
          o[c * 8 + 4] += pr[i] * bflo(u.z); o[c * 8 + 5] += pr[i] * bfhi(u.z); o[c * 8 + 6] += pr[i] * bflo(u.w); o[c * 8 + 7] += pr[i] * bfhi(u.w);
        }
      }
    }
  }
  const float inv = 1.f / l;
  uint4* yp = (uint4*)(a.Y + (size_t)qrow * a.ldy + a.ycol + h * 64);
#pragma unroll
  for (int c = 0; c < 8; ++c) {
    uint4 u;
    u.x = cvtpk(o[c * 8 + 0] * inv, o[c * 8 + 1] * inv); u.y = cvtpk(o[c * 8 + 2] * inv, o[c * 8 + 3] * inv);
    u.z = cvtpk(o[c * 8 + 4] * inv, o[c * 8 + 5] * inv); u.w = cvtpk(o[c * 8 + 6] * inv, o[c * 8 + 7] * inv);
    yp[c] = u;
  }
}


constexpr int CW_BAR = 1024;
#define XB_TMO      128
#define XB_XCNT(j)  (256  + 64 * (j))
#define XB_XSUB(j)  (1280 + 64 * (j))
#define XB_XGEN(j)  (2304 + 64 * (j))
#define XB_TOP      3328
#define XB_TOPGEN   3392
#define XCD_BAR_WORDS 3456
#define XB_SPIN_CAP (1u << 22)
DI unsigned xb_ld(unsigned* p) { return __hip_atomic_load(p, __ATOMIC_RELAXED, __HIP_MEMORY_SCOPE_AGENT); }
DI unsigned xb_add(unsigned* p, unsigned v) { return __hip_atomic_fetch_add(p, v, __ATOMIC_RELAXED, __HIP_MEMORY_SCOPE_AGENT); }
DI unsigned xb_xcc_id() { return (unsigned)__builtin_amdgcn_s_getreg((3 << 11) | 20) & 0xFu; }
#define XB_SPIN(cond, bar) do { unsigned _sp = 0; while (cond) { __builtin_amdgcn_s_sleep(1); \
    if ((++_sp & 255u) == 0u) { if (xb_ld(&(bar)[XB_TMO])) break; if (_sp > XB_SPIN_CAP) { atomicAdd(&(bar)[XB_TMO], 1u); break; } } } } while (0)
struct XcdBarrier { unsigned* bar; unsigned x; volatile LAS unsigned* st; };
DI XcdBarrier xcd_barrier_post(unsigned* bar, volatile LAS unsigned* st) {
  XcdBarrier b; b.bar = bar; b.x = xb_xcc_id(); b.st = st;
  if (threadIdx.x == 0) (void)xb_add(&bar[XB_XCNT(b.x)], 1u);
  return b;
}
DI void xcd_barrier_complete(unsigned* bar, unsigned x, unsigned& nloc, unsigned& nx) {
  const unsigned G = gridDim.x * gridDim.y * gridDim.z;
  unsigned sum, cnt, mine, sp = 0u;
  for (;;) {
    sum = 0u; cnt = 0u; mine = 0u;
#pragma unroll
    for (unsigned j = 0; j < 16; ++j) { const unsigned c = xb_ld(&bar[XB_XCNT(j)]); sum += c; cnt += (c > 0u) ? 1u : 0u; mine = (j == x) ? c : mine; }
    if (sum == G) break;
    __builtin_amdgcn_s_sleep(1);
    if ((++sp & 255u) == 0u) { if (xb_ld(&bar[XB_TMO])) break; if (sp > XB_SPIN_CAP) { atomicAdd(&bar[XB_TMO], 1u); break; } }
  }
  nloc = mine > 0u ? mine : 1u; nx = cnt > 0u ? cnt : 1u;
}
DI void xcd_barrier(const XcdBarrier& b) {
  asm volatile("s_waitcnt vmcnt(0)" ::: "memory");
  __syncthreads();
  if (threadIdx.x == 0) {
    unsigned* bar = b.bar;
    __builtin_amdgcn_s_waitcnt(0);
    unsigned nloc = b.st[0], nx = b.st[1];
    if (nloc == 0u) { xcd_barrier_complete(bar, b.x, nloc, nx); b.st[0] = nloc; b.st[1] = nx; }
    const unsigned old = xb_add(&bar[XB_XSUB(b.x)], 1u);
    const unsigned gen = old / nloc;
    if (old + 1u == (gen + 1u) * nloc) {
      __builtin_amdgcn_fence(__ATOMIC_RELEASE, "agent");
      asm volatile("s_waitcnt vmcnt(0)" ::: "memory");
      const unsigned og = xb_add(&bar[XB_TOP], 1u);
      const unsigned tg = og / nx;
      if (og + 1u == (tg + 1u) * nx) xb_add(&bar[XB_TOPGEN], 1u);
      else XB_SPIN(xb_ld(&bar[XB_TOPGEN]) == tg, bar);
      __builtin_amdgcn_fence(__ATOMIC_ACQUIRE, "agent");
      xb_add(&bar[XB_XGEN(b.x)], 1u);
      asm volatile("s_waitcnt vmcnt(0)" ::: "memory");
    } else {
      XB_SPIN(xb_ld(&bar[XB_XGEN(b.x)]) == gen, bar);
      __builtin_amdgcn_fence(__ATOMIC_ACQUIRE, "agent");
      asm volatile("s_waitcnt vmcnt(0)" ::: "memory");
    }
  }
  __syncthreads();
}

__global__ __launch_bounds__(NTHR, 2) void k_mega(Params p) {
  extern __shared__ __attribute__((aligned(16))) unsigned char smem[];
  LAS char* lds = (LAS char*)smem;
  if (p.never) cooperative_groups::this_grid().sync();
  volatile LAS unsigned* st = (volatile LAS unsigned*)(lds + LDS_MISC + 3584);
  if (threadIdx.x < 4) st[threadIdx.x] = 0u;
  __syncthreads();
  XcdBarrier bar = xcd_barrier_post((unsigned*)(p.ws + OFF_CTRL) + CW_BAR, st);
#ifdef PROBE_SEG
  unsigned long long t_acc = 0ull, t_s = 0ull;
#define SEG_BEGIN(id) do { if ((id) == PROBE_SEG && blockIdx.x == 0 && threadIdx.x == 0) t_s = __builtin_amdgcn_s_memrealtime(); } while (0)
#define SEG_END(id) do { if ((id) == PROBE_SEG && blockIdx.x == 0 && threadIdx.x == 0) t_acc += __builtin_amdgcn_s_memrealtime() - t_s; } while (0)
#else
#define SEG_BEGIN(id) do {} while (0)
#define SEG_END(id) do {} while (0)
#endif
  SEG_BEGIN(0); p0_prologue(p, lds); xcd_barrier(bar); SEG_END(0);
  SEG_BEGIN(1); p1_norm_mix(p, 0); xcd_barrier(bar); SEG_END(1);
#pragma unroll 1
  for (int l = 0; l < 2; ++l) {
    const int nrows = l == 0 ? NT : NL;
    SEG_BEGIN(2 + 10 * l); p2_inproj(p, l, lds); xcd_barrier(bar); SEG_END(2 + 10 * l);
    SEG_BEGIN(3 + 10 * l); p3_attention(p, l, lds); xcd_barrier(bar); SEG_END(3 + 10 * l);
    SEG_BEGIN(4 + 10 * l); p4_outproj(p, l, nrows, lds); xcd_barrier(bar); SEG_END(4 + 10 * l);
    SEG_BEGIN(5 + 10 * l); p5_norm_ffn(p, l, nrows, lds); xcd_barrier(bar); SEG_END(5 + 10 * l);
    SEG_BEGIN(6 + 10 * l); p6_gateup(p, l, nrows, lds); xcd_barrier(bar); SEG_END(6 + 10 * l);
    SEG_BEGIN(7 + 10 * l); p7_down(p, l, nrows, lds); xcd_barrier(bar); SEG_END(7 + 10 * l);
    SEG_BEGIN(8 + 10 * l); p8_combine(p, l, nrows); if (l == 0) xcd_barrier(bar); SEG_END(8 + 10 * l);
  }
#ifdef PROBE_SEG
  if (blockIdx.x == 0 && threadIdx.x == 0) {
    const unsigned long long t0 = __builtin_amdgcn_s_memrealtime();
    while (__builtin_amdgcn_s_memrealtime() - t0 < 9ull * t_acc) __builtin_amdgcn_s_sleep(8);
  }
#endif
}

template <int PH>
__global__ __launch_bounds__(NTHR, 2) void k_phase(Params p, int layer, int nrows) {
  extern __shared__ __attribute__((aligned(16))) unsigned char smem[];
  LAS char* lds = (LAS char*)smem;
  if (PH == 0) p0_prologue(p, lds);
  if (PH == 1) p1_norm_mix(p, layer);
  if (PH == 2) p2_inproj(p, layer, lds);
  if (PH == 3) p3_attention(p, layer, lds);
  if (PH == 4) p4_outproj(p, layer, nrows, lds);
  if (PH == 5) p5_norm_ffn(p, layer, nrows, lds);
  if (PH == 6) p6_gateup(p, layer, nrows, lds);
  if (PH == 7) p7_down(p, layer, nrows, lds);
  if (PH == 8) p8_combine(p, layer, nrows);
}

extern "C" void kernel_launch(void* const* d_in, const int* in_sizes, int n_in, void* d_out, int out_size, void* d_ws, size_t ws_size, hipStream_t stream) {
  Params p{};
  p.x = (const float*)d_in[0]; p.c = (const float*)d_in[1]; p.ctx = (const float*)d_in[2]; p.c_ctx = (const float*)d_in[3];
  p.w_mod = (const float*)d_in[4]; p.b_mod = (const float*)d_in[5]; p.norm_mix_g = (const float*)d_in[6]; p.norm_ffn_g = (const float*)d_in[7];
  p.w_in = (const float*)d_in[8]; p.w_out = (const float*)d_in[9]; p.swa_sink = (const float*)d_in[10]; p.glb_q_gain = (const float*)d_in[11];
  p.glb_k_gain = (const float*)d_in[12]; p.mla_q_gain = (const float*)d_in[13]; p.mla_w_uq = (const float*)d_in[14]; p.mla_kv_gain = (const float*)d_in[15];
  p.mla_w_ukv = (const float*)d_in[16]; p.router_w = (const float*)d_in[17]; p.router_bias = (const float*)d_in[18]; p.exp_w_gate = (const float*)d_in[19];
  p.exp_w_up = (const float*)d_in[20]; p.exp_w_down = (const float*)d_in[21]; p.shr_w_gate = (const float*)d_in[22]; p.shr_w_up = (const float*)d_in[23];
  p.shr_w_down = (const float*)d_in[24]; p.final_norm_g = (const float*)d_in[25];
  p.out = (float*)d_out; p.ws = (char*)d_ws;
  char* ws = (char*)d_ws;

#ifndef MEGA
#define MEGA 1
#endif
#if MEGA
  static int grid_blocks = 0;
  if (!grid_blocks) {
    (void)hipFuncSetAttribute((const void*)k_mega, hipFuncAttributeMaxDynamicSharedMemorySize, LDS_BYTES);
    int dev = 0, cus = 0, per_cu = 0;
    (void)hipGetDevice(&dev);
    (void)hipDeviceGetAttribute(&cus, hipDeviceAttributeMultiprocessorCount, dev);
    (void)hipOccupancyMaxActiveBlocksPerMultiprocessor(&per_cu, (const void*)k_mega, NTHR, LDS_BYTES);
    if (per_cu > 2) per_cu = 2;
    if (per_cu < 1) per_cu = 1;
    grid_blocks = cus * per_cu;
  }
  (void)hipMemsetAsync(ws + OFF_CTRL, 0, CTRL_BYTES, stream);
  void* args[] = {&p};
  hipError_t e = hipLaunchCooperativeKernel((const void*)k_mega, dim3(grid_blocks), dim3(NTHR), args, LDS_BYTES, stream);
  if (e != hipSuccess) fprintf(stderr, "cooperative launch failed: %s (grid %d)\n", hipGetErrorString(e), grid_blocks);
#else
  static bool attr_done = false;
  if (!attr_done) {
    (void)hipFuncSetAttribute((const void*)k_phase<0>, hipFuncAttributeMaxDynamicSharedMemorySize, LDS_BYTES);
    (void)hipFuncSetAttribute((const void*)k_phase<1>, hipFuncAttributeMaxDynamicSharedMemorySize, LDS_BYTES);
    (void)hipFuncSetAttribute((const void*)k_phase<2>, hipFuncAttributeMaxDynamicSharedMemorySize, LDS_BYTES);
    (void)hipFuncSetAttribute((const void*)k_phase<3>, hipFuncAttributeMaxDynamicSharedMemorySize, LDS_BYTES);
    (void)hipFuncSetAttribute((const void*)k_phase<4>, hipFuncAttributeMaxDynamicSharedMemorySize, LDS_BYTES);
    (void)hipFuncSetAttribute((const void*)k_phase<5>, hipFuncAttributeMaxDynamicSharedMemorySize, LDS_BYTES);
    (void)hipFuncSetAttribute((const void*)k_phase<6>, hipFuncAttributeMaxDynamicSharedMemorySize, LDS_BYTES);
    (void)hipFuncSetAttribute((const void*)k_phase<7>, hipFuncAttributeMaxDynamicSharedMemorySize, LDS_BYTES);
    (void)hipFuncSetAttribute((const void*)k_phase<8>, hipFuncAttributeMaxDynamicSharedMemorySize, LDS_BYTES);
    attr_done = true;
  }

  (void)hipMemsetAsync(ws + OFF_CTRL, 0, CTRL_BYTES, stream);
  k_phase<0><<<GRID, NTHR, LDS_BYTES, stream>>>(p, 0, 0);
  k_phase<1><<<GRID, NTHR, LDS_BYTES, stream>>>(p, 0, NT);
  for (int l = 0; l < 2; ++l) {
    const bool last = (l == 1);
    const int Mres = last ? NL : NT;
    k_phase<2><<<GRID, NTHR, LDS_BYTES, stream>>>(p, l, NT);
    k_phase<3><<<GRID, NTHR, LDS_BYTES, stream>>>(p, l, NT);
    k_phase<4><<<GRID, NTHR, LDS_BYTES, stream>>>(p, l, Mres);
    k_phase<5><<<GRID, NTHR, LDS_BYTES, stream>>>(p, l, Mres);
    k_phase<6><<<GRID, NTHR, LDS_BYTES, stream>>>(p, l, Mres);
    k_phase<7><<<GRID, NTHR, LDS_BYTES, stream>>>(p, l, Mres);
    k_phase<8><<<GRID, NTHR, LDS_BYTES, stream>>>(p, l, Mres);
  }
#endif
}
```

```cpp
#include <hip/hip_runtime.h>
#include <hip/hip_cooperative_groups.h>
#include <cstdio>
#include <stdint.h>
#include <stddef.h>

typedef unsigned short u16;
typedef short bf16x8 __attribute__((ext_vector_type(8)));
typedef float f32x4 __attribute__((ext_vector_type(4)));
typedef float f32x2_t __attribute__((ext_vector_type(2)));
typedef __bf16 bf16x2_t __attribute__((ext_vector_type(2)));
typedef unsigned u32x2_t __attribute__((ext_vector_type(2)));
typedef unsigned u32x4_t __attribute__((ext_vector_type(4)));
#define DI __device__ __forceinline__
#define LAS __attribute__((address_space(3)))

constexpr int B_ = 8, S_ = 4096, D_ = 1024, C_ = 256;
constexpr int NL = B_ * S_, NC = B_ * C_, NT = NL + NC;
constexpr int INW = 1696, INWP = 1792;
constexpr int NE = 16;
constexpr int MAXSLOT = NT * 2 + NE * 128;
constexpr float EPS = 1e-6f;
constexpr int NTHR = 256;
constexpr int GRID = 512;

DI float bf2f(u16 v) { return __uint_as_float(((unsigned)v) << 16); }
DI float bflo(unsigned u) { return __uint_as_float(u << 16); }
DI float bfhi(unsigned u) { return __uint_as_float(u & 0xffff0000u); }
DI unsigned cvtpk(float lo, float hi) { f32x2_t v = {lo, hi}; bf16x2_t b = __builtin_convertvector(v, bf16x2_t); return __builtin_bit_cast(unsigned, b); }
template <int CTRL> DI float dpp_mov(float v) { return __int_as_float(__builtin_amdgcn_update_dpp(0, __float_as_int(v), CTRL, 0xf, 0xf, false)); }
DI float wave_sum(float v) {
  v += dpp_mov<0xB1>(v);
  v += dpp_mov<0x4E>(v);
  v += dpp_mov<0x141>(v);
  v += dpp_mov<0x140>(v);
  { auto rr = __builtin_amdgcn_permlane16_swap(__float_as_uint(v), __float_as_uint(v), false, false); v = __uint_as_float(rr[0]) + __uint_as_float(rr[1]); }
  { auto rr = __builtin_amdgcn_permlane32_swap(__float_as_uint(v), __float_as_uint(v), false, false); v = __uint_as_float(rr[0]) + __uint_as_float(rr[1]); }
  return v;
}
DI float silu(float g) { return g / (1.f + __expf(-g)); }
DI int opaque(int v) { asm volatile("" : "+v"(v)); return v; }

constexpr size_t al256(size_t x) { return (x + 255) & ~(size_t)255; }
constexpr size_t OFF_CTRL = 0;
constexpr size_t CTRL_BYTES = 65536;
constexpr size_t OFF_CTXR = OFF_CTRL + CTRL_BYTES;
constexpr size_t OFF_MOD = OFF_CTXR + al256((size_t)NC * D_ * 4);
constexpr size_t OFF_TOKE = OFF_MOD + al256((size_t)2 * 9 * 6144 * 4);
constexpr size_t OFF_TOKW = OFF_TOKE + al256((size_t)NT * 2 * 4);
constexpr size_t OFF_TOKP = OFF_TOKW + al256((size_t)NT * 2 * 4);
constexpr size_t OFF_LIST = OFF_TOKP + al256((size_t)NT * 2 * 4);
constexpr size_t OFF_WIN = OFF_LIST + al256((size_t)NE * NT * 4);
constexpr size_t OFF_WO = OFF_WIN + (size_t)2 * INWP * 1024 * 2;
constexpr size_t OFF_WUQ = OFF_WO + (size_t)2 * 1024 * 1024 * 2;
constexpr size_t OFF_WUKV = OFF_WUQ + (size_t)2 * 384 * 256 * 2;
constexpr size_t OFF_WGU = OFF_WUKV + (size_t)2 * 512 * 128 * 2;
constexpr size_t OFF_WD = OFF_WGU + (size_t)2 * 16 * 1024 * 1024 * 2;
constexpr size_t OFF_SGU = OFF_WD + (size_t)2 * 16 * 1024 * 512 * 2;
constexpr size_t OFF_SD = OFF_SGU + (size_t)2 * 1024 * 1024 * 2;
constexpr size_t OFF_H = OFF_SD + (size_t)2 * 1024 * 512 * 2;
constexpr size_t OFF_BIG = OFF_H + (size_t)NT * 1024 * 2;
constexpr size_t OFF_SWQ = OFF_BIG;
constexpr size_t OFF_SWK = OFF_SWQ + (size_t)NT * 384 * 2;
constexpr size_t OFF_SWV = OFF_SWK + (size_t)NT * 128 * 2;
constexpr size_t OFF_GLQ = OFF_SWV + (size_t)NT * 128 * 2;
constexpr size_t OFF_GLK = OFF_GLQ + (size_t)NT * 384 * 2;
constexpr size_t OFF_GLV = OFF_GLK + (size_t)NT * 128 * 2;
constexpr size_t OFF_MLQ = OFF_GLV + (size_t)NT * 128 * 2;
constexpr size_t OFF_MLK = OFF_MLQ + (size_t)NT * 384 * 2;
constexpr size_t OFF_MLKR = OFF_MLK + (size_t)NT * 256 * 2;
constexpr size_t OFF_MLV = OFF_MLKR + (size_t)NT * 32 * 2;
constexpr size_t OFF_QLAT = OFF_MLV + (size_t)NT * 256 * 2;
constexpr size_t OFF_KVLAT = OFF_QLAT + (size_t)NT * 256 * 2;
constexpr size_t OFF_Y = OFF_KVLAT + (size_t)NT * 128 * 2;
constexpr size_t END_A = OFF_Y + (size_t)NT * 1024 * 2;
constexpr size_t OFF_ACT = OFF_BIG;
constexpr size_t OFF_ACTS = OFF_ACT + (size_t)MAXSLOT * 512 * 2;
constexpr size_t OFF_YEXP = OFF_ACTS + (size_t)NT * 512 * 2;
constexpr size_t END_B = OFF_YEXP + (size_t)MAXSLOT * 1024 * 2;
constexpr size_t OFF_YSH = OFF_H;
constexpr size_t OFF_DELTA = OFF_SWQ;
static_assert(OFF_DELTA + (size_t)NT * 1024 * 2 <= OFF_MLQ, "DELTA must fit below MLQ");
constexpr size_t WS_NEED = END_A > END_B ? END_A : END_B;
static_assert(WS_NEED <= (size_t)536870912, "workspace too large");

constexpr int CW_CTR = 0;
constexpr int CW_CNT = 8192;
constexpr int CW_Q = 10240;

struct Params {
  const float *x, *c, *ctx, *c_ctx, *w_mod, *b_mod, *norm_mix_g, *norm_ffn_g, *w_in, *w_out, *swa_sink, *glb_q_gain, *glb_k_gain,
      *mla_q_gain, *mla_w_uq, *mla_kv_gain, *mla_w_ukv, *router_w, *router_bias, *exp_w_gate, *exp_w_up, *exp_w_down, *shr_w_gate,
      *shr_w_up, *shr_w_down, *final_norm_g;
  float* out;
  char* ws;
  int never; int pad;
};

constexpr int LDS_MISC = 65536;
constexpr int LDS_BYTES = 65536 + 8192;

DI int next_unit(unsigned* ctr, LAS char* lds) {
  volatile LAS int* slot = (volatile LAS int*)(lds + LDS_MISC + 2560);
  __syncthreads();
  if (threadIdx.x == 0) *slot = (int)atomicAdd(ctr, 1u);
  __syncthreads();
  return *slot;
}

DI unsigned xcc_id_() { return (unsigned)__builtin_amdgcn_s_getreg((3 << 11) | 20) & 0x7u; }
DI int next_unit_xcd(unsigned* ctr8, int per_queue, LAS char* lds) {
  volatile LAS int* slot = (volatile LAS int*)(lds + LDS_MISC + 2560);
  __syncthreads();
  if (threadIdx.x == 0) {
    const int q0 = (int)xcc_id_();
    int res = -1;
    for (int i = 0; i < 8; ++i) {
      const int q = (q0 + i) & 7;
      const int v = (int)atomicAdd(&ctr8[q * 64], 1u);
      if (v < per_queue) { res = q * per_queue + v; break; }
    }
    *slot = res;
  }
  __syncthreads();
  return *slot;
}
DI void cvt_job(const float* __restrict__ src, int ld, int N, int k0, int n0, u16* __restrict__ dst, int K, int mode  , LAS char* lds) {
  LAS float* T = (LAS float*)lds;
  const int tid = threadIdx.x;
  __syncthreads();
  {
    const int kk = tid >> 2, nq = (tid & 3) * 32;
    const float* s = src + (size_t)(k0 + kk) * ld + n0 + nq;
#pragma unroll
    for (int i = 0; i < 8; ++i) {
      float4 v = make_float4(0.f, 0.f, 0.f, 0.f);
      if (n0 + nq + i * 4 < N) v = *(const float4*)(s + i * 4);
      LAS float* t = T + kk * 129 + nq + i * 4;
      t[0] = v.x; t[1] = v.y; t[2] = v.z; t[3] = v.w;
    }
  }
  __syncthreads();
#pragma unroll
  for (int i = 0; i < 4; ++i) {
    const int chn = tid + i * 256;
    const int n = chn >> 3, kc = (chn & 7) * 8;
    if (n0 + n < N) {
      const LAS float* t = T + kc * 129 + n;
      uint4 o;
      o.x = cvtpk(t[0], t[129]); o.y = cvtpk(t[2 * 129], t[3 * 129]); o.z = cvtpk(t[4 * 129], t[5 * 129]); o.w = cvtpk(t[6 * 129], t[7 * 129]);
      const int gn = n0 + n;
      int drow = gn;
      if (mode) drow = (gn >> 5) * 64 + (gn & 31) + (mode == 2 ? 32 : 0);
      *(uint4*)(dst + (size_t)drow * K + k0 + kc) = o;
    }
  }
}

DI void mod_job(const Params& p, int l, int j0, LAS char* lds) {
  LAS float* sc = (LAS float*)lds;
  LAS float* red = (LAS float*)(lds + 36864);
  const int tid = threadIdx.x;
  __syncthreads();
  for (int i = tid; i < 9 * 1024; i += NTHR) {
    int r = i >> 10, k = i & 1023;
    float v = r < 8 ? p.c[r * 1024 + k] : p.c_ctx[k];
    sc[i] = v / (1.f + __expf(-v));
  }
  __syncthreads();
  const int col = tid & 31, kg = tid >> 5;
  float acc[9];
#pragma unroll
  for (int r = 0; r < 9; ++r) acc[r] = 0.f;
  const float* w = p.w_mod + (size_t)l * 1024 * 6144 + (size_t)(kg * 128) * 6144 + j0 + col;
#pragma unroll 1
  for (int k0 = 0; k0 < 128; k0 += 16) {
    float wv[16];
#pragma unroll
    for (int u = 0; u < 16; ++u) wv[u] = w[(size_t)(k0 + u) * 6144];
#pragma unroll
    for (int u = 0; u < 16; ++u)
#pragma unroll
      for (int r = 0; r < 9; ++r) acc[r] += sc[r * 1024 + kg * 128 + k0 + u] * wv[u];
  }
#pragma unroll
  for (int r = 0; r < 9; ++r) red[(kg * 9 + r) * 32 + col] = acc[r];
  __syncthreads();
  float* MOD = (float*)(p.ws + OFF_MOD);
  for (int i = tid; i < 9 * 32; i += NTHR) {
    int r = i >> 5, cc = i & 31;
    float sum = 0.f;
#pragma unroll
    for (int g = 0; g < 8; ++g) sum += red[(g * 9 + r) * 32 + cc];
    MOD[(size_t)(l * 9 + r) * 6144 + j0 + cc] = sum + p.b_mod[l * 6144 + j0 + cc];
  }
}

constexpr int J_WIN = 16 * 14, J_WO = 16 * 8, J_UQ = 4 * 3, J_UKV = 2 * 4, J_EG = 16 * 4, J_ED = 8 * 8;
constexpr int J_DENSE = J_WIN + J_WO + J_UQ + J_UKV;
constexpr int J_EXP = 16 * (2 * J_EG + J_ED);
constexpr int J_SHR = 2 * J_EG + J_ED;
constexpr int J_LAYER = J_DENSE + J_EXP + J_SHR;
constexpr int J_MOD = 2 * 192;
constexpr int J_TOTAL = 2 * J_LAYER + J_MOD;

DI void p0_prologue(const Params& p, LAS char* lds) {
  char* ws = p.ws;
  for (int job = blockIdx.x; job < J_TOTAL; job += gridDim.x) {
    if (job < J_MOD) { mod_job(p, job / 192, (job % 192) * 32, lds); continue; }
    int r = job - J_MOD;
    const int l = r / J_LAYER; r -= l * J_LAYER;
    if (r < J_WIN) { cvt_job(p.w_in + (size_t)l * 1024 * INW, INW, INW, (r / 14) * 64, (r % 14) * 128, (u16*)(ws + OFF_WIN) + (size_t)l * INWP * 1024, 1024, 0, lds); continue; } r -= J_WIN;
    if (r < J_WO) { cvt_job(p.w_out + (size_t)l * 1024 * 1024, 1024, 1024, (r / 8) * 64, (r % 8) * 128, (u16*)(ws + OFF_WO) + (size_t)l * 1024 * 1024, 1024, 0, lds); continue; } r -= J_WO;
    if (r < J_UQ) { cvt_job(p.mla_w_uq + (size_t)l * 256 * 384, 384, 384, (r / 3) * 64, (r % 3) * 128, (u16*)(ws + OFF_WUQ) + (size_t)l * 384 * 256, 256, 0, lds); continue; } r -= J_UQ;
    if (r < J_UKV) { cvt_job(p.mla_w_ukv + (size_t)l * 128 * 512, 512, 512, (r / 4) * 64, (r % 4) * 128, (u16*)(ws + OFF_WUKV) + (size_t)l * 512 * 128, 128, 0, lds); continue; } r -= J_UKV;
    if (r < J_EXP) {
      const int e = r / (2 * J_EG + J_ED); int q = r % (2 * J_EG + J_ED);
      const size_t le = (size_t)l * NE + e;
      if (q < J_EG) { cvt_job(p.exp_w_gate + le * 1024 * 512, 512, 512, (q / 4) * 64, (q % 4) * 128, (u16*)(ws + OFF_WGU) + le * 1024 * 1024, 1024, 1, lds); continue; } q -= J_EG;
      if (q < J_EG) { cvt_job(p.exp_w_up + le * 1024 * 512, 512, 512, (q / 4) * 64, (q % 4) * 128, (u16*)(ws + OFF_WGU) + le * 1024 * 1024, 1024, 2, lds); continue; } q -= J_EG;
      cvt_job(p.exp_w_down + le * 512 * 1024, 1024, 1024, (q / 8) * 64, (q % 8) * 128, (u16*)(ws + OFF_WD) + le * 1024 * 512, 512, 0, lds); continue;
    }
    r -= J_EXP;
    if (r < J_EG) { cvt_job(p.shr_w_gate + (size_t)l * 1024 * 512, 512, 512, (r / 4) * 64, (r % 4) * 128, (u16*)(ws + OFF_SGU) + (size_t)l * 1024 * 1024, 1024, 1, lds); continue; } r -= J_EG;
    if (r < J_EG) { cvt_job(p.shr_w_up + (size_t)l * 1024 * 512, 512, 512, (r / 4) * 64, (r % 4) * 128, (u16*)(ws + OFF_SGU) + (size_t)l * 1024 * 1024, 1024, 2, lds); continue; } r -= J_EG;
    cvt_job(p.shr_w_down + (size_t)l * 512 * 1024, 1024, 1024, (r / 8) * 64, (r % 8) * 128, (u16*)(ws + OFF_SD) + (size_t)l * 1024 * 512, 512, 0, lds);
  }
}

DI const float* xrow_ptr(const Params& p, int layer_src  , int row) {
  if (layer_src == 0) return row < NL ? p.x + (size_t)row * 1024 : p.ctx + (size_t)(row - NL) * 1024;
  return row < NL ? p.out + (size_t)row * 1024 : (const float*)(p.ws + OFF_CTXR) + (size_t)(row - NL) * 1024;
}
DI float* xrow_out(const Params& p, int row) {
  return row < NL ? p.out + (size_t)row * 1024 : (float*)(p.ws + OFF_CTXR) + (size_t)(row - NL) * 1024;
}

DI void norm_mod_row(f32x4 (&v)[4], const float* __restrict__ g, const float* __restrict__ md  , int lane) {
  float ss = 0.f;
#pragma unroll
  for (int i = 0; i < 4; ++i) ss += v[i].x * v[i].x + v[i].y * v[i].y + v[i].z * v[i].z + v[i].w * v[i].w;
  ss = wave_sum(ss);
  const float rstd = rsqrtf(ss * (1.f / 1024.f) + EPS);
#pragma unroll
  for (int i = 0; i < 4; ++i) {
    const f32x4 gg = *(const f32x4*)(g + lane * 4 + i * 256);
    const f32x4 sh = *(const f32x4*)(md + lane * 4 + i * 256);
    const f32x4 sc = *(const f32x4*)(md + 1024 + lane * 4 + i * 256);
    v[i] = v[i] * rstd * gg * (sc + 1.f) + sh;
  }
}
DI void store_h_row(const f32x4 (&v)[4], u16* __restrict__ hrow, int lane) {
#pragma unroll
  for (int i = 0; i < 4; ++i) {
    uint2 o; o.x = cvtpk(v[i].x, v[i].y); o.y = cvtpk(v[i].z, v[i].w);
    *(uint2*)(hrow + lane * 4 + i * 256) = o;
  }
}

DI void p1_norm_mix(const Params& p, int layer) {
  const int tid_ = opaque((int)threadIdx.x); const int lane = tid_ & 63, gw = blockIdx.x * 4 + (tid_ >> 6), ngw = gridDim.x * 4;
  const float* MODl = (const float*)(p.ws + OFF_MOD) + (size_t)layer * 9 * 6144;
  u16* H = (u16*)(p.ws + OFF_H);
  f32x4 vn[4];
  int row = gw;
  if (row < NT) { const float* xr = xrow_ptr(p, layer, row);
#pragma unroll
    for (int i = 0; i < 4; ++i) vn[i] = __builtin_nontemporal_load((const f32x4*)(xr + lane * 4 + i * 256)); }
  while (row < NT) {
    f32x4 v[4];
#pragma unroll
    for (int i = 0; i < 4; ++i) v[i] = vn[i];
    const int rown = row + ngw;
    if (rown < NT) { const float* xr = xrow_ptr(p, layer, rown);
#pragma unroll
      for (int i = 0; i < 4; ++i) vn[i] = __builtin_nontemporal_load((const f32x4*)(xr + lane * 4 + i * 256)); }
    const int mr = row < NL ? row / S_ : 8;
    norm_mod_row(v, p.norm_mix_g + layer * 1024, MODl + (size_t)mr * 6144, lane);
    store_h_row(v, H + (size_t)row * 1024, lane);
    row = rown;
  }
}

DI float max2nd4(float a, float b, float c, float d, float& m1) {
  const float ab = fmaxf(a, b), cd = fmaxf(c, d);
  m1 = fmaxf(ab, cd);
  return fmaxf(fmaxf(fminf(a, b), fminf(c, d)), fminf(ab, cd));
}
template <int CTRL> DI float dppz(float v) { return __int_as_float(__builtin_amdgcn_update_dpp(0, __float_as_int(v), CTRL, 0xf, 0xf, true)); }
DI float lane_xor4(float v, bool b2) { const float a = dppz<0x114>(v), b = dppz<0x104>(v); return b2 ? a : b; }
DI float lane_xor8(float v, bool b3) { const float a = dppz<0x118>(v), b = dppz<0x108>(v); return b3 ? a : b; }
DI bool beats(float a, int ia, float b, int ib) { return a > b || (a == b && ia < ib); }
DI void route_row(float bias_lane, const f32x4 (&v)[4], LAS char* lds, int lane, int& i0, int& i1, float& w0, float& w1) {
  const LAS f32x4* R = (const LAS f32x4*)lds;
  f32x4 pl4[4];
#pragma unroll
  for (int q = 0; q < 4; ++q) pl4[q] = (f32x4){0.f, 0.f, 0.f, 0.f};
#pragma unroll
  for (int i = 0; i < 4; ++i) {
    const int kq = i * 64 + lane;
    f32x4 wq[16];
#pragma unroll
    for (int j = 0; j < 16; ++j) wq[j] = R[j * 256 + kq];
    __builtin_amdgcn_sched_barrier(0);
#pragma unroll
    for (int kk = 0; kk < 4; ++kk) {
      const float hv = v[i][kk];
      const f32x4 hv4 = (f32x4){hv, hv, hv, hv};
#pragma unroll
      for (int q = 0; q < 4; ++q) pl4[q] = __builtin_elementwise_fma(hv4, wq[kk * 4 + q], pl4[q]);
    }
    __builtin_amdgcn_sched_barrier(0);
  }
  float pl[16];
#pragma unroll
  for (int q = 0; q < 4; ++q) { pl[q * 4 + 0] = pl4[q][0]; pl[q * 4 + 1] = pl4[q][1]; pl[q * 4 + 2] = pl4[q][2]; pl[q * 4 + 3] = pl4[q][3]; }
  const bool b0 = (lane & 1) != 0, b1 = (lane & 2) != 0, b2 = (lane & 4) != 0, b3 = (lane & 8) != 0;
  float r8[8], r4[4], r2[2];
#pragma unroll
  for (int i = 0; i < 8; ++i) { const float keep = b0 ? pl[i + 8] : pl[i], send = b0 ? pl[i] : pl[i + 8]; r8[i] = keep + dppz<0xB1>(send); }
#pragma unroll
  for (int i = 0; i < 4; ++i) { const float keep = b1 ? r8[i + 4] : r8[i], send = b1 ? r8[i] : r8[i + 4]; r4[i] = keep + dppz<0x4E>(send); }
#pragma unroll
  for (int i = 0; i < 2; ++i) { const float keep = b2 ? r4[i + 2] : r4[i], send = b2 ? r4[i] : r4[i + 2]; r2[i] = keep + lane_xor4(send, b2); }
  float lg;
  { const float keep = b3 ? r2[1] : r2[0], send = b3 ? r2[0] : r2[1]; lg = keep + lane_xor8(send, b3); }
  { auto rr = __builtin_amdgcn_permlane16_swap(__float_as_uint(lg), __float_as_uint(lg), false, false); lg = __uint_as_float(rr[0]) + __uint_as_float(rr[1]); }
  { auto rr = __builtin_amdgcn_permlane32_swap(__float_as_uint(lg), __float_as_uint(lg), false, false); lg = __uint_as_float(rr[0]) + __uint_as_float(rr[1]); }
  const float sg = __builtin_amdgcn_rcpf(1.f + __builtin_amdgcn_exp2f(-1.4426950408889634f * lg));
  const float bv = sg + bias_lane;
  const float m1v = lane_xor4(bv, b2), m2v = lane_xor8(bv, b3), m3v = lane_xor8(m1v, b3);
  float mtop; const float m2nd = max2nd4(bv, m1v, m2v, m3v, mtop);
  const float gs = mtop + m2nd;
  const float gA = dppz<0xB1>(gs), gB = dppz<0x4E>(gs), gC = dppz<0x1B>(gs);
  const int g = (b0 ? 2 : 0) + (b1 ? 1 : 0);
  const bool win = beats(gs, g, gA, g ^ 2) && beats(gs, g, gB, g ^ 1) && beats(gs, g, gC, g ^ 3);
  const int el = (b2 ? 2 : 0) + (b3 ? 1 : 0);
  const int rank = (beats(m1v, el ^ 2, bv, el) ? 1 : 0) + (beats(m2v, el ^ 1, bv, el) ? 1 : 0) + (beats(m3v, el ^ 3, bv, el) ? 1 : 0);
  const unsigned long long k0 = __ballot(win && rank == 0), k1 = __ballot(win && rank == 1);
  const int L0 = __builtin_ctzll(k0 | (1ull << 63)), L1 = __builtin_ctzll(k1 | (1ull << 63));
  const float s0 = __int_as_float(__builtin_amdgcn_readlane(__float_as_int(sg), L0));
  const float s1 = __int_as_float(__builtin_amdgcn_readlane(__float_as_int(sg), L1));
  i0 = 8 * (L0 & 1) + 4 * ((L0 >> 1) & 1) + 2 * ((L0 >> 2) & 1) + ((L0 >> 3) & 1);
  i1 = 8 * (L1 & 1) + 4 * ((L1 >> 1) & 1) + 2 * ((L1 >> 2) & 1) + ((L1 >> 3) & 1);
  const float inv = 1.f / (s0 + s1);
  w0 = s0 * inv; w1 = s1 * inv;
}

DI void load_router_lds(const Params& p, LAS char* lds) {
  LAS f32x4* R = (LAS f32x4*)lds;
  __syncthreads();
  for (int g = threadIdx.x; g < 4096; g += NTHR) {
    const int k = g >> 2, q = g & 3;
    R[((k & 3) * 4 + q) * 256 + (k >> 2)] = *(const f32x4*)(p.router_w + (size_t)g * 4);
  }
  __syncthreads();
}

constexpr int CNT_STRIDE = 64;
DI void p5_norm_ffn(const Params& p, int layer, int nrows, LAS char* lds) {
  load_router_lds(p, lds);
  const int tid = opaque((int)threadIdx.x), lane = tid & 63, wid = tid >> 6, gw = blockIdx.x * 4 + wid, ngw = gridDim.x * 4;
  const float* MODl = (const float*)(p.ws + OFF_MOD) + (size_t)layer * 9 * 6144;
  u16* H = (u16*)(p.ws + OFF_H);
  volatile LAS int* lcnt = (volatile LAS int*)(lds + LDS_MISC + 3072);
  volatile LAS int* lbase = lcnt + 16;
  volatile LAS int* stash = (volatile LAS int*)(lds + LDS_MISC + 4096) + wid * 160;
  int* tok_e = (int*)(p.ws + OFF_TOKE); float* tok_w = (float*)(p.ws + OFF_TOKW); int* tok_p = (int*)(p.ws + OFF_TOKP);
  int* list = (int*)(p.ws + OFF_LIST);
  unsigned* cnt = (unsigned*)(p.ws + OFF_CTRL) + CW_CNT + layer * 16 * CNT_STRIDE;
  if (tid < 16) lcnt[tid] = 0;
  __syncthreads();
  const float bias = p.router_bias[8 * (lane & 1) + 4 * ((lane >> 1) & 1) + 2 * ((lane >> 2) & 1) + ((lane >> 3) & 1)];
  int nst = 0;
  f32x4 vn[4]; u32x2_t dn[4];
  const u16* DELTA = (const u16*)(p.ws + OFF_DELTA);
  if (gw < nrows) { const float* xr0 = xrow_ptr(p, layer, gw);
#pragma unroll
    for (int i = 0; i < 4; ++i) { vn[i] = __builtin_nontemporal_load((const f32x4*)(xr0 + lane * 4 + i * 256)); dn[i] = __builtin_nontemporal_load((const u32x2_t*)(DELTA + (size_t)gw * 1024 + lane * 4 + i * 256)); } }
  for (int row = gw; row < nrows; row += ngw) {
    f32x4 v[4];
#pragma unroll
    for (int i = 0; i < 4; ++i) { v[i] = vn[i]; v[i][0] += bflo(dn[i][0]); v[i][1] += bfhi(dn[i][0]); v[i][2] += bflo(dn[i][1]); v[i][3] += bfhi(dn[i][1]); }
    if (row + ngw < nrows) { const float* xrn = xrow_ptr(p, layer, row + ngw);
#pragma unroll
      for (int i = 0; i < 4; ++i) { vn[i] = __builtin_nontemporal_load((const f32x4*)(xrn + lane * 4 + i * 256)); dn[i] = __builtin_nontemporal_load((const u32x2_t*)(DELTA + (size_t)(row + ngw) * 1024 + lane * 4 + i * 256)); } }
    { float* xw = xrow_out(p, row);
#pragma unroll
      for (int i = 0; i < 4; ++i) *(f32x4*)(xw + lane * 4 + i * 256) = v[i]; }
    const int mr = row < NL ? row / S_ : 8;
    norm_mod_row(v, p.norm_ffn_g + layer * 1024, MODl + (size_t)mr * 6144 + 3 * 1024, lane);
    store_h_row(v, H + (size_t)row * 1024, lane);
    int i0, i1; float w0, w1;
    route_row(bias, v, lds, lane, i0, i1, w0, w1);
    if (lane == 0) {
      const int lp0 = __hip_atomic_fetch_add((LAS int*)&lcnt[i0], 1, __ATOMIC_RELAXED, __HIP_MEMORY_SCOPE_WORKGROUP);
      const int lp1 = __hip_atomic_fetch_add((LAS int*)&lcnt[i1], 1, __ATOMIC_RELAXED, __HIP_MEMORY_SCOPE_WORKGROUP);
      tok_e[row * 2] = i0; tok_e[row * 2 + 1] = i1;
      tok_w[row * 2] = w0; tok_w[row * 2 + 1] = w1;
      stash[nst * 4 + 0] = i0; stash[nst * 4 + 1] = lp0; stash[nst * 4 + 2] = i1; stash[nst * 4 + 3] = lp1;
    }
    ++nst;
  }
  __syncthreads();
  if (tid < 16) { const int c = lcnt[tid]; lbase[tid] = c > 0 ? (int)atomicAdd(&cnt[tid * CNT_STRIDE], (unsigned)c) : 0; }
  __syncthreads();
  if (lane == 0) {
    int k = 0;
    for (int row = gw; row < nrows; row += ngw, ++k) {
      const int e0 = stash[k * 4 + 0], e1 = stash[k * 4 + 2];
      const int p0 = lbase[e0] + stash[k * 4 + 1], p1 = lbase[e1] + stash[k * 4 + 3];
      tok_p[row * 2] = p0; tok_p[row * 2 + 1] = p1;
      list[(size_t)e0 * NT + p0] = row; list[(size_t)e1 * NT + p1] = row;
    }
  }
}

DI void seg_scan(const Params& p, int layer, int (&tb)[NE + 1]) {
  const unsigned* cnt = (const unsigned*)(p.ws + OFF_CTRL) + CW_CNT + layer * 16 * CNT_STRIDE;
  int acc = 0;
#pragma unroll
  for (int e = 0; e < NE; ++e) { tb[e] = acc; acc += ((int)cnt[e * CNT_STRIDE] + 127) >> 7; }
  tb[NE] = acc;
}

DI void p8_combine(const Params& p, int layer, int nrows) {
  const int tid_ = opaque((int)threadIdx.x); const int lane = tid_ & 63, gw = blockIdx.x * 4 + (tid_ >> 6), ngw = gridDim.x * 4;
  const float* MODl = (const float*)(p.ws + OFF_MOD) + (size_t)layer * 9 * 6144;
  const float* MODn = (const float*)(p.ws + OFF_MOD) + (size_t)(layer + 1) * 9 * 6144;
  u16* H = (u16*)(p.ws + OFF_H);
  const u16* YSH = (const u16*)(p.ws + OFF_YSH);
  const u16* YEXP = (const u16*)(p.ws + OFF_YEXP);
  const int* tok_e = (const int*)(p.ws + OFF_TOKE); const float* tok_w = (const float*)(p.ws + OFF_TOKW); const int* tok_p = (const int*)(p.ws + OFF_TOKP);
  int tb[NE + 1]; seg_scan(p, layer, tb);
  int me0 = 0, me1 = 0, mp0 = 0, mp1 = 0; float mw0 = 0.f, mw1 = 0.f;
  u32x2_t an[4], bn[4], cn[4]; f32x4 xn[4]; float nw0 = 0.f, nw1 = 0.f;
#define P8_META(r) do { me0 = tok_e[(r) * 2]; me1 = tok_e[(r) * 2 + 1]; mp0 = tok_p[(r) * 2]; mp1 = tok_p[(r) * 2 + 1]; mw0 = tok_w[(r) * 2]; mw1 = tok_w[(r) * 2 + 1]; } while (0)
#define P8_DATA(r) do { int ps0 = 0, ps1 = 0; _Pragma("unroll") for (int e = 0; e < NE; ++e) { if (e == me0) ps0 = tb[e]; if (e == me1) ps1 = tb[e]; } \
    const size_t s0 = (size_t)ps0 * 128 + mp0, s1 = (size_t)ps1 * 128 + mp1; nw0 = mw0; nw1 = mw1; const float* xrn = xrow_out(p, (r)); \
    _Pragma("unroll") for (int i = 0; i < 4; ++i) { const int cidx = lane * 4 + i * 256; \
      an[i] = __builtin_nontemporal_load((const u32x2_t*)(YEXP + s0 * 1024 + cidx)); bn[i] = __builtin_nontemporal_load((const u32x2_t*)(YEXP + s1 * 1024 + cidx)); \
      cn[i] = __builtin_nontemporal_load((const u32x2_t*)(YSH + (size_t)(r) * 1024 + cidx)); xn[i] = __builtin_nontemporal_load((const f32x4*)(xrn + cidx)); } } while (0)
  if (gw < nrows) { P8_META(gw); P8_DATA(gw); }
  if (gw + ngw < nrows) P8_META(gw + ngw);
  for (int row = gw; row < nrows; row += ngw) {
    u32x2_t a[4], b[4], c[4]; f32x4 v[4];
#pragma unroll
    for (int i = 0; i < 4; ++i) { a[i] = an[i]; b[i] = bn[i]; c[i] = cn[i]; v[i] = xn[i]; }
    const float w0 = nw0, w1 = nw1;
    if (row + ngw < nrows) P8_DATA(row + ngw);
    if (row + 2 * ngw < nrows) P8_META(row + 2 * ngw);
    float* xr = xrow_out(p, row);
    const int mr = row < NL ? row / S_ : 8;
    const float* gate = MODl + (size_t)mr * 6144 + 5 * 1024;
#pragma unroll
    for (int i = 0; i < 4; ++i) {
      const int cidx = lane * 4 + i * 256;
      const f32x4 g = *(const f32x4*)(gate + cidx);
      f32x4 x = v[i];
      x.x += g.x * (w0 * bflo(a[i][0]) + w1 * bflo(b[i][0]) + bflo(c[i][0]));
      x.y += g.y * (w0 * bfhi(a[i][0]) + w1 * bfhi(b[i][0]) + bfhi(c[i][0]));
      x.z += g.z * (w0 * bflo(a[i][1]) + w1 * bflo(b[i][1]) + bflo(c[i][1]));
      x.w += g.w * (w0 * bfhi(a[i][1]) + w1 * bfhi(b[i][1]) + bfhi(c[i][1]));
      v[i] = x;
    }
    if (layer == 0) {
#pragma unroll
      for (int i = 0; i < 4; ++i) __builtin_nontemporal_store(v[i], (f32x4*)(xr + lane * 4 + i * 256));
      norm_mod_row(v, p.norm_mix_g + 1024, MODn + (size_t)mr * 6144, lane);
      store_h_row(v, H + (size_t)row * 1024, lane);
    } else {
      float ss = 0.f;
#pragma unroll
      for (int i = 0; i < 4; ++i) ss += v[i].x * v[i].x + v[i].y * v[i].y + v[i].z * v[i].z + v[i].w * v[i].w;
      ss = wave_sum(ss);
      const float rstd = rsqrtf(ss * (1.f / 1024.f) + EPS);
#pragma unroll
      for (int i = 0; i < 4; ++i) {
        const f32x4 gg = *(const f32x4*)(p.final_norm_g + lane * 4 + i * 256);
        __builtin_nontemporal_store(v[i] * rstd * gg, (f32x4*)(xr + lane * 4 + i * 256));
      }
    }
  }
#undef P8_META
#undef P8_DATA
}

DI void glds16(const u16* g, LAS char* l) {
  __builtin_amdgcn_global_load_lds((const void*)g, (LAS void*)l, 16, 0, 0);
}
struct TilePtrs { const u16 *a0, *a1, *b0, *b1; };
#define GT_ISSUE_P(T, kt, s) do { const int _ko = (kt) * 64; LAS char* _d = ldst + (s) * 32768; \
    glds16((T).a0 + _ko, _d); glds16((T).a1 + _ko, _d + 4096); glds16((T).a0 + _ko + 32, _d + 8192); glds16((T).a1 + _ko + 32, _d + 12288); \
    glds16((T).b0 + _ko, _d + 16384); glds16((T).b1 + _ko, _d + 20480); glds16((T).b0 + _ko + 32, _d + 24576); glds16((T).b1 + _ko + 32, _d + 28672); } while (0)
template <bool HOIST = true>
DI void gemm_tile_s(LAS char* lds, const TilePtrs& cur, bool issued, const TilePtrs& nxt, bool has_next, int nk, f32x4 (&acc)[4][4]) {
  const int tid = opaque((int)threadIdx.x), lane = tid & 63, wid = tid >> 6, wr = wid >> 1, wc = wid & 1, fr = lane & 15, fq = lane >> 4;
  const int cx = (fq ^ ((0 - (fr >> 2)) & 3)) * 16;
  const int aoff = (wr * 64 + fr) * 64 + cx;
  const int boff = 16384 + (wc * 64 + fr) * 64 + cx;
#pragma unroll
  for (int m = 0; m < 4; ++m)
#pragma unroll
    for (int n = 0; n < 4; ++n) acc[m][n] = (f32x4){0.f, 0.f, 0.f, 0.f};
  LAS char* ldst = lds + tid * 16;
  if (!issued) GT_ISSUE_P(cur, 0, 0);
#pragma unroll 1
  for (int kt = 0; kt < nk; ++kt) {
    asm volatile("s_waitcnt vmcnt(0)" ::: "memory");
    __syncthreads();
    if (kt + 1 < nk) GT_ISSUE_P(cur, kt + 1, (kt + 1) & 1);
    else if (has_next) GT_ISSUE_P(nxt, 0, 0);
    const LAS char* sb = lds + (kt & 1) * 32768;
    if (!HOIST) {
#pragma unroll
      for (int h = 0; h < 2; ++h) {
        bf16x8 af1[4], bf1[4];
#pragma unroll
        for (int m = 0; m < 4; ++m) af1[m] = *(const LAS bf16x8*)(sb + h * 8192 + aoff + m * 1024);
#pragma unroll
        for (int n = 0; n < 4; ++n) bf1[n] = *(const LAS bf16x8*)(sb + h * 8192 + boff + n * 1024);
#pragma unroll
        for (int m = 0; m < 4; ++m)
#pragma unroll
          for (int n = 0; n < 4; ++n) acc[m][n] = __builtin_amdgcn_mfma_f32_16x16x32_bf16(bf1[n], af1[m], acc[m][n], 0, 0, 0);
      }
      continue;
    }
    bf16x8 af[2][4], bfr[2][4];
    const unsigned aad = (unsigned)(size_t)(sb + aoff), bad = (unsigned)(size_t)(sb + boff);
#define GT_LDR(dst, ad, off) asm volatile("ds_read_b128 %0, %1 offset:%c2" : "=v"(dst) : "v"(ad), "i"(off))
    GT_LDR(af[0][0], aad, 0); GT_LDR(af[0][1], aad, 1024); GT_LDR(af[0][2], aad, 2048); GT_LDR(af[0][3], aad, 3072);
    GT_LDR(bfr[0][0], bad, 0); GT_LDR(bfr[0][1], bad, 1024); GT_LDR(bfr[0][2], bad, 2048); GT_LDR(bfr[0][3], bad, 3072);
    GT_LDR(af[1][0], aad, 8192); GT_LDR(af[1][1], aad, 8192 + 1024); GT_LDR(af[1][2], aad, 8192 + 2048); GT_LDR(af[1][3], aad, 8192 + 3072);
    GT_LDR(bfr[1][0], bad, 8192); GT_LDR(bfr[1][1], bad, 8192 + 1024); GT_LDR(bfr[1][2], bad, 8192 + 2048); GT_LDR(bfr[1][3], bad, 8192 + 3072);
#undef GT_LDR
    asm volatile("s_waitcnt lgkmcnt(8)" : "+v"(af[0][0]), "+v"(af[0][1]), "+v"(af[0][2]), "+v"(af[0][3]), "+v"(bfr[0][0]), "+v"(bfr[0][1]), "+v"(bfr[0][2]), "+v"(bfr[0][3]) :: "memory");
    __builtin_amdgcn_sched_barrier(0);
#pragma unroll
    for (int m = 0; m < 4; ++m)
#pragma unroll
      for (int n = 0; n < 4; ++n) acc[m][n] = __builtin_amdgcn_mfma_f32_16x16x32_bf16(bfr[0][n], af[0][m], acc[m][n], 0, 0, 0);
    __builtin_amdgcn_sched_barrier(0);
    asm volatile("s_waitcnt lgkmcnt(0)" : "+v"(af[1][0]), "+v"(af[1][1]), "+v"(af[1][2]), "+v"(af[1][3]), "+v"(bfr[1][0]), "+v"(bfr[1][1]), "+v"(bfr[1][2]), "+v"(bfr[1][3]) :: "memory");
    __builtin_amdgcn_sched_barrier(0);
#pragma unroll
    for (int m = 0; m < 4; ++m)
#pragma unroll
      for (int n = 0; n < 4; ++n) acc[m][n] = __builtin_amdgcn_mfma_f32_16x16x32_bf16(bfr[1][n], af[1][m], acc[m][n], 0, 0, 0);
    __builtin_amdgcn_sched_barrier(0);
  }
}
DI void gemm_tile(LAS char* lds, const u16* a0, const u16* a1, const u16* b0, const u16* b1, int nk, f32x4 (&acc)[4][4]) {
  TilePtrs t; t.a0 = a0; t.a1 = a1; t.b0 = b0; t.b1 = b1;
  gemm_tile_s<false>(lds, t, false, t, false, nk, acc);
  __syncthreads();
}
DI int gt_chunk(int tid) { return (((tid & 3) ^ ((0 - ((tid >> 4) & 3)) & 3))) * 8; }
DI int gt_row0(int tid) { return tid >> 2; }

DI void sincos_rev(float pos, float invf, float& sn, float& cs) {
  float rev = pos * invf * 0.15915494309189535f;
  rev -= rintf(rev);
  sn = __builtin_amdgcn_sinf(rev); cs = __builtin_amdgcn_cosf(rev);
}
DI void st_bf4(u16* dst, const f32x4& v) { uint2 o; o.x = cvtpk(v[0], v[1]); o.y = cvtpk(v[2], v[3]); *(uint2*)dst = o; }


DI void stage_put4(LAS char* st, int row, int c8, const f32x4& v) {
  u32x2_t o; o[0] = cvtpk(v[0], v[1]); o[1] = cvtpk(v[2], v[3]);
  *(LAS u32x2_t*)(st + row * 128 + ((c8 ^ (row & 15)) * 8)) = o;
}
DI u32x4_t stage_get16(const LAS char* st, int row, int u) {
  u32x4_t v = *(const LAS u32x4_t*)(st + row * 128 + ((u ^ ((row >> 1) & 7)) * 16));
  if (row & 1) v = __builtin_shufflevector(v, v, 2, 3, 0, 1);
  return v;
}
template <int NC>
DI void stage_flush(const LAS char* st, u16* dst, size_t ld, int lane) {
  constexpr int UPR = NC / 8;
  constexpr int RPI = 64 / UPR;
#pragma unroll
  for (int i = 0; i < 64 / RPI; ++i) {
    const int row = i * RPI + lane / UPR, u = lane % UPR;
    const u32x4_t v = stage_get16(st, row, u);
    *(u32x4_t*)(dst + (size_t)row * ld + u * 8) = v;
  }
}

DI void epi_inproj(const Params& p, int layer, f32x4 (&acc)[4][4], int m0, int seg, int wr, int fr, int fq, LAS float* rowss_slot, LAS char* stg, int lane) {
  char* ws = p.ws;
  const bool lat = m0 < NL;
  const int rbase = m0 + wr * 64 + fr;
  u16* dst; int ld, cb; int kind;
  if (seg < 6) { dst = (u16*)(ws + OFF_SWQ); ld = 384; cb = seg * 64; kind = 1; }
  else if (seg < 8) { dst = (u16*)(ws + OFF_SWK); ld = 128; cb = (seg - 6) * 64; kind = 1; }
  else if (seg < 10) { dst = (u16*)(ws + OFF_SWV); ld = 128; cb = (seg - 8) * 64; kind = 0; }
  else if (seg < 16) { dst = (u16*)(ws + OFF_GLQ); ld = 384; cb = (seg - 10) * 64; kind = 2; }
  else if (seg < 18) { dst = (u16*)(ws + OFF_GLK); ld = 128; cb = (seg - 16) * 64; kind = 3; }
  else if (seg < 20) { dst = (u16*)(ws + OFF_GLV); ld = 128; cb = (seg - 18) * 64; kind = 0; }
  else if (seg < 24) { dst = (u16*)(ws + OFF_QLAT); ld = 256; cb = (seg - 20) * 64; kind = 4; }
  else if (seg < 26) { dst = (u16*)(ws + OFF_KVLAT); ld = 128; cb = (seg - 24) * 64; kind = 5; }
  else if (seg == 26) { dst = (u16*)(ws + OFF_MLKR); ld = 32; cb = 0; kind = 6; }
  else return;
  if (kind == 2 || kind == 3) {
    const float* gain = (kind == 2 ? p.glb_q_gain : p.glb_k_gain) + layer * 64;
    f32x4 gv[4];
#pragma unroll
    for (int n = 0; n < 4; ++n) gv[n] = *(const f32x4*)(gain + n * 16 + fq * 4);
#pragma unroll
    for (int m = 0; m < 4; ++m) {
      float ss = 0.f;
#pragma unroll
      for (int n = 0; n < 4; ++n) ss += acc[m][n][0] * acc[m][n][0] + acc[m][n][1] * acc[m][n][1] + acc[m][n][2] * acc[m][n][2] + acc[m][n][3] * acc[m][n][3];
      ss += __shfl_xor(ss, 16); ss += __shfl_xor(ss, 32);
      const float r = rsqrtf(ss * (1.f / 64.f) + EPS);
#pragma unroll
      for (int n = 0; n < 4; ++n) acc[m][n] = acc[m][n] * r * gv[n];
    }
  }
  if (kind == 4 || kind == 5) {
    const float* gain = (kind == 4 ? p.mla_q_gain + layer * 256 : p.mla_kv_gain + layer * 128) + cb;
    f32x4 gv[4];
#pragma unroll
    for (int n = 0; n < 4; ++n) gv[n] = *(const f32x4*)(gain + n * 16 + fq * 4);
#pragma unroll
    for (int m = 0; m < 4; ++m) {
      float ss = 0.f;
#pragma unroll
      for (int n = 0; n < 4; ++n) ss += acc[m][n][0] * acc[m][n][0] + acc[m][n][1] * acc[m][n][1] + acc[m][n][2] * acc[m][n][2] + acc[m][n][3] * acc[m][n][3];
      ss += __shfl_xor(ss, 16); ss += __shfl_xor(ss, 32);
      if (fq == 0) rowss_slot[wr * 64 + m * 16 + fr] = ss;
#pragma unroll
      for (int n = 0; n < 4; ++n) acc[m][n] = acc[m][n] * gv[n];
    }
  }
  if (lat && (kind == 1 || kind == 2 || kind == 3)) {
    float invf[4];
#pragma unroll
    for (int j = 0; j < 4; ++j) invf[j] = __builtin_amdgcn_exp2f(-(float)(fq * 4 + j) * (13.287712379549449f / 16.f));
#pragma unroll
    for (int m = 0; m < 4; ++m) {
      const int t = (rbase + m * 16) & (S_ - 1);
      const float prow = (float)(t >> 6), pcol = (float)(t & 63);
#pragma unroll
      for (int j = 0; j < 4; ++j) {
        float sr, cr, sc, cc;
        sincos_rev(prow, invf[j], sr, cr); sincos_rev(pcol, invf[j], sc, cc);
        float x1 = acc[m][0][j], x2 = acc[m][1][j];
        acc[m][0][j] = x1 * cr - x2 * sr; acc[m][1][j] = x2 * cr + x1 * sr;
        x1 = acc[m][2][j]; x2 = acc[m][3][j];
        acc[m][2][j] = x1 * cc - x2 * sc; acc[m][3][j] = x2 * cc + x1 * sc;
      }
    }
  }
  if (kind == 6) {
    if (lat) {
      float invf[4];
#pragma unroll
      for (int j = 0; j < 4; ++j) invf[j] = __builtin_amdgcn_exp2f(-(float)((fq & 1) * 4 + j) * (13.287712379549449f / 8.f));
#pragma unroll
      for (int m = 0; m < 4; ++m) {
        const int t = (rbase + m * 16) & (S_ - 1);
#pragma unroll
        for (int n = 0; n < 2; ++n) {
          const float pos = n == 0 ? (float)(t >> 6) : (float)(t & 63);
#pragma unroll
          for (int j = 0; j < 4; ++j) {
            float sn, cs; sincos_rev(pos, invf[j], sn, cs);
            const float v = acc[m][n][j], pr = __shfl_xor(v, 32);
            acc[m][n][j] = (fq & 2) ? v * cs + pr * sn : v * cs - pr * sn;
          }
        }
      }
    }
#pragma unroll
    for (int m = 0; m < 4; ++m)
#pragma unroll
      for (int n = 0; n < 2; ++n) stage_put4(stg, m * 16 + fr, n * 4 + fq, acc[m][n]);
    stage_flush<32>(stg, dst + (size_t)(m0 + wr * 64) * ld, ld, lane);
    return;
  }
#pragma unroll
  for (int m = 0; m < 4; ++m)
#pragma unroll
    for (int n = 0; n < 4; ++n) stage_put4(stg, m * 16 + fr, n * 4 + fq, acc[m][n]);
  stage_flush<64>(stg, dst + (size_t)(m0 + wr * 64) * ld + cb, ld, lane);
}

DI void p2_inproj(const Params& p, int layer, LAS char* lds, int cs = 0) {
  char* ws = p.ws;
  unsigned* ctr = (unsigned*)(ws + OFF_CTRL) + CW_CTR + layer * 16 + 2 + cs;
  const u16* H = (const u16*)(ws + OFF_H);
  const u16* WinT = (const u16*)(ws + OFF_WIN) + (size_t)layer * INWP * 1024;
  const u16* WuqT = (const u16*)(ws + OFF_WUQ) + (size_t)layer * 384 * 256;
  const u16* WukvT = (const u16*)(ws + OFF_WUKV) + (size_t)layer * 512 * 128;
  const int tid = opaque((int)threadIdx.x), lane = tid & 63, wid = tid >> 6, wr = wid >> 1, wc = wid & 1;
  LAS float* rowss = (LAS float*)(lds + LDS_MISC);
  LAS float* rstd = (LAS float*)(lds + LDS_MISC + 2048);
  unsigned* ctr8 = (unsigned*)(ws + OFF_CTRL) + CW_Q + (layer * 2 + 1) * 512;
  f32x4 acc[4][4];
  for (;;) {
    const int u = next_unit_xcd(ctr8, (NT / 128 / 8) * 12, lds);
    if (u < 0) break;
    const int tid_o = opaque(tid), lane_o = tid_o & 63;
    const int fr = lane_o & 15, fq = lane_o >> 4, ch = gt_chunk(tid_o), r0 = gt_row0(tid_o);
    const int qx = u / 408, v = u % 408;
    int rt, k;
    if (v < 34) { rt = qx * 34 + v; k = 10; } else if (v < 68) { rt = qx * 34 + v - 34; k = 11; } else { rt = qx * 34 + (v - 68) / 10; k = (v - 68) % 10; }
    const int m0 = rt * 128;
    const u16* a0 = H + (size_t)(m0 + r0) * 1024 + ch;
    const u16* a1 = a0 + (size_t)64 * 1024;
    if (k < 10) {
      const u16* b0 = WinT + (size_t)(k * 128 + r0) * 1024 + ch;
      gemm_tile(lds, a0, a1, b0, b0 + (size_t)64 * 1024, 16, acc);
      epi_inproj(p, layer, acc, m0, k * 2 + wc, wr, fr, fq, rowss, lds + 32768 + wid * 8192, lane_o);
    } else if (k == 10) {
#pragma unroll 1
      for (int t = 0; t < 2; ++t) {
        const u16* b0 = WinT + (size_t)(1280 + t * 128 + r0) * 1024 + ch;
        gemm_tile(lds, a0, a1, b0, b0 + (size_t)64 * 1024, 16, acc);
        epi_inproj(p, layer, acc, m0, 20 + t * 2 + wc, wr, fr, fq, rowss + (t * 2 + wc) * 128, lds + 32768 + wid * 8192, lane_o);
      }
      __syncthreads();
      if (tid < 128) rstd[tid] = rsqrtf((rowss[tid] + rowss[128 + tid] + rowss[256 + tid] + rowss[384 + tid]) * (1.f / 256.f) + EPS);
      __syncthreads();
      const u16* QL = (const u16*)(ws + OFF_QLAT);
      const u16* qa0 = QL + (size_t)(m0 + r0) * 256 + ch;
      const u16* qa1 = qa0 + (size_t)64 * 256;
      u16* MLQ = (u16*)(ws + OFF_MLQ);
      const bool lat = m0 < NL;
#pragma unroll 1
      for (int t = 0; t < 3; ++t) {
        const u16* b0 = WuqT + (size_t)(t * 128 + r0) * 256 + ch;
        gemm_tile(lds, qa0, qa1, b0, b0 + (size_t)64 * 256, 4, acc);
        const int c0 = t * 128 + wc * 64;
        float invf[4];
#pragma unroll
        for (int j = 0; j < 4; ++j) invf[j] = __builtin_amdgcn_exp2f(-(float)((fq & 1) * 4 + j) * (13.287712379549449f / 8.f));
#pragma unroll
        for (int m = 0; m < 4; ++m) {
          const int rl = wr * 64 + m * 16 + fr;
          const float rs = rstd[rl];
          const int tpos = (m0 + rl) & (S_ - 1);
#pragma unroll
          for (int n = 0; n < 4; ++n) {
            acc[m][n] = acc[m][n] * rs;
            const int w96 = (c0 + n * 16) % 96;
            if (lat && w96 >= 64) {
              const float pos = (w96 == 64) ? (float)(tpos >> 6) : (float)(tpos & 63);
#pragma unroll
              for (int j = 0; j < 4; ++j) {
                float sn, cs; sincos_rev(pos, invf[j], sn, cs);
                const float v = acc[m][n][j], pr = __shfl_xor(v, 32);
                acc[m][n][j] = (fq & 2) ? v * cs + pr * sn : v * cs - pr * sn;
              }
            }
            stage_put4(lds + 32768 + wid * 8192, m * 16 + fr, n * 4 + fq, acc[m][n]);
          }
        }
        stage_flush<64>(lds + 32768 + wid * 8192, MLQ + (size_t)(m0 + wr * 64) * 384 + c0, 384, lane_o);
      }
    } else {
      {
        const u16* b0 = WinT + (size_t)(1536 + r0) * 1024 + ch;
        gemm_tile(lds, a0, a1, b0, b0 + (size_t)64 * 1024, 16, acc);
        epi_inproj(p, layer, acc, m0, 24 + wc, wr, fr, fq, rowss + wc * 128, lds + 32768 + wid * 8192, lane_o);
        const u16* b2 = WinT + (size_t)(1664 + r0) * 1024 + ch;
        gemm_tile(lds, a0, a1, b2, b2 + (size_t)64 * 1024, 16, acc);
        epi_inproj(p, layer, acc, m0, 26 + wc, wr, fr, fq, rowss, lds + 32768 + wid * 8192, lane_o);
      }
      __syncthreads();
      if (tid < 128) rstd[tid] = rsqrtf((rowss[tid] + rowss[128 + tid]) * (1.f / 128.f) + EPS);
      __syncthreads();
      const u16* KL = (const u16*)(ws + OFF_KVLAT);
      const u16* ka0 = KL + (size_t)(m0 + r0) * 128 + ch;
      const u16* ka1 = ka0 + (size_t)64 * 128;
#pragma unroll 1
      for (int t = 0; t < 4; ++t) {
        const u16* b0 = WukvT + (size_t)(t * 128 + r0) * 128 + ch;
        gemm_tile(lds, ka0, ka1, b0, b0 + (size_t)64 * 128, 2, acc);
        u16* dst = (u16*)(ws + (wc == 0 ? OFF_MLK : OFF_MLV));
#pragma unroll
        for (int m = 0; m < 4; ++m) {
          const int rl = wr * 64 + m * 16 + fr;
          const float rs = rstd[rl];
#pragma unroll
          for (int n = 0; n < 4; ++n) { acc[m][n] = acc[m][n] * rs; stage_put4(lds + 32768 + wid * 8192, m * 16 + fr, n * 4 + fq, acc[m][n]); }
        }
        stage_flush<64>(lds + 32768 + wid * 8192, dst + (size_t)(m0 + wr * 64) * 256 + t * 64, 256, lane_o);
      }
    }
  }
}

DI void p4_outproj(const Params& p, int layer, int nrows, LAS char* lds, int cs = 0) {
  char* ws = p.ws;
  const u16* Y = (const u16*)(ws + OFF_Y);
  const u16* WoT = (const u16*)(ws + OFF_WO) + (size_t)layer * 1024 * 1024;
  const float* MODl = (const float*)(ws + OFF_MOD) + (size_t)layer * 9 * 6144;
  const int tid = opaque((int)threadIdx.x), wid = tid >> 6, wr = wid >> 1, wc = wid & 1;
  const int nunits = (nrows / 128) * 8;
  f32x4 acc[4][4];
  __syncthreads();
  TilePtrs cur, nxt;
  int u = (int)((blockIdx.x & 7) * (gridDim.x >> 3) + (blockIdx.x >> 3));
#define P4_DESC(T, uu) do { const int _t = opaque(tid); const int _ch = gt_chunk(_t), _r0 = gt_row0(_t); const int _rt = (uu) >> 3, _ct = (uu) & 7; \
    (T).a0 = Y + (size_t)(_rt * 128 + _r0) * 1024 + _ch; (T).a1 = (T).a0 + (size_t)64 * 1024; \
    (T).b0 = WoT + (size_t)(_ct * 128 + _r0) * 1024 + _ch; (T).b1 = (T).b0 + (size_t)64 * 1024; } while (0)
  bool issued = false;
  if (u < nunits) P4_DESC(cur, u);
  while (u < nunits) {
    const int un = u + gridDim.x;
    const bool hn = un < nunits;
    if (hn) P4_DESC(nxt, un); else nxt = cur;
    gemm_tile_s(lds, cur, issued, nxt, hn, 16, acc);
    issued = hn;
    const int tid_o = opaque(tid), lane_o = tid_o & 63;
    const int fr = lane_o & 15, fq = lane_o >> 4;
    const int rt = u >> 3, ct = u & 7, m0 = rt * 128;
    const int mr = m0 < NL ? m0 / S_ : 8;
    const float* gate = MODl + (size_t)mr * 6144 + 2 * 1024 + ct * 128 + wc * 64 + fq * 4;
    __syncthreads();
    LAS char* stg = lds + 32768 + wid * 8192;
#pragma unroll
    for (int n = 0; n < 4; ++n) {
      const f32x4 g = *(const f32x4*)(gate + n * 16);
#pragma unroll
      for (int m = 0; m < 4; ++m) stage_put4(stg, m * 16 + fr, n * 4 + fq, g * acc[m][n]);
    }
    stage_flush<64>(stg, (u16*)(ws + OFF_DELTA) + (size_t)(m0 + wr * 64) * 1024 + ct * 128 + wc * 64, 1024, lane_o);
    cur = nxt; u = un;
  }
#undef P4_DESC
  __syncthreads();
}

DI void p6_gateup(const Params& p, int layer, int nrows, LAS char* lds, int cs = 0) {
  char* ws = p.ws;
  const unsigned* cnt = (const unsigned*)(ws + OFF_CTRL) + CW_CNT + layer * 16 * CNT_STRIDE;
  const u16* H = (const u16*)(ws + OFF_H);
  const int* list = (const int*)(ws + OFF_LIST);
  const u16* WguT = (const u16*)(ws + OFF_WGU) + (size_t)layer * NE * 1024 * 1024;
  const u16* SguT = (const u16*)(ws + OFF_SGU) + (size_t)layer * 1024 * 1024;
  u16* ACT = (u16*)(ws + OFF_ACT); u16* ACTS = (u16*)(ws + OFF_ACTS);
  const int tid = opaque((int)threadIdx.x), wid = tid >> 6, wr = wid >> 1, wc = wid & 1;
  int tb[NE + 1]; seg_scan(p, layer, tb);
  const int R = tb[NE];
  const int nunits = (R + nrows / 128) * 8;
  f32x4 acc[4][4];
  __syncthreads();
  TilePtrs cur, nxt;
#define P6_DESC(T, uu) do { const int _t = opaque(tid); const int _ch = gt_chunk(_t), _r0 = gt_row0(_t); const int _rt = (uu) >> 3, _ct = (uu) & 7; \
    if (_rt < R) { int _e = 0, _tbe = 0; _Pragma("unroll") for (int q = 1; q < NE; ++q) if (_rt >= tb[q]) { _e = q; _tbe = tb[q]; } \
      const int _i = _rt - _tbe, _ce = (int)cnt[_e * CNT_STRIDE]; const int _i0 = _i * 128 + _r0, _i1 = _i0 + 64; \
      const int _t0 = _i0 < _ce ? list[(size_t)_e * NT + _i0] : 0, _t1 = _i1 < _ce ? list[(size_t)_e * NT + _i1] : 0; \
      (T).a0 = H + (size_t)_t0 * 1024 + _ch; (T).a1 = H + (size_t)_t1 * 1024 + _ch; \
      (T).b0 = WguT + ((size_t)_e * 1024 + _ct * 128 + _r0) * 1024 + _ch; } \
    else { const int _m0 = (_rt - R) * 128; (T).a0 = H + (size_t)(_m0 + _r0) * 1024 + _ch; (T).a1 = (T).a0 + (size_t)64 * 1024; \
      (T).b0 = SguT + (size_t)(_ct * 128 + _r0) * 1024 + _ch; } \
    (T).b1 = (T).b0 + (size_t)64 * 1024; } while (0)
  int u = (int)((blockIdx.x & 7) * (gridDim.x >> 3) + (blockIdx.x >> 3));
  bool issued = false;
  if (u < nunits) P6_DESC(cur, u);
  while (u < nunits) {
    const int un = u + gridDim.x;
    const bool hn = un < nunits;
    if (hn) P6_DESC(nxt, un); else nxt = cur;
    gemm_tile_s(lds, cur, issued, nxt, hn, 16, acc);
    issued = hn;
    const int tid_o = opaque(tid), lane_o = tid_o & 63;
    const int fr = lane_o & 15, fq = lane_o >> 4;
    const int rt = u >> 3, ct = u & 7;
    u16* dst; size_t orow;
    if (rt < R) { dst = ACT; orow = (size_t)rt * 128; } else { dst = ACTS; orow = (size_t)(rt - R) * 128; }
    __syncthreads();
    LAS char* stg = lds + 32768 + wid * 8192;
#pragma unroll
    for (int m = 0; m < 4; ++m)
#pragma unroll
      for (int n = 0; n < 2; ++n) {
        f32x4 r;
#pragma unroll
        for (int j = 0; j < 4; ++j) r[j] = silu(acc[m][n][j]) * acc[m][n + 2][j];
        stage_put4(stg, m * 16 + fr, n * 4 + fq, r);
      }
    stage_flush<32>(stg, dst + (orow + wr * 64) * 512 + ct * 64 + wc * 32, 512, lane_o);
    cur = nxt; u = un;
  }
#undef P6_DESC
  __syncthreads();
}

DI void p7_down(const Params& p, int layer, int nrows, LAS char* lds, int cs = 0) {
  char* ws = p.ws;
  const u16* WdT = (const u16*)(ws + OFF_WD) + (size_t)layer * NE * 1024 * 512;
  const u16* SdT = (const u16*)(ws + OFF_SD) + (size_t)layer * 1024 * 512;
  const u16* ACT = (const u16*)(ws + OFF_ACT); const u16* ACTS = (const u16*)(ws + OFF_ACTS);
  u16* YEXP = (u16*)(ws + OFF_YEXP); u16* YSH = (u16*)(ws + OFF_YSH);
  const int tid = opaque((int)threadIdx.x), wid = tid >> 6, wr = wid >> 1, wc = wid & 1;
  int tb[NE + 1]; seg_scan(p, layer, tb);
  const int R = tb[NE];
  const int nunits = (R + nrows / 128) * 8;
  f32x4 acc[4][4];
  __syncthreads();
  TilePtrs cur, nxt;
#define P7_DESC(T, uu) do { const int _t = opaque(tid); const int _ch = gt_chunk(_t), _r0 = gt_row0(_t); const int _rt = (uu) >> 3, _ct = (uu) & 7; \
    if (_rt < R) { int _e = 0; _Pragma("unroll") for (int q = 1; q < NE; ++q) if (_rt >= tb[q]) _e = q; \
      (T).a0 = ACT + ((size_t)_rt * 128 + _r0) * 512 + _ch; (T).b0 = WdT + ((size_t)_e * 1024 + _ct * 128 + _r0) * 512 + _ch; } \
    else { const int _m0 = (_rt - R) * 128; (T).a0 = ACTS + (size_t)(_m0 + _r0) * 512 + _ch; (T).b0 = SdT + (size_t)(_ct * 128 + _r0) * 512 + _ch; } \
    (T).a1 = (T).a0 + (size_t)64 * 512; (T).b1 = (T).b0 + (size_t)64 * 512; } while (0)
  int u = (int)((blockIdx.x & 7) * (gridDim.x >> 3) + (blockIdx.x >> 3));
  bool issued = false;
  if (u < nunits) P7_DESC(cur, u);
  while (u < nunits) {
    const int un = u + gridDim.x;
    const bool hn = un < nunits;
    if (hn) P7_DESC(nxt, un); else nxt = cur;
    gemm_tile_s(lds, cur, issued, nxt, hn, 8, acc);
    issued = hn;
    const int tid_o = opaque(tid), lane_o = tid_o & 63;
    const int fr = lane_o & 15, fq = lane_o >> 4;
    const int rt = u >> 3, ct = u & 7;
    u16* dst; size_t orow;
    if (rt < R) { dst = YEXP; orow = (size_t)rt * 128; } else { dst = YSH; orow = (size_t)(rt - R) * 128; }
    __syncthreads();
    LAS char* stg = lds + 32768 + wid * 8192;
#pragma unroll
    for (int m = 0; m < 4; ++m)
#pragma unroll
      for (int n = 0; n < 4; ++n) stage_put4(stg, m * 16 + fr, n * 4 + fq, acc[m][n]);
    stage_flush<64>(stg, dst + (orow + wr * 64) * 1024 + ct * 128 + wc * 64, 1024, lane_o);
    cur = nxt; u = un;
  }
#undef P7_DESC
  __syncthreads();
}

typedef float f32x16 __attribute__((ext_vector_type(16)));
typedef short s16x4 __attribute__((ext_vector_type(4)));
DI s16x4 tr_read(const LAS char* a) { return __builtin_bit_cast(s16x4, __builtin_amdgcn_ds_read_tr16_b64_v4i16((LAS s16x4*)a)); }
DI float half_max(float m) { auto rr = __builtin_amdgcn_permlane32_swap(__float_as_uint(m), __float_as_uint(m), false, false); return fmaxf(__uint_as_float(rr[0]), __uint_as_float(rr[1])); }
DI float half_sum(float m) { auto rr = __builtin_amdgcn_permlane32_swap(__float_as_uint(m), __float_as_uint(m), false, false); return __uint_as_float(rr[0]) + __uint_as_float(rr[1]); }
DI bf16x8 pack8(const f32x16& x, int s8) {
  typedef unsigned u32x4 __attribute__((ext_vector_type(4)));
  u32x4 r;
  r[0] = cvtpk(x[s8 + 0], x[s8 + 1]); r[1] = cvtpk(x[s8 + 2], x[s8 + 3]); r[2] = cvtpk(x[s8 + 4], x[s8 + 5]); r[3] = cvtpk(x[s8 + 6], x[s8 + 7]);
  return __builtin_bit_cast(bf16x8, r);
}
constexpr int AT_STAGE = 20480;

DI float max3f(float a, float b, float c) { float r; asm("v_max3_f32 %0, %1, %2, %3" : "=v"(r) : "v"(a), "v"(b), "v"(c)); return r; }
template <bool MLA, bool SWA>
DI void attn_unit(const Params& p, int layer, int isctx, int b, int h, int qb, LAS char* lds) {
  char* ws = p.ws;
  const int tid = opaque((int)threadIdx.x), lane = tid & 63, wid = tid >> 6, r32 = lane & 31, hi = lane >> 5;
  const u16 *Qg, *Kg, *Vg; int ldq, ldk, qoff, koff, ycol; float cs;
  if (MLA) { Qg = (const u16*)(ws + OFF_MLQ); Kg = (const u16*)(ws + OFF_MLK); Vg = (const u16*)(ws + OFF_MLV); ldq = 384; ldk = 256; qoff = h * 96; koff = h * 64; ycol = 768 + h * 64; cs = 0.10206207261596575f * 1.4426950408889634f; }
  else if (!SWA) { Qg = (const u16*)(ws + OFF_GLQ); Kg = (const u16*)(ws + OFF_GLK); Vg = (const u16*)(ws + OFF_GLV); ldq = 384; ldk = 128; qoff = h * 64; koff = (h / 3) * 64; ycol = 384 + h * 64; cs = 0.125f * 1.4426950408889634f; }
  else { Qg = (const u16*)(ws + OFF_SWQ); Kg = (const u16*)(ws + OFF_SWK); Vg = (const u16*)(ws + OFF_SWV); ldq = 384; ldk = 128; qoff = h * 64; koff = (h / 3) * 64; ycol = h * 64; cs = 0.125f * 1.4426950408889634f; }
  const u16* Rg = (const u16*)(ws + OFF_MLKR);
  const int q0 = qb * 128;
  const int qrow0 = (isctx ? NL + b * C_ : b * S_) + q0;
  const int qw = q0 + wid * 32;
  int lat_first = 0, nlat = 0;
  if (!isctx) { if (SWA) { lat_first = 2 * qb - 2; if (lat_first < 0) lat_first = 0; int lat_last = 2 * qb + 3; if (lat_last > 63) lat_last = 63; nlat = lat_last - lat_first + 1; } else nlat = 64; }
  const int T = 4 + nlat;
  constexpr int NQ = MLA ? 6 : 4;
  bf16x8 qf[NQ];
  {
    const u16* qp = Qg + (size_t)(qrow0 + wid * 32 + r32) * ldq + qoff + hi * 8;
#pragma unroll
    for (int d0 = 0; d0 < NQ; ++d0) {
      const u32x4_t raw = *(const u32x4_t*)(qp + d0 * 16);
      u32x4_t sc;
#pragma unroll
      for (int i = 0; i < 4; ++i) sc[i] = cvtpk(bflo(raw[i]) * cs, bfhi(raw[i]) * cs);
      qf[d0] = __builtin_bit_cast(bf16x8, sc);
    }
  }
  int kaddr[4];
#pragma unroll
  for (int d0 = 0; d0 < 4; ++d0) kaddr[d0] = r32 * 128 + (((d0 * 2 + hi) ^ ((r32 >> 1) & 7)) * 16);
  int kraddr[2];
#pragma unroll
  for (int e = 0; e < 2; ++e) kraddr[e] = 16384 + r32 * 64 + (((e * 2 + hi) ^ ((r32 >> 3) & 3)) * 16);
  int vbo[2];
  {
    const int i16 = lane & 15, sw = (lane >> 3) & 1;
    const int x = ((lane >> 4) & 1) * 32 + (lane & 3) * 8;
    const int rowpart = ((i16 >> 2) + 4 * hi) * 128;
    vbo[0] = 8192 + rowpart + x + (sw * 64);
    vbo[1] = 8192 + rowpart + x + ((1 - sw) * 64);
  }
  const int skey = tid >> 3;
  const int kch = ((tid & 7) ^ ((tid >> 4) & 7)) * 8;
  const int vch = ((tid & 7) ^ (((tid >> 4) & 1) << 2)) * 8;
  const int rkey = tid >> 2, rch = ((tid & 3) ^ ((tid >> 5) & 3)) * 8;
  LAS char* ldst = lds + tid * 16;
#define AT_ISSUE(j, st) do { const int _j = (j); const int _kr = _j < 4 ? NL + b * C_ + 64 * _j : b * S_ + 64 * (lat_first + _j - 4); \
    LAS char* _d = ldst + (st) * AT_STAGE; \
    const u16* _k = Kg + (size_t)(_kr + skey) * ldk + koff + kch; glds16(_k, _d); glds16(_k + (size_t)32 * ldk, _d + 4096); \
    const u16* _v = Vg + (size_t)(_kr + skey) * ldk + koff + vch; glds16(_v, _d + 8192); glds16(_v + (size_t)32 * ldk, _d + 8192 + 4096); \
    if (MLA) glds16(Rg + (size_t)(_kr + rkey) * 32 + rch, _d + 16384); } while (0)
#define AT_QK(sb, P0, P1) do { \
    bf16x8 kk0[MLA ? 6 : 4], kk1[MLA ? 6 : 4]; \
    _Pragma("unroll") for (int d0 = 0; d0 < 4; ++d0) { kk0[d0] = *(const LAS bf16x8*)((sb) + kaddr[d0]); kk1[d0] = *(const LAS bf16x8*)((sb) + kaddr[d0] + 4096); } \
    if (MLA) { _Pragma("unroll") for (int e = 0; e < 2; ++e) { kk0[MLA ? 4 + e : 0] = *(const LAS bf16x8*)((sb) + kraddr[e]); kk1[MLA ? 4 + e : 0] = *(const LAS bf16x8*)((sb) + kraddr[e] + 2048); } } \
    __builtin_amdgcn_sched_barrier(0);     \
    P0 = __builtin_amdgcn_mfma_f32_32x32x16_bf16(kk0[0], qf[0], negm, 0, 0, 0); P1 = __builtin_amdgcn_mfma_f32_32x32x16_bf16(kk1[0], qf[0], negm, 0, 0, 0); \
    _Pragma("unroll") for (int d0 = 1; d0 < (MLA ? 6 : 4); ++d0) { \
      P0 = __builtin_amdgcn_mfma_f32_32x32x16_bf16(kk0[d0], qf[d0], P0, 0, 0, 0); P1 = __builtin_amdgcn_mfma_f32_32x32x16_bf16(kk1[d0], qf[d0], P1, 0, 0, 0); } \
  } while (0)
#define AT_WSTATE(jj, pos0v, st) do { st = 0; pos0v = 64 * (lat_first + (jj) - 4); if (SWA && (jj) >= 4) { \
      if (pos0v + 63 < qw - 128 || pos0v > qw + 31 + 128) st = 2; else if (qw + 31 - pos0v > 128 || pos0v + 63 - qw > 128) st = 1; } } while (0)
#define AT_SOFTMAX(P0, P1, PA, wst, pos0v, FIRST) do { \
    if (SWA && wst == 1) { const int dq = qw + r32 - pos0v - 4 * hi + 128; \
      _Pragma("unroll") for (int r = 0; r < 16; ++r) { const int cr = (r & 3) + 8 * (r >> 2); \
        if ((unsigned)(dq - cr) > 256u) P0[r] = -1e30f; if ((unsigned)(dq - cr - 32) > 256u) P1[r] = -1e30f; } } \
    asm volatile("s_nop 15\n\ts_nop 15" : "+v"(P0), "+v"(P1));     \
    float mx = max3f(P0[0], P0[1], P1[0]); mx = max3f(mx, P1[1], P0[2]); \
    _Pragma("unroll") for (int r = 3; r < 16; r += 2) { mx = max3f(mx, P0[r], P0[(r + 1) & 15]); } \
    _Pragma("unroll") for (int r = 2; r < 16; r += 2) { mx = max3f(mx, P1[r], P1[r + 1]); } \
    mx = half_max(mx); \
    if ((FIRST) || __ballot(mx > 8.0f) != 0ull) { \
      const float delta = (FIRST) ? mx : fmaxf(mx, 0.f); \
      const float al = __builtin_amdgcn_exp2f(-delta); \
      m_run += delta; \
      _Pragma("unroll") for (int i = 0; i < 16; ++i) { o[0][i] *= al; o[1][i] *= al; P0[i] -= delta; P1[i] -= delta; negm[i] = -m_run; } \
      osum[0] *= al; \
    } \
    _Pragma("unroll") for (int r = 0; r < 16; ++r) { P0[r] = __builtin_amdgcn_exp2f(P0[r]); P1[r] = __builtin_amdgcn_exp2f(P1[r]); } \
    PA[0] = pack8(P0, 0); PA[1] = pack8(P0, 8); PA[2] = pack8(P1, 0); PA[3] = pack8(P1, 8); \
  } while (0)
#define AT_PV(sb, PA) do { \
    bf16x8 vf[2][4]; \
    _Pragma("unroll") for (int db = 0; db < 2; ++db) { _Pragma("unroll") for (int ts = 0; ts < 4; ++ts) { \
      const LAS char* va = (sb) + vbo[db] + ts * 2048; const s16x4 lo = tr_read(va), hh = tr_read(va + 1024); \
      vf[db][ts] = __builtin_shufflevector(lo, hh, 0, 1, 2, 3, 4, 5, 6, 7); } } \
    __builtin_amdgcn_sched_barrier(0);     \
    _Pragma("unroll") for (int ts = 0; ts < 4; ++ts) osum = __builtin_amdgcn_mfma_f32_32x32x16_bf16(ones, PA[ts], osum, 0, 0, 0); \
    _Pragma("unroll") for (int db = 0; db < 2; ++db) { _Pragma("unroll") for (int ts = 0; ts < 4; ++ts) \
      o[db] = __builtin_amdgcn_mfma_f32_32x32x16_bf16(vf[db][ts], PA[ts], o[db], 0, 0, 0); } } while (0)

  float m_run = SWA ? p.swa_sink[layer * 6 + h] * 1.4426950408889634f : 0.f;
  f32x16 o[2], osum, negm;
#pragma unroll
  for (int i = 0; i < 16; ++i) { o[0][i] = 0.f; o[1][i] = 0.f; osum[i] = SWA ? 1.f : 0.f; negm[i] = -m_run; }
  bf16x8 ones;
#pragma unroll
  for (int i = 0; i < 8; ++i) ones[i] = (short)0x3F80;
  bf16x8 pa[4];
  f32x16 s0, s1;
  AT_ISSUE(0, 0);
  asm volatile("s_waitcnt vmcnt(0)" ::: "memory");
  __syncthreads();
  AT_ISSUE(1, 1);
  AT_QK(lds, s0, s1);
  { int wst = 0, pos0v = 0; AT_SOFTMAX(s0, s1, pa, wst, pos0v, !SWA); }
  bool cur_skip = false;
#pragma unroll 1
  for (int j = 0; j < T - 1; ++j) {
    asm volatile("s_waitcnt vmcnt(0)" ::: "memory");
    __syncthreads();
    const int st_cur = j % 3, st_nxt = (j + 1) % 3;
    if (j + 2 < T) AT_ISSUE(j + 2, (j + 2) % 3);
    const LAS char* sbn = lds + st_nxt * AT_STAGE;
    const LAS char* sbc = lds + st_cur * AT_STAGE;
    int wst, pos0v; AT_WSTATE(j + 1, pos0v, wst);
    if (!SWA || wst != 2) AT_QK(sbn, s0, s1);
    if (!SWA || !cur_skip) AT_PV(sbc, pa);
    if (!SWA || wst != 2) {
      bf16x8 pn[4];
      AT_SOFTMAX(s0, s1, pn, wst, pos0v, false);
      pa[0] = pn[0]; pa[1] = pn[1]; pa[2] = pn[2]; pa[3] = pn[3];
      cur_skip = false;
    } else cur_skip = true;
  }
  if (!SWA || !cur_skip) { const LAS char* sbc = lds + ((T - 1) % 3) * AT_STAGE; AT_PV(sbc, pa); }
#undef AT_ISSUE
#undef AT_QK
#undef AT_WSTATE
#undef AT_SOFTMAX
#undef AT_PV
  const float inv = 1.f / osum[0];
  u16* yp = (u16*)(ws + OFF_Y) + (size_t)(qrow0 + wid * 32 + r32) * 1024 + ycol + 4 * hi;
#pragma unroll
  for (int db = 0; db < 2; ++db)
#pragma unroll
    for (int g = 0; g < 4; ++g) {
      uint2 w; w.x = cvtpk(o[db][4 * g] * inv, o[db][4 * g + 1] * inv); w.y = cvtpk(o[db][4 * g + 2] * inv, o[db][4 * g + 3] * inv);
      *(uint2*)(yp + db * 32 + 8 * g) = w;
    }
  __syncthreads();
}


typedef float f32x4v __attribute__((ext_vector_type(4)));
#define MFMA16(a, b, c) __builtin_amdgcn_mfma_f32_16x16x32_bf16((a), (b), (c), 0, 0, 0)
DI float quad_max_x(float m) {
  { auto rr = __builtin_amdgcn_permlane16_swap(__float_as_uint(m), __float_as_uint(m), false, false); m = fmaxf(__uint_as_float(rr[0]), __uint_as_float(rr[1])); }
  { auto rr = __builtin_amdgcn_permlane32_swap(__float_as_uint(m), __float_as_uint(m), false, false); m = fmaxf(__uint_as_float(rr[0]), __uint_as_float(rr[1])); }
  return m;
}
template <bool MLA, bool SWA>
DI void attn_unit16(const Params& p, int layer, int isctx, int b, int h, int qb, LAS char* lds) {
  char* ws = p.ws;
  const int tid = opaque((int)threadIdx.x), lane = tid & 63, wid = tid >> 6, c16 = lane & 15, g = lane >> 4;
  const u16 *Qg, *Kg, *Vg; int ldq, ldk, qoff, koff, ycol; float cs;
  if (MLA) { Qg = (const u16*)(ws + OFF_MLQ); Kg = (const u16*)(ws + OFF_MLK); Vg = (const u16*)(ws + OFF_MLV); ldq = 384; ldk = 256; qoff = h * 96; koff = h * 64; ycol = 768 + h * 64; cs = 0.10206207261596575f * 1.4426950408889634f; }
  else if (!SWA) { Qg = (const u16*)(ws + OFF_GLQ); Kg = (const u16*)(ws + OFF_GLK); Vg = (const u16*)(ws + OFF_GLV); ldq = 384; ldk = 128; qoff = h * 64; koff = (h / 3) * 64; ycol = 384 + h * 64; cs = 0.125f * 1.4426950408889634f; }
  else { Qg = (const u16*)(ws + OFF_SWQ); Kg = (const u16*)(ws + OFF_SWK); Vg = (const u16*)(ws + OFF_SWV); ldq = 384; ldk = 128; qoff = h * 64; koff = (h / 3) * 64; ycol = h * 64; cs = 0.125f * 1.4426950408889634f; }
  const u16* Rg = (const u16*)(ws + OFF_MLKR);
  const int q0 = qb * 128;
  const int qrow0 = (isctx ? NL + b * C_ : b * S_) + q0;
  const int qw = q0 + wid * 32;
  int lat_first = 0, nlat = 0;
  if (!isctx) { if (SWA) { lat_first = 2 * qb - 2; if (lat_first < 0) lat_first = 0; int lat_last = 2 * qb + 3; if (lat_last > 63) lat_last = 63; nlat = lat_last - lat_first + 1; } else nlat = 64; }
  const int T = 4 + nlat;
  constexpr int NS = MLA ? 3 : 2;
  bf16x8 qf[2][NS];
#pragma unroll
  for (int bq = 0; bq < 2; ++bq) {
    const u16* qp = Qg + (size_t)(qrow0 + wid * 32 + bq * 16 + c16) * ldq + qoff + g * 8;
#pragma unroll
    for (int s = 0; s < NS; ++s) {
      const u32x4_t raw = *(const u32x4_t*)(qp + s * 32);
      u32x4_t sc;
#pragma unroll
      for (int i = 0; i < 4; ++i) sc[i] = cvtpk(bflo(raw[i]) * cs, bfhi(raw[i]) * cs);
      qf[bq][s] = __builtin_bit_cast(bf16x8, sc);
    }
  }
  int kaddr[2];
#pragma unroll
  for (int s = 0; s < 2; ++s) kaddr[s] = c16 * 128 + (((4 * s + g) ^ ((c16 >> 1) & 7)) * 16);
  const int kraddr = 16384 + c16 * 64 + ((g ^ ((0 - (c16 >> 2)) & 3)) * 16);
  int vbo[4];
#pragma unroll
  for (int d = 0; d < 4; ++d) vbo[d] = 8192 + (4 * g + (c16 >> 2)) * 128 + ((d ^ ((lane >> 3) & 3)) * 32) + (lane & 3) * 8;
  const int skey = tid >> 3;
  const int kch = ((tid & 7) ^ ((tid >> 4) & 7)) * 8;
  const int vch = ((tid & 7) ^ (((tid >> 4) & 3) << 1)) * 8;
  const int rkey = tid >> 2, rch = ((tid & 3) ^ ((0 - (tid >> 4)) & 3)) * 8;
  LAS char* ldst = lds + tid * 16;
#define A6_ISSUE(j, st) do { const int _j = (j); const int _kr = _j < 4 ? NL + b * C_ + 64 * _j : b * S_ + 64 * (lat_first + _j - 4); \
    LAS char* _d = ldst + (st) * AT_STAGE; \
    const u16* _k = Kg + (size_t)(_kr + skey) * ldk + koff + kch; glds16(_k, _d); glds16(_k + (size_t)32 * ldk, _d + 4096); \
    const u16* _v = Vg + (size_t)(_kr + skey) * ldk + koff + vch; glds16(_v, _d + 8192); glds16(_v + (size_t)32 * ldk, _d + 8192 + 4096); \
    if (MLA) glds16(Rg + (size_t)(_kr + rkey) * 32 + rch, _d + 16384); } while (0)
#define A6_QK(sb) do { \
    bf16x8 kk[4][NS]; \
    _Pragma("unroll") for (int a = 0; a < 4; ++a) { kk[a][0] = *(const LAS bf16x8*)((sb) + kaddr[0] + a * 2048); kk[a][1] = *(const LAS bf16x8*)((sb) + kaddr[1] + a * 2048); \
      if (MLA) kk[a][MLA ? 2 : 0] = *(const LAS bf16x8*)((sb) + kraddr + a * 1024); } \
    __builtin_amdgcn_sched_barrier(0); \
    _Pragma("unroll") for (int a = 0; a < 4; ++a) { _Pragma("unroll") for (int bq = 0; bq < 2; ++bq) { \
      S[a][bq] = MFMA16(kk[a][0], qf[bq][0], negm[bq]); \
      _Pragma("unroll") for (int s = 1; s < NS; ++s) S[a][bq] = MFMA16(kk[a][s], qf[bq][s], S[a][bq]); } } \
  } while (0)
#define A6_WSTATE(jj, pos0v, st) do { st = 0; pos0v = 64 * (lat_first + (jj) - 4); if (SWA && (jj) >= 4) { \
      if (pos0v + 63 < qw - 128 || pos0v > qw + 31 + 128) st = 2; else if (qw + 31 - pos0v > 128 || pos0v + 63 - qw > 128) st = 1; } } while (0)
#define A6_SOFTMAX(PA, wst, pos0v, FIRST, CHECK) do { \
    if (SWA && wst == 1) { _Pragma("unroll") for (int bq = 0; bq < 2; ++bq) { const int dq = qw + 16 * bq + c16 - pos0v - 4 * g + 128; \
      _Pragma("unroll") for (int a = 0; a < 4; ++a) { _Pragma("unroll") for (int r = 0; r < 4; ++r) { if ((unsigned)(dq - (16 * a + r)) > 256u) S[a][bq][r] = -1e30f; } } } } \
    float mx[2] = {0.f, 0.f}; \
    if (CHECK) { \
    asm volatile("s_nop 15\n\ts_nop 15" : "+v"(S[0][0]), "+v"(S[0][1]), "+v"(S[1][0]), "+v"(S[1][1]), "+v"(S[2][0]), "+v"(S[2][1]), "+v"(S[3][0]), "+v"(S[3][1])); \
    _Pragma("unroll") for (int bq = 0; bq < 2; ++bq) { \
      float m_ = max3f(S[0][bq][0], S[0][bq][1], S[0][bq][2]); m_ = max3f(m_, S[0][bq][3], S[1][bq][0]); \
      m_ = max3f(m_, S[1][bq][1], S[1][bq][2]); m_ = max3f(m_, S[1][bq][3], S[2][bq][0]); m_ = max3f(m_, S[2][bq][1], S[2][bq][2]); \
      m_ = max3f(m_, S[2][bq][3], S[3][bq][0]); m_ = max3f(m_, S[3][bq][1], S[3][bq][2]); m_ = fmaxf(m_, S[3][bq][3]); \
      mx[bq] = quad_max_x(m_); } } \
    if ((FIRST) || ((CHECK) && __ballot(fmaxf(mx[0], mx[1]) > 8.0f) != 0ull)) { \
      _Pragma("unroll") for (int bq = 0; bq < 2; ++bq) { \
        const float delta = (FIRST) ? mx[bq] : fmaxf(mx[bq], 0.f); \
        const float al = __builtin_amdgcn_exp2f(-delta); \
        m_run[bq] += delta; \
        _Pragma("unroll") for (int a = 0; a < 4; ++a) { S[a][bq] = S[a][bq] - delta; o[a][bq] = o[a][bq] * al; } \
        negm[bq] = (f32x4v){-m_run[bq], -m_run[bq], -m_run[bq], -m_run[bq]}; \
        osum[bq] = osum[bq] * al; } \
    } \
    _Pragma("unroll") for (int a = 0; a < 4; ++a) { _Pragma("unroll") for (int bq = 0; bq < 2; ++bq) { _Pragma("unroll") for (int r = 0; r < 4; ++r) S[a][bq][r] = __builtin_amdgcn_exp2f(S[a][bq][r]); } } \
    _Pragma("unroll") for (int ks = 0; ks < 2; ++ks) { _Pragma("unroll") for (int bq = 0; bq < 2; ++bq) { u32x4_t w_; \
      w_[0] = cvtpk(S[2 * ks][bq][0], S[2 * ks][bq][1]); w_[1] = cvtpk(S[2 * ks][bq][2], S[2 * ks][bq][3]); \
      w_[2] = cvtpk(S[2 * ks + 1][bq][0], S[2 * ks + 1][bq][1]); w_[3] = cvtpk(S[2 * ks + 1][bq][2], S[2 * ks + 1][bq][3]); \
      PA[ks][bq] = __builtin_bit_cast(bf16x8, w_); } } \
  } while (0)
#define A6_PV(sb, PA) do { \
    bf16x8 vf[2][4]; \
    _Pragma("unroll") for (int ks = 0; ks < 2; ++ks) { _Pragma("unroll") for (int d = 0; d < 4; ++d) { \
      const LAS char* va = (sb) + vbo[d] + ks * 4096; const s16x4 lo = tr_read(va), hh = tr_read(va + 2048); \
      vf[ks][d] = __builtin_shufflevector(lo, hh, 0, 1, 2, 3, 4, 5, 6, 7); } } \
    __builtin_amdgcn_sched_barrier(0); \
    _Pragma("unroll") for (int ks = 0; ks < 2; ++ks) { _Pragma("unroll") for (int bq = 0; bq < 2; ++bq) osum[bq] = MFMA16(ones, PA[ks][bq], osum[bq]); } \
    _Pragma("unroll") for (int d = 0; d < 4; ++d) { _Pragma("unroll") for (int bq = 0; bq < 2; ++bq) { _Pragma("unroll") for (int ks = 0; ks < 2; ++ks) \
      o[d][bq] = MFMA16(vf[ks][d], PA[ks][bq], o[d][bq]); } } } while (0)

  float m_run[2];
  m_run[0] = m_run[1] = SWA ? p.swa_sink[layer * 6 + h] * 1.4426950408889634f : 0.f;
  f32x4v S[4][2], o[4][2], osum[2], negm[2];
#pragma unroll
  for (int bq = 0; bq < 2; ++bq) {
    const float i1 = SWA ? 1.f : 0.f;
    osum[bq] = (f32x4v){i1, i1, i1, i1}; negm[bq] = (f32x4v){-m_run[bq], -m_run[bq], -m_run[bq], -m_run[bq]};
#pragma unroll
    for (int d = 0; d < 4; ++d) o[d][bq] = (f32x4v){0.f, 0.f, 0.f, 0.f};
  }
  bf16x8 ones;
#pragma unroll
  for (int i = 0; i < 8; ++i) ones[i] = (short)0x3F80;
  bf16x8 pa[2][2];
  A6_ISSUE(0, 0);
  asm volatile("s_waitcnt vmcnt(0)" ::: "memory");
  __syncthreads();
  A6_ISSUE(1, 1);
  A6_QK(lds);
  { int wst = 0, pos0v = 0; A6_SOFTMAX(pa, wst, pos0v, !SWA, true); }
  bool cur_skip = false;
#pragma unroll 1
  for (int j = 0; j < T - 1; ++j) {
    asm volatile("s_waitcnt vmcnt(0)" ::: "memory");
    __syncthreads();
    if (j + 2 < T) A6_ISSUE(j + 2, (j + 2) % 3);
    const LAS char* sbn = lds + ((j + 1) % 3) * AT_STAGE;
    const LAS char* sbc = lds + (j % 3) * AT_STAGE;
    int wst, pos0v; A6_WSTATE(j + 1, pos0v, wst);
    if (!SWA || wst != 2) A6_QK(sbn);
    if (!SWA || !cur_skip) A6_PV(sbc, pa);
    if (!SWA || wst != 2) {
      bf16x8 pn[2][2];
      A6_SOFTMAX(pn, wst, pos0v, false, (SWA || (j & 1) == 0));
      pa[0][0] = pn[0][0]; pa[0][1] = pn[0][1]; pa[1][0] = pn[1][0]; pa[1][1] = pn[1][1];
      cur_skip = false;
    } else cur_skip = true;
  }
  if (!SWA || !cur_skip) { const LAS char* sbc = lds + ((T - 1) % 3) * AT_STAGE; A6_PV(sbc, pa); }
#undef A6_ISSUE
#undef A6_QK
#undef A6_WSTATE
#undef A6_SOFTMAX
#undef A6_PV
#pragma unroll
  for (int bq = 0; bq < 2; ++bq) {
    const float inv = 1.f / osum[bq][0];
    u16* yp = (u16*)(ws + OFF_Y) + (size_t)(qrow0 + wid * 32 + bq * 16 + c16) * 1024 + ycol + 4 * g;
#pragma unroll
    for (int d = 0; d < 4; ++d) {
      u32x2_t w; w[0] = cvtpk(o[d][bq][0] * inv, o[d][bq][1] * inv); w[1] = cvtpk(o[d][bq][2] * inv, o[d][bq][3] * inv);
      *(u32x2_t*)(yp + d * 16) = w;
    }
  }
  __syncthreads();
}

DI void p3_attention(const Params& p, int layer, LAS char* lds, int cs = 0) {
  unsigned* ctr8 = (unsigned*)(p.ws + OFF_CTRL) + CW_Q + (layer * 2 + 0) * 512;
  const int per_q = 512 + (layer == 0 ? 32 : 0);
  for (;;) {
    const int u = next_unit_xcd(ctr8, per_q, lds);
    if (u < 0) break;
    const int b = u / per_q, v = u % per_q;
    if (v < 128) { attn_unit16<true, false>(p, layer, 0, b, v >> 5, v & 31, lds); }
    else if (v < 320) { const int w = v - 128; attn_unit16<false, false>(p, layer, 0, b, w >> 5, w & 31, lds); }
    else if (v < 512) { const int w = v - 320; attn_unit16<false, true>(p, layer, 0, b, w >> 5, w & 31, lds); }
    else {
      const int w = v - 512;
      if (w < 8) attn_unit16<true, false>(p, layer, 1, b, w >> 1, w & 1, lds);
      else if (w < 20) { const int x = w - 8; attn_unit16<false, false>(p, layer, 1, b, x >> 1, x & 1, lds); }
      else { const int x = w - 20; attn_unit16<false, true>(p, layer, 1, b, x >> 1, x & 1, lds); }
    }
  }
}

struct AttnArgs {
  const u16* Q; const u16* K; const u16* K2; const u16* V; u16* Y; const float* sink;
  int ldq, ldk, ldk2, ldv, ldy, ycol, G, window, q_is_ctx; float scale;
};
static_assert(sizeof(AttnArgs) == 88, "no padding");
template <int DK1, int DK2>
__global__ __launch_bounds__(64) void k_attn(AttnArgs a) {
  const int qt = blockIdx.x * 64 + threadIdx.x, b = blockIdx.y, h = blockIdx.z, kvh = h / a.G;
  const int qrow = a.q_is_ctx ? NL + b * C_ + qt : b * S_ + qt;
  float q[DK1 + DK2];
  {
    const uint4* qp = (const uint4*)(a.Q + (size_t)qrow * a.ldq + h * (DK1 + DK2));
#pragma unroll
    for (int i = 0; i < (DK1 + DK2) / 8; ++i) {
      uint4 u = qp[i];
      q[i * 8 + 0] = bflo(u.x) * a.scale; q[i * 8 + 1] = bfhi(u.x) * a.scale; q[i * 8 + 2] = bflo(u.y) * a.scale; q[i * 8 + 3] = bfhi(u.y) * a.scale;
      q[i * 8 + 4] = bflo(u.z) * a.scale; q[i * 8 + 5] = bfhi(u.z) * a.scale; q[i * 8 + 6] = bflo(u.w) * a.scale; q[i * 8 + 7] = bfhi(u.w) * a.scale;
    }
  }
  float m, l, o[64];
  if (a.sink) { m = a.sink[h]; l = 1.f; } else { m = -1e30f; l = 0.f; }
#pragma unroll
  for (int d = 0; d < 64; ++d) o[d] = 0.f;
  const int nseg = a.q_is_ctx ? 1 : 2;
  for (int seg = 0; seg < nseg; ++seg) {
    int lo, hi, rbase; bool masked = false;
    if (seg == 0) { lo = 0; hi = C_; rbase = NL + b * C_; }
    else {
      lo = 0; hi = S_; rbase = b * S_;
      if (a.window) { int t0 = blockIdx.x * 64; lo = t0 - a.window; if (lo < 0) lo = 0; hi = t0 + 64 + a.window; if (hi > S_) hi = S_; masked = true; }
    }
    for (int s = lo; s < hi; s += 4) {
      float sc[4];
#pragma unroll
      for (int i = 0; i < 4; ++i) {
        const uint4* kp = (const uint4*)(a.K + (size_t)(rbase + s + i) * a.ldk + kvh * DK1);
        float dot = 0.f;
#pragma unroll
        for (int c = 0; c < DK1 / 8; ++c) {
          uint4 u = kp[c];
          dot += q[c * 8 + 0] * bflo(u.x) + q[c * 8 + 1] * bfhi(u.x) + q[c * 8 + 2] * bflo(u.y) + q[c * 8 + 3] * bfhi(u.y)
               + q[c * 8 + 4] * bflo(u.z) + q[c * 8 + 5] * bfhi(u.z) + q[c * 8 + 6] * bflo(u.w) + q[c * 8 + 7] * bfhi(u.w);
        }
        if (DK2 > 0) {
          const uint4* kp2 = (const uint4*)(a.K2 + (size_t)(rbase + s + i) * a.ldk2);
#pragma unroll
          for (int c = 0; c < DK2 / 8; ++c) {
            uint4 u = kp2[c];
            dot += q[DK1 + c * 8 + 0] * bflo(u.x) + q[DK1 + c * 8 + 1] * bfhi(u.x) + q[DK1 + c * 8 + 2] * bflo(u.y) + q[DK1 + c * 8 + 3] * bfhi(u.y)
                 + q[DK1 + c * 8 + 4] * bflo(u.z) + q[DK1 + c * 8 + 5] * bfhi(u.z) + q[DK1 + c * 8 + 6] * bflo(u.w) + q[DK1 + c * 8 + 7] * bfhi(u.w);
          }
        }
        if (masked) { int dlt = qt - (s + i); if (dlt < 0) dlt = -dlt; if (dlt > a.window) dot = -1e30f; }
        sc[i] = dot;
      }
      float mx = fmaxf(fmaxf(fmaxf(sc[0], sc[1]), fmaxf(sc[2], sc[3])), m);
      const float alpha = __expf(m - mx);
      float pr[4];
#pragma unroll
      for (int i = 0; i < 4; ++i) pr[i] = __expf(sc[i] - mx);
      l = l * alpha + (pr[0] + pr[1]) + (pr[2] + pr[3]);
      m = mx;
#pragma unroll
      for (int d = 0; d < 64; ++d) o[d] *= alpha;
#pragma unroll
      for (int i = 0; i < 4; ++i) {
        const uint4* vp = (const uint4*)(a.V + (size_t)(rbase + s + i) * a.ldv + kvh * 64);
#pragma unroll
        for (int c = 0; c < 8; ++c) {
          uint4 u = vp[c];
          o[c * 8 + 0] += pr[i] * bflo(u.x); o[c * 8 + 1] += pr[i] * bfhi(u.x); o[c * 8 + 2] += pr[i] * bflo(u.y); o[c * 8 + 3] += pr[i] * bfhi(u.y);
          o[c * 8 + 4] += pr[i] * bflo(u.z); o[c * 8 + 5] += pr[i] * bfhi(u.z); o[c * 8 + 6] += pr[i] * bflo(u.w); o[c * 8 + 7] += pr[i] * bfhi(u.w);
        }
      }
    }
  }
  const float inv = 1.f / l;
  uint4* yp = (uint4*)(a.Y + (size_t)qrow * a.ldy + a.ycol + h * 64);
#pragma unroll
  for (int c = 0; c < 8; ++c) {
    uint4 u;
    u.x = cvtpk(o[c * 8 + 0] * inv, o[c * 8 + 1] * inv); u.y = cvtpk(o[c * 8 + 2] * inv, o[c * 8 + 3] * inv);
    u.z = cvtpk(o[c * 8 + 4] * inv, o[c * 8 + 5] * inv); u.w = cvtpk(o[c * 8 + 6] * inv, o[c * 8 + 7] * inv);
    yp[c] = u;
  }
}


constexpr int CW_BAR = 1024;
#define XB_TMO      128
#define XB_XCNT(j)  (256  + 64 * (j))
#define XB_XSUB(j)  (1280 + 64 * (j))
#define XB_XGEN(j)  (2304 + 64 * (j))
#define XB_TOP      3328
#define XB_TOPGEN   3392
#define XCD_BAR_WORDS 3456
#define XB_SPIN_CAP (1u << 22)
DI unsigned xb_ld(unsigned* p) { return __hip_atomic_load(p, __ATOMIC_RELAXED, __HIP_MEMORY_SCOPE_AGENT); }
DI unsigned xb_add(unsigned* p, unsigned v) { return __hip_atomic_fetch_add(p, v, __ATOMIC_RELAXED, __HIP_MEMORY_SCOPE_AGENT); }
DI unsigned xb_xcc_id() { return (unsigned)__builtin_amdgcn_s_getreg((3 << 11) | 20) & 0xFu; }
#define XB_SPIN(cond, bar) do { unsigned _sp = 0; while (cond) { __builtin_amdgcn_s_sleep(1); \
    if ((++_sp & 255u) == 0u) { if (xb_ld(&(bar)[XB_TMO])) break; if (_sp > XB_SPIN_CAP) { atomicAdd(&(bar)[XB_TMO], 1u); break; } } } } while (0)
struct XcdBarrier { unsigned* bar; unsigned x; volatile LAS unsigned* st; };
DI XcdBarrier xcd_barrier_post(unsigned* bar, volatile LAS unsigned* st) {
  XcdBarrier b; b.bar = bar; b.x = xb_xcc_id(); b.st = st;
  if (threadIdx.x == 0) (void)xb_add(&bar[XB_XCNT(b.x)], 1u);
  return b;
}
DI void xcd_barrier_complete(unsigned* bar, unsigned x, unsigned& nloc, unsigned& nx) {
  const unsigned G = gridDim.x * gridDim.y * gridDim.z;
  unsigned sum, cnt, mine, sp = 0u;
  for (;;) {
    sum = 0u; cnt = 0u; mine = 0u;
#pragma unroll
    for (unsigned j = 0; j < 16; ++j) { const unsigned c = xb_ld(&bar[XB_XCNT(j)]); sum += c; cnt += (c > 0u) ? 1u : 0u; mine = (j == x) ? c : mine; }
    if (sum == G) break;
    __builtin_amdgcn_s_sleep(1);
    if ((++sp & 255u) == 0u) { if (xb_ld(&bar[XB_TMO])) break; if (sp > XB_SPIN_CAP) { atomicAdd(&bar[XB_TMO], 1u); break; } }
  }
  nloc = mine > 0u ? mine : 1u; nx = cnt > 0u ? cnt : 1u;
}
DI void xcd_barrier(const XcdBarrier& b) {
  asm volatile("s_waitcnt vmcnt(0)" ::: "memory");
  __syncthreads();
  if (threadIdx.x == 0) {
    unsigned* bar = b.bar;
    __builtin_amdgcn_s_waitcnt(0);
    unsigned nloc = b.st[0], nx = b.st[1];
    if (nloc == 0u) { xcd_barrier_complete(bar, b.x, nloc, nx); b.st[0] = nloc; b.st[1] = nx; }
    const unsigned old = xb_add(&bar[XB_XSUB(b.x)], 1u);
    const unsigned gen = old / nloc;
    if (old + 1u == (gen + 1u) * nloc) {
      __builtin_amdgcn_fence(__ATOMIC_RELEASE, "agent");
      asm volatile("s_waitcnt vmcnt(0)" ::: "memory");
      const unsigned og = xb_add(&bar[XB_TOP], 1u);
      const unsigned tg = og / nx;
      if (og + 1u == (tg + 1u) * nx) xb_add(&bar[XB_TOPGEN], 1u);
      else XB_SPIN(xb_ld(&bar[XB_TOPGEN]) == tg, bar);
      __builtin_amdgcn_fence(__ATOMIC_ACQUIRE, "agent");
      xb_add(&bar[XB_XGEN(b.x)], 1u);
      asm volatile("s_waitcnt vmcnt(0)" ::: "memory");
    } else {
      XB_SPIN(xb_ld(&bar[XB_XGEN(b.x)]) == gen, bar);
      __builtin_amdgcn_fence(__ATOMIC_ACQUIRE, "agent");
      asm volatile("s_waitcnt vmcnt(0)" ::: "memory");
    }
  }
  __syncthreads();
}

__global__ __launch_bounds__(NTHR, 2) void k_mega(Params p) {
  extern __shared__ __attribute__((aligned(16))) unsigned char smem[];
  LAS char* lds = (LAS char*)smem;
  if (p.never) cooperative_groups::this_grid().sync();
  volatile LAS unsigned* st = (volatile LAS unsigned*)(lds + LDS_MISC + 3584);
  if (threadIdx.x < 4) st[threadIdx.x] = 0u;
  __syncthreads();
  XcdBarrier bar = xcd_barrier_post((unsigned*)(p.ws + OFF_CTRL) + CW_BAR, st);
#ifdef PROBE_SEG
  unsigned long long t_acc = 0ull, t_s = 0ull;
#define SEG_BEGIN(id) do { if ((id) == PROBE_SEG && blockIdx.x == 0 && threadIdx.x == 0) t_s = __builtin_amdgcn_s_memrealtime(); } while (0)
#define SEG_END(id) do { if ((id) == PROBE_SEG && blockIdx.x == 0 && threadIdx.x == 0) t_acc += __builtin_amdgcn_s_memrealtime() - t_s; } while (0)
#else
#define SEG_BEGIN(id) do {} while (0)
#define SEG_END(id) do {} while (0)
#endif
  SEG_BEGIN(0); p0_prologue(p, lds); xcd_barrier(bar); SEG_END(0);
  SEG_BEGIN(1); p1_norm_mix(p, 0); xcd_barrier(bar); SEG_END(1);
#pragma unroll 1
  for (int l = 0; l < 2; ++l) {
    const int nrows = l == 0 ? NT : NL;
    SEG_BEGIN(2 + 10 * l); p2_inproj(p, l, lds); xcd_barrier(bar); SEG_END(2 + 10 * l);
    SEG_BEGIN(3 + 10 * l); p3_attention(p, l, lds); xcd_barrier(bar); SEG_END(3 + 10 * l);
    SEG_BEGIN(4 + 10 * l); p4_outproj(p, l, nrows, lds); xcd_barrier(bar); SEG_END(4 + 10 * l);
    SEG_BEGIN(5 + 10 * l); p5_norm_ffn(p, l, nrows, lds); xcd_barrier(bar); SEG_END(5 + 10 * l);
    SEG_BEGIN(6 + 10 * l); p6_gateup(p, l, nrows, lds); xcd_barrier(bar); SEG_END(6 + 10 * l);
    SEG_BEGIN(7 + 10 * l); p7_down(p, l, nrows, lds); xcd_barrier(bar); SEG_END(7 + 10 * l);
    SEG_BEGIN(8 + 10 * l); p8_combine(p, l, nrows); if (l == 0) xcd_barrier(bar); SEG_END(8 + 10 * l);
  }
#ifdef PROBE_SEG
  if (blockIdx.x == 0 && threadIdx.x == 0) {
    const unsigned long long t0 = __builtin_amdgcn_s_memrealtime();
    while (__builtin_amdgcn_s_memrealtime() - t0 < 9ull * t_acc) __builtin_amdgcn_s_sleep(8);
  }
#endif
}

template <int PH>
__global__ __launch_bounds__(NTHR, 2) void k_phase(Params p, int layer, int nrows) {
  extern __shared__ __attribute__((aligned(16))) unsigned char smem[];
  LAS char* lds = (LAS char*)smem;
  if (PH == 0) p0_prologue(p, lds);
  if (PH == 1) p1_norm_mix(p, layer);
  if (PH == 2) p2_inproj(p, layer, lds);
  if (PH == 3) p3_attention(p, layer, lds);
  if (PH == 4) p4_outproj(p, layer, nrows, lds);
  if (PH == 5) p5_norm_ffn(p, layer, nrows, lds);
  if (PH == 6) p6_gateup(p, layer, nrows, lds);
  if (PH == 7) p7_down(p, layer, nrows, lds);
  if (PH == 8) p8_combine(p, layer, nrows);
}

extern "C" void kernel_launch(void* const* d_in, const int* in_sizes, int n_in, void* d_out, int out_size, void* d_ws, size_t ws_size, hipStream_t stream) {
  Params p{};
  p.x = (const float*)d_in[0]; p.c = (const float*)d_in[1]; p.ctx = (const float*)d_in[2]; p.c_ctx = (const float*)d_in[3];
  p.w_mod = (const float*)d_in[4]; p.b_mod = (const float*)d_in[5]; p.norm_mix_g = (const float*)d_in[6]; p.norm_ffn_g = (const float*)d_in[7];
  p.w_in = (const float*)d_in[8]; p.w_out = (const float*)d_in[9]; p.swa_sink = (const float*)d_in[10]; p.glb_q_gain = (const float*)d_in[11];
  p.glb_k_gain = (const float*)d_in[12]; p.mla_q_gain = (const float*)d_in[13]; p.mla_w_uq = (const float*)d_in[14]; p.mla_kv_gain = (const float*)d_in[15];
  p.mla_w_ukv = (const float*)d_in[16]; p.router_w = (const float*)d_in[17]; p.router_bias = (const float*)d_in[18]; p.exp_w_gate = (const float*)d_in[19];
  p.exp_w_up = (const float*)d_in[20]; p.exp_w_down = (const float*)d_in[21]; p.shr_w_gate = (const float*)d_in[22]; p.shr_w_up = (const float*)d_in[23];
  p.shr_w_down = (const float*)d_in[24]; p.final_norm_g = (const float*)d_in[25];
  p.out = (float*)d_out; p.ws = (char*)d_ws;
  char* ws = (char*)d_ws;

#ifndef MEGA
#define MEGA 1
#endif
#if MEGA
  static int grid_blocks = 0;
  if (!grid_blocks) {
    (void)hipFuncSetAttribute((const void*)k_mega, hipFuncAttributeMaxDynamicSharedMemorySize, LDS_BYTES);
    int dev = 0, cus = 0, per_cu = 0;
    (void)hipGetDevice(&dev);
    (void)hipDeviceGetAttribute(&cus, hipDeviceAttributeMultiprocessorCount, dev);
    (void)hipOccupancyMaxActiveBlocksPerMultiprocessor(&per_cu, (const void*)k_mega, NTHR, LDS_BYTES);
    if (per_cu > 2) per_cu = 2;
    if (per_cu < 1) per_cu = 1;
    grid_blocks = cus * per_cu;
  }
  (void)hipMemsetAsync(ws + OFF_CTRL, 0, CTRL_BYTES, stream);
  void* args[] = {&p};
  hipError_t e = hipLaunchCooperativeKernel((const void*)k_mega, dim3(grid_blocks), dim3(NTHR), args, LDS_BYTES, stream);
  if (e != hipSuccess) fprintf(stderr, "cooperative launch failed: %s (grid %d)\n", hipGetErrorString(e), grid_blocks);
#else
  static bool attr_done = false;
  if (!attr_done) {
    (void)hipFuncSetAttribute((const void*)k_phase<0>, hipFuncAttributeMaxDynamicSharedMemorySize, LDS_BYTES);
    (void)hipFuncSetAttribute((const void*)k_phase<1>, hipFuncAttributeMaxDynamicSharedMemorySize, LDS_BYTES);
    (void)hipFuncSetAttribute((const void*)k_phase<2>, hipFuncAttributeMaxDynamicSharedMemorySize, LDS_BYTES);
    (void)hipFuncSetAttribute((const void*)k_phase<3>, hipFuncAttributeMaxDynamicSharedMemorySize, LDS_BYTES);
    (void)hipFuncSetAttribute((const void*)k_phase<4>, hipFuncAttributeMaxDynamicSharedMemorySize, LDS_BYTES);
    (void)hipFuncSetAttribute((const void*)k_phase<5>, hipFuncAttributeMaxDynamicSharedMemorySize, LDS_BYTES);
    (void)hipFuncSetAttribute((const void*)k_phase<6>, hipFuncAttributeMaxDynamicSharedMemorySize, LDS_BYTES);
    (void)hipFuncSetAttribute((const void*)k_phase<7>, hipFuncAttributeMaxDynamicSharedMemorySize, LDS_BYTES);
    (void)hipFuncSetAttribute((const void*)k_phase<8>, hipFuncAttributeMaxDynamicSharedMemorySize, LDS_BYTES);
    attr_done = true;
  }

  (void)hipMemsetAsync(ws + OFF_CTRL, 0, CTRL_BYTES, stream);
  k_phase<0><<<GRID, NTHR, LDS_BYTES, stream>>>(p, 0, 0);
  k_phase<1><<<GRID, NTHR, LDS_BYTES, stream>>>(p, 0, NT);
  for (int l = 0; l < 2; ++l) {
    const bool last = (l == 1);
    const int Mres = last ? NL : NT;
    k_phase<2><<<GRID, NTHR, LDS_BYTES, stream>>>(p, l, NT);
    k_phase<3><<<GRID, NTHR, LDS_BYTES, stream>>>(p, l, NT);
    k_phase<4><<<GRID, NTHR, LDS_BYTES, stream>>>(p, l, Mres);
    k_phase<5><<<GRID, NTHR, LDS_BYTES, stream>>>(p, l, Mres);
    k_phase<6><<<GRID, NTHR, LDS_BYTES, stream>>>(p, l, Mres);
    k_phase<7><<<GRID, NTHR, LDS_BYTES, stream>>>(p, l, Mres);
    k_phase<8><<<GRID, NTHR, LDS_BYTES, stream>>>(p, l, Mres);
  }
#endif
}
```

```cpp
#include <hip/hip_runtime.h>
#include <hip/hip_cooperative_groups.h>
#include <cstdio>
#include <stdint.h>
#include <stddef.h>

typedef unsigned short u16;
typedef short bf16x8 __attribute__((ext_vector_type(8)));
typedef float f32x4 __attribute__((ext_vector_type(4)));
typedef float f32x2_t __attribute__((ext_vector_type(2)));
typedef __bf16 bf16x2_t __attribute__((ext_vector_type(2)));
typedef unsigned u32x2_t __attribute__((ext_vector_type(2)));
typedef unsigned u32x4_t __attribute__((ext_vector_type(4)));
#define DI __device__ __forceinline__
#define LAS __attribute__((address_space(3)))

constexpr int B_ = 8, S_ = 4096, D_ = 1024, C_ = 256;
constexpr int NL = B_ * S_, NC = B_ * C_, NT = NL + NC;
constexpr int INW = 1696, INWP = 1792;
constexpr int NE = 16;
constexpr int MAXSLOT = NT * 2 + NE * 128;
constexpr float EPS = 1e-6f;
constexpr int NTHR = 256;
constexpr int GRID = 512;

DI float bf2f(u16 v) { return __uint_as_float(((unsigned)v) << 16); }
DI float bflo(unsigned u) { return __uint_as_float(u << 16); }
DI float bfhi(unsigned u) { return __uint_as_float(u & 0xffff0000u); }
DI unsigned cvtpk(float lo, float hi) { f32x2_t v = {lo, hi}; bf16x2_t b = __builtin_convertvector(v, bf16x2_t); return __builtin_bit_cast(unsigned, b); }
template <int CTRL> DI float dpp_mov(float v) { return __int_as_float(__builtin_amdgcn_update_dpp(0, __float_as_int(v), CTRL, 0xf, 0xf, false)); }
DI float wave_sum(float v) {
  v += dpp_mov<0xB1>(v);
  v += dpp_mov<0x4E>(v);
  v += dpp_mov<0x141>(v);
  v += dpp_mov<0x140>(v);
  { auto rr = __builtin_amdgcn_permlane16_swap(__float_as_uint(v), __float_as_uint(v), false, false); v = __uint_as_float(rr[0]) + __uint_as_float(rr[1]); }
  { auto rr = __builtin_amdgcn_permlane32_swap(__float_as_uint(v), __float_as_uint(v), false, false); v = __uint_as_float(rr[0]) + __uint_as_float(rr[1]); }
  return v;
}
DI float silu(float g) { return g / (1.f + __expf(-g)); }
DI int opaque(int v) { asm volatile("" : "+v"(v)); return v; }

constexpr size_t al256(size_t x) { return (x + 255) & ~(size_t)255; }
constexpr size_t OFF_CTRL = 0;
constexpr size_t CTRL_BYTES = 65536;
constexpr size_t OFF_CTXR = OFF_CTRL + CTRL_BYTES;
constexpr size_t OFF_MOD = OFF_CTXR + al256((size_t)NC * D_ * 4);
constexpr size_t OFF_TOKE = OFF_MOD + al256((size_t)2 * 9 * 6144 * 4);
constexpr size_t OFF_TOKW = OFF_TOKE + al256((size_t)NT * 2 * 4);
constexpr size_t OFF_TOKP = OFF_TOKW + al256((size_t)NT * 2 * 4);
constexpr size_t OFF_LIST = OFF_TOKP + al256((size_t)NT * 2 * 4);
constexpr size_t OFF_WIN = OFF_LIST + al256((size_t)NE * NT * 4);
constexpr size_t OFF_WO = OFF_WIN + (size_t)2 * INWP * 1024 * 2;
constexpr size_t OFF_WUQ = OFF_WO + (size_t)2 * 1024 * 1024 * 2;
constexpr size_t OFF_WUKV = OFF_WUQ + (size_t)2 * 384 * 256 * 2;
constexpr size_t OFF_WGU = OFF_WUKV + (size_t)2 * 512 * 128 * 2;
constexpr size_t OFF_WD = OFF_WGU + (size_t)2 * 16 * 1024 * 1024 * 2;
constexpr size_t OFF_SGU = OFF_WD + (size_t)2 * 16 * 1024 * 512 * 2;
constexpr size_t OFF_SD = OFF_SGU + (size_t)2 * 1024 * 1024 * 2;
constexpr size_t OFF_H = OFF_SD + (size_t)2 * 1024 * 512 * 2;
constexpr size_t OFF_BIG = OFF_H + (size_t)NT * 1024 * 2;
constexpr size_t OFF_SWQ = OFF_BIG;
constexpr size_t OFF_SWK = OFF_SWQ + (size_t)NT * 384 * 2;
constexpr size_t OFF_SWV = OFF_SWK + (size_t)NT * 128 * 2;
constexpr size_t OFF_GLQ = OFF_SWV + (size_t)NT * 128 * 2;
constexpr size_t OFF_GLK = OFF_GLQ + (size_t)NT * 384 * 2;
constexpr size_t OFF_GLV = OFF_GLK + (size_t)NT * 128 * 2;
constexpr size_t OFF_MLQ = OFF_GLV + (size_t)NT * 128 * 2;
constexpr size_t OFF_MLK = OFF_MLQ + (size_t)NT * 384 * 2;
constexpr size_t OFF_MLKR = OFF_MLK + (size_t)NT * 256 * 2;
constexpr size_t OFF_MLV = OFF_MLKR + (size_t)NT * 32 * 2;
constexpr size_t OFF_QLAT = OFF_MLV + (size_t)NT * 256 * 2;
constexpr size_t OFF_KVLAT = OFF_QLAT + (size_t)NT * 256 * 2;
constexpr size_t OFF_Y = OFF_KVLAT + (size_t)NT * 128 * 2;
constexpr size_t END_A = OFF_Y + (size_t)NT * 1024 * 2;
constexpr size_t OFF_ACT = OFF_BIG;
constexpr size_t OFF_ACTS = OFF_ACT + (size_t)MAXSLOT * 512 * 2;
constexpr size_t OFF_YEXP = OFF_ACTS + (size_t)NT * 512 * 2;
constexpr size_t END_B = OFF_YEXP + (size_t)MAXSLOT * 1024 * 2;
constexpr size_t OFF_YSH = OFF_H;
constexpr size_t OFF_DELTA = OFF_SWQ;
static_assert(OFF_DELTA + (size_t)NT * 1024 * 2 <= OFF_MLQ, "DELTA must fit below MLQ");
constexpr size_t WS_NEED = END_A > END_B ? END_A : END_B;
static_assert(WS_NEED <= (size_t)536870912, "workspace too large");

constexpr int CW_CTR = 0;
constexpr int CW_CNT = 8192;
constexpr int CW_Q = 10240;

struct Params {
  const float *x, *c, *ctx, *c_ctx, *w_mod, *b_mod, *norm_mix_g, *norm_ffn_g, *w_in, *w_out, *swa_sink, *glb_q_gain, *glb_k_gain,
      *mla_q_gain, *mla_w_uq, *mla_kv_gain, *mla_w_ukv, *router_w, *router_bias, *exp_w_gate, *exp_w_up, *exp_w_down, *shr_w_gate,
      *shr_w_up, *shr_w_down, *final_norm_g;
  float* out;
  char* ws;
  int never; int pad;
};

constexpr int LDS_MISC = 65536;
constexpr int LDS_BYTES = 65536 + 8192;

DI int next_unit(unsigned* ctr, LAS char* lds) {
  volatile LAS int* slot = (volatile LAS int*)(lds + LDS_MISC + 2560);
  __syncthreads();
  if (threadIdx.x == 0) *slot = (int)atomicAdd(ctr, 1u);
  __syncthreads();
  return *slot;
}

DI unsigned xcc_id_() { return (unsigned)__builtin_amdgcn_s_getreg((3 << 11) | 20) & 0x7u; }
DI int next_unit_xcd(unsigned* ctr8, int per_queue, LAS char* lds) {
  volatile LAS int* slot = (volatile LAS int*)(lds + LDS_MISC + 2560);
  __syncthreads();
  if (threadIdx.x == 0) {
    const int q0 = (int)xcc_id_();
    int res = -1;
    for (int i = 0; i < 8; ++i) {
      const int q = (q0 + i) & 7;
      const int v = (int)atomicAdd(&ctr8[q * 64], 1u);
      if (v < per_queue) { res = q * per_queue + v; break; }
    }
    *slot = res;
  }
  __syncthreads();
  return *slot;
}
DI void cvt_job(const float* __restrict__ src, int ld, int N, int k0, int n0, u16* __restrict__ dst, int K, int mode  , LAS char* lds) {
  LAS float* T = (LAS float*)lds;
  const int tid = threadIdx.x;
  __syncthreads();
  {
    const int kk = tid >> 2, nq = (tid & 3) * 32;
    const float* s = src + (size_t)(k0 + kk) * ld + n0 + nq;
#pragma unroll
    for (int i = 0; i < 8; ++i) {
      float4 v = make_float4(0.f, 0.f, 0.f, 0.f);
      if (n0 + nq + i * 4 < N) v = *(const float4*)(s + i * 4);
      LAS float* t = T + kk * 129 + nq + i * 4;
      t[0] = v.x; t[1] = v.y; t[2] = v.z; t[3] = v.w;
    }
  }
  __syncthreads();
#pragma unroll
  for (int i = 0; i < 4; ++i) {
    const int chn = tid + i * 256;
    const int n = chn >> 3, kc = (chn & 7) * 8;
    if (n0 + n < N) {
      const LAS float* t = T + kc * 129 + n;
      uint4 o;
      o.x = cvtpk(t[0], t[129]); o.y = cvtpk(t[2 * 129], t[3 * 129]); o.z = cvtpk(t[4 * 129], t[5 * 129]); o.w = cvtpk(t[6 * 129], t[7 * 129]);
      const int gn = n0 + n;
      int drow = gn;
      if (mode) drow = (gn >> 5) * 64 + (gn & 31) + (mode == 2 ? 32 : 0);
      *(uint4*)(dst + (size_t)drow * K + k0 + kc) = o;
    }
  }
}

DI void mod_job(const Params& p, int l, int j0, LAS char* lds) {
  LAS float* sc = (LAS float*)lds;
  LAS float* red = (LAS float*)(lds + 36864);
  const int tid = threadIdx.x;
  __syncthreads();
  for (int i = tid; i < 9 * 1024; i += NTHR) {
    int r = i >> 10, k = i & 1023;
    float v = r < 8 ? p.c[r * 1024 + k] : p.c_ctx[k];
    sc[i] = v / (1.f + __expf(-v));
  }
  __syncthreads();
  const int col = tid & 31, kg = tid >> 5;
  float acc[9];
#pragma unroll
  for (int r = 0; r < 9; ++r) acc[r] = 0.f;
  const float* w = p.w_mod + (size_t)l * 1024 * 6144 + (size_t)(kg * 128) * 6144 + j0 + col;
#pragma unroll 1
  for (int k0 = 0; k0 < 128; k0 += 16) {
    float wv[16];
#pragma unroll
    for (int u = 0; u < 16; ++u) wv[u] = w[(size_t)(k0 + u) * 6144];
#pragma unroll
    for (int u = 0; u < 16; ++u)
#pragma unroll
      for (int r = 0; r < 9; ++r) acc[r] += sc[r * 1024 + kg * 128 + k0 + u] * wv[u];
  }
#pragma unroll
  for (int r = 0; r < 9; ++r) red[(kg * 9 + r) * 32 + col] = acc[r];
  __syncthreads();
  float* MOD = (float*)(p.ws + OFF_MOD);
  for (int i = tid; i < 9 * 32; i += NTHR) {
    int r = i >> 5, cc = i & 31;
    float sum = 0.f;
#pragma unroll
    for (int g = 0; g < 8; ++g) sum += red[(g * 9 + r) * 32 + cc];
    MOD[(size_t)(l * 9 + r) * 6144 + j0 + cc] = sum + p.b_mod[l * 6144 + j0 + cc];
  }
}

constexpr int J_WIN = 16 * 14, J_WO = 16 * 8, J_UQ = 4 * 3, J_UKV = 2 * 4, J_EG = 16 * 4, J_ED = 8 * 8;
constexpr int J_DENSE = J_WIN + J_WO + J_UQ + J_UKV;
constexpr int J_EXP = 16 * (2 * J_EG + J_ED);
constexpr int J_SHR = 2 * J_EG + J_ED;
constexpr int J_LAYER = J_DENSE + J_EXP + J_SHR;
constexpr int J_MOD = 2 * 192;
constexpr int J_TOTAL = 2 * J_LAYER + J_MOD;

DI void p0_prologue(const Params& p, LAS char* lds) {
  char* ws = p.ws;
  for (int job = blockIdx.x; job < J_TOTAL; job += gridDim.x) {
    if (job < J_MOD) { mod_job(p, job / 192, (job % 192) * 32, lds); continue; }
    int r = job - J_MOD;
    const int l = r / J_LAYER; r -= l * J_LAYER;
    if (r < J_WIN) { cvt_job(p.w_in + (size_t)l * 1024 * INW, INW, INW, (r / 14) * 64, (r % 14) * 128, (u16*)(ws + OFF_WIN) + (size_t)l * INWP * 1024, 1024, 0, lds); continue; } r -= J_WIN;
    if (r < J_WO) { cvt_job(p.w_out + (size_t)l * 1024 * 1024, 1024, 1024, (r / 8) * 64, (r % 8) * 128, (u16*)(ws + OFF_WO) + (size_t)l * 1024 * 1024, 1024, 0, lds); continue; } r -= J_WO;
    if (r < J_UQ) { cvt_job(p.mla_w_uq + (size_t)l * 256 * 384, 384, 384, (r / 3) * 64, (r % 3) * 128, (u16*)(ws + OFF_WUQ) + (size_t)l * 384 * 256, 256, 0, lds); continue; } r -= J_UQ;
    if (r < J_UKV) { cvt_job(p.mla_w_ukv + (size_t)l * 128 * 512, 512, 512, (r / 4) * 64, (r % 4) * 128, (u16*)(ws + OFF_WUKV) + (size_t)l * 512 * 128, 128, 0, lds); continue; } r -= J_UKV;
    if (r < J_EXP) {
      const int e = r / (2 * J_EG + J_ED); int q = r % (2 * J_EG + J_ED);
      const size_t le = (size_t)l * NE + e;
      if (q < J_EG) { cvt_job(p.exp_w_gate + le * 1024 * 512, 512, 512, (q / 4) * 64, (q % 4) * 128, (u16*)(ws + OFF_WGU) + le * 1024 * 1024, 1024, 1, lds); continue; } q -= J_EG;
      if (q < J_EG) { cvt_job(p.exp_w_up + le * 1024 * 512, 512, 512, (q / 4) * 64, (q % 4) * 128, (u16*)(ws + OFF_WGU) + le * 1024 * 1024, 1024, 2, lds); continue; } q -= J_EG;
      cvt_job(p.exp_w_down + le * 512 * 1024, 1024, 1024, (q / 8) * 64, (q % 8) * 128, (u16*)(ws + OFF_WD) + le * 1024 * 512, 512, 0, lds); continue;
    }
    r -= J_EXP;
    if (r < J_EG) { cvt_job(p.shr_w_gate + (size_t)l * 1024 * 512, 512, 512, (r / 4) * 64, (r % 4) * 128, (u16*)(ws + OFF_SGU) + (size_t)l * 1024 * 1024, 1024, 1, lds); continue; } r -= J_EG;
    if (r < J_EG) { cvt_job(p.shr_w_up + (size_t)l * 1024 * 512, 512, 512, (r / 4) * 64, (r % 4) * 128, (u16*)(ws + OFF_SGU) + (size_t)l * 1024 * 1024, 1024, 2, lds); continue; } r -= J_EG;
    cvt_job(p.shr_w_down + (size_t)l * 512 * 1024, 1024, 1024, (r / 8) * 64, (r % 8) * 128, (u16*)(ws + OFF_SD) + (size_t)l * 1024 * 512, 512, 0, lds);
  }
}

DI const float* xrow_ptr(const Params& p, int layer_src  , int row) {
  if (layer_src == 0) return row < NL ? p.x + (size_t)row * 1024 : p.ctx + (size_t)(row - NL) * 1024;
  return row < NL ? p.out + (size_t)row * 1024 : (const float*)(p.ws + OFF_CTXR) + (size_t)(row - NL) * 1024;
}
DI float* xrow_out(const Params& p, int row) {
  return row < NL ? p.out + (size_t)row * 1024 : (float*)(p.ws + OFF_CTXR) + (size_t)(row - NL) * 1024;
}

DI void norm_mod_row(f32x4 (&v)[4], const float* __restrict__ g, const float* __restrict__ md  , int lane) {
  float ss = 0.f;
#pragma unroll
  for (int i = 0; i < 4; ++i) ss += v[i].x * v[i].x + v[i].y * v[i].y + v[i].z * v[i].z + v[i].w * v[i].w;
  ss = wave_sum(ss);
  const float rstd = rsqrtf(ss * (1.f / 1024.f) + EPS);
#pragma unroll
  for (int i = 0; i < 4; ++i) {
    const f32x4 gg = *(const f32x4*)(g + lane * 4 + i * 256);
    const f32x4 sh = *(const f32x4*)(md + lane * 4 + i * 256);
    const f32x4 sc = *(const f32x4*)(md + 1024 + lane * 4 + i * 256);
    v[i] = v[i] * rstd * gg * (sc + 1.f) + sh;
  }
}
DI void store_h_row(const f32x4 (&v)[4], u16* __restrict__ hrow, int lane) {
#pragma unroll
  for (int i = 0; i < 4; ++i) {
    uint2 o; o.x = cvtpk(v[i].x, v[i].y); o.y = cvtpk(v[i].z, v[i].w);
    *(uint2*)(hrow + lane * 4 + i * 256) = o;
  }
}

DI void p1_norm_mix(const Params& p, int layer) {
  const int tid_ = opaque((int)threadIdx.x); const int lane = tid_ & 63, gw = blockIdx.x * 4 + (tid_ >> 6), ngw = gridDim.x * 4;
  const float* MODl = (const float*)(p.ws + OFF_MOD) + (size_t)layer * 9 * 6144;
  u16* H = (u16*)(p.ws + OFF_H);
  f32x4 vn[4];
  int row = gw;
  if (row < NT) { const float* xr = xrow_ptr(p, layer, row);
#pragma unroll
    for (int i = 0; i < 4; ++i) vn[i] = __builtin_nontemporal_load((const f32x4*)(xr + lane * 4 + i * 256)); }
  while (row < NT) {
    f32x4 v[4];
#pragma unroll
    for (int i = 0; i < 4; ++i) v[i] = vn[i];
    const int rown = row + ngw;
    if (rown < NT) { const float* xr = xrow_ptr(p, layer, rown);
#pragma unroll
      for (int i = 0; i < 4; ++i) vn[i] = __builtin_nontemporal_load((const f32x4*)(xr + lane * 4 + i * 256)); }
    const int mr = row < NL ? row / S_ : 8;
    norm_mod_row(v, p.norm_mix_g + layer * 1024, MODl + (size_t)mr * 6144, lane);
    store_h_row(v, H + (size_t)row * 1024, lane);
    row = rown;
  }
}

DI float max2nd4(float a, float b, float c, float d, float& m1) {
  const float ab = fmaxf(a, b), cd = fmaxf(c, d);
  m1 = fmaxf(ab, cd);
  return fmaxf(fmaxf(fminf(a, b), fminf(c, d)), fminf(ab, cd));
}
template <int CTRL> DI float dppz(float v) { return __int_as_float(__builtin_amdgcn_update_dpp(0, __float_as_int(v), CTRL, 0xf, 0xf, true)); }
DI float lane_xor4(float v, bool b2) { const float a = dppz<0x114>(v), b = dppz<0x104>(v); return b2 ? a : b; }
DI float lane_xor8(float v, bool b3) { const float a = dppz<0x118>(v), b = dppz<0x108>(v); return b3 ? a : b; }
DI bool beats(float a, int ia, float b, int ib) { return a > b || (a == b && ia < ib); }
DI void route_row(float bias_lane, const f32x4 (&v)[4], LAS char* lds, int lane, int& i0, int& i1, float& w0, float& w1) {
  const LAS f32x4* R = (const LAS f32x4*)lds;
  f32x4 pl4[4];
#pragma unroll
  for (int q = 0; q < 4; ++q) pl4[q] = (f32x4){0.f, 0.f, 0.f, 0.f};
#pragma unroll
  for (int i = 0; i < 4; ++i) {
    const int kq = i * 64 + lane;
    f32x4 wq[16];
#pragma unroll
    for (int j = 0; j < 16; ++j) wq[j] = R[j * 256 + kq];
    __builtin_amdgcn_sched_barrier(0);
#pragma unroll
    for (int kk = 0; kk < 4; ++kk) {
      const float hv = v[i][kk];
      const f32x4 hv4 = (f32x4){hv, hv, hv, hv};
#pragma unroll
      for (int q = 0; q < 4; ++q) pl4[q] = __builtin_elementwise_fma(hv4, wq[kk * 4 + q], pl4[q]);
    }
    __builtin_amdgcn_sched_barrier(0);
  }
  float pl[16];
#pragma unroll
  for (int q = 0; q < 4; ++q) { pl[q * 4 + 0] = pl4[q][0]; pl[q * 4 + 1] = pl4[q][1]; pl[q * 4 + 2] = pl4[q][2]; pl[q * 4 + 3] = pl4[q][3]; }
  const bool b0 = (lane & 1) != 0, b1 = (lane & 2) != 0, b2 = (lane & 4) != 0, b3 = (lane & 8) != 0;
  float r8[8], r4[4], r2[2];
#pragma unroll
  for (int i = 0; i < 8; ++i) { const float keep = b0 ? pl[i + 8] : pl[i], send = b0 ? pl[i] : pl[i + 8]; r8[i] = keep + dppz<0xB1>(send); }
#pragma unroll
  for (int i = 0; i < 4; ++i) { const float keep = b1 ? r8[i + 4] : r8[i], send = b1 ? r8[i] : r8[i + 4]; r4[i] = keep + dppz<0x4E>(send); }
#pragma unroll
  for (int i = 0; i < 2; ++i) { const float keep = b2 ? r4[i + 2] : r4[i], send = b2 ? r4[i] : r4[i + 2]; r2[i] = keep + lane_xor4(send, b2); }
  float lg;
  { const float keep = b3 ? r2[1] : r2[0], send = b3 ? r2[0] : r2[1]; lg = keep + lane_xor8(send, b3); }
  { auto rr = __builtin_amdgcn_permlane16_swap(__float_as_uint(lg), __float_as_uint(lg), false, false); lg = __uint_as_float(rr[0]) + __uint_as_float(rr[1]); }
  { auto rr = __builtin_amdgcn_permlane32_swap(__float_as_uint(lg), __float_as_uint(lg), false, false); lg = __uint_as_float(rr[0]) + __uint_as_float(rr[1]); }
  const float sg = __builtin_amdgcn_rcpf(1.f + __builtin_amdgcn_exp2f(-1.4426950408889634f * lg));
  const float bv = sg + bias_lane;
  const float m1v = lane_xor4(bv, b2), m2v = lane_xor8(bv, b3), m3v = lane_xor8(m1v, b3);
  float mtop; const float m2nd = max2nd4(bv, m1v, m2v, m3v, mtop);
  const float gs = mtop + m2nd;
  const float gA = dppz<0xB1>(gs), gB = dppz<0x4E>(gs), gC = dppz<0x1B>(gs);
  const int g = (b0 ? 2 : 0) + (b1 ? 1 : 0);
  const bool win = beats(gs, g, gA, g ^ 2) && beats(gs, g, gB, g ^ 1) && beats(gs, g, gC, g ^ 3);
  const int el = (b2 ? 2 : 0) + (b3 ? 1 : 0);
  const int rank = (beats(m1v, el ^ 2, bv, el) ? 1 : 0) + (beats(m2v, el ^ 1, bv, el) ? 1 : 0) + (beats(m3v, el ^ 3, bv, el) ? 1 : 0);
  const unsigned long long k0 = __ballot(win && rank == 0), k1 = __ballot(win && rank == 1);
  const int L0 = __builtin_ctzll(k0 | (1ull << 63)), L1 = __builtin_ctzll(k1 | (1ull << 63));
  const float s0 = __int_as_float(__builtin_amdgcn_readlane(__float_as_int(sg), L0));
  const float s1 = __int_as_float(__builtin_amdgcn_readlane(__float_as_int(sg), L1));
  i0 = 8 * (L0 & 1) + 4 * ((L0 >> 1) & 1) + 2 * ((L0 >> 2) & 1) + ((L0 >> 3) & 1);
  i1 = 8 * (L1 & 1) + 4 * ((L1 >> 1) & 1) + 2 * ((L1 >> 2) & 1) + ((L1 >> 3) & 1);
  const float inv = 1.f / (s0 + s1);
  w0 = s0 * inv; w1 = s1 * inv;
}

DI void load_router_lds(const Params& p, LAS char* lds) {
  LAS f32x4* R = (LAS f32x4*)lds;
  __syncthreads();
  for (int g = threadIdx.x; g < 4096; g += NTHR) {
    const int k = g >> 2, q = g & 3;
    R[((k & 3) * 4 + q) * 256 + (k >> 2)] = *(const f32x4*)(p.router_w + (size_t)g * 4);
  }
  __syncthreads();
}

constexpr int CNT_STRIDE = 64;
DI void p5_norm_ffn(const Params& p, int layer, int nrows, LAS char* lds) {
  load_router_lds(p, lds);
  const int tid = opaque((int)threadIdx.x), lane = tid & 63, wid = tid >> 6, gw = blockIdx.x * 4 + wid, ngw = gridDim.x * 4;
  const float* MODl = (const float*)(p.ws + OFF_MOD) + (size_t)layer * 9 * 6144;
  u16* H = (u16*)(p.ws + OFF_H);
  volatile LAS int* lcnt = (volatile LAS int*)(lds + LDS_MISC + 3072);
  volatile LAS int* lbase = lcnt + 16;
  volatile LAS int* stash = (volatile LAS int*)(lds + LDS_MISC + 4096) + wid * 160;
  int* tok_e = (int*)(p.ws + OFF_TOKE); float* tok_w = (float*)(p.ws + OFF_TOKW); int* tok_p = (int*)(p.ws + OFF_TOKP);
  int* list = (int*)(p.ws + OFF_LIST);
  unsigned* cnt = (unsigned*)(p.ws + OFF_CTRL) + CW_CNT + layer * 16 * CNT_STRIDE;
  if (tid < 16) lcnt[tid] = 0;
  __syncthreads();
  const float bias = p.router_bias[8 * (lane & 1) + 4 * ((lane >> 1) & 1) + 2 * ((lane >> 2) & 1) + ((lane >> 3) & 1)];
  int nst = 0;
  f32x4 vn[4]; u32x2_t dn[4];
  const u16* DELTA = (const u16*)(p.ws + OFF_DELTA);
  if (gw < nrows) { const float* xr0 = xrow_ptr(p, layer, gw);
#pragma unroll
    for (int i = 0; i < 4; ++i) { vn[i] = __builtin_nontemporal_load((const f32x4*)(xr0 + lane * 4 + i * 256)); dn[i] = __builtin_nontemporal_load((const u32x2_t*)(DELTA + (size_t)gw * 1024 + lane * 4 + i * 256)); } }
  for (int row = gw; row < nrows; row += ngw) {
    f32x4 v[4];
#pragma unroll
    for (int i = 0; i < 4; ++i) { v[i] = vn[i]; v[i][0] += bflo(dn[i][0]); v[i][1] += bfhi(dn[i][0]); v[i][2] += bflo(dn[i][1]); v[i][3] += bfhi(dn[i][1]); }
    if (row + ngw < nrows) { const float* xrn = xrow_ptr(p, layer, row + ngw);
#pragma unroll
      for (int i = 0; i < 4; ++i) { vn[i] = __builtin_nontemporal_load((const f32x4*)(xrn + lane * 4 + i * 256)); dn[i] = __builtin_nontemporal_load((const u32x2_t*)(DELTA + (size_t)(row + ngw) * 1024 + lane * 4 + i * 256)); } }
    { float* xw = xrow_out(p, row);
#pragma unroll
      for (int i = 0; i < 4; ++i) *(f32x4*)(xw + lane * 4 + i * 256) = v[i]; }
    const int mr = row < NL ? row / S_ : 8;
    norm_mod_row(v, p.norm_ffn_g + layer * 1024, MODl + (size_t)mr * 6144 + 3 * 1024, lane);
    store_h_row(v, H + (size_t)row * 1024, lane);
    int i0, i1; float w0, w1;
    route_row(bias, v, lds, lane, i0, i1, w0, w1);
    if (lane == 0) {
      const int lp0 = __hip_atomic_fetch_add((LAS int*)&lcnt[i0], 1, __ATOMIC_RELAXED, __HIP_MEMORY_SCOPE_WORKGROUP);
      const int lp1 = __hip_atomic_fetch_add((LAS int*)&lcnt[i1], 1, __ATOMIC_RELAXED, __HIP_MEMORY_SCOPE_WORKGROUP);
      tok_e[row * 2] = i0; tok_e[row * 2 + 1] = i1;
      tok_w[row * 2] = w0; tok_w[row * 2 + 1] = w1;
      stash[nst * 4 + 0] = i0; stash[nst * 4 + 1] = lp0; stash[nst * 4 + 2] = i1; stash[nst * 4 + 3] = lp1;
    }
    ++nst;
  }
  __syncthreads();
  if (tid < 16) { const int c = lcnt[tid]; lbase[tid] = c > 0 ? (int)atomicAdd(&cnt[tid * CNT_STRIDE], (unsigned)c) : 0; }
  __syncthreads();
  if (lane == 0) {
    int k = 0;
    for (int row = gw; row < nrows; row += ngw, ++k) {
      const int e0 = stash[k * 4 + 0], e1 = stash[k * 4 + 2];
      const int p0 = lbase[e0] + stash[k * 4 + 1], p1 = lbase[e1] + stash[k * 4 + 3];
      tok_p[row * 2] = p0; tok_p[row * 2 + 1] = p1;
      list[(size_t)e0 * NT + p0] = row; list[(size_t)e1 * NT + p1] = row;
    }
  }
}

DI void seg_scan(const Params& p, int layer, int (&tb)[NE + 1]) {
  const unsigned* cnt = (const unsigned*)(p.ws + OFF_CTRL) + CW_CNT + layer * 16 * CNT_STRIDE;
  int acc = 0;
#pragma unroll
  for (int e = 0; e < NE; ++e) { tb[e] = acc; acc += ((int)cnt[e * CNT_STRIDE] + 127) >> 7; }
  tb[NE] = acc;
}

DI void p8_combine(const Params& p, int layer, int nrows) {
  const int tid_ = opaque((int)threadIdx.x); const int lane = tid_ & 63, gw = blockIdx.x * 4 + (tid_ >> 6), ngw = gridDim.x * 4;
  const float* MODl = (const float*)(p.ws + OFF_MOD) + (size_t)layer * 9 * 6144;
  const float* MODn = (const float*)(p.ws + OFF_MOD) + (size_t)(layer + 1) * 9 * 6144;
  u16* H = (u16*)(p.ws + OFF_H);
  const u16* YSH = (const u16*)(p.ws + OFF_YSH);
  const u16* YEXP = (const u16*)(p.ws + OFF_YEXP);
  const int* tok_e = (const int*)(p.ws + OFF_TOKE); const float* tok_w = (const float*)(p.ws + OFF_TOKW); const int* tok_p = (const int*)(p.ws + OFF_TOKP);
  int tb[NE + 1]; seg_scan(p, layer, tb);
  int me0 = 0, me1 = 0, mp0 = 0, mp1 = 0; float mw0 = 0.f, mw1 = 0.f;
  u32x2_t an[4], bn[4], cn[4]; f32x4 xn[4]; float nw0 = 0.f, nw1 = 0.f;
#define P8_META(r) do { me0 = tok_e[(r) * 2]; me1 = tok_e[(r) * 2 + 1]; mp0 = tok_p[(r) * 2]; mp1 = tok_p[(r) * 2 + 1]; mw0 = tok_w[(r) * 2]; mw1 = tok_w[(r) * 2 + 1]; } while (0)
#define P8_DATA(r) do { int ps0 = 0, ps1 = 0; _Pragma("unroll") for (int e = 0; e < NE; ++e) { if (e == me0) ps0 = tb[e]; if (e == me1) ps1 = tb[e]; } \
    const size_t s0 = (size_t)ps0 * 128 + mp0, s1 = (size_t)ps1 * 128 + mp1; nw0 = mw0; nw1 = mw1; const float* xrn = xrow_out(p, (r)); \
    _Pragma("unroll") for (int i = 0; i < 4; ++i) { const int cidx = lane * 4 + i * 256; \
      an[i] = __builtin_nontemporal_load((const u32x2_t*)(YEXP + s0 * 1024 + cidx)); bn[i] = __builtin_nontemporal_load((const u32x2_t*)(YEXP + s1 * 1024 + cidx)); \
      cn[i] = __builtin_nontemporal_load((const u32x2_t*)(YSH + (size_t)(r) * 1024 + cidx)); xn[i] = __builtin_nontemporal_load((const f32x4*)(xrn + cidx)); } } while (0)
  if (gw < nrows) { P8_META(gw); P8_DATA(gw); }
  if (gw + ngw < nrows) P8_META(gw + ngw);
  for (int row = gw; row < nrows; row += ngw) {
    u32x2_t a[4], b[4], c[4]; f32x4 v[4];
#pragma unroll
    for (int i = 0; i < 4; ++i) { a[i] = an[i]; b[i] = bn[i]; c[i] = cn[i]; v[i] = xn[i]; }
    const float w0 = nw0, w1 = nw1;
    if (row + ngw < nrows) P8_DATA(row + ngw);
    if (row + 2 * ngw < nrows) P8_META(row + 2 * ngw);
    float* xr = xrow_out(p, row);
    const int mr = row < NL ? row / S_ : 8;
    const float* gate = MODl + (size_t)mr * 6144 + 5 * 1024;
#pragma unroll
    for (int i = 0; i < 4; ++i) {
      const int cidx = lane * 4 + i * 256;
      const f32x4 g = *(const f32x4*)(gate + cidx);
      f32x4 x = v[i];
      x.x += g.x * (w0 * bflo(a[i][0]) + w1 * bflo(b[i][0]) + bflo(c[i][0]));
      x.y += g.y * (w0 * bfhi(a[i][0]) + w1 * bfhi(b[i][0]) + bfhi(c[i][0]));
      x.z += g.z * (w0 * bflo(a[i][1]) + w1 * bflo(b[i][1]) + bflo(c[i][1]));
      x.w += g.w * (w0 * bfhi(a[i][1]) + w1 * bfhi(b[i][1]) + bfhi(c[i][1]));
      v[i] = x;
    }
    if (layer == 0) {
#pragma unroll
      for (int i = 0; i < 4; ++i) __builtin_nontemporal_store(v[i], (f32x4*)(xr + lane * 4 + i * 256));
      norm_mod_row(v, p.norm_mix_g + 1024, MODn + (size_t)mr * 6144, lane);
      store_h_row(v, H + (size_t)row * 1024, lane);
    } else {
      float ss = 0.f;
#pragma unroll
      for (int i = 0; i < 4; ++i) ss += v[i].x * v[i].x + v[i].y * v[i].y + v[i].z * v[i].z + v[i].w * v[i].w;
      ss = wave_sum(ss);
      const float rstd = rsqrtf(ss * (1.f / 1024.f) + EPS);
#pragma unroll
      for (int i = 0; i < 4; ++i) {
        const f32x4 gg = *(const f32x4*)(p.final_norm_g + lane * 4 + i * 256);
        __builtin_nontemporal_store(v[i] * rstd * gg, (f32x4*)(xr + lane * 4 + i * 256));
      }
    }
  }
#undef P8_META
#undef P8_DATA
}

DI void glds16(const u16* g, LAS char* l) {
  __builtin_amdgcn_global_load_lds((const void*)g, (LAS void*)l, 16, 0, 0);
}
struct TilePtrs { const u16 *a0, *a1, *b0, *b1; };
#define GT_ISSUE_P(T, kt, s) do { const int _ko = (kt) * 64; LAS char* _d = ldst + (s) * 32768; \
    glds16((T).a0 + _ko, _d); glds16((T).a1 + _ko, _d + 4096); glds16((T).a0 + _ko + 32, _d + 8192); glds16((T).a1 + _ko + 32, _d + 12288); \
    glds16((T).b0 + _ko, _d + 16384); glds16((T).b1 + _ko, _d + 20480); glds16((T).b0 + _ko + 32, _d + 24576); glds16((T).b1 + _ko + 32, _d + 28672); } while (0)
template <bool HOIST = true>
DI void gemm_tile_s(LAS char* lds, const TilePtrs& cur, bool issued, const TilePtrs& nxt, bool has_next, int nk, f32x4 (&acc)[4][4]) {
  const int tid = opaque((int)threadIdx.x), lane = tid & 63, wid = tid >> 6, wr = wid >> 1, wc = wid & 1, fr = lane & 15, fq = lane >> 4;
  const int cx = (fq ^ ((0 - (fr >> 2)) & 3)) * 16;
  const int aoff = (wr * 64 + fr) * 64 + cx;
  const int boff = 16384 + (wc * 64 + fr) * 64 + cx;
#pragma unroll
  for (int m = 0; m < 4; ++m)
#pragma unroll
    for (int n = 0; n < 4; ++n) acc[m][n] = (f32x4){0.f, 0.f, 0.f, 0.f};
  LAS char* ldst = lds + tid * 16;
  if (!issued) GT_ISSUE_P(cur, 0, 0);
#pragma unroll 1
  for (int kt = 0; kt < nk; ++kt) {
    asm volatile("s_waitcnt vmcnt(0)" ::: "memory");
    __syncthreads();
    if (kt + 1 < nk) GT_ISSUE_P(cur, kt + 1, (kt + 1) & 1);
    else if (has_next) GT_ISSUE_P(nxt, 0, 0);
    const LAS char* sb = lds + (kt & 1) * 32768;
    if (!HOIST) {
#pragma unroll
      for (int h = 0; h < 2; ++h) {
        bf16x8 af1[4], bf1[4];
#pragma unroll
        for (int m = 0; m < 4; ++m) af1[m] = *(const LAS bf16x8*)(sb + h * 8192 + aoff + m * 1024);
#pragma unroll
        for (int n = 0; n < 4; ++n) bf1[n] = *(const LAS bf16x8*)(sb + h * 8192 + boff + n * 1024);
#pragma unroll
        for (int m = 0; m < 4; ++m)
#pragma unroll
          for (int n = 0; n < 4; ++n) acc[m][n] = __builtin_amdgcn_mfma_f32_16x16x32_bf16(bf1[n], af1[m], acc[m][n], 0, 0, 0);
      }
      continue;
    }
    bf16x8 af[2][4], bfr[2][4];
    const unsigned aad = (unsigned)(size_t)(sb + aoff), bad = (unsigned)(size_t)(sb + boff);
#define GT_LDR(dst, ad, off) asm volatile("ds_read_b128 %0, %1 offset:%c2" : "=v"(dst) : "v"(ad), "i"(off))
    GT_LDR(af[0][0], aad, 0); GT_LDR(af[0][1], aad, 1024); GT_LDR(af[0][2], aad, 2048); GT_LDR(af[0][3], aad, 3072);
    GT_LDR(bfr[0][0], bad, 0); GT_LDR(bfr[0][1], bad, 1024); GT_LDR(bfr[0][2], bad, 2048); GT_LDR(bfr[0][3], bad, 3072);
    GT_LDR(af[1][0], aad, 8192); GT_LDR(af[1][1], aad, 8192 + 1024); GT_LDR(af[1][2], aad, 8192 + 2048); GT_LDR(af[1][3], aad, 8192 + 3072);
    GT_LDR(bfr[1][0], bad, 8192); GT_LDR(bfr[1][1], bad, 8192 + 1024); GT_LDR(bfr[1][2], bad, 8192 + 2048); GT_LDR(bfr[1][3], bad, 8192 + 3072);
#undef GT_LDR
    asm volatile("s_waitcnt lgkmcnt(8)" : "+v"(af[0][0]), "+v"(af[0][1]), "+v"(af[0][2]), "+v"(af[0][3]), "+v"(bfr[0][0]), "+v"(bfr[0][1]), "+v"(bfr[0][2]), "+v"(bfr[0][3]) :: "memory");
    __builtin_amdgcn_sched_barrier(0);
#pragma unroll
    for (int m = 0; m < 4; ++m)
#pragma unroll
      for (int n = 0; n < 4; ++n) acc[m][n] = __builtin_amdgcn_mfma_f32_16x16x32_bf16(bfr[0][n], af[0][m], acc[m][n], 0, 0, 0);
    __builtin_amdgcn_sched_barrier(0);
    asm volatile("s_waitcnt lgkmcnt(0)" : "+v"(af[1][0]), "+v"(af[1][1]), "+v"(af[1][2]), "+v"(af[1][3]), "+v"(bfr[1][0]), "+v"(bfr[1][1]), "+v"(bfr[1][2]), "+v"(bfr[1][3]) :: "memory");
    __builtin_amdgcn_sched_barrier(0);
#pragma unroll
    for (int m = 0; m < 4; ++m)
#pragma unroll
      for (int n = 0; n < 4; ++n) acc[m][n] = __builtin_amdgcn_mfma_f32_16x16x32_bf16(bfr[1][n], af[1][m], acc[m][n], 0, 0, 0);
    __builtin_amdgcn_sched_barrier(0);
  }
}
DI void gemm_tile(LAS char* lds, const u16* a0, const u16* a1, const u16* b0, const u16* b1, int nk, f32x4 (&acc)[4][4]) {
  TilePtrs t; t.a0 = a0; t.a1 = a1; t.b0 = b0; t.b1 = b1;
  gemm_tile_s<false>(lds, t, false, t, false, nk, acc);
  __syncthreads();
}
DI int gt_chunk(int tid) { return (((tid & 3) ^ ((0 - ((tid >> 4) & 3)) & 3))) * 8; }
DI int gt_row0(int tid) { return tid >> 2; }

DI void sincos_rev(float pos, float invf, float& sn, float& cs) {
  float rev = pos * invf * 0.15915494309189535f;
  rev -= rintf(rev);
  sn = __builtin_amdgcn_sinf(rev); cs = __builtin_amdgcn_cosf(rev);
}
DI void st_bf4(u16* dst, const f32x4& v) { uint2 o; o.x = cvtpk(v[0], v[1]); o.y = cvtpk(v[2], v[3]); *(uint2*)dst = o; }


DI void stage_put4(LAS char* st, int row, int c8, const f32x4& v) {
  u32x2_t o; o[0] = cvtpk(v[0], v[1]); o[1] = cvtpk(v[2], v[3]);
  *(LAS u32x2_t*)(st + row * 128 + ((c8 ^ (row & 15)) * 8)) = o;
}
DI u32x4_t stage_get16(const LAS char* st, int row, int u) {
  u32x4_t v = *(const LAS u32x4_t*)(st + row * 128 + ((u ^ ((row >> 1) & 7)) * 16));
  if (row & 1) v = __builtin_shufflevector(v, v, 2, 3, 0, 1);
  return v;
}
template <int NC>
DI void stage_flush(const LAS char* st, u16* dst, size_t ld, int lane) {
  constexpr int UPR = NC / 8;
  constexpr int RPI = 64 / UPR;
#pragma unroll
  for (int i = 0; i < 64 / RPI; ++i) {
    const int row = i * RPI + lane / UPR, u = lane % UPR;
    const u32x4_t v = stage_get16(st, row, u);
    *(u32x4_t*)(dst + (size_t)row * ld + u * 8) = v;
  }
}

DI void epi_inproj(const Params& p, int layer, f32x4 (&acc)[4][4], int m0, int seg, int wr, int fr, int fq, LAS float* rowss_slot, LAS char* stg, int lane) {
  char* ws = p.ws;
  const bool lat = m0 < NL;
  const int rbase = m0 + wr * 64 + fr;
  u16* dst; int ld, cb; int kind;
  if (seg < 6) { dst = (u16*)(ws + OFF_SWQ); ld = 384; cb = seg * 64; kind = 1; }
  else if (seg < 8) { dst = (u16*)(ws + OFF_SWK); ld = 128; cb = (seg - 6) * 64; kind = 1; }
  else if (seg < 10) { dst = (u16*)(ws + OFF_SWV); ld = 128; cb = (seg - 8) * 64; kind = 0; }
  else if (seg < 16) { dst = (u16*)(ws + OFF_GLQ); ld = 384; cb = (seg - 10) * 64; kind = 2; }
  else if (seg < 18) { dst = (u16*)(ws + OFF_GLK); ld = 128; cb = (seg - 16) * 64; kind = 3; }
  else if (seg < 20) { dst = (u16*)(ws + OFF_GLV); ld = 128; cb = (seg - 18) * 64; kind = 0; }
  else if (seg < 24) { dst = (u16*)(ws + OFF_QLAT); ld = 256; cb = (seg - 20) * 64; kind = 4; }
  else if (seg < 26) { dst = (u16*)(ws + OFF_KVLAT); ld = 128; cb = (seg - 24) * 64; kind = 5; }
  else if (seg == 26) { dst = (u16*)(ws + OFF_MLKR); ld = 32; cb = 0; kind = 6; }
  else return;
  if (kind == 2 || kind == 3) {
    const float* gain = (kind == 2 ? p.glb_q_gain : p.glb_k_gain) + layer * 64;
    f32x4 gv[4];
#pragma unroll
    for (int n = 0; n < 4; ++n) gv[n] = *(const f32x4*)(gain + n * 16 + fq * 4);
#pragma unroll
    for (int m = 0; m < 4; ++m) {
      float ss = 0.f;
#pragma unroll
      for (int n = 0; n < 4; ++n) ss += acc[m][n][0] * acc[m][n][0] + acc[m][n][1] * acc[m][n][1] + acc[m][n][2] * acc[m][n][2] + acc[m][n][3] * acc[m][n][3];
      ss += __shfl_xor(ss, 16); ss += __shfl_xor(ss, 32);
      const float r = rsqrtf(ss * (1.f / 64.f) + EPS);
#pragma unroll
      for (int n = 0; n < 4; ++n) acc[m][n] = acc[m][n] * r * gv[n];
    }
  }
  if (kind == 4 || kind == 5) {
    const float* gain = (kind == 4 ? p.mla_q_gain + layer * 256 : p.mla_kv_gain + layer * 128) + cb;
    f32x4 gv[4];
#pragma unroll
    for (int n = 0; n < 4; ++n) gv[n] = *(const f32x4*)(gain + n * 16 + fq * 4);
#pragma unroll
    for (int m = 0; m < 4; ++m) {
      float ss = 0.f;
#pragma unroll
      for (int n = 0; n < 4; ++n) ss += acc[m][n][0] * acc[m][n][0] + acc[m][n][1] * acc[m][n][1] + acc[m][n][2] * acc[m][n][2] + acc[m][n][3] * acc[m][n][3];
      ss += __shfl_xor(ss, 16); ss += __shfl_xor(ss, 32);
      if (fq == 0) rowss_slot[wr * 64 + m * 16 + fr] = ss;
#pragma unroll
      for (int n = 0; n < 4; ++n) acc[m][n] = acc[m][n] * gv[n];
    }
  }
  if (lat && (kind == 1 || kind == 2 || kind == 3)) {
    float invf[4];
#pragma unroll
    for (int j = 0; j < 4; ++j) invf[j] = __builtin_amdgcn_exp2f(-(float)(fq * 4 + j) * (13.287712379549449f / 16.f));
#pragma unroll
    for (int m = 0; m < 4; ++m) {
      const int t = (rbase + m * 16) & (S_ - 1);
      const float prow = (float)(t >> 6), pcol = (float)(t & 63);
#pragma unroll
      for (int j = 0; j < 4; ++j) {
        float sr, cr, sc, cc;
        sincos_rev(prow, invf[j], sr, cr); sincos_rev(pcol, invf[j], sc, cc);
        float x1 = acc[m][0][j], x2 = acc[m][1][j];
        acc[m][0][j] = x1 * cr - x2 * sr; acc[m][1][j] = x2 * cr + x1 * sr;
        x1 = acc[m][2][j]; x2 = acc[m][3][j];
        acc[m][2][j] = x1 * cc - x2 * sc; acc[m][3][j] = x2 * cc + x1 * sc;
      }
    }
  }
  if (kind == 6) {
    if (lat) {
      float invf[4];
#pragma unroll
      for (int j = 0; j < 4; ++j) invf[j] = __builtin_amdgcn_exp2f(-(float)((fq & 1) * 4 + j) * (13.287712379549449f / 8.f));
#pragma unroll
      for (int m = 0; m < 4; ++m) {
        const int t = (rbase + m * 16) & (S_ - 1);
#pragma unroll
        for (int n = 0; n < 2; ++n) {
          const float pos = n == 0 ? (float)(t >> 6) : (float)(t & 63);
#pragma unroll
          for (int j = 0; j < 4; ++j) {
            float sn, cs; sincos_rev(pos, invf[j], sn, cs);
            const float v = acc[m][n][j], pr = __shfl_xor(v, 32);
            acc[m][n][j] = (fq & 2) ? v * cs + pr * sn : v * cs - pr * sn;
          }
        }
      }
    }
#pragma unroll
    for (int m = 0; m < 4; ++m)
#pragma unroll
      for (int n = 0; n < 2; ++n) stage_put4(stg, m * 16 + fr, n * 4 + fq, acc[m][n]);
    stage_flush<32>(stg, dst + (size_t)(m0 + wr * 64) * ld, ld, lane);
    return;
  }
#pragma unroll
  for (int m = 0; m < 4; ++m)
#pragma unroll
    for (int n = 0; n < 4; ++n) stage_put4(stg, m * 16 + fr, n * 4 + fq, acc[m][n]);
  stage_flush<64>(stg, dst + (size_t)(m0 + wr * 64) * ld + cb, ld, lane);
}

DI void p2_inproj(const Params& p, int layer, LAS char* lds, int cs = 0) {
  char* ws = p.ws;
  unsigned* ctr = (unsigned*)(ws + OFF_CTRL) + CW_CTR + layer * 16 + 2 + cs;
  const u16* H = (const u16*)(ws + OFF_H);
  const u16* WinT = (const u16*)(ws + OFF_WIN) + (size_t)layer * INWP * 1024;
  const u16* WuqT = (const u16*)(ws + OFF_WUQ) + (size_t)layer * 384 * 256;
  const u16* WukvT = (const u16*)(ws + OFF_WUKV) + (size_t)layer * 512 * 128;
  const int tid = opaque((int)threadIdx.x), lane = tid & 63, wid = tid >> 6, wr = wid >> 1, wc = wid & 1;
  LAS float* rowss = (LAS float*)(lds + LDS_MISC);
  LAS float* rstd = (LAS float*)(lds + LDS_MISC + 2048);
  unsigned* ctr8 = (unsigned*)(ws + OFF_CTRL) + CW_Q + (layer * 2 + 1) * 512;
  f32x4 acc[4][4];
  for (;;) {
    const int u = next_unit_xcd(ctr8, (NT / 128 / 8) * 12, lds);
    if (u < 0) break;
    const int tid_o = opaque(tid), lane_o = tid_o & 63;
    const int fr = lane_o & 15, fq = lane_o >> 4, ch = gt_chunk(tid_o), r0 = gt_row0(tid_o);
    const int qx = u / 408, v = u % 408;
    int rt, k;
    if (v < 34) { rt = qx * 34 + v; k = 10; } else if (v < 68) { rt = qx * 34 + v - 34; k = 11; } else { rt = qx * 34 + (v - 68) / 10; k = (v - 68) % 10; }
    const int m0 = rt * 128;
    const u16* a0 = H + (size_t)(m0 + r0) * 1024 + ch;
    const u16* a1 = a0 + (size_t)64 * 1024;
    if (k < 10) {
      const u16* b0 = WinT + (size_t)(k * 128 + r0) * 1024 + ch;
      gemm_tile(lds, a0, a1, b0, b0 + (size_t)64 * 1024, 16, acc);
      epi_inproj(p, layer, acc, m0, k * 2 + wc, wr, fr, fq, rowss, lds + 32768 + wid * 8192, lane_o);
    } else if (k == 10) {
#pragma unroll 1
      for (int t = 0; t < 2; ++t) {
        const u16* b0 = WinT + (size_t)(1280 + t * 128 + r0) * 1024 + ch;
        gemm_tile(lds, a0, a1, b0, b0 + (size_t)64 * 1024, 16, acc);
        epi_inproj(p, layer, acc, m0, 20 + t * 2 + wc, wr, fr, fq, rowss + (t * 2 + wc) * 128, lds + 32768 + wid * 8192, lane_o);
      }
      __syncthreads();
      if (tid < 128) rstd[tid] = rsqrtf((rowss[tid] + rowss[128 + tid] + rowss[256 + tid] + rowss[384 + tid]) * (1.f / 256.f) + EPS);
      __syncthreads();
      const u16* QL = (const u16*)(ws + OFF_QLAT);
      const u16* qa0 = QL + (size_t)(m0 + r0) * 256 + ch;
      const u16* qa1 = qa0 + (size_t)64 * 256;
      u16* MLQ = (u16*)(ws + OFF_MLQ);
      const bool lat = m0 < NL;
#pragma unroll 1
      for (int t = 0; t < 3; ++t) {
        const u16* b0 = WuqT + (size_t)(t * 128 + r0) * 256 + ch;
        gemm_tile(lds, qa0, qa1, b0, b0 + (size_t)64 * 256, 4, acc);
        const int c0 = t * 128 + wc * 64;
        float invf[4];
#pragma unroll
        for (int j = 0; j < 4; ++j) invf[j] = __builtin_amdgcn_exp2f(-(float)((fq & 1) * 4 + j) * (13.287712379549449f / 8.f));
#pragma unroll
        for (int m = 0; m < 4; ++m) {
          const int rl = wr * 64 + m * 16 + fr;
          const float rs = rstd[rl];
          const int tpos = (m0 + rl) & (S_ - 1);
#pragma unroll
          for (int n = 0; n < 4; ++n) {
            acc[m][n] = acc[m][n] * rs;
            const int w96 = (c0 + n * 16) % 96;
            if (lat && w96 >= 64) {
              const float pos = (w96 == 64) ? (float)(tpos >> 6) : (float)(tpos & 63);
#pragma unroll
              for (int j = 0; j < 4; ++j) {
                float sn, cs; sincos_rev(pos, invf[j], sn, cs);
                const float v = acc[m][n][j], pr = __shfl_xor(v, 32);
                acc[m][n][j] = (fq & 2) ? v * cs + pr * sn : v * cs - pr * sn;
              }
            }
            stage_put4(lds + 32768 + wid * 8192, m * 16 + fr, n * 4 + fq, acc[m][n]);
          }
        }
        stage_flush<64>(lds + 32768 + wid * 8192, MLQ + (size_t)(m0 + wr * 64) * 384 + c0, 384, lane_o);
      }
    } else {
      {
        const u16* b0 = WinT + (size_t)(1536 + r0) * 1024 + ch;
        gemm_tile(lds, a0, a1, b0, b0 + (size_t)64 * 1024, 16, acc);
        epi_inproj(p, layer, acc, m0, 24 + wc, wr, fr, fq, rowss + wc * 128, lds + 32768 + wid * 8192, lane_o);
        const u16* b2 = WinT + (size_t)(1664 + r0) * 1024 + ch;
        gemm_tile(lds, a0, a1, b2, b2 + (size_t)64 * 1024, 16, acc);
        epi_inproj(p, layer, acc, m0, 26 + wc, wr, fr, fq, rowss, lds + 32768 + wid * 8192, lane_o);
      }
      __syncthreads();
      if (tid < 128) rstd[tid] = rsqrtf((rowss[tid] + rowss[128 + tid]) * (1.f / 128.f) + EPS);
      __syncthreads();
      const u16* KL = (const u16*)(ws + OFF_KVLAT);
      const u16* ka0 = KL + (size_t)(m0 + r0) * 128 + ch;
      const u16* ka1 = ka0 + (size_t)64 * 128;
#pragma unroll 1
      for (int t = 0; t < 4; ++t) {
        const u16* b0 = WukvT + (size_t)(t * 128 + r0) * 128 + ch;
        gemm_tile(lds, ka0, ka1, b0, b0 + (size_t)64 * 128, 2, acc);
        u16* dst = (u16*)(ws + (wc == 0 ? OFF_MLK : OFF_MLV));
#pragma unroll
        for (int m = 0; m < 4; ++m) {
          const int rl = wr * 64 + m * 16 + fr;
          const float rs = rstd[rl];
#pragma unroll
          for (int n = 0; n < 4; ++n) { acc[m][n] = acc[m][n] * rs; stage_put4(lds + 32768 + wid * 8192, m * 16 + fr, n * 4 + fq, acc[m][n]); }
        }
        stage_flush<64>(lds + 32768 + wid * 8192, dst + (size_t)(m0 + wr * 64) * 256 + t * 64, 256, lane_o);
      }
    }
  }
}

DI void p4_outproj(const Params& p, int layer, int nrows, LAS char* lds, int cs = 0) {
  char* ws = p.ws;
  const u16* Y = (const u16*)(ws + OFF_Y);
  const u16* WoT = (const u16*)(ws + OFF_WO) + (size_t)layer * 1024 * 1024;
  const float* MODl = (const float*)(ws + OFF_MOD) + (size_t)layer * 9 * 6144;
  const int tid = opaque((int)threadIdx.x), wid = tid >> 6, wr = wid >> 1, wc = wid & 1;
  const int nunits = (nrows / 128) * 8;
  f32x4 acc[4][4];
  __syncthreads();
  TilePtrs cur, nxt;
  int u = (int)((blockIdx.x & 7) * (gridDim.x >> 3) + (blockIdx.x >> 3));
#define P4_DESC(T, uu) do { const int _t = opaque(tid); const int _ch = gt_chunk(_t), _r0 = gt_row0(_t); const int _rt = (uu) >> 3, _ct = (uu) & 7; \
    (T).a0 = Y + (size_t)(_rt * 128 + _r0) * 1024 + _ch; (T).a1 = (T).a0 + (size_t)64 * 1024; \
    (T).b0 = WoT + (size_t)(_ct * 128 + _r0) * 1024 + _ch; (T).b1 = (T).b0 + (size_t)64 * 1024; } while (0)
  bool issued = false;
  if (u < nunits) P4_DESC(cur, u);
  while (u < nunits) {
    const int un = u + gridDim.x;
    const bool hn = un < nunits;
    if (hn) P4_DESC(nxt, un); else nxt = cur;
    gemm_tile_s(lds, cur, issued, nxt, hn, 16, acc);
    issued = hn;
    const int tid_o = opaque(tid), lane_o = tid_o & 63;
    const int fr = lane_o & 15, fq = lane_o >> 4;
    const int rt = u >> 3, ct = u & 7, m0 = rt * 128;
    const int mr = m0 < NL ? m0 / S_ : 8;
    const float* gate = MODl + (size_t)mr * 6144 + 2 * 1024 + ct * 128 + wc * 64 + fq * 4;
    __syncthreads();
    LAS char* stg = lds + 32768 + wid * 8192;
#pragma unroll
    for (int n = 0; n < 4; ++n) {
      const f32x4 g = *(const f32x4*)(gate + n * 16);
#pragma unroll
      for (int m = 0; m < 4; ++m) stage_put4(stg, m * 16 + fr, n * 4 + fq, g * acc[m][n]);
    }
    stage_flush<64>(stg, (u16*)(ws + OFF_DELTA) + (size_t)(m0 + wr * 64) * 1024 + ct * 128 + wc * 64, 1024, lane_o);
    cur = nxt; u = un;
  }
#undef P4_DESC
  __syncthreads();
}

DI void p6_gateup(const Params& p, int layer, int nrows, LAS char* lds, int cs = 0) {
  char* ws = p.ws;
  const unsigned* cnt = (const unsigned*)(ws + OFF_CTRL) + CW_CNT + layer * 16 * CNT_STRIDE;
  const u16* H = (const u16*)(ws + OFF_H);
  const int* list = (const int*)(ws + OFF_LIST);
  const u16* WguT = (const u16*)(ws + OFF_WGU) + (size_t)layer * NE * 1024 * 1024;
  const u16* SguT = (const u16*)(ws + OFF_SGU) + (size_t)layer * 1024 * 1024;
  u16* ACT = (u16*)(ws + OFF_ACT); u16* ACTS = (u16*)(ws + OFF_ACTS);
  const int tid = opaque((int)threadIdx.x), wid = tid >> 6, wr = wid >> 1, wc = wid & 1;
  int tb[NE + 1]; seg_scan(p, layer, tb);
  const int R = tb[NE];
  const int nunits = (R + nrows / 128) * 8;
  f32x4 acc[4][4];
  __syncthreads();
  TilePtrs cur, nxt;
#define P6_DESC(T, uu) do { const int _t = opaque(tid); const int _ch = gt_chunk(_t), _r0 = gt_row0(_t); const int _rt = (uu) >> 3, _ct = (uu) & 7; \
    if (_rt < R) { int _e = 0, _tbe = 0; _Pragma("unroll") for (int q = 1; q < NE; ++q) if (_rt >= tb[q]) { _e = q; _tbe = tb[q]; } \
      const int _i = _rt - _tbe, _ce = (int)cnt[_e * CNT_STRIDE]; const int _i0 = _i * 128 + _r0, _i1 = _i0 + 64; \
      const int _t0 = _i0 < _ce ? list[(size_t)_e * NT + _i0] : 0, _t1 = _i1 < _ce ? list[(size_t)_e * NT + _i1] : 0; \
      (T).a0 = H + (size_t)_t0 * 1024 + _ch; (T).a1 = H + (size_t)_t1 * 1024 + _ch; \
      (T).b0 = WguT + ((size_t)_e * 1024 + _ct * 128 + _r0) * 1024 + _ch; } \
    else { const int _m0 = (_rt - R) * 128; (T).a0 = H + (size_t)(_m0 + _r0) * 1024 + _ch; (T).a1 = (T).a0 + (size_t)64 * 1024; \
      (T).b0 = SguT + (size_t)(_ct * 128 + _r0) * 1024 + _ch; } \
    (T).b1 = (T).b0 + (size_t)64 * 1024; } while (0)
  int u = (int)((blockIdx.x & 7) * (gridDim.x >> 3) + (blockIdx.x >> 3));
  bool issued = false;
  if (u < nunits) P6_DESC(cur, u);
  while (u < nunits) {
    const int un = u + gridDim.x;
    const bool hn = un < nunits;
    if (hn) P6_DESC(nxt, un); else nxt = cur;
    gemm_tile_s(lds, cur, issued, nxt, hn, 16, acc);
    issued = hn;
    const int tid_o = opaque(tid), lane_o = tid_o & 63;
    const int fr = lane_o & 15, fq = lane_o >> 4;
    const int rt = u >> 3, ct = u & 7;
    u16* dst; size_t orow;
    if (rt < R) { dst = ACT; orow = (size_t)rt * 128; } else { dst = ACTS; orow = (size_t)(rt - R) * 128; }
    __syncthreads();
    LAS char* stg = lds + 32768 + wid * 8192;
#pragma unroll
    for (int m = 0; m < 4; ++m)
#pragma unroll
      for (int n = 0; n < 2; ++n) {
        f32x4 r;
#pragma unroll
        for (int j = 0; j < 4; ++j) r[j] = silu(acc[m][n][j]) * acc[m][n + 2][j];
        stage_put4(stg, m * 16 + fr, n * 4 + fq, r);
      }
    stage_flush<32>(stg, dst + (orow + wr * 64) * 512 + ct * 64 + wc * 32, 512, lane_o);
    cur = nxt; u = un;
  }
#undef P6_DESC
  __syncthreads();
}

DI void p7_down(const Params& p, int layer, int nrows, LAS char* lds, int cs = 0) {
  char* ws = p.ws;
  const u16* WdT = (const u16*)(ws + OFF_WD) + (size_t)layer * NE * 1024 * 512;
  const u16* SdT = (const u16*)(ws + OFF_SD) + (size_t)layer * 1024 * 512;
  const u16* ACT = (const u16*)(ws + OFF_ACT); const u16* ACTS = (const u16*)(ws + OFF_ACTS);
  u16* YEXP = (u16*)(ws + OFF_YEXP); u16* YSH = (u16*)(ws + OFF_YSH);
  const int tid = opaque((int)threadIdx.x), wid = tid >> 6, wr = wid >> 1, wc = wid & 1;
  int tb[NE + 1]; seg_scan(p, layer, tb);
  const int R = tb[NE];
  const int nunits = (R + nrows / 128) * 8;
  f32x4 acc[4][4];
  __syncthreads();
  TilePtrs cur, nxt;
#define P7_DESC(T, uu) do { const int _t = opaque(tid); const int _ch = gt_chunk(_t), _r0 = gt_row0(_t); const int _rt = (uu) >> 3, _ct = (uu) & 7; \
    if (_rt < R) { int _e = 0; _Pragma("unroll") for (int q = 1; q < NE; ++q) if (_rt >= tb[q]) _e = q; \
      (T).a0 = ACT + ((size_t)_rt * 128 + _r0) * 512 + _ch; (T).b0 = WdT + ((size_t)_e * 1024 + _ct * 128 + _r0) * 512 + _ch; } \
    else { const int _m0 = (_rt - R) * 128; (T).a0 = ACTS + (size_t)(_m0 + _r0) * 512 + _ch; (T).b0 = SdT + (size_t)(_ct * 128 + _r0) * 512 + _ch; } \
    (T).a1 = (T).a0 + (size_t)64 * 512; (T).b1 = (T).b0 + (size_t)64 * 512; } while (0)
  int u = (int)((blockIdx.x & 7) * (gridDim.x >> 3) + (blockIdx.x >> 3));
  bool issued = false;
  if (u < nunits) P7_DESC(cur, u);
  while (u < nunits) {
    const int un = u + gridDim.x;
    const bool hn = un < nunits;
    if (hn) P7_DESC(nxt, un); else nxt = cur;
    gemm_tile_s(lds, cur, issued, nxt, hn, 8, acc);
    issued = hn;
    const int tid_o = opaque(tid), lane_o = tid_o & 63;
    const int fr = lane_o & 15, fq = lane_o >> 4;
    const int rt = u >> 3, ct = u & 7;
    u16* dst; size_t orow;
    if (rt < R) { dst = YEXP; orow = (size_t)rt * 128; } else { dst = YSH; orow = (size_t)(rt - R) * 128; }
    __syncthreads();
    LAS char* stg = lds + 32768 + wid * 8192;
#pragma unroll
    for (int m = 0; m < 4; ++m)
#pragma unroll
      for (int n = 0; n < 4; ++n) stage_put4(stg, m * 16 + fr, n * 4 + fq, acc[m][n]);
    stage_flush<64>(stg, dst + (orow + wr * 64) * 1024 + ct * 128 + wc * 64, 1024, lane_o);
    cur = nxt; u = un;
  }
#undef P7_DESC
  __syncthreads();
}

typedef float f32x16 __attribute__((ext_vector_type(16)));
typedef short s16x4 __attribute__((ext_vector_type(4)));
DI s16x4 tr_read(const LAS char* a) { return __builtin_bit_cast(s16x4, __builtin_amdgcn_ds_read_tr16_b64_v4i16((LAS s16x4*)a)); }
DI float half_max(float m) { auto rr = __builtin_amdgcn_permlane32_swap(__float_as_uint(m), __float_as_uint(m), false, false); return fmaxf(__uint_as_float(rr[0]), __uint_as_float(rr[1])); }
DI float half_sum(float m) { auto rr = __builtin_amdgcn_permlane32_swap(__float_as_uint(m), __float_as_uint(m), false, false); return __uint_as_float(rr[0]) + __uint_as_float(rr[1]); }
DI bf16x8 pack8(const f32x16& x, int s8) {
  typedef unsigned u32x4 __attribute__((ext_vector_type(4)));
  u32x4 r;
  r[0] = cvtpk(x[s8 + 0], x[s8 + 1]); r[1] = cvtpk(x[s8 + 2], x[s8 + 3]); r[2] = cvtpk(x[s8 + 4], x[s8 + 5]); r[3] = cvtpk(x[s8 + 6], x[s8 + 7]);
  return __builtin_bit_cast(bf16x8, r);
}
constexpr int AT_STAGE = 20480;

DI float max3f(float a, float b, float c) { float r; asm("v_max3_f32 %0, %1, %2, %3" : "=v"(r) : "v"(a), "v"(b), "v"(c)); return r; }
template <bool MLA, bool SWA>
DI void attn_unit(const Params& p, int layer, int isctx, int b, int h, int qb, LAS char* lds) {
  char* ws = p.ws;
  const int tid = opaque((int)threadIdx.x), lane = tid & 63, wid = tid >> 6, r32 = lane & 31, hi = lane >> 5;
  const u16 *Qg, *Kg, *Vg; int ldq, ldk, qoff, koff, ycol; float cs;
  if (MLA) { Qg = (const u16*)(ws + OFF_MLQ); Kg = (const u16*)(ws + OFF_MLK); Vg = (const u16*)(ws + OFF_MLV); ldq = 384; ldk = 256; qoff = h * 96; koff = h * 64; ycol = 768 + h * 64; cs = 0.10206207261596575f * 1.4426950408889634f; }
  else if (!SWA) { Qg = (const u16*)(ws + OFF_GLQ); Kg = (const u16*)(ws + OFF_GLK); Vg = (const u16*)(ws + OFF_GLV); ldq = 384; ldk = 128; qoff = h * 64; koff = (h / 3) * 64; ycol = 384 + h * 64; cs = 0.125f * 1.4426950408889634f; }
  else { Qg = (const u16*)(ws + OFF_SWQ); Kg = (const u16*)(ws + OFF_SWK); Vg = (const u16*)(ws + OFF_SWV); ldq = 384; ldk = 128; qoff = h * 64; koff = (h / 3) * 64; ycol = h * 64; cs = 0.125f * 1.4426950408889634f; }
  const u16* Rg = (const u16*)(ws + OFF_MLKR);
  const int q0 = qb * 128;
  const int qrow0 = (isctx ? NL + b * C_ : b * S_) + q0;
  const int qw = q0 + wid * 32;
  int lat_first = 0, nlat = 0;
  if (!isctx) { if (SWA) { lat_first = 2 * qb - 2; if (lat_first < 0) lat_first = 0; int lat_last = 2 * qb + 3; if (lat_last > 63) lat_last = 63; nlat = lat_last - lat_first + 1; } else nlat = 64; }
  const int T = 4 + nlat;
  constexpr int NQ = MLA ? 6 : 4;
  bf16x8 qf[NQ];
  {
    const u16* qp = Qg + (size_t)(qrow0 + wid * 32 + r32) * ldq + qoff + hi * 8;
#pragma unroll
    for (int d0 = 0; d0 < NQ; ++d0) {
      const u32x4_t raw = *(const u32x4_t*)(qp + d0 * 16);
      u32x4_t sc;
#pragma unroll
      for (int i = 0; i < 4; ++i) sc[i] = cvtpk(bflo(raw[i]) * cs, bfhi(raw[i]) * cs);
      qf[d0] = __builtin_bit_cast(bf16x8, sc);
    }
  }
  int kaddr[4];
#pragma unroll
  for (int d0 = 0; d0 < 4; ++d0) kaddr[d0] = r32 * 128 + (((d0 * 2 + hi) ^ ((r32 >> 1) & 7)) * 16);
  int kraddr[2];
#pragma unroll
  for (int e = 0; e < 2; ++e) kraddr[e] = 16384 + r32 * 64 + (((e * 2 + hi) ^ ((r32 >> 3) & 3)) * 16);
  int vbo[2];
  {
    const int i16 = lane & 15, sw = (lane >> 3) & 1;
    const int x = ((lane >> 4) & 1) * 32 + (lane & 3) * 8;
    const int rowpart = ((i16 >> 2) + 4 * hi) * 128;
    vbo[0] = 8192 + rowpart + x + (sw * 64);
    vbo[1] = 8192 + rowpart + x + ((1 - sw) * 64);
  }
  const int skey = tid >> 3;
  const int kch = ((tid & 7) ^ ((tid >> 4) & 7)) * 8;
  const int vch = ((tid & 7) ^ (((tid >> 4) & 1) << 2)) * 8;
  const int rkey = tid >> 2, rch = ((tid & 3) ^ ((tid >> 5) & 3)) * 8;
  LAS char* ldst = lds + tid * 16;
#define AT_ISSUE(j, st) do { const int _j = (j); const int _kr = _j < 4 ? NL + b * C_ + 64 * _j : b * S_ + 64 * (lat_first + _j - 4); \
    LAS char* _d = ldst + (st) * AT_STAGE; \
    const u16* _k = Kg + (size_t)(_kr + skey) * ldk + koff + kch; glds16(_k, _d); glds16(_k + (size_t)32 * ldk, _d + 4096); \
    const u16* _v = Vg + (size_t)(_kr + skey) * ldk + koff + vch; glds16(_v, _d + 8192); glds16(_v + (size_t)32 * ldk, _d + 8192 + 4096); \
    if (MLA) glds16(Rg + (size_t)(_kr + rkey) * 32 + rch, _d + 16384); } while (0)
#define AT_QK(sb, P0, P1) do { \
    bf16x8 kk0[MLA ? 6 : 4], kk1[MLA ? 6 : 4]; \
    _Pragma("unroll") for (int d0 = 0; d0 < 4; ++d0) { kk0[d0] = *(const LAS bf16x8*)((sb) + kaddr[d0]); kk1[d0] = *(const LAS bf16x8*)((sb) + kaddr[d0] + 4096); } \
    if (MLA) { _Pragma("unroll") for (int e = 0; e < 2; ++e) { kk0[MLA ? 4 + e : 0] = *(const LAS bf16x8*)((sb) + kraddr[e]); kk1[MLA ? 4 + e : 0] = *(const LAS bf16x8*)((sb) + kraddr[e] + 2048); } } \
    __builtin_amdgcn_sched_barrier(0);     \
    P0 = __builtin_amdgcn_mfma_f32_32x32x16_bf16(kk0[0], qf[0], negm, 0, 0, 0); P1 = __builtin_amdgcn_mfma_f32_32x32x16_bf16(kk1[0], qf[0], negm, 0, 0, 0); \
    _Pragma("unroll") for (int d0 = 1; d0 < (MLA ? 6 : 4); ++d0) { \
      P0 = __builtin_amdgcn_mfma_f32_32x32x16_bf16(kk0[d0], qf[d0], P0, 0, 0, 0); P1 = __builtin_amdgcn_mfma_f32_32x32x16_bf16(kk1[d0], qf[d0], P1, 0, 0, 0); } \
  } while (0)
#define AT_WSTATE(jj, pos0v, st) do { st = 0; pos0v = 64 * (lat_first + (jj) - 4); if (SWA && (jj) >= 4) { \
      if (pos0v + 63 < qw - 128 || pos0v > qw + 31 + 128) st = 2; else if (qw + 31 - pos0v > 128 || pos0v + 63 - qw > 128) st = 1; } } while (0)
#define AT_SOFTMAX(P0, P1, PA, wst, pos0v, FIRST) do { \
    if (SWA && wst == 1) { const int dq = qw + r32 - pos0v - 4 * hi + 128; \
      _Pragma("unroll") for (int r = 0; r < 16; ++r) { const int cr = (r & 3) + 8 * (r >> 2); \
        if ((unsigned)(dq - cr) > 256u) P0[r] = -1e30f; if ((unsigned)(dq - cr - 32) > 256u) P1[r] = -1e30f; } } \
    asm volatile("s_nop 15\n\ts_nop 15" : "+v"(P0), "+v"(P1));     \
    float mx = max3f(P0[0], P0[1], P1[0]); mx = max3f(mx, P1[1], P0[2]); \
    _Pragma("unroll") for (int r = 3; r < 16; r += 2) { mx = max3f(mx, P0[r], P0[(r + 1) & 15]); } \
    _Pragma("unroll") for (int r = 2; r < 16; r += 2) { mx = max3f(mx, P1[r], P1[r + 1]); } \
    mx = half_max(mx); \
    if ((FIRST) || __ballot(mx > 8.0f) != 0ull) { \
      const float delta = (FIRST) ? mx : fmaxf(mx, 0.f); \
      const float al = __builtin_amdgcn_exp2f(-delta); \
      m_run += delta; \
      _Pragma("unroll") for (int i = 0; i < 16; ++i) { o[0][i] *= al; o[1][i] *= al; P0[i] -= delta; P1[i] -= delta; negm[i] = -m_run; } \
      osum[0] *= al; \
    } \
    _Pragma("unroll") for (int r = 0; r < 16; ++r) { P0[r] = __builtin_amdgcn_exp2f(P0[r]); P1[r] = __builtin_amdgcn_exp2f(P1[r]); } \
    PA[0] = pack8(P0, 0); PA[1] = pack8(P0, 8); PA[2] = pack8(P1, 0); PA[3] = pack8(P1, 8); \
  } while (0)
#define AT_PV(sb, PA) do { \
    bf16x8 vf[2][4]; \
    _Pragma("unroll") for (int db = 0; db < 2; ++db) { _Pragma("unroll") for (int ts = 0; ts < 4; ++ts) { \
      const LAS char* va = (sb) + vbo[db] + ts * 2048; const s16x4 lo = tr_read(va), hh = tr_read(va + 1024); \
      vf[db][ts] = __builtin_shufflevector(lo, hh, 0, 1, 2, 3, 4, 5, 6, 7); } } \
    __builtin_amdgcn_sched_barrier(0);     \
    _Pragma("unroll") for (int ts = 0; ts < 4; ++ts) osum = __builtin_amdgcn_mfma_f32_32x32x16_bf16(ones, PA[ts], osum, 0, 0, 0); \
    _Pragma("unroll") for (int db = 0; db < 2; ++db) { _Pragma("unroll") for (int ts = 0; ts < 4; ++ts) \
      o[db] = __builtin_amdgcn_mfma_f32_32x32x16_bf16(vf[db][ts], PA[ts], o[db], 0, 0, 0); } } while (0)

  float m_run = SWA ? p.swa_sink[layer * 6 + h] * 1.4426950408889634f : 0.f;
  f32x16 o[2], osum, negm;
#pragma unroll
  for (int i = 0; i < 16; ++i) { o[0][i] = 0.f; o[1][i] = 0.f; osum[i] = SWA ? 1.f : 0.f; negm[i] = -m_run; }
  bf16x8 ones;
#pragma unroll
  for (int i = 0; i < 8; ++i) ones[i] = (short)0x3F80;
  bf16x8 pa[4];
  f32x16 s0, s1;
  AT_ISSUE(0, 0);
  asm volatile("s_waitcnt vmcnt(0)" ::: "memory");
  __syncthreads();
  AT_ISSUE(1, 1);
  AT_QK(lds, s0, s1);
  { int wst = 0, pos0v = 0; AT_SOFTMAX(s0, s1, pa, wst, pos0v, !SWA); }
  bool cur_skip = false;
#pragma unroll 1
  for (int j = 0; j < T - 1; ++j) {
    asm volatile("s_waitcnt vmcnt(0)" ::: "memory");
    __syncthreads();
    const int st_cur = j % 3, st_nxt = (j + 1) % 3;
    if (j + 2 < T) AT_ISSUE(j + 2, (j + 2) % 3);
    const LAS char* sbn = lds + st_nxt * AT_STAGE;
    const LAS char* sbc = lds + st_cur * AT_STAGE;
    int wst, pos0v; AT_WSTATE(j + 1, pos0v, wst);
    if (!SWA || wst != 2) AT_QK(sbn, s0, s1);
    if (!SWA || !cur_skip) AT_PV(sbc, pa);
    if (!SWA || wst != 2) {
      bf16x8 pn[4];
      AT_SOFTMAX(s0, s1, pn, wst, pos0v, false);
      pa[0] = pn[0]; pa[1] = pn[1]; pa[2] = pn[2]; pa[3] = pn[3];
      cur_skip = false;
    } else cur_skip = true;
  }
  if (!SWA || !cur_skip) { const LAS char* sbc = lds + ((T - 1) % 3) * AT_STAGE; AT_PV(sbc, pa); }
#undef AT_ISSUE
#undef AT_QK
#undef AT_WSTATE
#undef AT_SOFTMAX
#undef AT_PV
  const float inv = 1.f / osum[0];
  u16* yp = (u16*)(ws + OFF_Y) + (size_t)(qrow0 + wid * 32 + r32) * 1024 + ycol + 4 * hi;
#pragma unroll
  for (int db = 0; db < 2; ++db)
#pragma unroll
    for (int g = 0; g < 4; ++g) {
      uint2 w; w.x = cvtpk(o[db][4 * g] * inv, o[db][4 * g + 1] * inv); w.y = cvtpk(o[db][4 * g + 2] * inv, o[db][4 * g + 3] * inv);
      *(uint2*)(yp + db * 32 + 8 * g) = w;
    }
  __syncthreads();
}


typedef float f32x4v __attribute__((ext_vector_type(4)));
#define MFMA16(a, b, c) __builtin_amdgcn_mfma_f32_16x16x32_bf16((a), (b), (c), 0, 0, 0)
DI float quad_max_x(float m) {
  { auto rr = __builtin_amdgcn_permlane16_swap(__float_as_uint(m), __float_as_uint(m), false, false); m = fmaxf(__uint_as_float(rr[0]), __uint_as_float(rr[1])); }
  { auto rr = __builtin_amdgcn_permlane32_swap(__float_as_uint(m), __float_as_uint(m), false, false); m = fmaxf(__uint_as_float(rr[0]), __uint_as_float(rr[1])); }
  return m;
}
template <bool MLA, bool SWA>
DI void attn_unit16(const Params& p, int layer, int isctx, int b, int h, int qb, LAS char* lds) {
  char* ws = p.ws;
  const int tid = opaque((int)threadIdx.x), lane = tid & 63, wid = tid >> 6, c16 = lane & 15, g = lane >> 4;
  const u16 *Qg, *Kg, *Vg; int ldq, ldk, qoff, koff, ycol; float cs;
  if (MLA) { Qg = (const u16*)(ws + OFF_MLQ); Kg = (const u16*)(ws + OFF_MLK); Vg = (const u16*)(ws + OFF_MLV); ldq = 384; ldk = 256; qoff = h * 96; koff = h * 64; ycol = 768 + h * 64; cs = 0.10206207261596575f * 1.4426950408889634f; }
  else if (!SWA) { Qg = (const u16*)(ws + OFF_GLQ); Kg = (const u16*)(ws + OFF_GLK); Vg = (const u16*)(ws + OFF_GLV); ldq = 384; ldk = 128; qoff = h * 64; koff = (h / 3) * 64; ycol = 384 + h * 64; cs = 0.125f * 1.4426950408889634f; }
  else { Qg = (const u16*)(ws + OFF_SWQ); Kg = (const u16*)(ws + OFF_SWK); Vg = (const u16*)(ws + OFF_SWV); ldq = 384; ldk = 128; qoff = h * 64; koff = (h / 3) * 64; ycol = h * 64; cs = 0.125f * 1.4426950408889634f; }
  const u16* Rg = (const u16*)(ws + OFF_MLKR);
  const int q0 = qb * 128;
  const int qrow0 = (isctx ? NL + b * C_ : b * S_) + q0;
  const int qw = q0 + wid * 32;
  int lat_first = 0, nlat = 0;
  if (!isctx) { if (SWA) { lat_first = 2 * qb - 2; if (lat_first < 0) lat_first = 0; int lat_last = 2 * qb + 3; if (lat_last > 63) lat_last = 63; nlat = lat_last - lat_first + 1; } else nlat = 64; }
  const int T = 4 + nlat;
  constexpr int NS = MLA ? 3 : 2;
  bf16x8 qf[2][NS];
#pragma unroll
  for (int bq = 0; bq < 2; ++bq) {
    const u16* qp = Qg + (size_t)(qrow0 + wid * 32 + bq * 16 + c16) * ldq + qoff + g * 8;
#pragma unroll
    for (int s = 0; s < NS; ++s) {
      const u32x4_t raw = *(const u32x4_t*)(qp + s * 32);
      u32x4_t sc;
#pragma unroll
      for (int i = 0; i < 4; ++i) sc[i] = cvtpk(bflo(raw[i]) * cs, bfhi(raw[i]) * cs);
      qf[bq][s] = __builtin_bit_cast(bf16x8, sc);
    }
  }
  int kaddr[2];
#pragma unroll
  for (int s = 0; s < 2; ++s) kaddr[s] = c16 * 128 + (((4 * s + g) ^ ((c16 >> 1) & 7)) * 16);
  const int kraddr = 16384 + c16 * 64 + ((g ^ ((0 - (c16 >> 2)) & 3)) * 16);
  int vbo[4];
#pragma unroll
  for (int d = 0; d < 4; ++d) vbo[d] = 8192 + (4 * g + (c16 >> 2)) * 128 + ((d ^ ((lane >> 3) & 3)) * 32) + (lane & 3) * 8;
  const int skey = tid >> 3;
  const int kch = ((tid & 7) ^ ((tid >> 4) & 7)) * 8;
  const int vch = ((tid & 7) ^ (((tid >> 4) & 3) << 1)) * 8;
  const int rkey = tid >> 2, rch = ((tid & 3) ^ ((0 - (tid >> 4)) & 3)) * 8;
  LAS char* ldst = lds + tid * 16;
#define A6_ISSUE(j, st) do { const int _j = (j); const int _kr = _j < 4 ? NL + b * C_ + 64 * _j : b * S_ + 64 * (lat_first + _j - 4); \
    LAS char* _d = ldst + (st) * AT_STAGE; \
    const u16* _k = Kg + (size_t)(_kr + skey) * ldk + koff + kch; glds16(_k, _d); glds16(_k + (size_t)32 * ldk, _d + 4096); \
    const u16* _v = Vg + (size_t)(_kr + skey) * ldk + koff + vch; glds16(_v, _d + 8192); glds16(_v + (size_t)32 * ldk, _d + 8192 + 4096); \
    if (MLA) glds16(Rg + (size_t)(_kr + rkey) * 32 + rch, _d + 16384); } while (0)
#define A6_QK(sb) do { \
    bf16x8 kk[4][NS]; \
    _Pragma("unroll") for (int a = 0; a < 4; ++a) { kk[a][0] = *(const LAS bf16x8*)((sb) + kaddr[0] + a * 2048); kk[a][1] = *(const LAS bf16x8*)((sb) + kaddr[1] + a * 2048); \
      if (MLA) kk[a][MLA ? 2 : 0] = *(const LAS bf16x8*)((sb) + kraddr + a * 1024); } \
    __builtin_amdgcn_sched_barrier(0); \
    _Pragma("unroll") for (int a = 0; a < 4; ++a) { _Pragma("unroll") for (int bq = 0; bq < 2; ++bq) { \
      S[a][bq] = MFMA16(kk[a][0], qf[bq][0], negm[bq]); \
      _Pragma("unroll") for (int s = 1; s < NS; ++s) S[a][bq] = MFMA16(kk[a][s], qf[bq][s], S[a][bq]); } } \
  } while (0)
#define A6_WSTATE(jj, pos0v, st) do { st = 0; pos0v = 64 * (lat_first + (jj) - 4); if (SWA && (jj) >= 4) { \
      if (pos0v + 63 < qw - 128 || pos0v > qw + 31 + 128) st = 2; else if (qw + 31 - pos0v > 128 || pos0v + 63 - qw > 128) st = 1; } } while (0)
#define A6_SOFTMAX(PA, wst, pos0v, FIRST, CHECK) do { \
    if (SWA && wst == 1) { _Pragma("unroll") for (int bq = 0; bq < 2; ++bq) { const int dq = qw + 16 * bq + c16 - pos0v - 4 * g + 128; \
      _Pragma("unroll") for (int a = 0; a < 4; ++a) { _Pragma("unroll") for (int r = 0; r < 4; ++r) { if ((unsigned)(dq - (16 * a + r)) > 256u) S[a][bq][r] = -1e30f; } } } } \
    float mx[2] = {0.f, 0.f}; \
    if (CHECK) { \
    asm volatile("s_nop 15\n\ts_nop 15" : "+v"(S[0][0]), "+v"(S[0][1]), "+v"(S[1][0]), "+v"(S[1][1]), "+v"(S[2][0]), "+v"(S[2][1]), "+v"(S[3][0]), "+v"(S[3][1])); \
    _Pragma("unroll") for (int bq = 0; bq < 2; ++bq) { \
      float m_ = max3f(S[0][bq][0], S[0][bq][1], S[0][bq][2]); m_ = max3f(m_, S[0][bq][3], S[1][bq][0]); \
      m_ = max3f(m_, S[1][bq][1], S[1][bq][2]); m_ = max3f(m_, S[1][bq][3], S[2][bq][0]); m_ = max3f(m_, S[2][bq][1], S[2][bq][2]); \
      m_ = max3f(m_, S[2][bq][3], S[3][bq][0]); m_ = max3f(m_, S[3][bq][1], S[3][bq][2]); m_ = fmaxf(m_, S[3][bq][3]); \
      mx[bq] = quad_max_x(m_); } } \
    if ((FIRST) || ((CHECK) && __ballot(fmaxf(mx[0], mx[1]) > 8.0f) != 0ull)) { \
      _Pragma("unroll") for (int bq = 0; bq < 2; ++bq) { \
        const float delta = (FIRST) ? mx[bq] : fmaxf(mx[bq], 0.f); \
        const float al = __builtin_amdgcn_exp2f(-delta); \
        m_run[bq] += delta; \
        _Pragma("unroll") for (int a = 0; a < 4; ++a) { S[a][bq] = S[a][bq] - delta; o[a][bq] = o[a][bq] * al; } \
        negm[bq] = (f32x4v){-m_run[bq], -m_run[bq], -m_run[bq], -m_run[bq]}; \
        osum[bq] = osum[bq] * al; } \
    } \
    _Pragma("unroll") for (int a = 0; a < 4; ++a) { _Pragma("unroll") for (int bq = 0; bq < 2; ++bq) { _Pragma("unroll") for (int r = 0; r < 4; ++r) S[a][bq][r] = __builtin_amdgcn_exp2f(S[a][bq][r]); } } \
    _Pragma("unroll") for (int ks = 0; ks < 2; ++ks) { _Pragma("unroll") for (int bq = 0; bq < 2; ++bq) { u32x4_t w_; \
      w_[0] = cvtpk(S[2 * ks][bq][0], S[2 * ks][bq][1]); w_[1] = cvtpk(S[2 * ks][bq][2], S[2 * ks][bq][3]); \
      w_[2] = cvtpk(S[2 * ks + 1][bq][0], S[2 * ks + 1][bq][1]); w_[3] = cvtpk(S[2 * ks + 1][bq][2], S[2 * ks + 1][bq][3]); \
      PA[ks][bq] = __builtin_bit_cast(bf16x8, w_); } } \
  } while (0)
#define A6_PV(sb, PA) do { \
    bf16x8 vf[2][4]; \
    _Pragma("unroll") for (int ks = 0; ks < 2; ++ks) { _Pragma("unroll") for (int d = 0; d < 4; ++d) { \
      const LAS char* va = (sb) + vbo[d] + ks * 4096; const s16x4 lo = tr_read(va), hh = tr_read(va + 2048); \
      vf[ks][d] = __builtin_shufflevector(lo, hh, 0, 1, 2, 3, 4, 5, 6, 7); } } \
    __builtin_amdgcn_sched_barrier(0); \
    _Pragma("unroll") for (int ks = 0; ks < 2; ++ks) { _Pragma("unroll") for (int bq = 0; bq < 2; ++bq) osum[bq] = MFMA16(ones, PA[ks][bq], osum[bq]); } \
    _Pragma("unroll") for (int d = 0; d < 4; ++d) { _Pragma("unroll") for (int bq = 0; bq < 2; ++bq) { _Pragma("unroll") for (int ks = 0; ks < 2; ++ks) \
      o[d][bq] = MFMA16(vf[ks][d], PA[ks][bq], o[d][bq]); } } } while (0)

  float m_run[2];
  m_run[0] = m_run[1] = SWA ? p.swa_sink[layer * 6 + h] * 1.4426950408889634f : 0.f;
  f32x4v S[4][2], o[4][2], osum[2], negm[2];
#pragma unroll
  for (int bq = 0; bq < 2; ++bq) {
    const float i1 = SWA ? 1.f : 0.f;
    osum[bq] = (f32x4v){i1, i1, i1, i1}; negm[bq] = (f32x4v){-m_run[bq], -m_run[bq], -m_run[bq], -m_run[bq]};
#pragma unroll
    for (int d = 0; d < 4; ++d) o[d][bq] = (f32x4v){0.f, 0.f, 0.f, 0.f};
  }
  bf16x8 ones;
#pragma unroll
  for (int i = 0; i < 8; ++i) ones[i] = (short)0x3F80;
  bf16x8 pa[2][2];
  A6_ISSUE(0, 0);
  asm volatile("s_waitcnt vmcnt(0)" ::: "memory");
  __syncthreads();
  A6_ISSUE(1, 1);
  A6_QK(lds);
  { int wst = 0, pos0v = 0; A6_SOFTMAX(pa, wst, pos0v, !SWA, true); }
  bool cur_skip = false;
#pragma unroll 1
  for (int j = 0; j < T - 1; ++j) {
    asm volatile("s_waitcnt vmcnt(0)" ::: "memory");
    __syncthreads();
    if (j + 2 < T) A6_ISSUE(j + 2, (j + 2) % 3);
    const LAS char* sbn = lds + ((j + 1) % 3) * AT_STAGE;
    const LAS char* sbc = lds + (j % 3) * AT_STAGE;
    int wst, pos0v; A6_WSTATE(j + 1, pos0v, wst);
    if (!SWA || wst != 2) A6_QK(sbn);
    if (!SWA || !cur_skip) A6_PV(sbc, pa);
    if (!SWA || wst != 2) {
      bf16x8 pn[2][2];
      A6_SOFTMAX(pn, wst, pos0v, false, (SWA || (j & 7) == 7));
      pa[0][0] = pn[0][0]; pa[0][1] = pn[0][1]; pa[1][0] = pn[1][0]; pa[1][1] = pn[1][1];
      cur_skip = false;
    } else cur_skip = true;
  }
  if (!SWA || !cur_skip) { const LAS char* sbc = lds + ((T - 1) % 3) * AT_STAGE; A6_PV(sbc, pa); }
#undef A6_ISSUE
#undef A6_QK
#undef A6_WSTATE
#undef A6_SOFTMAX
#undef A6_PV
#pragma unroll
  for (int bq = 0; bq < 2; ++bq) {
    const float inv = 1.f / osum[bq][0];
    u16* yp = (u16*)(ws + OFF_Y) + (size_t)(qrow0 + wid * 32 + bq * 16 + c16) * 1024 + ycol + 4 * g;
#pragma unroll
    for (int d = 0; d < 4; ++d) {
      u32x2_t w; w[0] = cvtpk(o[d][bq][0] * inv, o[d][bq][1] * inv); w[1] = cvtpk(o[d][bq][2] * inv, o[d][bq][3] * inv);
      *(u32x2_t*)(yp + d * 16) = w;
    }
  }
  __syncthreads();
}

DI void p3_attention(const Params& p, int layer, LAS char* lds, int cs = 0) {
  unsigned* ctr8 = (unsigned*)(p.ws + OFF_CTRL) + CW_Q + (layer * 2 + 0) * 512;
  const int per_q = 512 + (layer == 0 ? 32 : 0);
  for (;;) {
    const int u = next_unit_xcd(ctr8, per_q, lds);
    if (u < 0) break;
    const int b = u / per_q, v = u % per_q;
    if (v < 128) { attn_unit16<true, false>(p, layer, 0, b, v >> 5, v & 31, lds); }
    else if (v < 320) { const int w = v - 128; attn_unit16<false, false>(p, layer, 0, b, w >> 5, w & 31, lds); }
    else if (v < 512) { const int w = v - 320; attn_unit16<false, true>(p, layer, 0, b, w >> 5, w & 31, lds); }
    else {
      const int w = v - 512;
      if (w < 8) attn_unit16<true, false>(p, layer, 1, b, w >> 1, w & 1, lds);
      else if (w < 20) { const int x = w - 8; attn_unit16<false, false>(p, layer, 1, b, x >> 1, x & 1, lds); }
      else { const int x = w - 20; attn_unit16<false, true>(p, layer, 1, b, x >> 1, x & 1, lds); }
    }
  }
}

struct AttnArgs {
  const u16* Q; const u16* K; const u16* K2; const u16* V; u16* Y; const float* sink;
  int ldq, ldk, ldk2, ldv, ldy, ycol, G, window, q_is_ctx; float scale;
};
static_assert(sizeof(AttnArgs) == 88, "no padding");
template <int DK1, int DK2>
__global__ __launch_bounds__(64) void k_attn(AttnArgs a) {
  const int qt = blockIdx.x * 64 + threadIdx.x, b = blockIdx.y, h = blockIdx.z, kvh = h / a.G;
  const int qrow = a.q_is_ctx ? NL + b * C_ + qt : b * S_ + qt;
  float q[DK1 + DK2];
  {
    const uint4* qp = (const uint4*)(a.Q + (size_t)qrow * a.ldq + h * (DK1 + DK2));
#pragma unroll
    for (int i = 0; i < (DK1 + DK2) / 8; ++i) {
      uint4 u = qp[i];
      q[i * 8 + 0] = bflo(u.x) * a.scale; q[i * 8 + 1] = bfhi(u.x) * a.scale; q[i * 8 + 2] = bflo(u.y) * a.scale; q[i * 8 + 3] = bfhi(u.y) * a.scale;
      q[i * 8 + 4] = bflo(u.z) * a.scale; q[i * 8 + 5] = bfhi(u.z) * a.scale; q[i * 8 + 6] = bflo(u.w) * a.scale; q[i * 8 + 7] = bfhi(u.w) * a.scale;
    }
  }
  float m, l, o[64];
  if (a.sink) { m = a.sink[h]; l = 1.f; } else { m = -1e30f; l = 0.f; }
#pragma unroll
  for (int d = 0; d < 64; ++d) o[d] = 0.f;
  const int nseg = a.q_is_ctx ? 1 : 2;
  for (int seg = 0; seg < nseg; ++seg) {
    int lo, hi, rbase; bool masked = false;
    if (seg == 0) { lo = 0; hi = C_; rbase = NL + b * C_; }
    else {
      lo = 0; hi = S_; rbase = b * S_;
      if (a.window) { int t0 = blockIdx.x * 64; lo = t0 - a.window; if (lo < 0) lo = 0; hi = t0 + 64 + a.window; if (hi > S_) hi = S_; masked = true; }
    }
    for (int s = lo; s < hi; s += 4) {
      float sc[4];
#pragma unroll
      for (int i = 0; i < 4; ++i) {
        const uint4* kp = (const uint4*)(a.K + (size_t)(rbase + s + i) * a.ldk + kvh * DK1);
        float dot = 0.f;
#pragma unroll
        for (int c = 0; c < DK1 / 8; ++c) {
          uint4 u = kp[c];
          dot += q[c * 8 + 0] * bflo(u.x) + q[c * 8 + 1] * bfhi(u.x) + q[c * 8 + 2] * bflo(u.y) + q[c * 8 + 3] * bfhi(u.y)
               + q[c * 8 + 4] * bflo(u.z) + q[c * 8 + 5] * bfhi(u.z) + q[c * 8 + 6] * bflo(u.w) + q[c * 8 + 7] * bfhi(u.w);
        }
        if (DK2 > 0) {
          const uint4* kp2 = (const uint4*)(a.K2 + (size_t)(rbase + s + i) * a.ldk2);
#pragma unroll
          for (int c = 0; c < DK2 / 8; ++c) {
            uint4 u = kp2[c];
            dot += q[DK1 + c * 8 + 0] * bflo(u.x) + q[DK1 + c * 8 + 1] * bfhi(u.x) + q[DK1 + c * 8 + 2] * bflo(u.y) + q[DK1 + c * 8 + 3] * bfhi(u.y)
                 + q[DK1 + c * 8 + 4] * bflo(u.z) + q[DK1 + c * 8 + 5] * bfhi(u.z) + q[DK1 + c * 8 + 6] * bflo(u.w) + q[DK1 + c * 8 + 7] * bfhi(u.w);
          }
        }
        if (masked) { int dlt = qt - (s + i); if (dlt < 0) dlt = -dlt; if (dlt > a.window) dot = -1e30f; }
        sc[i] = dot;
      }
      float mx = fmaxf(fmaxf(fmaxf(sc[0], sc[1]), fmaxf(sc[2], sc[3])), m);
      const float alpha = __expf(m - mx);
      float pr[4];
#pragma unroll
      for (int i = 0; i < 4; ++i) pr[i] = __expf(sc[i] - mx);
      l = l * alpha + (pr[0] + pr[1]) + (pr[2] + pr[3]);
      m = mx;
#pragma unroll
      for (int d = 0; d < 64; ++d) o[d] *= alpha;
#pragma unroll
      for (int i = 0; i < 4; ++i) {
        const uint4* vp = (const uint4*)(a.V + (size_t)(rbase + s + i) * a.ldv + kvh * 64);
#pragma unroll
        for (int c = 0; c < 8; ++c) {
          uint4 u = vp[c];
          o[c * 8 + 0] += pr[i] * bflo(u.x); o[c * 8 + 1] += pr[i] * bfhi(u.x); o[c * 8 + 2] += pr[i] * bflo(u.y); o[c * 8 + 3] += pr[i] * bfhi(u.y);
          o[c * 8 + 4] += pr[i] * bflo(u.z); o[c * 8 + 5] += pr[i] * bfhi(u.z); o[c * 8 + 6] += pr[i] * bflo(u.w); o[c * 8 + 7] += pr[i] * bfhi(u.w);
        }
      }
    }
  }
  const float inv = 1.f / l;
  uint4* yp = (uint4*)(a.Y + (size_t)qrow * a.ldy + a.ycol + h * 64);
#pragma unroll
  for (int c = 0; c < 8; ++c) {
    uint4 u;
    u.x = cvtpk(o[c * 8 + 0] * inv, o[c * 8 + 1] * inv); u.y = cvtpk(o[c * 8 + 2] * inv, o[c * 8 + 3] * inv);
    u.z = cvtpk(o[c * 8 + 4] * inv, o[c * 8 + 5] * inv); u.w = cvtpk(o[c * 8 + 6] * inv, o[c * 8 + 7] * inv);
    yp[c] = u;
  }
}


constexpr int CW_BAR = 1024;
#define XB_TMO      128
#define XB_XCNT(j)  (256  + 64 * (j))
#define XB_XSUB(j)  (1280 + 64 * (j))
#define XB_XGEN(j)  (2304 + 64 * (j))
#define XB_TOP      3328
#define XB_TOPGEN   3392
#define XCD_BAR_WORDS 3456
#define XB_SPIN_CAP (1u << 22)
DI unsigned xb_ld(unsigned* p) { return __hip_atomic_load(p, __ATOMIC_RELAXED, __HIP_MEMORY_SCOPE_AGENT); }
DI unsigned xb_add(unsigned* p, unsigned v) { return __hip_atomic_fetch_add(p, v, __ATOMIC_RELAXED, __HIP_MEMORY_SCOPE_AGENT); }
DI unsigned xb_xcc_id() { return (unsigned)__builtin_amdgcn_s_getreg((3 << 11) | 20) & 0xFu; }
#define XB_SPIN(cond, bar) do { unsigned _sp = 0; while (cond) { __builtin_amdgcn_s_sleep(1); \
    if ((++_sp & 255u) == 0u) { if (xb_ld(&(bar)[XB_TMO])) break; if (_sp > XB_SPIN_CAP) { atomicAdd(&(bar)[XB_TMO], 1u); break; } } } } while (0)
struct XcdBarrier { unsigned* bar; unsigned x; volatile LAS unsigned* st; };
DI XcdBarrier xcd_barrier_post(unsigned* bar, volatile LAS unsigned* st) {
  XcdBarrier b; b.bar = bar; b.x = xb_xcc_id(); b.st = st;
  if (threadIdx.x == 0) (void)xb_add(&bar[XB_XCNT(b.x)], 1u);
  return b;
}
DI void xcd_barrier_complete(unsigned* bar, unsigned x, unsigned& nloc, unsigned& nx) {
  const unsigned G = gridDim.x * gridDim.y * gridDim.z;
  unsigned sum, cnt, mine, sp = 0u;
  for (;;) {
    sum = 0u; cnt = 0u; mine = 0u;
#pragma unroll
    for (unsigned j = 0; j < 16; ++j) { const unsigned c = xb_ld(&bar[XB_XCNT(j)]); sum += c; cnt += (c > 0u) ? 1u : 0u; mine = (j == x) ? c : mine; }
    if (sum == G) break;
    __builtin_amdgcn_s_sleep(1);
    if ((++sp & 255u) == 0u) { if (xb_ld(&bar[XB_TMO])) break; if (sp > XB_SPIN_CAP) { atomicAdd(&bar[XB_TMO], 1u); break; } }
  }
  nloc = mine > 0u ? mine : 1u; nx = cnt > 0u ? cnt : 1u;
}
DI void xcd_barrier(const XcdBarrier& b) {
  asm volatile("s_waitcnt vmcnt(0)" ::: "memory");
  __syncthreads();
  if (threadIdx.x == 0) {
    unsigned* bar = b.bar;
    __builtin_amdgcn_s_waitcnt(0);
    unsigned nloc = b.st[0], nx = b.st[1];
    if (nloc == 0u) { xcd_barrier_complete(bar, b.x, nloc, nx); b.st[0] = nloc; b.st[1] = nx; }
    const unsigned old = xb_add(&bar[XB_XSUB(b.x)], 1u);
    const unsigned gen = old / nloc;
    if (old + 1u == (gen + 1u) * nloc) {
      __builtin_amdgcn_fence(__ATOMIC_RELEASE, "agent");
      asm volatile("s_waitcnt vmcnt(0)" ::: "memory");
      const unsigned og = xb_add(&bar[XB_TOP], 1u);
      const unsigned tg = og / nx;
      if (og + 1u == (tg + 1u) * nx) xb_add(&bar[XB_TOPGEN], 1u);
      else XB_SPIN(xb_ld(&bar[XB_TOPGEN]) == tg, bar);
      __builtin_amdgcn_fence(__ATOMIC_ACQUIRE, "agent");
      xb_add(&bar[XB_XGEN(b.x)], 1u);
      asm volatile("s_waitcnt vmcnt(0)" ::: "memory");
    } else {
      XB_SPIN(xb_ld(&bar[XB_XGEN(b.x)]) == gen, bar);
      __builtin_amdgcn_fence(__ATOMIC_ACQUIRE, "agent");
      asm volatile("s_waitcnt vmcnt(0)" ::: "memory");
    }
  }
  __syncthreads();
}

__global__ __launch_bounds__(NTHR, 2) void k_mega(Params p) {
  extern __shared__ __attribute__((aligned(16))) unsigned char smem[];
  LAS char* lds = (LAS char*)smem;
  if (p.never) cooperative_groups::this_grid().sync();
  volatile LAS unsigned* st = (volatile LAS unsigned*)(lds + LDS_MISC + 3584);
  if (threadIdx.x < 4) st[threadIdx.x] = 0u;
  __syncthreads();
  XcdBarrier bar = xcd_barrier_post((unsigned*)(p.ws + OFF_CTRL) + CW_BAR, st);
#ifdef PROBE_SEG
  unsigned long long t_acc = 0ull, t_s = 0ull;
#define SEG_BEGIN(id) do { if ((id) == PROBE_SEG && blockIdx.x == 0 && threadIdx.x == 0) t_s = __builtin_amdgcn_s_memrealtime(); } while (0)
#define SEG_END(id) do { if ((id) == PROBE_SEG && blockIdx.x == 0 && threadIdx.x == 0) t_acc += __builtin_amdgcn_s_memrealtime() - t_s; } while (0)
#else
#define SEG_BEGIN(id) do {} while (0)
#define SEG_END(id) do {} while (0)
#endif
  SEG_BEGIN(0); p0_prologue(p, lds); xcd_barrier(bar); SEG_END(0);
  SEG_BEGIN(1); p1_norm_mix(p, 0); xcd_barrier(bar); SEG_END(1);
#pragma unroll 1
  for (int l = 0; l < 2; ++l) {
    const int nrows = l == 0 ? NT : NL;
    SEG_BEGIN(2 + 10 * l); p2_inproj(p, l, lds); xcd_barrier(bar); SEG_END(2 + 10 * l);
    SEG_BEGIN(3 + 10 * l); p3_attention(p, l, lds); xcd_barrier(bar); SEG_END(3 + 10 * l);
    SEG_BEGIN(4 + 10 * l); p4_outproj(p, l, nrows, lds); xcd_barrier(bar); SEG_END(4 + 10 * l);
    SEG_BEGIN(5 + 10 * l); p5_norm_ffn(p, l, nrows, lds); xcd_barrier(bar); SEG_END(5 + 10 * l);
    SEG_BEGIN(6 + 10 * l); p6_gateup(p, l, nrows, lds); xcd_barrier(bar); SEG_END(6 + 10 * l);
    SEG_BEGIN(7 + 10 * l); p7_down(p, l, nrows, lds); xcd_barrier(bar); SEG_END(7 + 10 * l);
    SEG_BEGIN(8 + 10 * l); p8_combine(p, l, nrows); if (l == 0) xcd_barrier(bar); SEG_END(8 + 10 * l);
  }
#ifdef PROBE_SEG
  if (blockIdx.x == 0 && threadIdx.x == 0) {
    const unsigned long long t0 = __builtin_amdgcn_s_memrealtime();
    while (__builtin_amdgcn_s_memrealtime() - t0 < 9ull * t_acc) __builtin_amdgcn_s_sleep(8);
  }
#endif
}

template <int PH>
__global__ __launch_bounds__(NTHR, 2) void k_phase(Params p, int layer, int nrows) {
  extern __shared__ __attribute__((aligned(16))) unsigned char smem[];
  LAS char* lds = (LAS char*)smem;
  if (PH == 0) p0_prologue(p, lds);
  if (PH == 1) p1_norm_mix(p, layer);
  if (PH == 2) p2_inproj(p, layer, lds);
  if (PH == 3) p3_attention(p, layer, lds);
  if (PH == 4) p4_outproj(p, layer, nrows, lds);
  if (PH == 5) p5_norm_ffn(p, layer, nrows, lds);
  if (PH == 6) p6_gateup(p, layer, nrows, lds);
  if (PH == 7) p7_down(p, layer, nrows, lds);
  if (PH == 8) p8_combine(p, layer, nrows);
}

extern "C" void kernel_launch(void* const* d_in, const int* in_sizes, int n_in, void* d_out, int out_size, void* d_ws, size_t ws_size, hipStream_t stream) {
  Params p{};
  p.x = (const float*)d_in[0]; p.c = (const float*)d_in[1]; p.ctx = (const float*)d_in[2]; p.c_ctx = (const float*)d_in[3];
  p.w_mod = (const float*)d_in[4]; p.b_mod = (const float*)d_in[5]; p.norm_mix_g = (const float*)d_in[6]; p.norm_ffn_g = (const float*)d_in[7];
  p.w_in = (const float*)d_in[8]; p.w_out = (const float*)d_in[9]; p.swa_sink = (const float*)d_in[10]; p.glb_q_gain = (const float*)d_in[11];
  p.glb_k_gain = (const float*)d_in[12]; p.mla_q_gain = (const float*)d_in[13]; p.mla_w_uq = (const float*)d_in[14]; p.mla_kv_gain = (const float*)d_in[15];
  p.mla_w_ukv = (const float*)d_in[16]; p.router_w = (const float*)d_in[17]; p.router_bias = (const float*)d_in[18]; p.exp_w_gate = (const float*)d_in[19];
  p.exp_w_up = (const float*)d_in[20]; p.exp_w_down = (const float*)d_in[21]; p.shr_w_gate = (const float*)d_in[22]; p.shr_w_up = (const float*)d_in[23];
  p.shr_w_down = (const float*)d_in[24]; p.final_norm_g = (const float*)d_in[25];
  p.out = (float*)d_out; p.ws = (char*)d_ws;
  char* ws = (char*)d_ws;

#ifndef MEGA
#define MEGA 1
#endif
#if MEGA
  static int grid_blocks = 0;
  if (!grid_blocks) {
    (void)hipFuncSetAttribute((const void*)k_mega, hipFuncAttributeMaxDynamicSharedMemorySize, LDS_BYTES);
    int dev = 0, cus = 0, per_cu = 0;
    (void)hipGetDevice(&dev);
    (void)hipDeviceGetAttribute(&cus, hipDeviceAttributeMultiprocessorCount, dev);
    (void)hipOccupancyMaxActiveBlocksPerMultiprocessor(&per_cu, (const void*)k_mega, NTHR, LDS_BYTES);
    if (per_cu > 2) per_cu = 2;
    if (per_cu < 1) per_cu = 1;
    grid_blocks = cus * per_cu;
  }
  (void)hipMemsetAsync(ws + OFF_CTRL, 0, CTRL_BYTES, stream);
  void* args[] = {&p};
  hipError_t e = hipLaunchCooperativeKernel((const void*)k_mega, dim3(grid_blocks), dim3(NTHR), args, LDS_BYTES, stream);
  if (e != hipSuccess) fprintf(stderr, "cooperative launch failed: %s (grid %d)\n", hipGetErrorString(e), grid_blocks);
#else
  static bool attr_done = false;
  if (!attr_done) {
    (void)hipFuncSetAttribute((const void*)k_phase<0>, hipFuncAttributeMaxDynamicSharedMemorySize, LDS_BYTES);
    (void)hipFuncSetAttribute((const void*)k_phase<1>, hipFuncAttributeMaxDynamicSharedMemorySize, LDS_BYTES);
    (void)hipFuncSetAttribute((const void*)k_phase<2>, hipFuncAttributeMaxDynamicSharedMemorySize, LDS_BYTES);
    (void)hipFuncSetAttribute((const void*)k_phase<3>, hipFuncAttributeMaxDynamicSharedMemorySize, LDS_BYTES);
    (void)hipFuncSetAttribute((const void*)k_phase<4>, hipFuncAttributeMaxDynamicSharedMemorySize, LDS_BYTES);
    (void)hipFuncSetAttribute((const void*)k_phase<5>, hipFuncAttributeMaxDynamicSharedMemorySize, LDS_BYTES);
    (void)hipFuncSetAttribute((const void*)k_phase<6>, hipFuncAttributeMaxDynamicSharedMemorySize, LDS_BYTES);
    (void)hipFuncSetAttribute((const void*)k_phase<7>, hipFuncAttributeMaxDynamicSharedMemorySize, LDS_BYTES);
    (void)hipFuncSetAttribute((const void*)k_phase<8>, hipFuncAttributeMaxDynamicSharedMemorySize, LDS_BYTES);
    attr_done = true;
  }

  (void)hipMemsetAsync(ws + OFF_CTRL, 0, CTRL_BYTES, stream);
  k_phase<0><<<GRID, NTHR, LDS_BYTES, stream>>>(p, 0, 0);
  k_phase<1><<<GRID, NTHR, LDS_BYTES, stream>>>(p, 0, NT);
  for (int l = 0; l < 2; ++l) {
    const bool last = (l == 1);
    const int Mres = last ? NL : NT;
    k_phase<2><<<GRID, NTHR, LDS_BYTES, stream>>>(p, l, NT);
    k_phase<3><<<GRID, NTHR, LDS_BYTES, stream>>>(p, l, NT);
    k_phase<4><<<GRID, NTHR, LDS_BYTES, stream>>>(p, l, Mres);
    k_phase<5><<<GRID, NTHR, LDS_BYTES, stream>>>(p, l, Mres);
    k_phase<6><<<GRID, NTHR, LDS_BYTES, stream>>>(p, l, Mres);
    k_phase<7><<<GRID, NTHR, LDS_BYTES, stream>>>(p, l, Mres);
    k_phase<8><<<GRID, NTHR, LDS_BYTES, stream>>>(p, l, Mres);
  }
#endif
}
```

```cpp
#include <hip/hip_runtime.h>
#include <hip/hip_cooperative_groups.h>
#include <cstdio>
#include <stdint.h>
#include <stddef.h>

typedef unsigned short u16;
typedef short bf16x8 __attribute__((ext_vector_type(8)));
typedef float f32x4 __attribute__((ext_vector_type(4)));
typedef float f32x2_t __attribute__((ext_vector_type(2)));
typedef __bf16 bf16x2_t __attribute__((ext_vector_type(2)));
typedef unsigned u32x2_t __attribute__((ext_vector_type(2)));
typedef unsigned u32x4_t __attribute__((ext_vector_type(4)));
#define DI __device__ __forceinline__
#define LAS __attribute__((address_space(3)))

constexpr int B_ = 8, S_ = 4096, D_ = 1024, C_ = 256;
constexpr int NL = B_ * S_, NC = B_ * C_, NT = NL + NC;
constexpr int INW = 1696, INWP = 1792;
constexpr int NE = 16;
constexpr int MAXSLOT = NT * 2 + NE * 128;
constexpr float EPS = 1e-6f;
constexpr int NTHR = 256;
constexpr int GRID = 512;

DI float bf2f(u16 v) { return __uint_as_float(((unsigned)v) << 16); }
DI float bflo(unsigned u) { return __uint_as_float(u << 16); }
DI float bfhi(unsigned u) { return __uint_as_float(u & 0xffff0000u); }
DI unsigned cvtpk(float lo, float hi) { f32x2_t v = {lo, hi}; bf16x2_t b = __builtin_convertvector(v, bf16x2_t); return __builtin_bit_cast(unsigned, b); }
template <int CTRL> DI float dpp_mov(float v) { return __int_as_float(__builtin_amdgcn_update_dpp(0, __float_as_int(v), CTRL, 0xf, 0xf, false)); }
DI float wave_sum(float v) {
  v += dpp_mov<0xB1>(v);
  v += dpp_mov<0x4E>(v);
  v += dpp_mov<0x141>(v);
  v += dpp_mov<0x140>(v);
  { auto rr = __builtin_amdgcn_permlane16_swap(__float_as_uint(v), __float_as_uint(v), false, false); v = __uint_as_float(rr[0]) + __uint_as_float(rr[1]); }
  { auto rr = __builtin_amdgcn_permlane32_swap(__float_as_uint(v), __float_as_uint(v), false, false); v = __uint_as_float(rr[0]) + __uint_as_float(rr[1]); }
  return v;
}
DI float silu(float g) { return g / (1.f + __expf(-g)); }
DI int opaque(int v) { asm volatile("" : "+v"(v)); return v; }

constexpr size_t al256(size_t x) { return (x + 255) & ~(size_t)255; }
constexpr size_t OFF_CTRL = 0;
constexpr size_t CTRL_BYTES = 65536;
constexpr size_t OFF_CTXR = OFF_CTRL + CTRL_BYTES;
constexpr size_t OFF_MOD = OFF_CTXR + al256((size_t)NC * D_ * 4);
constexpr size_t OFF_TOKE = OFF_MOD + al256((size_t)2 * 9 * 6144 * 4);
constexpr size_t OFF_TOKW = OFF_TOKE + al256((size_t)NT * 2 * 4);
constexpr size_t OFF_TOKP = OFF_TOKW + al256((size_t)NT * 2 * 4);
constexpr size_t OFF_LIST = OFF_TOKP + al256((size_t)NT * 2 * 4);
constexpr size_t OFF_WIN = OFF_LIST + al256((size_t)NE * NT * 4);
constexpr size_t OFF_WO = OFF_WIN + (size_t)2 * INWP * 1024 * 2;
constexpr size_t OFF_WUQ = OFF_WO + (size_t)2 * 1024 * 1024 * 2;
constexpr size_t OFF_WUKV = OFF_WUQ + (size_t)2 * 384 * 256 * 2;
constexpr size_t OFF_WGU = OFF_WUKV + (size_t)2 * 512 * 128 * 2;
constexpr size_t OFF_WD = OFF_WGU + (size_t)2 * 16 * 1024 * 1024 * 2;
constexpr size_t OFF_SGU = OFF_WD + (size_t)2 * 16 * 1024 * 512 * 2;
constexpr size_t OFF_SD = OFF_SGU + (size_t)2 * 1024 * 1024 * 2;
constexpr size_t OFF_H = OFF_SD + (size_t)2 * 1024 * 512 * 2;
constexpr size_t OFF_BIG = OFF_H + (size_t)NT * 1024 * 2;
constexpr size_t OFF_SWQ = OFF_BIG;
constexpr size_t OFF_SWK = OFF_SWQ + (size_t)NT * 384 * 2;
constexpr size_t OFF_SWV = OFF_SWK + (size_t)NT * 128 * 2;
constexpr size_t OFF_GLQ = OFF_SWV + (size_t)NT * 128 * 2;
constexpr size_t OFF_GLK = OFF_GLQ + (size_t)NT * 384 * 2;
constexpr size_t OFF_GLV = OFF_GLK + (size_t)NT * 128 * 2;
constexpr size_t OFF_MLQ = OFF_GLV + (size_t)NT * 128 * 2;
constexpr size_t OFF_MLK = OFF_MLQ + (size_t)NT * 384 * 2;
constexpr size_t OFF_MLKR = OFF_MLK + (size_t)NT * 256 * 2;
constexpr size_t OFF_MLV = OFF_MLKR + (size_t)NT * 32 * 2;
constexpr size_t OFF_QLAT = OFF_MLV + (size_t)NT * 256 * 2;
constexpr size_t OFF_KVLAT = OFF_QLAT + (size_t)NT * 256 * 2;
constexpr size_t OFF_Y = OFF_KVLAT + (size_t)NT * 128 * 2;
constexpr size_t END_A = OFF_Y + (size_t)NT * 1024 * 2;
constexpr size_t OFF_ACT = OFF_BIG;
constexpr size_t OFF_ACTS = OFF_ACT + (size_t)MAXSLOT * 512 * 2;
constexpr size_t OFF_YEXP = OFF_ACTS + (size_t)NT * 512 * 2;
constexpr size_t END_B = OFF_YEXP + (size_t)MAXSLOT * 1024 * 2;
constexpr size_t OFF_YSH = OFF_H;
constexpr size_t OFF_DELTA = OFF_SWQ;
static_assert(OFF_DELTA + (size_t)NT * 1024 * 2 <= OFF_MLQ, "DELTA must fit below MLQ");
constexpr size_t WS_NEED = END_A > END_B ? END_A : END_B;
static_assert(WS_NEED <= (size_t)536870912, "workspace too large");

constexpr int CW_CTR = 0;
constexpr int CW_CNT = 8192;
constexpr int CW_Q = 10240;

struct Params {
  const float *x, *c, *ctx, *c_ctx, *w_mod, *b_mod, *norm_mix_g, *norm_ffn_g, *w_in, *w_out, *swa_sink, *glb_q_gain, *glb_k_gain,
      *mla_q_gain, *mla_w_uq, *mla_kv_gain, *mla_w_ukv, *router_w, *router_bias, *exp_w_gate, *exp_w_up, *exp_w_down, *shr_w_gate,
      *shr_w_up, *shr_w_down, *final_norm_g;
  float* out;
  char* ws;
  int never; int pad;
};

constexpr int LDS_MISC = 65536;
constexpr int LDS_BYTES = 65536 + 8192;

DI int next_unit(unsigned* ctr, LAS char* lds) {
  volatile LAS int* slot = (volatile LAS int*)(lds + LDS_MISC + 2560);
  __syncthreads();
  if (threadIdx.x == 0) *slot = (int)atomicAdd(ctr, 1u);
  __syncthreads();
  return *slot;
}

DI unsigned xcc_id_() { return (unsigned)__builtin_amdgcn_s_getreg((3 << 11) | 20) & 0x7u; }
DI int next_unit_xcd(unsigned* ctr8, int per_queue, LAS char* lds) {
  volatile LAS int* slot = (volatile LAS int*)(lds + LDS_MISC + 2560);
  __syncthreads();
  if (threadIdx.x == 0) {
    const int q0 = (int)xcc_id_();
    int res = -1;
    for (int i = 0; i < 8; ++i) {
      const int q = (q0 + i) & 7;
      const int v = (int)atomicAdd(&ctr8[q * 64], 1u);
      if (v < per_queue) { res = q * per_queue + v; break; }
    }
    *slot = res;
  }
  __syncthreads();
  return *slot;
}
DI void cvt_job(const float* __restrict__ src, int ld, int N, int k0, int n0, u16* __restrict__ dst, int K, int mode  , LAS char* lds) {
  LAS float* T = (LAS float*)lds;
  const int tid = threadIdx.x;
  __syncthreads();
  {
    const int kk = tid >> 2, nq = (tid & 3) * 32;
    const float* s = src + (size_t)(k0 + kk) * ld + n0 + nq;
#pragma unroll
    for (int i = 0; i < 8; ++i) {
      float4 v = make_float4(0.f, 0.f, 0.f, 0.f);
      if (n0 + nq + i * 4 < N) v = *(const float4*)(s + i * 4);
      LAS float* t = T + kk * 129 + nq + i * 4;
      t[0] = v.x; t[1] = v.y; t[2] = v.z; t[3] = v.w;
    }
  }
  __syncthreads();
#pragma unroll
  for (int i = 0; i < 4; ++i) {
    const int chn = tid + i * 256;
    const int n = chn >> 3, kc = (chn & 7) * 8;
    if (n0 + n < N) {
      const LAS float* t = T + kc * 129 + n;
      uint4 o;
      o.x = cvtpk(t[0], t[129]); o.y = cvtpk(t[2 * 129], t[3 * 129]); o.z = cvtpk(t[4 * 129], t[5 * 129]); o.w = cvtpk(t[6 * 129], t[7 * 129]);
      const int gn = n0 + n;
      int drow = gn;
      if (mode) drow = (gn >> 5) * 64 + (gn & 31) + (mode == 2 ? 32 : 0);
      *(uint4*)(dst + (size_t)drow * K + k0 + kc) = o;
    }
  }
}

DI void mod_job(const Params& p, int l, int j0, LAS char* lds) {
  LAS float* sc = (LAS float*)lds;
  LAS float* red = (LAS float*)(lds + 36864);
  const int tid = threadIdx.x;
  __syncthreads();
  for (int i = tid; i < 9 * 1024; i += NTHR) {
    int r = i >> 10, k = i & 1023;
    float v = r < 8 ? p.c[r * 1024 + k] : p.c_ctx[k];
    sc[i] = v / (1.f + __expf(-v));
  }
  __syncthreads();
  const int col = tid & 31, kg = tid >> 5;
  float acc[9];
#pragma unroll
  for (int r = 0; r < 9; ++r) acc[r] = 0.f;
  const float* w = p.w_mod + (size_t)l * 1024 * 6144 + (size_t)(kg * 128) * 6144 + j0 + col;
#pragma unroll 1
  for (int k0 = 0; k0 < 128; k0 += 16) {
    float wv[16];
#pragma unroll
    for (int u = 0; u < 16; ++u) wv[u] = w[(size_t)(k0 + u) * 6144];
#pragma unroll
    for (int u = 0; u < 16; ++u)
#pragma unroll
      for (int r = 0; r < 9; ++r) acc[r] += sc[r * 1024 + kg * 128 + k0 + u] * wv[u];
  }
#pragma unroll
  for (int r = 0; r < 9; ++r) red[(kg * 9 + r) * 32 + col] = acc[r];
  __syncthreads();
  float* MOD = (float*)(p.ws + OFF_MOD);
  for (int i = tid; i < 9 * 32; i += NTHR) {
    int r = i >> 5, cc = i & 31;
    float sum = 0.f;
#pragma unroll
    for (int g = 0; g < 8; ++g) sum += red[(g * 9 + r) * 32 + cc];
    MOD[(size_t)(l * 9 + r) * 6144 + j0 + cc] = sum + p.b_mod[l * 6144 + j0 + cc];
  }
}

constexpr int J_WIN = 16 * 14, J_WO = 16 * 8, J_UQ = 4 * 3, J_UKV = 2 * 4, J_EG = 16 * 4, J_ED = 8 * 8;
constexpr int J_DENSE = J_WIN + J_WO + J_UQ + J_UKV;
constexpr int J_EXP = 16 * (2 * J_EG + J_ED);
constexpr int J_SHR = 2 * J_EG + J_ED;
constexpr int J_LAYER = J_DENSE + J_EXP + J_SHR;
constexpr int J_MOD = 2 * 192;
constexpr int J_TOTAL = 2 * J_LAYER + J_MOD;

DI void p0_prologue(const Params& p, LAS char* lds) {
  char* ws = p.ws;
  for (int job = blockIdx.x; job < J_TOTAL; job += gridDim.x) {
    if (job < J_MOD) { mod_job(p, job / 192, (job % 192) * 32, lds); continue; }
    int r = job - J_MOD;
    const int l = r / J_LAYER; r -= l * J_LAYER;
    if (r < J_WIN) { cvt_job(p.w_in + (size_t)l * 1024 * INW, INW, INW, (r / 14) * 64, (r % 14) * 128, (u16*)(ws + OFF_WIN) + (size_t)l * INWP * 1024, 1024, 0, lds); continue; } r -= J_WIN;
    if (r < J_WO) { cvt_job(p.w_out + (size_t)l * 1024 * 1024, 1024, 1024, (r / 8) * 64, (r % 8) * 128, (u16*)(ws + OFF_WO) + (size_t)l * 1024 * 1024, 1024, 0, lds); continue; } r -= J_WO;
    if (r < J_UQ) { cvt_job(p.mla_w_uq + (size_t)l * 256 * 384, 384, 384, (r / 3) * 64, (r % 3) * 128, (u16*)(ws + OFF_WUQ) + (size_t)l * 384 * 256, 256, 0, lds); continue; } r -= J_UQ;
    if (r < J_UKV) { cvt_job(p.mla_w_ukv + (size_t)l * 128 * 512, 512, 512, (r / 4) * 64, (r % 4) * 128, (u16*)(ws + OFF_WUKV) + (size_t)l * 512 * 128, 128, 0, lds); continue; } r -= J_UKV;
    if (r < J_EXP) {
      const int e = r / (2 * J_EG + J_ED); int q = r % (2 * J_EG + J_ED);
      const size_t le = (size_t)l * NE + e;
      if (q < J_EG) { cvt_job(p.exp_w_gate + le * 1024 * 512, 512, 512, (q / 4) * 64, (q % 4) * 128, (u16*)(ws + OFF_WGU) + le * 1024 * 1024, 1024, 1, lds); continue; } q -= J_EG;
      if (q < J_EG) { cvt_job(p.exp_w_up + le * 1024 * 512, 512, 512, (q / 4) * 64, (q % 4) * 128, (u16*)(ws + OFF_WGU) + le * 1024 * 1024, 1024, 2, lds); continue; } q -= J_EG;
      cvt_job(p.exp_w_down + le * 512 * 1024, 1024, 1024, (q / 8) * 64, (q % 8) * 128, (u16*)(ws + OFF_WD) + le * 1024 * 512, 512, 0, lds); continue;
    }
    r -= J_EXP;
    if (r < J_EG) { cvt_job(p.shr_w_gate + (size_t)l * 1024 * 512, 512, 512, (r / 4) * 64, (r % 4) * 128, (u16*)(ws + OFF_SGU) + (size_t)l * 1024 * 1024, 1024, 1, lds); continue; } r -= J_EG;
    if (r < J_EG) { cvt_job(p.shr_w_up + (size_t)l * 1024 * 512, 512, 512, (r / 4) * 64, (r % 4) * 128, (u16*)(ws + OFF_SGU) + (size_t)l * 1024 * 1024, 1024, 2, lds); continue; } r -= J_EG;
    cvt_job(p.shr_w_down + (size_t)l * 512 * 1024, 1024, 1024, (r / 8) * 64, (r % 8) * 128, (u16*)(ws + OFF_SD) + (size_t)l * 1024 * 512, 512, 0, lds);
  }
}

DI const float* xrow_ptr(const Params& p, int layer_src  , int row) {
  if (layer_src == 0) return row < NL ? p.x + (size_t)row * 1024 : p.ctx + (size_t)(row - NL) * 1024;
  return row < NL ? p.out + (size_t)row * 1024 : (const float*)(p.ws + OFF_CTXR) + (size_t)(row - NL) * 1024;
}
DI float* xrow_out(const Params& p, int row) {
  return row < NL ? p.out + (size_t)row * 1024 : (float*)(p.ws + OFF_CTXR) + (size_t)(row - NL) * 1024;
}

DI void norm_mod_row(f32x4 (&v)[4], const float* __restrict__ g, const float* __restrict__ md  , int lane) {
  float ss = 0.f;
#pragma unroll
  for (int i = 0; i < 4; ++i) ss += v[i].x * v[i].x + v[i].y * v[i].y + v[i].z * v[i].z + v[i].w * v[i].w;
  ss = wave_sum(ss);
  const float rstd = rsqrtf(ss * (1.f / 1024.f) + EPS);
#pragma unroll
  for (int i = 0; i < 4; ++i) {
    const f32x4 gg = *(const f32x4*)(g + lane * 4 + i * 256);
    const f32x4 sh = *(const f32x4*)(md + lane * 4 + i * 256);
    const f32x4 sc = *(const f32x4*)(md + 1024 + lane * 4 + i * 256);
    v[i] = v[i] * rstd * gg * (sc + 1.f) + sh;
  }
}
DI void store_h_row(const f32x4 (&v)[4], u16* __restrict__ hrow, int lane) {
#pragma unroll
  for (int i = 0; i < 4; ++i) {
    uint2 o; o.x = cvtpk(v[i].x, v[i].y); o.y = cvtpk(v[i].z, v[i].w);
    *(uint2*)(hrow + lane * 4 + i * 256) = o;
  }
}

DI void p1_norm_mix(const Params& p, int layer) {
  const int tid_ = opaque((int)threadIdx.x); const int lane = tid_ & 63, gw = blockIdx.x * 4 + (tid_ >> 6), ngw = gridDim.x * 4;
  const float* MODl = (const float*)(p.ws + OFF_MOD) + (size_t)layer * 9 * 6144;
  u16* H = (u16*)(p.ws + OFF_H);
  f32x4 vn[4];
  int row = gw;
  if (row < NT) { const float* xr = xrow_ptr(p, layer, row);
#pragma unroll
    for (int i = 0; i < 4; ++i) vn[i] = __builtin_nontemporal_load((const f32x4*)(xr + lane * 4 + i * 256)); }
  while (row < NT) {
    f32x4 v[4];
#pragma unroll
    for (int i = 0; i < 4; ++i) v[i] = vn[i];
    const int rown = row + ngw;
    if (rown < NT) { const float* xr = xrow_ptr(p, layer, rown);
#pragma unroll
      for (int i = 0; i < 4; ++i) vn[i] = __builtin_nontemporal_load((const f32x4*)(xr + lane * 4 + i * 256)); }
    const int mr = row < NL ? row / S_ : 8;
    norm_mod_row(v, p.norm_mix_g + layer * 1024, MODl + (size_t)mr * 6144, lane);
    store_h_row(v, H + (size_t)row * 1024, lane);
    row = rown;
  }
}

DI float max2nd4(float a, float b, float c, float d, float& m1) {
  const float ab = fmaxf(a, b), cd = fmaxf(c, d);
  m1 = fmaxf(ab, cd);
  return fmaxf(fmaxf(fminf(a, b), fminf(c, d)), fminf(ab, cd));
}
template <int CTRL> DI float dppz(float v) { return __int_as_float(__builtin_amdgcn_update_dpp(0, __float_as_int(v), CTRL, 0xf, 0xf, true)); }
DI float lane_xor4(float v, bool b2) { const float a = dppz<0x114>(v), b = dppz<0x104>(v); return b2 ? a : b; }
DI float lane_xor8(float v, bool b3) { const float a = dppz<0x118>(v), b = dppz<0x108>(v); return b3 ? a : b; }
DI bool beats(float a, int ia, float b, int ib) { return a > b || (a == b && ia < ib); }
DI void route_row(float bias_lane, const f32x4 (&v)[4], LAS char* lds, int lane, int& i0, int& i1, float& w0, float& w1) {
  const LAS f32x4* R = (const LAS f32x4*)lds;
  f32x4 pl4[4];
#pragma unroll
  for (int q = 0; q < 4; ++q) pl4[q] = (f32x4){0.f, 0.f, 0.f, 0.f};
#pragma unroll
  for (int i = 0; i < 4; ++i) {
    const int kq = i * 64 + lane;
    f32x4 wq[16];
#pragma unroll
    for (int j = 0; j < 16; ++j) wq[j] = R[j * 256 + kq];
    __builtin_amdgcn_sched_barrier(0);
#pragma unroll
    for (int kk = 0; kk < 4; ++kk) {
      const float hv = v[i][kk];
      const f32x4 hv4 = (f32x4){hv, hv, hv, hv};
#pragma unroll
      for (int q = 0; q < 4; ++q) pl4[q] = __builtin_elementwise_fma(hv4, wq[kk * 4 + q], pl4[q]);
    }
    __builtin_amdgcn_sched_barrier(0);
  }
  float pl[16];
#pragma unroll
  for (int q = 0; q < 4; ++q) { pl[q * 4 + 0] = pl4[q][0]; pl[q * 4 + 1] = pl4[q][1]; pl[q * 4 + 2] = pl4[q][2]; pl[q * 4 + 3] = pl4[q][3]; }
  const bool b0 = (lane & 1) != 0, b1 = (lane & 2) != 0, b2 = (lane & 4) != 0, b3 = (lane & 8) != 0;
  float r8[8], r4[4], r2[2];
#pragma unroll
  for (int i = 0; i < 8; ++i) { const float keep = b0 ? pl[i + 8] : pl[i], send = b0 ? pl[i] : pl[i + 8]; r8[i] = keep + dppz<0xB1>(send); }
#pragma unroll
  for (int i = 0; i < 4; ++i) { const float keep = b1 ? r8[i + 4] : r8[i], send = b1 ? r8[i] : r8[i + 4]; r4[i] = keep + dppz<0x4E>(send); }
#pragma unroll
  for (int i = 0; i < 2; ++i) { const float keep = b2 ? r4[i + 2] : r4[i], send = b2 ? r4[i] : r4[i + 2]; r2[i] = keep + lane_xor4(send, b2); }
  float lg;
  { const float keep = b3 ? r2[1] : r2[0], send = b3 ? r2[0] : r2[1]; lg = keep + lane_xor8(send, b3); }
  { auto rr = __builtin_amdgcn_permlane16_swap(__float_as_uint(lg), __float_as_uint(lg), false, false); lg = __uint_as_float(rr[0]) + __uint_as_float(rr[1]); }
  { auto rr = __builtin_amdgcn_permlane32_swap(__float_as_uint(lg), __float_as_uint(lg), false, false); lg = __uint_as_float(rr[0]) + __uint_as_float(rr[1]); }
  const float sg = __builtin_amdgcn_rcpf(1.f + __builtin_amdgcn_exp2f(-1.4426950408889634f * lg));
  const float bv = sg + bias_lane;
  const float m1v = lane_xor4(bv, b2), m2v = lane_xor8(bv, b3), m3v = lane_xor8(m1v, b3);
  float mtop; const float m2nd = max2nd4(bv, m1v, m2v, m3v, mtop);
  const float gs = mtop + m2nd;
  const float gA = dppz<0xB1>(gs), gB = dppz<0x4E>(gs), gC = dppz<0x1B>(gs);
  const int g = (b0 ? 2 : 0) + (b1 ? 1 : 0);
  const bool win = beats(gs, g, gA, g ^ 2) && beats(gs, g, gB, g ^ 1) && beats(gs, g, gC, g ^ 3);
  const int el = (b2 ? 2 : 0) + (b3 ? 1 : 0);
  const int rank = (beats(m1v, el ^ 2, bv, el) ? 1 : 0) + (beats(m2v, el ^ 1, bv, el) ? 1 : 0) + (beats(m3v, el ^ 3, bv, el) ? 1 : 0);
  const unsigned long long k0 = __ballot(win && rank == 0), k1 = __ballot(win && rank == 1);
  const int L0 = __builtin_ctzll(k0 | (1ull << 63)), L1 = __builtin_ctzll(k1 | (1ull << 63));
  const float s0 = __int_as_float(__builtin_amdgcn_readlane(__float_as_int(sg), L0));
  const float s1 = __int_as_float(__builtin_amdgcn_readlane(__float_as_int(sg), L1));
  i0 = 8 * (L0 & 1) + 4 * ((L0 >> 1) & 1) + 2 * ((L0 >> 2) & 1) + ((L0 >> 3) & 1);
  i1 = 8 * (L1 & 1) + 4 * ((L1 >> 1) & 1) + 2 * ((L1 >> 2) & 1) + ((L1 >> 3) & 1);
  const float inv = 1.f / (s0 + s1);
  w0 = s0 * inv; w1 = s1 * inv;
}

DI void load_router_lds(const Params& p, LAS char* lds) {
  LAS f32x4* R = (LAS f32x4*)lds;
  __syncthreads();
  for (int g = threadIdx.x; g < 4096; g += NTHR) {
    const int k = g >> 2, q = g & 3;
    R[((k & 3) * 4 + q) * 256 + (k >> 2)] = *(const f32x4*)(p.router_w + (size_t)g * 4);
  }
  __syncthreads();
}

constexpr int CNT_STRIDE = 64;
DI void p5_norm_ffn(const Params& p, int layer, int nrows, LAS char* lds) {
  load_router_lds(p, lds);
  const int tid = opaque((int)threadIdx.x), lane = tid & 63, wid = tid >> 6, gw = blockIdx.x * 4 + wid, ngw = gridDim.x * 4;
  const float* MODl = (const float*)(p.ws + OFF_MOD) + (size_t)layer * 9 * 6144;
  u16* H = (u16*)(p.ws + OFF_H);
  volatile LAS int* lcnt = (volatile LAS int*)(lds + LDS_MISC + 3072);
  volatile LAS int* lbase = lcnt + 16;
  volatile LAS int* stash = (volatile LAS int*)(lds + LDS_MISC + 4096) + wid * 160;
  int* tok_e = (int*)(p.ws + OFF_TOKE); float* tok_w = (float*)(p.ws + OFF_TOKW); int* tok_p = (int*)(p.ws + OFF_TOKP);
  int* list = (int*)(p.ws + OFF_LIST);
  unsigned* cnt = (unsigned*)(p.ws + OFF_CTRL) + CW_CNT + layer * 16 * CNT_STRIDE;
  if (tid < 16) lcnt[tid] = 0;
  __syncthreads();
  const float bias = p.router_bias[8 * (lane & 1) + 4 * ((lane >> 1) & 1) + 2 * ((lane >> 2) & 1) + ((lane >> 3) & 1)];
  int nst = 0;
  f32x4 vn[4]; u32x2_t dn[4];
  const u16* DELTA = (const u16*)(p.ws + OFF_DELTA);
  if (gw < nrows) { const float* xr0 = xrow_ptr(p, layer, gw);
#pragma unroll
    for (int i = 0; i < 4; ++i) { vn[i] = __builtin_nontemporal_load((const f32x4*)(xr0 + lane * 4 + i * 256)); dn[i] = __builtin_nontemporal_load((const u32x2_t*)(DELTA + (size_t)gw * 1024 + lane * 4 + i * 256)); } }
  for (int row = gw; row < nrows; row += ngw) {
    f32x4 v[4];
#pragma unroll
    for (int i = 0; i < 4; ++i) { v[i] = vn[i]; v[i][0] += bflo(dn[i][0]); v[i][1] += bfhi(dn[i][0]); v[i][2] += bflo(dn[i][1]); v[i][3] += bfhi(dn[i][1]); }
    if (row + ngw < nrows) { const float* xrn = xrow_ptr(p, layer, row + ngw);
#pragma unroll
      for (int i = 0; i < 4; ++i) { vn[i] = __builtin_nontemporal_load((const f32x4*)(xrn + lane * 4 + i * 256)); dn[i] = __builtin_nontemporal_load((const u32x2_t*)(DELTA + (size_t)(row + ngw) * 1024 + lane * 4 + i * 256)); } }
    { float* xw = xrow_out(p, row);
#pragma unroll
      for (int i = 0; i < 4; ++i) *(f32x4*)(xw + lane * 4 + i * 256) = v[i]; }
    const int mr = row < NL ? row / S_ : 8;
    norm_mod_row(v, p.norm_ffn_g + layer * 1024, MODl + (size_t)mr * 6144 + 3 * 1024, lane);
    store_h_row(v, H + (size_t)row * 1024, lane);
    int i0, i1; float w0, w1;
    route_row(bias, v, lds, lane, i0, i1, w0, w1);
    if (lane == 0) {
      const int lp0 = __hip_atomic_fetch_add((LAS int*)&lcnt[i0], 1, __ATOMIC_RELAXED, __HIP_MEMORY_SCOPE_WORKGROUP);
      const int lp1 = __hip_atomic_fetch_add((LAS int*)&lcnt[i1], 1, __ATOMIC_RELAXED, __HIP_MEMORY_SCOPE_WORKGROUP);
      tok_e[row * 2] = i0; tok_e[row * 2 + 1] = i1;
      tok_w[row * 2] = w0; tok_w[row * 2 + 1] = w1;
      stash[nst * 4 + 0] = i0; stash[nst * 4 + 1] = lp0; stash[nst * 4 + 2] = i1; stash[nst * 4 + 3] = lp1;
    }
    ++nst;
  }
  __syncthreads();
  if (tid < 16) { const int c = lcnt[tid]; lbase[tid] = c > 0 ? (int)atomicAdd(&cnt[tid * CNT_STRIDE], (unsigned)c) : 0; }
  __syncthreads();
  if (lane == 0) {
    int k = 0;
    for (int row = gw; row < nrows; row += ngw, ++k) {
      const int e0 = stash[k * 4 + 0], e1 = stash[k * 4 + 2];
      const int p0 = lbase[e0] + stash[k * 4 + 1], p1 = lbase[e1] + stash[k * 4 + 3];
      tok_p[row * 2] = p0; tok_p[row * 2 + 1] = p1;
      list[(size_t)e0 * NT + p0] = row; list[(size_t)e1 * NT + p1] = row;
    }
  }
}

DI void seg_scan(const Params& p, int layer, int (&tb)[NE + 1]) {
  const unsigned* cnt = (const unsigned*)(p.ws + OFF_CTRL) + CW_CNT + layer * 16 * CNT_STRIDE;
  int acc = 0;
#pragma unroll
  for (int e = 0; e < NE; ++e) { tb[e] = acc; acc += ((int)cnt[e * CNT_STRIDE] + 127) >> 7; }
  tb[NE] = acc;
}

DI void p8_combine(const Params& p, int layer, int nrows) {
  const int tid_ = opaque((int)threadIdx.x); const int lane = tid_ & 63, gw = blockIdx.x * 4 + (tid_ >> 6), ngw = gridDim.x * 4;
  const float* MODl = (const float*)(p.ws + OFF_MOD) + (size_t)layer * 9 * 6144;
  const float* MODn = (const float*)(p.ws + OFF_MOD) + (size_t)(layer + 1) * 9 * 6144;
  u16* H = (u16*)(p.ws + OFF_H);
  const u16* YSH = (const u16*)(p.ws + OFF_YSH);
  const u16* YEXP = (const u16*)(p.ws + OFF_YEXP);
  const int* tok_e = (const int*)(p.ws + OFF_TOKE); const float* tok_w = (const float*)(p.ws + OFF_TOKW); const int* tok_p = (const int*)(p.ws + OFF_TOKP);
  int tb[NE + 1]; seg_scan(p, layer, tb);
  int me0 = 0, me1 = 0, mp0 = 0, mp1 = 0; float mw0 = 0.f, mw1 = 0.f;
  u32x2_t an[4], bn[4], cn[4]; f32x4 xn[4]; float nw0 = 0.f, nw1 = 0.f;
#define P8_META(r) do { me0 = tok_e[(r) * 2]; me1 = tok_e[(r) * 2 + 1]; mp0 = tok_p[(r) * 2]; mp1 = tok_p[(r) * 2 + 1]; mw0 = tok_w[(r) * 2]; mw1 = tok_w[(r) * 2 + 1]; } while (0)
#define P8_DATA(r) do { int ps0 = 0, ps1 = 0; _Pragma("unroll") for (int e = 0; e < NE; ++e) { if (e == me0) ps0 = tb[e]; if (e == me1) ps1 = tb[e]; } \
    const size_t s0 = (size_t)ps0 * 128 + mp0, s1 = (size_t)ps1 * 128 + mp1; nw0 = mw0; nw1 = mw1; const float* xrn = xrow_out(p, (r)); \
    _Pragma("unroll") for (int i = 0; i < 4; ++i) { const int cidx = lane * 4 + i * 256; \
      an[i] = __builtin_nontemporal_load((const u32x2_t*)(YEXP + s0 * 1024 + cidx)); bn[i] = __builtin_nontemporal_load((const u32x2_t*)(YEXP + s1 * 1024 + cidx)); \
      cn[i] = __builtin_nontemporal_load((const u32x2_t*)(YSH + (size_t)(r) * 1024 + cidx)); xn[i] = __builtin_nontemporal_load((const f32x4*)(xrn + cidx)); } } while (0)
  if (gw < nrows) { P8_META(gw); P8_DATA(gw); }
  if (gw + ngw < nrows) P8_META(gw + ngw);
  for (int row = gw; row < nrows; row += ngw) {
    u32x2_t a[4], b[4], c[4]; f32x4 v[4];
#pragma unroll
    for (int i = 0; i < 4; ++i) { a[i] = an[i]; b[i] = bn[i]; c[i] = cn[i]; v[i] = xn[i]; }
    const float w0 = nw0, w1 = nw1;
    if (row + ngw < nrows) P8_DATA(row + ngw);
    if (row + 2 * ngw < nrows) P8_META(row + 2 * ngw);
    float* xr = xrow_out(p, row);
    const int mr = row < NL ? row / S_ : 8;
    const float* gate = MODl + (size_t)mr * 6144 + 5 * 1024;
#pragma unroll
    for (int i = 0; i < 4; ++i) {
      const int cidx = lane * 4 + i * 256;
      const f32x4 g = *(const f32x4*)(gate + cidx);
      f32x4 x = v[i];
      x.x += g.x * (w0 * bflo(a[i][0]) + w1 * bflo(b[i][0]) + bflo(c[i][0]));
      x.y += g.y * (w0 * bfhi(a[i][0]) + w1 * bfhi(b[i][0]) + bfhi(c[i][0]));
      x.z += g.z * (w0 * bflo(a[i][1]) + w1 * bflo(b[i][1]) + bflo(c[i][1]));
      x.w += g.w * (w0 * bfhi(a[i][1]) + w1 * bfhi(b[i][1]) + bfhi(c[i][1]));
      v[i] = x;
    }
    if (layer == 0) {
#pragma unroll
      for (int i = 0; i < 4; ++i) __builtin_nontemporal_store(v[i], (f32x4*)(xr + lane * 4 + i * 256));
      norm_mod_row(v, p.norm_mix_g + 1024, MODn + (size_t)mr * 6144, lane);
      store_h_row(v, H + (size_t)row * 1024, lane);
    } else {
      float ss = 0.f;
#pragma unroll
      for (int i = 0; i < 4; ++i) ss += v[i].x * v[i].x + v[i].y * v[i].y + v[i].z * v[i].z + v[i].w * v[i].w;
      ss = wave_sum(ss);
      const float rstd = rsqrtf(ss * (1.f / 1024.f) + EPS);
#pragma unroll
      for (int i = 0; i < 4; ++i) {
        const f32x4 gg = *(const f32x4*)(p.final_norm_g + lane * 4 + i * 256);
        __builtin_nontemporal_store(v[i] * rstd * gg, (f32x4*)(xr + lane * 4 + i * 256));
      }
    }
  }
#undef P8_META
#undef P8_DATA
}

DI void glds16(const u16* g, LAS char* l) {
  __builtin_amdgcn_global_load_lds((const void*)g, (LAS void*)l, 16, 0, 0);
}
struct TilePtrs { const u16 *a0, *a1, *a2, *a3, *b0; long ldb32; };
#define GT_ISSUE_P(T, kt, s) do { const int _ko = (kt) * 64; LAS char* _d = ldst + (s) * 32768; \
    glds16((T).a0 + _ko, _d); glds16((T).a1 + _ko, _d + 4096); glds16((T).a2 + _ko, _d + 8192); glds16((T).a3 + _ko, _d + 12288); \
    glds16((T).b0 + _ko, _d + 16384); glds16((T).b0 + (T).ldb32 + _ko, _d + 20480); glds16((T).b0 + 2 * (T).ldb32 + _ko, _d + 24576); glds16((T).b0 + 3 * (T).ldb32 + _ko, _d + 28672); } while (0)
template <bool HOIST = true>
DI void gemm_tile_s(LAS char* lds, const TilePtrs& cur, bool issued, const TilePtrs& nxt, bool has_next, int nk, f32x4 (&acc)[4][4]) {
  const int tid = opaque((int)threadIdx.x), lane = tid & 63, wid = tid >> 6, wr = wid >> 1, wc = wid & 1, fr = lane & 15, fq = lane >> 4;
  const int kx = (fr >> 1) & 7;
  const int aoff0 = (wr * 64 + fr) * 128 + ((fq ^ kx) * 16), aoff1 = (wr * 64 + fr) * 128 + (((4 + fq) ^ kx) * 16);
  const int boff0 = 16384 + (wc * 64 + fr) * 128 + ((fq ^ kx) * 16), boff1 = 16384 + (wc * 64 + fr) * 128 + (((4 + fq) ^ kx) * 16);
#pragma unroll
  for (int m = 0; m < 4; ++m)
#pragma unroll
    for (int n = 0; n < 4; ++n) acc[m][n] = (f32x4){0.f, 0.f, 0.f, 0.f};
  LAS char* ldst = lds + tid * 16;
  if (!issued) GT_ISSUE_P(cur, 0, 0);
#pragma unroll 1
  for (int kt = 0; kt < nk; ++kt) {
    asm volatile("s_waitcnt vmcnt(0)" ::: "memory");
    __syncthreads();
    if (kt + 1 < nk) GT_ISSUE_P(cur, kt + 1, (kt + 1) & 1);
    else if (has_next) GT_ISSUE_P(nxt, 0, 0);
    const LAS char* sb = lds + (kt & 1) * 32768;
    if (!HOIST) {
#pragma unroll
      for (int h = 0; h < 2; ++h) {
        bf16x8 af1[4], bf1[4];
#pragma unroll
        for (int m = 0; m < 4; ++m) af1[m] = *(const LAS bf16x8*)(sb + (h ? aoff1 : aoff0) + m * 2048);
#pragma unroll
        for (int n = 0; n < 4; ++n) bf1[n] = *(const LAS bf16x8*)(sb + (h ? boff1 : boff0) + n * 2048);
#pragma unroll
        for (int m = 0; m < 4; ++m)
#pragma unroll
          for (int n = 0; n < 4; ++n) acc[m][n] = __builtin_amdgcn_mfma_f32_16x16x32_bf16(bf1[n], af1[m], acc[m][n], 0, 0, 0);
      }
      continue;
    }
    bf16x8 af[2][4], bfr[2][4];
    const unsigned aad0 = (unsigned)(size_t)(sb + aoff0), aad1 = (unsigned)(size_t)(sb + aoff1), bad0 = (unsigned)(size_t)(sb + boff0), bad1 = (unsigned)(size_t)(sb + boff1);
#define GT_LDR(dst, ad, off) asm volatile("ds_read_b128 %0, %1 offset:%c2" : "=v"(dst) : "v"(ad), "i"(off))
    GT_LDR(af[0][0], aad0, 0); GT_LDR(af[0][1], aad0, 2048); GT_LDR(af[0][2], aad0, 4096); GT_LDR(af[0][3], aad0, 6144);
    GT_LDR(bfr[0][0], bad0, 0); GT_LDR(bfr[0][1], bad0, 2048); GT_LDR(bfr[0][2], bad0, 4096); GT_LDR(bfr[0][3], bad0, 6144);
    GT_LDR(af[1][0], aad1, 0); GT_LDR(af[1][1], aad1, 2048); GT_LDR(af[1][2], aad1, 4096); GT_LDR(af[1][3], aad1, 6144);
    GT_LDR(bfr[1][0], bad1, 0); GT_LDR(bfr[1][1], bad1, 2048); GT_LDR(bfr[1][2], bad1, 4096); GT_LDR(bfr[1][3], bad1, 6144);
#undef GT_LDR
    asm volatile("s_waitcnt lgkmcnt(8)" : "+v"(af[0][0]), "+v"(af[0][1]), "+v"(af[0][2]), "+v"(af[0][3]), "+v"(bfr[0][0]), "+v"(bfr[0][1]), "+v"(bfr[0][2]), "+v"(bfr[0][3]) :: "memory");
    __builtin_amdgcn_sched_barrier(0);
#pragma unroll
    for (int m = 0; m < 4; ++m)
#pragma unroll
      for (int n = 0; n < 4; ++n) acc[m][n] = __builtin_amdgcn_mfma_f32_16x16x32_bf16(bfr[0][n], af[0][m], acc[m][n], 0, 0, 0);
    __builtin_amdgcn_sched_barrier(0);
    asm volatile("s_waitcnt lgkmcnt(0)" : "+v"(af[1][0]), "+v"(af[1][1]), "+v"(af[1][2]), "+v"(af[1][3]), "+v"(bfr[1][0]), "+v"(bfr[1][1]), "+v"(bfr[1][2]), "+v"(bfr[1][3]) :: "memory");
    __builtin_amdgcn_sched_barrier(0);
#pragma unroll
    for (int m = 0; m < 4; ++m)
#pragma unroll
      for (int n = 0; n < 4; ++n) acc[m][n] = __builtin_amdgcn_mfma_f32_16x16x32_bf16(bfr[1][n], af[1][m], acc[m][n], 0, 0, 0);
    __builtin_amdgcn_sched_barrier(0);
  }
}
DI void gemm_tile(LAS char* lds, const u16* a0, long lda32, const u16* b0, long ldb32, int nk, f32x4 (&acc)[4][4]) {
  TilePtrs t; t.a0 = a0; t.a1 = a0 + lda32; t.a2 = a0 + 2 * lda32; t.a3 = a0 + 3 * lda32; t.b0 = b0; t.ldb32 = ldb32;
  gemm_tile_s<false>(lds, t, false, t, false, nk, acc);
  __syncthreads();
}
DI int gt_chunk(int tid) { return ((tid & 7) ^ ((tid >> 4) & 7)) * 8; }
DI int gt_row0(int tid) { return tid >> 3; }

DI void sincos_rev(float pos, float invf, float& sn, float& cs) {
  float rev = pos * invf * 0.15915494309189535f;
  rev -= rintf(rev);
  sn = __builtin_amdgcn_sinf(rev); cs = __builtin_amdgcn_cosf(rev);
}
DI void st_bf4(u16* dst, const f32x4& v) { uint2 o; o.x = cvtpk(v[0], v[1]); o.y = cvtpk(v[2], v[3]); *(uint2*)dst = o; }


DI void stage_put4(LAS char* st, int row, int c8, const f32x4& v) {
  u32x2_t o; o[0] = cvtpk(v[0], v[1]); o[1] = cvtpk(v[2], v[3]);
  *(LAS u32x2_t*)(st + row * 128 + ((c8 ^ (row & 15)) * 8)) = o;
}
DI u32x4_t stage_get16(const LAS char* st, int row, int u) {
  u32x4_t v = *(const LAS u32x4_t*)(st + row * 128 + ((u ^ ((row >> 1) & 7)) * 16));
  if (row & 1) v = __builtin_shufflevector(v, v, 2, 3, 0, 1);
  return v;
}
template <int NC>
DI void stage_flush(const LAS char* st, u16* dst, size_t ld, int lane) {
  constexpr int UPR = NC / 8;
  constexpr int RPI = 64 / UPR;
#pragma unroll
  for (int i = 0; i < 64 / RPI; ++i) {
    const int row = i * RPI + lane / UPR, u = lane % UPR;
    const u32x4_t v = stage_get16(st, row, u);
    *(u32x4_t*)(dst + (size_t)row * ld + u * 8) = v;
  }
}

DI void epi_inproj(const Params& p, int layer, f32x4 (&acc)[4][4], int m0, int seg, int wr, int fr, int fq, LAS float* rowss_slot, LAS char* stg, int lane) {
  char* ws = p.ws;
  const bool lat = m0 < NL;
  const int rbase = m0 + wr * 64 + fr;
  u16* dst; int ld, cb; int kind;
  if (seg < 6) { dst = (u16*)(ws + OFF_SWQ); ld = 384; cb = seg * 64; kind = 1; }
  else if (seg < 8) { dst = (u16*)(ws + OFF_SWK); ld = 128; cb = (seg - 6) * 64; kind = 1; }
  else if (seg < 10) { dst = (u16*)(ws + OFF_SWV); ld = 128; cb = (seg - 8) * 64; kind = 0; }
  else if (seg < 16) { dst = (u16*)(ws + OFF_GLQ); ld = 384; cb = (seg - 10) * 64; kind = 2; }
  else if (seg < 18) { dst = (u16*)(ws + OFF_GLK); ld = 128; cb = (seg - 16) * 64; kind = 3; }
  else if (seg < 20) { dst = (u16*)(ws + OFF_GLV); ld = 128; cb = (seg - 18) * 64; kind = 0; }
  else if (seg < 24) { dst = (u16*)(ws + OFF_QLAT); ld = 256; cb = (seg - 20) * 64; kind = 4; }
  else if (seg < 26) { dst = (u16*)(ws + OFF_KVLAT); ld = 128; cb = (seg - 24) * 64; kind = 5; }
  else if (seg == 26) { dst = (u16*)(ws + OFF_MLKR); ld = 32; cb = 0; kind = 6; }
  else return;
  if (kind == 2 || kind == 3) {
    const float* gain = (kind == 2 ? p.glb_q_gain : p.glb_k_gain) + layer * 64;
    f32x4 gv[4];
#pragma unroll
    for (int n = 0; n < 4; ++n) gv[n] = *(const f32x4*)(gain + n * 16 + fq * 4);
#pragma unroll
    for (int m = 0; m < 4; ++m) {
      float ss = 0.f;
#pragma unroll
      for (int n = 0; n < 4; ++n) ss += acc[m][n][0] * acc[m][n][0] + acc[m][n][1] * acc[m][n][1] + acc[m][n][2] * acc[m][n][2] + acc[m][n][3] * acc[m][n][3];
      ss += __shfl_xor(ss, 16); ss += __shfl_xor(ss, 32);
      const float r = rsqrtf(ss * (1.f / 64.f) + EPS);
#pragma unroll
      for (int n = 0; n < 4; ++n) acc[m][n] = acc[m][n] * r * gv[n];
    }
  }
  if (kind == 4 || kind == 5) {
    const float* gain = (kind == 4 ? p.mla_q_gain + layer * 256 : p.mla_kv_gain + layer * 128) + cb;
    f32x4 gv[4];
#pragma unroll
    for (int n = 0; n < 4; ++n) gv[n] = *(const f32x4*)(gain + n * 16 + fq * 4);
#pragma unroll
    for (int m = 0; m < 4; ++m) {
      float ss = 0.f;
#pragma unroll
      for (int n = 0; n < 4; ++n) ss += acc[m][n][0] * acc[m][n][0] + acc[m][n][1] * acc[m][n][1] + acc[m][n][2] * acc[m][n][2] + acc[m][n][3] * acc[m][n][3];
      ss += __shfl_xor(ss, 16); ss += __shfl_xor(ss, 32);
      if (fq == 0) rowss_slot[wr * 64 + m * 16 + fr] = ss;
#pragma unroll
      for (int n = 0; n < 4; ++n) acc[m][n] = acc[m][n] * gv[n];
    }
  }
  if (lat && (kind == 1 || kind == 2 || kind == 3)) {
    float invf[4];
#pragma unroll
    for (int j = 0; j < 4; ++j) invf[j] = __builtin_amdgcn_exp2f(-(float)(fq * 4 + j) * (13.287712379549449f / 16.f));
#pragma unroll
    for (int m = 0; m < 4; ++m) {
      const int t = (rbase + m * 16) & (S_ - 1);
      const float prow = (float)(t >> 6), pcol = (float)(t & 63);
#pragma unroll
      for (int j = 0; j < 4; ++j) {
        float sr, cr, sc, cc;
        sincos_rev(prow, invf[j], sr, cr); sincos_rev(pcol, invf[j], sc, cc);
        float x1 = acc[m][0][j], x2 = acc[m][1][j];
        acc[m][0][j] = x1 * cr - x2 * sr; acc[m][1][j] = x2 * cr + x1 * sr;
        x1 = acc[m][2][j]; x2 = acc[m][3][j];
        acc[m][2][j] = x1 * cc - x2 * sc; acc[m][3][j] = x2 * cc + x1 * sc;
      }
    }
  }
  if (kind == 6) {
    if (lat) {
      float invf[4];
#pragma unroll
      for (int j = 0; j < 4; ++j) invf[j] = __builtin_amdgcn_exp2f(-(float)((fq & 1) * 4 + j) * (13.287712379549449f / 8.f));
#pragma unroll
      for (int m = 0; m < 4; ++m) {
        const int t = (rbase + m * 16) & (S_ - 1);
#pragma unroll
        for (int n = 0; n < 2; ++n) {
          const float pos = n == 0 ? (float)(t >> 6) : (float)(t & 63);
#pragma unroll
          for (int j = 0; j < 4; ++j) {
            float sn, cs; sincos_rev(pos, invf[j], sn, cs);
            const float v = acc[m][n][j], pr = __shfl_xor(v, 32);
            acc[m][n][j] = (fq & 2) ? v * cs + pr * sn : v * cs - pr * sn;
          }
        }
      }
    }
#pragma unroll
    for (int m = 0; m < 4; ++m)
#pragma unroll
      for (int n = 0; n < 2; ++n) stage_put4(stg, m * 16 + fr, n * 4 + fq, acc[m][n]);
    stage_flush<32>(stg, dst + (size_t)(m0 + wr * 64) * ld, ld, lane);
    return;
  }
#pragma unroll
  for (int m = 0; m < 4; ++m)
#pragma unroll
    for (int n = 0; n < 4; ++n) stage_put4(stg, m * 16 + fr, n * 4 + fq, acc[m][n]);
  stage_flush<64>(stg, dst + (size_t)(m0 + wr * 64) * ld + cb, ld, lane);
}

DI void p2_inproj(const Params& p, int layer, LAS char* lds, int cs = 0) {
  char* ws = p.ws;
  unsigned* ctr = (unsigned*)(ws + OFF_CTRL) + CW_CTR + layer * 16 + 2 + cs;
  const u16* H = (const u16*)(ws + OFF_H);
  const u16* WinT = (const u16*)(ws + OFF_WIN) + (size_t)layer * INWP * 1024;
  const u16* WuqT = (const u16*)(ws + OFF_WUQ) + (size_t)layer * 384 * 256;
  const u16* WukvT = (const u16*)(ws + OFF_WUKV) + (size_t)layer * 512 * 128;
  const int tid = opaque((int)threadIdx.x), lane = tid & 63, wid = tid >> 6, wr = wid >> 1, wc = wid & 1;
  LAS float* rowss = (LAS float*)(lds + LDS_MISC);
  LAS float* rstd = (LAS float*)(lds + LDS_MISC + 2048);
  unsigned* ctr8 = (unsigned*)(ws + OFF_CTRL) + CW_Q + (layer * 2 + 1) * 512;
  f32x4 acc[4][4];
  for (;;) {
    const int u = next_unit_xcd(ctr8, (NT / 128 / 8) * 12, lds);
    if (u < 0) break;
    const int tid_o = opaque(tid), lane_o = tid_o & 63;
    const int fr = lane_o & 15, fq = lane_o >> 4, ch = gt_chunk(tid_o), r0 = gt_row0(tid_o);
    const int qx = u / 408, v = u % 408;
    int rt, k;
    if (v < 34) { rt = qx * 34 + v; k = 10; } else if (v < 68) { rt = qx * 34 + v - 34; k = 11; } else { rt = qx * 34 + (v - 68) / 10; k = (v - 68) % 10; }
    const int m0 = rt * 128;
    const u16* a0 = H + (size_t)(m0 + r0) * 1024 + ch;
    if (k < 10) {
      const u16* b0 = WinT + (size_t)(k * 128 + r0) * 1024 + ch;
      gemm_tile(lds, a0, 32 * 1024, b0, 32 * 1024, 16, acc);
      epi_inproj(p, layer, acc, m0, k * 2 + wc, wr, fr, fq, rowss, lds + 32768 + wid * 8192, lane_o);
    } else if (k == 10) {
#pragma unroll 1
      for (int t = 0; t < 2; ++t) {
        const u16* b0 = WinT + (size_t)(1280 + t * 128 + r0) * 1024 + ch;
        gemm_tile(lds, a0, 32 * 1024, b0, 32 * 1024, 16, acc);
        epi_inproj(p, layer, acc, m0, 20 + t * 2 + wc, wr, fr, fq, rowss + (t * 2 + wc) * 128, lds + 32768 + wid * 8192, lane_o);
      }
      __syncthreads();
      if (tid < 128) rstd[tid] = rsqrtf((rowss[tid] + rowss[128 + tid] + rowss[256 + tid] + rowss[384 + tid]) * (1.f / 256.f) + EPS);
      __syncthreads();
      const u16* QL = (const u16*)(ws + OFF_QLAT);
      const u16* qa0 = QL + (size_t)(m0 + r0) * 256 + ch;
      u16* MLQ = (u16*)(ws + OFF_MLQ);
      const bool lat = m0 < NL;
#pragma unroll 1
      for (int t = 0; t < 3; ++t) {
        const u16* b0 = WuqT + (size_t)(t * 128 + r0) * 256 + ch;
        gemm_tile(lds, qa0, 32 * 256, b0, 32 * 256, 4, acc);
        const int c0 = t * 128 + wc * 64;
        float invf[4];
#pragma unroll
        for (int j = 0; j < 4; ++j) invf[j] = __builtin_amdgcn_exp2f(-(float)((fq & 1) * 4 + j) * (13.287712379549449f / 8.f));
#pragma unroll
        for (int m = 0; m < 4; ++m) {
          const int rl = wr * 64 + m * 16 + fr;
          const float rs = rstd[rl];
          const int tpos = (m0 + rl) & (S_ - 1);
#pragma unroll
          for (int n = 0; n < 4; ++n) {
            acc[m][n] = acc[m][n] * rs;
            const int w96 = (c0 + n * 16) % 96;
            if (lat && w96 >= 64) {
              const float pos = (w96 == 64) ? (float)(tpos >> 6) : (float)(tpos & 63);
#pragma unroll
              for (int j = 0; j < 4; ++j) {
                float sn, cs; sincos_rev(pos, invf[j], sn, cs);
                const float v = acc[m][n][j], pr = __shfl_xor(v, 32);
                acc[m][n][j] = (fq & 2) ? v * cs + pr * sn : v * cs - pr * sn;
              }
            }
            stage_put4(lds + 32768 + wid * 8192, m * 16 + fr, n * 4 + fq, acc[m][n]);
          }
        }
        stage_flush<64>(lds + 32768 + wid * 8192, MLQ + (size_t)(m0 + wr * 64) * 384 + c0, 384, lane_o);
      }
    } else {
      {
        const u16* b0 = WinT + (size_t)(1536 + r0) * 1024 + ch;
        gemm_tile(lds, a0, 32 * 1024, b0, 32 * 1024, 16, acc);
        epi_inproj(p, layer, acc, m0, 24 + wc, wr, fr, fq, rowss + wc * 128, lds + 32768 + wid * 8192, lane_o);
        const u16* b2 = WinT + (size_t)(1664 + r0) * 1024 + ch;
        gemm_tile(lds, a0, 32 * 1024, b2, 32 * 1024, 16, acc);
        epi_inproj(p, layer, acc, m0, 26 + wc, wr, fr, fq, rowss, lds + 32768 + wid * 8192, lane_o);
      }
      __syncthreads();
      if (tid < 128) rstd[tid] = rsqrtf((rowss[tid] + rowss[128 + tid]) * (1.f / 128.f) + EPS);
      __syncthreads();
      const u16* KL = (const u16*)(ws + OFF_KVLAT);
      const u16* ka0 = KL + (size_t)(m0 + r0) * 128 + ch;
#pragma unroll 1
      for (int t = 0; t < 4; ++t) {
        const u16* b0 = WukvT + (size_t)(t * 128 + r0) * 128 + ch;
        gemm_tile(lds, ka0, 32 * 128, b0, 32 * 128, 2, acc);
        u16* dst = (u16*)(ws + (wc == 0 ? OFF_MLK : OFF_MLV));
#pragma unroll
        for (int m = 0; m < 4; ++m) {
          const int rl = wr * 64 + m * 16 + fr;
          const float rs = rstd[rl];
#pragma unroll
          for (int n = 0; n < 4; ++n) { acc[m][n] = acc[m][n] * rs; stage_put4(lds + 32768 + wid * 8192, m * 16 + fr, n * 4 + fq, acc[m][n]); }
        }
        stage_flush<64>(lds + 32768 + wid * 8192, dst + (size_t)(m0 + wr * 64) * 256 + t * 64, 256, lane_o);
      }
    }
  }
}

DI void p4_outproj(const Params& p, int layer, int nrows, LAS char* lds, int cs = 0) {
  char* ws = p.ws;
  const u16* Y = (const u16*)(ws + OFF_Y);
  const u16* WoT = (const u16*)(ws + OFF_WO) + (size_t)layer * 1024 * 1024;
  const float* MODl = (const float*)(ws + OFF_MOD) + (size_t)layer * 9 * 6144;
  const int tid = opaque((int)threadIdx.x), wid = tid >> 6, wr = wid >> 1, wc = wid & 1;
  const int nunits = (nrows / 128) * 8;
  f32x4 acc[4][4];
  __syncthreads();
  TilePtrs cur, nxt;
  int u = (int)((blockIdx.x & 7) * (gridDim.x >> 3) + (blockIdx.x >> 3));
#define P4_DESC(T, uu) do { const int _t = opaque(tid); const int _ch = gt_chunk(_t), _r0 = gt_row0(_t); const int _rt = (uu) >> 3, _ct = (uu) & 7; \
    (T).a0 = Y + (size_t)(_rt * 128 + _r0) * 1024 + _ch; (T).a1 = (T).a0 + 32 * 1024; (T).a2 = (T).a0 + 64 * 1024; (T).a3 = (T).a0 + 96 * 1024; \
    (T).b0 = WoT + (size_t)(_ct * 128 + _r0) * 1024 + _ch; (T).ldb32 = 32 * 1024; } while (0)
  bool issued = false;
  if (u < nunits) P4_DESC(cur, u);
  while (u < nunits) {
    const int un = u + gridDim.x;
    const bool hn = un < nunits;
    if (hn) P4_DESC(nxt, un); else nxt = cur;
    gemm_tile_s(lds, cur, issued, nxt, hn, 16, acc);
    issued = hn;
    const int tid_o = opaque(tid), lane_o = tid_o & 63;
    const int fr = lane_o & 15, fq = lane_o >> 4;
    const int rt = u >> 3, ct = u & 7, m0 = rt * 128;
    const int mr = m0 < NL ? m0 / S_ : 8;
    const float* gate = MODl + (size_t)mr * 6144 + 2 * 1024 + ct * 128 + wc * 64 + fq * 4;
    __syncthreads();
    LAS char* stg = lds + 32768 + wid * 8192;
#pragma unroll
    for (int n = 0; n < 4; ++n) {
      const f32x4 g = *(const f32x4*)(gate + n * 16);
#pragma unroll
      for (int m = 0; m < 4; ++m) stage_put4(stg, m * 16 + fr, n * 4 + fq, g * acc[m][n]);
    }
    stage_flush<64>(stg, (u16*)(ws + OFF_DELTA) + (size_t)(m0 + wr * 64) * 1024 + ct * 128 + wc * 64, 1024, lane_o);
    cur = nxt; u = un;
  }
#undef P4_DESC
  __syncthreads();
}

DI void p6_gateup(const Params& p, int layer, int nrows, LAS char* lds, int cs = 0) {
  char* ws = p.ws;
  const unsigned* cnt = (const unsigned*)(ws + OFF_CTRL) + CW_CNT + layer * 16 * CNT_STRIDE;
  const u16* H = (const u16*)(ws + OFF_H);
  const int* list = (const int*)(ws + OFF_LIST);
  const u16* WguT = (const u16*)(ws + OFF_WGU) + (size_t)layer * NE * 1024 * 1024;
  const u16* SguT = (const u16*)(ws + OFF_SGU) + (size_t)layer * 1024 * 1024;
  u16* ACT = (u16*)(ws + OFF_ACT); u16* ACTS = (u16*)(ws + OFF_ACTS);
  const int tid = opaque((int)threadIdx.x), wid = tid >> 6, wr = wid >> 1, wc = wid & 1;
  int tb[NE + 1]; seg_scan(p, layer, tb);
  const int R = tb[NE];
  const int nunits = (R + nrows / 128) * 8;
  f32x4 acc[4][4];
  __syncthreads();
  TilePtrs cur, nxt;
#define P6_DESC(T, uu) do { const int _t = opaque(tid); const int _ch = gt_chunk(_t), _r0 = gt_row0(_t); const int _rt = (uu) >> 3, _ct = (uu) & 7; \
    if (_rt < R) { int _e = 0, _tbe = 0; _Pragma("unroll") for (int q = 1; q < NE; ++q) if (_rt >= tb[q]) { _e = q; _tbe = tb[q]; } \
      const int _i = _rt - _tbe, _ce = (int)cnt[_e * CNT_STRIDE]; const int _i0 = _i * 128 + _r0; const int* _lp = list + (size_t)_e * NT + _i0; \
      const int _t0 = _i0 < _ce ? _lp[0] : 0, _t1 = _i0 + 32 < _ce ? _lp[32] : 0, _t2 = _i0 + 64 < _ce ? _lp[64] : 0, _t3 = _i0 + 96 < _ce ? _lp[96] : 0; \
      (T).a0 = H + (size_t)_t0 * 1024 + _ch; (T).a1 = H + (size_t)_t1 * 1024 + _ch; (T).a2 = H + (size_t)_t2 * 1024 + _ch; (T).a3 = H + (size_t)_t3 * 1024 + _ch; \
      (T).b0 = WguT + ((size_t)_e * 1024 + _ct * 128 + _r0) * 1024 + _ch; } \
    else { const int _m0 = (_rt - R) * 128; (T).a0 = H + (size_t)(_m0 + _r0) * 1024 + _ch; (T).a1 = (T).a0 + 32 * 1024; (T).a2 = (T).a0 + 64 * 1024; (T).a3 = (T).a0 + 96 * 1024; \
      (T).b0 = SguT + (size_t)(_ct * 128 + _r0) * 1024 + _ch; } \
    (T).ldb32 = 32 * 1024; } while (0)
  int u = (int)((blockIdx.x & 7) * (gridDim.x >> 3) + (blockIdx.x >> 3));
  bool issued = false;
  if (u < nunits) P6_DESC(cur, u);
  while (u < nunits) {
    const int un = u + gridDim.x;
    const bool hn = un < nunits;
    if (hn) P6_DESC(nxt, un); else nxt = cur;
    gemm_tile_s(lds, cur, issued, nxt, hn, 16, acc);
    issued = hn;
    const int tid_o = opaque(tid), lane_o = tid_o & 63;
    const int fr = lane_o & 15, fq = lane_o >> 4;
    const int rt = u >> 3, ct = u & 7;
    u16* dst; size_t orow;
    if (rt < R) { dst = ACT; orow = (size_t)rt * 128; } else { dst = ACTS; orow = (size_t)(rt - R) * 128; }
    __syncthreads();
    LAS char* stg = lds + 32768 + wid * 8192;
#pragma unroll
    for (int m = 0; m < 4; ++m)
#pragma unroll
      for (int n = 0; n < 2; ++n) {
        f32x4 r;
#pragma unroll
        for (int j = 0; j < 4; ++j) r[j] = silu(acc[m][n][j]) * acc[m][n + 2][j];
        stage_put4(stg, m * 16 + fr, n * 4 + fq, r);
      }
    stage_flush<32>(stg, dst + (orow + wr * 64) * 512 + ct * 64 + wc * 32, 512, lane_o);
    cur = nxt; u = un;
  }
#undef P6_DESC
  __syncthreads();
}

DI void p7_down(const Params& p, int layer, int nrows, LAS char* lds, int cs = 0) {
  char* ws = p.ws;
  const u16* WdT = (const u16*)(ws + OFF_WD) + (size_t)layer * NE * 1024 * 512;
  const u16* SdT = (const u16*)(ws + OFF_SD) + (size_t)layer * 1024 * 512;
  const u16* ACT = (const u16*)(ws + OFF_ACT); const u16* ACTS = (const u16*)(ws + OFF_ACTS);
  u16* YEXP = (u16*)(ws + OFF_YEXP); u16* YSH = (u16*)(ws + OFF_YSH);
  const int tid = opaque((int)threadIdx.x), wid = tid >> 6, wr = wid >> 1, wc = wid & 1;
  int tb[NE + 1]; seg_scan(p, layer, tb);
  const int R = tb[NE];
  const int nunits = (R + nrows / 128) * 8;
  f32x4 acc[4][4];
  __syncthreads();
  TilePtrs cur, nxt;
#define P7_DESC(T, uu) do { const int _t = opaque(tid); const int _ch = gt_chunk(_t), _r0 = gt_row0(_t); const int _rt = (uu) >> 3, _ct = (uu) & 7; \
    if (_rt < R) { int _e = 0; _Pragma("unroll") for (int q = 1; q < NE; ++q) if (_rt >= tb[q]) _e = q; \
      (T).a0 = ACT + ((size_t)_rt * 128 + _r0) * 512 + _ch; (T).b0 = WdT + ((size_t)_e * 1024 + _ct * 128 + _r0) * 512 + _ch; } \
    else { const int _m0 = (_rt - R) * 128; (T).a0 = ACTS + (size_t)(_m0 + _r0) * 512 + _ch; (T).b0 = SdT + (size_t)(_ct * 128 + _r0) * 512 + _ch; } \
    (T).a1 = (T).a0 + 32 * 512; (T).a2 = (T).a0 + 64 * 512; (T).a3 = (T).a0 + 96 * 512; (T).ldb32 = 32 * 512; } while (0)
  int u = (int)((blockIdx.x & 7) * (gridDim.x >> 3) + (blockIdx.x >> 3));
  bool issued = false;
  if (u < nunits) P7_DESC(cur, u);
  while (u < nunits) {
    const int un = u + gridDim.x;
    const bool hn = un < nunits;
    if (hn) P7_DESC(nxt, un); else nxt = cur;
    gemm_tile_s(lds, cur, issued, nxt, hn, 8, acc);
    issued = hn;
    const int tid_o = opaque(tid), lane_o = tid_o & 63;
    const int fr = lane_o & 15, fq = lane_o >> 4;
    const int rt = u >> 3, ct = u & 7;
    u16* dst; size_t orow;
    if (rt < R) { dst = YEXP; orow = (size_t)rt * 128; } else { dst = YSH; orow = (size_t)(rt - R) * 128; }
    __syncthreads();
    LAS char* stg = lds + 32768 + wid * 8192;
#pragma unroll
    for (int m = 0; m < 4; ++m)
#pragma unroll
      for (int n = 0; n < 4; ++n) stage_put4(stg, m * 16 + fr, n * 4 + fq, acc[m][n]);
    stage_flush<64>(stg, dst + (orow + wr * 64) * 1024 + ct * 128 + wc * 64, 1024, lane_o);
    cur = nxt; u = un;
  }
#undef P7_DESC
  __syncthreads();
}

typedef float f32x16 __attribute__((ext_vector_type(16)));
typedef short s16x4 __attribute__((ext_vector_type(4)));
DI s16x4 tr_read(const LAS char* a) { return __builtin_bit_cast(s16x4, __builtin_amdgcn_ds_read_tr16_b64_v4i16((LAS s16x4*)a)); }
DI float half_max(float m) { auto rr = __builtin_amdgcn_permlane32_swap(__float_as_uint(m), __float_as_uint(m), false, false); return fmaxf(__uint_as_float(rr[0]), __uint_as_float(rr[1])); }
DI float half_sum(float m) { auto rr = __builtin_amdgcn_permlane32_swap(__float_as_uint(m), __float_as_uint(m), false, false); return __uint_as_float(rr[0]) + __uint_as_float(rr[1]); }
DI bf16x8 pack8(const f32x16& x, int s8) {
  typedef unsigned u32x4 __attribute__((ext_vector_type(4)));
  u32x4 r;
  r[0] = cvtpk(x[s8 + 0], x[s8 + 1]); r[1] = cvtpk(x[s8 + 2], x[s8 + 3]); r[2] = cvtpk(x[s8 + 4], x[s8 + 5]); r[3] = cvtpk(x[s8 + 6], x[s8 + 7]);
  return __builtin_bit_cast(bf16x8, r);
}
constexpr int AT_STAGE = 20480;

DI float max3f(float a, float b, float c) { float r; asm("v_max3_f32 %0, %1, %2, %3" : "=v"(r) : "v"(a), "v"(b), "v"(c)); return r; }
template <bool MLA, bool SWA>
DI void attn_unit(const Params& p, int layer, int isctx, int b, int h, int qb, LAS char* lds) {
  char* ws = p.ws;
  const int tid = opaque((int)threadIdx.x), lane = tid & 63, wid = tid >> 6, r32 = lane & 31, hi = lane >> 5;
  const u16 *Qg, *Kg, *Vg; int ldq, ldk, qoff, koff, ycol; float cs;
  if (MLA) { Qg = (const u16*)(ws + OFF_MLQ); Kg = (const u16*)(ws + OFF_MLK); Vg = (const u16*)(ws + OFF_MLV); ldq = 384; ldk = 256; qoff = h * 96; koff = h * 64; ycol = 768 + h * 64; cs = 0.10206207261596575f * 1.4426950408889634f; }
  else if (!SWA) { Qg = (const u16*)(ws + OFF_GLQ); Kg = (const u16*)(ws + OFF_GLK); Vg = (const u16*)(ws + OFF_GLV); ldq = 384; ldk = 128; qoff = h * 64; koff = (h / 3) * 64; ycol = 384 + h * 64; cs = 0.125f * 1.4426950408889634f; }
  else { Qg = (const u16*)(ws + OFF_SWQ); Kg = (const u16*)(ws + OFF_SWK); Vg = (const u16*)(ws + OFF_SWV); ldq = 384; ldk = 128; qoff = h * 64; koff = (h / 3) * 64; ycol = h * 64; cs = 0.125f * 1.4426950408889634f; }
  const u16* Rg = (const u16*)(ws + OFF_MLKR);
  const int q0 = qb * 128;
  const int qrow0 = (isctx ? NL + b * C_ : b * S_) + q0;
  const int qw = q0 + wid * 32;
  int lat_first = 0, nlat = 0;
  if (!isctx) { if (SWA) { lat_first = 2 * qb - 2; if (lat_first < 0) lat_first = 0; int lat_last = 2 * qb + 3; if (lat_last > 63) lat_last = 63; nlat = lat_last - lat_first + 1; } else nlat = 64; }
  const int T = 4 + nlat;
  constexpr int NQ = MLA ? 6 : 4;
  bf16x8 qf[NQ];
  {
    const u16* qp = Qg + (size_t)(qrow0 + wid * 32 + r32) * ldq + qoff + hi * 8;
#pragma unroll
    for (int d0 = 0; d0 < NQ; ++d0) {
      const u32x4_t raw = *(const u32x4_t*)(qp + d0 * 16);
      u32x4_t sc;
#pragma unroll
      for (int i = 0; i < 4; ++i) sc[i] = cvtpk(bflo(raw[i]) * cs, bfhi(raw[i]) * cs);
      qf[d0] = __builtin_bit_cast(bf16x8, sc);
    }
  }
  int kaddr[4];
#pragma unroll
  for (int d0 = 0; d0 < 4; ++d0) kaddr[d0] = r32 * 128 + (((d0 * 2 + hi) ^ ((r32 >> 1) & 7)) * 16);
  int kraddr[2];
#pragma unroll
  for (int e = 0; e < 2; ++e) kraddr[e] = 16384 + r32 * 64 + (((e * 2 + hi) ^ ((r32 >> 3) & 3)) * 16);
  int vbo[2];
  {
    const int i16 = lane & 15, sw = (lane >> 3) & 1;
    const int x = ((lane >> 4) & 1) * 32 + (lane & 3) * 8;
    const int rowpart = ((i16 >> 2) + 4 * hi) * 128;
    vbo[0] = 8192 + rowpart + x + (sw * 64);
    vbo[1] = 8192 + rowpart + x + ((1 - sw) * 64);
  }
  const int skey = tid >> 3;
  const int kch = ((tid & 7) ^ ((tid >> 4) & 7)) * 8;
  const int vch = ((tid & 7) ^ (((tid >> 4) & 1) << 2)) * 8;
  const int rkey = tid >> 2, rch = ((tid & 3) ^ ((tid >> 5) & 3)) * 8;
  LAS char* ldst = lds + tid * 16;
#define AT_ISSUE(j, st) do { const int _j = (j); const int _kr = _j < 4 ? NL + b * C_ + 64 * _j : b * S_ + 64 * (lat_first + _j - 4); \
    LAS char* _d = ldst + (st) * AT_STAGE; \
    const u16* _k = Kg + (size_t)(_kr + skey) * ldk + koff + kch; glds16(_k, _d); glds16(_k + (size_t)32 * ldk, _d + 4096); \
    const u16* _v = Vg + (size_t)(_kr + skey) * ldk + koff + vch; glds16(_v, _d + 8192); glds16(_v + (size_t)32 * ldk, _d + 8192 + 4096); \
    if (MLA) glds16(Rg + (size_t)(_kr + rkey) * 32 + rch, _d + 16384); } while (0)
#define AT_QK(sb, P0, P1) do { \
    bf16x8 kk0[MLA ? 6 : 4], kk1[MLA ? 6 : 4]; \
    _Pragma("unroll") for (int d0 = 0; d0 < 4; ++d0) { kk0[d0] = *(const LAS bf16x8*)((sb) + kaddr[d0]); kk1[d0] = *(const LAS bf16x8*)((sb) + kaddr[d0] + 4096); } \
    if (MLA) { _Pragma("unroll") for (int e = 0; e < 2; ++e) { kk0[MLA ? 4 + e : 0] = *(const LAS bf16x8*)((sb) + kraddr[e]); kk1[MLA ? 4 + e : 0] = *(const LAS bf16x8*)((sb) + kraddr[e] + 2048); } } \
    __builtin_amdgcn_sched_barrier(0);     \
    P0 = __builtin_amdgcn_mfma_f32_32x32x16_bf16(kk0[0], qf[0], negm, 0, 0, 0); P1 = __builtin_amdgcn_mfma_f32_32x32x16_bf16(kk1[0], qf[0], negm, 0, 0, 0); \
    _Pragma("unroll") for (int d0 = 1; d0 < (MLA ? 6 : 4); ++d0) { \
      P0 = __builtin_amdgcn_mfma_f32_32x32x16_bf16(kk0[d0], qf[d0], P0, 0, 0, 0); P1 = __builtin_amdgcn_mfma_f32_32x32x16_bf16(kk1[d0], qf[d0], P1, 0, 0, 0); } \
  } while (0)
#define AT_WSTATE(jj, pos0v, st) do { st = 0; pos0v = 64 * (lat_first + (jj) - 4); if (SWA && (jj) >= 4) { \
      if (pos0v + 63 < qw - 128 || pos0v > qw + 31 + 128) st = 2; else if (qw + 31 - pos0v > 128 || pos0v + 63 - qw > 128) st = 1; } } while (0)
#define AT_SOFTMAX(P0, P1, PA, wst, pos0v, FIRST) do { \
    if (SWA && wst == 1) { const int dq = qw + r32 - pos0v - 4 * hi + 128; \
      _Pragma("unroll") for (int r = 0; r < 16; ++r) { const int cr = (r & 3) + 8 * (r >> 2); \
        if ((unsigned)(dq - cr) > 256u) P0[r] = -1e30f; if ((unsigned)(dq - cr - 32) > 256u) P1[r] = -1e30f; } } \
    asm volatile("s_nop 15\n\ts_nop 15" : "+v"(P0), "+v"(P1));     \
    float mx = max3f(P0[0], P0[1], P1[0]); mx = max3f(mx, P1[1], P0[2]); \
    _Pragma("unroll") for (int r = 3; r < 16; r += 2) { mx = max3f(mx, P0[r], P0[(r + 1) & 15]); } \
    _Pragma("unroll") for (int r = 2; r < 16; r += 2) { mx = max3f(mx, P1[r], P1[r + 1]); } \
    mx = half_max(mx); \
    if ((FIRST) || __ballot(mx > 8.0f) != 0ull) { \
      const float delta = (FIRST) ? mx : fmaxf(mx, 0.f); \
      const float al = __builtin_amdgcn_exp2f(-delta); \
      m_run += delta; \
      _Pragma("unroll") for (int i = 0; i < 16; ++i) { o[0][i] *= al; o[1][i] *= al; P0[i] -= delta; P1[i] -= delta; negm[i] = -m_run; } \
      osum[0] *= al; \
    } \
    _Pragma("unroll") for (int r = 0; r < 16; ++r) { P0[r] = __builtin_amdgcn_exp2f(P0[r]); P1[r] = __builtin_amdgcn_exp2f(P1[r]); } \
    PA[0] = pack8(P0, 0); PA[1] = pack8(P0, 8); PA[2] = pack8(P1, 0); PA[3] = pack8(P1, 8); \
  } while (0)
#define AT_PV(sb, PA) do { \
    bf16x8 vf[2][4]; \
    _Pragma("unroll") for (int db = 0; db < 2; ++db) { _Pragma("unroll") for (int ts = 0; ts < 4; ++ts) { \
      const LAS char* va = (sb) + vbo[db] + ts * 2048; const s16x4 lo = tr_read(va), hh = tr_read(va + 1024); \
      vf[db][ts] = __builtin_shufflevector(lo, hh, 0, 1, 2, 3, 4, 5, 6, 7); } } \
    __builtin_amdgcn_sched_barrier(0);     \
    _Pragma("unroll") for (int ts = 0; ts < 4; ++ts) osum = __builtin_amdgcn_mfma_f32_32x32x16_bf16(ones, PA[ts], osum, 0, 0, 0); \
    _Pragma("unroll") for (int db = 0; db < 2; ++db) { _Pragma("unroll") for (int ts = 0; ts < 4; ++ts) \
      o[db] = __builtin_amdgcn_mfma_f32_32x32x16_bf16(vf[db][ts], PA[ts], o[db], 0, 0, 0); } } while (0)

  float m_run = SWA ? p.swa_sink[layer * 6 + h] * 1.4426950408889634f : 0.f;
  f32x16 o[2], osum, negm;
#pragma unroll
  for (int i = 0; i < 16; ++i) { o[0][i] = 0.f; o[1][i] = 0.f; osum[i] = SWA ? 1.f : 0.f; negm[i] = -m_run; }
  bf16x8 ones;
#pragma unroll
  for (int i = 0; i < 8; ++i) ones[i] = (short)0x3F80;
  bf16x8 pa[4];
  f32x16 s0, s1;
  AT_ISSUE(0, 0);
  asm volatile("s_waitcnt vmcnt(0)" ::: "memory");
  __syncthreads();
  AT_ISSUE(1, 1);
  AT_QK(lds, s0, s1);
  { int wst = 0, pos0v = 0; AT_SOFTMAX(s0, s1, pa, wst, pos0v, !SWA); }
  bool cur_skip = false;
#pragma unroll 1
  for (int j = 0; j < T - 1; ++j) {
    asm volatile("s_waitcnt vmcnt(0)" ::: "memory");
    __syncthreads();
    const int st_cur = j % 3, st_nxt = (j + 1) % 3;
    if (j + 2 < T) AT_ISSUE(j + 2, (j + 2) % 3);
    const LAS char* sbn = lds + st_nxt * AT_STAGE;
    const LAS char* sbc = lds + st_cur * AT_STAGE;
    int wst, pos0v; AT_WSTATE(j + 1, pos0v, wst);
    if (!SWA || wst != 2) AT_QK(sbn, s0, s1);
    if (!SWA || !cur_skip) AT_PV(sbc, pa);
    if (!SWA || wst != 2) {
      bf16x8 pn[4];
      AT_SOFTMAX(s0, s1, pn, wst, pos0v, false);
      pa[0] = pn[0]; pa[1] = pn[1]; pa[2] = pn[2]; pa[3] = pn[3];
      cur_skip = false;
    } else cur_skip = true;
  }
  if (!SWA || !cur_skip) { const LAS char* sbc = lds + ((T - 1) % 3) * AT_STAGE; AT_PV(sbc, pa); }
#undef AT_ISSUE
#undef AT_QK
#undef AT_WSTATE
#undef AT_SOFTMAX
#undef AT_PV
  const float inv = 1.f / osum[0];
  u16* yp = (u16*)(ws + OFF_Y) + (size_t)(qrow0 + wid * 32 + r32) * 1024 + ycol + 4 * hi;
#pragma unroll
  for (int db = 0; db < 2; ++db)
#pragma unroll
    for (int g = 0; g < 4; ++g) {
      uint2 w; w.x = cvtpk(o[db][4 * g] * inv, o[db][4 * g + 1] * inv); w.y = cvtpk(o[db][4 * g + 2] * inv, o[db][4 * g + 3] * inv);
      *(uint2*)(yp + db * 32 + 8 * g) = w;
    }
  __syncthreads();
}


typedef float f32x4v __attribute__((ext_vector_type(4)));
#define MFMA16(a, b, c) __builtin_amdgcn_mfma_f32_16x16x32_bf16((a), (b), (c), 0, 0, 0)
DI float quad_max_x(float m) {
  { auto rr = __builtin_amdgcn_permlane16_swap(__float_as_uint(m), __float_as_uint(m), false, false); m = fmaxf(__uint_as_float(rr[0]), __uint_as_float(rr[1])); }
  { auto rr = __builtin_amdgcn_permlane32_swap(__float_as_uint(m), __float_as_uint(m), false, false); m = fmaxf(__uint_as_float(rr[0]), __uint_as_float(rr[1])); }
  return m;
}
template <bool MLA, bool SWA>
DI void attn_unit16(const Params& p, int layer, int isctx, int b, int h, int qb, LAS char* lds) {
  char* ws = p.ws;
  const int tid = opaque((int)threadIdx.x), lane = tid & 63, wid = tid >> 6, c16 = lane & 15, g = lane >> 4;
  const u16 *Qg, *Kg, *Vg; int ldq, ldk, qoff, koff, ycol; float cs;
  if (MLA) { Qg = (const u16*)(ws + OFF_MLQ); Kg = (const u16*)(ws + OFF_MLK); Vg = (const u16*)(ws + OFF_MLV); ldq = 384; ldk = 256; qoff = h * 96; koff = h * 64; ycol = 768 + h * 64; cs = 0.10206207261596575f * 1.4426950408889634f; }
  else if (!SWA) { Qg = (const u16*)(ws + OFF_GLQ); Kg = (const u16*)(ws + OFF_GLK); Vg = (const u16*)(ws + OFF_GLV); ldq = 384; ldk = 128; qoff = h * 64; koff = (h / 3) * 64; ycol = 384 + h * 64; cs = 0.125f * 1.4426950408889634f; }
  else { Qg = (const u16*)(ws + OFF_SWQ); Kg = (const u16*)(ws + OFF_SWK); Vg = (const u16*)(ws + OFF_SWV); ldq = 384; ldk = 128; qoff = h * 64; koff = (h / 3) * 64; ycol = h * 64; cs = 0.125f * 1.4426950408889634f; }
  const u16* Rg = (const u16*)(ws + OFF_MLKR);
  const int q0 = qb * 128;
  const int qrow0 = (isctx ? NL + b * C_ : b * S_) + q0;
  const int qw = q0 + wid * 32;
  int lat_first = 0, nlat = 0;
  if (!isctx) { if (SWA) { lat_first = 2 * qb - 2; if (lat_first < 0) lat_first = 0; int lat_last = 2 * qb + 3; if (lat_last > 63) lat_last = 63; nlat = lat_last - lat_first + 1; } else nlat = 64; }
  const int T = 4 + nlat;
  constexpr int NS = MLA ? 3 : 2;
  bf16x8 qf[2][NS];
#pragma unroll
  for (int bq = 0; bq < 2; ++bq) {
    const u16* qp = Qg + (size_t)(qrow0 + wid * 32 + bq * 16 + c16) * ldq + qoff + g * 8;
#pragma unroll
    for (int s = 0; s < NS; ++s) {
      const u32x4_t raw = *(const u32x4_t*)(qp + s * 32);
      u32x4_t sc;
#pragma unroll
      for (int i = 0; i < 4; ++i) sc[i] = cvtpk(bflo(raw[i]) * cs, bfhi(raw[i]) * cs);
      qf[bq][s] = __builtin_bit_cast(bf16x8, sc);
    }
  }
  int kaddr[2];
#pragma unroll
  for (int s = 0; s < 2; ++s) kaddr[s] = c16 * 128 + (((4 * s + g) ^ ((c16 >> 1) & 7)) * 16);
  const int kraddr = 16384 + c16 * 64 + ((g ^ ((0 - (c16 >> 2)) & 3)) * 16);
  int vbo[4];
#pragma unroll
  for (int d = 0; d < 4; ++d) vbo[d] = 8192 + (4 * g + (c16 >> 2)) * 128 + ((d ^ ((lane >> 3) & 3)) * 32) + (lane & 3) * 8;
  const int skey = tid >> 3;
  const int kch = ((tid & 7) ^ ((tid >> 4) & 7)) * 8;
  const int vch = ((tid & 7) ^ (((tid >> 4) & 3) << 1)) * 8;
  const int rkey = tid >> 2, rch = ((tid & 3) ^ ((0 - (tid >> 4)) & 3)) * 8;
  LAS char* ldst = lds + tid * 16;
#define A6_ISSUE(j, st) do { const int _j = (j); const int _kr = _j < 4 ? NL + b * C_ + 64 * _j : b * S_ + 64 * (lat_first + _j - 4); \
    LAS char* _d = ldst + (st) * AT_STAGE; \
    const u16* _k = Kg + (size_t)(_kr + skey) * ldk + koff + kch; glds16(_k, _d); glds16(_k + (size_t)32 * ldk, _d + 4096); \
    const u16* _v = Vg + (size_t)(_kr + skey) * ldk + koff + vch; glds16(_v, _d + 8192); glds16(_v + (size_t)32 * ldk, _d + 8192 + 4096); \
    if (MLA) glds16(Rg + (size_t)(_kr + rkey) * 32 + rch, _d + 16384); } while (0)
#define A6_QK(sb) do { \
    bf16x8 kk[4][NS]; \
    _Pragma("unroll") for (int a = 0; a < 4; ++a) { kk[a][0] = *(const LAS bf16x8*)((sb) + kaddr[0] + a * 2048); kk[a][1] = *(const LAS bf16x8*)((sb) + kaddr[1] + a * 2048); \
      if (MLA) kk[a][MLA ? 2 : 0] = *(const LAS bf16x8*)((sb) + kraddr + a * 1024); } \
    __builtin_amdgcn_sched_barrier(0); \
    _Pragma("unroll") for (int a = 0; a < 4; ++a) { _Pragma("unroll") for (int bq = 0; bq < 2; ++bq) { \
      S[a][bq] = MFMA16(kk[a][0], qf[bq][0], negm[bq]); \
      _Pragma("unroll") for (int s = 1; s < NS; ++s) S[a][bq] = MFMA16(kk[a][s], qf[bq][s], S[a][bq]); } } \
  } while (0)
#define A6_WSTATE(jj, pos0v, st) do { st = 0; pos0v = 64 * (lat_first + (jj) - 4); if (SWA && (jj) >= 4) { \
      if (pos0v + 63 < qw - 128 || pos0v > qw + 31 + 128) st = 2; else if (qw + 31 - pos0v > 128 || pos0v + 63 - qw > 128) st = 1; } } while (0)
#define A6_SOFTMAX(PA, wst, pos0v, FIRST, CHECK) do { \
    if (SWA && wst == 1) { _Pragma("unroll") for (int bq = 0; bq < 2; ++bq) { const int dq = qw + 16 * bq + c16 - pos0v - 4 * g + 128; \
      _Pragma("unroll") for (int a = 0; a < 4; ++a) { _Pragma("unroll") for (int r = 0; r < 4; ++r) { if ((unsigned)(dq - (16 * a + r)) > 256u) S[a][bq][r] = -1e30f; } } } } \
    float mx[2] = {0.f, 0.f}; \
    if (CHECK) { \
    asm volatile("s_nop 15\n\ts_nop 15" : "+v"(S[0][0]), "+v"(S[0][1]), "+v"(S[1][0]), "+v"(S[1][1]), "+v"(S[2][0]), "+v"(S[2][1]), "+v"(S[3][0]), "+v"(S[3][1])); \
    _Pragma("unroll") for (int bq = 0; bq < 2; ++bq) { \
      float m_ = max3f(S[0][bq][0], S[0][bq][1], S[0][bq][2]); m_ = max3f(m_, S[0][bq][3], S[1][bq][0]); \
      m_ = max3f(m_, S[1][bq][1], S[1][bq][2]); m_ = max3f(m_, S[1][bq][3], S[2][bq][0]); m_ = max3f(m_, S[2][bq][1], S[2][bq][2]); \
      m_ = max3f(m_, S[2][bq][3], S[3][bq][0]); m_ = max3f(m_, S[3][bq][1], S[3][bq][2]); m_ = fmaxf(m_, S[3][bq][3]); \
      mx[bq] = quad_max_x(m_); } } \
    if ((FIRST) || ((CHECK) && __ballot(fmaxf(mx[0], mx[1]) > 8.0f) != 0ull)) { \
      _Pragma("unroll") for (int bq = 0; bq < 2; ++bq) { \
        const float delta = (FIRST) ? mx[bq] : fmaxf(mx[bq], 0.f); \
        const float al = __builtin_amdgcn_exp2f(-delta); \
        m_run[bq] += delta; \
        _Pragma("unroll") for (int a = 0; a < 4; ++a) { S[a][bq] = S[a][bq] - delta; o[a][bq] = o[a][bq] * al; } \
        negm[bq] = (f32x4v){-m_run[bq], -m_run[bq], -m_run[bq], -m_run[bq]}; \
        osum[bq] = osum[bq] * al; } \
    } \
    _Pragma("unroll") for (int a = 0; a < 4; ++a) { _Pragma("unroll") for (int bq = 0; bq < 2; ++bq) { _Pragma("unroll") for (int r = 0; r < 4; ++r) S[a][bq][r] = __builtin_amdgcn_exp2f(S[a][bq][r]); } } \
    _Pragma("unroll") for (int ks = 0; ks < 2; ++ks) { _Pragma("unroll") for (int bq = 0; bq < 2; ++bq) { u32x4_t w_; \
      w_[0] = cvtpk(S[2 * ks][bq][0], S[2 * ks][bq][1]); w_[1] = cvtpk(S[2 * ks][bq][2], S[2 * ks][bq][3]); \
      w_[2] = cvtpk(S[2 * ks + 1][bq][0], S[2 * ks + 1][bq][1]); w_[3] = cvtpk(S[2 * ks + 1][bq][2], S[2 * ks + 1][bq][3]); \
      PA[ks][bq] = __builtin_bit_cast(bf16x8, w_); } } \
  } while (0)
#define A6_PV(sb, PA) do { \
    bf16x8 vf[2][4]; \
    _Pragma("unroll") for (int ks = 0; ks < 2; ++ks) { _Pragma("unroll") for (int d = 0; d < 4; ++d) { \
      const LAS char* va = (sb) + vbo[d] + ks * 4096; const s16x4 lo = tr_read(va), hh = tr_read(va + 2048); \
      vf[ks][d] = __builtin_shufflevector(lo, hh, 0, 1, 2, 3, 4, 5, 6, 7); } } \
    __builtin_amdgcn_sched_barrier(0); \
    _Pragma("unroll") for (int ks = 0; ks < 2; ++ks) { _Pragma("unroll") for (int bq = 0; bq < 2; ++bq) osum[bq] = MFMA16(ones, PA[ks][bq], osum[bq]); } \
    _Pragma("unroll") for (int d = 0; d < 4; ++d) { _Pragma("unroll") for (int bq = 0; bq < 2; ++bq) { _Pragma("unroll") for (int ks = 0; ks < 2; ++ks) \
      o[d][bq] = MFMA16(vf[ks][d], PA[ks][bq], o[d][bq]); } } } while (0)

  float m_run[2];
  m_run[0] = m_run[1] = SWA ? p.swa_sink[layer * 6 + h] * 1.4426950408889634f : 0.f;
  f32x4v S[4][2], o[4][2], osum[2], negm[2];
#pragma unroll
  for (int bq = 0; bq < 2; ++bq) {
    const float i1 = SWA ? 1.f : 0.f;
    osum[bq] = (f32x4v){i1, i1, i1, i1}; negm[bq] = (f32x4v){-m_run[bq], -m_run[bq], -m_run[bq], -m_run[bq]};
#pragma unroll
    for (int d = 0; d < 4; ++d) o[d][bq] = (f32x4v){0.f, 0.f, 0.f, 0.f};
  }
  bf16x8 ones;
#pragma unroll
  for (int i = 0; i < 8; ++i) ones[i] = (short)0x3F80;
  bf16x8 pa[2][2];
  A6_ISSUE(0, 0);
  asm volatile("s_waitcnt vmcnt(0)" ::: "memory");
  __syncthreads();
  A6_ISSUE(1, 1);
  A6_QK(lds);
  { int wst = 0, pos0v = 0; A6_SOFTMAX(pa, wst, pos0v, !SWA, true); }
  bool cur_skip = false;
#pragma unroll 1
  for (int j = 0; j < T - 1; ++j) {
    asm volatile("s_waitcnt vmcnt(0)" ::: "memory");
    __syncthreads();
    if (j + 2 < T) A6_ISSUE(j + 2, (j + 2) % 3);
    const LAS char* sbn = lds + ((j + 1) % 3) * AT_STAGE;
    const LAS char* sbc = lds + (j % 3) * AT_STAGE;
    int wst, pos0v; A6_WSTATE(j + 1, pos0v, wst);
    if (!SWA || wst != 2) A6_QK(sbn);
    if (!SWA || !cur_skip) A6_PV(sbc, pa);
    if (!SWA || wst != 2) {
      bf16x8 pn[2][2];
      A6_SOFTMAX(pn, wst, pos0v, false, (SWA || (j & 7) == 7));
      pa[0][0] = pn[0][0]; pa[0][1] = pn[0][1]; pa[1][0] = pn[1][0]; pa[1][1] = pn[1][1];
      cur_skip = false;
    } else cur_skip = true;
  }
  if (!SWA || !cur_skip) { const LAS char* sbc = lds + ((T - 1) % 3) * AT_STAGE; A6_PV(sbc, pa); }
#undef A6_ISSUE
#undef A6_QK
#undef A6_WSTATE
#undef A6_SOFTMAX
#undef A6_PV
#pragma unroll
  for (int bq = 0; bq < 2; ++bq) {
    const float inv = 1.f / osum[bq][0];
    u16* yp = (u16*)(ws + OFF_Y) + (size_t)(qrow0 + wid * 32 + bq * 16 + c16) * 1024 + ycol + 4 * g;
#pragma unroll
    for (int d = 0; d < 4; ++d) {
      u32x2_t w; w[0] = cvtpk(o[d][bq][0] * inv, o[d][bq][1] * inv); w[1] = cvtpk(o[d][bq][2] * inv, o[d][bq][3] * inv);
      *(u32x2_t*)(yp + d * 16) = w;
    }
  }
  __syncthreads();
}

DI void p3_attention(const Params& p, int layer, LAS char* lds, int cs = 0) {
  unsigned* ctr8 = (unsigned*)(p.ws + OFF_CTRL) + CW_Q + (layer * 2 + 0) * 512;
  const int per_q = 512 + (layer == 0 ? 32 : 0);
  for (;;) {
    const int u = next_unit_xcd(ctr8, per_q, lds);
    if (u < 0) break;
    const int b = u / per_q, v = u % per_q;
    if (v < 128) { attn_unit16<true, false>(p, layer, 0, b, v >> 5, v & 31, lds); }
    else if (v < 320) { const int w = v - 128; attn_unit16<false, false>(p, layer, 0, b, w >> 5, w & 31, lds); }
    else if (v < 512) { const int w = v - 320; attn_unit16<false, true>(p, layer, 0, b, w >> 5, w & 31, lds); }
    else {
      const int w = v - 512;
      if (w < 8) attn_unit16<true, false>(p, layer, 1, b, w >> 1, w & 1, lds);
      else if (w < 20) { const int x = w - 8; attn_unit16<false, false>(p, layer, 1, b, x >> 1, x & 1, lds); }
      else { const int x = w - 20; attn_unit16<false, true>(p, layer, 1, b, x >> 1, x & 1, lds); }
    }
  }
}

struct AttnArgs {
  const u16* Q; const u16* K; const u16* K2; const u16* V; u16* Y; const float* sink;
  int ldq, ldk, ldk2, ldv, ldy, ycol, G, window, q_is_ctx; float scale;
};
static_assert(sizeof(AttnArgs) == 88, "no padding");
template <int DK1, int DK2>
__global__ __launch_bounds__(64) void k_attn(AttnArgs a) {
  const int qt = blockIdx.x * 64 + threadIdx.x, b = blockIdx.y, h = blockIdx.z, kvh = h / a.G;
  const int qrow = a.q_is_ctx ? NL + b * C_ + qt : b * S_ + qt;
  float q[DK1 + DK2];
  {
    const uint4* qp = (const uint4*)(a.Q + (size_t)qrow * a.ldq + h * (DK1 + DK2));
#pragma unroll
    for (int i = 0; i < (DK1 + DK2) / 8; ++i) {
      uint4 u = qp[i];
      q[i * 8 + 0] = bflo(u.x) * a.scale; q[i * 8 + 1] = bfhi(u.x) * a.scale; q[i * 8 + 2] = bflo(u.y) * a.scale; q[i * 8 + 3] = bfhi(u.y) * a.scale;
      q[i * 8 + 4] = bflo(u.z) * a.scale; q[i * 8 + 5] = bfhi(u.z) * a.scale; q[i * 8 + 6] = bflo(u.w) * a.scale; q[i * 8 + 7] = bfhi(u.w) * a.scale;
    }
  }
  float m, l, o[64];
  if (a.sink) { m = a.sink[h]; l = 1.f; } else { m = -1e30f; l = 0.f; }
#pragma unroll
  for (int d = 0; d < 64; ++d) o[d] = 0.f;
  const int nseg = a.q_is_ctx ? 1 : 2;
  for (int seg = 0; seg < nseg; ++seg) {
    int lo, hi, rbase; bool masked = false;
    if (seg == 0) { lo = 0; hi = C_; rbase = NL + b * C_; }
    else {
      lo = 0; hi = S_; rbase = b * S_;
      if (a.window) { int t0 = blockIdx.x * 64; lo = t0 - a.window; if (lo < 0) lo = 0; hi = t0 + 64 + a.window; if (hi > S_) hi = S_; masked = true; }
    }
    for (int s = lo; s < hi; s += 4) {
      float sc[4];
#pragma unroll
      for (int i = 0; i < 4; ++i) {
        const uint4* kp = (const uint4*)(a.K + (size_t)(rbase + s + i) * a.ldk + kvh * DK1);
        float dot = 0.f;
#pragma unroll
        for (int c = 0; c < DK1 / 8; ++c) {
          uint4 u = kp[c];
          dot += q[c * 8 + 0] * bflo(u.x) + q[c * 8 + 1] * bfhi(u.x) + q[c * 8 + 2] * bflo(u.y) + q[c * 8 + 3] * bfhi(u.y)
               + q[c * 8 + 4] * bflo(u.z) + q[c * 8 + 5] * bfhi(u.z) + q[c * 8 + 6] * bflo(u.w) + q[c * 8 + 7] * bfhi(u.w);
        }
        if (DK2 > 0) {
          const uint4* kp2 = (const uint4*)(a.K2 + (size_t)(rbase + s + i) * a.ldk2);
#pragma unroll
          for (int c = 0; c < DK2 / 8; ++c) {
            uint4 u = kp2[c];
            dot += q[DK1 + c * 8 + 0] * bflo(u.x) + q[DK1 + c * 8 + 1] * bfhi(u.x) + q[DK1 + c * 8 + 2] * bflo(u.y) + q[DK1 + c * 8 + 3] * bfhi(u.y)
                 + q[DK1 + c * 8 + 4] * bflo(u.z) + q[DK1 + c * 8 + 5] * bfhi(u.z) + q[DK1 + c * 8 + 6] * bflo(u.w) + q[DK1 + c * 8 + 7] * bfhi(u.w);
          }
        }
        if (masked) { int dlt = qt - (s + i); if (dlt < 0) dlt = -dlt; if (dlt > a.window) dot = -1e30f; }
        sc[i] = dot;
      }
      float mx = fmaxf(fmaxf(fmaxf(sc[0], sc[1]), fmaxf(sc[2], sc[3])), m);
      const float alpha = __expf(m - mx);
      float pr[4];
#pragma unroll
      for (int i = 0; i < 4; ++i) pr[i] = __expf(sc[i] - mx);
      l = l * alpha + (pr[0] + pr[1]) + (pr[2] + pr[3]);
      m = mx;
#pragma unroll
      for (int d = 0; d < 64; ++d) o[d] *= alpha;
#pragma unroll
      for (int i = 0; i < 4; ++i) {
        const uint4* vp = (const uint4*)(a.V + (size_t)(rbase + s + i) * a.ldv + kvh * 64);
#pragma unroll
        for (int c = 0; c < 8; ++c) {
          uint4 u = vp[c];
          o[c * 8 + 0] += pr[i] * bflo(u.x); o[c * 8 + 1] += pr[i] * bfhi(u.x); o[c * 8 + 2] += pr[i] * bflo(u.y); o[c * 8 + 3] += pr[i] * bfhi(u.y);
          o[c * 8 + 4] += pr[i] * bflo(u.z); o[c * 8 + 5] += pr[i] * bfhi(u.z); o[c * 8 + 6] += pr[i] * bflo(u.w); o[c * 8 + 7] += pr[i] * bfhi(u.w);
        }
      }
    }
  }
  const float inv = 1.f / l;
  uint4* yp = (uint4*)(a.Y + (size_t)qrow * a.ldy + a.ycol + h * 64);
#pragma unroll
  for (int c = 0; c < 8; ++c) {
    uint4 u;
    u.x = cvtpk(o[c * 8 + 0] * inv, o[c * 8 + 1] * inv); u.y = cvtpk(o[c * 8 + 2] * inv, o[c * 8 + 3] * inv);
    u.z = cvtpk(o[c * 8 + 4] * inv, o[c * 8 + 5] * inv); u.w = cvtpk(o[c * 8 + 6] * inv, o[c * 8 + 7] * inv);
    yp[c] = u;
  }
}


constexpr int CW_BAR = 1024;
#define XB_TMO      128
#define XB_XCNT(j)  (256  + 64 * (j))
#define XB_XSUB(j)  (1280 + 64 * (j))
#define XB_XGEN(j)  (2304 + 64 * (j))
#define XB_TOP      3328
#define XB_TOPGEN   3392
#define XCD_BAR_WORDS 3456
#define XB_SPIN_CAP (1u << 22)
DI unsigned xb_ld(unsigned* p) { return __hip_atomic_load(p, __ATOMIC_RELAXED, __HIP_MEMORY_SCOPE_AGENT); }
DI unsigned xb_add(unsigned* p, unsigned v) { return __hip_atomic_fetch_add(p, v, __ATOMIC_RELAXED, __HIP_MEMORY_SCOPE_AGENT); }
DI unsigned xb_xcc_id() { return (unsigned)__builtin_amdgcn_s_getreg((3 << 11) | 20) & 0xFu; }
#define XB_SPIN(cond, bar) do { unsigned _sp = 0; while (cond) { __builtin_amdgcn_s_sleep(1); \
    if ((++_sp & 255u) == 0u) { if (xb_ld(&(bar)[XB_TMO])) break; if (_sp > XB_SPIN_CAP) { atomicAdd(&(bar)[XB_TMO], 1u); break; } } } } while (0)
struct XcdBarrier { unsigned* bar; unsigned x; volatile LAS unsigned* st; };
DI XcdBarrier xcd_barrier_post(unsigned* bar, volatile LAS unsigned* st) {
  XcdBarrier b; b.bar = bar; b.x = xb_xcc_id(); b.st = st;
  if (threadIdx.x == 0) (void)xb_add(&bar[XB_XCNT(b.x)], 1u);
  return b;
}
DI void xcd_barrier_complete(unsigned* bar, unsigned x, unsigned& nloc, unsigned& nx) {
  const unsigned G = gridDim.x * gridDim.y * gridDim.z;
  unsigned sum, cnt, mine, sp = 0u;
  for (;;) {
    sum = 0u; cnt = 0u; mine = 0u;
#pragma unroll
    for (unsigned j = 0; j < 16; ++j) { const unsigned c = xb_ld(&bar[XB_XCNT(j)]); sum += c; cnt += (c > 0u) ? 1u : 0u; mine = (j == x) ? c : mine; }
    if (sum == G) break;
    __builtin_amdgcn_s_sleep(1);
    if ((++sp & 255u) == 0u) { if (xb_ld(&bar[XB_TMO])) break; if (sp > XB_SPIN_CAP) { atomicAdd(&bar[XB_TMO], 1u); break; } }
  }
  nloc = mine > 0u ? mine : 1u; nx = cnt > 0u ? cnt : 1u;
}
DI void xcd_barrier(const XcdBarrier& b) {
  asm volatile("s_waitcnt vmcnt(0)" ::: "memory");
  __syncthreads();
  if (threadIdx.x == 0) {
    unsigned* bar = b.bar;
    __builtin_amdgcn_s_waitcnt(0);
    unsigned nloc = b.st[0], nx = b.st[1];
    if (nloc == 0u) { xcd_barrier_complete(bar, b.x, nloc, nx); b.st[0] = nloc; b.st[1] = nx; }
    const unsigned old = xb_add(&bar[XB_XSUB(b.x)], 1u);
    const unsigned gen = old / nloc;
    if (old + 1u == (gen + 1u) * nloc) {
      __builtin_amdgcn_fence(__ATOMIC_RELEASE, "agent");
      asm volatile("s_waitcnt vmcnt(0)" ::: "memory");
      const unsigned og = xb_add(&bar[XB_TOP], 1u);
      const unsigned tg = og / nx;
      if (og + 1u == (tg + 1u) * nx) xb_add(&bar[XB_TOPGEN], 1u);
      else XB_SPIN(xb_ld(&bar[XB_TOPGEN]) == tg, bar);
      __builtin_amdgcn_fence(__ATOMIC_ACQUIRE, "agent");
      xb_add(&bar[XB_XGEN(b.x)], 1u);
      asm volatile("s_waitcnt vmcnt(0)" ::: "memory");
    } else {
      XB_SPIN(xb_ld(&bar[XB_XGEN(b.x)]) == gen, bar);
      __builtin_amdgcn_fence(__ATOMIC_ACQUIRE, "agent");
      asm volatile("s_waitcnt vmcnt(0)" ::: "memory");
    }
  }
  __syncthreads();
}

__global__ __launch_bounds__(NTHR, 2) void k_mega(Params p) {
  extern __shared__ __attribute__((aligned(16))) unsigned char smem[];
  LAS char* lds = (LAS char*)smem;
  if (p.never) cooperative_groups::this_grid().sync();
  volatile LAS unsigned* st = (volatile LAS unsigned*)(lds + LDS_MISC + 3584);
  if (threadIdx.x < 4) st[threadIdx.x] = 0u;
  __syncthreads();
  XcdBarrier bar = xcd_barrier_post((unsigned*)(p.ws + OFF_CTRL) + CW_BAR, st);
#ifdef PROBE_SEG
  unsigned long long t_acc = 0ull, t_s = 0ull;
#define SEG_BEGIN(id) do { if ((id) == PROBE_SEG && blockIdx.x == 0 && threadIdx.x == 0) t_s = __builtin_amdgcn_s_memrealtime(); } while (0)
#define SEG_END(id) do { if ((id) == PROBE_SEG && blockIdx.x == 0 && threadIdx.x == 0) t_acc += __builtin_amdgcn_s_memrealtime() - t_s; } while (0)
#else
#define SEG_BEGIN(id) do {} while (0)
#define SEG_END(id) do {} while (0)
#endif
  SEG_BEGIN(0); p0_prologue(p, lds); xcd_barrier(bar); SEG_END(0);
  SEG_BEGIN(1); p1_norm_mix(p, 0); xcd_barrier(bar); SEG_END(1);
#pragma unroll 1
  for (int l = 0; l < 2; ++l) {
    const int nrows = l == 0 ? NT : NL;
    SEG_BEGIN(2 + 10 * l); p2_inproj(p, l, lds); xcd_barrier(bar); SEG_END(2 + 10 * l);
    SEG_BEGIN(3 + 10 * l); p3_attention(p, l, lds); xcd_barrier(bar); SEG_END(3 + 10 * l);
    SEG_BEGIN(4 + 10 * l); p4_outproj(p, l, nrows, lds); xcd_barrier(bar); SEG_END(4 + 10 * l);
    SEG_BEGIN(5 + 10 * l); p5_norm_ffn(p, l, nrows, lds); xcd_barrier(bar); SEG_END(5 + 10 * l);
    SEG_BEGIN(6 + 10 * l); p6_gateup(p, l, nrows, lds); xcd_barrier(bar); SEG_END(6 + 10 * l);
    SEG_BEGIN(7 + 10 * l); p7_down(p, l, nrows, lds); xcd_barrier(bar); SEG_END(7 + 10 * l);
    SEG_BEGIN(8 + 10 * l); p8_combine(p, l, nrows); if (l == 0) xcd_barrier(bar); SEG_END(8 + 10 * l);
  }
#ifdef PROBE_SEG
  if (blockIdx.x == 0 && threadIdx.x == 0) {
    const unsigned long long t0 = __builtin_amdgcn_s_memrealtime();
    while (__builtin_amdgcn_s_memrealtime() - t0 < 9ull * t_acc) __builtin_amdgcn_s_sleep(8);
  }
#endif
}

template <int PH>
__global__ __launch_bounds__(NTHR, 2) void k_phase(Params p, int layer, int nrows) {
  extern __shared__ __attribute__((aligned(16))) unsigned char smem[];
  LAS char* lds = (LAS char*)smem;
  if (PH == 0) p0_prologue(p, lds);
  if (PH == 1) p1_norm_mix(p, layer);
  if (PH == 2) p2_inproj(p, layer, lds);
  if (PH == 3) p3_attention(p, layer, lds);
  if (PH == 4) p4_outproj(p, layer, nrows, lds);
  if (PH == 5) p5_norm_ffn(p, layer, nrows, lds);
  if (PH == 6) p6_gateup(p, layer, nrows, lds);
  if (PH == 7) p7_down(p, layer, nrows, lds);
  if (PH == 8) p8_combine(p, layer, nrows);
}

extern "C" void kernel_launch(void* const* d_in, const int* in_sizes, int n_in, void* d_out, int out_size, void* d_ws, size_t ws_size, hipStream_t stream) {
  Params p{};
  p.x = (const float*)d_in[0]; p.c = (const float*)d_in[1]; p.ctx = (const float*)d_in[2]; p.c_ctx = (const float*)d_in[3];
  p.w_mod = (const float*)d_in[4]; p.b_mod = (const float*)d_in[5]; p.norm_mix_g = (const float*)d_in[6]; p.norm_ffn_g = (const float*)d_in[7];
  p.w_in = (const float*)d_in[8]; p.w_out = (const float*)d_in[9]; p.swa_sink = (const float*)d_in[10]; p.glb_q_gain = (const float*)d_in[11];
  p.glb_k_gain = (const float*)d_in[12]; p.mla_q_gain = (const float*)d_in[13]; p.mla_w_uq = (const float*)d_in[14]; p.mla_kv_gain = (const float*)d_in[15];
  p.mla_w_ukv = (const float*)d_in[16]; p.router_w = (const float*)d_in[17]; p.router_bias = (const float*)d_in[18]; p.exp_w_gate = (const float*)d_in[19];
  p.exp_w_up = (const float*)d_in[20]; p.exp_w_down = (const float*)d_in[21]; p.shr_w_gate = (const float*)d_in[22]; p.shr_w_up = (const float*)d_in[23];
  p.shr_w_down = (const float*)d_in[24]; p.final_norm_g = (const float*)d_in[25];
  p.out = (float*)d_out; p.ws = (char*)d_ws;
  char* ws = (char*)d_ws;

#ifndef MEGA
#define MEGA 1
#endif
#if MEGA
  static int grid_blocks = 0;
  if (!grid_blocks) {
    (void)hipFuncSetAttribute((const void*)k_mega, hipFuncAttributeMaxDynamicSharedMemorySize, LDS_BYTES);
    int dev = 0, cus = 0, per_cu = 0;
    (void)hipGetDevice(&dev);
    (void)hipDeviceGetAttribute(&cus, hipDeviceAttributeMultiprocessorCount, dev);
    (void)hipOccupancyMaxActiveBlocksPerMultiprocessor(&per_cu, (const void*)k_mega, NTHR, LDS_BYTES);
    if (per_cu > 2) per_cu = 2;
    if (per_cu < 1) per_cu = 1;
    grid_blocks = cus * per_cu;
  }
  (void)hipMemsetAsync(ws + OFF_CTRL, 0, CTRL_BYTES, stream);
  void* args[] = {&p};
  hipError_t e = hipLaunchCooperativeKernel((const void*)k_mega, dim3(grid_blocks), dim3(NTHR), args, LDS_BYTES, stream);
  if (e != hipSuccess) fprintf(stderr, "cooperative launch failed: %s (grid %d)\n", hipGetErrorString(e), grid_blocks);
#else
  static bool attr_done = false;
  if (!attr_done) {
    (void)hipFuncSetAttribute((const void*)k_phase<0>, hipFuncAttributeMaxDynamicSharedMemorySize, LDS_BYTES);
    (void)hipFuncSetAttribute((const void*)k_phase<1>, hipFuncAttributeMaxDynamicSharedMemorySize, LDS_BYTES);
    (void)hipFuncSetAttribute((const void*)k_phase<2>, hipFuncAttributeMaxDynamicSharedMemorySize, LDS_BYTES);
    (void)hipFuncSetAttribute((const void*)k_phase<3>, hipFuncAttributeMaxDynamicSharedMemorySize, LDS_BYTES);
    (void)hipFuncSetAttribute((const void*)k_phase<4>, hipFuncAttributeMaxDynamicSharedMemorySize, LDS_BYTES);
    (void)hipFuncSetAttribute((const void*)k_phase<5>, hipFuncAttributeMaxDynamicSharedMemorySize, LDS_BYTES);
    (void)hipFuncSetAttribute((const void*)k_phase<6>, hipFuncAttributeMaxDynamicSharedMemorySize, LDS_BYTES);
    (void)hipFuncSetAttribute((const void*)k_phase<7>, hipFuncAttributeMaxDynamicSharedMemorySize, LDS_BYTES);
    (void)hipFuncSetAttribute((const void*)k_phase<8>, hipFuncAttributeMaxDynamicSharedMemorySize, LDS_BYTES);
    attr_done = true;
  }

  (void)hipMemsetAsync(ws + OFF_CTRL, 0, CTRL_BYTES, stream);
  k_phase<0><<<GRID, NTHR, LDS_BYTES, stream>>>(p, 0, 0);
  k_phase<1><<<GRID, NTHR, LDS_BYTES, stream>>>(p, 0, NT);
  for (int l = 0; l < 2; ++l) {
    const bool last = (l == 1);
    const int Mres = last ? NL : NT;
    k_phase<2><<<GRID, NTHR, LDS_BYTES, stream>>>(p, l, NT);
    k_phase<3><<<GRID, NTHR, LDS_BYTES, stream>>>(p, l, NT);
    k_phase<4><<<GRID, NTHR, LDS_BYTES, stream>>>(p, l, Mres);
    k_phase<5><<<GRID, NTHR, LDS_BYTES, stream>>>(p, l, Mres);
    k_phase<6><<<GRID, NTHR, LDS_BYTES, stream>>>(p, l, Mres);
    k_phase<7><<<GRID, NTHR, LDS_BYTES, stream>>>(p, l, Mres);
    k_phase<8><<<GRID, NTHR, LDS_BYTES, stream>>>(p, l, Mres);
  }
#endif
}
```

```cpp
#include <hip/hip_runtime.h>
#include <hip/hip_cooperative_groups.h>
#include <cstdio>
#include <stdint.h>
#include <stddef.h>

typedef unsigned short u16;
typedef short bf16x8 __attribute__((ext_vector_type(8)));
typedef float f32x4 __attribute__((ext_vector_type(4)));
typedef float f32x2_t __attribute__((ext_vector_type(2)));
typedef __bf16 bf16x2_t __attribute__((ext_vector_type(2)));
typedef unsigned u32x2_t __attribute__((ext_vector_type(2)));
typedef unsigned u32x4_t __attribute__((ext_vector_type(4)));
#define DI __device__ __forceinline__
#define LAS __attribute__((address_space(3)))

constexpr int B_ = 8, S_ = 4096, D_ = 1024, C_ = 256;
constexpr int NL = B_ * S_, NC = B_ * C_, NT = NL + NC;
constexpr int INW = 1696, INWP = 1792;
constexpr int NE = 16;
constexpr int MAXSLOT = NT * 2 + NE * 128;
constexpr float EPS = 1e-6f;
constexpr int NTHR = 256;
constexpr int GRID = 512;

DI float bf2f(u16 v) { return __uint_as_float(((unsigned)v) << 16); }
DI float bflo(unsigned u) { return __uint_as_float(u << 16); }
DI float bfhi(unsigned u) { return __uint_as_float(u & 0xffff0000u); }
DI unsigned cvtpk(float lo, float hi) { f32x2_t v = {lo, hi}; bf16x2_t b = __builtin_convertvector(v, bf16x2_t); return __builtin_bit_cast(unsigned, b); }
template <int CTRL> DI float dpp_mov(float v) { return __int_as_float(__builtin_amdgcn_update_dpp(0, __float_as_int(v), CTRL, 0xf, 0xf, false)); }
DI float wave_sum(float v) {
  v += dpp_mov<0xB1>(v);
  v += dpp_mov<0x4E>(v);
  v += dpp_mov<0x141>(v);
  v += dpp_mov<0x140>(v);
  { auto rr = __builtin_amdgcn_permlane16_swap(__float_as_uint(v), __float_as_uint(v), false, false); v = __uint_as_float(rr[0]) + __uint_as_float(rr[1]); }
  { auto rr = __builtin_amdgcn_permlane32_swap(__float_as_uint(v), __float_as_uint(v), false, false); v = __uint_as_float(rr[0]) + __uint_as_float(rr[1]); }
  return v;
}
DI float silu(float g) { return g / (1.f + __expf(-g)); }
DI int opaque(int v) { asm volatile("" : "+v"(v)); return v; }

constexpr size_t al256(size_t x) { return (x + 255) & ~(size_t)255; }
constexpr size_t OFF_CTRL = 0;
constexpr size_t CTRL_BYTES = 65536;
constexpr size_t OFF_CTXR = OFF_CTRL + CTRL_BYTES;
constexpr size_t OFF_MOD = OFF_CTXR + al256((size_t)NC * D_ * 4);
constexpr size_t OFF_TOKE = OFF_MOD + al256((size_t)2 * 9 * 6144 * 4);
constexpr size_t OFF_TOKW = OFF_TOKE + al256((size_t)NT * 2 * 4);
constexpr size_t OFF_TOKP = OFF_TOKW + al256((size_t)NT * 2 * 4);
constexpr size_t OFF_LIST = OFF_TOKP + al256((size_t)NT * 2 * 4);
constexpr size_t OFF_WIN = OFF_LIST + al256((size_t)NE * NT * 4);
constexpr size_t OFF_WO = OFF_WIN + (size_t)2 * INWP * 1024 * 2;
constexpr size_t OFF_WUQ = OFF_WO + (size_t)2 * 1024 * 1024 * 2;
constexpr size_t OFF_WUKV = OFF_WUQ + (size_t)2 * 384 * 256 * 2;
constexpr size_t OFF_WGU = OFF_WUKV + (size_t)2 * 512 * 128 * 2;
constexpr size_t OFF_WD = OFF_WGU + (size_t)2 * 16 * 1024 * 1024 * 2;
constexpr size_t OFF_SGU = OFF_WD + (size_t)2 * 16 * 1024 * 512 * 2;
constexpr size_t OFF_SD = OFF_SGU + (size_t)2 * 1024 * 1024 * 2;
constexpr size_t OFF_H = OFF_SD + (size_t)2 * 1024 * 512 * 2;
constexpr size_t OFF_BIG = OFF_H + (size_t)NT * 1024 * 2;
constexpr size_t OFF_SWQ = OFF_BIG;
constexpr size_t OFF_SWK = OFF_SWQ + (size_t)NT * 384 * 2;
constexpr size_t OFF_SWV = OFF_SWK + (size_t)NT * 128 * 2;
constexpr size_t OFF_GLQ = OFF_SWV + (size_t)NT * 128 * 2;
constexpr size_t OFF_GLK = OFF_GLQ + (size_t)NT * 384 * 2;
constexpr size_t OFF_GLV = OFF_GLK + (size_t)NT * 128 * 2;
constexpr size_t OFF_MLQ = OFF_GLV + (size_t)NT * 128 * 2;
constexpr size_t OFF_MLK = OFF_MLQ + (size_t)NT * 384 * 2;
constexpr size_t OFF_MLKR = OFF_MLK + (size_t)NT * 256 * 2;
constexpr size_t OFF_MLV = OFF_MLKR + (size_t)NT * 32 * 2;
constexpr size_t OFF_QLAT = OFF_MLV + (size_t)NT * 256 * 2;
constexpr size_t OFF_KVLAT = OFF_QLAT + (size_t)NT * 256 * 2;
constexpr size_t OFF_Y = OFF_KVLAT + (size_t)NT * 128 * 2;
constexpr size_t END_A = OFF_Y + (size_t)NT * 1024 * 2;
constexpr size_t OFF_ACT = OFF_BIG;
constexpr size_t OFF_ACTS = OFF_ACT + (size_t)MAXSLOT * 512 * 2;
constexpr size_t OFF_YEXP = OFF_ACTS + (size_t)NT * 512 * 2;
constexpr size_t END_B = OFF_YEXP + (size_t)MAXSLOT * 1024 * 2;
constexpr size_t OFF_YSH = OFF_H;
constexpr size_t OFF_DELTA = OFF_SWQ;
static_assert(OFF_DELTA + (size_t)NT * 1024 * 2 <= OFF_MLQ, "DELTA must fit below MLQ");
constexpr size_t OFF_XB = al256(END_A > END_B ? END_A : END_B);
constexpr size_t WS_NEED = OFF_XB + (size_t)NT * 1024 * 2;
static_assert(WS_NEED <= (size_t)536870912, "workspace too large");

constexpr int CW_CTR = 0;
constexpr int CW_CNT = 8192;
constexpr int CW_Q = 10240;

struct Params {
  const float *x, *c, *ctx, *c_ctx, *w_mod, *b_mod, *norm_mix_g, *norm_ffn_g, *w_in, *w_out, *swa_sink, *glb_q_gain, *glb_k_gain,
      *mla_q_gain, *mla_w_uq, *mla_kv_gain, *mla_w_ukv, *router_w, *router_bias, *exp_w_gate, *exp_w_up, *exp_w_down, *shr_w_gate,
      *shr_w_up, *shr_w_down, *final_norm_g;
  float* out;
  char* ws;
  int never; int pad;
};

constexpr int LDS_MISC = 65536;
constexpr int LDS_BYTES = 65536 + 8192;

DI int next_unit(unsigned* ctr, LAS char* lds) {
  volatile LAS int* slot = (volatile LAS int*)(lds + LDS_MISC + 2560);
  __syncthreads();
  if (threadIdx.x == 0) *slot = (int)atomicAdd(ctr, 1u);
  __syncthreads();
  return *slot;
}

DI unsigned xcc_id_() { return (unsigned)__builtin_amdgcn_s_getreg((3 << 11) | 20) & 0x7u; }
DI int next_unit_xcd(unsigned* ctr8, int per_queue, LAS char* lds) {
  volatile LAS int* slot = (volatile LAS int*)(lds + LDS_MISC + 2560);
  __syncthreads();
  if (threadIdx.x == 0) {
    const int q0 = (int)xcc_id_();
    int res = -1;
    for (int i = 0; i < 8; ++i) {
      const int q = (q0 + i) & 7;
      const int v = (int)atomicAdd(&ctr8[q * 64], 1u);
      if (v < per_queue) { res = q * per_queue + v; break; }
    }
    *slot = res;
  }
  __syncthreads();
  return *slot;
}
DI void cvt_job(const float* __restrict__ src, int ld, int N, int k0, int n0, u16* __restrict__ dst, int K, int mode  , LAS char* lds) {
  LAS float* T = (LAS float*)lds;
  const int tid = threadIdx.x;
  __syncthreads();
  {
    const int kk = tid >> 2, nq = (tid & 3) * 32;
    const float* s = src + (size_t)(k0 + kk) * ld + n0 + nq;
#pragma unroll
    for (int i = 0; i < 8; ++i) {
      float4 v = make_float4(0.f, 0.f, 0.f, 0.f);
      if (n0 + nq + i * 4 < N) v = *(const float4*)(s + i * 4);
      LAS float* t = T + kk * 129 + nq + i * 4;
      t[0] = v.x; t[1] = v.y; t[2] = v.z; t[3] = v.w;
    }
  }
  __syncthreads();
#pragma unroll
  for (int i = 0; i < 4; ++i) {
    const int chn = tid + i * 256;
    const int n = chn >> 3, kc = (chn & 7) * 8;
    if (n0 + n < N) {
      const LAS float* t = T + kc * 129 + n;
      uint4 o;
      o.x = cvtpk(t[0], t[129]); o.y = cvtpk(t[2 * 129], t[3 * 129]); o.z = cvtpk(t[4 * 129], t[5 * 129]); o.w = cvtpk(t[6 * 129], t[7 * 129]);
      const int gn = n0 + n;
      int drow = gn;
      if (mode) drow = (gn >> 5) * 64 + (gn & 31) + (mode == 2 ? 32 : 0);
      *(uint4*)(dst + (size_t)drow * K + k0 + kc) = o;
    }
  }
}

DI void mod_job(const Params& p, int l, int j0, LAS char* lds) {
  LAS float* sc = (LAS float*)lds;
  LAS float* red = (LAS float*)(lds + 36864);
  const int tid = threadIdx.x;
  __syncthreads();
  for (int i = tid; i < 9 * 1024; i += NTHR) {
    int r = i >> 10, k = i & 1023;
    float v = r < 8 ? p.c[r * 1024 + k] : p.c_ctx[k];
    sc[i] = v / (1.f + __expf(-v));
  }
  __syncthreads();
  const int col = tid & 31, kg = tid >> 5;
  float acc[9];
#pragma unroll
  for (int r = 0; r < 9; ++r) acc[r] = 0.f;
  const float* w = p.w_mod + (size_t)l * 1024 * 6144 + (size_t)(kg * 128) * 6144 + j0 + col;
#pragma unroll 1
  for (int k0 = 0; k0 < 128; k0 += 16) {
    float wv[16];
#pragma unroll
    for (int u = 0; u < 16; ++u) wv[u] = w[(size_t)(k0 + u) * 6144];
#pragma unroll
    for (int u = 0; u < 16; ++u)
#pragma unroll
      for (int r = 0; r < 9; ++r) acc[r] += sc[r * 1024 + kg * 128 + k0 + u] * wv[u];
  }
#pragma unroll
  for (int r = 0; r < 9; ++r) red[(kg * 9 + r) * 32 + col] = acc[r];
  __syncthreads();
  float* MOD = (float*)(p.ws + OFF_MOD);
  for (int i = tid; i < 9 * 32; i += NTHR) {
    int r = i >> 5, cc = i & 31;
    float sum = 0.f;
#pragma unroll
    for (int g = 0; g < 8; ++g) sum += red[(g * 9 + r) * 32 + cc];
    MOD[(size_t)(l * 9 + r) * 6144 + j0 + cc] = sum + p.b_mod[l * 6144 + j0 + cc];
  }
}

constexpr int J_WIN = 16 * 14, J_WO = 16 * 8, J_UQ = 4 * 3, J_UKV = 2 * 4, J_EG = 16 * 4, J_ED = 8 * 8;
constexpr int J_DENSE = J_WIN + J_WO + J_UQ + J_UKV;
constexpr int J_EXP = 16 * (2 * J_EG + J_ED);
constexpr int J_SHR = 2 * J_EG + J_ED;
constexpr int J_LAYER = J_DENSE + J_EXP + J_SHR;
constexpr int J_MOD = 2 * 192;
constexpr int J_TOTAL = 2 * J_LAYER + J_MOD;

DI void p0_prologue(const Params& p, LAS char* lds) {
  char* ws = p.ws;
  for (int job = blockIdx.x; job < J_TOTAL; job += gridDim.x) {
    if (job < J_MOD) { mod_job(p, job / 192, (job % 192) * 32, lds); continue; }
    int r = job - J_MOD;
    const int l = r / J_LAYER; r -= l * J_LAYER;
    if (r < J_WIN) { cvt_job(p.w_in + (size_t)l * 1024 * INW, INW, INW, (r / 14) * 64, (r % 14) * 128, (u16*)(ws + OFF_WIN) + (size_t)l * INWP * 1024, 1024, 0, lds); continue; } r -= J_WIN;
    if (r < J_WO) { cvt_job(p.w_out + (size_t)l * 1024 * 1024, 1024, 1024, (r / 8) * 64, (r % 8) * 128, (u16*)(ws + OFF_WO) + (size_t)l * 1024 * 1024, 1024, 0, lds); continue; } r -= J_WO;
    if (r < J_UQ) { cvt_job(p.mla_w_uq + (size_t)l * 256 * 384, 384, 384, (r / 3) * 64, (r % 3) * 128, (u16*)(ws + OFF_WUQ) + (size_t)l * 384 * 256, 256, 0, lds); continue; } r -= J_UQ;
    if (r < J_UKV) { cvt_job(p.mla_w_ukv + (size_t)l * 128 * 512, 512, 512, (r / 4) * 64, (r % 4) * 128, (u16*)(ws + OFF_WUKV) + (size_t)l * 512 * 128, 128, 0, lds); continue; } r -= J_UKV;
    if (r < J_EXP) {
      const int e = r / (2 * J_EG + J_ED); int q = r % (2 * J_EG + J_ED);
      const size_t le = (size_t)l * NE + e;
      if (q < J_EG) { cvt_job(p.exp_w_gate + le * 1024 * 512, 512, 512, (q / 4) * 64, (q % 4) * 128, (u16*)(ws + OFF_WGU) + le * 1024 * 1024, 1024, 1, lds); continue; } q -= J_EG;
      if (q < J_EG) { cvt_job(p.exp_w_up + le * 1024 * 512, 512, 512, (q / 4) * 64, (q % 4) * 128, (u16*)(ws + OFF_WGU) + le * 1024 * 1024, 1024, 2, lds); continue; } q -= J_EG;
      cvt_job(p.exp_w_down + le * 512 * 1024, 1024, 1024, (q / 8) * 64, (q % 8) * 128, (u16*)(ws + OFF_WD) + le * 1024 * 512, 512, 0, lds); continue;
    }
    r -= J_EXP;
    if (r < J_EG) { cvt_job(p.shr_w_gate + (size_t)l * 1024 * 512, 512, 512, (r / 4) * 64, (r % 4) * 128, (u16*)(ws + OFF_SGU) + (size_t)l * 1024 * 1024, 1024, 1, lds); continue; } r -= J_EG;
    if (r < J_EG) { cvt_job(p.shr_w_up + (size_t)l * 1024 * 512, 512, 512, (r / 4) * 64, (r % 4) * 128, (u16*)(ws + OFF_SGU) + (size_t)l * 1024 * 1024, 1024, 2, lds); continue; } r -= J_EG;
    cvt_job(p.shr_w_down + (size_t)l * 512 * 1024, 1024, 1024, (r / 8) * 64, (r % 8) * 128, (u16*)(ws + OFF_SD) + (size_t)l * 1024 * 512, 512, 0, lds);
  }
}

DI const float* xrow_ptr(const Params& p, int layer_src  , int row) {
  if (layer_src == 0) return row < NL ? p.x + (size_t)row * 1024 : p.ctx + (size_t)(row - NL) * 1024;
  return row < NL ? p.out + (size_t)row * 1024 : (const float*)(p.ws + OFF_CTXR) + (size_t)(row - NL) * 1024;
}
DI float* xrow_out(const Params& p, int row) {
  return row < NL ? p.out + (size_t)row * 1024 : (float*)(p.ws + OFF_CTXR) + (size_t)(row - NL) * 1024;
}

DI void norm_mod_row(f32x4 (&v)[4], const float* __restrict__ g, const float* __restrict__ md  , int lane) {
  float ss = 0.f;
#pragma unroll
  for (int i = 0; i < 4; ++i) ss += v[i].x * v[i].x + v[i].y * v[i].y + v[i].z * v[i].z + v[i].w * v[i].w;
  ss = wave_sum(ss);
  const float rstd = rsqrtf(ss * (1.f / 1024.f) + EPS);
#pragma unroll
  for (int i = 0; i < 4; ++i) {
    const f32x4 gg = *(const f32x4*)(g + lane * 4 + i * 256);
    const f32x4 sh = *(const f32x4*)(md + lane * 4 + i * 256);
    const f32x4 sc = *(const f32x4*)(md + 1024 + lane * 4 + i * 256);
    v[i] = v[i] * rstd * gg * (sc + 1.f) + sh;
  }
}
DI void store_h_row(const f32x4 (&v)[4], u16* __restrict__ hrow, int lane) {
#pragma unroll
  for (int i = 0; i < 4; ++i) {
    uint2 o; o.x = cvtpk(v[i].x, v[i].y); o.y = cvtpk(v[i].z, v[i].w);
    *(uint2*)(hrow + lane * 4 + i * 256) = o;
  }
}

DI void p1_norm_mix(const Params& p, int layer) {
  const int tid_ = opaque((int)threadIdx.x); const int lane = tid_ & 63, gw = blockIdx.x * 4 + (tid_ >> 6), ngw = gridDim.x * 4;
  const float* MODl = (const float*)(p.ws + OFF_MOD) + (size_t)layer * 9 * 6144;
  u16* H = (u16*)(p.ws + OFF_H);
  f32x4 vn[4];
  int row = gw;
  if (row < NT) { const float* xr = xrow_ptr(p, layer, row);
#pragma unroll
    for (int i = 0; i < 4; ++i) vn[i] = __builtin_nontemporal_load((const f32x4*)(xr + lane * 4 + i * 256)); }
  while (row < NT) {
    f32x4 v[4];
#pragma unroll
    for (int i = 0; i < 4; ++i) v[i] = vn[i];
    const int rown = row + ngw;
    if (rown < NT) { const float* xr = xrow_ptr(p, layer, rown);
#pragma unroll
      for (int i = 0; i < 4; ++i) vn[i] = __builtin_nontemporal_load((const f32x4*)(xr + lane * 4 + i * 256)); }
    const int mr = row < NL ? row / S_ : 8;
    norm_mod_row(v, p.norm_mix_g + layer * 1024, MODl + (size_t)mr * 6144, lane);
    store_h_row(v, H + (size_t)row * 1024, lane);
    row = rown;
  }
}

DI float max2nd4(float a, float b, float c, float d, float& m1) {
  const float ab = fmaxf(a, b), cd = fmaxf(c, d);
  m1 = fmaxf(ab, cd);
  return fmaxf(fmaxf(fminf(a, b), fminf(c, d)), fminf(ab, cd));
}
template <int CTRL> DI float dppz(float v) { return __int_as_float(__builtin_amdgcn_update_dpp(0, __float_as_int(v), CTRL, 0xf, 0xf, true)); }
DI float lane_xor4(float v, bool b2) { const float a = dppz<0x114>(v), b = dppz<0x104>(v); return b2 ? a : b; }
DI float lane_xor8(float v, bool b3) { const float a = dppz<0x118>(v), b = dppz<0x108>(v); return b3 ? a : b; }
DI bool beats(float a, int ia, float b, int ib) { return a > b || (a == b && ia < ib); }
DI void route_row(float bias_lane, const f32x4 (&v)[4], LAS char* lds, int lane, int& i0, int& i1, float& w0, float& w1) {
  const LAS f32x4* R = (const LAS f32x4*)lds;
  f32x4 pl4[4];
#pragma unroll
  for (int q = 0; q < 4; ++q) pl4[q] = (f32x4){0.f, 0.f, 0.f, 0.f};
#pragma unroll
  for (int i = 0; i < 4; ++i) {
    const int kq = i * 64 + lane;
    f32x4 wq[16];
#pragma unroll
    for (int j = 0; j < 16; ++j) wq[j] = R[j * 256 + kq];
    __builtin_amdgcn_sched_barrier(0);
#pragma unroll
    for (int kk = 0; kk < 4; ++kk) {
      const float hv = v[i][kk];
      const f32x4 hv4 = (f32x4){hv, hv, hv, hv};
#pragma unroll
      for (int q = 0; q < 4; ++q) pl4[q] = __builtin_elementwise_fma(hv4, wq[kk * 4 + q], pl4[q]);
    }
    __builtin_amdgcn_sched_barrier(0);
  }
  float pl[16];
#pragma unroll
  for (int q = 0; q < 4; ++q) { pl[q * 4 + 0] = pl4[q][0]; pl[q * 4 + 1] = pl4[q][1]; pl[q * 4 + 2] = pl4[q][2]; pl[q * 4 + 3] = pl4[q][3]; }
  const bool b0 = (lane & 1) != 0, b1 = (lane & 2) != 0, b2 = (lane & 4) != 0, b3 = (lane & 8) != 0;
  float r8[8], r4[4], r2[2];
#pragma unroll
  for (int i = 0; i < 8; ++i) { const float keep = b0 ? pl[i + 8] : pl[i], send = b0 ? pl[i] : pl[i + 8]; r8[i] = keep + dppz<0xB1>(send); }
#pragma unroll
  for (int i = 0; i < 4; ++i) { const float keep = b1 ? r8[i + 4] : r8[i], send = b1 ? r8[i] : r8[i + 4]; r4[i] = keep + dppz<0x4E>(send); }
#pragma unroll
  for (int i = 0; i < 2; ++i) { const float keep = b2 ? r4[i + 2] : r4[i], send = b2 ? r4[i] : r4[i + 2]; r2[i] = keep + lane_xor4(send, b2); }
  float lg;
  { const float keep = b3 ? r2[1] : r2[0], send = b3 ? r2[0] : r2[1]; lg = keep + lane_xor8(send, b3); }
  { auto rr = __builtin_amdgcn_permlane16_swap(__float_as_uint(lg), __float_as_uint(lg), false, false); lg = __uint_as_float(rr[0]) + __uint_as_float(rr[1]); }
  { auto rr = __builtin_amdgcn_permlane32_swap(__float_as_uint(lg), __float_as_uint(lg), false, false); lg = __uint_as_float(rr[0]) + __uint_as_float(rr[1]); }
  const float sg = __builtin_amdgcn_rcpf(1.f + __builtin_amdgcn_exp2f(-1.4426950408889634f * lg));
  const float bv = sg + bias_lane;
  const float m1v = lane_xor4(bv, b2), m2v = lane_xor8(bv, b3), m3v = lane_xor8(m1v, b3);
  float mtop; const float m2nd = max2nd4(bv, m1v, m2v, m3v, mtop);
  const float gs = mtop + m2nd;
  const float gA = dppz<0xB1>(gs), gB = dppz<0x4E>(gs), gC = dppz<0x1B>(gs);
  const int g = (b0 ? 2 : 0) + (b1 ? 1 : 0);
  const bool win = beats(gs, g, gA, g ^ 2) && beats(gs, g, gB, g ^ 1) && beats(gs, g, gC, g ^ 3);
  const int el = (b2 ? 2 : 0) + (b3 ? 1 : 0);
  const int rank = (beats(m1v, el ^ 2, bv, el) ? 1 : 0) + (beats(m2v, el ^ 1, bv, el) ? 1 : 0) + (beats(m3v, el ^ 3, bv, el) ? 1 : 0);
  const unsigned long long k0 = __ballot(win && rank == 0), k1 = __ballot(win && rank == 1);
  const int L0 = __builtin_ctzll(k0 | (1ull << 63)), L1 = __builtin_ctzll(k1 | (1ull << 63));
  const float s0 = __int_as_float(__builtin_amdgcn_readlane(__float_as_int(sg), L0));
  const float s1 = __int_as_float(__builtin_amdgcn_readlane(__float_as_int(sg), L1));
  i0 = 8 * (L0 & 1) + 4 * ((L0 >> 1) & 1) + 2 * ((L0 >> 2) & 1) + ((L0 >> 3) & 1);
  i1 = 8 * (L1 & 1) + 4 * ((L1 >> 1) & 1) + 2 * ((L1 >> 2) & 1) + ((L1 >> 3) & 1);
  const float inv = 1.f / (s0 + s1);
  w0 = s0 * inv; w1 = s1 * inv;
}

DI void load_router_lds(const Params& p, LAS char* lds) {
  LAS f32x4* R = (LAS f32x4*)lds;
  __syncthreads();
  for (int g = threadIdx.x; g < 4096; g += NTHR) {
    const int k = g >> 2, q = g & 3;
    R[((k & 3) * 4 + q) * 256 + (k >> 2)] = *(const f32x4*)(p.router_w + (size_t)g * 4);
  }
  __syncthreads();
}

constexpr int CNT_STRIDE = 64;
DI void p5_norm_ffn(const Params& p, int layer, int nrows, LAS char* lds) {
  load_router_lds(p, lds);
  const int tid = opaque((int)threadIdx.x), lane = tid & 63, wid = tid >> 6, gw = blockIdx.x * 4 + wid, ngw = gridDim.x * 4;
  const float* MODl = (const float*)(p.ws + OFF_MOD) + (size_t)layer * 9 * 6144;
  u16* H = (u16*)(p.ws + OFF_H);
  volatile LAS int* lcnt = (volatile LAS int*)(lds + LDS_MISC + 3072);
  volatile LAS int* lbase = lcnt + 16;
  volatile LAS int* stash = (volatile LAS int*)(lds + LDS_MISC + 4096) + wid * 160;
  int* tok_e = (int*)(p.ws + OFF_TOKE); float* tok_w = (float*)(p.ws + OFF_TOKW); int* tok_p = (int*)(p.ws + OFF_TOKP);
  int* list = (int*)(p.ws + OFF_LIST);
  unsigned* cnt = (unsigned*)(p.ws + OFF_CTRL) + CW_CNT + layer * 16 * CNT_STRIDE;
  if (tid < 16) lcnt[tid] = 0;
  __syncthreads();
  const float bias = p.router_bias[8 * (lane & 1) + 4 * ((lane >> 1) & 1) + 2 * ((lane >> 2) & 1) + ((lane >> 3) & 1)];
  int nst = 0;
  u32x2_t dn[4];
  const u16* XB = (const u16*)(p.ws + OFF_XB);
  if (gw < nrows) {
#pragma unroll
    for (int i = 0; i < 4; ++i) dn[i] = __builtin_nontemporal_load((const u32x2_t*)(XB + (size_t)gw * 1024 + lane * 4 + i * 256)); }
  for (int row = gw; row < nrows; row += ngw) {
    f32x4 v[4];
#pragma unroll
    for (int i = 0; i < 4; ++i) v[i] = (f32x4){bflo(dn[i][0]), bfhi(dn[i][0]), bflo(dn[i][1]), bfhi(dn[i][1])};
    if (row + ngw < nrows) {
#pragma unroll
      for (int i = 0; i < 4; ++i) dn[i] = __builtin_nontemporal_load((const u32x2_t*)(XB + (size_t)(row + ngw) * 1024 + lane * 4 + i * 256)); }
    const int mr = row < NL ? row / S_ : 8;
    norm_mod_row(v, p.norm_ffn_g + layer * 1024, MODl + (size_t)mr * 6144 + 3 * 1024, lane);
    store_h_row(v, H + (size_t)row * 1024, lane);
    int i0, i1; float w0, w1;
    route_row(bias, v, lds, lane, i0, i1, w0, w1);
    if (lane == 0) {
      const int lp0 = __hip_atomic_fetch_add((LAS int*)&lcnt[i0], 1, __ATOMIC_RELAXED, __HIP_MEMORY_SCOPE_WORKGROUP);
      const int lp1 = __hip_atomic_fetch_add((LAS int*)&lcnt[i1], 1, __ATOMIC_RELAXED, __HIP_MEMORY_SCOPE_WORKGROUP);
      tok_e[row * 2] = i0; tok_e[row * 2 + 1] = i1;
      tok_w[row * 2] = w0; tok_w[row * 2 + 1] = w1;
      stash[nst * 4 + 0] = i0; stash[nst * 4 + 1] = lp0; stash[nst * 4 + 2] = i1; stash[nst * 4 + 3] = lp1;
    }
    ++nst;
  }
  __syncthreads();
  if (tid < 16) { const int c = lcnt[tid]; lbase[tid] = c > 0 ? (int)atomicAdd(&cnt[tid * CNT_STRIDE], (unsigned)c) : 0; }
  __syncthreads();
  if (lane == 0) {
    int k = 0;
    for (int row = gw; row < nrows; row += ngw, ++k) {
      const int e0 = stash[k * 4 + 0], e1 = stash[k * 4 + 2];
      const int p0 = lbase[e0] + stash[k * 4 + 1], p1 = lbase[e1] + stash[k * 4 + 3];
      tok_p[row * 2] = p0; tok_p[row * 2 + 1] = p1;
      list[(size_t)e0 * NT + p0] = row; list[(size_t)e1 * NT + p1] = row;
    }
  }
}

DI void seg_scan(const Params& p, int layer, int (&tb)[NE + 1]) {
  const unsigned* cnt = (const unsigned*)(p.ws + OFF_CTRL) + CW_CNT + layer * 16 * CNT_STRIDE;
  int acc = 0;
#pragma unroll
  for (int e = 0; e < NE; ++e) { tb[e] = acc; acc += ((int)cnt[e * CNT_STRIDE] + 127) >> 7; }
  tb[NE] = acc;
}

DI void p8_combine(const Params& p, int layer, int nrows) {
  const int tid_ = opaque((int)threadIdx.x); const int lane = tid_ & 63, gw = blockIdx.x * 4 + (tid_ >> 6), ngw = gridDim.x * 4;
  const float* MODl = (const float*)(p.ws + OFF_MOD) + (size_t)layer * 9 * 6144;
  const float* MODn = (const float*)(p.ws + OFF_MOD) + (size_t)(layer + 1) * 9 * 6144;
  u16* H = (u16*)(p.ws + OFF_H);
  const u16* YSH = (const u16*)(p.ws + OFF_YSH);
  const u16* YEXP = (const u16*)(p.ws + OFF_YEXP);
  u16* XB = (u16*)(p.ws + OFF_XB);
  const int* tok_e = (const int*)(p.ws + OFF_TOKE); const float* tok_w = (const float*)(p.ws + OFF_TOKW); const int* tok_p = (const int*)(p.ws + OFF_TOKP);
  int tb[NE + 1]; seg_scan(p, layer, tb);
  int me0 = 0, me1 = 0, mp0 = 0, mp1 = 0; float mw0 = 0.f, mw1 = 0.f;
  u32x2_t an[4], bn[4], cn[4], xn[4]; float nw0 = 0.f, nw1 = 0.f;
#define P8_META(r) do { me0 = tok_e[(r) * 2]; me1 = tok_e[(r) * 2 + 1]; mp0 = tok_p[(r) * 2]; mp1 = tok_p[(r) * 2 + 1]; mw0 = tok_w[(r) * 2]; mw1 = tok_w[(r) * 2 + 1]; } while (0)
#define P8_DATA(r) do { int ps0 = 0, ps1 = 0; _Pragma("unroll") for (int e = 0; e < NE; ++e) { if (e == me0) ps0 = tb[e]; if (e == me1) ps1 = tb[e]; } \
    const size_t s0 = (size_t)ps0 * 128 + mp0, s1 = (size_t)ps1 * 128 + mp1; nw0 = mw0; nw1 = mw1; const u16* xrn = XB + (size_t)(r) * 1024; \
    _Pragma("unroll") for (int i = 0; i < 4; ++i) { const int cidx = lane * 4 + i * 256; \
      an[i] = __builtin_nontemporal_load((const u32x2_t*)(YEXP + s0 * 1024 + cidx)); bn[i] = __builtin_nontemporal_load((const u32x2_t*)(YEXP + s1 * 1024 + cidx)); \
      cn[i] = __builtin_nontemporal_load((const u32x2_t*)(YSH + (size_t)(r) * 1024 + cidx)); xn[i] = __builtin_nontemporal_load((const u32x2_t*)(xrn + cidx)); } } while (0)
  if (gw < nrows) { P8_META(gw); P8_DATA(gw); }
  if (gw + ngw < nrows) P8_META(gw + ngw);
  for (int row = gw; row < nrows; row += ngw) {
    u32x2_t a[4], b[4], c[4]; f32x4 v[4];
#pragma unroll
    for (int i = 0; i < 4; ++i) { a[i] = an[i]; b[i] = bn[i]; c[i] = cn[i]; v[i] = (f32x4){bflo(xn[i][0]), bfhi(xn[i][0]), bflo(xn[i][1]), bfhi(xn[i][1])}; }
    const float w0 = nw0, w1 = nw1;
    if (row + ngw < nrows) P8_DATA(row + ngw);
    if (row + 2 * ngw < nrows) P8_META(row + 2 * ngw);
    float* xr = xrow_out(p, row);
    const int mr = row < NL ? row / S_ : 8;
    const float* gate = MODl + (size_t)mr * 6144 + 5 * 1024;
#pragma unroll
    for (int i = 0; i < 4; ++i) {
      const int cidx = lane * 4 + i * 256;
      const f32x4 g = *(const f32x4*)(gate + cidx);
      f32x4 x = v[i];
      x.x += g.x * (w0 * bflo(a[i][0]) + w1 * bflo(b[i][0]) + bflo(c[i][0]));
      x.y += g.y * (w0 * bfhi(a[i][0]) + w1 * bfhi(b[i][0]) + bfhi(c[i][0]));
      x.z += g.z * (w0 * bflo(a[i][1]) + w1 * bflo(b[i][1]) + bflo(c[i][1]));
      x.w += g.w * (w0 * bfhi(a[i][1]) + w1 * bfhi(b[i][1]) + bfhi(c[i][1]));
      v[i] = x;
    }
    if (layer == 0) {
#pragma unroll
      for (int i = 0; i < 4; ++i) { u32x2_t o; o[0] = cvtpk(v[i].x, v[i].y); o[1] = cvtpk(v[i].z, v[i].w); *(u32x2_t*)(XB + (size_t)row * 1024 + lane * 4 + i * 256) = o; }
      norm_mod_row(v, p.norm_mix_g + 1024, MODn + (size_t)mr * 6144, lane);
      store_h_row(v, H + (size_t)row * 1024, lane);
    } else {
      float ss = 0.f;
#pragma unroll
      for (int i = 0; i < 4; ++i) ss += v[i].x * v[i].x + v[i].y * v[i].y + v[i].z * v[i].z + v[i].w * v[i].w;
      ss = wave_sum(ss);
      const float rstd = rsqrtf(ss * (1.f / 1024.f) + EPS);
#pragma unroll
      for (int i = 0; i < 4; ++i) {
        const f32x4 gg = *(const f32x4*)(p.final_norm_g + lane * 4 + i * 256);
        __builtin_nontemporal_store(v[i] * rstd * gg, (f32x4*)(xr + lane * 4 + i * 256));
      }
    }
  }
#undef P8_META
#undef P8_DATA
}

DI void glds16(const u16* g, LAS char* l) {
  __builtin_amdgcn_global_load_lds((const void*)g, (LAS void*)l, 16, 0, 0);
}
struct TilePtrs { const u16 *a0, *a1, *a2, *a3, *b0; long ldb32; };
#define GT_ISSUE_P(T, kt, s) do { const int _ko = (kt) * 64; LAS char* _d = ldst + (s) * 32768; \
    glds16((T).a0 + _ko, _d); glds16((T).a1 + _ko, _d + 4096); glds16((T).a2 + _ko, _d + 8192); glds16((T).a3 + _ko, _d + 12288); \
    glds16((T).b0 + _ko, _d + 16384); glds16((T).b0 + (T).ldb32 + _ko, _d + 20480); glds16((T).b0 + 2 * (T).ldb32 + _ko, _d + 24576); glds16((T).b0 + 3 * (T).ldb32 + _ko, _d + 28672); } while (0)
template <bool HOIST = true>
DI void gemm_tile_s(LAS char* lds, const TilePtrs& cur, bool issued, const TilePtrs& nxt, bool has_next, int nk, f32x4 (&acc)[4][4]) {
  const int tid = opaque((int)threadIdx.x), lane = tid & 63, wid = tid >> 6, wr = wid >> 1, wc = wid & 1, fr = lane & 15, fq = lane >> 4;
  const int kx = (fr >> 1) & 7;
  const int aoff0 = (wr * 64 + fr) * 128 + ((fq ^ kx) * 16), aoff1 = (wr * 64 + fr) * 128 + (((4 + fq) ^ kx) * 16);
  const int boff0 = 16384 + (wc * 64 + fr) * 128 + ((fq ^ kx) * 16), boff1 = 16384 + (wc * 64 + fr) * 128 + (((4 + fq) ^ kx) * 16);
#pragma unroll
  for (int m = 0; m < 4; ++m)
#pragma unroll
    for (int n = 0; n < 4; ++n) acc[m][n] = (f32x4){0.f, 0.f, 0.f, 0.f};
  LAS char* ldst = lds + tid * 16;
  if (!issued) GT_ISSUE_P(cur, 0, 0);
#pragma unroll 1
  for (int kt = 0; kt < nk; ++kt) {
    asm volatile("s_waitcnt vmcnt(0)" ::: "memory");
    __syncthreads();
    if (kt + 1 < nk) GT_ISSUE_P(cur, kt + 1, (kt + 1) & 1);
    else if (has_next) GT_ISSUE_P(nxt, 0, 0);
    const LAS char* sb = lds + (kt & 1) * 32768;
    if (!HOIST) {
#pragma unroll
      for (int h = 0; h < 2; ++h) {
        bf16x8 af1[4], bf1[4];
#pragma unroll
        for (int m = 0; m < 4; ++m) af1[m] = *(const LAS bf16x8*)(sb + (h ? aoff1 : aoff0) + m * 2048);
#pragma unroll
        for (int n = 0; n < 4; ++n) bf1[n] = *(const LAS bf16x8*)(sb + (h ? boff1 : boff0) + n * 2048);
#pragma unroll
        for (int m = 0; m < 4; ++m)
#pragma unroll
          for (int n = 0; n < 4; ++n) acc[m][n] = __builtin_amdgcn_mfma_f32_16x16x32_bf16(bf1[n], af1[m], acc[m][n], 0, 0, 0);
      }
      continue;
    }
    bf16x8 af[2][4], bfr[2][4];
    const unsigned aad0 = (unsigned)(size_t)(sb + aoff0), aad1 = (unsigned)(size_t)(sb + aoff1), bad0 = (unsigned)(size_t)(sb + boff0), bad1 = (unsigned)(size_t)(sb + boff1);
#define GT_LDR(dst, ad, off) asm volatile("ds_read_b128 %0, %1 offset:%c2" : "=v"(dst) : "v"(ad), "i"(off))
    GT_LDR(af[0][0], aad0, 0); GT_LDR(af[0][1], aad0, 2048); GT_LDR(af[0][2], aad0, 4096); GT_LDR(af[0][3], aad0, 6144);
    GT_LDR(bfr[0][0], bad0, 0); GT_LDR(bfr[0][1], bad0, 2048); GT_LDR(bfr[0][2], bad0, 4096); GT_LDR(bfr[0][3], bad0, 6144);
    GT_LDR(af[1][0], aad1, 0); GT_LDR(af[1][1], aad1, 2048); GT_LDR(af[1][2], aad1, 4096); GT_LDR(af[1][3], aad1, 6144);
    GT_LDR(bfr[1][0], bad1, 0); GT_LDR(bfr[1][1], bad1, 2048); GT_LDR(bfr[1][2], bad1, 4096); GT_LDR(bfr[1][3], bad1, 6144);
#undef GT_LDR
    asm volatile("s_waitcnt lgkmcnt(8)" : "+v"(af[0][0]), "+v"(af[0][1]), "+v"(af[0][2]), "+v"(af[0][3]), "+v"(bfr[0][0]), "+v"(bfr[0][1]), "+v"(bfr[0][2]), "+v"(bfr[0][3]) :: "memory");
    __builtin_amdgcn_sched_barrier(0);
#pragma unroll
    for (int m = 0; m < 4; ++m)
#pragma unroll
      for (int n = 0; n < 4; ++n) acc[m][n] = __builtin_amdgcn_mfma_f32_16x16x32_bf16(bfr[0][n], af[0][m], acc[m][n], 0, 0, 0);
    __builtin_amdgcn_sched_barrier(0);
    asm volatile("s_waitcnt lgkmcnt(0)" : "+v"(af[1][0]), "+v"(af[1][1]), "+v"(af[1][2]), "+v"(af[1][3]), "+v"(bfr[1][0]), "+v"(bfr[1][1]), "+v"(bfr[1][2]), "+v"(bfr[1][3]) :: "memory");
    __builtin_amdgcn_sched_barrier(0);
#pragma unroll
    for (int m = 0; m < 4; ++m)
#pragma unroll
      for (int n = 0; n < 4; ++n) acc[m][n] = __builtin_amdgcn_mfma_f32_16x16x32_bf16(bfr[1][n], af[1][m], acc[m][n], 0, 0, 0);
    __builtin_amdgcn_sched_barrier(0);
  }
}
DI void gemm_tile(LAS char* lds, const u16* a0, long lda32, const u16* b0, long ldb32, int nk, f32x4 (&acc)[4][4]) {
  TilePtrs t; t.a0 = a0; t.a1 = a0 + lda32; t.a2 = a0 + 2 * lda32; t.a3 = a0 + 3 * lda32; t.b0 = b0; t.ldb32 = ldb32;
  gemm_tile_s<false>(lds, t, false, t, false, nk, acc);
  __syncthreads();
}
DI int gt_chunk(int tid) { return ((tid & 7) ^ ((tid >> 4) & 7)) * 8; }
DI int gt_row0(int tid) { return tid >> 3; }

DI void sincos_rev(float pos, float invf, float& sn, float& cs) {
  float rev = pos * invf * 0.15915494309189535f;
  rev -= rintf(rev);
  sn = __builtin_amdgcn_sinf(rev); cs = __builtin_amdgcn_cosf(rev);
}
DI void st_bf4(u16* dst, const f32x4& v) { uint2 o; o.x = cvtpk(v[0], v[1]); o.y = cvtpk(v[2], v[3]); *(uint2*)dst = o; }


DI void stage_put4(LAS char* st, int row, int c8, const f32x4& v) {
  u32x2_t o; o[0] = cvtpk(v[0], v[1]); o[1] = cvtpk(v[2], v[3]);
  *(LAS u32x2_t*)(st + row * 128 + ((c8 ^ (row & 15)) * 8)) = o;
}
DI u32x4_t stage_get16(const LAS char* st, int row, int u) {
  u32x4_t v = *(const LAS u32x4_t*)(st + row * 128 + ((u ^ ((row >> 1) & 7)) * 16));
  if (row & 1) v = __builtin_shufflevector(v, v, 2, 3, 0, 1);
  return v;
}
template <int NC>
DI void stage_flush(const LAS char* st, u16* dst, size_t ld, int lane) {
  constexpr int UPR = NC / 8;
  constexpr int RPI = 64 / UPR;
#pragma unroll
  for (int i = 0; i < 64 / RPI; ++i) {
    const int row = i * RPI + lane / UPR, u = lane % UPR;
    const u32x4_t v = stage_get16(st, row, u);
    *(u32x4_t*)(dst + (size_t)row * ld + u * 8) = v;
  }
}

template <bool F32SRC>
DI void stage_flush_resid(const LAS char* st, const float* __restrict__ xs, u16* xb, int lane) {
#pragma unroll
  for (int h = 0; h < 2; ++h) {
    f32x4 xa[4], xc[4]; u32x4_t xo[4];
#pragma unroll
    for (int i = 0; i < 4; ++i) {
      const int row = (h * 4 + i) * 8 + (lane >> 3), u = lane & 7;
      if (F32SRC) { xa[i] = __builtin_nontemporal_load((const f32x4*)(xs + (size_t)row * 1024 + u * 8)); xc[i] = __builtin_nontemporal_load((const f32x4*)(xs + (size_t)row * 1024 + u * 8 + 4)); }
      else xo[i] = __builtin_nontemporal_load((const u32x4_t*)(xb + (size_t)row * 1024 + u * 8));
    }
#pragma unroll
    for (int i = 0; i < 4; ++i) {
      const int row = (h * 4 + i) * 8 + (lane >> 3), u = lane & 7;
      const u32x4_t d = stage_get16(st, row, u);
      if (!F32SRC) { xa[i] = (f32x4){bflo(xo[i][0]), bfhi(xo[i][0]), bflo(xo[i][1]), bfhi(xo[i][1])}; xc[i] = (f32x4){bflo(xo[i][2]), bfhi(xo[i][2]), bflo(xo[i][3]), bfhi(xo[i][3])}; }
      u32x4_t o;
      o[0] = cvtpk(xa[i][0] + bflo(d[0]), xa[i][1] + bfhi(d[0])); o[1] = cvtpk(xa[i][2] + bflo(d[1]), xa[i][3] + bfhi(d[1]));
      o[2] = cvtpk(xc[i][0] + bflo(d[2]), xc[i][1] + bfhi(d[2])); o[3] = cvtpk(xc[i][2] + bflo(d[3]), xc[i][3] + bfhi(d[3]));
      *(u32x4_t*)(xb + (size_t)row * 1024 + u * 8) = o;
    }
  }
}

DI void epi_inproj(const Params& p, int layer, f32x4 (&acc)[4][4], int m0, int seg, int wr, int fr, int fq, LAS float* rowss_slot, LAS char* stg, int lane) {
  char* ws = p.ws;
  const bool lat = m0 < NL;
  const int rbase = m0 + wr * 64 + fr;
  u16* dst; int ld, cb; int kind;
  if (seg < 6) { dst = (u16*)(ws + OFF_SWQ); ld = 384; cb = seg * 64; kind = 1; }
  else if (seg < 8) { dst = (u16*)(ws + OFF_SWK); ld = 128; cb = (seg - 6) * 64; kind = 1; }
  else if (seg < 10) { dst = (u16*)(ws + OFF_SWV); ld = 128; cb = (seg - 8) * 64; kind = 0; }
  else if (seg < 16) { dst = (u16*)(ws + OFF_GLQ); ld = 384; cb = (seg - 10) * 64; kind = 2; }
  else if (seg < 18) { dst = (u16*)(ws + OFF_GLK); ld = 128; cb = (seg - 16) * 64; kind = 3; }
  else if (seg < 20) { dst = (u16*)(ws + OFF_GLV); ld = 128; cb = (seg - 18) * 64; kind = 0; }
  else if (seg < 24) { dst = (u16*)(ws + OFF_QLAT); ld = 256; cb = (seg - 20) * 64; kind = 4; }
  else if (seg < 26) { dst = (u16*)(ws + OFF_KVLAT); ld = 128; cb = (seg - 24) * 64; kind = 5; }
  else if (seg == 26) { dst = (u16*)(ws + OFF_MLKR); ld = 32; cb = 0; kind = 6; }
  else return;
  if (kind == 2 || kind == 3) {
    const float* gain = (kind == 2 ? p.glb_q_gain : p.glb_k_gain) + layer * 64;
    f32x4 gv[4];
#pragma unroll
    for (int n = 0; n < 4; ++n) gv[n] = *(const f32x4*)(gain + n * 16 + fq * 4);
#pragma unroll
    for (int m = 0; m < 4; ++m) {
      float ss = 0.f;
#pragma unroll
      for (int n = 0; n < 4; ++n) ss += acc[m][n][0] * acc[m][n][0] + acc[m][n][1] * acc[m][n][1] + acc[m][n][2] * acc[m][n][2] + acc[m][n][3] * acc[m][n][3];
      ss += __shfl_xor(ss, 16); ss += __shfl_xor(ss, 32);
      const float r = rsqrtf(ss * (1.f / 64.f) + EPS);
#pragma unroll
      for (int n = 0; n < 4; ++n) acc[m][n] = acc[m][n] * r * gv[n];
    }
  }
  if (kind == 4 || kind == 5) {
    const float* gain = (kind == 4 ? p.mla_q_gain + layer * 256 : p.mla_kv_gain + layer * 128) + cb;
    f32x4 gv[4];
#pragma unroll
    for (int n = 0; n < 4; ++n) gv[n] = *(const f32x4*)(gain + n * 16 + fq * 4);
#pragma unroll
    for (int m = 0; m < 4; ++m) {
      float ss = 0.f;
#pragma unroll
      for (int n = 0; n < 4; ++n) ss += acc[m][n][0] * acc[m][n][0] + acc[m][n][1] * acc[m][n][1] + acc[m][n][2] * acc[m][n][2] + acc[m][n][3] * acc[m][n][3];
      ss += __shfl_xor(ss, 16); ss += __shfl_xor(ss, 32);
      if (fq == 0) rowss_slot[wr * 64 + m * 16 + fr] = ss;
#pragma unroll
      for (int n = 0; n < 4; ++n) acc[m][n] = acc[m][n] * gv[n];
    }
  }
  if (lat && (kind == 1 || kind == 2 || kind == 3)) {
    float invf[4];
#pragma unroll
    for (int j = 0; j < 4; ++j) invf[j] = __builtin_amdgcn_exp2f(-(float)(fq * 4 + j) * (13.287712379549449f / 16.f));
#pragma unroll
    for (int m = 0; m < 4; ++m) {
      const int t = (rbase + m * 16) & (S_ - 1);
      const float prow = (float)(t >> 6), pcol = (float)(t & 63);
#pragma unroll
      for (int j = 0; j < 4; ++j) {
        float sr, cr, sc, cc;
        sincos_rev(prow, invf[j], sr, cr); sincos_rev(pcol, invf[j], sc, cc);
        float x1 = acc[m][0][j], x2 = acc[m][1][j];
        acc[m][0][j] = x1 * cr - x2 * sr; acc[m][1][j] = x2 * cr + x1 * sr;
        x1 = acc[m][2][j]; x2 = acc[m][3][j];
        acc[m][2][j] = x1 * cc - x2 * sc; acc[m][3][j] = x2 * cc + x1 * sc;
      }
    }
  }
  if (kind == 6) {
    if (lat) {
      float invf[4];
#pragma unroll
      for (int j = 0; j < 4; ++j) invf[j] = __builtin_amdgcn_exp2f(-(float)((fq & 1) * 4 + j) * (13.287712379549449f / 8.f));
#pragma unroll
      for (int m = 0; m < 4; ++m) {
        const int t = (rbase + m * 16) & (S_ - 1);
#pragma unroll
        for (int n = 0; n < 2; ++n) {
          const float pos = n == 0 ? (float)(t >> 6) : (float)(t & 63);
#pragma unroll
          for (int j = 0; j < 4; ++j) {
            float sn, cs; sincos_rev(pos, invf[j], sn, cs);
            const float v = acc[m][n][j], pr = __shfl_xor(v, 32);
            acc[m][n][j] = (fq & 2) ? v * cs + pr * sn : v * cs - pr * sn;
          }
        }
      }
    }
#pragma unroll
    for (int m = 0; m < 4; ++m)
#pragma unroll
      for (int n = 0; n < 2; ++n) stage_put4(stg, m * 16 + fr, n * 4 + fq, acc[m][n]);
    stage_flush<32>(stg, dst + (size_t)(m0 + wr * 64) * ld, ld, lane);
    return;
  }
#pragma unroll
  for (int m = 0; m < 4; ++m)
#pragma unroll
    for (int n = 0; n < 4; ++n) stage_put4(stg, m * 16 + fr, n * 4 + fq, acc[m][n]);
  stage_flush<64>(stg, dst + (size_t)(m0 + wr * 64) * ld + cb, ld, lane);
}

DI void p2_inproj(const Params& p, int layer, LAS char* lds, int cs = 0) {
  char* ws = p.ws;
  unsigned* ctr = (unsigned*)(ws + OFF_CTRL) + CW_CTR + layer * 16 + 2 + cs;
  const u16* H = (const u16*)(ws + OFF_H);
  const u16* WinT = (const u16*)(ws + OFF_WIN) + (size_t)layer * INWP * 1024;
  const u16* WuqT = (const u16*)(ws + OFF_WUQ) + (size_t)layer * 384 * 256;
  const u16* WukvT = (const u16*)(ws + OFF_WUKV) + (size_t)layer * 512 * 128;
  const int tid = opaque((int)threadIdx.x), lane = tid & 63, wid = tid >> 6, wr = wid >> 1, wc = wid & 1;
  LAS float* rowss = (LAS float*)(lds + LDS_MISC);
  LAS float* rstd = (LAS float*)(lds + LDS_MISC + 2048);
  unsigned* ctr8 = (unsigned*)(ws + OFF_CTRL) + CW_Q + (layer * 2 + 1) * 512;
  f32x4 acc[4][4];
  for (;;) {
    const int u = next_unit_xcd(ctr8, (NT / 128 / 8) * 12, lds);
    if (u < 0) break;
    const int tid_o = opaque(tid), lane_o = tid_o & 63;
    const int fr = lane_o & 15, fq = lane_o >> 4, ch = gt_chunk(tid_o), r0 = gt_row0(tid_o);
    const int qx = u / 408, v = u % 408;
    int rt, k;
    if (v < 34) { rt = qx * 34 + v; k = 10; } else if (v < 68) { rt = qx * 34 + v - 34; k = 11; } else { rt = qx * 34 + (v - 68) / 10; k = (v - 68) % 10; }
    const int m0 = rt * 128;
    const u16* a0 = H + (size_t)(m0 + r0) * 1024 + ch;
    if (k < 10) {
      const u16* b0 = WinT + (size_t)(k * 128 + r0) * 1024 + ch;
      gemm_tile(lds, a0, 32 * 1024, b0, 32 * 1024, 16, acc);
      epi_inproj(p, layer, acc, m0, k * 2 + wc, wr, fr, fq, rowss, lds + 32768 + wid * 8192, lane_o);
    } else if (k == 10) {
#pragma unroll 1
      for (int t = 0; t < 2; ++t) {
        const u16* b0 = WinT + (size_t)(1280 + t * 128 + r0) * 1024 + ch;
        gemm_tile(lds, a0, 32 * 1024, b0, 32 * 1024, 16, acc);
        epi_inproj(p, layer, acc, m0, 20 + t * 2 + wc, wr, fr, fq, rowss + (t * 2 + wc) * 128, lds + 32768 + wid * 8192, lane_o);
      }
      __syncthreads();
      if (tid < 128) rstd[tid] = rsqrtf((rowss[tid] + rowss[128 + tid] + rowss[256 + tid] + rowss[384 + tid]) * (1.f / 256.f) + EPS);
      __syncthreads();
      const u16* QL = (const u16*)(ws + OFF_QLAT);
      const u16* qa0 = QL + (size_t)(m0 + r0) * 256 + ch;
      u16* MLQ = (u16*)(ws + OFF_MLQ);
      const bool lat = m0 < NL;
#pragma unroll 1
      for (int t = 0; t < 3; ++t) {
        const u16* b0 = WuqT + (size_t)(t * 128 + r0) * 256 + ch;
        gemm_tile(lds, qa0, 32 * 256, b0, 32 * 256, 4, acc);
        const int c0 = t * 128 + wc * 64;
        float invf[4];
#pragma unroll
        for (int j = 0; j < 4; ++j) invf[j] = __builtin_amdgcn_exp2f(-(float)((fq & 1) * 4 + j) * (13.287712379549449f / 8.f));
#pragma unroll
        for (int m = 0; m < 4; ++m) {
          const int rl = wr * 64 + m * 16 + fr;
          const float rs = rstd[rl];
          const int tpos = (m0 + rl) & (S_ - 1);
#pragma unroll
          for (int n = 0; n < 4; ++n) {
            acc[m][n] = acc[m][n] * rs;
            const int w96 = (c0 + n * 16) % 96;
            if (lat && w96 >= 64) {
              const float pos = (w96 == 64) ? (float)(tpos >> 6) : (float)(tpos & 63);
#pragma unroll
              for (int j = 0; j < 4; ++j) {
                float sn, cs; sincos_rev(pos, invf[j], sn, cs);
                const float v = acc[m][n][j], pr = __shfl_xor(v, 32);
                acc[m][n][j] = (fq & 2) ? v * cs + pr * sn : v * cs - pr * sn;
              }
            }
            stage_put4(lds + 32768 + wid * 8192, m * 16 + fr, n * 4 + fq, acc[m][n]);
          }
        }
        stage_flush<64>(lds + 32768 + wid * 8192, MLQ + (size_t)(m0 + wr * 64) * 384 + c0, 384, lane_o);
      }
    } else {
      {
        const u16* b0 = WinT + (size_t)(1536 + r0) * 1024 + ch;
        gemm_tile(lds, a0, 32 * 1024, b0, 32 * 1024, 16, acc);
        epi_inproj(p, layer, acc, m0, 24 + wc, wr, fr, fq, rowss + wc * 128, lds + 32768 + wid * 8192, lane_o);
        const u16* b2 = WinT + (size_t)(1664 + r0) * 1024 + ch;
        gemm_tile(lds, a0, 32 * 1024, b2, 32 * 1024, 16, acc);
        epi_inproj(p, layer, acc, m0, 26 + wc, wr, fr, fq, rowss, lds + 32768 + wid * 8192, lane_o);
      }
      __syncthreads();
      if (tid < 128) rstd[tid] = rsqrtf((rowss[tid] + rowss[128 + tid]) * (1.f / 128.f) + EPS);
      __syncthreads();
      const u16* KL = (const u16*)(ws + OFF_KVLAT);
      const u16* ka0 = KL + (size_t)(m0 + r0) * 128 + ch;
#pragma unroll 1
      for (int t = 0; t < 4; ++t) {
        const u16* b0 = WukvT + (size_t)(t * 128 + r0) * 128 + ch;
        gemm_tile(lds, ka0, 32 * 128, b0, 32 * 128, 2, acc);
        u16* dst = (u16*)(ws + (wc == 0 ? OFF_MLK : OFF_MLV));
#pragma unroll
        for (int m = 0; m < 4; ++m) {
          const int rl = wr * 64 + m * 16 + fr;
          const float rs = rstd[rl];
#pragma unroll
          for (int n = 0; n < 4; ++n) { acc[m][n] = acc[m][n] * rs; stage_put4(lds + 32768 + wid * 8192, m * 16 + fr, n * 4 + fq, acc[m][n]); }
        }
        stage_flush<64>(lds + 32768 + wid * 8192, dst + (size_t)(m0 + wr * 64) * 256 + t * 64, 256, lane_o);
      }
    }
  }
}

DI void p4_outproj(const Params& p, int layer, int nrows, LAS char* lds, int cs = 0) {
  char* ws = p.ws;
  const u16* Y = (const u16*)(ws + OFF_Y);
  const u16* WoT = (const u16*)(ws + OFF_WO) + (size_t)layer * 1024 * 1024;
  const float* MODl = (const float*)(ws + OFF_MOD) + (size_t)layer * 9 * 6144;
  const int tid = opaque((int)threadIdx.x), wid = tid >> 6, wr = wid >> 1, wc = wid & 1;
  const int nunits = (nrows / 128) * 8;
  f32x4 acc[4][4];
  __syncthreads();
  TilePtrs cur, nxt;
  int u = (int)((blockIdx.x & 7) * (gridDim.x >> 3) + (blockIdx.x >> 3));
#define P4_DESC(T, uu) do { const int _t = opaque(tid); const int _ch = gt_chunk(_t), _r0 = gt_row0(_t); const int _rt = (uu) >> 3, _ct = (uu) & 7; \
    (T).a0 = Y + (size_t)(_rt * 128 + _r0) * 1024 + _ch; (T).a1 = (T).a0 + 32 * 1024; (T).a2 = (T).a0 + 64 * 1024; (T).a3 = (T).a0 + 96 * 1024; \
    (T).b0 = WoT + (size_t)(_ct * 128 + _r0) * 1024 + _ch; (T).ldb32 = 32 * 1024; } while (0)
  bool issued = false;
  if (u < nunits) P4_DESC(cur, u);
  while (u < nunits) {
    const int un = u + gridDim.x;
    const bool hn = un < nunits;
    if (hn) P4_DESC(nxt, un); else nxt = cur;
    gemm_tile_s(lds, cur, issued, nxt, hn, 16, acc);
    issued = hn;
    const int tid_o = opaque(tid), lane_o = tid_o & 63;
    const int fr = lane_o & 15, fq = lane_o >> 4;
    const int rt = u >> 3, ct = u & 7, m0 = rt * 128;
    const int mr = m0 < NL ? m0 / S_ : 8;
    const float* gate = MODl + (size_t)mr * 6144 + 2 * 1024 + ct * 128 + wc * 64 + fq * 4;
    __syncthreads();
    LAS char* stg = lds + 32768 + wid * 8192;
#pragma unroll
    for (int n = 0; n < 4; ++n) {
      const f32x4 g = *(const f32x4*)(gate + n * 16);
#pragma unroll
      for (int m = 0; m < 4; ++m) stage_put4(stg, m * 16 + fr, n * 4 + fq, g * acc[m][n]);
    }
    { const int grow = m0 + wr * 64, gcol = ct * 128 + wc * 64;
      u16* xb = (u16*)(ws + OFF_XB) + (size_t)grow * 1024 + gcol;
      if (layer == 0) stage_flush_resid<true>(stg, (grow < NL ? p.x + (size_t)grow * 1024 : p.ctx + (size_t)(grow - NL) * 1024) + gcol, xb, lane_o);
      else stage_flush_resid<false>(stg, nullptr, xb, lane_o); }
    cur = nxt; u = un;
  }
#undef P4_DESC
  __syncthreads();
}

DI void p6_gateup(const Params& p, int layer, int nrows, LAS char* lds, int cs = 0) {
  char* ws = p.ws;
  const unsigned* cnt = (const unsigned*)(ws + OFF_CTRL) + CW_CNT + layer * 16 * CNT_STRIDE;
  const u16* H = (const u16*)(ws + OFF_H);
  const int* list = (const int*)(ws + OFF_LIST);
  const u16* WguT = (const u16*)(ws + OFF_WGU) + (size_t)layer * NE * 1024 * 1024;
  const u16* SguT = (const u16*)(ws + OFF_SGU) + (size_t)layer * 1024 * 1024;
  u16* ACT = (u16*)(ws + OFF_ACT); u16* ACTS = (u16*)(ws + OFF_ACTS);
  const int tid = opaque((int)threadIdx.x), wid = tid >> 6, wr = wid >> 1, wc = wid & 1;
  int tb[NE + 1]; seg_scan(p, layer, tb);
  const int R = tb[NE];
  const int nunits = (R + nrows / 128) * 8;
  f32x4 acc[4][4];
  __syncthreads();
  TilePtrs cur, nxt;
#define P6_DESC(T, uu) do { const int _t = opaque(tid); const int _ch = gt_chunk(_t), _r0 = gt_row0(_t); const int _rt = (uu) >> 3, _ct = (uu) & 7; \
    if (_rt < R) { int _e = 0, _tbe = 0; _Pragma("unroll") for (int q = 1; q < NE; ++q) if (_rt >= tb[q]) { _e = q; _tbe = tb[q]; } \
      const int _i = _rt - _tbe, _ce = (int)cnt[_e * CNT_STRIDE]; const int _i0 = _i * 128 + _r0; const int* _lp = list + (size_t)_e * NT + _i0; \
      const int _t0 = _i0 < _ce ? _lp[0] : 0, _t1 = _i0 + 32 < _ce ? _lp[32] : 0, _t2 = _i0 + 64 < _ce ? _lp[64] : 0, _t3 = _i0 + 96 < _ce ? _lp[96] : 0; \
      (T).a0 = H + (size_t)_t0 * 1024 + _ch; (T).a1 = H + (size_t)_t1 * 1024 + _ch; (T).a2 = H + (size_t)_t2 * 1024 + _ch; (T).a3 = H + (size_t)_t3 * 1024 + _ch; \
      (T).b0 = WguT + ((size_t)_e * 1024 + _ct * 128 + _r0) * 1024 + _ch; } \
    else { const int _m0 = (_rt - R) * 128; (T).a0 = H + (size_t)(_m0 + _r0) * 1024 + _ch; (T).a1 = (T).a0 + 32 * 1024; (T).a2 = (T).a0 + 64 * 1024; (T).a3 = (T).a0 + 96 * 1024; \
      (T).b0 = SguT + (size_t)(_ct * 128 + _r0) * 1024 + _ch; } \
    (T).ldb32 = 32 * 1024; } while (0)
  int u = (int)((blockIdx.x & 7) * (gridDim.x >> 3) + (blockIdx.x >> 3));
  bool issued = false;
  if (u < nunits) P6_DESC(cur, u);
  while (u < nunits) {
    const int un = u + gridDim.x;
    const bool hn = un < nunits;
    if (hn) P6_DESC(nxt, un); else nxt = cur;
    gemm_tile_s(lds, cur, issued, nxt, hn, 16, acc);
    issued = hn;
    const int tid_o = opaque(tid), lane_o = tid_o & 63;
    const int fr = lane_o & 15, fq = lane_o >> 4;
    const int rt = u >> 3, ct = u & 7;
    u16* dst; size_t orow;
    if (rt < R) { dst = ACT; orow = (size_t)rt * 128; } else { dst = ACTS; orow = (size_t)(rt - R) * 128; }
    __syncthreads();
    LAS char* stg = lds + 32768 + wid * 8192;
#pragma unroll
    for (int m = 0; m < 4; ++m)
#pragma unroll
      for (int n = 0; n < 2; ++n) {
        f32x4 r;
#pragma unroll
        for (int j = 0; j < 4; ++j) r[j] = silu(acc[m][n][j]) * acc[m][n + 2][j];
        stage_put4(stg, m * 16 + fr, n * 4 + fq, r);
      }
    stage_flush<32>(stg, dst + (orow + wr * 64) * 512 + ct * 64 + wc * 32, 512, lane_o);
    cur = nxt; u = un;
  }
#undef P6_DESC
  __syncthreads();
}

DI void p7_down(const Params& p, int layer, int nrows, LAS char* lds, int cs = 0) {
  char* ws = p.ws;
  const u16* WdT = (const u16*)(ws + OFF_WD) + (size_t)layer * NE * 1024 * 512;
  const u16* SdT = (const u16*)(ws + OFF_SD) + (size_t)layer * 1024 * 512;
  const u16* ACT = (const u16*)(ws + OFF_ACT); const u16* ACTS = (const u16*)(ws + OFF_ACTS);
  u16* YEXP = (u16*)(ws + OFF_YEXP); u16* YSH = (u16*)(ws + OFF_YSH);
  const int tid = opaque((int)threadIdx.x), wid = tid >> 6, wr = wid >> 1, wc = wid & 1;
  int tb[NE + 1]; seg_scan(p, layer, tb);
  const int R = tb[NE];
  const int nunits = (R + nrows / 128) * 8;
  f32x4 acc[4][4];
  __syncthreads();
  TilePtrs cur, nxt;
#define P7_DESC(T, uu) do { const int _t = opaque(tid); const int _ch = gt_chunk(_t), _r0 = gt_row0(_t); const int _rt = (uu) >> 3, _ct = (uu) & 7; \
    if (_rt < R) { int _e = 0; _Pragma("unroll") for (int q = 1; q < NE; ++q) if (_rt >= tb[q]) _e = q; \
      (T).a0 = ACT + ((size_t)_rt * 128 + _r0) * 512 + _ch; (T).b0 = WdT + ((size_t)_e * 1024 + _ct * 128 + _r0) * 512 + _ch; } \
    else { const int _m0 = (_rt - R) * 128; (T).a0 = ACTS + (size_t)(_m0 + _r0) * 512 + _ch; (T).b0 = SdT + (size_t)(_ct * 128 + _r0) * 512 + _ch; } \
    (T).a1 = (T).a0 + 32 * 512; (T).a2 = (T).a0 + 64 * 512; (T).a3 = (T).a0 + 96 * 512; (T).ldb32 = 32 * 512; } while (0)
  int u = (int)((blockIdx.x & 7) * (gridDim.x >> 3) + (blockIdx.x >> 3));
  bool issued = false;
  if (u < nunits) P7_DESC(cur, u);
  while (u < nunits) {
    const int un = u + gridDim.x;
    const bool hn = un < nunits;
    if (hn) P7_DESC(nxt, un); else nxt = cur;
    gemm_tile_s(lds, cur, issued, nxt, hn, 8, acc);
    issued = hn;
    const int tid_o = opaque(tid), lane_o = tid_o & 63;
    const int fr = lane_o & 15, fq = lane_o >> 4;
    const int rt = u >> 3, ct = u & 7;
    u16* dst; size_t orow;
    if (rt < R) { dst = YEXP; orow = (size_t)rt * 128; } else { dst = YSH; orow = (size_t)(rt - R) * 128; }
    __syncthreads();
    LAS char* stg = lds + 32768 + wid * 8192;
#pragma unroll
    for (int m = 0; m < 4; ++m)
#pragma unroll
      for (int n = 0; n < 4; ++n) stage_put4(stg, m * 16 + fr, n * 4 + fq, acc[m][n]);
    stage_flush<64>(stg, dst + (orow + wr * 64) * 1024 + ct * 128 + wc * 64, 1024, lane_o);
    cur = nxt; u = un;
  }
#undef P7_DESC
  __syncthreads();
}

typedef float f32x16 __attribute__((ext_vector_type(16)));
typedef short s16x4 __attribute__((ext_vector_type(4)));
DI s16x4 tr_read(const LAS char* a) { return __builtin_bit_cast(s16x4, __builtin_amdgcn_ds_read_tr16_b64_v4i16((LAS s16x4*)a)); }
DI float half_max(float m) { auto rr = __builtin_amdgcn_permlane32_swap(__float_as_uint(m), __float_as_uint(m), false, false); return fmaxf(__uint_as_float(rr[0]), __uint_as_float(rr[1])); }
DI float half_sum(float m) { auto rr = __builtin_amdgcn_permlane32_swap(__float_as_uint(m), __float_as_uint(m), false, false); return __uint_as_float(rr[0]) + __uint_as_float(rr[1]); }
DI bf16x8 pack8(const f32x16& x, int s8) {
  typedef unsigned u32x4 __attribute__((ext_vector_type(4)));
  u32x4 r;
  r[0] = cvtpk(x[s8 + 0], x[s8 + 1]); r[1] = cvtpk(x[s8 + 2], x[s8 + 3]); r[2] = cvtpk(x[s8 + 4], x[s8 + 5]); r[3] = cvtpk(x[s8 + 6], x[s8 + 7]);
  return __builtin_bit_cast(bf16x8, r);
}
constexpr int AT_STAGE = 20480;

DI float max3f(float a, float b, float c) { float r; asm("v_max3_f32 %0, %1, %2, %3" : "=v"(r) : "v"(a), "v"(b), "v"(c)); return r; }
template <bool MLA, bool SWA>
DI void attn_unit(const Params& p, int layer, int isctx, int b, int h, int qb, LAS char* lds) {
  char* ws = p.ws;
  const int tid = opaque((int)threadIdx.x), lane = tid & 63, wid = tid >> 6, r32 = lane & 31, hi = lane >> 5;
  const u16 *Qg, *Kg, *Vg; int ldq, ldk, qoff, koff, ycol; float cs;
  if (MLA) { Qg = (const u16*)(ws + OFF_MLQ); Kg = (const u16*)(ws + OFF_MLK); Vg = (const u16*)(ws + OFF_MLV); ldq = 384; ldk = 256; qoff = h * 96; koff = h * 64; ycol = 768 + h * 64; cs = 0.10206207261596575f * 1.4426950408889634f; }
  else if (!SWA) { Qg = (const u16*)(ws + OFF_GLQ); Kg = (const u16*)(ws + OFF_GLK); Vg = (const u16*)(ws + OFF_GLV); ldq = 384; ldk = 128; qoff = h * 64; koff = (h / 3) * 64; ycol = 384 + h * 64; cs = 0.125f * 1.4426950408889634f; }
  else { Qg = (const u16*)(ws + OFF_SWQ); Kg = (const u16*)(ws + OFF_SWK); Vg = (const u16*)(ws + OFF_SWV); ldq = 384; ldk = 128; qoff = h * 64; koff = (h / 3) * 64; ycol = h * 64; cs = 0.125f * 1.4426950408889634f; }
  const u16* Rg = (const u16*)(ws + OFF_MLKR);
  const int q0 = qb * 128;
  const int qrow0 = (isctx ? NL + b * C_ : b * S_) + q0;
  const int qw = q0 + wid * 32;
  int lat_first = 0, nlat = 0;
  if (!isctx) { if (SWA) { lat_first = 2 * qb - 2; if (lat_first < 0) lat_first = 0; int lat_last = 2 * qb + 3; if (lat_last > 63) lat_last = 63; nlat = lat_last - lat_first + 1; } else nlat = 64; }
  const int T = 4 + nlat;
  constexpr int NQ = MLA ? 6 : 4;
  bf16x8 qf[NQ];
  {
    const u16* qp = Qg + (size_t)(qrow0 + wid * 32 + r32) * ldq + qoff + hi * 8;
#pragma unroll
    for (int d0 = 0; d0 < NQ; ++d0) {
      const u32x4_t raw = *(const u32x4_t*)(qp + d0 * 16);
      u32x4_t sc;
#pragma unroll
      for (int i = 0; i < 4; ++i) sc[i] = cvtpk(bflo(raw[i]) * cs, bfhi(raw[i]) * cs);
      qf[d0] = __builtin_bit_cast(bf16x8, sc);
    }
  }
  int kaddr[4];
#pragma unroll
  for (int d0 = 0; d0 < 4; ++d0) kaddr[d0] = r32 * 128 + (((d0 * 2 + hi) ^ ((r32 >> 1) & 7)) * 16);
  int kraddr[2];
#pragma unroll
  for (int e = 0; e < 2; ++e) kraddr[e] = 16384 + r32 * 64 + (((e * 2 + hi) ^ ((r32 >> 3) & 3)) * 16);
  int vbo[2];
  {
    const int i16 = lane & 15, sw = (lane >> 3) & 1;
    const int x = ((lane >> 4) & 1) * 32 + (lane & 3) * 8;
    const int rowpart = ((i16 >> 2) + 4 * hi) * 128;
    vbo[0] = 8192 + rowpart + x + (sw * 64);
    vbo[1] = 8192 + rowpart + x + ((1 - sw) * 64);
  }
  const int skey = tid >> 3;
  const int kch = ((tid & 7) ^ ((tid >> 4) & 7)) * 8;
  const int vch = ((tid & 7) ^ (((tid >> 4) & 1) << 2)) * 8;
  const int rkey = tid >> 2, rch = ((tid & 3) ^ ((tid >> 5) & 3)) * 8;
  LAS char* ldst = lds + tid * 16;
#define AT_ISSUE(j, st) do { const int _j = (j); const int _kr = _j < 4 ? NL + b * C_ + 64 * _j : b * S_ + 64 * (lat_first + _j - 4); \
    LAS char* _d = ldst + (st) * AT_STAGE; \
    const u16* _k = Kg + (size_t)(_kr + skey) * ldk + koff + kch; glds16(_k, _d); glds16(_k + (size_t)32 * ldk, _d + 4096); \
    const u16* _v = Vg + (size_t)(_kr + skey) * ldk + koff + vch; glds16(_v, _d + 8192); glds16(_v + (size_t)32 * ldk, _d + 8192 + 4096); \
    if (MLA) glds16(Rg + (size_t)(_kr + rkey) * 32 + rch, _d + 16384); } while (0)
#define AT_QK(sb, P0, P1) do { \
    bf16x8 kk0[MLA ? 6 : 4], kk1[MLA ? 6 : 4]; \
    _Pragma("unroll") for (int d0 = 0; d0 < 4; ++d0) { kk0[d0] = *(const LAS bf16x8*)((sb) + kaddr[d0]); kk1[d0] = *(const LAS bf16x8*)((sb) + kaddr[d0] + 4096); } \
    if (MLA) { _Pragma("unroll") for (int e = 0; e < 2; ++e) { kk0[MLA ? 4 + e : 0] = *(const LAS bf16x8*)((sb) + kraddr[e]); kk1[MLA ? 4 + e : 0] = *(const LAS bf16x8*)((sb) + kraddr[e] + 2048); } } \
    __builtin_amdgcn_sched_barrier(0);     \
    P0 = __builtin_amdgcn_mfma_f32_32x32x16_bf16(kk0[0], qf[0], negm, 0, 0, 0); P1 = __builtin_amdgcn_mfma_f32_32x32x16_bf16(kk1[0], qf[0], negm, 0, 0, 0); \
    _Pragma("unroll") for (int d0 = 1; d0 < (MLA ? 6 : 4); ++d0) { \
      P0 = __builtin_amdgcn_mfma_f32_32x32x16_bf16(kk0[d0], qf[d0], P0, 0, 0, 0); P1 = __builtin_amdgcn_mfma_f32_32x32x16_bf16(kk1[d0], qf[d0], P1, 0, 0, 0); } \
  } while (0)
#define AT_WSTATE(jj, pos0v, st) do { st = 0; pos0v = 64 * (lat_first + (jj) - 4); if (SWA && (jj) >= 4) { \
      if (pos0v + 63 < qw - 128 || pos0v > qw + 31 + 128) st = 2; else if (qw + 31 - pos0v > 128 || pos0v + 63 - qw > 128) st = 1; } } while (0)
#define AT_SOFTMAX(P0, P1, PA, wst, pos0v, FIRST) do { \
    if (SWA && wst == 1) { const int dq = qw + r32 - pos0v - 4 * hi + 128; \
      _Pragma("unroll") for (int r = 0; r < 16; ++r) { const int cr = (r & 3) + 8 * (r >> 2); \
        if ((unsigned)(dq - cr) > 256u) P0[r] = -1e30f; if ((unsigned)(dq - cr - 32) > 256u) P1[r] = -1e30f; } } \
    asm volatile("s_nop 15\n\ts_nop 15" : "+v"(P0), "+v"(P1));     \
    float mx = max3f(P0[0], P0[1], P1[0]); mx = max3f(mx, P1[1], P0[2]); \
    _Pragma("unroll") for (int r = 3; r < 16; r += 2) { mx = max3f(mx, P0[r], P0[(r + 1) & 15]); } \
    _Pragma("unroll") for (int r = 2; r < 16; r += 2) { mx = max3f(mx, P1[r], P1[r + 1]); } \
    mx = half_max(mx); \
    if ((FIRST) || __ballot(mx > 8.0f) != 0ull) { \
      const float delta = (FIRST) ? mx : fmaxf(mx, 0.f); \
      const float al = __builtin_amdgcn_exp2f(-delta); \
      m_run += delta; \
      _Pragma("unroll") for (int i = 0; i < 16; ++i) { o[0][i] *= al; o[1][i] *= al; P0[i] -= delta; P1[i] -= delta; negm[i] = -m_run; } \
      osum[0] *= al; \
    } \
    _Pragma("unroll") for (int r = 0; r < 16; ++r) { P0[r] = __builtin_amdgcn_exp2f(P0[r]); P1[r] = __builtin_amdgcn_exp2f(P1[r]); } \
    PA[0] = pack8(P0, 0); PA[1] = pack8(P0, 8); PA[2] = pack8(P1, 0); PA[3] = pack8(P1, 8); \
  } while (0)
#define AT_PV(sb, PA) do { \
    bf16x8 vf[2][4]; \
    _Pragma("unroll") for (int db = 0; db < 2; ++db) { _Pragma("unroll") for (int ts = 0; ts < 4; ++ts) { \
      const LAS char* va = (sb) + vbo[db] + ts * 2048; const s16x4 lo = tr_read(va), hh = tr_read(va + 1024); \
      vf[db][ts] = __builtin_shufflevector(lo, hh, 0, 1, 2, 3, 4, 5, 6, 7); } } \
    __builtin_amdgcn_sched_barrier(0);     \
    _Pragma("unroll") for (int ts = 0; ts < 4; ++ts) osum = __builtin_amdgcn_mfma_f32_32x32x16_bf16(ones, PA[ts], osum, 0, 0, 0); \
    _Pragma("unroll") for (int db = 0; db < 2; ++db) { _Pragma("unroll") for (int ts = 0; ts < 4; ++ts) \
      o[db] = __builtin_amdgcn_mfma_f32_32x32x16_bf16(vf[db][ts], PA[ts], o[db], 0, 0, 0); } } while (0)

  float m_run = SWA ? p.swa_sink[layer * 6 + h] * 1.4426950408889634f : 0.f;
  f32x16 o[2], osum, negm;
#pragma unroll
  for (int i = 0; i < 16; ++i) { o[0][i] = 0.f; o[1][i] = 0.f; osum[i] = SWA ? 1.f : 0.f; negm[i] = -m_run; }
  bf16x8 ones;
#pragma unroll
  for (int i = 0; i < 8; ++i) ones[i] = (short)0x3F80;
  bf16x8 pa[4];
  f32x16 s0, s1;
  AT_ISSUE(0, 0);
  asm volatile("s_waitcnt vmcnt(0)" ::: "memory");
  __syncthreads();
  AT_ISSUE(1, 1);
  AT_QK(lds, s0, s1);
  { int wst = 0, pos0v = 0; AT_SOFTMAX(s0, s1, pa, wst, pos0v, !SWA); }
  bool cur_skip = false;
#pragma unroll 1
  for (int j = 0; j < T - 1; ++j) {
    asm volatile("s_waitcnt vmcnt(0)" ::: "memory");
    __syncthreads();
    const int st_cur = j % 3, st_nxt = (j + 1) % 3;
    if (j + 2 < T) AT_ISSUE(j + 2, (j + 2) % 3);
    const LAS char* sbn = lds + st_nxt * AT_STAGE;
    const LAS char* sbc = lds + st_cur * AT_STAGE;
    int wst, pos0v; AT_WSTATE(j + 1, pos0v, wst);
    if (!SWA || wst != 2) AT_QK(sbn, s0, s1);
    if (!SWA || !cur_skip) AT_PV(sbc, pa);
    if (!SWA || wst != 2) {
      bf16x8 pn[4];
      AT_SOFTMAX(s0, s1, pn, wst, pos0v, false);
      pa[0] = pn[0]; pa[1] = pn[1]; pa[2] = pn[2]; pa[3] = pn[3];
      cur_skip = false;
    } else cur_skip = true;
  }
  if (!SWA || !cur_skip) { const LAS char* sbc = lds + ((T - 1) % 3) * AT_STAGE; AT_PV(sbc, pa); }
#undef AT_ISSUE
#undef AT_QK
#undef AT_WSTATE
#undef AT_SOFTMAX
#undef AT_PV
  const float inv = 1.f / osum[0];
  u16* yp = (u16*)(ws + OFF_Y) + (size_t)(qrow0 + wid * 32 + r32) * 1024 + ycol + 4 * hi;
#pragma unroll
  for (int db = 0; db < 2; ++db)
#pragma unroll
    for (int g = 0; g < 4; ++g) {
      uint2 w; w.x = cvtpk(o[db][4 * g] * inv, o[db][4 * g + 1] * inv); w.y = cvtpk(o[db][4 * g + 2] * inv, o[db][4 * g + 3] * inv);
      *(uint2*)(yp + db * 32 + 8 * g) = w;
    }
  __syncthreads();
}


typedef float f32x4v __attribute__((ext_vector_type(4)));
#define MFMA16(a, b, c) __builtin_amdgcn_mfma_f32_16x16x32_bf16((a), (b), (c), 0, 0, 0)
DI float quad_max_x(float m) {
  { auto rr = __builtin_amdgcn_permlane16_swap(__float_as_uint(m), __float_as_uint(m), false, false); m = fmaxf(__uint_as_float(rr[0]), __uint_as_float(rr[1])); }
  { auto rr = __builtin_amdgcn_permlane32_swap(__float_as_uint(m), __float_as_uint(m), false, false); m = fmaxf(__uint_as_float(rr[0]), __uint_as_float(rr[1])); }
  return m;
}
template <bool MLA, bool SWA>
DI void attn_unit16(const Params& p, int layer, int isctx, int b, int h, int qb, LAS char* lds) {
  char* ws = p.ws;
  const int tid = opaque((int)threadIdx.x), lane = tid & 63, wid = tid >> 6, c16 = lane & 15, g = lane >> 4;
  const u16 *Qg, *Kg, *Vg; int ldq, ldk, qoff, koff, ycol; float cs;
  if (MLA) { Qg = (const u16*)(ws + OFF_MLQ); Kg = (const u16*)(ws + OFF_MLK); Vg = (const u16*)(ws + OFF_MLV); ldq = 384; ldk = 256; qoff = h * 96; koff = h * 64; ycol = 768 + h * 64; cs = 0.10206207261596575f * 1.4426950408889634f; }
  else if (!SWA) { Qg = (const u16*)(ws + OFF_GLQ); Kg = (const u16*)(ws + OFF_GLK); Vg = (const u16*)(ws + OFF_GLV); ldq = 384; ldk = 128; qoff = h * 64; koff = (h / 3) * 64; ycol = 384 + h * 64; cs = 0.125f * 1.4426950408889634f; }
  else { Qg = (const u16*)(ws + OFF_SWQ); Kg = (const u16*)(ws + OFF_SWK); Vg = (const u16*)(ws + OFF_SWV); ldq = 384; ldk = 128; qoff = h * 64; koff = (h / 3) * 64; ycol = h * 64; cs = 0.125f * 1.4426950408889634f; }
  const u16* Rg = (const u16*)(ws + OFF_MLKR);
  const int q0 = qb * 128;
  const int qrow0 = (isctx ? NL + b * C_ : b * S_) + q0;
  const int qw = q0 + wid * 32;
  int lat_first = 0, nlat = 0;
  if (!isctx) { if (SWA) { lat_first = 2 * qb - 2; if (lat_first < 0) lat_first = 0; int lat_last = 2 * qb + 3; if (lat_last > 63) lat_last = 63; nlat = lat_last - lat_first + 1; } else nlat = 64; }
  const int T = 4 + nlat;
  constexpr int NS = MLA ? 3 : 2;
  bf16x8 qf[2][NS];
#pragma unroll
  for (int bq = 0; bq < 2; ++bq) {
    const u16* qp = Qg + (size_t)(qrow0 + wid * 32 + bq * 16 + c16) * ldq + qoff + g * 8;
#pragma unroll
    for (int s = 0; s < NS; ++s) {
      const u32x4_t raw = *(const u32x4_t*)(qp + s * 32);
      u32x4_t sc;
#pragma unroll
      for (int i = 0; i < 4; ++i) sc[i] = cvtpk(bflo(raw[i]) * cs, bfhi(raw[i]) * cs);
      qf[bq][s] = __builtin_bit_cast(bf16x8, sc);
    }
  }
  int kaddr[2];
#pragma unroll
  for (int s = 0; s < 2; ++s) kaddr[s] = c16 * 128 + (((4 * s + g) ^ ((c16 >> 1) & 7)) * 16);
  const int kraddr = 16384 + c16 * 64 + ((g ^ ((0 - (c16 >> 2)) & 3)) * 16);
  int vbo[4];
#pragma unroll
  for (int d = 0; d < 4; ++d) vbo[d] = 8192 + (4 * g + (c16 >> 2)) * 128 + ((d ^ ((lane >> 3) & 3)) * 32) + (lane & 3) * 8;
  const int skey = tid >> 3;
  const int kch = ((tid & 7) ^ ((tid >> 4) & 7)) * 8;
  const int vch = ((tid & 7) ^ (((tid >> 4) & 3) << 1)) * 8;
  const int rkey = tid >> 2, rch = ((tid & 3) ^ ((0 - (tid >> 4)) & 3)) * 8;
  LAS char* ldst = lds + tid * 16;
#define A6_ISSUE(j, st) do { const int _j = (j); const int _kr = _j < 4 ? NL + b * C_ + 64 * _j : b * S_ + 64 * (lat_first + _j - 4); \
    LAS char* _d = ldst + (st) * AT_STAGE; \
    const u16* _k = Kg + (size_t)(_kr + skey) * ldk + koff + kch; glds16(_k, _d); glds16(_k + (size_t)32 * ldk, _d + 4096); \
    const u16* _v = Vg + (size_t)(_kr + skey) * ldk + koff + vch; glds16(_v, _d + 8192); glds16(_v + (size_t)32 * ldk, _d + 8192 + 4096); \
    if (MLA) glds16(Rg + (size_t)(_kr + rkey) * 32 + rch, _d + 16384); } while (0)
#define A6_QK(sb) do { \
    bf16x8 kk[4][NS]; \
    _Pragma("unroll") for (int a = 0; a < 4; ++a) { kk[a][0] = *(const LAS bf16x8*)((sb) + kaddr[0] + a * 2048); kk[a][1] = *(const LAS bf16x8*)((sb) + kaddr[1] + a * 2048); \
      if (MLA) kk[a][MLA ? 2 : 0] = *(const LAS bf16x8*)((sb) + kraddr + a * 1024); } \
    __builtin_amdgcn_sched_barrier(0); \
    _Pragma("unroll") for (int a = 0; a < 4; ++a) { _Pragma("unroll") for (int bq = 0; bq < 2; ++bq) { \
      S[a][bq] = MFMA16(kk[a][0], qf[bq][0], negm[bq]); \
      _Pragma("unroll") for (int s = 1; s < NS; ++s) S[a][bq] = MFMA16(kk[a][s], qf[bq][s], S[a][bq]); } } \
  } while (0)
#define A6_WSTATE(jj, pos0v, st) do { st = 0; pos0v = 64 * (lat_first + (jj) - 4); if (SWA && (jj) >= 4) { \
      if (pos0v + 63 < qw - 128 || pos0v > qw + 31 + 128) st = 2; else if (qw + 31 - pos0v > 128 || pos0v + 63 - qw > 128) st = 1; } } while (0)
#define A6_SOFTMAX(PA, wst, pos0v, FIRST, CHECK) do { \
    if (SWA && wst == 1) { _Pragma("unroll") for (int bq = 0; bq < 2; ++bq) { const int dq = qw + 16 * bq + c16 - pos0v - 4 * g + 128; \
      _Pragma("unroll") for (int a = 0; a < 4; ++a) { _Pragma("unroll") for (int r = 0; r < 4; ++r) { if ((unsigned)(dq - (16 * a + r)) > 256u) S[a][bq][r] = -1e30f; } } } } \
    float mx[2] = {0.f, 0.f}; \
    if (CHECK) { \
    asm volatile("s_nop 15\n\ts_nop 15" : "+v"(S[0][0]), "+v"(S[0][1]), "+v"(S[1][0]), "+v"(S[1][1]), "+v"(S[2][0]), "+v"(S[2][1]), "+v"(S[3][0]), "+v"(S[3][1])); \
    _Pragma("unroll") for (int bq = 0; bq < 2; ++bq) { \
      float m_ = max3f(S[0][bq][0], S[0][bq][1], S[0][bq][2]); m_ = max3f(m_, S[0][bq][3], S[1][bq][0]); \
      m_ = max3f(m_, S[1][bq][1], S[1][bq][2]); m_ = max3f(m_, S[1][bq][3], S[2][bq][0]); m_ = max3f(m_, S[2][bq][1], S[2][bq][2]); \
      m_ = max3f(m_, S[2][bq][3], S[3][bq][0]); m_ = max3f(m_, S[3][bq][1], S[3][bq][2]); m_ = fmaxf(m_, S[3][bq][3]); \
      mx[bq] = quad_max_x(m_); } } \
    if ((FIRST) || ((CHECK) && __ballot(fmaxf(mx[0], mx[1]) > 8.0f) != 0ull)) { \
      _Pragma("unroll") for (int bq = 0; bq < 2; ++bq) { \
        const float delta = (FIRST) ? mx[bq] : fmaxf(mx[bq], 0.f); \
        const float al = __builtin_amdgcn_exp2f(-delta); \
        m_run[bq] += delta; \
        _Pragma("unroll") for (int a = 0; a < 4; ++a) { S[a][bq] = S[a][bq] - delta; o[a][bq] = o[a][bq] * al; } \
        negm[bq] = (f32x4v){-m_run[bq], -m_run[bq], -m_run[bq], -m_run[bq]}; \
        osum[bq] = osum[bq] * al; } \
    } \
    _Pragma("unroll") for (int a = 0; a < 4; ++a) { _Pragma("unroll") for (int bq = 0; bq < 2; ++bq) { _Pragma("unroll") for (int r = 0; r < 4; ++r) S[a][bq][r] = __builtin_amdgcn_exp2f(S[a][bq][r]); } } \
    _Pragma("unroll") for (int ks = 0; ks < 2; ++ks) { _Pragma("unroll") for (int bq = 0; bq < 2; ++bq) { u32x4_t w_; \
      w_[0] = cvtpk(S[2 * ks][bq][0], S[2 * ks][bq][1]); w_[1] = cvtpk(S[2 * ks][bq][2], S[2 * ks][bq][3]); \
      w_[2] = cvtpk(S[2 * ks + 1][bq][0], S[2 * ks + 1][bq][1]); w_[3] = cvtpk(S[2 * ks + 1][bq][2], S[2 * ks + 1][bq][3]); \
      PA[ks][bq] = __builtin_bit_cast(bf16x8, w_); } } \
  } while (0)
#define A6_PV(sb, PA) do { \
    bf16x8 vf[2][4]; \
    _Pragma("unroll") for (int ks = 0; ks < 2; ++ks) { _Pragma("unroll") for (int d = 0; d < 4; ++d) { \
      const LAS char* va = (sb) + vbo[d] + ks * 4096; const s16x4 lo = tr_read(va), hh = tr_read(va + 2048); \
      vf[ks][d] = __builtin_shufflevector(lo, hh, 0, 1, 2, 3, 4, 5, 6, 7); } } \
    __builtin_amdgcn_sched_barrier(0); \
    _Pragma("unroll") for (int ks = 0; ks < 2; ++ks) { _Pragma("unroll") for (int bq = 0; bq < 2; ++bq) osum[bq] = MFMA16(ones, PA[ks][bq], osum[bq]); } \
    _Pragma("unroll") for (int d = 0; d < 4; ++d) { _Pragma("unroll") for (int bq = 0; bq < 2; ++bq) { _Pragma("unroll") for (int ks = 0; ks < 2; ++ks) \
      o[d][bq] = MFMA16(vf[ks][d], PA[ks][bq], o[d][bq]); } } } while (0)

  float m_run[2];
  m_run[0] = m_run[1] = SWA ? p.swa_sink[layer * 6 + h] * 1.4426950408889634f : 0.f;
  f32x4v S[4][2], o[4][2], osum[2], negm[2];
#pragma unroll
  for (int bq = 0; bq < 2; ++bq) {
    const float i1 = SWA ? 1.f : 0.f;
    osum[bq] = (f32x4v){i1, i1, i1, i1}; negm[bq] = (f32x4v){-m_run[bq], -m_run[bq], -m_run[bq], -m_run[bq]};
#pragma unroll
    for (int d = 0; d < 4; ++d) o[d][bq] = (f32x4v){0.f, 0.f, 0.f, 0.f};
  }
  bf16x8 ones;
#pragma unroll
  for (int i = 0; i < 8; ++i) ones[i] = (short)0x3F80;
  bf16x8 pa[2][2];
  A6_ISSUE(0, 0);
  asm volatile("s_waitcnt vmcnt(0)" ::: "memory");
  __syncthreads();
  A6_ISSUE(1, 1);
  A6_QK(lds);
  { int wst = 0, pos0v = 0; A6_SOFTMAX(pa, wst, pos0v, !SWA, true); }
  bool cur_skip = false;
#pragma unroll 1
  for (int j = 0; j < T - 1; ++j) {
    asm volatile("s_waitcnt vmcnt(0)" ::: "memory");
    __syncthreads();
    if (j + 2 < T) A6_ISSUE(j + 2, (j + 2) % 3);
    const LAS char* sbn = lds + ((j + 1) % 3) * AT_STAGE;
    const LAS char* sbc = lds + (j % 3) * AT_STAGE;
    int wst, pos0v; A6_WSTATE(j + 1, pos0v, wst);
    if (!SWA || wst != 2) A6_QK(sbn);
    if (!SWA || !cur_skip) A6_PV(sbc, pa);
    if (!SWA || wst != 2) {
      bf16x8 pn[2][2];
      A6_SOFTMAX(pn, wst, pos0v, false, (SWA || (j & 7) == 7));
      pa[0][0] = pn[0][0]; pa[0][1] = pn[0][1]; pa[1][0] = pn[1][0]; pa[1][1] = pn[1][1];
      cur_skip = false;
    } else cur_skip = true;
  }
  if (!SWA || !cur_skip) { const LAS char* sbc = lds + ((T - 1) % 3) * AT_STAGE; A6_PV(sbc, pa); }
#undef A6_ISSUE
#undef A6_QK
#undef A6_WSTATE
#undef A6_SOFTMAX
#undef A6_PV
#pragma unroll
  for (int bq = 0; bq < 2; ++bq) {
    const float inv = 1.f / osum[bq][0];
    u16* yp = (u16*)(ws + OFF_Y) + (size_t)(qrow0 + wid * 32 + bq * 16 + c16) * 1024 + ycol + 4 * g;
#pragma unroll
    for (int d = 0; d < 4; ++d) {
      u32x2_t w; w[0] = cvtpk(o[d][bq][0] * inv, o[d][bq][1] * inv); w[1] = cvtpk(o[d][bq][2] * inv, o[d][bq][3] * inv);
      *(u32x2_t*)(yp + d * 16) = w;
    }
  }
  __syncthreads();
}

DI void p3_attention(const Params& p, int layer, LAS char* lds, int cs = 0) {
  unsigned* ctr8 = (unsigned*)(p.ws + OFF_CTRL) + CW_Q + (layer * 2 + 0) * 512;
  const int per_q = 512 + (layer == 0 ? 32 : 0);
  for (;;) {
    const int u = next_unit_xcd(ctr8, per_q, lds);
    if (u < 0) break;
    const int b = u / per_q, v = u % per_q;
    if (v < 128) { attn_unit16<true, false>(p, layer, 0, b, v >> 5, v & 31, lds); }
    else if (v < 320) { const int w = v - 128; attn_unit16<false, false>(p, layer, 0, b, w >> 5, w & 31, lds); }
    else if (v < 512) { const int w = v - 320; attn_unit16<false, true>(p, layer, 0, b, w >> 5, w & 31, lds); }
    else {
      const int w = v - 512;
      if (w < 8) attn_unit16<true, false>(p, layer, 1, b, w >> 1, w & 1, lds);
      else if (w < 20) { const int x = w - 8; attn_unit16<false, false>(p, layer, 1, b, x >> 1, x & 1, lds); }
      else { const int x = w - 20; attn_unit16<false, true>(p, layer, 1, b, x >> 1, x & 1, lds); }
    }
  }
}

struct AttnArgs {
  const u16* Q; const u16* K; const u16* K2; const u16* V; u16* Y; const float* sink;
  int ldq, ldk, ldk2, ldv, ldy, ycol, G, window, q_is_ctx; float scale;
};
static_assert(sizeof(AttnArgs) == 88, "no padding");
template <int DK1, int DK2>
__global__ __launch_bounds__(64) void k_attn(AttnArgs a) {
  const int qt = blockIdx.x * 64 + threadIdx.x, b = blockIdx.y, h = blockIdx.z, kvh = h / a.G;
  const int qrow = a.q_is_ctx ? NL + b * C_ + qt : b * S_ + qt;
  float q[DK1 + DK2];
  {
    const uint4* qp = (const uint4*)(a.Q + (size_t)qrow * a.ldq + h * (DK1 + DK2));
#pragma unroll
    for (int i = 0; i < (DK1 + DK2) / 8; ++i) {
      uint4 u = qp[i];
      q[i * 8 + 0] = bflo(u.x) * a.scale; q[i * 8 + 1] = bfhi(u.x) * a.scale; q[i * 8 + 2] = bflo(u.y) * a.scale; q[i * 8 + 3] = bfhi(u.y) * a.scale;
      q[i * 8 + 4] = bflo(u.z) * a.scale; q[i * 8 + 5] = bfhi(u.z) * a.scale; q[i * 8 + 6] = bflo(u.w) * a.scale; q[i * 8 + 7] = bfhi(u.w) * a.scale;
    }
  }
  float m, l, o[64];
  if (a.sink) { m = a.sink[h]; l = 1.f; } else { m = -1e30f; l = 0.f; }
#pragma unroll
  for (int d = 0; d < 64; ++d) o[d] = 0.f;
  const int nseg = a.q_is_ctx ? 1 : 2;
  for (int seg = 0; seg < nseg; ++seg) {
    int lo, hi, rbase; bool masked = false;
    if (seg == 0) { lo = 0; hi = C_; rbase = NL + b * C_; }
    else {
      lo = 0; hi = S_; rbase = b * S_;
      if (a.window) { int t0 = blockIdx.x * 64; lo = t0 - a.window; if (lo < 0) lo = 0; hi = t0 + 64 + a.window; if (hi > S_) hi = S_; masked = true; }
    }
    for (int s = lo; s < hi; s += 4) {
      float sc[4];
#pragma unroll
      for (int i = 0; i < 4; ++i) {
        const uint4* kp = (const uint4*)(a.K + (size_t)(rbase + s + i) * a.ldk + kvh * DK1);
        float dot = 0.f;
#pragma unroll
        for (int c = 0; c < DK1 / 8; ++c) {
          uint4 u = kp[c];
          dot += q[c * 8 + 0] * bflo(u.x) + q[c * 8 + 1] * bfhi(u.x) + q[c * 8 + 2] * bflo(u.y) + q[c * 8 + 3] * bfhi(u.y)
               + q[c * 8 + 4] * bflo(u.z) + q[c * 8 + 5] * bfhi(u.z) + q[c * 8 + 6] * bflo(u.w) + q[c * 8 + 7] * bfhi(u.w);
        }
        if (DK2 > 0) {
          const uint4* kp2 = (const uint4*)(a.K2 + (size_t)(rbase + s + i) * a.ldk2);
#pragma unroll
          for (int c = 0; c < DK2 / 8; ++c) {
            uint4 u = kp2[c];
            dot += q[DK1 + c * 8 + 0] * bflo(u.x) + q[DK1 + c * 8 + 1] * bfhi(u.x) + q[DK1 + c * 8 + 2] * bflo(u.y) + q[DK1 + c * 8 + 3] * bfhi(u.y)
                 + q[DK1 + c * 8 + 4] * bflo(u.z) + q[DK1 + c * 8 + 5] * bfhi(u.z) + q[DK1 + c * 8 + 6] * bflo(u.w) + q[DK1 + c * 8 + 7] * bfhi(u.w);
          }
        }
        if (masked) { int dlt = qt - (s + i); if (dlt < 0) dlt = -dlt; if (dlt > a.window) dot = -1e30f; }
        sc[i] = dot;
      }
      float mx = fmaxf(fmaxf(fmaxf(sc[0], sc[1]), fmaxf(sc[2], sc[3])), m);
      const float alpha = __expf(m - mx);
      float pr[4];
#pragma unroll
      for (int i = 0; i < 4; ++i) pr[i] = __expf(sc[i] - mx);
      l = l * alpha + (pr[0] + pr[1]) + (pr[2] + pr[3]);
      m = mx;
#pragma unroll
      for (int d = 0; d < 64; ++d) o[d] *= alpha;
#pragma unroll
      for (int i = 0; i < 4; ++i) {
        const uint4* vp = (const uint4*)(a.V + (size_t)(rbase + s + i) * a.ldv + kvh * 64);
#pragma unroll
        for (int c = 0; c < 8; ++c) {
          uint4 u = vp[c];
          o[c * 8 + 0] += pr[i] * bflo(u.x); o[c * 8 + 1] += pr[i] * bfhi(u.x); o[c * 8 + 2] += pr[i] * bflo(u.y); o[c * 8 + 3] += pr[i] * bfhi(u.y);
          o[c * 8 + 4] += pr[i] * bflo(u.z); o[c * 8 + 5] += pr[i] * bfhi(u.z); o[c * 8 + 6] += pr[i] * bflo(u.w); o[c * 8 + 7] += pr[i] * bfhi(u.w);
        }
      }
    }
  }
  const float inv = 1.f / l;
  uint4* yp = (uint4*)(a.Y + (size_t)qrow * a.ldy + a.ycol + h * 64);
#pragma unroll
  for (int c = 0; c < 8; ++c) {
    uint4 u;
    u.x = cvtpk(o[c * 8 + 0] * inv, o[c * 8 + 1] * inv); u.y = cvtpk(o[c * 8 + 2] * inv, o[c * 8 + 3] * inv);
    u.z = cvtpk(o[c * 8 + 4] * inv, o[c * 8 + 5] * inv); u.w = cvtpk(o[c * 8 + 6] * inv, o[c * 8 + 7] * inv);
    yp[c] = u;
  }
}


constexpr int CW_BAR = 1024;
#define XB_TMO      128
#define XB_XCNT(j)  (256  + 64 * (j))
#define XB_XSUB(j)  (1280 + 64 * (j))
#define XB_XGEN(j)  (2304 + 64 * (j))
#define XB_TOP      3328
#define XB_TOPGEN   3392
#define XCD_BAR_WORDS 3456
#define XB_SPIN_CAP (1u << 22)
DI unsigned xb_ld(unsigned* p) { return __hip_atomic_load(p, __ATOMIC_RELAXED, __HIP_MEMORY_SCOPE_AGENT); }
DI unsigned xb_add(unsigned* p, unsigned v) { return __hip_atomic_fetch_add(p, v, __ATOMIC_RELAXED, __HIP_MEMORY_SCOPE_AGENT); }
DI unsigned xb_xcc_id() { return (unsigned)__builtin_amdgcn_s_getreg((3 << 11) | 20) & 0xFu; }
#define XB_SPIN(cond, bar) do { unsigned _sp = 0; while (cond) { __builtin_amdgcn_s_sleep(1); \
    if ((++_sp & 255u) == 0u) { if (xb_ld(&(bar)[XB_TMO])) break; if (_sp > XB_SPIN_CAP) { atomicAdd(&(bar)[XB_TMO], 1u); break; } } } } while (0)
struct XcdBarrier { unsigned* bar; unsigned x; volatile LAS unsigned* st; };
DI XcdBarrier xcd_barrier_post(unsigned* bar, volatile LAS unsigned* st) {
  XcdBarrier b; b.bar = bar; b.x = xb_xcc_id(); b.st = st;
  if (threadIdx.x == 0) (void)xb_add(&bar[XB_XCNT(b.x)], 1u);
  return b;
}
DI void xcd_barrier_complete(unsigned* bar, unsigned x, unsigned& nloc, unsigned& nx) {
  const unsigned G = gridDim.x * gridDim.y * gridDim.z;
  unsigned sum, cnt, mine, sp = 0u;
  for (;;) {
    sum = 0u; cnt = 0u; mine = 0u;
#pragma unroll
    for (unsigned j = 0; j < 16; ++j) { const unsigned c = xb_ld(&bar[XB_XCNT(j)]); sum += c; cnt += (c > 0u) ? 1u : 0u; mine = (j == x) ? c : mine; }
    if (sum == G) break;
    __builtin_amdgcn_s_sleep(1);
    if ((++sp & 255u) == 0u) { if (xb_ld(&bar[XB_TMO])) break; if (sp > XB_SPIN_CAP) { atomicAdd(&bar[XB_TMO], 1u); break; } }
  }
  nloc = mine > 0u ? mine : 1u; nx = cnt > 0u ? cnt : 1u;
}
DI void xcd_barrier(const XcdBarrier& b) {
  asm volatile("s_waitcnt vmcnt(0)" ::: "memory");
  __syncthreads();
  if (threadIdx.x == 0) {
    unsigned* bar = b.bar;
    __builtin_amdgcn_s_waitcnt(0);
    unsigned nloc = b.st[0], nx = b.st[1];
    if (nloc == 0u) { xcd_barrier_complete(bar, b.x, nloc, nx); b.st[0] = nloc; b.st[1] = nx; }
    const unsigned old = xb_add(&bar[XB_XSUB(b.x)], 1u);
    const unsigned gen = old / nloc;
    if (old + 1u == (gen + 1u) * nloc) {
      __builtin_amdgcn_fence(__ATOMIC_RELEASE, "agent");
      asm volatile("s_waitcnt vmcnt(0)" ::: "memory");
      const unsigned og = xb_add(&bar[XB_TOP], 1u);
      const unsigned tg = og / nx;
      if (og + 1u == (tg + 1u) * nx) xb_add(&bar[XB_TOPGEN], 1u);
      else XB_SPIN(xb_ld(&bar[XB_TOPGEN]) == tg, bar);
      __builtin_amdgcn_fence(__ATOMIC_ACQUIRE, "agent");
      xb_add(&bar[XB_XGEN(b.x)], 1u);
      asm volatile("s_waitcnt vmcnt(0)" ::: "memory");
    } else {
      XB_SPIN(xb_ld(&bar[XB_XGEN(b.x)]) == gen, bar);
      __builtin_amdgcn_fence(__ATOMIC_ACQUIRE, "agent");
      asm volatile("s_waitcnt vmcnt(0)" ::: "memory");
    }
  }
  __syncthreads();
}

__global__ __launch_bounds__(NTHR, 2) void k_mega(Params p) {
  extern __shared__ __attribute__((aligned(16))) unsigned char smem[];
  LAS char* lds = (LAS char*)smem;
  if (p.never) cooperative_groups::this_grid().sync();
  volatile LAS unsigned* st = (volatile LAS unsigned*)(lds + LDS_MISC + 3584);
  if (threadIdx.x < 4) st[threadIdx.x] = 0u;
  __syncthreads();
  XcdBarrier bar = xcd_barrier_post((unsigned*)(p.ws + OFF_CTRL) + CW_BAR, st);
#ifdef PROBE_SEG
  unsigned long long t_acc = 0ull, t_s = 0ull;
#define SEG_BEGIN(id) do { if ((id) == PROBE_SEG && blockIdx.x == 0 && threadIdx.x == 0) t_s = __builtin_amdgcn_s_memrealtime(); } while (0)
#define SEG_END(id) do { if ((id) == PROBE_SEG && blockIdx.x == 0 && threadIdx.x == 0) t_acc += __builtin_amdgcn_s_memrealtime() - t_s; } while (0)
#else
#define SEG_BEGIN(id) do {} while (0)
#define SEG_END(id) do {} while (0)
#endif
  SEG_BEGIN(0); p0_prologue(p, lds); xcd_barrier(bar); SEG_END(0);
  SEG_BEGIN(1); p1_norm_mix(p, 0); xcd_barrier(bar); SEG_END(1);
#pragma unroll 1
  for (int l = 0; l < 2; ++l) {
    const int nrows = l == 0 ? NT : NL;
    SEG_BEGIN(2 + 10 * l); p2_inproj(p, l, lds); xcd_barrier(bar); SEG_END(2 + 10 * l);
    SEG_BEGIN(3 + 10 * l); p3_attention(p, l, lds); xcd_barrier(bar); SEG_END(3 + 10 * l);
    SEG_BEGIN(4 + 10 * l); p4_outproj(p, l, nrows, lds); xcd_barrier(bar); SEG_END(4 + 10 * l);
    SEG_BEGIN(5 + 10 * l); p5_norm_ffn(p, l, nrows, lds); xcd_barrier(bar); SEG_END(5 + 10 * l);
    SEG_BEGIN(6 + 10 * l); p6_gateup(p, l, nrows, lds); xcd_barrier(bar); SEG_END(6 + 10 * l);
    SEG_BEGIN(7 + 10 * l); p7_down(p, l, nrows, lds); xcd_barrier(bar); SEG_END(7 + 10 * l);
    SEG_BEGIN(8 + 10 * l); p8_combine(p, l, nrows); if (l == 0) xcd_barrier(bar); SEG_END(8 + 10 * l);
  }
#ifdef PROBE_SEG
  if (blockIdx.x == 0 && threadIdx.x == 0) {
    const unsigned long long t0 = __builtin_amdgcn_s_memrealtime();
    while (__builtin_amdgcn_s_memrealtime() - t0 < 9ull * t_acc) __builtin_amdgcn_s_sleep(8);
  }
#endif
}

template <int PH>
__global__ __launch_bounds__(NTHR, 2) void k_phase(Params p, int layer, int nrows) {
  extern __shared__ __attribute__((aligned(16))) unsigned char smem[];
  LAS char* lds = (LAS char*)smem;
  if (PH == 0) p0_prologue(p, lds);
  if (PH == 1) p1_norm_mix(p, layer);
  if (PH == 2) p2_inproj(p, layer, lds);
  if (PH == 3) p3_attention(p, layer, lds);
  if (PH == 4) p4_outproj(p, layer, nrows, lds);
  if (PH == 5) p5_norm_ffn(p, layer, nrows, lds);
  if (PH == 6) p6_gateup(p, layer, nrows, lds);
  if (PH == 7) p7_down(p, layer, nrows, lds);
  if (PH == 8) p8_combine(p, layer, nrows);
}

extern "C" void kernel_launch(void* const* d_in, const int* in_sizes, int n_in, void* d_out, int out_size, void* d_ws, size_t ws_size, hipStream_t stream) {
  Params p{};
  p.x = (const float*)d_in[0]; p.c = (const float*)d_in[1]; p.ctx = (const float*)d_in[2]; p.c_ctx = (const float*)d_in[3];
  p.w_mod = (const float*)d_in[4]; p.b_mod = (const float*)d_in[5]; p.norm_mix_g = (const float*)d_in[6]; p.norm_ffn_g = (const float*)d_in[7];
  p.w_in = (const float*)d_in[8]; p.w_out = (const float*)d_in[9]; p.swa_sink = (const float*)d_in[10]; p.glb_q_gain = (const float*)d_in[11];
  p.glb_k_gain = (const float*)d_in[12]; p.mla_q_gain = (const float*)d_in[13]; p.mla_w_uq = (const float*)d_in[14]; p.mla_kv_gain = (const float*)d_in[15];
  p.mla_w_ukv = (const float*)d_in[16]; p.router_w = (const float*)d_in[17]; p.router_bias = (const float*)d_in[18]; p.exp_w_gate = (const float*)d_in[19];
  p.exp_w_up = (const float*)d_in[20]; p.exp_w_down = (const float*)d_in[21]; p.shr_w_gate = (const float*)d_in[22]; p.shr_w_up = (const float*)d_in[23];
  p.shr_w_down = (const float*)d_in[24]; p.final_norm_g = (const float*)d_in[25];
  p.out = (float*)d_out; p.ws = (char*)d_ws;
  char* ws = (char*)d_ws;

#ifndef MEGA
#define MEGA 1
#endif
#if MEGA
  static int grid_blocks = 0;
  if (!grid_blocks) {
    (void)hipFuncSetAttribute((const void*)k_mega, hipFuncAttributeMaxDynamicSharedMemorySize, LDS_BYTES);
    int dev = 0, cus = 0, per_cu = 0;
    (void)hipGetDevice(&dev);
    (void)hipDeviceGetAttribute(&cus, hipDeviceAttributeMultiprocessorCount, dev);
    (void)hipOccupancyMaxActiveBlocksPerMultiprocessor(&per_cu, (const void*)k_mega, NTHR, LDS_BYTES);
    if (per_cu > 2) per_cu = 2;
    if (per_cu < 1) per_cu = 1;
    grid_blocks = cus * per_cu;
  }
  (void)hipMemsetAsync(ws + OFF_CTRL, 0, CTRL_BYTES, stream);
  void* args[] = {&p};
  hipError_t e = hipLaunchCooperativeKernel((const void*)k_mega, dim3(grid_blocks), dim3(NTHR), args, LDS_BYTES, stream);
  if (e != hipSuccess) fprintf(stderr, "cooperative launch failed: %s (grid %d)\n", hipGetErrorString(e), grid_blocks);
#else
  static bool attr_done = false;
  if (!attr_done) {
    (void)hipFuncSetAttribute((const void*)k_phase<0>, hipFuncAttributeMaxDynamicSharedMemorySize, LDS_BYTES);
    (void)hipFuncSetAttribute((const void*)k_phase<1>, hipFuncAttributeMaxDynamicSharedMemorySize, LDS_BYTES);
    (void)hipFuncSetAttribute((const void*)k_phase<2>, hipFuncAttributeMaxDynamicSharedMemorySize, LDS_BYTES);
    (void)hipFuncSetAttribute((const void*)k_phase<3>, hipFuncAttributeMaxDynamicSharedMemorySize, LDS_BYTES);
    (void)hipFuncSetAttribute((const void*)k_phase<4>, hipFuncAttributeMaxDynamicSharedMemorySize, LDS_BYTES);
    (void)hipFuncSetAttribute((const void*)k_phase<5>, hipFuncAttributeMaxDynamicSharedMemorySize, LDS_BYTES);
    (void)hipFuncSetAttribute((const void*)k_phase<6>, hipFuncAttributeMaxDynamicSharedMemorySize, LDS_BYTES);
    (void)hipFuncSetAttribute((const void*)k_phase<7>, hipFuncAttributeMaxDynamicSharedMemorySize, LDS_BYTES);
    (void)hipFuncSetAttribute((const void*)k_phase<8>, hipFuncAttributeMaxDynamicSharedMemorySize, LDS_BYTES);
    attr_done = true;
  }

  (void)hipMemsetAsync(ws + OFF_CTRL, 0, CTRL_BYTES, stream);
  k_phase<0><<<GRID, NTHR, LDS_BYTES, stream>>>(p, 0, 0);
  k_phase<1><<<GRID, NTHR, LDS_BYTES, stream>>>(p, 0, NT);
  for (int l = 0; l < 2; ++l) {
    const bool last = (l == 1);
    const int Mres = last ? NL : NT;
    k_phase<2><<<GRID, NTHR, LDS_BYTES, stream>>>(p, l, NT);
    k_phase<3><<<GRID, NTHR, LDS_BYTES, stream>>>(p, l, NT);
    k_phase<4><<<GRID, NTHR, LDS_BYTES, stream>>>(p, l, Mres);
    k_phase<5><<<GRID, NTHR, LDS_BYTES, stream>>>(p, l, Mres);
    k_phase<6><<<GRID, NTHR, LDS_BYTES, stream>>>(p, l, Mres);
    k_phase<7><<<GRID, NTHR, LDS_BYTES, stream>>>(p, l, Mres);
    k_phase<8><<<GRID, NTHR, LDS_BYTES, stream>>>(p, l, Mres);
  }
#endif
}
```

```cpp
#include <hip/hip_runtime.h>
#include <hip/hip_cooperative_groups.h>
#include <cstdio>
#include <stdint.h>
#include <stddef.h>

typedef unsigned short u16;
typedef short bf16x8 __attribute__((ext_vector_type(8)));
typedef float f32x4 __attribute__((ext_vector_type(4)));
typedef float f32x2_t __attribute__((ext_vector_type(2)));
typedef __bf16 bf16x2_t __attribute__((ext_vector_type(2)));
typedef unsigned u32x2_t __attribute__((ext_vector_type(2)));
typedef unsigned u32x4_t __attribute__((ext_vector_type(4)));
#define DI __device__ __forceinline__
#define LAS __attribute__((address_space(3)))

constexpr int B_ = 8, S_ = 4096, D_ = 1024, C_ = 256;
constexpr int NL = B_ * S_, NC = B_ * C_, NT = NL + NC;
constexpr int INW = 1696, INWP = 1792;
constexpr int NE = 16;
constexpr int MAXSLOT = NT * 2 + NE * 256;
constexpr float EPS = 1e-6f;
constexpr int NTHR = 512;
#define VTID ((int)(threadIdx.x & 255u))
#define VHALF (__builtin_amdgcn_readfirstlane((int)(threadIdx.x >> 8)))
#define VBID ((int)(blockIdx.x * 2u) + VHALF)
#define VGRID ((int)(gridDim.x * 2u))

DI float bf2f(u16 v) { return __uint_as_float(((unsigned)v) << 16); }
DI float bflo(unsigned u) { return __uint_as_float(u << 16); }
DI float bfhi(unsigned u) { return __uint_as_float(u & 0xffff0000u); }
DI unsigned cvtpk(float lo, float hi) { f32x2_t v = {lo, hi}; bf16x2_t b = __builtin_convertvector(v, bf16x2_t); return __builtin_bit_cast(unsigned, b); }
template <int CTRL> DI float dpp_mov(float v) { return __int_as_float(__builtin_amdgcn_update_dpp(0, __float_as_int(v), CTRL, 0xf, 0xf, false)); }
DI float wave_sum(float v) {
  v += dpp_mov<0xB1>(v);
  v += dpp_mov<0x4E>(v);
  v += dpp_mov<0x141>(v);
  v += dpp_mov<0x140>(v);
  { auto rr = __builtin_amdgcn_permlane16_swap(__float_as_uint(v), __float_as_uint(v), false, false); v = __uint_as_float(rr[0]) + __uint_as_float(rr[1]); }
  { auto rr = __builtin_amdgcn_permlane32_swap(__float_as_uint(v), __float_as_uint(v), false, false); v = __uint_as_float(rr[0]) + __uint_as_float(rr[1]); }
  return v;
}
DI float silu(float g) { return g / (1.f + __expf(-g)); }
DI int opaque(int v) { asm volatile("" : "+v"(v)); return v; }

constexpr size_t al256(size_t x) { return (x + 255) & ~(size_t)255; }
constexpr size_t OFF_CTRL = 0;
constexpr size_t CTRL_BYTES = 65536;
constexpr size_t OFF_CTXR = OFF_CTRL + CTRL_BYTES;
constexpr size_t OFF_MOD = OFF_CTXR + 256;
constexpr size_t OFF_TOKE = OFF_MOD + al256((size_t)2 * 9 * 6144 * 4);
constexpr size_t OFF_TOKW = OFF_TOKE + al256((size_t)NT * 2 * 4);
constexpr size_t OFF_TOKP = OFF_TOKW + al256((size_t)NT * 2 * 4);
constexpr size_t OFF_LIST = OFF_TOKP + al256((size_t)NT * 2 * 4);
constexpr size_t OFF_WIN = OFF_LIST + al256((size_t)NE * NT * 4);
constexpr size_t OFF_WO = OFF_WIN + (size_t)2 * INWP * 1024 * 2;
constexpr size_t OFF_WUQ = OFF_WO + (size_t)2 * 1024 * 1024 * 2;
constexpr size_t OFF_WUKV = OFF_WUQ + (size_t)2 * 384 * 256 * 2;
constexpr size_t OFF_WGU = OFF_WUKV + (size_t)2 * 512 * 128 * 2;
constexpr size_t OFF_WD = OFF_WGU + (size_t)2 * 16 * 1024 * 1024 * 2;
constexpr size_t OFF_SGU = OFF_WD + (size_t)2 * 16 * 1024 * 512 * 2;
constexpr size_t OFF_SD = OFF_SGU + (size_t)2 * 1024 * 1024 * 2;
constexpr size_t OFF_H = OFF_SD + (size_t)2 * 1024 * 512 * 2;
constexpr size_t OFF_BIG = OFF_H + (size_t)NT * 1024 * 2;
constexpr size_t OFF_SWQ = OFF_BIG;
constexpr size_t OFF_SWK = OFF_SWQ + (size_t)NT * 384 * 2;
constexpr size_t OFF_SWV = OFF_SWK + (size_t)NT * 128 * 2;
constexpr size_t OFF_GLQ = OFF_SWV + (size_t)NT * 128 * 2;
constexpr size_t OFF_GLK = OFF_GLQ + (size_t)NT * 384 * 2;
constexpr size_t OFF_GLV = OFF_GLK + (size_t)NT * 128 * 2;
constexpr size_t OFF_MLQ = OFF_GLV + (size_t)NT * 128 * 2;
constexpr size_t OFF_MLK = OFF_MLQ + (size_t)NT * 384 * 2;
constexpr size_t OFF_MLKR = OFF_MLK + (size_t)NT * 256 * 2;
constexpr size_t OFF_MLV = OFF_MLKR + (size_t)NT * 32 * 2;
constexpr size_t OFF_QLAT = OFF_MLV + (size_t)NT * 256 * 2;
constexpr size_t OFF_KVLAT = OFF_QLAT + (size_t)NT * 256 * 2;
constexpr size_t OFF_Y = OFF_KVLAT + (size_t)NT * 128 * 2;
constexpr size_t END_A = OFF_Y + (size_t)NT * 1024 * 2;
constexpr size_t OFF_ACT = OFF_BIG;
constexpr size_t OFF_ACTS = OFF_ACT + (size_t)MAXSLOT * 512 * 2;
constexpr size_t OFF_YEXP = OFF_ACTS + (size_t)NT * 512 * 2;
constexpr size_t END_B = OFF_YEXP + (size_t)MAXSLOT * 1024 * 2;
constexpr size_t OFF_YSH = OFF_H;
constexpr size_t OFF_DELTA = OFF_SWQ;
static_assert(OFF_DELTA + (size_t)NT * 1024 * 2 <= OFF_MLQ, "DELTA must fit below MLQ");
constexpr size_t OFF_XB = al256(END_A > END_B ? END_A : END_B);
constexpr size_t WS_NEED = OFF_XB + (size_t)NT * 1024 * 2;
static_assert(WS_NEED <= (size_t)536870912, "workspace too large");

constexpr int CW_CTR = 0;
constexpr int CW_CNT = 8192;
constexpr int CW_Q = 10240;

struct Params {
  const float *x, *c, *ctx, *c_ctx, *w_mod, *b_mod, *norm_mix_g, *norm_ffn_g, *w_in, *w_out, *swa_sink, *glb_q_gain, *glb_k_gain,
      *mla_q_gain, *mla_w_uq, *mla_kv_gain, *mla_w_ukv, *router_w, *router_bias, *exp_w_gate, *exp_w_up, *exp_w_down, *shr_w_gate,
      *shr_w_up, *shr_w_down, *final_norm_g;
  float* out;
  char* ws;
  int never; int pad;
};

constexpr int LDS_MISC = 65536;
constexpr int LDS_HALF = 73728;
constexpr int LDS_ESTG = 131072;
constexpr int LDS_RMISC = 147456;
constexpr int LDS_BYTES = 159744;

DI int next_unit(unsigned* ctr, LAS char* lds) {
  volatile LAS int* slot = (volatile LAS int*)(lds + LDS_RMISC);
  __syncthreads();
  if (threadIdx.x == 0) *slot = (int)atomicAdd(ctr, 1u);
  __syncthreads();
  return *slot;
}

DI unsigned xcc_id_() { return (unsigned)__builtin_amdgcn_s_getreg((3 << 11) | 20) & 0x7u; }
DI int next_unit_xcd(unsigned* ctr8, int per_queue, LAS char* lds  ) {
  volatile LAS int* slot = (volatile LAS int*)(lds + LDS_RMISC);
  __syncthreads();
  if (threadIdx.x == 0) {
    const int q0 = (int)xcc_id_();
    int res = -1;
    for (int i = 0; i < 8; ++i) {
      const int q = (q0 + i) & 7;
      const int v = (int)atomicAdd(&ctr8[q * 64], 1u);
      if (v < per_queue) { res = q * per_queue + v; break; }
    }
    *slot = res;
  }
  __syncthreads();
  return *slot;
}
DI void cvt_job(const float* __restrict__ src, int ld, int N, int k0, int n0, u16* __restrict__ dst, int K, int mode  , LAS char* lds) {
  LAS float* T = (LAS float*)lds;
  const int tid = VTID;
  __syncthreads();
  {
    const int kk = tid >> 2, nq = (tid & 3) * 32;
    const float* s = src + (size_t)(k0 + kk) * ld + n0 + nq;
#pragma unroll
    for (int i = 0; i < 8; ++i) {
      float4 v = make_float4(0.f, 0.f, 0.f, 0.f);
      if (n0 + nq + i * 4 < N) v = *(const float4*)(s + i * 4);
      LAS float* t = T + kk * 129 + nq + i * 4;
      t[0] = v.x; t[1] = v.y; t[2] = v.z; t[3] = v.w;
    }
  }
  __syncthreads();
#pragma unroll
  for (int i = 0; i < 4; ++i) {
    const int chn = tid + i * 256;
    const int n = chn >> 3, kc = (chn & 7) * 8;
    if (n0 + n < N) {
      const LAS float* t = T + kc * 129 + n;
      uint4 o;
      o.x = cvtpk(t[0], t[129]); o.y = cvtpk(t[2 * 129], t[3 * 129]); o.z = cvtpk(t[4 * 129], t[5 * 129]); o.w = cvtpk(t[6 * 129], t[7 * 129]);
      const int gn = n0 + n;
      int drow = gn;
      if (mode) drow = (gn >> 5) * 64 + (gn & 31) + (mode == 2 ? 32 : 0);
      *(uint4*)(dst + (size_t)drow * K + k0 + kc) = o;
    }
  }
}

DI void mod_job(const Params& p, int l, int j0, LAS char* lds) {
  LAS float* sc = (LAS float*)lds;
  LAS float* red = (LAS float*)(lds + 36864);
  const int tid = VTID;
  __syncthreads();
  for (int i = tid; i < 9 * 1024; i += 256) {
    int r = i >> 10, k = i & 1023;
    float v = r < 8 ? p.c[r * 1024 + k] : p.c_ctx[k];
    sc[i] = v / (1.f + __expf(-v));
  }
  __syncthreads();
  const int col = tid & 31, kg = tid >> 5;
  float acc[9];
#pragma unroll
  for (int r = 0; r < 9; ++r) acc[r] = 0.f;
  const float* w = p.w_mod + (size_t)l * 1024 * 6144 + (size_t)(kg * 128) * 6144 + j0 + col;
#pragma unroll 1
  for (int k0 = 0; k0 < 128; k0 += 16) {
    float wv[16];
#pragma unroll
    for (int u = 0; u < 16; ++u) wv[u] = w[(size_t)(k0 + u) * 6144];
#pragma unroll
    for (int u = 0; u < 16; ++u)
#pragma unroll
      for (int r = 0; r < 9; ++r) acc[r] += sc[r * 1024 + kg * 128 + k0 + u] * wv[u];
  }
#pragma unroll
  for (int r = 0; r < 9; ++r) red[(kg * 9 + r) * 32 + col] = acc[r];
  __syncthreads();
  float* MOD = (float*)(p.ws + OFF_MOD);
  for (int i = tid; i < 9 * 32; i += 256) {
    int r = i >> 5, cc = i & 31;
    float sum = 0.f;
#pragma unroll
    for (int g = 0; g < 8; ++g) sum += red[(g * 9 + r) * 32 + cc];
    MOD[(size_t)(l * 9 + r) * 6144 + j0 + cc] = sum + p.b_mod[l * 6144 + j0 + cc];
  }
}

constexpr int J_WIN = 16 * 14, J_WO = 16 * 8, J_UQ = 4 * 3, J_UKV = 2 * 4, J_EG = 16 * 4, J_ED = 8 * 8;
constexpr int J_DENSE = J_WIN + J_WO + J_UQ + J_UKV;
constexpr int J_EXP = 16 * (2 * J_EG + J_ED);
constexpr int J_SHR = 2 * J_EG + J_ED;
constexpr int J_LAYER = J_DENSE + J_EXP + J_SHR;
constexpr int J_MOD = 2 * 192;
constexpr int J_TOTAL = 2 * J_LAYER + J_MOD;

static_assert(J_MOD % 2 == 0 && J_TOTAL % 2 == 0, "job pairs (2i, 2i+1) must be of one kind and both valid");
DI void p0_prologue(const Params& p, LAS char* ldsr) {
  char* ws = p.ws;
  LAS char* lds = ldsr + VHALF * LDS_HALF;
  for (int job = VBID; job < J_TOTAL; job += VGRID) {
    if (job < J_MOD) { mod_job(p, job / 192, (job % 192) * 32, lds); continue; }
    int r = job - J_MOD;
    const int l = r / J_LAYER; r -= l * J_LAYER;
    if (r < J_WIN) { cvt_job(p.w_in + (size_t)l * 1024 * INW, INW, INW, (r / 14) * 64, (r % 14) * 128, (u16*)(ws + OFF_WIN) + (size_t)l * INWP * 1024, 1024, 0, lds); continue; } r -= J_WIN;
    if (r < J_WO) { cvt_job(p.w_out + (size_t)l * 1024 * 1024, 1024, 1024, (r / 8) * 64, (r % 8) * 128, (u16*)(ws + OFF_WO) + (size_t)l * 1024 * 1024, 1024, 0, lds); continue; } r -= J_WO;
    if (r < J_UQ) { cvt_job(p.mla_w_uq + (size_t)l * 256 * 384, 384, 384, (r / 3) * 64, (r % 3) * 128, (u16*)(ws + OFF_WUQ) + (size_t)l * 384 * 256, 256, 0, lds); continue; } r -= J_UQ;
    if (r < J_UKV) { cvt_job(p.mla_w_ukv + (size_t)l * 128 * 512, 512, 512, (r / 4) * 64, (r % 4) * 128, (u16*)(ws + OFF_WUKV) + (size_t)l * 512 * 128, 128, 0, lds); continue; } r -= J_UKV;
    if (r < J_EXP) {
      const int e = r / (2 * J_EG + J_ED); int q = r % (2 * J_EG + J_ED);
      const size_t le = (size_t)l * NE + e;
      if (q < J_EG) { cvt_job(p.exp_w_gate + le * 1024 * 512, 512, 512, (q / 4) * 64, (q % 4) * 128, (u16*)(ws + OFF_WGU) + le * 1024 * 1024, 1024, 1, lds); continue; } q -= J_EG;
      if (q < J_EG) { cvt_job(p.exp_w_up + le * 1024 * 512, 512, 512, (q / 4) * 64, (q % 4) * 128, (u16*)(ws + OFF_WGU) + le * 1024 * 1024, 1024, 2, lds); continue; } q -= J_EG;
      cvt_job(p.exp_w_down + le * 512 * 1024, 1024, 1024, (q / 8) * 64, (q % 8) * 128, (u16*)(ws + OFF_WD) + le * 1024 * 512, 512, 0, lds); continue;
    }
    r -= J_EXP;
    if (r < J_EG) { cvt_job(p.shr_w_gate + (size_t)l * 1024 * 512, 512, 512, (r / 4) * 64, (r % 4) * 128, (u16*)(ws + OFF_SGU) + (size_t)l * 1024 * 1024, 1024, 1, lds); continue; } r -= J_EG;
    if (r < J_EG) { cvt_job(p.shr_w_up + (size_t)l * 1024 * 512, 512, 512, (r / 4) * 64, (r % 4) * 128, (u16*)(ws + OFF_SGU) + (size_t)l * 1024 * 1024, 1024, 2, lds); continue; } r -= J_EG;
    cvt_job(p.shr_w_down + (size_t)l * 512 * 1024, 1024, 1024, (r / 8) * 64, (r % 8) * 128, (u16*)(ws + OFF_SD) + (size_t)l * 1024 * 512, 512, 0, lds);
  }
}

DI const float* xrow_ptr(const Params& p, int layer_src  , int row) {
  if (layer_src == 0) return row < NL ? p.x + (size_t)row * 1024 : p.ctx + (size_t)(row - NL) * 1024;
  return row < NL ? p.out + (size_t)row * 1024 : (const float*)(p.ws + OFF_CTXR) + (size_t)(row - NL) * 1024;
}
DI float* xrow_out(const Params& p, int row) {
  return row < NL ? p.out + (size_t)row * 1024 : (float*)(p.ws + OFF_CTXR) + (size_t)(row - NL) * 1024;
}

DI void norm_mod_row(f32x4 (&v)[4], const float* __restrict__ g, const float* __restrict__ md  , int lane) {
  float ss = 0.f;
#pragma unroll
  for (int i = 0; i < 4; ++i) ss += v[i].x * v[i].x + v[i].y * v[i].y + v[i].z * v[i].z + v[i].w * v[i].w;
  ss = wave_sum(ss);
  const float rstd = rsqrtf(ss * (1.f / 1024.f) + EPS);
#pragma unroll
  for (int i = 0; i < 4; ++i) {
    const f32x4 gg = *(const f32x4*)(g + lane * 4 + i * 256);
    const f32x4 sh = *(const f32x4*)(md + lane * 4 + i * 256);
    const f32x4 sc = *(const f32x4*)(md + 1024 + lane * 4 + i * 256);
    v[i] = v[i] * rstd * gg * (sc + 1.f) + sh;
  }
}
DI void store_h_row(const f32x4 (&v)[4], u16* __restrict__ hrow, int lane) {
#pragma unroll
  for (int i = 0; i < 4; ++i) {
    uint2 o; o.x = cvtpk(v[i].x, v[i].y); o.y = cvtpk(v[i].z, v[i].w);
    *(uint2*)(hrow + lane * 4 + i * 256) = o;
  }
}

DI void p1_norm_mix(const Params& p, int layer) {
  const int tid_ = opaque((int)threadIdx.x); const int lane = tid_ & 63, gw = blockIdx.x * 8 + (tid_ >> 6), ngw = gridDim.x * 8;
  const float* MODl = (const float*)(p.ws + OFF_MOD) + (size_t)layer * 9 * 6144;
  u16* H = (u16*)(p.ws + OFF_H);
  f32x4 vn[4];
  int row = gw;
  if (row < NT) { const float* xr = xrow_ptr(p, layer, row);
#pragma unroll
    for (int i = 0; i < 4; ++i) vn[i] = __builtin_nontemporal_load((const f32x4*)(xr + lane * 4 + i * 256)); }
  while (row < NT) {
    f32x4 v[4];
#pragma unroll
    for (int i = 0; i < 4; ++i) v[i] = vn[i];
    const int rown = row + ngw;
    if (rown < NT) { const float* xr = xrow_ptr(p, layer, rown);
#pragma unroll
      for (int i = 0; i < 4; ++i) vn[i] = __builtin_nontemporal_load((const f32x4*)(xr + lane * 4 + i * 256)); }
    const int mr = row < NL ? row / S_ : 8;
    norm_mod_row(v, p.norm_mix_g + layer * 1024, MODl + (size_t)mr * 6144, lane);
    store_h_row(v, H + (size_t)row * 1024, lane);
    row = rown;
  }
}

DI float max2nd4(float a, float b, float c, float d, float& m1) {
  const float ab = fmaxf(a, b), cd = fmaxf(c, d);
  m1 = fmaxf(ab, cd);
  return fmaxf(fmaxf(fminf(a, b), fminf(c, d)), fminf(ab, cd));
}
template <int CTRL> DI float dppz(float v) { return __int_as_float(__builtin_amdgcn_update_dpp(0, __float_as_int(v), CTRL, 0xf, 0xf, true)); }
DI float lane_xor4(float v, bool b2) { const float a = dppz<0x114>(v), b = dppz<0x104>(v); return b2 ? a : b; }
DI float lane_xor8(float v, bool b3) { const float a = dppz<0x118>(v), b = dppz<0x108>(v); return b3 ? a : b; }
DI bool beats(float a, int ia, float b, int ib) { return a > b || (a == b && ia < ib); }
DI void route_row(float bias_lane, const f32x4 (&v)[4], LAS char* lds, int lane, int& i0, int& i1, float& w0, float& w1) {
  const LAS f32x4* R = (const LAS f32x4*)lds;
  f32x4 pl4[4];
#pragma unroll
  for (int q = 0; q < 4; ++q) pl4[q] = (f32x4){0.f, 0.f, 0.f, 0.f};
#pragma unroll
  for (int i = 0; i < 4; ++i) {
    const int kq = i * 64 + lane;
    f32x4 wq[16];
#pragma unroll
    for (int j = 0; j < 16; ++j) wq[j] = R[j * 256 + kq];
    __builtin_amdgcn_sched_barrier(0);
#pragma unroll
    for (int kk = 0; kk < 4; ++kk) {
      const float hv = v[i][kk];
      const f32x4 hv4 = (f32x4){hv, hv, hv, hv};
#pragma unroll
      for (int q = 0; q < 4; ++q) pl4[q] = __builtin_elementwise_fma(hv4, wq[kk * 4 + q], pl4[q]);
    }
    __builtin_amdgcn_sched_barrier(0);
  }
  float pl[16];
#pragma unroll
  for (int q = 0; q < 4; ++q) { pl[q * 4 + 0] = pl4[q][0]; pl[q * 4 + 1] = pl4[q][1]; pl[q * 4 + 2] = pl4[q][2]; pl[q * 4 + 3] = pl4[q][3]; }
  const bool b0 = (lane & 1) != 0, b1 = (lane & 2) != 0, b2 = (lane & 4) != 0, b3 = (lane & 8) != 0;
  float r8[8], r4[4], r2[2];
#pragma unroll
  for (int i = 0; i < 8; ++i) { const float keep = b0 ? pl[i + 8] : pl[i], send = b0 ? pl[i] : pl[i + 8]; r8[i] = keep + dppz<0xB1>(send); }
#pragma unroll
  for (int i = 0; i < 4; ++i) { const float keep = b1 ? r8[i + 4] : r8[i], send = b1 ? r8[i] : r8[i + 4]; r4[i] = keep + dppz<0x4E>(send); }
#pragma unroll
  for (int i = 0; i < 2; ++i) { const float keep = b2 ? r4[i + 2] : r4[i], send = b2 ? r4[i] : r4[i + 2]; r2[i] = keep + lane_xor4(send, b2); }
  float lg;
  { const float keep = b3 ? r2[1] : r2[0], send = b3 ? r2[0] : r2[1]; lg = keep + lane_xor8(send, b3); }
  { auto rr = __builtin_amdgcn_permlane16_swap(__float_as_uint(lg), __float_as_uint(lg), false, false); lg = __uint_as_float(rr[0]) + __uint_as_float(rr[1]); }
  { auto rr = __builtin_amdgcn_permlane32_swap(__float_as_uint(lg), __float_as_uint(lg), false, false); lg = __uint_as_float(rr[0]) + __uint_as_float(rr[1]); }
  const float sg = __builtin_amdgcn_rcpf(1.f + __builtin_amdgcn_exp2f(-1.4426950408889634f * lg));
  const float bv = sg + bias_lane;
  const float m1v = lane_xor4(bv, b2), m2v = lane_xor8(bv, b3), m3v = lane_xor8(m1v, b3);
  float mtop; const float m2nd = max2nd4(bv, m1v, m2v, m3v, mtop);
  const float gs = mtop + m2nd;
  const float gA = dppz<0xB1>(gs), gB = dppz<0x4E>(gs), gC = dppz<0x1B>(gs);
  const int g = (b0 ? 2 : 0) + (b1 ? 1 : 0);
  const bool win = beats(gs, g, gA, g ^ 2) && beats(gs, g, gB, g ^ 1) && beats(gs, g, gC, g ^ 3);
  const int el = (b2 ? 2 : 0) + (b3 ? 1 : 0);
  const int rank = (beats(m1v, el ^ 2, bv, el) ? 1 : 0) + (beats(m2v, el ^ 1, bv, el) ? 1 : 0) + (beats(m3v, el ^ 3, bv, el) ? 1 : 0);
  const unsigned long long k0 = __ballot(win && rank == 0), k1 = __ballot(win && rank == 1);
  const int L0 = __builtin_ctzll(k0 | (1ull << 63)), L1 = __builtin_ctzll(k1 | (1ull << 63));
  const float s0 = __int_as_float(__builtin_amdgcn_readlane(__float_as_int(sg), L0));
  const float s1 = __int_as_float(__builtin_amdgcn_readlane(__float_as_int(sg), L1));
  i0 = 8 * (L0 & 1) + 4 * ((L0 >> 1) & 1) + 2 * ((L0 >> 2) & 1) + ((L0 >> 3) & 1);
  i1 = 8 * (L1 & 1) + 4 * ((L1 >> 1) & 1) + 2 * ((L1 >> 2) & 1) + ((L1 >> 3) & 1);
  const float inv = 1.f / (s0 + s1);
  w0 = s0 * inv; w1 = s1 * inv;
}

DI void load_router_lds(const Params& p, LAS char* lds) {
  LAS f32x4* R = (LAS f32x4*)lds;
  __syncthreads();
  for (int g = opaque((int)threadIdx.x); g < 4096; g += NTHR) {
    const int k = g >> 2, q = g & 3;
    R[((k & 3) * 4 + q) * 256 + (k >> 2)] = *(const f32x4*)(p.router_w + (size_t)g * 4);
  }
  __syncthreads();
}

constexpr int CNT_STRIDE = 64;
DI void p5_norm_ffn(const Params& p, int layer, int nrows, LAS char* lds) {
  load_router_lds(p, lds);
  const int tid = opaque((int)threadIdx.x), lane = tid & 63, wid = tid >> 6, gw = blockIdx.x * 8 + wid, ngw = gridDim.x * 8;
  const float* MODl = (const float*)(p.ws + OFF_MOD) + (size_t)layer * 9 * 6144;
  u16* H = (u16*)(p.ws + OFF_H);
  volatile LAS int* lcnt = (volatile LAS int*)(lds + LDS_RMISC + 128);
  volatile LAS int* lbase = lcnt + 16;
  volatile LAS int* stash = (volatile LAS int*)(lds + LDS_RMISC + 1024) + wid * 160;
  int* tok_e = (int*)(p.ws + OFF_TOKE); float* tok_w = (float*)(p.ws + OFF_TOKW); int* tok_p = (int*)(p.ws + OFF_TOKP);
  int* list = (int*)(p.ws + OFF_LIST);
  unsigned* cnt = (unsigned*)(p.ws + OFF_CTRL) + CW_CNT + layer * 16 * CNT_STRIDE;
  if (tid < 16) lcnt[tid] = 0;
  __syncthreads();
  const float bias = p.router_bias[8 * (lane & 1) + 4 * ((lane >> 1) & 1) + 2 * ((lane >> 2) & 1) + ((lane >> 3) & 1)];
  int nst = 0;
  u32x2_t dn[4], xbn[4]; f32x4 xfn[4];
  u16* XB = (u16*)(p.ws + OFF_XB);
  const u16* DELTA = (const u16*)(p.ws + OFF_DELTA);
#define P5_LOAD(r) do { const int _r = (r); _Pragma("unroll") for (int i = 0; i < 4; ++i) { const int _c = lane * 4 + i * 256; \
      dn[i] = __builtin_nontemporal_load((const u32x2_t*)(DELTA + (size_t)_r * 1024 + _c)); \
      if (layer == 0) xfn[i] = __builtin_nontemporal_load((const f32x4*)((_r < NL ? p.x + (size_t)_r * 1024 : p.ctx + (size_t)(_r - NL) * 1024) + _c)); \
      else xbn[i] = __builtin_nontemporal_load((const u32x2_t*)(XB + (size_t)_r * 1024 + _c)); } } while (0)
  if (gw < nrows) P5_LOAD(gw);
  for (int row = gw; row < nrows; row += ngw) {
    f32x4 v[4];
#pragma unroll
    for (int i = 0; i < 4; ++i) {
      if (layer == 0) v[i] = xfn[i]; else v[i] = (f32x4){bflo(xbn[i][0]), bfhi(xbn[i][0]), bflo(xbn[i][1]), bfhi(xbn[i][1])};
      v[i][0] += bflo(dn[i][0]); v[i][1] += bfhi(dn[i][0]); v[i][2] += bflo(dn[i][1]); v[i][3] += bfhi(dn[i][1]);
    }
    if (row + ngw < nrows) P5_LOAD(row + ngw);
#pragma unroll
    for (int i = 0; i < 4; ++i) { u32x2_t o; o[0] = cvtpk(v[i][0], v[i][1]); o[1] = cvtpk(v[i][2], v[i][3]); *(u32x2_t*)(XB + (size_t)row * 1024 + lane * 4 + i * 256) = o; }
    const int mr = row < NL ? row / S_ : 8;
    norm_mod_row(v, p.norm_ffn_g + layer * 1024, MODl + (size_t)mr * 6144 + 3 * 1024, lane);
    store_h_row(v, H + (size_t)row * 1024, lane);
    int i0, i1; float w0, w1;
    route_row(bias, v, lds, lane, i0, i1, w0, w1);
    if (lane == 0) {
      const int lp0 = __hip_atomic_fetch_add((LAS int*)&lcnt[i0], 1, __ATOMIC_RELAXED, __HIP_MEMORY_SCOPE_WORKGROUP);
      const int lp1 = __hip_atomic_fetch_add((LAS int*)&lcnt[i1], 1, __ATOMIC_RELAXED, __HIP_MEMORY_SCOPE_WORKGROUP);
      tok_e[row * 2] = i0; tok_e[row * 2 + 1] = i1;
      tok_w[row * 2] = w0; tok_w[row * 2 + 1] = w1;
      stash[nst * 4 + 0] = i0; stash[nst * 4 + 1] = lp0; stash[nst * 4 + 2] = i1; stash[nst * 4 + 3] = lp1;
    }
    ++nst;
  }
  __syncthreads();
  if (tid < 16) { const int c = lcnt[tid]; lbase[tid] = c > 0 ? (int)atomicAdd(&cnt[tid * CNT_STRIDE], (unsigned)c) : 0; }
  __syncthreads();
  if (lane == 0) {
    int k = 0;
    for (int row = gw; row < nrows; row += ngw, ++k) {
      const int e0 = stash[k * 4 + 0], e1 = stash[k * 4 + 2];
      const int p0 = lbase[e0] + stash[k * 4 + 1], p1 = lbase[e1] + stash[k * 4 + 3];
      tok_p[row * 2] = p0; tok_p[row * 2 + 1] = p1;
      list[(size_t)e0 * NT + p0] = row; list[(size_t)e1 * NT + p1] = row;
    }
  }
}

DI void seg_scan(const Params& p, int layer, int (&tb)[NE + 1]) {
  const unsigned* cnt = (const unsigned*)(p.ws + OFF_CTRL) + CW_CNT + layer * 16 * CNT_STRIDE;
  int acc = 0;
#pragma unroll
  for (int e = 0; e < NE; ++e) { tb[e] = acc; acc += ((int)cnt[e * CNT_STRIDE] + 255) >> 8; }
  tb[NE] = acc;
}

DI void p8_combine(const Params& p, int layer, int nrows) {
  const int tid_ = opaque((int)threadIdx.x); const int lane = tid_ & 63, gw = blockIdx.x * 8 + (tid_ >> 6), ngw = gridDim.x * 8;
  const float* MODl = (const float*)(p.ws + OFF_MOD) + (size_t)layer * 9 * 6144;
  const float* MODn = (const float*)(p.ws + OFF_MOD) + (size_t)(layer + 1) * 9 * 6144;
  u16* H = (u16*)(p.ws + OFF_H);
  const u16* YSH = (const u16*)(p.ws + OFF_YSH);
  const u16* YEXP = (const u16*)(p.ws + OFF_YEXP);
  u16* XB = (u16*)(p.ws + OFF_XB);
  const int* tok_e = (const int*)(p.ws + OFF_TOKE); const float* tok_w = (const float*)(p.ws + OFF_TOKW); const int* tok_p = (const int*)(p.ws + OFF_TOKP);
  int tb[NE + 1]; seg_scan(p, layer, tb);
  int me0 = 0, me1 = 0, mp0 = 0, mp1 = 0; float mw0 = 0.f, mw1 = 0.f;
  u32x2_t an[4], bn[4], cn[4], xn[4]; float nw0 = 0.f, nw1 = 0.f;
#define P8_META(r) do { me0 = tok_e[(r) * 2]; me1 = tok_e[(r) * 2 + 1]; mp0 = tok_p[(r) * 2]; mp1 = tok_p[(r) * 2 + 1]; mw0 = tok_w[(r) * 2]; mw1 = tok_w[(r) * 2 + 1]; } while (0)
#define P8_DATA(r) do { int ps0 = 0, ps1 = 0; _Pragma("unroll") for (int e = 0; e < NE; ++e) { if (e == me0) ps0 = tb[e]; if (e == me1) ps1 = tb[e]; } \
    const size_t s0 = (size_t)ps0 * 256 + mp0, s1 = (size_t)ps1 * 256 + mp1; nw0 = mw0; nw1 = mw1; const u16* xrn = XB + (size_t)(r) * 1024; \
    _Pragma("unroll") for (int i = 0; i < 4; ++i) { const int cidx = lane * 4 + i * 256; \
      an[i] = __builtin_nontemporal_load((const u32x2_t*)(YEXP + s0 * 1024 + cidx)); bn[i] = __builtin_nontemporal_load((const u32x2_t*)(YEXP + s1 * 1024 + cidx)); \
      cn[i] = __builtin_nontemporal_load((const u32x2_t*)(YSH + (size_t)(r) * 1024 + cidx)); xn[i] = __builtin_nontemporal_load((const u32x2_t*)(xrn + cidx)); } } while (0)
  if (gw < nrows) { P8_META(gw); P8_DATA(gw); }
  if (gw + ngw < nrows) P8_META(gw + ngw);
  for (int row = gw; row < nrows; row += ngw) {
    u32x2_t a[4], b[4], c[4]; f32x4 v[4];
#pragma unroll
    for (int i = 0; i < 4; ++i) { a[i] = an[i]; b[i] = bn[i]; c[i] = cn[i]; v[i] = (f32x4){bflo(xn[i][0]), bfhi(xn[i][0]), bflo(xn[i][1]), bfhi(xn[i][1])}; }
    const float w0 = nw0, w1 = nw1;
    if (row + ngw < nrows) P8_DATA(row + ngw);
    if (row + 2 * ngw < nrows) P8_META(row + 2 * ngw);
    float* xr = xrow_out(p, row);
    const int mr = row < NL ? row / S_ : 8;
    const float* gate = MODl + (size_t)mr * 6144 + 5 * 1024;
#pragma unroll
    for (int i = 0; i < 4; ++i) {
      const int cidx = lane * 4 + i * 256;
      const f32x4 g = *(const f32x4*)(gate + cidx);
      f32x4 x = v[i];
      x.x += g.x * (w0 * bflo(a[i][0]) + w1 * bflo(b[i][0]) + bflo(c[i][0]));
      x.y += g.y * (w0 * bfhi(a[i][0]) + w1 * bfhi(b[i][0]) + bfhi(c[i][0]));
      x.z += g.z * (w0 * bflo(a[i][1]) + w1 * bflo(b[i][1]) + bflo(c[i][1]));
      x.w += g.w * (w0 * bfhi(a[i][1]) + w1 * bfhi(b[i][1]) + bfhi(c[i][1]));
      v[i] = x;
    }
    if (layer == 0) {
#pragma unroll
      for (int i = 0; i < 4; ++i) { u32x2_t o; o[0] = cvtpk(v[i].x, v[i].y); o[1] = cvtpk(v[i].z, v[i].w); *(u32x2_t*)(XB + (size_t)row * 1024 + lane * 4 + i * 256) = o; }
      norm_mod_row(v, p.norm_mix_g + 1024, MODn + (size_t)mr * 6144, lane);
      store_h_row(v, H + (size_t)row * 1024, lane);
    } else {
      float ss = 0.f;
#pragma unroll
      for (int i = 0; i < 4; ++i) ss += v[i].x * v[i].x + v[i].y * v[i].y + v[i].z * v[i].z + v[i].w * v[i].w;
      ss = wave_sum(ss);
      const float rstd = rsqrtf(ss * (1.f / 1024.f) + EPS);
#pragma unroll
      for (int i = 0; i < 4; ++i) {
        const f32x4 gg = *(const f32x4*)(p.final_norm_g + lane * 4 + i * 256);
        __builtin_nontemporal_store(v[i] * rstd * gg, (f32x4*)(xr + lane * 4 + i * 256));
      }
    }
  }
#undef P8_META
#undef P8_DATA
}

DI void glds16(const u16* g, LAS char* l) {
  __builtin_amdgcn_global_load_lds((const void*)g, (LAS void*)l, 16, 0, 0);
}
struct TilePtrs { const u16 *a0, *a1, *a2, *a3, *b0; long ldb32; };
#define GT_ISSUE_P(T, kt, s) do { const int _ko = (kt) * 64; LAS char* _d = ldst + (s) * 32768; \
    glds16((T).a0 + _ko, _d); glds16((T).a1 + _ko, _d + 4096); glds16((T).a2 + _ko, _d + 8192); glds16((T).a3 + _ko, _d + 12288); \
    glds16((T).b0 + _ko, _d + 16384); glds16((T).b0 + (T).ldb32 + _ko, _d + 20480); glds16((T).b0 + 2 * (T).ldb32 + _ko, _d + 24576); glds16((T).b0 + 3 * (T).ldb32 + _ko, _d + 28672); } while (0)
template <bool HOIST = true>
DI void gemm_tile_s(LAS char* lds, const TilePtrs& cur, bool issued, const TilePtrs& nxt, bool has_next, int nk, f32x4 (&acc)[4][4]) {
  const int tid = opaque(VTID), lane = tid & 63, wid = tid >> 6, wr = wid >> 1, wc = wid & 1, fr = lane & 15, fq = lane >> 4;
  const int kx = (fr >> 1) & 7;
  const int aoff0 = (wr * 64 + fr) * 128 + ((fq ^ kx) * 16), aoff1 = (wr * 64 + fr) * 128 + (((4 + fq) ^ kx) * 16);
  const int boff0 = 16384 + (wc * 64 + fr) * 128 + ((fq ^ kx) * 16), boff1 = 16384 + (wc * 64 + fr) * 128 + (((4 + fq) ^ kx) * 16);
#pragma unroll
  for (int m = 0; m < 4; ++m)
#pragma unroll
    for (int n = 0; n < 4; ++n) acc[m][n] = (f32x4){0.f, 0.f, 0.f, 0.f};
  LAS char* ldst = lds + tid * 16;
  if (!issued) GT_ISSUE_P(cur, 0, 0);
#pragma unroll 1
  for (int kt = 0; kt < nk; ++kt) {
    asm volatile("s_waitcnt vmcnt(0)" ::: "memory");
    __syncthreads();
    if (kt + 1 < nk) GT_ISSUE_P(cur, kt + 1, (kt + 1) & 1);
    else if (has_next) GT_ISSUE_P(nxt, 0, 0);
    const LAS char* sb = lds + (kt & 1) * 32768;
    if (!HOIST) {
#pragma unroll
      for (int h = 0; h < 2; ++h) {
        bf16x8 af1[4], bf1[4];
#pragma unroll
        for (int m = 0; m < 4; ++m) af1[m] = *(const LAS bf16x8*)(sb + (h ? aoff1 : aoff0) + m * 2048);
#pragma unroll
        for (int n = 0; n < 4; ++n) bf1[n] = *(const LAS bf16x8*)(sb + (h ? boff1 : boff0) + n * 2048);
#pragma unroll
        for (int m = 0; m < 4; ++m)
#pragma unroll
          for (int n = 0; n < 4; ++n) acc[m][n] = __builtin_amdgcn_mfma_f32_16x16x32_bf16(bf1[n], af1[m], acc[m][n], 0, 0, 0);
      }
      continue;
    }
    bf16x8 af[2][4], bfr[2][4];
    const unsigned aad0 = (unsigned)(size_t)(sb + aoff0), aad1 = (unsigned)(size_t)(sb + aoff1), bad0 = (unsigned)(size_t)(sb + boff0), bad1 = (unsigned)(size_t)(sb + boff1);
#define GT_LDR(dst, ad, off) asm volatile("ds_read_b128 %0, %1 offset:%c2" : "=v"(dst) : "v"(ad), "i"(off))
    GT_LDR(af[0][0], aad0, 0); GT_LDR(af[0][1], aad0, 2048); GT_LDR(af[0][2], aad0, 4096); GT_LDR(af[0][3], aad0, 6144);
    GT_LDR(bfr[0][0], bad0, 0); GT_LDR(bfr[0][1], bad0, 2048); GT_LDR(bfr[0][2], bad0, 4096); GT_LDR(bfr[0][3], bad0, 6144);
    GT_LDR(af[1][0], aad1, 0); GT_LDR(af[1][1], aad1, 2048); GT_LDR(af[1][2], aad1, 4096); GT_LDR(af[1][3], aad1, 6144);
    GT_LDR(bfr[1][0], bad1, 0); GT_LDR(bfr[1][1], bad1, 2048); GT_LDR(bfr[1][2], bad1, 4096); GT_LDR(bfr[1][3], bad1, 6144);
#undef GT_LDR
    asm volatile("s_waitcnt lgkmcnt(8)" : "+v"(af[0][0]), "+v"(af[0][1]), "+v"(af[0][2]), "+v"(af[0][3]), "+v"(bfr[0][0]), "+v"(bfr[0][1]), "+v"(bfr[0][2]), "+v"(bfr[0][3]) :: "memory");
    __builtin_amdgcn_sched_barrier(0);
#pragma unroll
    for (int m = 0; m < 4; ++m)
#pragma unroll
      for (int n = 0; n < 4; ++n) acc[m][n] = __builtin_amdgcn_mfma_f32_16x16x32_bf16(bfr[0][n], af[0][m], acc[m][n], 0, 0, 0);
    __builtin_amdgcn_sched_barrier(0);
    asm volatile("s_waitcnt lgkmcnt(0)" : "+v"(af[1][0]), "+v"(af[1][1]), "+v"(af[1][2]), "+v"(af[1][3]), "+v"(bfr[1][0]), "+v"(bfr[1][1]), "+v"(bfr[1][2]), "+v"(bfr[1][3]) :: "memory");
    __builtin_amdgcn_sched_barrier(0);
#pragma unroll
    for (int m = 0; m < 4; ++m)
#pragma unroll
      for (int n = 0; n < 4; ++n) acc[m][n] = __builtin_amdgcn_mfma_f32_16x16x32_bf16(bfr[1][n], af[1][m], acc[m][n], 0, 0, 0);
    __builtin_amdgcn_sched_barrier(0);
  }
}
DI void gemm_tile(LAS char* lds, const u16* a0, long lda32, const u16* b0, long ldb32, int nk, f32x4 (&acc)[4][4]) {
  TilePtrs t; t.a0 = a0; t.a1 = a0 + lda32; t.a2 = a0 + 2 * lda32; t.a3 = a0 + 3 * lda32; t.b0 = b0; t.ldb32 = ldb32;
  gemm_tile_s<false>(lds, t, false, t, false, nk, acc);
  __syncthreads();
}
DI int gt_chunk(int tid) { return ((tid & 7) ^ ((tid >> 4) & 7)) * 8; }
DI int gt_row0(int tid) { return tid >> 3; }

DI void sincos_rev(float pos, float invf, float& sn, float& cs) {
  float rev = pos * invf * 0.15915494309189535f;
  rev -= rintf(rev);
  sn = __builtin_amdgcn_sinf(rev); cs = __builtin_amdgcn_cosf(rev);
}
DI void st_bf4(u16* dst, const f32x4& v) { uint2 o; o.x = cvtpk(v[0], v[1]); o.y = cvtpk(v[2], v[3]); *(uint2*)dst = o; }


DI void stage_put4(LAS char* st, int row, int c8, const f32x4& v) {
  u32x2_t o; o[0] = cvtpk(v[0], v[1]); o[1] = cvtpk(v[2], v[3]);
  *(LAS u32x2_t*)(st + row * 128 + ((c8 ^ (row & 15)) * 8)) = o;
}
DI u32x4_t stage_get16(const LAS char* st, int row, int u) {
  u32x4_t v = *(const LAS u32x4_t*)(st + row * 128 + ((u ^ ((row >> 1) & 7)) * 16));
  if (row & 1) v = __builtin_shufflevector(v, v, 2, 3, 0, 1);
  return v;
}
template <int NC>
DI void stage_flush(const LAS char* st, u16* dst, size_t ld, int lane) {
  constexpr int UPR = NC / 8;
  constexpr int RPI = 64 / UPR;
#pragma unroll
  for (int i = 0; i < 64 / RPI; ++i) {
    const int row = i * RPI + lane / UPR, u = lane % UPR;
    const u32x4_t v = stage_get16(st, row, u);
    *(u32x4_t*)(dst + (size_t)row * ld + u * 8) = v;
  }
}

template <bool F32SRC>
DI void stage_flush_resid(const LAS char* st, const float* __restrict__ xs, u16* xb, int lane) {
#pragma unroll
  for (int h = 0; h < 2; ++h) {
    f32x4 xa[4], xc[4]; u32x4_t xo[4];
#pragma unroll
    for (int i = 0; i < 4; ++i) {
      const int row = (h * 4 + i) * 8 + (lane >> 3), u = lane & 7;
      if (F32SRC) { xa[i] = __builtin_nontemporal_load((const f32x4*)(xs + (size_t)row * 1024 + u * 8)); xc[i] = __builtin_nontemporal_load((const f32x4*)(xs + (size_t)row * 1024 + u * 8 + 4)); }
      else xo[i] = __builtin_nontemporal_load((const u32x4_t*)(xb + (size_t)row * 1024 + u * 8));
    }
#pragma unroll
    for (int i = 0; i < 4; ++i) {
      const int row = (h * 4 + i) * 8 + (lane >> 3), u = lane & 7;
      const u32x4_t d = stage_get16(st, row, u);
      if (!F32SRC) { xa[i] = (f32x4){bflo(xo[i][0]), bfhi(xo[i][0]), bflo(xo[i][1]), bfhi(xo[i][1])}; xc[i] = (f32x4){bflo(xo[i][2]), bfhi(xo[i][2]), bflo(xo[i][3]), bfhi(xo[i][3])}; }
      u32x4_t o;
      o[0] = cvtpk(xa[i][0] + bflo(d[0]), xa[i][1] + bfhi(d[0])); o[1] = cvtpk(xa[i][2] + bflo(d[1]), xa[i][3] + bfhi(d[1]));
      o[2] = cvtpk(xc[i][0] + bflo(d[2]), xc[i][1] + bfhi(d[2])); o[3] = cvtpk(xc[i][2] + bflo(d[3]), xc[i][3] + bfhi(d[3]));
      *(u32x4_t*)(xb + (size_t)row * 1024 + u * 8) = o;
    }
  }
}

DI void epi_inproj(const Params& p, int layer, f32x4 (&acc)[4][4], int m0, int seg, int wr, int fr, int fq, LAS float* rowss_slot, LAS char* stg, int lane) {
  char* ws = p.ws;
  const bool lat = m0 < NL;
  const int rbase = m0 + wr * 64 + fr;
  u16* dst; int ld, cb; int kind;
  if (seg < 6) { dst = (u16*)(ws + OFF_SWQ); ld = 384; cb = seg * 64; kind = 1; }
  else if (seg < 8) { dst = (u16*)(ws + OFF_SWK); ld = 128; cb = (seg - 6) * 64; kind = 1; }
  else if (seg < 10) { dst = (u16*)(ws + OFF_SWV); ld = 128; cb = (seg - 8) * 64; kind = 0; }
  else if (seg < 16) { dst = (u16*)(ws + OFF_GLQ); ld = 384; cb = (seg - 10) * 64; kind = 2; }
  else if (seg < 18) { dst = (u16*)(ws + OFF_GLK); ld = 128; cb = (seg - 16) * 64; kind = 3; }
  else if (seg < 20) { dst = (u16*)(ws + OFF_GLV); ld = 128; cb = (seg - 18) * 64; kind = 0; }
  else if (seg < 24) { dst = (u16*)(ws + OFF_QLAT); ld = 256; cb = (seg - 20) * 64; kind = 4; }
  else if (seg < 26) { dst = (u16*)(ws + OFF_KVLAT); ld = 128; cb = (seg - 24) * 64; kind = 5; }
  else if (seg == 26) { dst = (u16*)(ws + OFF_MLKR); ld = 32; cb = 0; kind = 6; }
  else return;
  if (kind == 2 || kind == 3) {
    const float* gain = (kind == 2 ? p.glb_q_gain : p.glb_k_gain) + layer * 64;
    f32x4 gv[4];
#pragma unroll
    for (int n = 0; n < 4; ++n) gv[n] = *(const f32x4*)(gain + n * 16 + fq * 4);
#pragma unroll
    for (int m = 0; m < 4; ++m) {
      float ss = 0.f;
#pragma unroll
      for (int n = 0; n < 4; ++n) ss += acc[m][n][0] * acc[m][n][0] + acc[m][n][1] * acc[m][n][1] + acc[m][n][2] * acc[m][n][2] + acc[m][n][3] * acc[m][n][3];
      ss += __shfl_xor(ss, 16); ss += __shfl_xor(ss, 32);
      const float r = rsqrtf(ss * (1.f / 64.f) + EPS);
#pragma unroll
      for (int n = 0; n < 4; ++n) acc[m][n] = acc[m][n] * r * gv[n];
    }
  }
  if (kind == 4 || kind == 5) {
    const float* gain = (kind == 4 ? p.mla_q_gain + layer * 256 : p.mla_kv_gain + layer * 128) + cb;
    f32x4 gv[4];
#pragma unroll
    for (int n = 0; n < 4; ++n) gv[n] = *(const f32x4*)(gain + n * 16 + fq * 4);
#pragma unroll
    for (int m = 0; m < 4; ++m) {
      float ss = 0.f;
#pragma unroll
      for (int n = 0; n < 4; ++n) ss += acc[m][n][0] * acc[m][n][0] + acc[m][n][1] * acc[m][n][1] + acc[m][n][2] * acc[m][n][2] + acc[m][n][3] * acc[m][n][3];
      ss += __shfl_xor(ss, 16); ss += __shfl_xor(ss, 32);
      if (fq == 0) rowss_slot[wr * 64 + m * 16 + fr] = ss;
#pragma unroll
      for (int n = 0; n < 4; ++n) acc[m][n] = acc[m][n] * gv[n];
    }
  }
  if (lat && (kind == 1 || kind == 2 || kind == 3)) {
    float invf[4];
#pragma unroll
    for (int j = 0; j < 4; ++j) invf[j] = __builtin_amdgcn_exp2f(-(float)(fq * 4 + j) * (13.287712379549449f / 16.f));
#pragma unroll
    for (int m = 0; m < 4; ++m) {
      const int t = (rbase + m * 16) & (S_ - 1);
      const float prow = (float)(t >> 6), pcol = (float)(t & 63);
#pragma unroll
      for (int j = 0; j < 4; ++j) {
        float sr, cr, sc, cc;
        sincos_rev(prow, invf[j], sr, cr); sincos_rev(pcol, invf[j], sc, cc);
        float x1 = acc[m][0][j], x2 = acc[m][1][j];
        acc[m][0][j] = x1 * cr - x2 * sr; acc[m][1][j] = x2 * cr + x1 * sr;
        x1 = acc[m][2][j]; x2 = acc[m][3][j];
        acc[m][2][j] = x1 * cc - x2 * sc; acc[m][3][j] = x2 * cc + x1 * sc;
      }
    }
  }
  if (kind == 6) {
    if (lat) {
      float invf[4];
#pragma unroll
      for (int j = 0; j < 4; ++j) invf[j] = __builtin_amdgcn_exp2f(-(float)((fq & 1) * 4 + j) * (13.287712379549449f / 8.f));
#pragma unroll
      for (int m = 0; m < 4; ++m) {
        const int t = (rbase + m * 16) & (S_ - 1);
#pragma unroll
        for (int n = 0; n < 2; ++n) {
          const float pos = n == 0 ? (float)(t >> 6) : (float)(t & 63);
#pragma unroll
          for (int j = 0; j < 4; ++j) {
            float sn, cs; sincos_rev(pos, invf[j], sn, cs);
            const float v = acc[m][n][j], pr = __shfl_xor(v, 32);
            acc[m][n][j] = (fq & 2) ? v * cs + pr * sn : v * cs - pr * sn;
          }
        }
      }
    }
#pragma unroll
    for (int m = 0; m < 4; ++m)
#pragma unroll
      for (int n = 0; n < 2; ++n) stage_put4(stg, m * 16 + fr, n * 4 + fq, acc[m][n]);
    stage_flush<32>(stg, dst + (size_t)(m0 + wr * 64) * ld, ld, lane);
    return;
  }
#pragma unroll
  for (int m = 0; m < 4; ++m)
#pragma unroll
    for (int n = 0; n < 4; ++n) stage_put4(stg, m * 16 + fr, n * 4 + fq, acc[m][n]);
  stage_flush<64>(stg, dst + (size_t)(m0 + wr * 64) * ld + cb, ld, lane);
}

DI void p2_inproj(const Params& p, int layer, LAS char* ldsr, int cs = 0) {
  char* ws = p.ws;
  LAS char* lds = ldsr + VHALF * LDS_HALF;
  unsigned* ctr = (unsigned*)(ws + OFF_CTRL) + CW_CTR + layer * 16 + 2 + cs;
  const u16* H = (const u16*)(ws + OFF_H);
  const u16* WinT = (const u16*)(ws + OFF_WIN) + (size_t)layer * INWP * 1024;
  const u16* WuqT = (const u16*)(ws + OFF_WUQ) + (size_t)layer * 384 * 256;
  const u16* WukvT = (const u16*)(ws + OFF_WUKV) + (size_t)layer * 512 * 128;
  const int tid = opaque(VTID), lane = tid & 63, wid = tid >> 6, wr = wid >> 1, wc = wid & 1;
  LAS float* rowss = (LAS float*)(lds + LDS_MISC);
  LAS float* rstd = (LAS float*)(lds + LDS_MISC + 2048);
  unsigned* ctr8 = (unsigned*)(ws + OFF_CTRL) + CW_Q + (layer * 2 + 1) * 512;
  f32x4 acc[4][4];
  for (;;) {
    const int u = next_unit_xcd(ctr8, (NT / 128 / 8 / 2) * 12, ldsr);
    if (u < 0) break;
    const int tid_o = opaque(tid), lane_o = tid_o & 63;
    const int fr = lane_o & 15, fq = lane_o >> 4, ch = gt_chunk(tid_o), r0 = gt_row0(tid_o);
    const int qx = u / 204, v = u % 204, hf = opaque(VHALF);
    int rt, k;
    if (v < 17) { rt = qx * 34 + 2 * v + hf; k = 10; } else if (v < 34) { rt = qx * 34 + 2 * (v - 17) + hf; k = 11; } else { rt = qx * 34 + 2 * ((v - 34) / 10) + hf; k = (v - 34) % 10; }
    const int m0 = rt * 128;
    const u16* a0 = H + (size_t)(m0 + r0) * 1024 + ch;
    if (k < 10) {
      const u16* b0 = WinT + (size_t)(k * 128 + r0) * 1024 + ch;
      gemm_tile(lds, a0, 32 * 1024, b0, 32 * 1024, 16, acc);
      epi_inproj(p, layer, acc, m0, k * 2 + wc, wr, fr, fq, rowss, lds + 32768 + wid * 8192, lane_o);
    } else if (k == 10) {
#pragma unroll 1
      for (int t = 0; t < 2; ++t) {
        const u16* b0 = WinT + (size_t)(1280 + t * 128 + r0) * 1024 + ch;
        gemm_tile(lds, a0, 32 * 1024, b0, 32 * 1024, 16, acc);
        epi_inproj(p, layer, acc, m0, 20 + t * 2 + wc, wr, fr, fq, rowss + (t * 2 + wc) * 128, lds + 32768 + wid * 8192, lane_o);
      }
      __syncthreads();
      if (tid < 128) rstd[tid] = rsqrtf((rowss[tid] + rowss[128 + tid] + rowss[256 + tid] + rowss[384 + tid]) * (1.f / 256.f) + EPS);
      __syncthreads();
      const u16* QL = (const u16*)(ws + OFF_QLAT);
      const u16* qa0 = QL + (size_t)(m0 + r0) * 256 + ch;
      u16* MLQ = (u16*)(ws + OFF_MLQ);
      const bool lat = m0 < NL;
#pragma unroll 1
      for (int t = 0; t < 3; ++t) {
        const u16* b0 = WuqT + (size_t)(t * 128 + r0) * 256 + ch;
        gemm_tile(lds, qa0, 32 * 256, b0, 32 * 256, 4, acc);
        const int c0 = t * 128 + wc * 64;
        float invf[4];
#pragma unroll
        for (int j = 0; j < 4; ++j) invf[j] = __builtin_amdgcn_exp2f(-(float)((fq & 1) * 4 + j) * (13.287712379549449f / 8.f));
#pragma unroll
        for (int m = 0; m < 4; ++m) {
          const int rl = wr * 64 + m * 16 + fr;
          const float rs = rstd[rl];
          const int tpos = (m0 + rl) & (S_ - 1);
#pragma unroll
          for (int n = 0; n < 4; ++n) {
            acc[m][n] = acc[m][n] * rs;
            const int w96 = (c0 + n * 16) % 96;
            if (lat && w96 >= 64) {
              const float pos = (w96 == 64) ? (float)(tpos >> 6) : (float)(tpos & 63);
#pragma unroll
              for (int j = 0; j < 4; ++j) {
                float sn, cs; sincos_rev(pos, invf[j], sn, cs);
                const float v = acc[m][n][j], pr = __shfl_xor(v, 32);
                acc[m][n][j] = (fq & 2) ? v * cs + pr * sn : v * cs - pr * sn;
              }
            }
            stage_put4(lds + 32768 + wid * 8192, m * 16 + fr, n * 4 + fq, acc[m][n]);
          }
        }
        stage_flush<64>(lds + 32768 + wid * 8192, MLQ + (size_t)(m0 + wr * 64) * 384 + c0, 384, lane_o);
      }
    } else {
      {
        const u16* b0 = WinT + (size_t)(1536 + r0) * 1024 + ch;
        gemm_tile(lds, a0, 32 * 1024, b0, 32 * 1024, 16, acc);
        epi_inproj(p, layer, acc, m0, 24 + wc, wr, fr, fq, rowss + wc * 128, lds + 32768 + wid * 8192, lane_o);
        const u16* b2 = WinT + (size_t)(1664 + r0) * 1024 + ch;
        gemm_tile(lds, a0, 32 * 1024, b2, 32 * 1024, 16, acc);
        epi_inproj(p, layer, acc, m0, 26 + wc, wr, fr, fq, rowss, lds + 32768 + wid * 8192, lane_o);
      }
      __syncthreads();
      if (tid < 128) rstd[tid] = rsqrtf((rowss[tid] + rowss[128 + tid]) * (1.f / 128.f) + EPS);
      __syncthreads();
      const u16* KL = (const u16*)(ws + OFF_KVLAT);
      const u16* ka0 = KL + (size_t)(m0 + r0) * 128 + ch;
#pragma unroll 1
      for (int t = 0; t < 4; ++t) {
        const u16* b0 = WukvT + (size_t)(t * 128 + r0) * 128 + ch;
        gemm_tile(lds, ka0, 32 * 128, b0, 32 * 128, 2, acc);
        u16* dst = (u16*)(ws + (wc == 0 ? OFF_MLK : OFF_MLV));
#pragma unroll
        for (int m = 0; m < 4; ++m) {
          const int rl = wr * 64 + m * 16 + fr;
          const float rs = rstd[rl];
#pragma unroll
          for (int n = 0; n < 4; ++n) { acc[m][n] = acc[m][n] * rs; stage_put4(lds + 32768 + wid * 8192, m * 16 + fr, n * 4 + fq, acc[m][n]); }
        }
        stage_flush<64>(lds + 32768 + wid * 8192, dst + (size_t)(m0 + wr * 64) * 256 + t * 64, 256, lane_o);
      }
    }
  }
}


namespace g8 {
constexpr int HTB = 16384;
DI int lds_byte(int r, int c) { const int st = (r >> 4) * 2 + (c >> 5), rr = r & 15, cc = c & 31, ob = rr * 64 + cc * 2; return st * 1024 + (ob ^ (((ob >> 9) & 1) << 5)); }
DI void stage_rc(int b, int& R, int& C) { const int st = b / 1024, sb = b % 1024, swz = sb ^ (((sb >> 9) & 1) << 5); R = (st >> 1) * 16 + swz / 64; C = (st & 1) * 32 + (swz % 64) / 2; }
struct Unit { const char* B; unsigned va[2][2]; int id; };
template <int K, class PH>
DI void gemm8(LAS char* lds, const PH& ph) {
  const int tid = opaque((int)threadIdx.x), wid = __builtin_amdgcn_readfirstlane(tid >> 6), lane = tid & 63, wr = wid >> 2, wc = wid & 3, fr = lane & 15, fq = lane >> 4;
  constexpr int nt = K / 64;
  int sr[2], sc[2]; unsigned voffB[2];
#pragma unroll
  for (int i = 0; i < 2; ++i) { stage_rc(tid * 16 + i * 8192, sr[i], sc[i]); const int Rb = 64 * (sr[i] >> 5) + (sr[i] & 31); voffB[i] = (unsigned)(Rb * K + sc[i]) * 2u; }
  constexpr int hstepB = 32 * K * 2;
  const unsigned ldsw = (unsigned)wid * 1024u;
  const int aoff = lds_byte(wr * 64 + fr, fq * 8), boff = lds_byte(wc * 32 + fr, fq * 8);
  const char* Ab = ph.abase();
#define G8_SA(b, h) (((b) * 2 + (h)) * g8::HTB)
#define G8_SB(b, h) ((4 + (b) * 2 + (h)) * g8::HTB)
#define G8_STAGE(bufoff, gbase, v0, v1) do { \
    __builtin_amdgcn_global_load_lds((const unsigned*)((gbase) + (v0)), (LAS unsigned*)(lds + (bufoff) + ldsw), 16, 0, 0); \
    __builtin_amdgcn_global_load_lds((const unsigned*)((gbase) + (v1)), (LAS unsigned*)(lds + (bufoff) + ldsw + 8192), 16, 0, 0); } while (0)
#define G8_STA(b, h, kt, V) G8_STAGE(G8_SA(b, h), Ab + (size_t)(kt) * 128, (V)[h][0], (V)[h][1])
#define G8_STB(b, h, Bp, kt) G8_STAGE(G8_SB(b, h), (Bp) + (size_t)(kt) * 128 + (h) * hstepB, voffB[0], voffB[1])
#define G8_LDA(dst, b, h) do { _Pragma("unroll") for (int m = 0; m < 4; ++m) _Pragma("unroll") for (int k = 0; k < 2; ++k) dst[m][k] = *(const LAS bf16x8*)(lds + G8_SA(b, h) + aoff + m * 2048 + k * 1024); } while (0)
#define G8_LDB(dst, b, h) do { _Pragma("unroll") for (int n = 0; n < 2; ++n) _Pragma("unroll") for (int k = 0; k < 2; ++k) dst[n][k] = *(const LAS bf16x8*)(lds + G8_SB(b, h) + boff + n * 2048 + k * 1024); } while (0)
#define G8_MMA(ai, bj, At, Bt) do { __builtin_amdgcn_s_setprio(1); _Pragma("unroll") for (int m = 0; m < 4; ++m) _Pragma("unroll") for (int n = 0; n < 2; ++n) _Pragma("unroll") for (int k = 0; k < 2; ++k) \
    acc[ai][bj][m][n] = __builtin_amdgcn_mfma_f32_16x16x32_bf16(Bt[n][k], At[m][k], acc[ai][bj][m][n], 0, 0, 0); __builtin_amdgcn_s_setprio(0); } while (0)
#define G8_WAIT_V(n) asm volatile("s_waitcnt vmcnt(" #n ")" ::: "memory")
#define G8_WAIT_L(n) asm volatile("s_waitcnt lgkmcnt(" #n ")" ::: "memory")
#define G8_BAR __builtin_amdgcn_s_barrier()
#define G8_SCHED __builtin_amdgcn_sched_barrier(0)
  Unit cur, nxt; int ui = 0;
  if (!ph.unit(0, cur, sr, sc)) return;
  f32x4 acc[2][2][4][2];
#pragma unroll
  for (int a = 0; a < 2; ++a)
#pragma unroll
    for (int b = 0; b < 2; ++b)
#pragma unroll
      for (int m = 0; m < 4; ++m)
#pragma unroll
        for (int n = 0; n < 2; ++n) acc[a][b][m][n] = (f32x4){0.f, 0.f, 0.f, 0.f};
  bf16x8 At[4][2], B0[2][2], B1[2][2];
  G8_STB(0, 0, cur.B, 0); G8_STA(0, 0, 0, cur.va); G8_STB(0, 1, cur.B, 0); G8_STA(0, 1, 0, cur.va);
  if (wr == 1) G8_BAR;
  G8_WAIT_V(4); G8_BAR;
  G8_STB(1, 0, cur.B, 1); G8_STA(1, 0, 1, cur.va); G8_STB(1, 1, cur.B, 1);
  G8_WAIT_V(6); G8_BAR;
  for (;;) {
    const bool has_next = ph.unit(ui + 1, nxt, sr, sc);
    if (!has_next) nxt = cur;
#pragma unroll 1
    for (int t = 0; t < nt; t += 2) {
      const bool last = (t == nt - 2);
      const char* B2 = last ? nxt.B : cur.B;
      const int k2 = last ? 0 : t + 2, k3 = k2 + 1;
      unsigned v2[2][2];
#pragma unroll
      for (int h = 0; h < 2; ++h)
#pragma unroll
        for (int i = 0; i < 2; ++i) v2[h][i] = last ? nxt.va[h][i] : cur.va[h][i];
      G8_LDB(B0, 0, 0); G8_SCHED; G8_LDA(At, 0, 0); G8_STA(1, 1, t + 1, cur.va);
      G8_WAIT_L(8); G8_BAR; G8_WAIT_L(0); G8_MMA(0, 0, At, B0); G8_BAR; G8_SCHED;
      G8_LDB(B1, 0, 1); G8_STB(0, 0, B2, k2);
      G8_BAR; G8_WAIT_L(0); G8_MMA(0, 1, At, B1); G8_BAR;
      G8_LDA(At, 0, 1); G8_STA(0, 0, k2, v2);
      G8_BAR; G8_WAIT_L(0); G8_MMA(1, 0, At, B0); G8_BAR; G8_SCHED;
      G8_STB(0, 1, B2, k2);
      G8_WAIT_V(6); G8_BAR; G8_MMA(1, 1, At, B1); G8_BAR;
      G8_LDB(B0, 1, 0); G8_SCHED; G8_LDA(At, 1, 0); G8_STA(0, 1, k2, v2);
      G8_WAIT_L(8); G8_BAR; G8_WAIT_L(0); G8_MMA(0, 0, At, B0); G8_BAR; G8_SCHED;
      G8_LDB(B1, 1, 1); G8_STB(1, 0, B2, k3);
      G8_BAR; G8_WAIT_L(0); G8_MMA(0, 1, At, B1); G8_BAR;
      G8_LDA(At, 1, 1); G8_STA(1, 0, k3, v2);
      G8_BAR; G8_WAIT_L(0); G8_MMA(1, 0, At, B0); G8_BAR; G8_SCHED;
      G8_STB(1, 1, B2, k3);
      G8_WAIT_V(6); G8_BAR; G8_MMA(1, 1, At, B1); G8_BAR;
    }
    ph.epi(acc, cur, wid, lane);
    if (!has_next) break;
#pragma unroll
    for (int a = 0; a < 2; ++a)
#pragma unroll
      for (int b = 0; b < 2; ++b)
#pragma unroll
        for (int m = 0; m < 4; ++m)
#pragma unroll
          for (int n = 0; n < 2; ++n) acc[a][b][m][n] = (f32x4){0.f, 0.f, 0.f, 0.f};
    cur = nxt; ++ui;
  }
  G8_WAIT_V(0);
  if (wr == 0) G8_BAR;
  G8_BAR;
#undef G8_SA
#undef G8_SB
#undef G8_STAGE
#undef G8_STA
#undef G8_STB
#undef G8_LDA
#undef G8_LDB
#undef G8_MMA
#undef G8_WAIT_V
#undef G8_WAIT_L
#undef G8_BAR
#undef G8_SCHED
}
template <int NC>
DI void flush16(const LAS char* st, u16* dst, size_t ld, int lane) {
  constexpr int UPR = NC / 8, RPI = 64 / UPR;
#pragma unroll
  for (int i = 0; i < 16 / RPI; ++i) {
    const int row = i * RPI + lane / UPR, u = lane % UPR;
    *(u32x4_t*)(dst + (size_t)row * ld + u * 8) = stage_get16(st, row, u);
  }
}
DI int unit_id(int i) { return (int)((blockIdx.x & 7) * (gridDim.x >> 3) + (blockIdx.x >> 3)) + i * (int)gridDim.x; }
}

struct P4Phase {
  const u16* Y; const u16* WoT; const float* MODl; u16* DELTA; int nunits; LAS char* lds;
  DI const char* abase() const { return (const char*)Y; }
  DI bool unit(int i, g8::Unit& u, const int (&sr)[2], const int (&sc)[2]) const {
    const int id = g8::unit_id(i); if (id >= nunits) return false;
    const int rt = id >> 2, pn = id & 3;
    u.id = id; u.B = (const char*)(WoT + (size_t)pn * 256 * 1024);
#pragma unroll
    for (int h = 0; h < 2; ++h)
#pragma unroll
      for (int j = 0; j < 2; ++j) u.va[h][j] = (unsigned)((rt * 256 + h * 128 + sr[j]) * 1024 + sc[j]) * 2u;
    return true;
  }
  DI void epi(f32x4 (&acc)[2][2][4][2], const g8::Unit& u, int wid, int lane) const {
    const int wr = wid >> 2, wc = wid & 3, fr = lane & 15, fq = lane >> 4;
    const int rt = u.id >> 2, pn = u.id & 3, m0 = rt * 256;
    const int mr = m0 < NL ? m0 / S_ : 8;
    const float* gate = MODl + (size_t)mr * 6144 + 2 * 1024 + pn * 256 + wc * 64 + fq * 4;
    f32x4 g[4];
#pragma unroll
    for (int n = 0; n < 4; ++n) g[n] = *(const f32x4*)(gate + n * 16);
    LAS char* stg = lds + LDS_ESTG + wid * 2048;
#pragma unroll
    for (int ai = 0; ai < 2; ++ai)
#pragma unroll
      for (int m = 0; m < 4; ++m) {
#pragma unroll
        for (int bj = 0; bj < 2; ++bj)
#pragma unroll
          for (int n = 0; n < 2; ++n) stage_put4(stg, fr, (2 * bj + n) * 4 + fq, g[2 * bj + n] * acc[ai][bj][m][n]);
        g8::flush16<64>(stg, DELTA + (size_t)(m0 + ai * 128 + wr * 64 + m * 16) * 1024 + pn * 256 + wc * 64, 1024, lane);
      }
  }
};
DI void p4_outproj8(const Params& p, int layer, int nrows, LAS char* lds) {
  P4Phase ph;
  ph.Y = (const u16*)(p.ws + OFF_Y); ph.WoT = (const u16*)(p.ws + OFF_WO) + (size_t)layer * 1024 * 1024;
  ph.MODl = (const float*)(p.ws + OFF_MOD) + (size_t)layer * 9 * 6144; ph.DELTA = (u16*)(p.ws + OFF_DELTA);
  ph.nunits = (nrows / 256) * 4; ph.lds = lds;
  __syncthreads();
  g8::gemm8<1024>(lds, ph);
  __syncthreads();
}


struct P6Phase {
  const u16 *H, *WguT, *SguT; const int* list; const unsigned* cnt; u16 *ACT, *ACTS; int tb[NE + 1]; int R, nunits; LAS char* lds;
  DI const char* abase() const { return (const char*)H; }
  DI bool unit(int i, g8::Unit& u, const int (&sr)[2], const int (&sc)[2]) const {
    const int id = g8::unit_id(i); if (id >= nunits) return false;
    const int rt = id >> 2, pn = id & 3;
    u.id = id;
    if (rt < R) {
      int e = 0, tbe = 0;
#pragma unroll
      for (int q = 1; q < NE; ++q) if (rt >= tb[q]) { e = q; tbe = tb[q]; }
      const int i0 = (rt - tbe) * 256, ce = (int)cnt[e * CNT_STRIDE];
      const int* lp = list + (size_t)e * NT + i0;
#pragma unroll
      for (int h = 0; h < 2; ++h)
#pragma unroll
        for (int j = 0; j < 2; ++j) { const int ix = h * 128 + sr[j]; const int tok = i0 + ix < ce ? lp[ix] : 0; u.va[h][j] = (unsigned)(tok * 1024 + sc[j]) * 2u; }
      u.B = (const char*)(WguT + ((size_t)e * 1024 + pn * 256) * 1024);
    } else {
      const int m0 = (rt - R) * 256;
#pragma unroll
      for (int h = 0; h < 2; ++h)
#pragma unroll
        for (int j = 0; j < 2; ++j) u.va[h][j] = (unsigned)((m0 + h * 128 + sr[j]) * 1024 + sc[j]) * 2u;
      u.B = (const char*)(SguT + (size_t)pn * 256 * 1024);
    }
    return true;
  }
  DI void epi(f32x4 (&acc)[2][2][4][2], const g8::Unit& u, int wid, int lane) const {
    const int wr = wid >> 2, wc = wid & 3, fr = lane & 15, fq = lane >> 4;
    const int rt = u.id >> 2, pn = u.id & 3;
    u16* dst; size_t orow;
    if (rt < R) { dst = ACT; orow = (size_t)rt * 256; } else { dst = ACTS; orow = (size_t)(rt - R) * 256; }
    LAS char* stg = lds + LDS_ESTG + wid * 2048;
#pragma unroll
    for (int ai = 0; ai < 2; ++ai)
#pragma unroll
      for (int m = 0; m < 4; ++m) {
#pragma unroll
        for (int n = 0; n < 2; ++n) {
          f32x4 r;
#pragma unroll
          for (int j = 0; j < 4; ++j) r[j] = silu(acc[ai][0][m][n][j]) * acc[ai][1][m][n][j];
          stage_put4(stg, fr, n * 4 + fq, r);
        }
        g8::flush16<32>(stg, dst + (orow + ai * 128 + wr * 64 + m * 16) * 512 + pn * 128 + wc * 32, 512, lane);
      }
  }
};
DI void p6_gateup8(const Params& p, int layer, int nrows, LAS char* lds) {
  P6Phase ph;
  ph.H = (const u16*)(p.ws + OFF_H); ph.WguT = (const u16*)(p.ws + OFF_WGU) + (size_t)layer * NE * 1024 * 1024; ph.SguT = (const u16*)(p.ws + OFF_SGU) + (size_t)layer * 1024 * 1024;
  ph.list = (const int*)(p.ws + OFF_LIST); ph.cnt = (const unsigned*)(p.ws + OFF_CTRL) + CW_CNT + layer * 16 * CNT_STRIDE;
  ph.ACT = (u16*)(p.ws + OFF_ACT); ph.ACTS = (u16*)(p.ws + OFF_ACTS);
  seg_scan(p, layer, ph.tb); ph.R = ph.tb[NE]; ph.nunits = (ph.R + nrows / 256) * 4; ph.lds = lds;
  __syncthreads();
  g8::gemm8<1024>(lds, ph);
  __syncthreads();
}
struct P7Phase {
  const u16 *ACT, *WdT, *SdT; u16 *YEXP, *YSH; int tb[NE + 1]; int R, nunits; LAS char* lds;
  DI const char* abase() const { return (const char*)ACT; }
  DI bool unit(int i, g8::Unit& u, const int (&sr)[2], const int (&sc)[2]) const {
    const int id = g8::unit_id(i); if (id >= nunits) return false;
    const int rt = id >> 2, pn = id & 3;
    u.id = id;
    if (rt < R) {
      int e = 0;
#pragma unroll
      for (int q = 1; q < NE; ++q) if (rt >= tb[q]) e = q;
#pragma unroll
      for (int h = 0; h < 2; ++h)
#pragma unroll
        for (int j = 0; j < 2; ++j) u.va[h][j] = (unsigned)((rt * 256 + h * 128 + sr[j]) * 512 + sc[j]) * 2u;
      u.B = (const char*)(WdT + ((size_t)e * 1024 + pn * 256) * 512);
    } else {
      const int m0 = (rt - R) * 256;
#pragma unroll
      for (int h = 0; h < 2; ++h)
#pragma unroll
        for (int j = 0; j < 2; ++j) u.va[h][j] = (unsigned)(OFF_ACTS - OFF_ACT) + (unsigned)((m0 + h * 128 + sr[j]) * 512 + sc[j]) * 2u;
      u.B = (const char*)(SdT + (size_t)pn * 256 * 512);
    }
    return true;
  }
  DI void epi(f32x4 (&acc)[2][2][4][2], const g8::Unit& u, int wid, int lane) const {
    const int wr = wid >> 2, wc = wid & 3, fr = lane & 15, fq = lane >> 4;
    const int rt = u.id >> 2, pn = u.id & 3;
    u16* dst; size_t orow;
    if (rt < R) { dst = YEXP; orow = (size_t)rt * 256; } else { dst = YSH; orow = (size_t)(rt - R) * 256; }
    LAS char* stg = lds + LDS_ESTG + wid * 2048;
#pragma unroll
    for (int ai = 0; ai < 2; ++ai)
#pragma unroll
      for (int m = 0; m < 4; ++m) {
#pragma unroll
        for (int bj = 0; bj < 2; ++bj)
#pragma unroll
          for (int n = 0; n < 2; ++n) stage_put4(stg, fr, (2 * bj + n) * 4 + fq, acc[ai][bj][m][n]);
        g8::flush16<64>(stg, dst + (orow + ai * 128 + wr * 64 + m * 16) * 1024 + pn * 256 + wc * 64, 1024, lane);
      }
  }
};
DI void p7_down8(const Params& p, int layer, int nrows, LAS char* lds) {
  P7Phase ph;
  ph.ACT = (const u16*)(p.ws + OFF_ACT); ph.WdT = (const u16*)(p.ws + OFF_WD) + (size_t)layer * NE * 1024 * 512; ph.SdT = (const u16*)(p.ws + OFF_SD) + (size_t)layer * 1024 * 512;
  ph.YEXP = (u16*)(p.ws + OFF_YEXP); ph.YSH = (u16*)(p.ws + OFF_YSH);
  seg_scan(p, layer, ph.tb); ph.R = ph.tb[NE]; ph.nunits = (ph.R + nrows / 256) * 4; ph.lds = lds;
  __syncthreads();
  g8::gemm8<512>(lds, ph);
  __syncthreads();
}

DI void p4_outproj(const Params& p, int layer, int nrows, LAS char* ldsr, int cs = 0) {
  char* ws = p.ws;
  LAS char* lds = ldsr + VHALF * LDS_HALF;
  const u16* Y = (const u16*)(ws + OFF_Y);
  const u16* WoT = (const u16*)(ws + OFF_WO) + (size_t)layer * 1024 * 1024;
  const float* MODl = (const float*)(ws + OFF_MOD) + (size_t)layer * 9 * 6144;
  const int tid = opaque(VTID), wid = tid >> 6, wr = wid >> 1, wc = wid & 1;
  const int nunits = (nrows / 128) * 8;
  f32x4 acc[4][4];
  __syncthreads();
  TilePtrs cur, nxt;
  const int vb = VBID, vg = VGRID;
  int u = ((vb >> 1) & 7) * (vg >> 3) + (vb >> 4) * 2 + (vb & 1);
  int uo = ((vb >> 1) & 7) * (vg >> 3) + (vb >> 4) * 2 + ((vb & 1) ^ 1);
#define P4_DESC(T, uu) do { const int _t = opaque(tid); const int _ch = gt_chunk(_t), _r0 = gt_row0(_t); const int _rt = (uu) >> 3, _ct = (uu) & 7; \
    (T).a0 = Y + (size_t)(_rt * 128 + _r0) * 1024 + _ch; (T).a1 = (T).a0 + 32 * 1024; (T).a2 = (T).a0 + 64 * 1024; (T).a3 = (T).a0 + 96 * 1024; \
    (T).b0 = WoT + (size_t)(_ct * 128 + _r0) * 1024 + _ch; (T).ldb32 = 32 * 1024; } while (0)
  bool issued = false;
  P4_DESC(cur, u < nunits ? u : 0);
  while (u < nunits || uo < nunits) {
    const bool act = u < nunits;
    const int un = u + vg;
    const bool hn = un < nunits;
    if (hn) P4_DESC(nxt, un); else nxt = cur;
    gemm_tile_s(lds, cur, issued, nxt, hn, 16, acc);
    issued = hn;
    const int tid_o = opaque(tid), lane_o = tid_o & 63;
    const int fr = lane_o & 15, fq = lane_o >> 4;
    const int rt = u >> 3, ct = u & 7, m0 = rt * 128;
    const int mr = m0 < NL ? m0 / S_ : 8;
    const float* gate = MODl + (size_t)mr * 6144 + 2 * 1024 + ct * 128 + wc * 64 + fq * 4;
    __syncthreads();
    LAS char* stg = lds + 32768 + wid * 8192;
#pragma unroll
    for (int n = 0; n < 4; ++n) {
      const f32x4 g = *(const f32x4*)(gate + n * 16);
#pragma unroll
      for (int m = 0; m < 4; ++m) stage_put4(stg, m * 16 + fr, n * 4 + fq, g * acc[m][n]);
    }
    if (act) { const int grow = m0 + wr * 64, gcol = ct * 128 + wc * 64;
      u16* xb = (u16*)(ws + OFF_XB) + (size_t)grow * 1024 + gcol;
      if (layer == 0) stage_flush_resid<true>(stg, (grow < NL ? p.x + (size_t)grow * 1024 : p.ctx + (size_t)(grow - NL) * 1024) + gcol, xb, lane_o);
      else stage_flush_resid<false>(stg, nullptr, xb, lane_o); }
    cur = nxt; u = un; uo += vg;
  }
#undef P4_DESC
  __syncthreads();
}

DI void p6_gateup(const Params& p, int layer, int nrows, LAS char* ldsr, int cs = 0) {
  char* ws = p.ws;
  LAS char* lds = ldsr + VHALF * LDS_HALF;
  const unsigned* cnt = (const unsigned*)(ws + OFF_CTRL) + CW_CNT + layer * 16 * CNT_STRIDE;
  const u16* H = (const u16*)(ws + OFF_H);
  const int* list = (const int*)(ws + OFF_LIST);
  const u16* WguT = (const u16*)(ws + OFF_WGU) + (size_t)layer * NE * 1024 * 1024;
  const u16* SguT = (const u16*)(ws + OFF_SGU) + (size_t)layer * 1024 * 1024;
  u16* ACT = (u16*)(ws + OFF_ACT); u16* ACTS = (u16*)(ws + OFF_ACTS);
  const int tid = opaque(VTID), wid = tid >> 6, wr = wid >> 1, wc = wid & 1;
  int tb[NE + 1]; seg_scan(p, layer, tb);
  const int R = tb[NE];
  const int nunits = (R + nrows / 128) * 8;
  f32x4 acc[4][4];
  __syncthreads();
  TilePtrs cur, nxt;
#define P6_DESC(T, uu) do { const int _t = opaque(tid); const int _ch = gt_chunk(_t), _r0 = gt_row0(_t); const int _rt = (uu) >> 3, _ct = (uu) & 7; \
    if (_rt < R) { int _e = 0, _tbe = 0; _Pragma("unroll") for (int q = 1; q < NE; ++q) if (_rt >= tb[q]) { _e = q; _tbe = tb[q]; } \
      const int _i = _rt - _tbe, _ce = (int)cnt[_e * CNT_STRIDE]; const int _i0 = _i * 128 + _r0; const int* _lp = list + (size_t)_e * NT + _i0; \
      const int _t0 = _i0 < _ce ? _lp[0] : 0, _t1 = _i0 + 32 < _ce ? _lp[32] : 0, _t2 = _i0 + 64 < _ce ? _lp[64] : 0, _t3 = _i0 + 96 < _ce ? _lp[96] : 0; \
      (T).a0 = H + (size_t)_t0 * 1024 + _ch; (T).a1 = H + (size_t)_t1 * 1024 + _ch; (T).a2 = H + (size_t)_t2 * 1024 + _ch; (T).a3 = H + (size_t)_t3 * 1024 + _ch; \
      (T).b0 = WguT + ((size_t)_e * 1024 + _ct * 128 + _r0) * 1024 + _ch; } \
    else { const int _m0 = (_rt - R) * 128; (T).a0 = H + (size_t)(_m0 + _r0) * 1024 + _ch; (T).a1 = (T).a0 + 32 * 1024; (T).a2 = (T).a0 + 64 * 1024; (T).a3 = (T).a0 + 96 * 1024; \
      (T).b0 = SguT + (size_t)(_ct * 128 + _r0) * 1024 + _ch; } \
    (T).ldb32 = 32 * 1024; } while (0)
  const int vb = VBID, vg = VGRID;
  int u = ((vb >> 1) & 7) * (vg >> 3) + (vb >> 4) * 2 + (vb & 1);
  int uo = ((vb >> 1) & 7) * (vg >> 3) + (vb >> 4) * 2 + ((vb & 1) ^ 1);
  bool issued = false;
  P6_DESC(cur, u < nunits ? u : 0);
  while (u < nunits || uo < nunits) {
    const bool act = u < nunits;
    const int un = u + vg;
    const bool hn = un < nunits;
    if (hn) P6_DESC(nxt, un); else nxt = cur;
    gemm_tile_s(lds, cur, issued, nxt, hn, 16, acc);
    issued = hn;
    const int tid_o = opaque(tid), lane_o = tid_o & 63;
    const int fr = lane_o & 15, fq = lane_o >> 4;
    const int rt = u >> 3, ct = u & 7;
    u16* dst; size_t orow;
    if (rt < R) { dst = ACT; orow = (size_t)rt * 128; } else { dst = ACTS; orow = (size_t)(rt - R) * 128; }
    __syncthreads();
    LAS char* stg = lds + 32768 + wid * 8192;
#pragma unroll
    for (int m = 0; m < 4; ++m)
#pragma unroll
      for (int n = 0; n < 2; ++n) {
        f32x4 r;
#pragma unroll
        for (int j = 0; j < 4; ++j) r[j] = silu(acc[m][n][j]) * acc[m][n + 2][j];
        stage_put4(stg, m * 16 + fr, n * 4 + fq, r);
      }
    if (act) stage_flush<32>(stg, dst + (orow + wr * 64) * 512 + ct * 64 + wc * 32, 512, lane_o);
    cur = nxt; u = un; uo += vg;
  }
#undef P6_DESC
  __syncthreads();
}

DI void p7_down(const Params& p, int layer, int nrows, LAS char* ldsr, int cs = 0) {
  char* ws = p.ws;
  LAS char* lds = ldsr + VHALF * LDS_HALF;
  const u16* WdT = (const u16*)(ws + OFF_WD) + (size_t)layer * NE * 1024 * 512;
  const u16* SdT = (const u16*)(ws + OFF_SD) + (size_t)layer * 1024 * 512;
  const u16* ACT = (const u16*)(ws + OFF_ACT); const u16* ACTS = (const u16*)(ws + OFF_ACTS);
  u16* YEXP = (u16*)(ws + OFF_YEXP); u16* YSH = (u16*)(ws + OFF_YSH);
  const int tid = opaque(VTID), wid = tid >> 6, wr = wid >> 1, wc = wid & 1;
  int tb[NE + 1]; seg_scan(p, layer, tb);
  const int R = tb[NE];
  const int nunits = (R + nrows / 128) * 8;
  f32x4 acc[4][4];
  __syncthreads();
  TilePtrs cur, nxt;
#define P7_DESC(T, uu) do { const int _t = opaque(tid); const int _ch = gt_chunk(_t), _r0 = gt_row0(_t); const int _rt = (uu) >> 3, _ct = (uu) & 7; \
    if (_rt < R) { int _e = 0; _Pragma("unroll") for (int q = 1; q < NE; ++q) if (_rt >= tb[q]) _e = q; \
      (T).a0 = ACT + ((size_t)_rt * 128 + _r0) * 512 + _ch; (T).b0 = WdT + ((size_t)_e * 1024 + _ct * 128 + _r0) * 512 + _ch; } \
    else { const int _m0 = (_rt - R) * 128; (T).a0 = ACTS + (size_t)(_m0 + _r0) * 512 + _ch; (T).b0 = SdT + (size_t)(_ct * 128 + _r0) * 512 + _ch; } \
    (T).a1 = (T).a0 + 32 * 512; (T).a2 = (T).a0 + 64 * 512; (T).a3 = (T).a0 + 96 * 512; (T).ldb32 = 32 * 512; } while (0)
  const int vb = VBID, vg = VGRID;
  int u = ((vb >> 1) & 7) * (vg >> 3) + (vb >> 4) * 2 + (vb & 1);
  int uo = ((vb >> 1) & 7) * (vg >> 3) + (vb >> 4) * 2 + ((vb & 1) ^ 1);
  bool issued = false;
  P7_DESC(cur, u < nunits ? u : 0);
  while (u < nunits || uo < nunits) {
    const bool act = u < nunits;
    const int un = u + vg;
    const bool hn = un < nunits;
    if (hn) P7_DESC(nxt, un); else nxt = cur;
    gemm_tile_s(lds, cur, issued, nxt, hn, 8, acc);
    issued = hn;
    const int tid_o = opaque(tid), lane_o = tid_o & 63;
    const int fr = lane_o & 15, fq = lane_o >> 4;
    const int rt = u >> 3, ct = u & 7;
    u16* dst; size_t orow;
    if (rt < R) { dst = YEXP; orow = (size_t)rt * 128; } else { dst = YSH; orow = (size_t)(rt - R) * 128; }
    __syncthreads();
    LAS char* stg = lds + 32768 + wid * 8192;
#pragma unroll
    for (int m = 0; m < 4; ++m)
#pragma unroll
      for (int n = 0; n < 4; ++n) stage_put4(stg, m * 16 + fr, n * 4 + fq, acc[m][n]);
    if (act) stage_flush<64>(stg, dst + (orow + wr * 64) * 1024 + ct * 128 + wc * 64, 1024, lane_o);
    cur = nxt; u = un; uo += vg;
  }
#undef P7_DESC
  __syncthreads();
}

typedef float f32x16 __attribute__((ext_vector_type(16)));
typedef short s16x4 __attribute__((ext_vector_type(4)));
DI s16x4 tr_read(const LAS char* a) { return __builtin_bit_cast(s16x4, __builtin_amdgcn_ds_read_tr16_b64_v4i16((LAS s16x4*)a)); }
DI float half_max(float m) { auto rr = __builtin_amdgcn_permlane32_swap(__float_as_uint(m), __float_as_uint(m), false, false); return fmaxf(__uint_as_float(rr[0]), __uint_as_float(rr[1])); }
DI float half_sum(float m) { auto rr = __builtin_amdgcn_permlane32_swap(__float_as_uint(m), __float_as_uint(m), false, false); return __uint_as_float(rr[0]) + __uint_as_float(rr[1]); }
DI bf16x8 pack8(const f32x16& x, int s8) {
  typedef unsigned u32x4 __attribute__((ext_vector_type(4)));
  u32x4 r;
  r[0] = cvtpk(x[s8 + 0], x[s8 + 1]); r[1] = cvtpk(x[s8 + 2], x[s8 + 3]); r[2] = cvtpk(x[s8 + 4], x[s8 + 5]); r[3] = cvtpk(x[s8 + 6], x[s8 + 7]);
  return __builtin_bit_cast(bf16x8, r);
}
constexpr int AT_STAGE = 20480;

DI float max3f(float a, float b, float c) { float r; asm("v_max3_f32 %0, %1, %2, %3" : "=v"(r) : "v"(a), "v"(b), "v"(c)); return r; }
template <bool MLA, bool SWA>
DI void attn_unit(const Params& p, int layer, int isctx, int b, int h, int qb, LAS char* lds) {
  char* ws = p.ws;
  const int tid = opaque((int)threadIdx.x), lane = tid & 63, wid = tid >> 6, r32 = lane & 31, hi = lane >> 5;
  const u16 *Qg, *Kg, *Vg; int ldq, ldk, qoff, koff, ycol; float cs;
  if (MLA) { Qg = (const u16*)(ws + OFF_MLQ); Kg = (const u16*)(ws + OFF_MLK); Vg = (const u16*)(ws + OFF_MLV); ldq = 384; ldk = 256; qoff = h * 96; koff = h * 64; ycol = 768 + h * 64; cs = 0.10206207261596575f * 1.4426950408889634f; }
  else if (!SWA) { Qg = (const u16*)(ws + OFF_GLQ); Kg = (const u16*)(ws + OFF_GLK); Vg = (const u16*)(ws + OFF_GLV); ldq = 384; ldk = 128; qoff = h * 64; koff = (h / 3) * 64; ycol = 384 + h * 64; cs = 0.125f * 1.4426950408889634f; }
  else { Qg = (const u16*)(ws + OFF_SWQ); Kg = (const u16*)(ws + OFF_SWK); Vg = (const u16*)(ws + OFF_SWV); ldq = 384; ldk = 128; qoff = h * 64; koff = (h / 3) * 64; ycol = h * 64; cs = 0.125f * 1.4426950408889634f; }
  const u16* Rg = (const u16*)(ws + OFF_MLKR);
  const int q0 = qb * 128;
  const int qrow0 = (isctx ? NL + b * C_ : b * S_) + q0;
  const int qw = q0 + wid * 32;
  int lat_first = 0, nlat = 0;
  if (!isctx) { if (SWA) { lat_first = 2 * qb - 2; if (lat_first < 0) lat_first = 0; int lat_last = 2 * qb + 3; if (lat_last > 63) lat_last = 63; nlat = lat_last - lat_first + 1; } else nlat = 64; }
  const int T = 4 + nlat;
  constexpr int NQ = MLA ? 6 : 4;
  bf16x8 qf[NQ];
  {
    const u16* qp = Qg + (size_t)(qrow0 + wid * 32 + r32) * ldq + qoff + hi * 8;
#pragma unroll
    for (int d0 = 0; d0 < NQ; ++d0) {
      const u32x4_t raw = *(const u32x4_t*)(qp + d0 * 16);
      u32x4_t sc;
#pragma unroll
      for (int i = 0; i < 4; ++i) sc[i] = cvtpk(bflo(raw[i]) * cs, bfhi(raw[i]) * cs);
      qf[d0] = __builtin_bit_cast(bf16x8, sc);
    }
  }
  int kaddr[4];
#pragma unroll
  for (int d0 = 0; d0 < 4; ++d0) kaddr[d0] = r32 * 128 + (((d0 * 2 + hi) ^ ((r32 >> 1) & 7)) * 16);
  int kraddr[2];
#pragma unroll
  for (int e = 0; e < 2; ++e) kraddr[e] = 16384 + r32 * 64 + (((e * 2 + hi) ^ ((r32 >> 3) & 3)) * 16);
  int vbo[2];
  {
    const int i16 = lane & 15, sw = (lane >> 3) & 1;
    const int x = ((lane >> 4) & 1) * 32 + (lane & 3) * 8;
    const int rowpart = ((i16 >> 2) + 4 * hi) * 128;
    vbo[0] = 8192 + rowpart + x + (sw * 64);
    vbo[1] = 8192 + rowpart + x + ((1 - sw) * 64);
  }
  const int skey = tid >> 3;
  const int kch = ((tid & 7) ^ ((tid >> 4) & 7)) * 8;
  const int vch = ((tid & 7) ^ (((tid >> 4) & 1) << 2)) * 8;
  const int rkey = tid >> 2, rch = ((tid & 3) ^ ((tid >> 5) & 3)) * 8;
  LAS char* ldst = lds + tid * 16;
#define AT_ISSUE(j, st) do { const int _j = (j); const int _kr = _j < 4 ? NL + b * C_ + 64 * _j : b * S_ + 64 * (lat_first + _j - 4); \
    LAS char* _d = ldst + (st) * AT_STAGE; \
    const u16* _k = Kg + (size_t)(_kr + skey) * ldk + koff + kch; glds16(_k, _d); glds16(_k + (size_t)32 * ldk, _d + 4096); \
    const u16* _v = Vg + (size_t)(_kr + skey) * ldk + koff + vch; glds16(_v, _d + 8192); glds16(_v + (size_t)32 * ldk, _d + 8192 + 4096); \
    if (MLA) glds16(Rg + (size_t)(_kr + rkey) * 32 + rch, _d + 16384); } while (0)
#define AT_QK(sb, P0, P1) do { \
    bf16x8 kk0[MLA ? 6 : 4], kk1[MLA ? 6 : 4]; \
    _Pragma("unroll") for (int d0 = 0; d0 < 4; ++d0) { kk0[d0] = *(const LAS bf16x8*)((sb) + kaddr[d0]); kk1[d0] = *(const LAS bf16x8*)((sb) + kaddr[d0] + 4096); } \
    if (MLA) { _Pragma("unroll") for (int e = 0; e < 2; ++e) { kk0[MLA ? 4 + e : 0] = *(const LAS bf16x8*)((sb) + kraddr[e]); kk1[MLA ? 4 + e : 0] = *(const LAS bf16x8*)((sb) + kraddr[e] + 2048); } } \
    __builtin_amdgcn_sched_barrier(0);     \
    P0 = __builtin_amdgcn_mfma_f32_32x32x16_bf16(kk0[0], qf[0], negm, 0, 0, 0); P1 = __builtin_amdgcn_mfma_f32_32x32x16_bf16(kk1[0], qf[0], negm, 0, 0, 0); \
    _Pragma("unroll") for (int d0 = 1; d0 < (MLA ? 6 : 4); ++d0) { \
      P0 = __builtin_amdgcn_mfma_f32_32x32x16_bf16(kk0[d0], qf[d0], P0, 0, 0, 0); P1 = __builtin_amdgcn_mfma_f32_32x32x16_bf16(kk1[d0], qf[d0], P1, 0, 0, 0); } \
  } while (0)
#define AT_WSTATE(jj, pos0v, st) do { st = 0; pos0v = 64 * (lat_first + (jj) - 4); if (SWA && (jj) >= 4) { \
      if (pos0v + 63 < qw - 128 || pos0v > qw + 31 + 128) st = 2; else if (qw + 31 - pos0v > 128 || pos0v + 63 - qw > 128) st = 1; } } while (0)
#define AT_SOFTMAX(P0, P1, PA, wst, pos0v, FIRST) do { \
    if (SWA && wst == 1) { const int dq = qw + r32 - pos0v - 4 * hi + 128; \
      _Pragma("unroll") for (int r = 0; r < 16; ++r) { const int cr = (r & 3) + 8 * (r >> 2); \
        if ((unsigned)(dq - cr) > 256u) P0[r] = -1e30f; if ((unsigned)(dq - cr - 32) > 256u) P1[r] = -1e30f; } } \
    asm volatile("s_nop 15\n\ts_nop 15" : "+v"(P0), "+v"(P1));     \
    float mx = max3f(P0[0], P0[1], P1[0]); mx = max3f(mx, P1[1], P0[2]); \
    _Pragma("unroll") for (int r = 3; r < 16; r += 2) { mx = max3f(mx, P0[r], P0[(r + 1) & 15]); } \
    _Pragma("unroll") for (int r = 2; r < 16; r += 2) { mx = max3f(mx, P1[r], P1[r + 1]); } \
    mx = half_max(mx); \
    if ((FIRST) || __ballot(mx > 8.0f) != 0ull) { \
      const float delta = (FIRST) ? mx : fmaxf(mx, 0.f); \
      const float al = __builtin_amdgcn_exp2f(-delta); \
      m_run += delta; \
      _Pragma("unroll") for (int i = 0; i < 16; ++i) { o[0][i] *= al; o[1][i] *= al; P0[i] -= delta; P1[i] -= delta; negm[i] = -m_run; } \
      osum[0] *= al; \
    } \
    _Pragma("unroll") for (int r = 0; r < 16; ++r) { P0[r] = __builtin_amdgcn_exp2f(P0[r]); P1[r] = __builtin_amdgcn_exp2f(P1[r]); } \
    PA[0] = pack8(P0, 0); PA[1] = pack8(P0, 8); PA[2] = pack8(P1, 0); PA[3] = pack8(P1, 8); \
  } while (0)
#define AT_PV(sb, PA) do { \
    bf16x8 vf[2][4]; \
    _Pragma("unroll") for (int db = 0; db < 2; ++db) { _Pragma("unroll") for (int ts = 0; ts < 4; ++ts) { \
      const LAS char* va = (sb) + vbo[db] + ts * 2048; const s16x4 lo = tr_read(va), hh = tr_read(va + 1024); \
      vf[db][ts] = __builtin_shufflevector(lo, hh, 0, 1, 2, 3, 4, 5, 6, 7); } } \
    __builtin_amdgcn_sched_barrier(0);     \
    _Pragma("unroll") for (int ts = 0; ts < 4; ++ts) osum = __builtin_amdgcn_mfma_f32_32x32x16_bf16(ones, PA[ts], osum, 0, 0, 0); \
    _Pragma("unroll") for (int db = 0; db < 2; ++db) { _Pragma("unroll") for (int ts = 0; ts < 4; ++ts) \
      o[db] = __builtin_amdgcn_mfma_f32_32x32x16_bf16(vf[db][ts], PA[ts], o[db], 0, 0, 0); } } while (0)

  float m_run = SWA ? p.swa_sink[layer * 6 + h] * 1.4426950408889634f : 0.f;
  f32x16 o[2], osum, negm;
#pragma unroll
  for (int i = 0; i < 16; ++i) { o[0][i] = 0.f; o[1][i] = 0.f; osum[i] = SWA ? 1.f : 0.f; negm[i] = -m_run; }
  bf16x8 ones;
#pragma unroll
  for (int i = 0; i < 8; ++i) ones[i] = (short)0x3F80;
  bf16x8 pa[4];
  f32x16 s0, s1;
  AT_ISSUE(0, 0);
  asm volatile("s_waitcnt vmcnt(0)" ::: "memory");
  __syncthreads();
  AT_ISSUE(1, 1);
  AT_QK(lds, s0, s1);
  { int wst = 0, pos0v = 0; AT_SOFTMAX(s0, s1, pa, wst, pos0v, !SWA); }
  bool cur_skip = false;
#pragma unroll 1
  for (int j = 0; j < T - 1; ++j) {
    asm volatile("s_waitcnt vmcnt(0)" ::: "memory");
    __syncthreads();
    const int st_cur = j % 3, st_nxt = (j + 1) % 3;
    if (j + 2 < T) AT_ISSUE(j + 2, (j + 2) % 3);
    const LAS char* sbn = lds + st_nxt * AT_STAGE;
    const LAS char* sbc = lds + st_cur * AT_STAGE;
    int wst, pos0v; AT_WSTATE(j + 1, pos0v, wst);
    if (!SWA || wst != 2) AT_QK(sbn, s0, s1);
    if (!SWA || !cur_skip) AT_PV(sbc, pa);
    if (!SWA || wst != 2) {
      bf16x8 pn[4];
      AT_SOFTMAX(s0, s1, pn, wst, pos0v, false);
      pa[0] = pn[0]; pa[1] = pn[1]; pa[2] = pn[2]; pa[3] = pn[3];
      cur_skip = false;
    } else cur_skip = true;
  }
  if (!SWA || !cur_skip) { const LAS char* sbc = lds + ((T - 1) % 3) * AT_STAGE; AT_PV(sbc, pa); }
#undef AT_ISSUE
#undef AT_QK
#undef AT_WSTATE
#undef AT_SOFTMAX
#undef AT_PV
  const float inv = 1.f / osum[0];
  u16* yp = (u16*)(ws + OFF_Y) + (size_t)(qrow0 + wid * 32 + r32) * 1024 + ycol + 4 * hi;
#pragma unroll
  for (int db = 0; db < 2; ++db)
#pragma unroll
    for (int g = 0; g < 4; ++g) {
      uint2 w; w.x = cvtpk(o[db][4 * g] * inv, o[db][4 * g + 1] * inv); w.y = cvtpk(o[db][4 * g + 2] * inv, o[db][4 * g + 3] * inv);
      *(uint2*)(yp + db * 32 + 8 * g) = w;
    }
  __syncthreads();
}


typedef float f32x4v __attribute__((ext_vector_type(4)));
#define MFMA16(a, b, c) __builtin_amdgcn_mfma_f32_16x16x32_bf16((a), (b), (c), 0, 0, 0)
DI float quad_max_x(float m) {
  { auto rr = __builtin_amdgcn_permlane16_swap(__float_as_uint(m), __float_as_uint(m), false, false); m = fmaxf(__uint_as_float(rr[0]), __uint_as_float(rr[1])); }
  { auto rr = __builtin_amdgcn_permlane32_swap(__float_as_uint(m), __float_as_uint(m), false, false); m = fmaxf(__uint_as_float(rr[0]), __uint_as_float(rr[1])); }
  return m;
}
template <bool MLA, bool SWA>
DI void attn_unit16(const Params& p, int layer, int isctx, int b, int h, int qb, LAS char* lds) {
  char* ws = p.ws;
  const int tid = opaque((int)threadIdx.x), lane = tid & 63, wid = tid >> 6, c16 = lane & 15, g = lane >> 4;
  const u16 *Qg, *Kg, *Vg; int ldq, ldk, qoff, koff, ycol; float cs;
  if (MLA) { Qg = (const u16*)(ws + OFF_MLQ); Kg = (const u16*)(ws + OFF_MLK); Vg = (const u16*)(ws + OFF_MLV); ldq = 384; ldk = 256; qoff = h * 96; koff = h * 64; ycol = 768 + h * 64; cs = 0.10206207261596575f * 1.4426950408889634f; }
  else if (!SWA) { Qg = (const u16*)(ws + OFF_GLQ); Kg = (const u16*)(ws + OFF_GLK); Vg = (const u16*)(ws + OFF_GLV); ldq = 384; ldk = 128; qoff = h * 64; koff = (h / 3) * 64; ycol = 384 + h * 64; cs = 0.125f * 1.4426950408889634f; }
  else { Qg = (const u16*)(ws + OFF_SWQ); Kg = (const u16*)(ws + OFF_SWK); Vg = (const u16*)(ws + OFF_SWV); ldq = 384; ldk = 128; qoff = h * 64; koff = (h / 3) * 64; ycol = h * 64; cs = 0.125f * 1.4426950408889634f; }
  const u16* Rg = (const u16*)(ws + OFF_MLKR);
  const int q0 = qb * 256;
  const int qrow0 = (isctx ? NL + b * C_ : b * S_) + q0;
  const int qw = q0 + wid * 32;
  int lat_first = 0, nlat = 0;
  if (!isctx) { if (SWA) { lat_first = 4 * qb - 2; if (lat_first < 0) lat_first = 0; int lat_last = 4 * qb + 5; if (lat_last > 63) lat_last = 63; nlat = lat_last - lat_first + 1; } else nlat = 64; }
  const int T = 4 + nlat;
  constexpr int NS = MLA ? 3 : 2;
  bf16x8 qf[2][NS];
#pragma unroll
  for (int bq = 0; bq < 2; ++bq) {
    const u16* qp = Qg + (size_t)(qrow0 + wid * 32 + bq * 16 + c16) * ldq + qoff + g * 8;
#pragma unroll
    for (int s = 0; s < NS; ++s) {
      const u32x4_t raw = *(const u32x4_t*)(qp + s * 32);
      u32x4_t sc;
#pragma unroll
      for (int i = 0; i < 4; ++i) sc[i] = cvtpk(bflo(raw[i]) * cs, bfhi(raw[i]) * cs);
      qf[bq][s] = __builtin_bit_cast(bf16x8, sc);
    }
  }
  int kaddr[2];
#pragma unroll
  for (int s = 0; s < 2; ++s) kaddr[s] = c16 * 128 + (((4 * s + g) ^ ((c16 >> 1) & 7)) * 16);
  const int kraddr = 16384 + c16 * 64 + ((g ^ ((0 - (c16 >> 2)) & 3)) * 16);
  int vbo[4];
#pragma unroll
  for (int d = 0; d < 4; ++d) vbo[d] = 8192 + (4 * g + (c16 >> 2)) * 128 + ((d ^ ((lane >> 3) & 3)) * 32) + (lane & 3) * 8;
  const int skey = tid >> 3;
  const int kch = ((tid & 7) ^ ((tid >> 4) & 7)) * 8;
  const int vch = ((tid & 7) ^ (((tid >> 4) & 3) << 1)) * 8;
  const int rkey = tid >> 2, rch = ((tid & 3) ^ ((0 - (tid >> 4)) & 3)) * 8;
  LAS char* ldst = lds + tid * 16;
#define A6_ISSUE(j, st) do { const int _j = (j); const int _kr = _j < 4 ? NL + b * C_ + 64 * _j : b * S_ + 64 * (lat_first + _j - 4); \
    LAS char* _d = ldst + (st) * AT_STAGE; \
    glds16(Kg + (size_t)(_kr + skey) * ldk + koff + kch, _d); \
    glds16(Vg + (size_t)(_kr + skey) * ldk + koff + vch, _d + 8192); \
    if (MLA && tid < 256) glds16(Rg + (size_t)(_kr + rkey) * 32 + rch, _d + 16384); } while (0)
#define A6_QK(sb) do { \
    bf16x8 kk[4][NS]; \
    _Pragma("unroll") for (int a = 0; a < 4; ++a) { kk[a][0] = *(const LAS bf16x8*)((sb) + kaddr[0] + a * 2048); kk[a][1] = *(const LAS bf16x8*)((sb) + kaddr[1] + a * 2048); \
      if (MLA) kk[a][MLA ? 2 : 0] = *(const LAS bf16x8*)((sb) + kraddr + a * 1024); } \
    __builtin_amdgcn_sched_barrier(0); \
    _Pragma("unroll") for (int a = 0; a < 4; ++a) { _Pragma("unroll") for (int bq = 0; bq < 2; ++bq) { \
      S[a][bq] = MFMA16(kk[a][0], qf[bq][0], negm[bq]); \
      _Pragma("unroll") for (int s = 1; s < NS; ++s) S[a][bq] = MFMA16(kk[a][s], qf[bq][s], S[a][bq]); } } \
  } while (0)
#define A6_WSTATE(jj, pos0v, st) do { st = 0; pos0v = 64 * (lat_first + (jj) - 4); if (SWA && (jj) >= 4) { \
      if (pos0v + 63 < qw - 128 || pos0v > qw + 31 + 128) st = 2; else if (qw + 31 - pos0v > 128 || pos0v + 63 - qw > 128) st = 1; } } while (0)
#define A6_SOFTMAX(PA, wst, pos0v, FIRST, CHECK) do { \
    if (SWA && wst == 1) { _Pragma("unroll") for (int bq = 0; bq < 2; ++bq) { const int dq = qw + 16 * bq + c16 - pos0v - 4 * g + 128; \
      _Pragma("unroll") for (int a = 0; a < 4; ++a) { _Pragma("unroll") for (int r = 0; r < 4; ++r) { if ((unsigned)(dq - (16 * a + r)) > 256u) S[a][bq][r] = -1e30f; } } } } \
    float mx[2] = {0.f, 0.f}; \
    if (CHECK) { \
    asm volatile("s_nop 15\n\ts_nop 15" : "+v"(S[0][0]), "+v"(S[0][1]), "+v"(S[1][0]), "+v"(S[1][1]), "+v"(S[2][0]), "+v"(S[2][1]), "+v"(S[3][0]), "+v"(S[3][1])); \
    _Pragma("unroll") for (int bq = 0; bq < 2; ++bq) { \
      float m_ = max3f(S[0][bq][0], S[0][bq][1], S[0][bq][2]); m_ = max3f(m_, S[0][bq][3], S[1][bq][0]); \
      m_ = max3f(m_, S[1][bq][1], S[1][bq][2]); m_ = max3f(m_, S[1][bq][3], S[2][bq][0]); m_ = max3f(m_, S[2][bq][1], S[2][bq][2]); \
      m_ = max3f(m_, S[2][bq][3], S[3][bq][0]); m_ = max3f(m_, S[3][bq][1], S[3][bq][2]); m_ = fmaxf(m_, S[3][bq][3]); \
      mx[bq] = quad_max_x(m_); } } \
    if ((FIRST) || ((CHECK) && __ballot(fmaxf(mx[0], mx[1]) > 8.0f) != 0ull)) { \
      _Pragma("unroll") for (int bq = 0; bq < 2; ++bq) { \
        const float delta = (FIRST) ? mx[bq] : fmaxf(mx[bq], 0.f); \
        const float al = __builtin_amdgcn_exp2f(-delta); \
        m_run[bq] += delta; \
        _Pragma("unroll") for (int a = 0; a < 4; ++a) { S[a][bq] = S[a][bq] - delta; o[a][bq] = o[a][bq] * al; } \
        negm[bq] = (f32x4v){-m_run[bq], -m_run[bq], -m_run[bq], -m_run[bq]}; \
        osum[bq] = osum[bq] * al; } \
    } \
    _Pragma("unroll") for (int a = 0; a < 4; ++a) { _Pragma("unroll") for (int bq = 0; bq < 2; ++bq) { _Pragma("unroll") for (int r = 0; r < 4; ++r) S[a][bq][r] = __builtin_amdgcn_exp2f(S[a][bq][r]); } } \
    _Pragma("unroll") for (int ks = 0; ks < 2; ++ks) { _Pragma("unroll") for (int bq = 0; bq < 2; ++bq) { u32x4_t w_; \
      w_[0] = cvtpk(S[2 * ks][bq][0], S[2 * ks][bq][1]); w_[1] = cvtpk(S[2 * ks][bq][2], S[2 * ks][bq][3]); \
      w_[2] = cvtpk(S[2 * ks + 1][bq][0], S[2 * ks + 1][bq][1]); w_[3] = cvtpk(S[2 * ks + 1][bq][2], S[2 * ks + 1][bq][3]); \
      PA[ks][bq] = __builtin_bit_cast(bf16x8, w_); } } \
  } while (0)
#define A6_PV(sb, PA) do { \
    bf16x8 vf[2][4]; \
    _Pragma("unroll") for (int ks = 0; ks < 2; ++ks) { _Pragma("unroll") for (int d = 0; d < 4; ++d) { \
      const LAS char* va = (sb) + vbo[d] + ks * 4096; const s16x4 lo = tr_read(va), hh = tr_read(va + 2048); \
      vf[ks][d] = __builtin_shufflevector(lo, hh, 0, 1, 2, 3, 4, 5, 6, 7); } } \
    __builtin_amdgcn_sched_barrier(0); \
    _Pragma("unroll") for (int ks = 0; ks < 2; ++ks) { _Pragma("unroll") for (int bq = 0; bq < 2; ++bq) osum[bq] = MFMA16(ones, PA[ks][bq], osum[bq]); } \
    _Pragma("unroll") for (int d = 0; d < 4; ++d) { _Pragma("unroll") for (int bq = 0; bq < 2; ++bq) { _Pragma("unroll") for (int ks = 0; ks < 2; ++ks) \
      o[d][bq] = MFMA16(vf[ks][d], PA[ks][bq], o[d][bq]); } } } while (0)

  float m_run[2];
  m_run[0] = m_run[1] = SWA ? p.swa_sink[layer * 6 + h] * 1.4426950408889634f : 0.f;
  f32x4v S[4][2], o[4][2], osum[2], negm[2];
#pragma unroll
  for (int bq = 0; bq < 2; ++bq) {
    const float i1 = SWA ? 1.f : 0.f;
    osum[bq] = (f32x4v){i1, i1, i1, i1}; negm[bq] = (f32x4v){-m_run[bq], -m_run[bq], -m_run[bq], -m_run[bq]};
#pragma unroll
    for (int d = 0; d < 4; ++d) o[d][bq] = (f32x4v){0.f, 0.f, 0.f, 0.f};
  }
  bf16x8 ones;
#pragma unroll
  for (int i = 0; i < 8; ++i) ones[i] = (short)0x3F80;
  bf16x8 pa[2][2];
  A6_ISSUE(0, 0); A6_ISSUE(1, 1); A6_ISSUE(2, 2);
  asm volatile("s_waitcnt vmcnt(0)" ::: "memory");
  __syncthreads();
  A6_ISSUE(3, 3); if (4 < T) A6_ISSUE(4, 4);
  A6_QK(lds);
  { int wst = 0, pos0v = 0; A6_SOFTMAX(pa, wst, pos0v, !SWA, true); }
  bool cur_skip = false;
#pragma unroll 1
  for (int j = 0; j < T - 1; ++j) {
    if (j > 0 && (j & 1) == 0) {
      asm volatile("s_waitcnt vmcnt(0)" ::: "memory");
      __syncthreads();
      if (j + 3 < T) A6_ISSUE(j + 3, (j + 3) % 5);
      if (j + 4 < T) A6_ISSUE(j + 4, (j + 4) % 5);
    }
    const LAS char* sbn = lds + ((j + 1) % 5) * AT_STAGE;
    const LAS char* sbc = lds + (j % 5) * AT_STAGE;
    int wst, pos0v; A6_WSTATE(j + 1, pos0v, wst);
    if (!SWA || wst != 2) A6_QK(sbn);
    if (!SWA || !cur_skip) A6_PV(sbc, pa);
    if (!SWA || wst != 2) {
      bf16x8 pn[2][2];
      A6_SOFTMAX(pn, wst, pos0v, false, (SWA || (j & 7) == 7));
      pa[0][0] = pn[0][0]; pa[0][1] = pn[0][1]; pa[1][0] = pn[1][0]; pa[1][1] = pn[1][1];
      cur_skip = false;
    } else cur_skip = true;
  }
  if (!SWA || !cur_skip) { const LAS char* sbc = lds + ((T - 1) % 5) * AT_STAGE; A6_PV(sbc, pa); }
#undef A6_ISSUE
#undef A6_QK
#undef A6_WSTATE
#undef A6_SOFTMAX
#undef A6_PV
#pragma unroll
  for (int bq = 0; bq < 2; ++bq) {
    const float inv = 1.f / osum[bq][0];
    u16* yp = (u16*)(ws + OFF_Y) + (size_t)(qrow0 + wid * 32 + bq * 16 + c16) * 1024 + ycol + 4 * g;
#pragma unroll
    for (int d = 0; d < 4; ++d) {
      u32x2_t w; w[0] = cvtpk(o[d][bq][0] * inv, o[d][bq][1] * inv); w[1] = cvtpk(o[d][bq][2] * inv, o[d][bq][3] * inv);
      *(u32x2_t*)(yp + d * 16) = w;
    }
  }
  __syncthreads();
}

DI void p3_attention(const Params& p, int layer, LAS char* lds, int cs = 0) {
  unsigned* ctr8 = (unsigned*)(p.ws + OFF_CTRL) + CW_Q + (layer * 2 + 0) * 512;
  const int per_q = 256 + (layer == 0 ? 16 : 0);
  for (;;) {
    const int u = next_unit_xcd(ctr8, per_q, lds);
    if (u < 0) break;
    const int b = u / per_q, v = u % per_q;
    if (v < 64) { attn_unit16<true, false>(p, layer, 0, b, v >> 4, v & 15, lds); }
    else if (v < 160) { const int w = v - 64; attn_unit16<false, false>(p, layer, 0, b, w >> 4, w & 15, lds); }
    else if (v < 256) { const int w = v - 160; attn_unit16<false, true>(p, layer, 0, b, w >> 4, w & 15, lds); }
    else {
      const int w = v - 256;
      if (w < 4) attn_unit16<true, false>(p, layer, 1, b, w, 0, lds);
      else if (w < 10) attn_unit16<false, false>(p, layer, 1, b, w - 4, 0, lds);
      else attn_unit16<false, true>(p, layer, 1, b, w - 10, 0, lds);
    }
  }
}

struct AttnArgs {
  const u16* Q; const u16* K; const u16* K2; const u16* V; u16* Y; const float* sink;
  int ldq, ldk, ldk2, ldv, ldy, ycol, G, window, q_is_ctx; float scale;
};
static_assert(sizeof(AttnArgs) == 88, "no padding");
template <int DK1, int DK2>
__global__ __launch_bounds__(64) void k_attn(AttnArgs a) {
  const int qt = blockIdx.x * 64 + threadIdx.x, b = blockIdx.y, h = blockIdx.z, kvh = h / a.G;
  const int qrow = a.q_is_ctx ? NL + b * C_ + qt : b * S_ + qt;
  float q[DK1 + DK2];
  {
    const uint4* qp = (const uint4*)(a.Q + (size_t)qrow * a.ldq + h * (DK1 + DK2));
#pragma unroll
    for (int i = 0; i < (DK1 + DK2) / 8; ++i) {
      uint4 u = qp[i];
      q[i * 8 + 0] = bflo(u.x) * a.scale; q[i * 8 + 1] = bfhi(u.x) * a.scale; q[i * 8 + 2] = bflo(u.y) * a.scale; q[i * 8 + 3] = bfhi(u.y) * a.scale;
      q[i * 8 + 4] = bflo(u.z) * a.scale; q[i * 8 + 5] = bfhi(u.z) * a.scale; q[i * 8 + 6] = bflo(u.w) * a.scale; q[i * 8 + 7] = bfhi(u.w) * a.scale;
    }
  }
  float m, l, o[64];
  if (a.sink) { m = a.sink[h]; l = 1.f; } else { m = -1e30f; l = 0.f; }
#pragma unroll
  for (int d = 0; d < 64; ++d) o[d] = 0.f;
  const int nseg = a.q_is_ctx ? 1 : 2;
  for (int seg = 0; seg < nseg; ++seg) {
    int lo, hi, rbase; bool masked = false;
    if (seg == 0) { lo = 0; hi = C_; rbase = NL + b * C_; }
    else {
      lo = 0; hi = S_; rbase = b * S_;
      if (a.window) { int t0 = blockIdx.x * 64; lo = t0 - a.window; if (lo < 0) lo = 0; hi = t0 + 64 + a.window; if (hi > S_) hi = S_; masked = true; }
    }
    for (int s = lo; s < hi; s += 4) {
      float sc[4];
#pragma unroll
      for (int i = 0; i < 4; ++i) {
        const uint4* kp = (const uint4*)(a.K + (size_t)(rbase + s + i) * a.ldk + kvh * DK1);
        float dot = 0.f;
#pragma unroll
        for (int c = 0; c < DK1 / 8; ++c) {
          uint4 u = kp[c];
          dot += q[c * 8 + 0] * bflo(u.x) + q[c * 8 + 1] * bfhi(u.x) + q[c * 8 + 2] * bflo(u.y) + q[c * 8 + 3] * bfhi(u.y)
               + q[c * 8 + 4] * bflo(u.z) + q[c * 8 + 5] * bfhi(u.z) + q[c * 8 + 6] * bflo(u.w) + q[c * 8 + 7] * bfhi(u.w);
        }
        if (DK2 > 0) {
          const uint4* kp2 = (const uint4*)(a.K2 + (size_t)(rbase + s + i) * a.ldk2);
#pragma unroll
          for (int c = 0; c < DK2 / 8; ++c) {
            uint4 u = kp2[c];
            dot += q[DK1 + c * 8 + 0] * bflo(u.x) + q[DK1 + c * 8 + 1] * bfhi(u.x) + q[DK1 + c * 8 + 2] * bflo(u.y) + q[DK1 + c * 8 + 3] * bfhi(u.y)
                 + q[DK1 + c * 8 + 4] * bflo(u.z) + q[DK1 + c * 8 + 5] * bfhi(u.z) + q[DK1 + c * 8 + 6] * bflo(u.w) + q[DK1 + c * 8 + 7] * bfhi(u.w);
          }
        }
        if (masked) { int dlt = qt - (s + i); if (dlt < 0) dlt = -dlt; if (dlt > a.window) dot = -1e30f; }
        sc[i] = dot;
      }
      float mx = fmaxf(fmaxf(fmaxf(sc[0], sc[1]), fmaxf(sc[2], sc[3])), m);
      const float alpha = __expf(m - mx);
      float pr[4];
#pragma unroll
      for (int i = 0; i < 4; ++i) pr[i] = __expf(sc[i] - mx);
      l = l * alpha + (pr[0] + pr[1]) + (pr[2] + pr[3]);
      m = mx;
#pragma unroll
      for (int d = 0; d < 64; ++d) o[d] *= alpha;
#pragma unroll
      for (int i = 0; i < 4; ++i) {
        const uint4* vp = (const uint4*)(a.V + (size_t)(rbase + s + i) * a.ldv + kvh * 64);
#pragma unroll
        for (int c = 0; c < 8; ++c) {
          uint4 u = vp[c];
          o[c * 8 + 0] += pr[i] * bflo(u.x); o[c * 8 + 1] += pr[i] * bfhi(u.x); o[c * 8 + 2] += pr[i] * bflo(u.y); o[c * 8 + 3] += pr[i] * bfhi(u.y);
          o[c * 8 + 4] += pr[i] * bflo(u.z); o[c * 8 + 5] += pr[i] * bfhi(u.z); o[c * 8 + 6] += pr[i] * bflo(u.w); o[c * 8 + 7] += pr[i] * bfhi(u.w);
        }
      }
    }
  }
  const float inv = 1.f / l;
  uint4* yp = (uint4*)(a.Y + (size_t)qrow * a.ldy + a.ycol + h * 64);
#pragma unroll
  for (int c = 0; c < 8; ++c) {
    uint4 u;
    u.x = cvtpk(o[c * 8 + 0] * inv, o[c * 8 + 1] * inv); u.y = cvtpk(o[c * 8 + 2] * inv, o[c * 8 + 3] * inv);
    u.z = cvtpk(o[c * 8 + 4] * inv, o[c * 8 + 5] * inv); u.w = cvtpk(o[c * 8 + 6] * inv, o[c * 8 + 7] * inv);
    yp[c] = u;
  }
}


constexpr int CW_BAR = 1024;
#define XB_TMO      128
#define XB_XCNT(j)  (256  + 64 * (j))
#define XB_XSUB(j)  (1280 + 64 * (j))
#define XB_XGEN(j)  (2304 + 64 * (j))
#define XB_TOP      3328
#define XB_TOPGEN   3392
#define XCD_BAR_WORDS 3456
#define XB_SPIN_CAP (1u << 22)
DI unsigned xb_ld(unsigned* p) { return __hip_atomic_load(p, __ATOMIC_RELAXED, __HIP_MEMORY_SCOPE_AGENT); }
DI unsigned xb_add(unsigned* p, unsigned v) { return __hip_atomic_fetch_add(p, v, __ATOMIC_RELAXED, __HIP_MEMORY_SCOPE_AGENT); }
DI unsigned xb_xcc_id() { return (unsigned)__builtin_amdgcn_s_getreg((3 << 11) | 20) & 0xFu; }
#define XB_SPIN(cond, bar) do { unsigned _sp = 0; while (cond) { __builtin_amdgcn_s_sleep(1); \
    if ((++_sp & 255u) == 0u) { if (xb_ld(&(bar)[XB_TMO])) break; if (_sp > XB_SPIN_CAP) { atomicAdd(&(bar)[XB_TMO], 1u); break; } } } } while (0)
struct XcdBarrier { unsigned* bar; unsigned x; volatile LAS unsigned* st; };
DI XcdBarrier xcd_barrier_post(unsigned* bar, volatile LAS unsigned* st) {
  XcdBarrier b; b.bar = bar; b.x = xb_xcc_id(); b.st = st;
  if (threadIdx.x == 0) (void)xb_add(&bar[XB_XCNT(b.x)], 1u);
  return b;
}
DI void xcd_barrier_complete(unsigned* bar, unsigned x, unsigned& nloc, unsigned& nx) {
  const unsigned G = gridDim.x * gridDim.y * gridDim.z;
  unsigned sum, cnt, mine, sp = 0u;
  for (;;) {
    sum = 0u; cnt = 0u; mine = 0u;
#pragma unroll
    for (unsigned j = 0; j < 16; ++j) { const unsigned c = xb_ld(&bar[XB_XCNT(j)]); sum += c; cnt += (c > 0u) ? 1u : 0u; mine = (j == x) ? c : mine; }
    if (sum == G) break;
    __builtin_amdgcn_s_sleep(1);
    if ((++sp & 255u) == 0u) { if (xb_ld(&bar[XB_TMO])) break; if (sp > XB_SPIN_CAP) { atomicAdd(&bar[XB_TMO], 1u); break; } }
  }
  nloc = mine > 0u ? mine : 1u; nx = cnt > 0u ? cnt : 1u;
}
DI void xcd_barrier(const XcdBarrier& b) {
  asm volatile("s_waitcnt vmcnt(0)" ::: "memory");
  __syncthreads();
  if (threadIdx.x == 0) {
    unsigned* bar = b.bar;
    __builtin_amdgcn_s_waitcnt(0);
    unsigned nloc = b.st[0], nx = b.st[1];
    if (nloc == 0u) { xcd_barrier_complete(bar, b.x, nloc, nx); b.st[0] = nloc; b.st[1] = nx; }
    const unsigned old = xb_add(&bar[XB_XSUB(b.x)], 1u);
    const unsigned gen = old / nloc;
    if (old + 1u == (gen + 1u) * nloc) {
      __builtin_amdgcn_fence(__ATOMIC_RELEASE, "agent");
      asm volatile("s_waitcnt vmcnt(0)" ::: "memory");
      const unsigned og = xb_add(&bar[XB_TOP], 1u);
      const unsigned tg = og / nx;
      if (og + 1u == (tg + 1u) * nx) xb_add(&bar[XB_TOPGEN], 1u);
      else XB_SPIN(xb_ld(&bar[XB_TOPGEN]) == tg, bar);
      __builtin_amdgcn_fence(__ATOMIC_ACQUIRE, "agent");
      xb_add(&bar[XB_XGEN(b.x)], 1u);
      asm volatile("s_waitcnt vmcnt(0)" ::: "memory");
    } else {
      XB_SPIN(xb_ld(&bar[XB_XGEN(b.x)]) == gen, bar);
      __builtin_amdgcn_fence(__ATOMIC_ACQUIRE, "agent");
      asm volatile("s_waitcnt vmcnt(0)" ::: "memory");
    }
  }
  __syncthreads();
}

__global__ __launch_bounds__(NTHR, 1) void k_mega(Params p) {
  extern __shared__ __attribute__((aligned(16))) unsigned char smem[];
  LAS char* lds = (LAS char*)smem;
  if (p.never) cooperative_groups::this_grid().sync();
  volatile LAS unsigned* st = (volatile LAS unsigned*)(lds + LDS_RMISC + 64);
  if (threadIdx.x < 4) st[threadIdx.x] = 0u;
  __syncthreads();
  XcdBarrier bar = xcd_barrier_post((unsigned*)(p.ws + OFF_CTRL) + CW_BAR, st);
#ifdef PROBE_SEG
  volatile LAS unsigned long long* pt = (volatile LAS unsigned long long*)(lds + LDS_RMISC + 256);
  if (threadIdx.x == 0) { pt[0] = 0ull; pt[1] = 0ull; }
#define SEG_BEGIN(id) do { if ((id) == PROBE_SEG && blockIdx.x == 0 && opaque((int)threadIdx.x) == 0) pt[0] = __builtin_amdgcn_s_memrealtime(); } while (0)
#define SEG_END(id) do { if ((id) == PROBE_SEG && blockIdx.x == 0 && opaque((int)threadIdx.x) == 0) pt[1] = pt[1] + (__builtin_amdgcn_s_memrealtime() - pt[0]); } while (0)
#else
#define SEG_BEGIN(id) do {} while (0)
#define SEG_END(id) do {} while (0)
#endif
  SEG_BEGIN(0); p0_prologue(p, lds); xcd_barrier(bar); SEG_END(0);
  SEG_BEGIN(1); p1_norm_mix(p, 0); xcd_barrier(bar); SEG_END(1);
#pragma unroll 1
  for (int l = 0; l < 2; ++l) {
    const int nrows = l == 0 ? NT : NL;
    SEG_BEGIN(2 + 10 * l); p2_inproj(p, l, lds); xcd_barrier(bar); SEG_END(2 + 10 * l);
    SEG_BEGIN(3 + 10 * l); p3_attention(p, l, lds); xcd_barrier(bar); SEG_END(3 + 10 * l);
    SEG_BEGIN(4 + 10 * l); p4_outproj8(p, l, nrows, lds); xcd_barrier(bar); SEG_END(4 + 10 * l);
    SEG_BEGIN(5 + 10 * l); p5_norm_ffn(p, l, nrows, lds); xcd_barrier(bar); SEG_END(5 + 10 * l);
    SEG_BEGIN(6 + 10 * l); p6_gateup8(p, l, nrows, lds); xcd_barrier(bar); SEG_END(6 + 10 * l);
    SEG_BEGIN(7 + 10 * l); p7_down8(p, l, nrows, lds); xcd_barrier(bar); SEG_END(7 + 10 * l);
    SEG_BEGIN(8 + 10 * l); p8_combine(p, l, nrows); if (l == 0) xcd_barrier(bar); SEG_END(8 + 10 * l);
  }
#ifdef PROBE_SEG
  if (blockIdx.x == 0 && opaque((int)threadIdx.x) == 0) {
    const unsigned long long t0 = __builtin_amdgcn_s_memrealtime(), t_acc = pt[1];
    while (__builtin_amdgcn_s_memrealtime() - t0 < 9ull * t_acc) __builtin_amdgcn_s_sleep(8);
  }
#endif
}

extern "C" void kernel_launch(void* const* d_in, const int* in_sizes, int n_in, void* d_out, int out_size, void* d_ws, size_t ws_size, hipStream_t stream) {
  Params p{};
  p.x = (const float*)d_in[0]; p.c = (const float*)d_in[1]; p.ctx = (const float*)d_in[2]; p.c_ctx = (const float*)d_in[3];
  p.w_mod = (const float*)d_in[4]; p.b_mod = (const float*)d_in[5]; p.norm_mix_g = (const float*)d_in[6]; p.norm_ffn_g = (const float*)d_in[7];
  p.w_in = (const float*)d_in[8]; p.w_out = (const float*)d_in[9]; p.swa_sink = (const float*)d_in[10]; p.glb_q_gain = (const float*)d_in[11];
  p.glb_k_gain = (const float*)d_in[12]; p.mla_q_gain = (const float*)d_in[13]; p.mla_w_uq = (const float*)d_in[14]; p.mla_kv_gain = (const float*)d_in[15];
  p.mla_w_ukv = (const float*)d_in[16]; p.router_w = (const float*)d_in[17]; p.router_bias = (const float*)d_in[18]; p.exp_w_gate = (const float*)d_in[19];
  p.exp_w_up = (const float*)d_in[20]; p.exp_w_down = (const float*)d_in[21]; p.shr_w_gate = (const float*)d_in[22]; p.shr_w_up = (const float*)d_in[23];
  p.shr_w_down = (const float*)d_in[24]; p.final_norm_g = (const float*)d_in[25];
  p.out = (float*)d_out; p.ws = (char*)d_ws;
  char* ws = (char*)d_ws;

#ifndef MEGA
#define MEGA 1
#endif
#if MEGA
  static int grid_blocks = 0;
  if (!grid_blocks) {
    (void)hipFuncSetAttribute((const void*)k_mega, hipFuncAttributeMaxDynamicSharedMemorySize, LDS_BYTES);
    int dev = 0, cus = 0, per_cu = 0;
    (void)hipGetDevice(&dev);
    (void)hipDeviceGetAttribute(&cus, hipDeviceAttributeMultiprocessorCount, dev);
    (void)hipOccupancyMaxActiveBlocksPerMultiprocessor(&per_cu, (const void*)k_mega, NTHR, LDS_BYTES);
    if (per_cu > 1) per_cu = 1;
    if (per_cu < 1) per_cu = 1;
    grid_blocks = cus * per_cu;
  }
  (void)hipMemsetAsync(ws + OFF_CTRL, 0, CTRL_BYTES, stream);
  void* args[] = {&p};
  hipError_t e = hipLaunchCooperativeKernel((const void*)k_mega, dim3(grid_blocks), dim3(NTHR), args, LDS_BYTES, stream);
  if (e != hipSuccess) fprintf(stderr, "cooperative launch failed: %s (grid %d)\n", hipGetErrorString(e), grid_blocks);
#endif
}
```

```cpp
#include <hip/hip_runtime.h>
#include <hip/hip_cooperative_groups.h>
#include <cstdio>
#include <stdint.h>
#include <stddef.h>

typedef unsigned short u16;
typedef short bf16x8 __attribute__((ext_vector_type(8)));
typedef float f32x4 __attribute__((ext_vector_type(4)));
typedef float f32x2_t __attribute__((ext_vector_type(2)));
typedef __bf16 bf16x2_t __attribute__((ext_vector_type(2)));
typedef unsigned u32x2_t __attribute__((ext_vector_type(2)));
typedef unsigned u32x4_t __attribute__((ext_vector_type(4)));
#define DI __device__ __forceinline__
#define LAS __attribute__((address_space(3)))

constexpr int B_ = 8, S_ = 4096, D_ = 1024, C_ = 256;
constexpr int NL = B_ * S_, NC = B_ * C_, NT = NL + NC;
constexpr int INW = 1696, INWP = 1792;
constexpr int NE = 16;
constexpr int MAXSLOT = NT * 2 + NE * 256;
constexpr float EPS = 1e-6f;
constexpr int NTHR = 512;
#define VTID ((int)(threadIdx.x & 255u))
#define VHALF (__builtin_amdgcn_readfirstlane((int)(threadIdx.x >> 8)))
#define VBID ((int)(blockIdx.x * 2u) + VHALF)
#define VGRID ((int)(gridDim.x * 2u))

DI float bf2f(u16 v) { return __uint_as_float(((unsigned)v) << 16); }
DI float bflo(unsigned u) { return __uint_as_float(u << 16); }
DI float bfhi(unsigned u) { return __uint_as_float(u & 0xffff0000u); }
DI unsigned cvtpk(float lo, float hi) { f32x2_t v = {lo, hi}; bf16x2_t b = __builtin_convertvector(v, bf16x2_t); return __builtin_bit_cast(unsigned, b); }
template <int CTRL> DI float dpp_mov(float v) { return __int_as_float(__builtin_amdgcn_update_dpp(0, __float_as_int(v), CTRL, 0xf, 0xf, false)); }
DI float wave_sum(float v) {
  v += dpp_mov<0xB1>(v);
  v += dpp_mov<0x4E>(v);
  v += dpp_mov<0x141>(v);
  v += dpp_mov<0x140>(v);
  { auto rr = __builtin_amdgcn_permlane16_swap(__float_as_uint(v), __float_as_uint(v), false, false); v = __uint_as_float(rr[0]) + __uint_as_float(rr[1]); }
  { auto rr = __builtin_amdgcn_permlane32_swap(__float_as_uint(v), __float_as_uint(v), false, false); v = __uint_as_float(rr[0]) + __uint_as_float(rr[1]); }
  return v;
}
DI float silu(float g) { return g / (1.f + __expf(-g)); }
DI int opaque(int v) { asm volatile("" : "+v"(v)); return v; }

constexpr size_t al256(size_t x) { return (x + 255) & ~(size_t)255; }
constexpr size_t OFF_CTRL = 0;
constexpr size_t CTRL_BYTES = 65536;
constexpr size_t OFF_CTXR = OFF_CTRL + CTRL_BYTES;
constexpr size_t OFF_MOD = OFF_CTXR + 256;
constexpr size_t OFF_TOKE = OFF_MOD + al256((size_t)2 * 9 * 6144 * 4);
constexpr size_t OFF_TOKW = OFF_TOKE + al256((size_t)NT * 2 * 4);
constexpr size_t OFF_TOKP = OFF_TOKW + al256((size_t)NT * 2 * 4);
constexpr size_t OFF_LIST = OFF_TOKP + al256((size_t)NT * 2 * 4);
constexpr size_t OFF_WIN = OFF_LIST + al256((size_t)NE * NT * 4);
constexpr size_t OFF_WO = OFF_WIN + (size_t)2 * INWP * 1024 * 2;
constexpr size_t OFF_WUQ = OFF_WO + (size_t)2 * 1024 * 1024 * 2;
constexpr size_t OFF_WUKV = OFF_WUQ + (size_t)2 * 384 * 256 * 2;
constexpr size_t OFF_WGU = OFF_WUKV + (size_t)2 * 512 * 128 * 2;
constexpr size_t OFF_WD = OFF_WGU + (size_t)2 * 16 * 1024 * 1024 * 2;
constexpr size_t OFF_SGU = OFF_WD + (size_t)2 * 16 * 1024 * 512 * 2;
constexpr size_t OFF_SD = OFF_SGU + (size_t)2 * 1024 * 1024 * 2;
constexpr size_t OFF_H = OFF_SD + (size_t)2 * 1024 * 512 * 2;
constexpr size_t OFF_BIG = OFF_H + (size_t)NT * 1024 * 2;
constexpr size_t OFF_SWQ = OFF_BIG;
constexpr size_t OFF_SWK = OFF_SWQ + (size_t)NT * 384 * 2;
constexpr size_t OFF_SWV = OFF_SWK + (size_t)NT * 128 * 2;
constexpr size_t OFF_GLQ = OFF_SWV + (size_t)NT * 128 * 2;
constexpr size_t OFF_GLK = OFF_GLQ + (size_t)NT * 384 * 2;
constexpr size_t OFF_GLV = OFF_GLK + (size_t)NT * 128 * 2;
constexpr size_t OFF_MLQ = OFF_GLV + (size_t)NT * 128 * 2;
constexpr size_t OFF_MLK = OFF_MLQ + (size_t)NT * 384 * 2;
constexpr size_t OFF_MLKR = OFF_MLK + (size_t)NT * 256 * 2;
constexpr size_t OFF_MLV = OFF_MLKR + (size_t)NT * 32 * 2;
constexpr size_t OFF_QLAT = OFF_MLV + (size_t)NT * 256 * 2;
constexpr size_t OFF_KVLAT = OFF_QLAT + (size_t)NT * 256 * 2;
constexpr size_t OFF_Y = OFF_KVLAT + (size_t)NT * 128 * 2;
constexpr size_t END_A = OFF_Y + (size_t)NT * 1024 * 2;
constexpr size_t OFF_ACT = OFF_BIG;
constexpr size_t OFF_ACTS = OFF_ACT + (size_t)MAXSLOT * 512 * 2;
constexpr size_t OFF_YEXP = OFF_ACTS + (size_t)NT * 512 * 2;
constexpr size_t END_B = OFF_YEXP + (size_t)MAXSLOT * 1024 * 2;
constexpr size_t OFF_YSH = OFF_H;
constexpr size_t OFF_DELTA = OFF_SWQ;
static_assert(OFF_DELTA + (size_t)NT * 1024 * 2 <= OFF_MLQ, "DELTA must fit below MLQ");
constexpr size_t OFF_XB = al256(END_A > END_B ? END_A : END_B);
constexpr size_t OFF_ROWSS = OFF_XB + (size_t)NT * 1024 * 2;
constexpr size_t WS_NEED = OFF_ROWSS + (size_t)6 * NT * 4;
static_assert(WS_NEED <= (size_t)536870912, "workspace too large");

constexpr int CW_CTR = 0;
constexpr int CW_CNT = 8192;
constexpr int CW_Q = 10240;

struct Params {
  const float *x, *c, *ctx, *c_ctx, *w_mod, *b_mod, *norm_mix_g, *norm_ffn_g, *w_in, *w_out, *swa_sink, *glb_q_gain, *glb_k_gain,
      *mla_q_gain, *mla_w_uq, *mla_kv_gain, *mla_w_ukv, *router_w, *router_bias, *exp_w_gate, *exp_w_up, *exp_w_down, *shr_w_gate,
      *shr_w_up, *shr_w_down, *final_norm_g;
  float* out;
  char* ws;
  int never; int pad;
};

constexpr int LDS_MISC = 65536;
constexpr int LDS_HALF = 73728;
constexpr int LDS_ESTG = 131072;
constexpr int LDS_RMISC = 147456;
constexpr int LDS_BYTES = 159744;

DI int next_unit(unsigned* ctr, LAS char* lds) {
  volatile LAS int* slot = (volatile LAS int*)(lds + LDS_RMISC);
  __syncthreads();
  if (threadIdx.x == 0) *slot = (int)atomicAdd(ctr, 1u);
  __syncthreads();
  return *slot;
}

DI unsigned xcc_id_() { return (unsigned)__builtin_amdgcn_s_getreg((3 << 11) | 20) & 0x7u; }
DI int next_unit_xcd(unsigned* ctr8, int per_queue, LAS char* lds  ) {
  volatile LAS int* slot = (volatile LAS int*)(lds + LDS_RMISC);
  __syncthreads();
  if (threadIdx.x == 0) {
    const int q0 = (int)xcc_id_();
    int res = -1;
    for (int i = 0; i < 8; ++i) {
      const int q = (q0 + i) & 7;
      const int v = (int)atomicAdd(&ctr8[q * 64], 1u);
      if (v < per_queue) { res = q * per_queue + v; break; }
    }
    *slot = res;
  }
  __syncthreads();
  return *slot;
}
DI void cvt_job(const float* __restrict__ src, int ld, int N, int k0, int n0, u16* __restrict__ dst, int K, int mode  , LAS char* lds) {
  LAS float* T = (LAS float*)lds;
  const int tid = VTID;
  __syncthreads();
  {
    const int kk = tid >> 2, nq = (tid & 3) * 32;
    const float* s = src + (size_t)(k0 + kk) * ld + n0 + nq;
#pragma unroll
    for (int i = 0; i < 8; ++i) {
      float4 v = make_float4(0.f, 0.f, 0.f, 0.f);
      if (n0 + nq + i * 4 < N) v = *(const float4*)(s + i * 4);
      LAS float* t = T + kk * 129 + nq + i * 4;
      t[0] = v.x; t[1] = v.y; t[2] = v.z; t[3] = v.w;
    }
  }
  __syncthreads();
#pragma unroll
  for (int i = 0; i < 4; ++i) {
    const int chn = tid + i * 256;
    const int n = chn >> 3, kc = (chn & 7) * 8;
    if (n0 + n < N) {
      const LAS float* t = T + kc * 129 + n;
      uint4 o;
      o.x = cvtpk(t[0], t[129]); o.y = cvtpk(t[2 * 129], t[3 * 129]); o.z = cvtpk(t[4 * 129], t[5 * 129]); o.w = cvtpk(t[6 * 129], t[7 * 129]);
      const int gn = n0 + n;
      int drow = gn;
      if (mode) drow = (gn >> 5) * 64 + (gn & 31) + (mode == 2 ? 32 : 0);
      *(uint4*)(dst + (size_t)drow * K + k0 + kc) = o;
    }
  }
}

DI void mod_job(const Params& p, int l, int j0, LAS char* lds) {
  LAS float* sc = (LAS float*)lds;
  LAS float* red = (LAS float*)(lds + 36864);
  const int tid = VTID;
  __syncthreads();
  for (int i = tid; i < 9 * 1024; i += 256) {
    int r = i >> 10, k = i & 1023;
    float v = r < 8 ? p.c[r * 1024 + k] : p.c_ctx[k];
    sc[i] = v / (1.f + __expf(-v));
  }
  __syncthreads();
  const int col = tid & 31, kg = tid >> 5;
  float acc[9];
#pragma unroll
  for (int r = 0; r < 9; ++r) acc[r] = 0.f;
  const float* w = p.w_mod + (size_t)l * 1024 * 6144 + (size_t)(kg * 128) * 6144 + j0 + col;
#pragma unroll 1
  for (int k0 = 0; k0 < 128; k0 += 16) {
    float wv[16];
#pragma unroll
    for (int u = 0; u < 16; ++u) wv[u] = w[(size_t)(k0 + u) * 6144];
#pragma unroll
    for (int u = 0; u < 16; ++u)
#pragma unroll
      for (int r = 0; r < 9; ++r) acc[r] += sc[r * 1024 + kg * 128 + k0 + u] * wv[u];
  }
#pragma unroll
  for (int r = 0; r < 9; ++r) red[(kg * 9 + r) * 32 + col] = acc[r];
  __syncthreads();
  float* MOD = (float*)(p.ws + OFF_MOD);
  for (int i = tid; i < 9 * 32; i += 256) {
    int r = i >> 5, cc = i & 31;
    float sum = 0.f;
#pragma unroll
    for (int g = 0; g < 8; ++g) sum += red[(g * 9 + r) * 32 + cc];
    MOD[(size_t)(l * 9 + r) * 6144 + j0 + cc] = sum + p.b_mod[l * 6144 + j0 + cc];
  }
}

constexpr int J_WIN = 16 * 14, J_WO = 16 * 8, J_UQ = 4 * 3, J_UKV = 2 * 4, J_EG = 16 * 4, J_ED = 8 * 8;
constexpr int J_DENSE = J_WIN + J_WO + J_UQ + J_UKV;
constexpr int J_EXP = 16 * (2 * J_EG + J_ED);
constexpr int J_SHR = 2 * J_EG + J_ED;
constexpr int J_LAYER = J_DENSE + J_EXP + J_SHR;
constexpr int J_MOD = 2 * 192;
constexpr int J_TOTAL = 2 * J_LAYER + J_MOD;

static_assert(J_MOD % 2 == 0 && J_TOTAL % 2 == 0, "job pairs (2i, 2i+1) must be of one kind and both valid");
DI void p0_prologue(const Params& p, LAS char* ldsr) {
  char* ws = p.ws;
  LAS char* lds = ldsr + VHALF * LDS_HALF;
  for (int job = VBID; job < J_TOTAL; job += VGRID) {
    if (job < J_MOD) { mod_job(p, job / 192, (job % 192) * 32, lds); continue; }
    int r = job - J_MOD;
    const int l = r / J_LAYER; r -= l * J_LAYER;
    if (r < J_WIN) { cvt_job(p.w_in + (size_t)l * 1024 * INW, INW, INW, (r / 14) * 64, (r % 14) * 128, (u16*)(ws + OFF_WIN) + (size_t)l * INWP * 1024, 1024, 0, lds); continue; } r -= J_WIN;
    if (r < J_WO) { cvt_job(p.w_out + (size_t)l * 1024 * 1024, 1024, 1024, (r / 8) * 64, (r % 8) * 128, (u16*)(ws + OFF_WO) + (size_t)l * 1024 * 1024, 1024, 0, lds); continue; } r -= J_WO;
    if (r < J_UQ) { cvt_job(p.mla_w_uq + (size_t)l * 256 * 384, 384, 384, (r / 3) * 64, (r % 3) * 128, (u16*)(ws + OFF_WUQ) + (size_t)l * 384 * 256, 256, 0, lds); continue; } r -= J_UQ;
    if (r < J_UKV) { cvt_job(p.mla_w_ukv + (size_t)l * 128 * 512, 512, 512, (r / 4) * 64, (r % 4) * 128, (u16*)(ws + OFF_WUKV) + (size_t)l * 512 * 128, 128, 0, lds); continue; } r -= J_UKV;
    if (r < J_EXP) {
      const int e = r / (2 * J_EG + J_ED); int q = r % (2 * J_EG + J_ED);
      const size_t le = (size_t)l * NE + e;
      if (q < J_EG) { cvt_job(p.exp_w_gate + le * 1024 * 512, 512, 512, (q / 4) * 64, (q % 4) * 128, (u16*)(ws + OFF_WGU) + le * 1024 * 1024, 1024, 1, lds); continue; } q -= J_EG;
      if (q < J_EG) { cvt_job(p.exp_w_up + le * 1024 * 512, 512, 512, (q / 4) * 64, (q % 4) * 128, (u16*)(ws + OFF_WGU) + le * 1024 * 1024, 1024, 2, lds); continue; } q -= J_EG;
      cvt_job(p.exp_w_down + le * 512 * 1024, 1024, 1024, (q / 8) * 64, (q % 8) * 128, (u16*)(ws + OFF_WD) + le * 1024 * 512, 512, 0, lds); continue;
    }
    r -= J_EXP;
    if (r < J_EG) { cvt_job(p.shr_w_gate + (size_t)l * 1024 * 512, 512, 512, (r / 4) * 64, (r % 4) * 128, (u16*)(ws + OFF_SGU) + (size_t)l * 1024 * 1024, 1024, 1, lds); continue; } r -= J_EG;
    if (r < J_EG) { cvt_job(p.shr_w_up + (size_t)l * 1024 * 512, 512, 512, (r / 4) * 64, (r % 4) * 128, (u16*)(ws + OFF_SGU) + (size_t)l * 1024 * 1024, 1024, 2, lds); continue; } r -= J_EG;
    cvt_job(p.shr_w_down + (size_t)l * 512 * 1024, 1024, 1024, (r / 8) * 64, (r % 8) * 128, (u16*)(ws + OFF_SD) + (size_t)l * 1024 * 512, 512, 0, lds);
  }
}

DI const float* xrow_ptr(const Params& p, int layer_src  , int row) {
  if (layer_src == 0) return row < NL ? p.x + (size_t)row * 1024 : p.ctx + (size_t)(row - NL) * 1024;
  return row < NL ? p.out + (size_t)row * 1024 : (const float*)(p.ws + OFF_CTXR) + (size_t)(row - NL) * 1024;
}
DI float* xrow_out(const Params& p, int row) {
  return row < NL ? p.out + (size_t)row * 1024 : (float*)(p.ws + OFF_CTXR) + (size_t)(row - NL) * 1024;
}

DI void norm_mod_row(f32x4 (&v)[4], const float* __restrict__ g, const float* __restrict__ md  , int lane) {
  float ss = 0.f;
#pragma unroll
  for (int i = 0; i < 4; ++i) ss += v[i].x * v[i].x + v[i].y * v[i].y + v[i].z * v[i].z + v[i].w * v[i].w;
  ss = wave_sum(ss);
  const float rstd = rsqrtf(ss * (1.f / 1024.f) + EPS);
#pragma unroll
  for (int i = 0; i < 4; ++i) {
    const f32x4 gg = *(const f32x4*)(g + lane * 4 + i * 256);
    const f32x4 sh = *(const f32x4*)(md + lane * 4 + i * 256);
    const f32x4 sc = *(const f32x4*)(md + 1024 + lane * 4 + i * 256);
    v[i] = v[i] * rstd * gg * (sc + 1.f) + sh;
  }
}
DI void store_h_row(const f32x4 (&v)[4], u16* __restrict__ hrow, int lane) {
#pragma unroll
  for (int i = 0; i < 4; ++i) {
    uint2 o; o.x = cvtpk(v[i].x, v[i].y); o.y = cvtpk(v[i].z, v[i].w);
    *(uint2*)(hrow + lane * 4 + i * 256) = o;
  }
}

DI void p1_norm_mix(const Params& p, int layer) {
  const int tid_ = opaque((int)threadIdx.x); const int lane = tid_ & 63, gw = blockIdx.x * 8 + (tid_ >> 6), ngw = gridDim.x * 8;
  const float* MODl = (const float*)(p.ws + OFF_MOD) + (size_t)layer * 9 * 6144;
  u16* H = (u16*)(p.ws + OFF_H);
  f32x4 vn[4];
  int row = gw;
  if (row < NT) { const float* xr = xrow_ptr(p, layer, row);
#pragma unroll
    for (int i = 0; i < 4; ++i) vn[i] = __builtin_nontemporal_load((const f32x4*)(xr + lane * 4 + i * 256)); }
  while (row < NT) {
    f32x4 v[4];
#pragma unroll
    for (int i = 0; i < 4; ++i) v[i] = vn[i];
    const int rown = row + ngw;
    if (rown < NT) { const float* xr = xrow_ptr(p, layer, rown);
#pragma unroll
      for (int i = 0; i < 4; ++i) vn[i] = __builtin_nontemporal_load((const f32x4*)(xr + lane * 4 + i * 256)); }
    const int mr = row < NL ? row / S_ : 8;
    norm_mod_row(v, p.norm_mix_g + layer * 1024, MODl + (size_t)mr * 6144, lane);
    store_h_row(v, H + (size_t)row * 1024, lane);
    row = rown;
  }
}

DI float max2nd4(float a, float b, float c, float d, float& m1) {
  const float ab = fmaxf(a, b), cd = fmaxf(c, d);
  m1 = fmaxf(ab, cd);
  return fmaxf(fmaxf(fminf(a, b), fminf(c, d)), fminf(ab, cd));
}
template <int CTRL> DI float dppz(float v) { return __int_as_float(__builtin_amdgcn_update_dpp(0, __float_as_int(v), CTRL, 0xf, 0xf, true)); }
DI float lane_xor4(float v, bool b2) { const float a = dppz<0x114>(v), b = dppz<0x104>(v); return b2 ? a : b; }
DI float lane_xor8(float v, bool b3) { const float a = dppz<0x118>(v), b = dppz<0x108>(v); return b3 ? a : b; }
DI bool beats(float a, int ia, float b, int ib) { return a > b || (a == b && ia < ib); }
DI void route_row(float bias_lane, const f32x4 (&v)[4], LAS char* lds, int lane, int& i0, int& i1, float& w0, float& w1) {
  const LAS f32x4* R = (const LAS f32x4*)lds;
  f32x4 pl4[4];
#pragma unroll
  for (int q = 0; q < 4; ++q) pl4[q] = (f32x4){0.f, 0.f, 0.f, 0.f};
#pragma unroll
  for (int i = 0; i < 4; ++i) {
    const int kq = i * 64 + lane;
    f32x4 wq[16];
#pragma unroll
    for (int j = 0; j < 16; ++j) wq[j] = R[j * 256 + kq];
    __builtin_amdgcn_sched_barrier(0);
#pragma unroll
    for (int kk = 0; kk < 4; ++kk) {
      const float hv = v[i][kk];
      const f32x4 hv4 = (f32x4){hv, hv, hv, hv};
#pragma unroll
      for (int q = 0; q < 4; ++q) pl4[q] = __builtin_elementwise_fma(hv4, wq[kk * 4 + q], pl4[q]);
    }
    __builtin_amdgcn_sched_barrier(0);
  }
  float pl[16];
#pragma unroll
  for (int q = 0; q < 4; ++q) { pl[q * 4 + 0] = pl4[q][0]; pl[q * 4 + 1] = pl4[q][1]; pl[q * 4 + 2] = pl4[q][2]; pl[q * 4 + 3] = pl4[q][3]; }
  const bool b0 = (lane & 1) != 0, b1 = (lane & 2) != 0, b2 = (lane & 4) != 0, b3 = (lane & 8) != 0;
  float r8[8], r4[4], r2[2];
#pragma unroll
  for (int i = 0; i < 8; ++i) { const float keep = b0 ? pl[i + 8] : pl[i], send = b0 ? pl[i] : pl[i + 8]; r8[i] = keep + dppz<0xB1>(send); }
#pragma unroll
  for (int i = 0; i < 4; ++i) { const float keep = b1 ? r8[i + 4] : r8[i], send = b1 ? r8[i] : r8[i + 4]; r4[i] = keep + dppz<0x4E>(send); }
#pragma unroll
  for (int i = 0; i < 2; ++i) { const float keep = b2 ? r4[i + 2] : r4[i], send = b2 ? r4[i] : r4[i + 2]; r2[i] = keep + lane_xor4(send, b2); }
  float lg;
  { const float keep = b3 ? r2[1] : r2[0], send = b3 ? r2[0] : r2[1]; lg = keep + lane_xor8(send, b3); }
  { auto rr = __builtin_amdgcn_permlane16_swap(__float_as_uint(lg), __float_as_uint(lg), false, false); lg = __uint_as_float(rr[0]) + __uint_as_float(rr[1]); }
  { auto rr = __builtin_amdgcn_permlane32_swap(__float_as_uint(lg), __float_as_uint(lg), false, false); lg = __uint_as_float(rr[0]) + __uint_as_float(rr[1]); }
  const float sg = __builtin_amdgcn_rcpf(1.f + __builtin_amdgcn_exp2f(-1.4426950408889634f * lg));
  const float bv = sg + bias_lane;
  const float m1v = lane_xor4(bv, b2), m2v = lane_xor8(bv, b3), m3v = lane_xor8(m1v, b3);
  float mtop; const float m2nd = max2nd4(bv, m1v, m2v, m3v, mtop);
  const float gs = mtop + m2nd;
  const float gA = dppz<0xB1>(gs), gB = dppz<0x4E>(gs), gC = dppz<0x1B>(gs);
  const int g = (b0 ? 2 : 0) + (b1 ? 1 : 0);
  const bool win = beats(gs, g, gA, g ^ 2) && beats(gs, g, gB, g ^ 1) && beats(gs, g, gC, g ^ 3);
  const int el = (b2 ? 2 : 0) + (b3 ? 1 : 0);
  const int rank = (beats(m1v, el ^ 2, bv, el) ? 1 : 0) + (beats(m2v, el ^ 1, bv, el) ? 1 : 0) + (beats(m3v, el ^ 3, bv, el) ? 1 : 0);
  const unsigned long long k0 = __ballot(win && rank == 0), k1 = __ballot(win && rank == 1);
  const int L0 = __builtin_ctzll(k0 | (1ull << 63)), L1 = __builtin_ctzll(k1 | (1ull << 63));
  const float s0 = __int_as_float(__builtin_amdgcn_readlane(__float_as_int(sg), L0));
  const float s1 = __int_as_float(__builtin_amdgcn_readlane(__float_as_int(sg), L1));
  i0 = 8 * (L0 & 1) + 4 * ((L0 >> 1) & 1) + 2 * ((L0 >> 2) & 1) + ((L0 >> 3) & 1);
  i1 = 8 * (L1 & 1) + 4 * ((L1 >> 1) & 1) + 2 * ((L1 >> 2) & 1) + ((L1 >> 3) & 1);
  const float inv = 1.f / (s0 + s1);
  w0 = s0 * inv; w1 = s1 * inv;
}

DI void load_router_lds(const Params& p, LAS char* lds) {
  LAS f32x4* R = (LAS f32x4*)lds;
  __syncthreads();
  for (int g = opaque((int)threadIdx.x); g < 4096; g += NTHR) {
    const int k = g >> 2, q = g & 3;
    R[((k & 3) * 4 + q) * 256 + (k >> 2)] = *(const f32x4*)(p.router_w + (size_t)g * 4);
  }
  __syncthreads();
}

constexpr int CNT_STRIDE = 64;
DI void p5_norm_ffn(const Params& p, int layer, int nrows, LAS char* lds) {
  load_router_lds(p, lds);
  const int tid = opaque((int)threadIdx.x), lane = tid & 63, wid = tid >> 6, gw = blockIdx.x * 8 + wid, ngw = gridDim.x * 8;
  const float* MODl = (const float*)(p.ws + OFF_MOD) + (size_t)layer * 9 * 6144;
  u16* H = (u16*)(p.ws + OFF_H);
  volatile LAS int* lcnt = (volatile LAS int*)(lds + LDS_RMISC + 128);
  volatile LAS int* lbase = lcnt + 16;
  volatile LAS int* stash = (volatile LAS int*)(lds + LDS_RMISC + 1024) + wid * 160;
  int* tok_e = (int*)(p.ws + OFF_TOKE); float* tok_w = (float*)(p.ws + OFF_TOKW); int* tok_p = (int*)(p.ws + OFF_TOKP);
  int* list = (int*)(p.ws + OFF_LIST);
  unsigned* cnt = (unsigned*)(p.ws + OFF_CTRL) + CW_CNT + layer * 16 * CNT_STRIDE;
  if (tid < 16) lcnt[tid] = 0;
  __syncthreads();
  const float bias = p.router_bias[8 * (lane & 1) + 4 * ((lane >> 1) & 1) + 2 * ((lane >> 2) & 1) + ((lane >> 3) & 1)];
  int nst = 0;
  u32x2_t dn[4], xbn[4]; f32x4 xfn[4];
  u16* XB = (u16*)(p.ws + OFF_XB);
  const u16* DELTA = (const u16*)(p.ws + OFF_DELTA);
#define P5_LOAD(r) do { const int _r = (r); _Pragma("unroll") for (int i = 0; i < 4; ++i) { const int _c = lane * 4 + i * 256; \
      dn[i] = __builtin_nontemporal_load((const u32x2_t*)(DELTA + (size_t)_r * 1024 + _c)); \
      if (layer == 0) xfn[i] = __builtin_nontemporal_load((const f32x4*)((_r < NL ? p.x + (size_t)_r * 1024 : p.ctx + (size_t)(_r - NL) * 1024) + _c)); \
      else xbn[i] = __builtin_nontemporal_load((const u32x2_t*)(XB + (size_t)_r * 1024 + _c)); } } while (0)
  if (gw < nrows) P5_LOAD(gw);
  for (int row = gw; row < nrows; row += ngw) {
    f32x4 v[4];
#pragma unroll
    for (int i = 0; i < 4; ++i) {
      if (layer == 0) v[i] = xfn[i]; else v[i] = (f32x4){bflo(xbn[i][0]), bfhi(xbn[i][0]), bflo(xbn[i][1]), bfhi(xbn[i][1])};
      v[i][0] += bflo(dn[i][0]); v[i][1] += bfhi(dn[i][0]); v[i][2] += bflo(dn[i][1]); v[i][3] += bfhi(dn[i][1]);
    }
    if (row + ngw < nrows) P5_LOAD(row + ngw);
#pragma unroll
    for (int i = 0; i < 4; ++i) { u32x2_t o; o[0] = cvtpk(v[i][0], v[i][1]); o[1] = cvtpk(v[i][2], v[i][3]); *(u32x2_t*)(XB + (size_t)row * 1024 + lane * 4 + i * 256) = o; }
    const int mr = row < NL ? row / S_ : 8;
    norm_mod_row(v, p.norm_ffn_g + layer * 1024, MODl + (size_t)mr * 6144 + 3 * 1024, lane);
    store_h_row(v, H + (size_t)row * 1024, lane);
    int i0, i1; float w0, w1;
    route_row(bias, v, lds, lane, i0, i1, w0, w1);
    if (lane == 0) {
      const int lp0 = __hip_atomic_fetch_add((LAS int*)&lcnt[i0], 1, __ATOMIC_RELAXED, __HIP_MEMORY_SCOPE_WORKGROUP);
      const int lp1 = __hip_atomic_fetch_add((LAS int*)&lcnt[i1], 1, __ATOMIC_RELAXED, __HIP_MEMORY_SCOPE_WORKGROUP);
      tok_e[row * 2] = i0; tok_e[row * 2 + 1] = i1;
      tok_w[row * 2] = w0; tok_w[row * 2 + 1] = w1;
      stash[nst * 4 + 0] = i0; stash[nst * 4 + 1] = lp0; stash[nst * 4 + 2] = i1; stash[nst * 4 + 3] = lp1;
    }
    ++nst;
  }
  __syncthreads();
  if (tid < 16) { const int c = lcnt[tid]; lbase[tid] = c > 0 ? (int)atomicAdd(&cnt[tid * CNT_STRIDE], (unsigned)c) : 0; }
  __syncthreads();
  if (lane == 0) {
    int k = 0;
    for (int row = gw; row < nrows; row += ngw, ++k) {
      const int e0 = stash[k * 4 + 0], e1 = stash[k * 4 + 2];
      const int p0 = lbase[e0] + stash[k * 4 + 1], p1 = lbase[e1] + stash[k * 4 + 3];
      tok_p[row * 2] = p0; tok_p[row * 2 + 1] = p1;
      list[(size_t)e0 * NT + p0] = row; list[(size_t)e1 * NT + p1] = row;
    }
  }
}

DI void seg_scan(const Params& p, int layer, int (&tb)[NE + 1]) {
  const unsigned* cnt = (const unsigned*)(p.ws + OFF_CTRL) + CW_CNT + layer * 16 * CNT_STRIDE;
  int acc = 0;
#pragma unroll
  for (int e = 0; e < NE; ++e) { tb[e] = acc; acc += ((int)cnt[e * CNT_STRIDE] + 255) >> 8; }
  tb[NE] = acc;
}

DI void p8_combine(const Params& p, int layer, int nrows) {
  const int tid_ = opaque((int)threadIdx.x); const int lane = tid_ & 63, gw = blockIdx.x * 8 + (tid_ >> 6), ngw = gridDim.x * 8;
  const float* MODl = (const float*)(p.ws + OFF_MOD) + (size_t)layer * 9 * 6144;
  const float* MODn = (const float*)(p.ws + OFF_MOD) + (size_t)(layer + 1) * 9 * 6144;
  u16* H = (u16*)(p.ws + OFF_H);
  const u16* YSH = (const u16*)(p.ws + OFF_YSH);
  const u16* YEXP = (const u16*)(p.ws + OFF_YEXP);
  u16* XB = (u16*)(p.ws + OFF_XB);
  const int* tok_e = (const int*)(p.ws + OFF_TOKE); const float* tok_w = (const float*)(p.ws + OFF_TOKW); const int* tok_p = (const int*)(p.ws + OFF_TOKP);
  int tb[NE + 1]; seg_scan(p, layer, tb);
  int me0 = 0, me1 = 0, mp0 = 0, mp1 = 0; float mw0 = 0.f, mw1 = 0.f;
  u32x2_t an[4], bn[4], cn[4], xn[4]; float nw0 = 0.f, nw1 = 0.f;
#define P8_META(r) do { me0 = tok_e[(r) * 2]; me1 = tok_e[(r) * 2 + 1]; mp0 = tok_p[(r) * 2]; mp1 = tok_p[(r) * 2 + 1]; mw0 = tok_w[(r) * 2]; mw1 = tok_w[(r) * 2 + 1]; } while (0)
#define P8_DATA(r) do { int ps0 = 0, ps1 = 0; _Pragma("unroll") for (int e = 0; e < NE; ++e) { if (e == me0) ps0 = tb[e]; if (e == me1) ps1 = tb[e]; } \
    const size_t s0 = (size_t)ps0 * 256 + mp0, s1 = (size_t)ps1 * 256 + mp1; nw0 = mw0; nw1 = mw1; const u16* xrn = XB + (size_t)(r) * 1024; \
    _Pragma("unroll") for (int i = 0; i < 4; ++i) { const int cidx = lane * 4 + i * 256; \
      an[i] = __builtin_nontemporal_load((const u32x2_t*)(YEXP + s0 * 1024 + cidx)); bn[i] = __builtin_nontemporal_load((const u32x2_t*)(YEXP + s1 * 1024 + cidx)); \
      cn[i] = __builtin_nontemporal_load((const u32x2_t*)(YSH + (size_t)(r) * 1024 + cidx)); xn[i] = __builtin_nontemporal_load((const u32x2_t*)(xrn + cidx)); } } while (0)
  if (gw < nrows) { P8_META(gw); P8_DATA(gw); }
  if (gw + ngw < nrows) P8_META(gw + ngw);
  for (int row = gw; row < nrows; row += ngw) {
    u32x2_t a[4], b[4], c[4]; f32x4 v[4];
#pragma unroll
    for (int i = 0; i < 4; ++i) { a[i] = an[i]; b[i] = bn[i]; c[i] = cn[i]; v[i] = (f32x4){bflo(xn[i][0]), bfhi(xn[i][0]), bflo(xn[i][1]), bfhi(xn[i][1])}; }
    const float w0 = nw0, w1 = nw1;
    if (row + ngw < nrows) P8_DATA(row + ngw);
    if (row + 2 * ngw < nrows) P8_META(row + 2 * ngw);
    float* xr = xrow_out(p, row);
    const int mr = row < NL ? row / S_ : 8;
    const float* gate = MODl + (size_t)mr * 6144 + 5 * 1024;
#pragma unroll
    for (int i = 0; i < 4; ++i) {
      const int cidx = lane * 4 + i * 256;
      const f32x4 g = *(const f32x4*)(gate + cidx);
      f32x4 x = v[i];
      x.x += g.x * (w0 * bflo(a[i][0]) + w1 * bflo(b[i][0]) + bflo(c[i][0]));
      x.y += g.y * (w0 * bfhi(a[i][0]) + w1 * bfhi(b[i][0]) + bfhi(c[i][0]));
      x.z += g.z * (w0 * bflo(a[i][1]) + w1 * bflo(b[i][1]) + bflo(c[i][1]));
      x.w += g.w * (w0 * bfhi(a[i][1]) + w1 * bfhi(b[i][1]) + bfhi(c[i][1]));
      v[i] = x;
    }
    if (layer == 0) {
#pragma unroll
      for (int i = 0; i < 4; ++i) { u32x2_t o; o[0] = cvtpk(v[i].x, v[i].y); o[1] = cvtpk(v[i].z, v[i].w); *(u32x2_t*)(XB + (size_t)row * 1024 + lane * 4 + i * 256) = o; }
      norm_mod_row(v, p.norm_mix_g + 1024, MODn + (size_t)mr * 6144, lane);
      store_h_row(v, H + (size_t)row * 1024, lane);
    } else {
      float ss = 0.f;
#pragma unroll
      for (int i = 0; i < 4; ++i) ss += v[i].x * v[i].x + v[i].y * v[i].y + v[i].z * v[i].z + v[i].w * v[i].w;
      ss = wave_sum(ss);
      const float rstd = rsqrtf(ss * (1.f / 1024.f) + EPS);
#pragma unroll
      for (int i = 0; i < 4; ++i) {
        const f32x4 gg = *(const f32x4*)(p.final_norm_g + lane * 4 + i * 256);
        __builtin_nontemporal_store(v[i] * rstd * gg, (f32x4*)(xr + lane * 4 + i * 256));
      }
    }
  }
#undef P8_META
#undef P8_DATA
}

DI void glds16(const u16* g, LAS char* l) {
  __builtin_amdgcn_global_load_lds((const void*)g, (LAS void*)l, 16, 0, 0);
}
struct TilePtrs { const u16 *a0, *a1, *a2, *a3, *b0; long ldb32; };
#define GT_ISSUE_P(T, kt, s) do { const int _ko = (kt) * 64; LAS char* _d = ldst + (s) * 32768; \
    glds16((T).a0 + _ko, _d); glds16((T).a1 + _ko, _d + 4096); glds16((T).a2 + _ko, _d + 8192); glds16((T).a3 + _ko, _d + 12288); \
    glds16((T).b0 + _ko, _d + 16384); glds16((T).b0 + (T).ldb32 + _ko, _d + 20480); glds16((T).b0 + 2 * (T).ldb32 + _ko, _d + 24576); glds16((T).b0 + 3 * (T).ldb32 + _ko, _d + 28672); } while (0)
template <bool HOIST = true>
DI void gemm_tile_s(LAS char* lds, const TilePtrs& cur, bool issued, const TilePtrs& nxt, bool has_next, int nk, f32x4 (&acc)[4][4]) {
  const int tid = opaque(VTID), lane = tid & 63, wid = tid >> 6, wr = wid >> 1, wc = wid & 1, fr = lane & 15, fq = lane >> 4;
  const int kx = (fr >> 1) & 7;
  const int aoff0 = (wr * 64 + fr) * 128 + ((fq ^ kx) * 16), aoff1 = (wr * 64 + fr) * 128 + (((4 + fq) ^ kx) * 16);
  const int boff0 = 16384 + (wc * 64 + fr) * 128 + ((fq ^ kx) * 16), boff1 = 16384 + (wc * 64 + fr) * 128 + (((4 + fq) ^ kx) * 16);
#pragma unroll
  for (int m = 0; m < 4; ++m)
#pragma unroll
    for (int n = 0; n < 4; ++n) acc[m][n] = (f32x4){0.f, 0.f, 0.f, 0.f};
  LAS char* ldst = lds + tid * 16;
  if (!issued) GT_ISSUE_P(cur, 0, 0);
#pragma unroll 1
  for (int kt = 0; kt < nk; ++kt) {
    asm volatile("s_waitcnt vmcnt(0)" ::: "memory");
    __syncthreads();
    if (kt + 1 < nk) GT_ISSUE_P(cur, kt + 1, (kt + 1) & 1);
    else if (has_next) GT_ISSUE_P(nxt, 0, 0);
    const LAS char* sb = lds + (kt & 1) * 32768;
    if (!HOIST) {
#pragma unroll
      for (int h = 0; h < 2; ++h) {
        bf16x8 af1[4], bf1[4];
#pragma unroll
        for (int m = 0; m < 4; ++m) af1[m] = *(const LAS bf16x8*)(sb + (h ? aoff1 : aoff0) + m * 2048);
#pragma unroll
        for (int n = 0; n < 4; ++n) bf1[n] = *(const LAS bf16x8*)(sb + (h ? boff1 : boff0) + n * 2048);
#pragma unroll
        for (int m = 0; m < 4; ++m)
#pragma unroll
          for (int n = 0; n < 4; ++n) acc[m][n] = __builtin_amdgcn_mfma_f32_16x16x32_bf16(bf1[n], af1[m], acc[m][n], 0, 0, 0);
      }
      continue;
    }
    bf16x8 af[2][4], bfr[2][4];
    const unsigned aad0 = (unsigned)(size_t)(sb + aoff0), aad1 = (unsigned)(size_t)(sb + aoff1), bad0 = (unsigned)(size_t)(sb + boff0), bad1 = (unsigned)(size_t)(sb + boff1);
#define GT_LDR(dst, ad, off) asm volatile("ds_read_b128 %0, %1 offset:%c2" : "=v"(dst) : "v"(ad), "i"(off))
    GT_LDR(af[0][0], aad0, 0); GT_LDR(af[0][1], aad0, 2048); GT_LDR(af[0][2], aad0, 4096); GT_LDR(af[0][3], aad0, 6144);
    GT_LDR(bfr[0][0], bad0, 0); GT_LDR(bfr[0][1], bad0, 2048); GT_LDR(bfr[0][2], bad0, 4096); GT_LDR(bfr[0][3], bad0, 6144);
    GT_LDR(af[1][0], aad1, 0); GT_LDR(af[1][1], aad1, 2048); GT_LDR(af[1][2], aad1, 4096); GT_LDR(af[1][3], aad1, 6144);
    GT_LDR(bfr[1][0], bad1, 0); GT_LDR(bfr[1][1], bad1, 2048); GT_LDR(bfr[1][2], bad1, 4096); GT_LDR(bfr[1][3], bad1, 6144);
#undef GT_LDR
    asm volatile("s_waitcnt lgkmcnt(8)" : "+v"(af[0][0]), "+v"(af[0][1]), "+v"(af[0][2]), "+v"(af[0][3]), "+v"(bfr[0][0]), "+v"(bfr[0][1]), "+v"(bfr[0][2]), "+v"(bfr[0][3]) :: "memory");
    __builtin_amdgcn_sched_barrier(0);
#pragma unroll
    for (int m = 0; m < 4; ++m)
#pragma unroll
      for (int n = 0; n < 4; ++n) acc[m][n] = __builtin_amdgcn_mfma_f32_16x16x32_bf16(bfr[0][n], af[0][m], acc[m][n], 0, 0, 0);
    __builtin_amdgcn_sched_barrier(0);
    asm volatile("s_waitcnt lgkmcnt(0)" : "+v"(af[1][0]), "+v"(af[1][1]), "+v"(af[1][2]), "+v"(af[1][3]), "+v"(bfr[1][0]), "+v"(bfr[1][1]), "+v"(bfr[1][2]), "+v"(bfr[1][3]) :: "memory");
    __builtin_amdgcn_sched_barrier(0);
#pragma unroll
    for (int m = 0; m < 4; ++m)
#pragma unroll
      for (int n = 0; n < 4; ++n) acc[m][n] = __builtin_amdgcn_mfma_f32_16x16x32_bf16(bfr[1][n], af[1][m], acc[m][n], 0, 0, 0);
    __builtin_amdgcn_sched_barrier(0);
  }
}
DI void gemm_tile(LAS char* lds, const u16* a0, long lda32, const u16* b0, long ldb32, int nk, f32x4 (&acc)[4][4]) {
  TilePtrs t; t.a0 = a0; t.a1 = a0 + lda32; t.a2 = a0 + 2 * lda32; t.a3 = a0 + 3 * lda32; t.b0 = b0; t.ldb32 = ldb32;
  gemm_tile_s<false>(lds, t, false, t, false, nk, acc);
  __syncthreads();
}
DI int gt_chunk(int tid) { return ((tid & 7) ^ ((tid >> 4) & 7)) * 8; }
DI int gt_row0(int tid) { return tid >> 3; }

DI void sincos_rev(float pos, float invf, float& sn, float& cs) {
  float rev = pos * invf * 0.15915494309189535f;
  rev -= rintf(rev);
  sn = __builtin_amdgcn_sinf(rev); cs = __builtin_amdgcn_cosf(rev);
}
DI void st_bf4(u16* dst, const f32x4& v) { uint2 o; o.x = cvtpk(v[0], v[1]); o.y = cvtpk(v[2], v[3]); *(uint2*)dst = o; }


DI void stage_put4(LAS char* st, int row, int c8, const f32x4& v) {
  u32x2_t o; o[0] = cvtpk(v[0], v[1]); o[1] = cvtpk(v[2], v[3]);
  *(LAS u32x2_t*)(st + row * 128 + ((c8 ^ (row & 15)) * 8)) = o;
}
DI u32x4_t stage_get16(const LAS char* st, int row, int u) {
  u32x4_t v = *(const LAS u32x4_t*)(st + row * 128 + ((u ^ ((row >> 1) & 7)) * 16));
  if (row & 1) v = __builtin_shufflevector(v, v, 2, 3, 0, 1);
  return v;
}
template <int NC>
DI void stage_flush(const LAS char* st, u16* dst, size_t ld, int lane) {
  constexpr int UPR = NC / 8;
  constexpr int RPI = 64 / UPR;
#pragma unroll
  for (int i = 0; i < 64 / RPI; ++i) {
    const int row = i * RPI + lane / UPR, u = lane % UPR;
    const u32x4_t v = stage_get16(st, row, u);
    *(u32x4_t*)(dst + (size_t)row * ld + u * 8) = v;
  }
}

template <bool F32SRC>
DI void stage_flush_resid(const LAS char* st, const float* __restrict__ xs, u16* xb, int lane) {
#pragma unroll
  for (int h = 0; h < 2; ++h) {
    f32x4 xa[4], xc[4]; u32x4_t xo[4];
#pragma unroll
    for (int i = 0; i < 4; ++i) {
      const int row = (h * 4 + i) * 8 + (lane >> 3), u = lane & 7;
      if (F32SRC) { xa[i] = __builtin_nontemporal_load((const f32x4*)(xs + (size_t)row * 1024 + u * 8)); xc[i] = __builtin_nontemporal_load((const f32x4*)(xs + (size_t)row * 1024 + u * 8 + 4)); }
      else xo[i] = __builtin_nontemporal_load((const u32x4_t*)(xb + (size_t)row * 1024 + u * 8));
    }
#pragma unroll
    for (int i = 0; i < 4; ++i) {
      const int row = (h * 4 + i) * 8 + (lane >> 3), u = lane & 7;
      const u32x4_t d = stage_get16(st, row, u);
      if (!F32SRC) { xa[i] = (f32x4){bflo(xo[i][0]), bfhi(xo[i][0]), bflo(xo[i][1]), bfhi(xo[i][1])}; xc[i] = (f32x4){bflo(xo[i][2]), bfhi(xo[i][2]), bflo(xo[i][3]), bfhi(xo[i][3])}; }
      u32x4_t o;
      o[0] = cvtpk(xa[i][0] + bflo(d[0]), xa[i][1] + bfhi(d[0])); o[1] = cvtpk(xa[i][2] + bflo(d[1]), xa[i][3] + bfhi(d[1]));
      o[2] = cvtpk(xc[i][0] + bflo(d[2]), xc[i][1] + bfhi(d[2])); o[3] = cvtpk(xc[i][2] + bflo(d[3]), xc[i][3] + bfhi(d[3]));
      *(u32x4_t*)(xb + (size_t)row * 1024 + u * 8) = o;
    }
  }
}

template <int NC>
DI void flush16(const LAS char* st, u16* dst, size_t ld, int lane) {
  constexpr int UPR = NC / 8, RPI = 64 / UPR;
#pragma unroll
  for (int i = 0; i < 16 / RPI; ++i) {
    const int row = i * RPI + lane / UPR, u = lane % UPR;
    *(u32x4_t*)(dst + (size_t)row * ld + u * 8) = stage_get16(st, row, u);
  }
}
template <bool G8>
DI void epi_inproj(const Params& p, int layer, f32x4 (&acc)[4][4], int m0, int seg, int wr, int fr, int fq, LAS float* rowss_slot, float* rowss_g, LAS char* stg, int lane) {
  char* ws = p.ws;
  const bool lat = m0 < NL;
  const int rbase = m0 + wr * 64 + fr;
  u16* dst; int ld, cb; int kind;
  if (seg < 6) { dst = (u16*)(ws + OFF_SWQ); ld = 384; cb = seg * 64; kind = 1; }
  else if (seg < 8) { dst = (u16*)(ws + OFF_SWK); ld = 128; cb = (seg - 6) * 64; kind = 1; }
  else if (seg < 10) { dst = (u16*)(ws + OFF_SWV); ld = 128; cb = (seg - 8) * 64; kind = 0; }
  else if (seg < 16) { dst = (u16*)(ws + OFF_GLQ); ld = 384; cb = (seg - 10) * 64; kind = 2; }
  else if (seg < 18) { dst = (u16*)(ws + OFF_GLK); ld = 128; cb = (seg - 16) * 64; kind = 3; }
  else if (seg < 20) { dst = (u16*)(ws + OFF_GLV); ld = 128; cb = (seg - 18) * 64; kind = 0; }
  else if (seg < 24) { dst = (u16*)(ws + OFF_QLAT); ld = 256; cb = (seg - 20) * 64; kind = 4; }
  else if (seg < 26) { dst = (u16*)(ws + OFF_KVLAT); ld = 128; cb = (seg - 24) * 64; kind = 5; }
  else if (seg == 26) { dst = (u16*)(ws + OFF_MLKR); ld = 32; cb = 0; kind = 6; }
  else return;
  if (kind == 2 || kind == 3) {
    const float* gain = (kind == 2 ? p.glb_q_gain : p.glb_k_gain) + layer * 64;
    f32x4 gv[4];
#pragma unroll
    for (int n = 0; n < 4; ++n) gv[n] = *(const f32x4*)(gain + n * 16 + fq * 4);
#pragma unroll
    for (int m = 0; m < 4; ++m) {
      float ss = 0.f;
#pragma unroll
      for (int n = 0; n < 4; ++n) ss += acc[m][n][0] * acc[m][n][0] + acc[m][n][1] * acc[m][n][1] + acc[m][n][2] * acc[m][n][2] + acc[m][n][3] * acc[m][n][3];
      ss += __shfl_xor(ss, 16); ss += __shfl_xor(ss, 32);
      const float r = rsqrtf(ss * (1.f / 64.f) + EPS);
#pragma unroll
      for (int n = 0; n < 4; ++n) acc[m][n] = acc[m][n] * r * gv[n];
    }
  }
  if (kind == 4 || kind == 5) {
    const float* gain = (kind == 4 ? p.mla_q_gain + layer * 256 : p.mla_kv_gain + layer * 128) + cb;
    f32x4 gv[4];
#pragma unroll
    for (int n = 0; n < 4; ++n) gv[n] = *(const f32x4*)(gain + n * 16 + fq * 4);
#pragma unroll
    for (int m = 0; m < 4; ++m) {
      float ss = 0.f;
#pragma unroll
      for (int n = 0; n < 4; ++n) ss += acc[m][n][0] * acc[m][n][0] + acc[m][n][1] * acc[m][n][1] + acc[m][n][2] * acc[m][n][2] + acc[m][n][3] * acc[m][n][3];
      ss += __shfl_xor(ss, 16); ss += __shfl_xor(ss, 32);
      if (fq == 0) { if (G8) rowss_g[(size_t)(seg - 20) * NT + m0 + wr * 64 + m * 16 + fr] = ss; else rowss_slot[wr * 64 + m * 16 + fr] = ss; }
#pragma unroll
      for (int n = 0; n < 4; ++n) acc[m][n] = acc[m][n] * gv[n];
    }
  }
  if (lat && (kind == 1 || kind == 2 || kind == 3)) {
    float invf[4];
#pragma unroll
    for (int j = 0; j < 4; ++j) invf[j] = __builtin_amdgcn_exp2f(-(float)(fq * 4 + j) * (13.287712379549449f / 16.f));
#pragma unroll
    for (int m = 0; m < 4; ++m) {
      const int t = (rbase + m * 16) & (S_ - 1);
      const float prow = (float)(t >> 6), pcol = (float)(t & 63);
#pragma unroll
      for (int j = 0; j < 4; ++j) {
        float sr, cr, sc, cc;
        sincos_rev(prow, invf[j], sr, cr); sincos_rev(pcol, invf[j], sc, cc);
        float x1 = acc[m][0][j], x2 = acc[m][1][j];
        acc[m][0][j] = x1 * cr - x2 * sr; acc[m][1][j] = x2 * cr + x1 * sr;
        x1 = acc[m][2][j]; x2 = acc[m][3][j];
        acc[m][2][j] = x1 * cc - x2 * sc; acc[m][3][j] = x2 * cc + x1 * sc;
      }
      if (G8) __builtin_amdgcn_sched_barrier(0);
    }
  }
  if (kind == 6) {
    if (lat) {
      float invf[4];
#pragma unroll
      for (int j = 0; j < 4; ++j) invf[j] = __builtin_amdgcn_exp2f(-(float)((fq & 1) * 4 + j) * (13.287712379549449f / 8.f));
#pragma unroll
      for (int m = 0; m < 4; ++m) {
        const int t = (rbase + m * 16) & (S_ - 1);
#pragma unroll
        for (int n = 0; n < 2; ++n) {
          const float pos = n == 0 ? (float)(t >> 6) : (float)(t & 63);
#pragma unroll
          for (int j = 0; j < 4; ++j) {
            float sn, cs; sincos_rev(pos, invf[j], sn, cs);
            const float v = acc[m][n][j], pr = __shfl_xor(v, 32);
            acc[m][n][j] = (fq & 2) ? v * cs + pr * sn : v * cs - pr * sn;
          }
        }
      }
    }
    if (G8) {
#pragma unroll
      for (int m = 0; m < 4; ++m) {
#pragma unroll
        for (int n = 0; n < 2; ++n) stage_put4(stg, fr, n * 4 + fq, acc[m][n]);
        flush16<32>(stg, dst + (size_t)(m0 + wr * 64 + m * 16) * ld, ld, lane);
      }
      return;
    }
#pragma unroll
    for (int m = 0; m < 4; ++m)
#pragma unroll
      for (int n = 0; n < 2; ++n) stage_put4(stg, m * 16 + fr, n * 4 + fq, acc[m][n]);
    stage_flush<32>(stg, dst + (size_t)(m0 + wr * 64) * ld, ld, lane);
    return;
  }
  if (G8) {
#pragma unroll
    for (int m = 0; m < 4; ++m) {
#pragma unroll
      for (int n = 0; n < 4; ++n) stage_put4(stg, fr, n * 4 + fq, acc[m][n]);
      flush16<64>(stg, dst + (size_t)(m0 + wr * 64 + m * 16) * ld + cb, ld, lane);
    }
    return;
  }
#pragma unroll
  for (int m = 0; m < 4; ++m)
#pragma unroll
    for (int n = 0; n < 4; ++n) stage_put4(stg, m * 16 + fr, n * 4 + fq, acc[m][n]);
  stage_flush<64>(stg, dst + (size_t)(m0 + wr * 64) * ld + cb, ld, lane);
}

DI void p2_inproj(const Params& p, int layer, LAS char* ldsr, int cs = 0) {
  char* ws = p.ws;
  LAS char* lds = ldsr + VHALF * LDS_HALF;
  unsigned* ctr = (unsigned*)(ws + OFF_CTRL) + CW_CTR + layer * 16 + 2 + cs;
  const u16* H = (const u16*)(ws + OFF_H);
  const u16* WinT = (const u16*)(ws + OFF_WIN) + (size_t)layer * INWP * 1024;
  const u16* WuqT = (const u16*)(ws + OFF_WUQ) + (size_t)layer * 384 * 256;
  const u16* WukvT = (const u16*)(ws + OFF_WUKV) + (size_t)layer * 512 * 128;
  const int tid = opaque(VTID), lane = tid & 63, wid = tid >> 6, wr = wid >> 1, wc = wid & 1;
  LAS float* rowss = (LAS float*)(lds + LDS_MISC);
  LAS float* rstd = (LAS float*)(lds + LDS_MISC + 2048);
  unsigned* ctr8 = (unsigned*)(ws + OFF_CTRL) + CW_Q + (layer * 2 + 1) * 512;
  f32x4 acc[4][4];
  for (;;) {
    const int u = next_unit_xcd(ctr8, (NT / 128 / 8 / 2) * 12, ldsr);
    if (u < 0) break;
    const int tid_o = opaque(tid), lane_o = tid_o & 63;
    const int fr = lane_o & 15, fq = lane_o >> 4, ch = gt_chunk(tid_o), r0 = gt_row0(tid_o);
    const int qx = u / 204, v = u % 204, hf = opaque(VHALF);
    int rt, k;
    if (v < 17) { rt = qx * 34 + 2 * v + hf; k = 10; } else if (v < 34) { rt = qx * 34 + 2 * (v - 17) + hf; k = 11; } else { rt = qx * 34 + 2 * ((v - 34) / 10) + hf; k = (v - 34) % 10; }
    const int m0 = rt * 128;
    const u16* a0 = H + (size_t)(m0 + r0) * 1024 + ch;
    if (k < 10) {
      const u16* b0 = WinT + (size_t)(k * 128 + r0) * 1024 + ch;
      gemm_tile(lds, a0, 32 * 1024, b0, 32 * 1024, 16, acc);
      epi_inproj<false>(p, layer, acc, m0, k * 2 + wc, wr, fr, fq, rowss, nullptr, lds + 32768 + wid * 8192, lane_o);
    } else if (k == 10) {
#pragma unroll 1
      for (int t = 0; t < 2; ++t) {
        const u16* b0 = WinT + (size_t)(1280 + t * 128 + r0) * 1024 + ch;
        gemm_tile(lds, a0, 32 * 1024, b0, 32 * 1024, 16, acc);
        epi_inproj<false>(p, layer, acc, m0, 20 + t * 2 + wc, wr, fr, fq, rowss + (t * 2 + wc) * 128, nullptr, lds + 32768 + wid * 8192, lane_o);
      }
      __syncthreads();
      if (tid < 128) rstd[tid] = rsqrtf((rowss[tid] + rowss[128 + tid] + rowss[256 + tid] + rowss[384 + tid]) * (1.f / 256.f) + EPS);
      __syncthreads();
      const u16* QL = (const u16*)(ws + OFF_QLAT);
      const u16* qa0 = QL + (size_t)(m0 + r0) * 256 + ch;
      u16* MLQ = (u16*)(ws + OFF_MLQ);
      const bool lat = m0 < NL;
#pragma unroll 1
      for (int t = 0; t < 3; ++t) {
        const u16* b0 = WuqT + (size_t)(t * 128 + r0) * 256 + ch;
        gemm_tile(lds, qa0, 32 * 256, b0, 32 * 256, 4, acc);
        const int c0 = t * 128 + wc * 64;
        float invf[4];
#pragma unroll
        for (int j = 0; j < 4; ++j) invf[j] = __builtin_amdgcn_exp2f(-(float)((fq & 1) * 4 + j) * (13.287712379549449f / 8.f));
#pragma unroll
        for (int m = 0; m < 4; ++m) {
          const int rl = wr * 64 + m * 16 + fr;
          const float rs = rstd[rl];
          const int tpos = (m0 + rl) & (S_ - 1);
#pragma unroll
          for (int n = 0; n < 4; ++n) {
            acc[m][n] = acc[m][n] * rs;
            const int w96 = (c0 + n * 16) % 96;
            if (lat && w96 >= 64) {
              const float pos = (w96 == 64) ? (float)(tpos >> 6) : (float)(tpos & 63);
#pragma unroll
              for (int j = 0; j < 4; ++j) {
                float sn, cs; sincos_rev(pos, invf[j], sn, cs);
                const float v = acc[m][n][j], pr = __shfl_xor(v, 32);
                acc[m][n][j] = (fq & 2) ? v * cs + pr * sn : v * cs - pr * sn;
              }
            }
            stage_put4(lds + 32768 + wid * 8192, m * 16 + fr, n * 4 + fq, acc[m][n]);
          }
        }
        stage_flush<64>(lds + 32768 + wid * 8192, MLQ + (size_t)(m0 + wr * 64) * 384 + c0, 384, lane_o);
      }
    } else {
      {
        const u16* b0 = WinT + (size_t)(1536 + r0) * 1024 + ch;
        gemm_tile(lds, a0, 32 * 1024, b0, 32 * 1024, 16, acc);
        epi_inproj<false>(p, layer, acc, m0, 24 + wc, wr, fr, fq, rowss + wc * 128, nullptr, lds + 32768 + wid * 8192, lane_o);
        const u16* b2 = WinT + (size_t)(1664 + r0) * 1024 + ch;
        gemm_tile(lds, a0, 32 * 1024, b2, 32 * 1024, 16, acc);
        epi_inproj<false>(p, layer, acc, m0, 26 + wc, wr, fr, fq, rowss, nullptr, lds + 32768 + wid * 8192, lane_o);
      }
      __syncthreads();
      if (tid < 128) rstd[tid] = rsqrtf((rowss[tid] + rowss[128 + tid]) * (1.f / 128.f) + EPS);
      __syncthreads();
      const u16* KL = (const u16*)(ws + OFF_KVLAT);
      const u16* ka0 = KL + (size_t)(m0 + r0) * 128 + ch;
#pragma unroll 1
      for (int t = 0; t < 4; ++t) {
        const u16* b0 = WukvT + (size_t)(t * 128 + r0) * 128 + ch;
        gemm_tile(lds, ka0, 32 * 128, b0, 32 * 128, 2, acc);
        u16* dst = (u16*)(ws + (wc == 0 ? OFF_MLK : OFF_MLV));
#pragma unroll
        for (int m = 0; m < 4; ++m) {
          const int rl = wr * 64 + m * 16 + fr;
          const float rs = rstd[rl];
#pragma unroll
          for (int n = 0; n < 4; ++n) { acc[m][n] = acc[m][n] * rs; stage_put4(lds + 32768 + wid * 8192, m * 16 + fr, n * 4 + fq, acc[m][n]); }
        }
        stage_flush<64>(lds + 32768 + wid * 8192, dst + (size_t)(m0 + wr * 64) * 256 + t * 64, 256, lane_o);
      }
    }
  }
}


namespace g8 {
constexpr int HTB = 16384;
DI int lds_byte(int r, int c) { const int st = (r >> 4) * 2 + (c >> 5), rr = r & 15, cc = c & 31, ob = rr * 64 + cc * 2; return st * 1024 + (ob ^ (((ob >> 9) & 1) << 5)); }
DI void stage_rc(int b, int& R, int& C) { const int st = b / 1024, sb = b % 1024, swz = sb ^ (((sb >> 9) & 1) << 5); R = (st >> 1) * 16 + swz / 64; C = (st & 1) * 32 + (swz % 64) / 2; }
struct Unit { const char* B; unsigned va[2][2]; int id; };
template <int K, class PH>
DI void gemm8(LAS char* lds, const PH& ph) {
  const int tid = opaque((int)threadIdx.x), wid = __builtin_amdgcn_readfirstlane(tid >> 6), lane = tid & 63, wr = wid >> 2, wc = wid & 3, fr = lane & 15, fq = lane >> 4;
  constexpr int nt = K / 64;
  int sr[2], sc[2]; unsigned voffB[2];
#pragma unroll
  for (int i = 0; i < 2; ++i) { stage_rc(tid * 16 + i * 8192, sr[i], sc[i]); const int Rb = 64 * (sr[i] >> 5) + (sr[i] & 31); voffB[i] = (unsigned)(Rb * K + sc[i]) * 2u; }
  constexpr int hstepB = 32 * K * 2;
  const unsigned ldsw = (unsigned)wid * 1024u;
  const int aoff = lds_byte(wr * 64 + fr, fq * 8), boff = lds_byte(wc * 32 + fr, fq * 8);
  const char* Ab = ph.abase();
#define G8_SA(b, h) (((b) * 2 + (h)) * g8::HTB)
#define G8_SB(b, h) ((4 + (b) * 2 + (h)) * g8::HTB)
#define G8_STAGE(bufoff, gbase, v0, v1) do { \
    __builtin_amdgcn_global_load_lds((const unsigned*)((gbase) + (v0)), (LAS unsigned*)(lds + (bufoff) + ldsw), 16, 0, 0); \
    __builtin_amdgcn_global_load_lds((const unsigned*)((gbase) + (v1)), (LAS unsigned*)(lds + (bufoff) + ldsw + 8192), 16, 0, 0); } while (0)
#define G8_STA(b, h, kt, V) G8_STAGE(G8_SA(b, h), Ab + (size_t)(kt) * 128, (V)[h][0], (V)[h][1])
#define G8_STB(b, h, Bp, kt) G8_STAGE(G8_SB(b, h), (Bp) + (size_t)(kt) * 128 + (h) * hstepB, voffB[0], voffB[1])
#define G8_LDA(dst, b, h) do { _Pragma("unroll") for (int m = 0; m < 4; ++m) _Pragma("unroll") for (int k = 0; k < 2; ++k) dst[m][k] = *(const LAS bf16x8*)(lds + G8_SA(b, h) + aoff + m * 2048 + k * 1024); } while (0)
#define G8_LDB(dst, b, h) do { _Pragma("unroll") for (int n = 0; n < 2; ++n) _Pragma("unroll") for (int k = 0; k < 2; ++k) dst[n][k] = *(const LAS bf16x8*)(lds + G8_SB(b, h) + boff + n * 2048 + k * 1024); } while (0)
#define G8_MMA(ai, bj, At, Bt) do { __builtin_amdgcn_s_setprio(1); _Pragma("unroll") for (int m = 0; m < 4; ++m) _Pragma("unroll") for (int n = 0; n < 2; ++n) _Pragma("unroll") for (int k = 0; k < 2; ++k) \
    acc[ai][m][2 * (bj) + n] = __builtin_amdgcn_mfma_f32_16x16x32_bf16(Bt[n][k], At[m][k], acc[ai][m][2 * (bj) + n], 0, 0, 0); __builtin_amdgcn_s_setprio(0); } while (0)
#define G8_WAIT_V(n) asm volatile("s_waitcnt vmcnt(" #n ")" ::: "memory")
#define G8_WAIT_L(n) asm volatile("s_waitcnt lgkmcnt(" #n ")" ::: "memory")
#define G8_BAR __builtin_amdgcn_s_barrier()
#define G8_SCHED __builtin_amdgcn_sched_barrier(0)
  Unit cur, nxt; int ui = 0;
  if (!ph.unit(0, cur, sr, sc)) return;
  f32x4 acc[2][4][4];
#pragma unroll
  for (int a = 0; a < 2; ++a)
#pragma unroll
    for (int m = 0; m < 4; ++m)
#pragma unroll
      for (int n = 0; n < 4; ++n) acc[a][m][n] = (f32x4){0.f, 0.f, 0.f, 0.f};
  bf16x8 At[4][2], B0[2][2], B1[2][2];
  G8_STB(0, 0, cur.B, 0); G8_STA(0, 0, 0, cur.va); G8_STB(0, 1, cur.B, 0); G8_STA(0, 1, 0, cur.va);
  if (wr == 1) G8_BAR;
  G8_WAIT_V(4); G8_BAR;
  G8_STB(1, 0, cur.B, 1); G8_STA(1, 0, 1, cur.va); G8_STB(1, 1, cur.B, 1);
  G8_WAIT_V(6); G8_BAR;
  for (;;) {
    const bool has_next = ph.unit(ui + 1, nxt, sr, sc);
    if (!has_next) nxt = cur;
#pragma unroll 1
    for (int t = 0; t < nt; t += 2) {
      const bool last = (t == nt - 2);
      const char* B2 = last ? nxt.B : cur.B;
      const int k2 = last ? 0 : t + 2, k3 = k2 + 1;
      unsigned v2[2][2];
#pragma unroll
      for (int h = 0; h < 2; ++h)
#pragma unroll
        for (int i = 0; i < 2; ++i) v2[h][i] = last ? nxt.va[h][i] : cur.va[h][i];
      G8_LDB(B0, 0, 0); G8_SCHED; G8_LDA(At, 0, 0); G8_STA(1, 1, t + 1, cur.va);
      G8_WAIT_L(8); G8_BAR; G8_WAIT_L(0); G8_MMA(0, 0, At, B0); G8_BAR; G8_SCHED;
      G8_LDB(B1, 0, 1); G8_STB(0, 0, B2, k2);
      G8_BAR; G8_WAIT_L(0); G8_MMA(0, 1, At, B1); G8_BAR;
      G8_LDA(At, 0, 1); G8_STA(0, 0, k2, v2);
      G8_BAR; G8_WAIT_L(0); G8_MMA(1, 0, At, B0); G8_BAR; G8_SCHED;
      G8_STB(0, 1, B2, k2);
      G8_WAIT_V(6); G8_BAR; G8_MMA(1, 1, At, B1); G8_BAR;
      G8_LDB(B0, 1, 0); G8_SCHED; G8_LDA(At, 1, 0); G8_STA(0, 1, k2, v2);
      G8_WAIT_L(8); G8_BAR; G8_WAIT_L(0); G8_MMA(0, 0, At, B0); G8_BAR; G8_SCHED;
      G8_LDB(B1, 1, 1); G8_STB(1, 0, B2, k3);
      G8_BAR; G8_WAIT_L(0); G8_MMA(0, 1, At, B1); G8_BAR;
      G8_LDA(At, 1, 1); G8_STA(1, 0, k3, v2);
      G8_BAR; G8_WAIT_L(0); G8_MMA(1, 0, At, B0); G8_BAR; G8_SCHED;
      G8_STB(1, 1, B2, k3);
      G8_WAIT_V(6); G8_BAR; G8_MMA(1, 1, At, B1); G8_BAR;
    }
    ph.epi(acc, cur, wid, lane);
    if (!has_next) break;
#pragma unroll
    for (int a = 0; a < 2; ++a)
#pragma unroll
      for (int m = 0; m < 4; ++m)
#pragma unroll
        for (int n = 0; n < 4; ++n) acc[a][m][n] = (f32x4){0.f, 0.f, 0.f, 0.f};
    cur = nxt; ++ui;
  }
  G8_WAIT_V(0);
  if (wr == 0) G8_BAR;
  G8_BAR;
#undef G8_SA
#undef G8_SB
#undef G8_STAGE
#undef G8_STA
#undef G8_STB
#undef G8_LDA
#undef G8_LDB
#undef G8_MMA
#undef G8_WAIT_V
#undef G8_WAIT_L
#undef G8_BAR
#undef G8_SCHED
}
DI int unit_id(int i) { return (int)((blockIdx.x & 7) * (gridDim.x >> 3) + (blockIdx.x >> 3)) + i * (int)gridDim.x; }
}

struct P4Phase {
  const u16* Y; const u16* WoT; const float* MODl; u16* DELTA; int nunits; LAS char* lds;
  DI const char* abase() const { return (const char*)Y; }
  DI bool unit(int i, g8::Unit& u, const int (&sr)[2], const int (&sc)[2]) const {
    const int id = g8::unit_id(i); if (id >= nunits) return false;
    const int rt = id >> 2, pn = id & 3;
    u.id = id; u.B = (const char*)(WoT + (size_t)pn * 256 * 1024);
#pragma unroll
    for (int h = 0; h < 2; ++h)
#pragma unroll
      for (int j = 0; j < 2; ++j) u.va[h][j] = (unsigned)((rt * 256 + h * 128 + sr[j]) * 1024 + sc[j]) * 2u;
    return true;
  }
  DI void epi(f32x4 (&acc)[2][4][4], const g8::Unit& u, int wid, int lane_) const {
    const int lane = opaque(lane_);
    const int wr = wid >> 2, wc = wid & 3, fr = lane & 15, fq = lane >> 4;
    const int rt = u.id >> 2, pn = u.id & 3, m0 = rt * 256;
    const int mr = m0 < NL ? m0 / S_ : 8;
    const float* gate = MODl + (size_t)mr * 6144 + 2 * 1024 + pn * 256 + wc * 64 + fq * 4;
    f32x4 g[4];
#pragma unroll
    for (int n = 0; n < 4; ++n) g[n] = *(const f32x4*)(gate + n * 16);
    LAS char* stg = lds + LDS_ESTG + wid * 2048;
#pragma unroll
    for (int ai = 0; ai < 2; ++ai)
#pragma unroll
      for (int m = 0; m < 4; ++m) {
#pragma unroll
        for (int n = 0; n < 4; ++n) stage_put4(stg, fr, n * 4 + fq, g[n] * acc[ai][m][n]);
        flush16<64>(stg, DELTA + (size_t)(m0 + ai * 128 + wr * 64 + m * 16) * 1024 + pn * 256 + wc * 64, 1024, lane);
      }
  }
};
DI void p4_outproj8(const Params& p, int layer, int nrows, LAS char* lds) {
  P4Phase ph;
  ph.Y = (const u16*)(p.ws + OFF_Y); ph.WoT = (const u16*)(p.ws + OFF_WO) + (size_t)layer * 1024 * 1024;
  ph.MODl = (const float*)(p.ws + OFF_MOD) + (size_t)layer * 9 * 6144; ph.DELTA = (u16*)(p.ws + OFF_DELTA);
  ph.nunits = (nrows / 256) * 4; ph.lds = lds;
  __syncthreads();
  g8::gemm8<1024>(lds, ph);
  __syncthreads();
}


struct P6Phase {
  const u16 *H, *WguT, *SguT; const int* list; const unsigned* cnt; u16 *ACT, *ACTS; int tb[NE + 1]; int R, nunits; LAS char* lds;
  DI const char* abase() const { return (const char*)H; }
  DI bool unit(int i, g8::Unit& u, const int (&sr)[2], const int (&sc)[2]) const {
    const int id = g8::unit_id(i); if (id >= nunits) return false;
    const int rt = id >> 2, pn = id & 3;
    u.id = id;
    if (rt < R) {
      int e = 0, tbe = 0;
#pragma unroll
      for (int q = 1; q < NE; ++q) if (rt >= tb[q]) { e = q; tbe = tb[q]; }
      const int i0 = (rt - tbe) * 256, ce = (int)cnt[e * CNT_STRIDE];
      const int* lp = list + (size_t)e * NT + i0;
#pragma unroll
      for (int h = 0; h < 2; ++h)
#pragma unroll
        for (int j = 0; j < 2; ++j) { const int ix = h * 128 + sr[j]; const int tok = i0 + ix < ce ? lp[ix] : 0; u.va[h][j] = (unsigned)(tok * 1024 + sc[j]) * 2u; }
      u.B = (const char*)(WguT + ((size_t)e * 1024 + pn * 256) * 1024);
    } else {
      const int m0 = (rt - R) * 256;
#pragma unroll
      for (int h = 0; h < 2; ++h)
#pragma unroll
        for (int j = 0; j < 2; ++j) u.va[h][j] = (unsigned)((m0 + h * 128 + sr[j]) * 1024 + sc[j]) * 2u;
      u.B = (const char*)(SguT + (size_t)pn * 256 * 1024);
    }
    return true;
  }
  DI void epi(f32x4 (&acc)[2][4][4], const g8::Unit& u, int wid, int lane_) const {
    const int lane = opaque(lane_);
    const int wr = wid >> 2, wc = wid & 3, fr = lane & 15, fq = lane >> 4;
    const int rt = u.id >> 2, pn = u.id & 3;
    u16* dst; size_t orow;
    if (rt < R) { dst = ACT; orow = (size_t)rt * 256; } else { dst = ACTS; orow = (size_t)(rt - R) * 256; }
    LAS char* stg = lds + LDS_ESTG + wid * 2048;
#pragma unroll
    for (int ai = 0; ai < 2; ++ai)
#pragma unroll
      for (int m = 0; m < 4; ++m) {
#pragma unroll
        for (int n = 0; n < 2; ++n) {
          f32x4 r;
#pragma unroll
          for (int j = 0; j < 4; ++j) r[j] = silu(acc[ai][m][n][j]) * acc[ai][m][n + 2][j];
          stage_put4(stg, fr, n * 4 + fq, r);
        }
        flush16<32>(stg, dst + (orow + ai * 128 + wr * 64 + m * 16) * 512 + pn * 128 + wc * 32, 512, lane);
      }
  }
};
DI void p6_gateup8(const Params& p, int layer, int nrows, LAS char* lds) {
  P6Phase ph;
  ph.H = (const u16*)(p.ws + OFF_H); ph.WguT = (const u16*)(p.ws + OFF_WGU) + (size_t)layer * NE * 1024 * 1024; ph.SguT = (const u16*)(p.ws + OFF_SGU) + (size_t)layer * 1024 * 1024;
  ph.list = (const int*)(p.ws + OFF_LIST); ph.cnt = (const unsigned*)(p.ws + OFF_CTRL) + CW_CNT + layer * 16 * CNT_STRIDE;
  ph.ACT = (u16*)(p.ws + OFF_ACT); ph.ACTS = (u16*)(p.ws + OFF_ACTS);
  seg_scan(p, layer, ph.tb); ph.R = ph.tb[NE]; ph.nunits = (ph.R + nrows / 256) * 4; ph.lds = lds;
  __syncthreads();
  g8::gemm8<1024>(lds, ph);
  __syncthreads();
}
struct P7Phase {
  const u16 *ACT, *WdT, *SdT; u16 *YEXP, *YSH; int tb[NE + 1]; int R, nunits; LAS char* lds;
  DI const char* abase() const { return (const char*)ACT; }
  DI bool unit(int i, g8::Unit& u, const int (&sr)[2], const int (&sc)[2]) const {
    const int id = g8::unit_id(i); if (id >= nunits) return false;
    const int rt = id >> 2, pn = id & 3;
    u.id = id;
    if (rt < R) {
      int e = 0;
#pragma unroll
      for (int q = 1; q < NE; ++q) if (rt >= tb[q]) e = q;
#pragma unroll
      for (int h = 0; h < 2; ++h)
#pragma unroll
        for (int j = 0; j < 2; ++j) u.va[h][j] = (unsigned)((rt * 256 + h * 128 + sr[j]) * 512 + sc[j]) * 2u;
      u.B = (const char*)(WdT + ((size_t)e * 1024 + pn * 256) * 512);
    } else {
      const int m0 = (rt - R) * 256;
#pragma unroll
      for (int h = 0; h < 2; ++h)
#pragma unroll
        for (int j = 0; j < 2; ++j) u.va[h][j] = (unsigned)(OFF_ACTS - OFF_ACT) + (unsigned)((m0 + h * 128 + sr[j]) * 512 + sc[j]) * 2u;
      u.B = (const char*)(SdT + (size_t)pn * 256 * 512);
    }
    return true;
  }
  DI void epi(f32x4 (&acc)[2][4][4], const g8::Unit& u, int wid, int lane_) const {
    const int lane = opaque(lane_);
    const int wr = wid >> 2, wc = wid & 3, fr = lane & 15, fq = lane >> 4;
    const int rt = u.id >> 2, pn = u.id & 3;
    u16* dst; size_t orow;
    if (rt < R) { dst = YEXP; orow = (size_t)rt * 256; } else { dst = YSH; orow = (size_t)(rt - R) * 256; }
    LAS char* stg = lds + LDS_ESTG + wid * 2048;
#pragma unroll
    for (int ai = 0; ai < 2; ++ai)
#pragma unroll
      for (int m = 0; m < 4; ++m) {
#pragma unroll
        for (int n = 0; n < 4; ++n) stage_put4(stg, fr, n * 4 + fq, acc[ai][m][n]);
        flush16<64>(stg, dst + (orow + ai * 128 + wr * 64 + m * 16) * 1024 + pn * 256 + wc * 64, 1024, lane);
      }
  }
};
DI void p7_down8(const Params& p, int layer, int nrows, LAS char* lds) {
  P7Phase ph;
  ph.ACT = (const u16*)(p.ws + OFF_ACT); ph.WdT = (const u16*)(p.ws + OFF_WD) + (size_t)layer * NE * 1024 * 512; ph.SdT = (const u16*)(p.ws + OFF_SD) + (size_t)layer * 1024 * 512;
  ph.YEXP = (u16*)(p.ws + OFF_YEXP); ph.YSH = (u16*)(p.ws + OFF_YSH);
  seg_scan(p, layer, ph.tb); ph.R = ph.tb[NE]; ph.nunits = (ph.R + nrows / 256) * 4; ph.lds = lds;
  __syncthreads();
  g8::gemm8<512>(lds, ph);
  __syncthreads();
}


struct P2Phase {
  const Params* pp; int layer; const u16 *H, *WinT; float* ROWSS; LAS char* lds;
  DI const char* abase() const { return (const char*)H; }
  DI bool unit(int i, g8::Unit& u, const int (&sr)[2], const int (&sc)[2]) const {
    const int id = g8::unit_id(i); if (id >= (NT / 256) * 7) return false;
    const int rt = id / 7, pn = id - rt * 7;
    u.id = id; u.B = (const char*)(WinT + (size_t)pn * 256 * 1024);
#pragma unroll
    for (int h = 0; h < 2; ++h)
#pragma unroll
      for (int j = 0; j < 2; ++j) u.va[h][j] = (unsigned)((rt * 256 + h * 128 + sr[j]) * 1024 + sc[j]) * 2u;
    return true;
  }
  DI void epi(f32x4 (&acc)[2][4][4], const g8::Unit& u, int wid, int lane_) const {
    const int lane = opaque(lane_);
    const int wr = wid >> 2, wc = wid & 3, fr = lane & 15, fq = lane >> 4;
    const int rt = u.id / 7, pn = u.id - rt * 7;
    LAS char* stg = lds + LDS_ESTG + wid * 2048;
#pragma unroll
    for (int ai = 0; ai < 2; ++ai) { epi_inproj<true>(*pp, layer, acc[ai], rt * 256 + ai * 128, pn * 4 + wc, wr, opaque(fr), opaque(fq), nullptr, ROWSS, stg, opaque(lane)); __builtin_amdgcn_sched_barrier(0); }
  }
};
DI void p2b_upproj(const Params& p, int layer, LAS char* ldsr) {
  char* ws = p.ws;
  LAS char* lds = ldsr + VHALF * LDS_HALF;
  const u16* WuqT = (const u16*)(ws + OFF_WUQ) + (size_t)layer * 384 * 256;
  const u16* WukvT = (const u16*)(ws + OFF_WUKV) + (size_t)layer * 512 * 128;
  const float* ROWSS = (const float*)(ws + OFF_ROWSS);
  const int tid = opaque(VTID), lane = tid & 63, wid = tid >> 6, wr = wid >> 1, wc = wid & 1;
  LAS float* rstd = (LAS float*)(lds + LDS_MISC + 2048);
  f32x4 acc[4][4];
  const int hf = opaque(VHALF);
  for (int pu = blockIdx.x; pu < (NT / 256) * 7; pu += gridDim.x) {
    const int tid_o = opaque(tid), lane_o = tid_o & 63;
    const int fr = lane_o & 15, fq = lane_o >> 4, ch = gt_chunk(tid_o), r0 = gt_row0(tid_o);
    const int pr = pu / 7, t = pu - pr * 7;
    const int m0 = (pr * 2 + hf) * 128;
    __syncthreads();
    if (t < 3) { if (tid < 128) rstd[tid] = rsqrtf((ROWSS[m0 + tid] + ROWSS[NT + m0 + tid] + ROWSS[2 * NT + m0 + tid] + ROWSS[3 * NT + m0 + tid]) * (1.f / 256.f) + EPS); }
    else { if (tid < 128) rstd[tid] = rsqrtf((ROWSS[4 * NT + m0 + tid] + ROWSS[5 * NT + m0 + tid]) * (1.f / 128.f) + EPS); }
    __syncthreads();
    if (t < 3) {
      const u16* qa0 = (const u16*)(ws + OFF_QLAT) + (size_t)(m0 + r0) * 256 + ch;
      u16* MLQ = (u16*)(ws + OFF_MLQ);
      const bool lat = m0 < NL;
      const u16* b0 = WuqT + (size_t)(t * 128 + r0) * 256 + ch;
      gemm_tile(lds, qa0, 32 * 256, b0, 32 * 256, 4, acc);
      const int c0 = t * 128 + wc * 64;
      float invf[4];
#pragma unroll
      for (int j = 0; j < 4; ++j) invf[j] = __builtin_amdgcn_exp2f(-(float)((fq & 1) * 4 + j) * (13.287712379549449f / 8.f));
#pragma unroll
      for (int m = 0; m < 4; ++m) {
        const int rl = wr * 64 + m * 16 + fr;
        const float rs = rstd[rl];
        const int tpos = (m0 + rl) & (S_ - 1);
#pragma unroll
        for (int n = 0; n < 4; ++n) {
          acc[m][n] = acc[m][n] * rs;
          const int w96 = (c0 + n * 16) % 96;
          if (lat && w96 >= 64) {
            const float pos = (w96 == 64) ? (float)(tpos >> 6) : (float)(tpos & 63);
#pragma unroll
            for (int j = 0; j < 4; ++j) {
              float sn, cs; sincos_rev(pos, invf[j], sn, cs);
              const float v = acc[m][n][j], prr = __shfl_xor(v, 32);
              acc[m][n][j] = (fq & 2) ? v * cs + prr * sn : v * cs - prr * sn;
            }
          }
          stage_put4(lds + 32768 + wid * 8192, m * 16 + fr, n * 4 + fq, acc[m][n]);
        }
      }
      stage_flush<64>(lds + 32768 + wid * 8192, MLQ + (size_t)(m0 + wr * 64) * 384 + c0, 384, lane_o);
    } else {
      const int tk = t - 3;
      const u16* ka0 = (const u16*)(ws + OFF_KVLAT) + (size_t)(m0 + r0) * 128 + ch;
      const u16* b0 = WukvT + (size_t)(tk * 128 + r0) * 128 + ch;
      gemm_tile(lds, ka0, 32 * 128, b0, 32 * 128, 2, acc);
      u16* dst = (u16*)(ws + (wc == 0 ? OFF_MLK : OFF_MLV));
#pragma unroll
      for (int m = 0; m < 4; ++m) {
        const int rl = wr * 64 + m * 16 + fr;
        const float rs = rstd[rl];
#pragma unroll
        for (int n = 0; n < 4; ++n) { acc[m][n] = acc[m][n] * rs; stage_put4(lds + 32768 + wid * 8192, m * 16 + fr, n * 4 + fq, acc[m][n]); }
      }
      stage_flush<64>(lds + 32768 + wid * 8192, dst + (size_t)(m0 + wr * 64) * 256 + tk * 64, 256, lane_o);
    }
  }
  __syncthreads();
}
DI void p2_inproj8(const Params& p, int layer, LAS char* lds) {
  P2Phase ph;
  ph.pp = &p; ph.layer = layer; ph.H = (const u16*)(p.ws + OFF_H); ph.WinT = (const u16*)(p.ws + OFF_WIN) + (size_t)layer * INWP * 1024;
  ph.ROWSS = (float*)(p.ws + OFF_ROWSS); ph.lds = lds;
  __syncthreads();
  g8::gemm8<1024>(lds, ph);
  __syncthreads();
}

DI void p4_outproj(const Params& p, int layer, int nrows, LAS char* ldsr, int cs = 0) {
  char* ws = p.ws;
  LAS char* lds = ldsr + VHALF * LDS_HALF;
  const u16* Y = (const u16*)(ws + OFF_Y);
  const u16* WoT = (const u16*)(ws + OFF_WO) + (size_t)layer * 1024 * 1024;
  const float* MODl = (const float*)(ws + OFF_MOD) + (size_t)layer * 9 * 6144;
  const int tid = opaque(VTID), wid = tid >> 6, wr = wid >> 1, wc = wid & 1;
  const int nunits = (nrows / 128) * 8;
  f32x4 acc[4][4];
  __syncthreads();
  TilePtrs cur, nxt;
  const int vb = VBID, vg = VGRID;
  int u = ((vb >> 1) & 7) * (vg >> 3) + (vb >> 4) * 2 + (vb & 1);
  int uo = ((vb >> 1) & 7) * (vg >> 3) + (vb >> 4) * 2 + ((vb & 1) ^ 1);
#define P4_DESC(T, uu) do { const int _t = opaque(tid); const int _ch = gt_chunk(_t), _r0 = gt_row0(_t); const int _rt = (uu) >> 3, _ct = (uu) & 7; \
    (T).a0 = Y + (size_t)(_rt * 128 + _r0) * 1024 + _ch; (T).a1 = (T).a0 + 32 * 1024; (T).a2 = (T).a0 + 64 * 1024; (T).a3 = (T).a0 + 96 * 1024; \
    (T).b0 = WoT + (size_t)(_ct * 128 + _r0) * 1024 + _ch; (T).ldb32 = 32 * 1024; } while (0)
  bool issued = false;
  P4_DESC(cur, u < nunits ? u : 0);
  while (u < nunits || uo < nunits) {
    const bool act = u < nunits;
    const int un = u + vg;
    const bool hn = un < nunits;
    if (hn) P4_DESC(nxt, un); else nxt = cur;
    gemm_tile_s(lds, cur, issued, nxt, hn, 16, acc);
    issued = hn;
    const int tid_o = opaque(tid), lane_o = tid_o & 63;
    const int fr = lane_o & 15, fq = lane_o >> 4;
    const int rt = u >> 3, ct = u & 7, m0 = rt * 128;
    const int mr = m0 < NL ? m0 / S_ : 8;
    const float* gate = MODl + (size_t)mr * 6144 + 2 * 1024 + ct * 128 + wc * 64 + fq * 4;
    __syncthreads();
    LAS char* stg = lds + 32768 + wid * 8192;
#pragma unroll
    for (int n = 0; n < 4; ++n) {
      const f32x4 g = *(const f32x4*)(gate + n * 16);
#pragma unroll
      for (int m = 0; m < 4; ++m) stage_put4(stg, m * 16 + fr, n * 4 + fq, g * acc[m][n]);
    }
    if (act) { const int grow = m0 + wr * 64, gcol = ct * 128 + wc * 64;
      u16* xb = (u16*)(ws + OFF_XB) + (size_t)grow * 1024 + gcol;
      if (layer == 0) stage_flush_resid<true>(stg, (grow < NL ? p.x + (size_t)grow * 1024 : p.ctx + (size_t)(grow - NL) * 1024) + gcol, xb, lane_o);
      else stage_flush_resid<false>(stg, nullptr, xb, lane_o); }
    cur = nxt; u = un; uo += vg;
  }
#undef P4_DESC
  __syncthreads();
}

DI void p6_gateup(const Params& p, int layer, int nrows, LAS char* ldsr, int cs = 0) {
  char* ws = p.ws;
  LAS char* lds = ldsr + VHALF * LDS_HALF;
  const unsigned* cnt = (const unsigned*)(ws + OFF_CTRL) + CW_CNT + layer * 16 * CNT_STRIDE;
  const u16* H = (const u16*)(ws + OFF_H);
  const int* list = (const int*)(ws + OFF_LIST);
  const u16* WguT = (const u16*)(ws + OFF_WGU) + (size_t)layer * NE * 1024 * 1024;
  const u16* SguT = (const u16*)(ws + OFF_SGU) + (size_t)layer * 1024 * 1024;
  u16* ACT = (u16*)(ws + OFF_ACT); u16* ACTS = (u16*)(ws + OFF_ACTS);
  const int tid = opaque(VTID), wid = tid >> 6, wr = wid >> 1, wc = wid & 1;
  int tb[NE + 1]; seg_scan(p, layer, tb);
  const int R = tb[NE];
  const int nunits = (R + nrows / 128) * 8;
  f32x4 acc[4][4];
  __syncthreads();
  TilePtrs cur, nxt;
#define P6_DESC(T, uu) do { const int _t = opaque(tid); const int _ch = gt_chunk(_t), _r0 = gt_row0(_t); const int _rt = (uu) >> 3, _ct = (uu) & 7; \
    if (_rt < R) { int _e = 0, _tbe = 0; _Pragma("unroll") for (int q = 1; q < NE; ++q) if (_rt >= tb[q]) { _e = q; _tbe = tb[q]; } \
      const int _i = _rt - _tbe, _ce = (int)cnt[_e * CNT_STRIDE]; const int _i0 = _i * 128 + _r0; const int* _lp = list + (size_t)_e * NT + _i0; \
      const int _t0 = _i0 < _ce ? _lp[0] : 0, _t1 = _i0 + 32 < _ce ? _lp[32] : 0, _t2 = _i0 + 64 < _ce ? _lp[64] : 0, _t3 = _i0 + 96 < _ce ? _lp[96] : 0; \
      (T).a0 = H + (size_t)_t0 * 1024 + _ch; (T).a1 = H + (size_t)_t1 * 1024 + _ch; (T).a2 = H + (size_t)_t2 * 1024 + _ch; (T).a3 = H + (size_t)_t3 * 1024 + _ch; \
      (T).b0 = WguT + ((size_t)_e * 1024 + _ct * 128 + _r0) * 1024 + _ch; } \
    else { const int _m0 = (_rt - R) * 128; (T).a0 = H + (size_t)(_m0 + _r0) * 1024 + _ch; (T).a1 = (T).a0 + 32 * 1024; (T).a2 = (T).a0 + 64 * 1024; (T).a3 = (T).a0 + 96 * 1024; \
      (T).b0 = SguT + (size_t)(_ct * 128 + _r0) * 1024 + _ch; } \
    (T).ldb32 = 32 * 1024; } while (0)
  const int vb = VBID, vg = VGRID;
  int u = ((vb >> 1) & 7) * (vg >> 3) + (vb >> 4) * 2 + (vb & 1);
  int uo = ((vb >> 1) & 7) * (vg >> 3) + (vb >> 4) * 2 + ((vb & 1) ^ 1);
  bool issued = false;
  P6_DESC(cur, u < nunits ? u : 0);
  while (u < nunits || uo < nunits) {
    const bool act = u < nunits;
    const int un = u + vg;
    const bool hn = un < nunits;
    if (hn) P6_DESC(nxt, un); else nxt = cur;
    gemm_tile_s(lds, cur, issued, nxt, hn, 16, acc);
    issued = hn;
    const int tid_o = opaque(tid), lane_o = tid_o & 63;
    const int fr = lane_o & 15, fq = lane_o >> 4;
    const int rt = u >> 3, ct = u & 7;
    u16* dst; size_t orow;
    if (rt < R) { dst = ACT; orow = (size_t)rt * 128; } else { dst = ACTS; orow = (size_t)(rt - R) * 128; }
    __syncthreads();
    LAS char* stg = lds + 32768 + wid * 8192;
#pragma unroll
    for (int m = 0; m < 4; ++m)
#pragma unroll
      for (int n = 0; n < 2; ++n) {
        f32x4 r;
#pragma unroll
        for (int j = 0; j < 4; ++j) r[j] = silu(acc[m][n][j]) * acc[m][n + 2][j];
        stage_put4(stg, m * 16 + fr, n * 4 + fq, r);
      }
    if (act) stage_flush<32>(stg, dst + (orow + wr * 64) * 512 + ct * 64 + wc * 32, 512, lane_o);
    cur = nxt; u = un; uo += vg;
  }
#undef P6_DESC
  __syncthreads();
}

DI void p7_down(const Params& p, int layer, int nrows, LAS char* ldsr, int cs = 0) {
  char* ws = p.ws;
  LAS char* lds = ldsr + VHALF * LDS_HALF;
  const u16* WdT = (const u16*)(ws + OFF_WD) + (size_t)layer * NE * 1024 * 512;
  const u16* SdT = (const u16*)(ws + OFF_SD) + (size_t)layer * 1024 * 512;
  const u16* ACT = (const u16*)(ws + OFF_ACT); const u16* ACTS = (const u16*)(ws + OFF_ACTS);
  u16* YEXP = (u16*)(ws + OFF_YEXP); u16* YSH = (u16*)(ws + OFF_YSH);
  const int tid = opaque(VTID), wid = tid >> 6, wr = wid >> 1, wc = wid & 1;
  int tb[NE + 1]; seg_scan(p, layer, tb);
  const int R = tb[NE];
  const int nunits = (R + nrows / 128) * 8;
  f32x4 acc[4][4];
  __syncthreads();
  TilePtrs cur, nxt;
#define P7_DESC(T, uu) do { const int _t = opaque(tid); const int _ch = gt_chunk(_t), _r0 = gt_row0(_t); const int _rt = (uu) >> 3, _ct = (uu) & 7; \
    if (_rt < R) { int _e = 0; _Pragma("unroll") for (int q = 1; q < NE; ++q) if (_rt >= tb[q]) _e = q; \
      (T).a0 = ACT + ((size_t)_rt * 128 + _r0) * 512 + _ch; (T).b0 = WdT + ((size_t)_e * 1024 + _ct * 128 + _r0) * 512 + _ch; } \
    else { const int _m0 = (_rt - R) * 128; (T).a0 = ACTS + (size_t)(_m0 + _r0) * 512 + _ch; (T).b0 = SdT + (size_t)(_ct * 128 + _r0) * 512 + _ch; } \
    (T).a1 = (T).a0 + 32 * 512; (T).a2 = (T).a0 + 64 * 512; (T).a3 = (T).a0 + 96 * 512; (T).ldb32 = 32 * 512; } while (0)
  const int vb = VBID, vg = VGRID;
  int u = ((vb >> 1) & 7) * (vg >> 3) + (vb >> 4) * 2 + (vb & 1);
  int uo = ((vb >> 1) & 7) * (vg >> 3) + (vb >> 4) * 2 + ((vb & 1) ^ 1);
  bool issued = false;
  P7_DESC(cur, u < nunits ? u : 0);
  while (u < nunits || uo < nunits) {
    const bool act = u < nunits;
    const int un = u + vg;
    const bool hn = un < nunits;
    if (hn) P7_DESC(nxt, un); else nxt = cur;
    gemm_tile_s(lds, cur, issued, nxt, hn, 8, acc);
    issued = hn;
    const int tid_o = opaque(tid), lane_o = tid_o & 63;
    const int fr = lane_o & 15, fq = lane_o >> 4;
    const int rt = u >> 3, ct = u & 7;
    u16* dst; size_t orow;
    if (rt < R) { dst = YEXP; orow = (size_t)rt * 128; } else { dst = YSH; orow = (size_t)(rt - R) * 128; }
    __syncthreads();
    LAS char* stg = lds + 32768 + wid * 8192;
#pragma unroll
    for (int m = 0; m < 4; ++m)
#pragma unroll
      for (int n = 0; n < 4; ++n) stage_put4(stg, m * 16 + fr, n * 4 + fq, acc[m][n]);
    if (act) stage_flush<64>(stg, dst + (orow + wr * 64) * 1024 + ct * 128 + wc * 64, 1024, lane_o);
    cur = nxt; u = un; uo += vg;
  }
#undef P7_DESC
  __syncthreads();
}

typedef float f32x16 __attribute__((ext_vector_type(16)));
typedef short s16x4 __attribute__((ext_vector_type(4)));
DI s16x4 tr_read(const LAS char* a) { return __builtin_bit_cast(s16x4, __builtin_amdgcn_ds_read_tr16_b64_v4i16((LAS s16x4*)a)); }
DI float half_max(float m) { auto rr = __builtin_amdgcn_permlane32_swap(__float_as_uint(m), __float_as_uint(m), false, false); return fmaxf(__uint_as_float(rr[0]), __uint_as_float(rr[1])); }
DI float half_sum(float m) { auto rr = __builtin_amdgcn_permlane32_swap(__float_as_uint(m), __float_as_uint(m), false, false); return __uint_as_float(rr[0]) + __uint_as_float(rr[1]); }
DI bf16x8 pack8(const f32x16& x, int s8) {
  typedef unsigned u32x4 __attribute__((ext_vector_type(4)));
  u32x4 r;
  r[0] = cvtpk(x[s8 + 0], x[s8 + 1]); r[1] = cvtpk(x[s8 + 2], x[s8 + 3]); r[2] = cvtpk(x[s8 + 4], x[s8 + 5]); r[3] = cvtpk(x[s8 + 6], x[s8 + 7]);
  return __builtin_bit_cast(bf16x8, r);
}
constexpr int AT_STAGE = 20480;

DI float max3f(float a, float b, float c) { float r; asm("v_max3_f32 %0, %1, %2, %3" : "=v"(r) : "v"(a), "v"(b), "v"(c)); return r; }
template <bool MLA, bool SWA>
DI void attn_unit(const Params& p, int layer, int isctx, int b, int h, int qb, LAS char* lds) {
  char* ws = p.ws;
  const int tid = opaque((int)threadIdx.x), lane = tid & 63, wid = tid >> 6, r32 = lane & 31, hi = lane >> 5;
  const u16 *Qg, *Kg, *Vg; int ldq, ldk, qoff, koff, ycol; float cs;
  if (MLA) { Qg = (const u16*)(ws + OFF_MLQ); Kg = (const u16*)(ws + OFF_MLK); Vg = (const u16*)(ws + OFF_MLV); ldq = 384; ldk = 256; qoff = h * 96; koff = h * 64; ycol = 768 + h * 64; cs = 0.10206207261596575f * 1.4426950408889634f; }
  else if (!SWA) { Qg = (const u16*)(ws + OFF_GLQ); Kg = (const u16*)(ws + OFF_GLK); Vg = (const u16*)(ws + OFF_GLV); ldq = 384; ldk = 128; qoff = h * 64; koff = (h / 3) * 64; ycol = 384 + h * 64; cs = 0.125f * 1.4426950408889634f; }
  else { Qg = (const u16*)(ws + OFF_SWQ); Kg = (const u16*)(ws + OFF_SWK); Vg = (const u16*)(ws + OFF_SWV); ldq = 384; ldk = 128; qoff = h * 64; koff = (h / 3) * 64; ycol = h * 64; cs = 0.125f * 1.4426950408889634f; }
  const u16* Rg = (const u16*)(ws + OFF_MLKR);
  const int q0 = qb * 128;
  const int qrow0 = (isctx ? NL + b * C_ : b * S_) + q0;
  const int qw = q0 + wid * 32;
  int lat_first = 0, nlat = 0;
  if (!isctx) { if (SWA) { lat_first = 2 * qb - 2; if (lat_first < 0) lat_first = 0; int lat_last = 2 * qb + 3; if (lat_last > 63) lat_last = 63; nlat = lat_last - lat_first + 1; } else nlat = 64; }
  const int T = 4 + nlat;
  constexpr int NQ = MLA ? 6 : 4;
  bf16x8 qf[NQ];
  {
    const u16* qp = Qg + (size_t)(qrow0 + wid * 32 + r32) * ldq + qoff + hi * 8;
#pragma unroll
    for (int d0 = 0; d0 < NQ; ++d0) {
      const u32x4_t raw = *(const u32x4_t*)(qp + d0 * 16);
      u32x4_t sc;
#pragma unroll
      for (int i = 0; i < 4; ++i) sc[i] = cvtpk(bflo(raw[i]) * cs, bfhi(raw[i]) * cs);
      qf[d0] = __builtin_bit_cast(bf16x8, sc);
    }
  }
  int kaddr[4];
#pragma unroll
  for (int d0 = 0; d0 < 4; ++d0) kaddr[d0] = r32 * 128 + (((d0 * 2 + hi) ^ ((r32 >> 1) & 7)) * 16);
  int kraddr[2];
#pragma unroll
  for (int e = 0; e < 2; ++e) kraddr[e] = 16384 + r32 * 64 + (((e * 2 + hi) ^ ((r32 >> 3) & 3)) * 16);
  int vbo[2];
  {
    const int i16 = lane & 15, sw = (lane >> 3) & 1;
    const int x = ((lane >> 4) & 1) * 32 + (lane & 3) * 8;
    const int rowpart = ((i16 >> 2) + 4 * hi) * 128;
    vbo[0] = 8192 + rowpart + x + (sw * 64);
    vbo[1] = 8192 + rowpart + x + ((1 - sw) * 64);
  }
  const int skey = tid >> 3;
  const int kch = ((tid & 7) ^ ((tid >> 4) & 7)) * 8;
  const int vch = ((tid & 7) ^ (((tid >> 4) & 1) << 2)) * 8;
  const int rkey = tid >> 2, rch = ((tid & 3) ^ ((tid >> 5) & 3)) * 8;
  LAS char* ldst = lds + tid * 16;
#define AT_ISSUE(j, st) do { const int _j = (j); const int _kr = _j < 4 ? NL + b * C_ + 64 * _j : b * S_ + 64 * (lat_first + _j - 4); \
    LAS char* _d = ldst + (st) * AT_STAGE; \
    const u16* _k = Kg + (size_t)(_kr + skey) * ldk + koff + kch; glds16(_k, _d); glds16(_k + (size_t)32 * ldk, _d + 4096); \
    const u16* _v = Vg + (size_t)(_kr + skey) * ldk + koff + vch; glds16(_v, _d + 8192); glds16(_v + (size_t)32 * ldk, _d + 8192 + 4096); \
    if (MLA) glds16(Rg + (size_t)(_kr + rkey) * 32 + rch, _d + 16384); } while (0)
#define AT_QK(sb, P0, P1) do { \
    bf16x8 kk0[MLA ? 6 : 4], kk1[MLA ? 6 : 4]; \
    _Pragma("unroll") for (int d0 = 0; d0 < 4; ++d0) { kk0[d0] = *(const LAS bf16x8*)((sb) + kaddr[d0]); kk1[d0] = *(const LAS bf16x8*)((sb) + kaddr[d0] + 4096); } \
    if (MLA) { _Pragma("unroll") for (int e = 0; e < 2; ++e) { kk0[MLA ? 4 + e : 0] = *(const LAS bf16x8*)((sb) + kraddr[e]); kk1[MLA ? 4 + e : 0] = *(const LAS bf16x8*)((sb) + kraddr[e] + 2048); } } \
    __builtin_amdgcn_sched_barrier(0);     \
    P0 = __builtin_amdgcn_mfma_f32_32x32x16_bf16(kk0[0], qf[0], negm, 0, 0, 0); P1 = __builtin_amdgcn_mfma_f32_32x32x16_bf16(kk1[0], qf[0], negm, 0, 0, 0); \
    _Pragma("unroll") for (int d0 = 1; d0 < (MLA ? 6 : 4); ++d0) { \
      P0 = __builtin_amdgcn_mfma_f32_32x32x16_bf16(kk0[d0], qf[d0], P0, 0, 0, 0); P1 = __builtin_amdgcn_mfma_f32_32x32x16_bf16(kk1[d0], qf[d0], P1, 0, 0, 0); } \
  } while (0)
#define AT_WSTATE(jj, pos0v, st) do { st = 0; pos0v = 64 * (lat_first + (jj) - 4); if (SWA && (jj) >= 4) { \
      if (pos0v + 63 < qw - 128 || pos0v > qw + 31 + 128) st = 2; else if (qw + 31 - pos0v > 128 || pos0v + 63 - qw > 128) st = 1; } } while (0)
#define AT_SOFTMAX(P0, P1, PA, wst, pos0v, FIRST) do { \
    if (SWA && wst == 1) { const int dq = qw + r32 - pos0v - 4 * hi + 128; \
      _Pragma("unroll") for (int r = 0; r < 16; ++r) { const int cr = (r & 3) + 8 * (r >> 2); \
        if ((unsigned)(dq - cr) > 256u) P0[r] = -1e30f; if ((unsigned)(dq - cr - 32) > 256u) P1[r] = -1e30f; } } \
    asm volatile("s_nop 15\n\ts_nop 15" : "+v"(P0), "+v"(P1));     \
    float mx = max3f(P0[0], P0[1], P1[0]); mx = max3f(mx, P1[1], P0[2]); \
    _Pragma("unroll") for (int r = 3; r < 16; r += 2) { mx = max3f(mx, P0[r], P0[(r + 1) & 15]); } \
    _Pragma("unroll") for (int r = 2; r < 16; r += 2) { mx = max3f(mx, P1[r], P1[r + 1]); } \
    mx = half_max(mx); \
    if ((FIRST) || __ballot(mx > 8.0f) != 0ull) { \
      const float delta = (FIRST) ? mx : fmaxf(mx, 0.f); \
      const float al = __builtin_amdgcn_exp2f(-delta); \
      m_run += delta; \
      _Pragma("unroll") for (int i = 0; i < 16; ++i) { o[0][i] *= al; o[1][i] *= al; P0[i] -= delta; P1[i] -= delta; negm[i] = -m_run; } \
      osum[0] *= al; \
    } \
    _Pragma("unroll") for (int r = 0; r < 16; ++r) { P0[r] = __builtin_amdgcn_exp2f(P0[r]); P1[r] = __builtin_amdgcn_exp2f(P1[r]); } \
    PA[0] = pack8(P0, 0); PA[1] = pack8(P0, 8); PA[2] = pack8(P1, 0); PA[3] = pack8(P1, 8); \
  } while (0)
#define AT_PV(sb, PA) do { \
    bf16x8 vf[2][4]; \
    _Pragma("unroll") for (int db = 0; db < 2; ++db) { _Pragma("unroll") for (int ts = 0; ts < 4; ++ts) { \
      const LAS char* va = (sb) + vbo[db] + ts * 2048; const s16x4 lo = tr_read(va), hh = tr_read(va + 1024); \
      vf[db][ts] = __builtin_shufflevector(lo, hh, 0, 1, 2, 3, 4, 5, 6, 7); } } \
    __builtin_amdgcn_sched_barrier(0);     \
    _Pragma("unroll") for (int ts = 0; ts < 4; ++ts) osum = __builtin_amdgcn_mfma_f32_32x32x16_bf16(ones, PA[ts], osum, 0, 0, 0); \
    _Pragma("unroll") for (int db = 0; db < 2; ++db) { _Pragma("unroll") for (int ts = 0; ts < 4; ++ts) \
      o[db] = __builtin_amdgcn_mfma_f32_32x32x16_bf16(vf[db][ts], PA[ts], o[db], 0, 0, 0); } } while (0)

  float m_run = SWA ? p.swa_sink[layer * 6 + h] * 1.4426950408889634f : 0.f;
  f32x16 o[2], osum, negm;
#pragma unroll
  for (int i = 0; i < 16; ++i) { o[0][i] = 0.f; o[1][i] = 0.f; osum[i] = SWA ? 1.f : 0.f; negm[i] = -m_run; }
  bf16x8 ones;
#pragma unroll
  for (int i = 0; i < 8; ++i) ones[i] = (short)0x3F80;
  bf16x8 pa[4];
  f32x16 s0, s1;
  AT_ISSUE(0, 0);
  asm volatile("s_waitcnt vmcnt(0)" ::: "memory");
  __syncthreads();
  AT_ISSUE(1, 1);
  AT_QK(lds, s0, s1);
  { int wst = 0, pos0v = 0; AT_SOFTMAX(s0, s1, pa, wst, pos0v, !SWA); }
  bool cur_skip = false;
#pragma unroll 1
  for (int j = 0; j < T - 1; ++j) {
    asm volatile("s_waitcnt vmcnt(0)" ::: "memory");
    __syncthreads();
    const int st_cur = j % 3, st_nxt = (j + 1) % 3;
    if (j + 2 < T) AT_ISSUE(j + 2, (j + 2) % 3);
    const LAS char* sbn = lds + st_nxt * AT_STAGE;
    const LAS char* sbc = lds + st_cur * AT_STAGE;
    int wst, pos0v; AT_WSTATE(j + 1, pos0v, wst);
    if (!SWA || wst != 2) AT_QK(sbn, s0, s1);
    if (!SWA || !cur_skip) AT_PV(sbc, pa);
    if (!SWA || wst != 2) {
      bf16x8 pn[4];
      AT_SOFTMAX(s0, s1, pn, wst, pos0v, false);
      pa[0] = pn[0]; pa[1] = pn[1]; pa[2] = pn[2]; pa[3] = pn[3];
      cur_skip = false;
    } else cur_skip = true;
  }
  if (!SWA || !cur_skip) { const LAS char* sbc = lds + ((T - 1) % 3) * AT_STAGE; AT_PV(sbc, pa); }
#undef AT_ISSUE
#undef AT_QK
#undef AT_WSTATE
#undef AT_SOFTMAX
#undef AT_PV
  const float inv = 1.f / osum[0];
  u16* yp = (u16*)(ws + OFF_Y) + (size_t)(qrow0 + wid * 32 + r32) * 1024 + ycol + 4 * hi;
#pragma unroll
  for (int db = 0; db < 2; ++db)
#pragma unroll
    for (int g = 0; g < 4; ++g) {
      uint2 w; w.x = cvtpk(o[db][4 * g] * inv, o[db][4 * g + 1] * inv); w.y = cvtpk(o[db][4 * g + 2] * inv, o[db][4 * g + 3] * inv);
      *(uint2*)(yp + db * 32 + 8 * g) = w;
    }
  __syncthreads();
}


typedef float f32x4v __attribute__((ext_vector_type(4)));
#define MFMA16(a, b, c) __builtin_amdgcn_mfma_f32_16x16x32_bf16((a), (b), (c), 0, 0, 0)
DI float quad_max_x(float m) {
  { auto rr = __builtin_amdgcn_permlane16_swap(__float_as_uint(m), __float_as_uint(m), false, false); m = fmaxf(__uint_as_float(rr[0]), __uint_as_float(rr[1])); }
  { auto rr = __builtin_amdgcn_permlane32_swap(__float_as_uint(m), __float_as_uint(m), false, false); m = fmaxf(__uint_as_float(rr[0]), __uint_as_float(rr[1])); }
  return m;
}
template <bool MLA, bool SWA>
DI void attn_unit16(const Params& p, int layer, int isctx, int b, int h, int qb, LAS char* lds) {
  char* ws = p.ws;
  const int tid = opaque((int)threadIdx.x), lane = tid & 63, wid = tid >> 6, c16 = lane & 15, g = lane >> 4;
  const u16 *Qg, *Kg, *Vg; int ldq, ldk, qoff, koff, ycol; float cs;
  if (MLA) { Qg = (const u16*)(ws + OFF_MLQ); Kg = (const u16*)(ws + OFF_MLK); Vg = (const u16*)(ws + OFF_MLV); ldq = 384; ldk = 256; qoff = h * 96; koff = h * 64; ycol = 768 + h * 64; cs = 0.10206207261596575f * 1.4426950408889634f; }
  else if (!SWA) { Qg = (const u16*)(ws + OFF_GLQ); Kg = (const u16*)(ws + OFF_GLK); Vg = (const u16*)(ws + OFF_GLV); ldq = 384; ldk = 128; qoff = h * 64; koff = (h / 3) * 64; ycol = 384 + h * 64; cs = 0.125f * 1.4426950408889634f; }
  else { Qg = (const u16*)(ws + OFF_SWQ); Kg = (const u16*)(ws + OFF_SWK); Vg = (const u16*)(ws + OFF_SWV); ldq = 384; ldk = 128; qoff = h * 64; koff = (h / 3) * 64; ycol = h * 64; cs = 0.125f * 1.4426950408889634f; }
  const u16* Rg = (const u16*)(ws + OFF_MLKR);
  const int q0 = qb * 256;
  const int qrow0 = (isctx ? NL + b * C_ : b * S_) + q0;
  const int qw = q0 + wid * 32;
  int lat_first = 0, nlat = 0;
  if (!isctx) { if (SWA) { lat_first = 4 * qb - 2; if (lat_first < 0) lat_first = 0; int lat_last = 4 * qb + 5; if (lat_last > 63) lat_last = 63; nlat = lat_last - lat_first + 1; } else nlat = 64; }
  const int T = 4 + nlat;
  constexpr int NS = MLA ? 3 : 2;
  bf16x8 qf[2][NS];
#pragma unroll
  for (int bq = 0; bq < 2; ++bq) {
    const u16* qp = Qg + (size_t)(qrow0 + wid * 32 + bq * 16 + c16) * ldq + qoff + g * 8;
#pragma unroll
    for (int s = 0; s < NS; ++s) {
      const u32x4_t raw = *(const u32x4_t*)(qp + s * 32);
      u32x4_t sc;
#pragma unroll
      for (int i = 0; i < 4; ++i) sc[i] = cvtpk(bflo(raw[i]) * cs, bfhi(raw[i]) * cs);
      qf[bq][s] = __builtin_bit_cast(bf16x8, sc);
    }
  }
  int kaddr[2];
#pragma unroll
  for (int s = 0; s < 2; ++s) kaddr[s] = c16 * 128 + (((4 * s + g) ^ ((c16 >> 1) & 7)) * 16);
  const int kraddr = 16384 + c16 * 64 + ((g ^ ((0 - (c16 >> 2)) & 3)) * 16);
  int vbo[4];
#pragma unroll
  for (int d = 0; d < 4; ++d) vbo[d] = 8192 + (4 * g + (c16 >> 2)) * 128 + ((d ^ ((lane >> 3) & 3)) * 32) + (lane & 3) * 8;
  const int skey = tid >> 3;
  const int kch = ((tid & 7) ^ ((tid >> 4) & 7)) * 8;
  const int vch = ((tid & 7) ^ (((tid >> 4) & 3) << 1)) * 8;
  const int rkey = tid >> 2, rch = ((tid & 3) ^ ((0 - (tid >> 4)) & 3)) * 8;
  LAS char* ldst = lds + tid * 16;
#define A6_ISSUE(j, st) do { const int _j = (j); const int _kr = _j < 4 ? NL + b * C_ + 64 * _j : b * S_ + 64 * (lat_first + _j - 4); \
    LAS char* _d = ldst + (st) * AT_STAGE; \
    glds16(Kg + (size_t)(_kr + skey) * ldk + koff + kch, _d); \
    glds16(Vg + (size_t)(_kr + skey) * ldk + koff + vch, _d + 8192); \
    if (MLA && tid < 256) glds16(Rg + (size_t)(_kr + rkey) * 32 + rch, _d + 16384); } while (0)
#define A6_QK(sb) do { \
    bf16x8 kk[4][NS]; \
    _Pragma("unroll") for (int a = 0; a < 4; ++a) { kk[a][0] = *(const LAS bf16x8*)((sb) + kaddr[0] + a * 2048); kk[a][1] = *(const LAS bf16x8*)((sb) + kaddr[1] + a * 2048); \
      if (MLA) kk[a][MLA ? 2 : 0] = *(const LAS bf16x8*)((sb) + kraddr + a * 1024); } \
    __builtin_amdgcn_sched_barrier(0); \
    _Pragma("unroll") for (int a = 0; a < 4; ++a) { _Pragma("unroll") for (int bq = 0; bq < 2; ++bq) { \
      S[a][bq] = MFMA16(kk[a][0], qf[bq][0], negm[bq]); \
      _Pragma("unroll") for (int s = 1; s < NS; ++s) S[a][bq] = MFMA16(kk[a][s], qf[bq][s], S[a][bq]); } } \
  } while (0)
#define A6_WSTATE(jj, pos0v, st) do { st = 0; pos0v = 64 * (lat_first + (jj) - 4); if (SWA && (jj) >= 4) { \
      if (pos0v + 63 < qw - 128 || pos0v > qw + 31 + 128) st = 2; else if (qw + 31 - pos0v > 128 || pos0v + 63 - qw > 128) st = 1; } } while (0)
#define A6_SOFTMAX(PA, wst, pos0v, FIRST, CHECK) do { \
    if (SWA && wst == 1) { _Pragma("unroll") for (int bq = 0; bq < 2; ++bq) { const int dq = qw + 16 * bq + c16 - pos0v - 4 * g + 128; \
      _Pragma("unroll") for (int a = 0; a < 4; ++a) { _Pragma("unroll") for (int r = 0; r < 4; ++r) { if ((unsigned)(dq - (16 * a + r)) > 256u) S[a][bq][r] = -1e30f; } } } } \
    float mx[2] = {0.f, 0.f}; \
    if (CHECK) { \
    asm volatile("s_nop 15\n\ts_nop 15" : "+v"(S[0][0]), "+v"(S[0][1]), "+v"(S[1][0]), "+v"(S[1][1]), "+v"(S[2][0]), "+v"(S[2][1]), "+v"(S[3][0]), "+v"(S[3][1])); \
    _Pragma("unroll") for (int bq = 0; bq < 2; ++bq) { \
      float m_ = max3f(S[0][bq][0], S[0][bq][1], S[0][bq][2]); m_ = max3f(m_, S[0][bq][3], S[1][bq][0]); \
      m_ = max3f(m_, S[1][bq][1], S[1][bq][2]); m_ = max3f(m_, S[1][bq][3], S[2][bq][0]); m_ = max3f(m_, S[2][bq][1], S[2][bq][2]); \
      m_ = max3f(m_, S[2][bq][3], S[3][bq][0]); m_ = max3f(m_, S[3][bq][1], S[3][bq][2]); m_ = fmaxf(m_, S[3][bq][3]); \
      mx[bq] = quad_max_x(m_); } } \
    if ((FIRST) || ((CHECK) && __ballot(fmaxf(mx[0], mx[1]) > 8.0f) != 0ull)) { \
      _Pragma("unroll") for (int bq = 0; bq < 2; ++bq) { \
        const float delta = (FIRST) ? mx[bq] : fmaxf(mx[bq], 0.f); \
        const float al = __builtin_amdgcn_exp2f(-delta); \
        m_run[bq] += delta; \
        _Pragma("unroll") for (int a = 0; a < 4; ++a) { S[a][bq] = S[a][bq] - delta; o[a][bq] = o[a][bq] * al; } \
        negm[bq] = (f32x4v){-m_run[bq], -m_run[bq], -m_run[bq], -m_run[bq]}; \
        osum[bq] = osum[bq] * al; } \
    } \
    _Pragma("unroll") for (int a = 0; a < 4; ++a) { _Pragma("unroll") for (int bq = 0; bq < 2; ++bq) { _Pragma("unroll") for (int r = 0; r < 4; ++r) S[a][bq][r] = __builtin_amdgcn_exp2f(S[a][bq][r]); } } \
    _Pragma("unroll") for (int ks = 0; ks < 2; ++ks) { _Pragma("unroll") for (int bq = 0; bq < 2; ++bq) { u32x4_t w_; \
      w_[0] = cvtpk(S[2 * ks][bq][0], S[2 * ks][bq][1]); w_[1] = cvtpk(S[2 * ks][bq][2], S[2 * ks][bq][3]); \
      w_[2] = cvtpk(S[2 * ks + 1][bq][0], S[2 * ks + 1][bq][1]); w_[3] = cvtpk(S[2 * ks + 1][bq][2], S[2 * ks + 1][bq][3]); \
      PA[ks][bq] = __builtin_bit_cast(bf16x8, w_); } } \
  } while (0)
#define A6_PV(sb, PA) do { \
    bf16x8 vf[2][4]; \
    _Pragma("unroll") for (int ks = 0; ks < 2; ++ks) { _Pragma("unroll") for (int d = 0; d < 4; ++d) { \
      const LAS char* va = (sb) + vbo[d] + ks * 4096; const s16x4 lo = tr_read(va), hh = tr_read(va + 2048); \
      vf[ks][d] = __builtin_shufflevector(lo, hh, 0, 1, 2, 3, 4, 5, 6, 7); } } \
    __builtin_amdgcn_sched_barrier(0); \
    _Pragma("unroll") for (int ks = 0; ks < 2; ++ks) { _Pragma("unroll") for (int bq = 0; bq < 2; ++bq) osum[bq] = MFMA16(ones, PA[ks][bq], osum[bq]); } \
    _Pragma("unroll") for (int d = 0; d < 4; ++d) { _Pragma("unroll") for (int bq = 0; bq < 2; ++bq) { _Pragma("unroll") for (int ks = 0; ks < 2; ++ks) \
      o[d][bq] = MFMA16(vf[ks][d], PA[ks][bq], o[d][bq]); } } } while (0)

  float m_run[2];
  m_run[0] = m_run[1] = SWA ? p.swa_sink[layer * 6 + h] * 1.4426950408889634f : 0.f;
  f32x4v S[4][2], o[4][2], osum[2], negm[2];
#pragma unroll
  for (int bq = 0; bq < 2; ++bq) {
    const float i1 = SWA ? 1.f : 0.f;
    osum[bq] = (f32x4v){i1, i1, i1, i1}; negm[bq] = (f32x4v){-m_run[bq], -m_run[bq], -m_run[bq], -m_run[bq]};
#pragma unroll
    for (int d = 0; d < 4; ++d) o[d][bq] = (f32x4v){0.f, 0.f, 0.f, 0.f};
  }
  bf16x8 ones;
#pragma unroll
  for (int i = 0; i < 8; ++i) ones[i] = (short)0x3F80;
  bf16x8 pa[2][2];
  A6_ISSUE(0, 0); A6_ISSUE(1, 1); A6_ISSUE(2, 2); A6_ISSUE(3, 3);
  asm volatile("s_waitcnt vmcnt(0)" ::: "memory");
  __syncthreads();
  if (4 < T) A6_ISSUE(4, 4); if (5 < T) A6_ISSUE(5, 5); if (6 < T) A6_ISSUE(6, 6);
  A6_QK(lds);
  { int wst = 0, pos0v = 0; A6_SOFTMAX(pa, wst, pos0v, !SWA, true); }
  bool cur_skip = false;
  int jm = 0;
#pragma unroll 1
  for (int j = 0; j < T - 1; ++j) {
    if (j > 0 && jm == 0) {
      asm volatile("s_waitcnt vmcnt(0)" ::: "memory");
      __syncthreads();
      if (j + 4 < T) A6_ISSUE(j + 4, (j + 4) % 7);
      if (j + 5 < T) A6_ISSUE(j + 5, (j + 5) % 7);
      if (j + 6 < T) A6_ISSUE(j + 6, (j + 6) % 7);
    }
    jm = jm == 2 ? 0 : jm + 1;
    const LAS char* sbn = lds + ((j + 1) % 7) * AT_STAGE;
    const LAS char* sbc = lds + (j % 7) * AT_STAGE;
    int wst, pos0v; A6_WSTATE(j + 1, pos0v, wst);
    if (!SWA || wst != 2) A6_QK(sbn);
    if (!SWA || !cur_skip) A6_PV(sbc, pa);
    if (!SWA || wst != 2) {
      bf16x8 pn[2][2];
      A6_SOFTMAX(pn, wst, pos0v, false, (SWA || (j & 7) == 7));
      pa[0][0] = pn[0][0]; pa[0][1] = pn[0][1]; pa[1][0] = pn[1][0]; pa[1][1] = pn[1][1];
      cur_skip = false;
    } else cur_skip = true;
  }
  if (!SWA || !cur_skip) { const LAS char* sbc = lds + ((T - 1) % 7) * AT_STAGE; A6_PV(sbc, pa); }
#undef A6_ISSUE
#undef A6_QK
#undef A6_WSTATE
#undef A6_SOFTMAX
#undef A6_PV
#pragma unroll
  for (int bq = 0; bq < 2; ++bq) {
    const float inv = 1.f / osum[bq][0];
    u16* yp = (u16*)(ws + OFF_Y) + (size_t)(qrow0 + wid * 32 + bq * 16 + c16) * 1024 + ycol + 4 * g;
#pragma unroll
    for (int d = 0; d < 4; ++d) {
      u32x2_t w; w[0] = cvtpk(o[d][bq][0] * inv, o[d][bq][1] * inv); w[1] = cvtpk(o[d][bq][2] * inv, o[d][bq][3] * inv);
      *(u32x2_t*)(yp + d * 16) = w;
    }
  }
  __syncthreads();
}

DI void p3_attention(const Params& p, int layer, LAS char* lds, int cs = 0) {
  unsigned* ctr8 = (unsigned*)(p.ws + OFF_CTRL) + CW_Q + (layer * 2 + 0) * 512;
  const int per_q = 256 + (layer == 0 ? 16 : 0);
  for (;;) {
    const int u = next_unit_xcd(ctr8, per_q, lds);
    if (u < 0) break;
    const int b = u / per_q, v = u % per_q;
    if (v < 64) { attn_unit16<true, false>(p, layer, 0, b, v >> 4, v & 15, lds); }
    else if (v < 160) { const int w = v - 64; attn_unit16<false, false>(p, layer, 0, b, w >> 4, w & 15, lds); }
    else if (v < 256) { const int w = v - 160; attn_unit16<false, true>(p, layer, 0, b, w >> 4, w & 15, lds); }
    else {
      const int w = v - 256;
      if (w < 4) attn_unit16<true, false>(p, layer, 1, b, w, 0, lds);
      else if (w < 10) attn_unit16<false, false>(p, layer, 1, b, w - 4, 0, lds);
      else attn_unit16<false, true>(p, layer, 1, b, w - 10, 0, lds);
    }
  }
}

struct AttnArgs {
  const u16* Q; const u16* K; const u16* K2; const u16* V; u16* Y; const float* sink;
  int ldq, ldk, ldk2, ldv, ldy, ycol, G, window, q_is_ctx; float scale;
};
static_assert(sizeof(AttnArgs) == 88, "no padding");
template <int DK1, int DK2>
__global__ __launch_bounds__(64) void k_attn(AttnArgs a) {
  const int qt = blockIdx.x * 64 + threadIdx.x, b = blockIdx.y, h = blockIdx.z, kvh = h / a.G;
  const int qrow = a.q_is_ctx ? NL + b * C_ + qt : b * S_ + qt;
  float q[DK1 + DK2];
  {
    const uint4* qp = (const uint4*)(a.Q + (size_t)qrow * a.ldq + h * (DK1 + DK2));
#pragma unroll
    for (int i = 0; i < (DK1 + DK2) / 8; ++i) {
      uint4 u = qp[i];
      q[i * 8 + 0] = bflo(u.x) * a.scale; q[i * 8 + 1] = bfhi(u.x) * a.scale; q[i * 8 + 2] = bflo(u.y) * a.scale; q[i * 8 + 3] = bfhi(u.y) * a.scale;
      q[i * 8 + 4] = bflo(u.z) * a.scale; q[i * 8 + 5] = bfhi(u.z) * a.scale; q[i * 8 + 6] = bflo(u.w) * a.scale; q[i * 8 + 7] = bfhi(u.w) * a.scale;
    }
  }
  float m, l, o[64];
  if (a.sink) { m = a.sink[h]; l = 1.f; } else { m = -1e30f; l = 0.f; }
#pragma unroll
  for (int d = 0; d < 64; ++d) o[d] = 0.f;
  const int nseg = a.q_is_ctx ? 1 : 2;
  for (int seg = 0; seg < nseg; ++seg) {
    int lo, hi, rbase; bool masked = false;
    if (seg == 0) { lo = 0; hi = C_; rbase = NL + b * C_; }
    else {
      lo = 0; hi = S_; rbase = b * S_;
      if (a.window) { int t0 = blockIdx.x * 64; lo = t0 - a.window; if (lo < 0) lo = 0; hi = t0 + 64 + a.window; if (hi > S_) hi = S_; masked = true; }
    }
    for (int s = lo; s < hi; s += 4) {
      float sc[4];
#pragma unroll
      for (int i = 0; i < 4; ++i) {
        const uint4* kp = (const uint4*)(a.K + (size_t)(rbase + s + i) * a.ldk + kvh * DK1);
        float dot = 0.f;
#pragma unroll
        for (int c = 0; c < DK1 / 8; ++c) {
          uint4 u = kp[c];
          dot += q[c * 8 + 0] * bflo(u.x) + q[c * 8 + 1] * bfhi(u.x) + q[c * 8 + 2] * bflo(u.y) + q[c * 8 + 3] * bfhi(u.y)
               + q[c * 8 + 4] * bflo(u.z) + q[c * 8 + 5] * bfhi(u.z) + q[c * 8 + 6] * bflo(u.w) + q[c * 8 + 7] * bfhi(u.w);
        }
        if (DK2 > 0) {
          const uint4* kp2 = (const uint4*)(a.K2 + (size_t)(rbase + s + i) * a.ldk2);
#pragma unroll
          for (int c = 0; c < DK2 / 8; ++c) {
            uint4 u = kp2[c];
            dot += q[DK1 + c * 8 + 0] * bflo(u.x) + q[DK1 + c * 8 + 1] * bfhi(u.x) + q[DK1 + c * 8 + 2] * bflo(u.y) + q[DK1 + c * 8 + 3] * bfhi(u.y)
                 + q[DK1 + c * 8 + 4] * bflo(u.z) + q[DK1 + c * 8 + 5] * bfhi(u.z) + q[DK1 + c * 8 + 6] * bflo(u.w) + q[DK1 + c * 8 + 7] * bfhi(u.w);
          }
        }
        if (masked) { int dlt = qt - (s + i); if (dlt < 0) dlt = -dlt; if (dlt > a.window) dot = -1e30f; }
        sc[i] = dot;
      }
      float mx = fmaxf(fmaxf(fmaxf(sc[0], sc[1]), fmaxf(sc[2], sc[3])), m);
      const float alpha = __expf(m - mx);
      float pr[4];
#pragma unroll
      for (int i = 0; i < 4; ++i) pr[i] = __expf(sc[i] - mx);
      l = l * alpha + (pr[0] + pr[1]) + (pr[2] + pr[3]);
      m = mx;
#pragma unroll
      for (int d = 0; d < 64; ++d) o[d] *= alpha;
#pragma unroll
      for (int i = 0; i < 4; ++i) {
        const uint4* vp = (const uint4*)(a.V + (size_t)(rbase + s + i) * a.ldv + kvh * 64);
#pragma unroll
        for (int c = 0; c < 8; ++c) {
          uint4 u = vp[c];
          o[c * 8 + 0] += pr[i] * bflo(u.x); o[c * 8 + 1] += pr[i] * bfhi(u.x); o[c * 8 + 2] += pr[i] * bflo(u.y); o[c * 8 + 3] += pr[i] * bfhi(u.y);
          o[c * 8 + 4] += pr[i] * bflo(u.z); o[c * 8 + 5] += pr[i] * bfhi(u.z); o[c * 8 + 6] += pr[i] * bflo(u.w); o[c * 8 + 7] += pr[i] * bfhi(u.w);
        }
      }
    }
  }
  const float inv = 1.f / l;
  uint4* yp = (uint4*)(a.Y + (size_t)qrow * a.ldy + a.ycol + h * 64);
#pragma unroll
  for (int c = 0; c < 8; ++c) {
    uint4 u;
    u.x = cvtpk(o[c * 8 + 0] * inv, o[c * 8 + 1] * inv); u.y = cvtpk(o[c * 8 + 2] * inv, o[c * 8 + 3] * inv);
    u.z = cvtpk(o[c * 8 + 4] * inv, o[c * 8 + 5] * inv); u.w = cvtpk(o[c * 8 + 6] * inv, o[c * 8 + 7] * inv);
    yp[c] = u;
  }
}


constexpr int CW_BAR = 1024;
#define XB_TMO      128
#define XB_XCNT(j)  (256  + 64 * (j))
#define XB_XSUB(j)  (1280 + 64 * (j))
#define XB_XGEN(j)  (2304 + 64 * (j))
#define XB_TOP      3328
#define XB_TOPGEN   3392
#define XCD_BAR_WORDS 3456
#define XB_SPIN_CAP (1u << 22)
DI unsigned xb_ld(unsigned* p) { return __hip_atomic_load(p, __ATOMIC_RELAXED, __HIP_MEMORY_SCOPE_AGENT); }
DI unsigned xb_add(unsigned* p, unsigned v) { return __hip_atomic_fetch_add(p, v, __ATOMIC_RELAXED, __HIP_MEMORY_SCOPE_AGENT); }
DI unsigned xb_xcc_id() { return (unsigned)__builtin_amdgcn_s_getreg((3 << 11) | 20) & 0xFu; }
#define XB_SPIN(cond, bar) do { unsigned _sp = 0; while (cond) { __builtin_amdgcn_s_sleep(1); \
    if ((++_sp & 255u) == 0u) { if (xb_ld(&(bar)[XB_TMO])) break; if (_sp > XB_SPIN_CAP) { atomicAdd(&(bar)[XB_TMO], 1u); break; } } } } while (0)
struct XcdBarrier { unsigned* bar; unsigned x; volatile LAS unsigned* st; };
DI XcdBarrier xcd_barrier_post(unsigned* bar, volatile LAS unsigned* st) {
  XcdBarrier b; b.bar = bar; b.x = xb_xcc_id(); b.st = st;
  if (threadIdx.x == 0) (void)xb_add(&bar[XB_XCNT(b.x)], 1u);
  return b;
}
DI void xcd_barrier_complete(unsigned* bar, unsigned x, unsigned& nloc, unsigned& nx) {
  const unsigned G = gridDim.x * gridDim.y * gridDim.z;
  unsigned sum, cnt, mine, sp = 0u;
  for (;;) {
    sum = 0u; cnt = 0u; mine = 0u;
#pragma unroll
    for (unsigned j = 0; j < 16; ++j) { const unsigned c = xb_ld(&bar[XB_XCNT(j)]); sum += c; cnt += (c > 0u) ? 1u : 0u; mine = (j == x) ? c : mine; }
    if (sum == G) break;
    __builtin_amdgcn_s_sleep(1);
    if ((++sp & 255u) == 0u) { if (xb_ld(&bar[XB_TMO])) break; if (sp > XB_SPIN_CAP) { atomicAdd(&bar[XB_TMO], 1u); break; } }
  }
  nloc = mine > 0u ? mine : 1u; nx = cnt > 0u ? cnt : 1u;
}
DI void xcd_barrier(const XcdBarrier& b) {
  asm volatile("s_waitcnt vmcnt(0)" ::: "memory");
  __syncthreads();
  if (threadIdx.x == 0) {
    unsigned* bar = b.bar;
    __builtin_amdgcn_s_waitcnt(0);
    unsigned nloc = b.st[0], nx = b.st[1];
    if (nloc == 0u) { xcd_barrier_complete(bar, b.x, nloc, nx); b.st[0] = nloc; b.st[1] = nx; }
    const unsigned old = xb_add(&bar[XB_XSUB(b.x)], 1u);
    const unsigned gen = old / nloc;
    if (old + 1u == (gen + 1u) * nloc) {
      __builtin_amdgcn_fence(__ATOMIC_RELEASE, "agent");
      asm volatile("s_waitcnt vmcnt(0)" ::: "memory");
      const unsigned og = xb_add(&bar[XB_TOP], 1u);
      const unsigned tg = og / nx;
      if (og + 1u == (tg + 1u) * nx) xb_add(&bar[XB_TOPGEN], 1u);
      else XB_SPIN(xb_ld(&bar[XB_TOPGEN]) == tg, bar);
      __builtin_amdgcn_fence(__ATOMIC_ACQUIRE, "agent");
      xb_add(&bar[XB_XGEN(b.x)], 1u);
      asm volatile("s_waitcnt vmcnt(0)" ::: "memory");
    } else {
      XB_SPIN(xb_ld(&bar[XB_XGEN(b.x)]) == gen, bar);
      __builtin_amdgcn_fence(__ATOMIC_ACQUIRE, "agent");
      asm volatile("s_waitcnt vmcnt(0)" ::: "memory");
    }
  }
  __syncthreads();
}

__global__ __launch_bounds__(NTHR, 1) void k_mega(Params p) {
  extern __shared__ __attribute__((aligned(16))) unsigned char smem[];
  LAS char* lds = (LAS char*)smem;
  if (p.never) cooperative_groups::this_grid().sync();
  volatile LAS unsigned* st = (volatile LAS unsigned*)(lds + LDS_RMISC + 64);
  if (threadIdx.x < 4) st[threadIdx.x] = 0u;
  __syncthreads();
  XcdBarrier bar = xcd_barrier_post((unsigned*)(p.ws + OFF_CTRL) + CW_BAR, st);
#ifdef PROBE_SEG
  volatile LAS unsigned long long* pt = (volatile LAS unsigned long long*)(lds + LDS_RMISC + 256);
  if (threadIdx.x == 0) { pt[0] = 0ull; pt[1] = 0ull; }
#define SEG_BEGIN(id) do { if ((id) == PROBE_SEG && blockIdx.x == 0 && opaque((int)threadIdx.x) == 0) pt[0] = __builtin_amdgcn_s_memrealtime(); } while (0)
#define SEG_END(id) do { if ((id) == PROBE_SEG && blockIdx.x == 0 && opaque((int)threadIdx.x) == 0) pt[1] = pt[1] + (__builtin_amdgcn_s_memrealtime() - pt[0]); } while (0)
#else
#define SEG_BEGIN(id) do {} while (0)
#define SEG_END(id) do {} while (0)
#endif
  SEG_BEGIN(0); p0_prologue(p, lds); xcd_barrier(bar); SEG_END(0);
  SEG_BEGIN(1); p1_norm_mix(p, 0); xcd_barrier(bar); SEG_END(1);
#pragma unroll 1
  for (int l = 0; l < 2; ++l) {
    const int nrows = l == 0 ? NT : NL;
    SEG_BEGIN(2 + 10 * l); p2_inproj8(p, l, lds); xcd_barrier(bar); p2b_upproj(p, l, lds); xcd_barrier(bar); SEG_END(2 + 10 * l);
    SEG_BEGIN(3 + 10 * l); p3_attention(p, l, lds); xcd_barrier(bar); SEG_END(3 + 10 * l);
    SEG_BEGIN(4 + 10 * l); p4_outproj8(p, l, nrows, lds); xcd_barrier(bar); SEG_END(4 + 10 * l);
    SEG_BEGIN(5 + 10 * l); p5_norm_ffn(p, l, nrows, lds); xcd_barrier(bar); SEG_END(5 + 10 * l);
    SEG_BEGIN(6 + 10 * l); p6_gateup8(p, l, nrows, lds); xcd_barrier(bar); SEG_END(6 + 10 * l);
    SEG_BEGIN(7 + 10 * l); p7_down8(p, l, nrows, lds); xcd_barrier(bar); SEG_END(7 + 10 * l);
    SEG_BEGIN(8 + 10 * l); p8_combine(p, l, nrows); if (l == 0) xcd_barrier(bar); SEG_END(8 + 10 * l);
  }
#ifdef PROBE_SEG
  if (blockIdx.x == 0 && opaque((int)threadIdx.x) == 0) {
    const unsigned long long t0 = __builtin_amdgcn_s_memrealtime(), t_acc = pt[1];
    while (__builtin_amdgcn_s_memrealtime() - t0 < 9ull * t_acc) __builtin_amdgcn_s_sleep(8);
  }
#endif
}

extern "C" void kernel_launch(void* const* d_in, const int* in_sizes, int n_in, void* d_out, int out_size, void* d_ws, size_t ws_size, hipStream_t stream) {
  Params p{};
  p.x = (const float*)d_in[0]; p.c = (const float*)d_in[1]; p.ctx = (const float*)d_in[2]; p.c_ctx = (const float*)d_in[3];
  p.w_mod = (const float*)d_in[4]; p.b_mod = (const float*)d_in[5]; p.norm_mix_g = (const float*)d_in[6]; p.norm_ffn_g = (const float*)d_in[7];
  p.w_in = (const float*)d_in[8]; p.w_out = (const float*)d_in[9]; p.swa_sink = (const float*)d_in[10]; p.glb_q_gain = (const float*)d_in[11];
  p.glb_k_gain = (const float*)d_in[12]; p.mla_q_gain = (const float*)d_in[13]; p.mla_w_uq = (const float*)d_in[14]; p.mla_kv_gain = (const float*)d_in[15];
  p.mla_w_ukv = (const float*)d_in[16]; p.router_w = (const float*)d_in[17]; p.router_bias = (const float*)d_in[18]; p.exp_w_gate = (const float*)d_in[19];
  p.exp_w_up = (const float*)d_in[20]; p.exp_w_down = (const float*)d_in[21]; p.shr_w_gate = (const float*)d_in[22]; p.shr_w_up = (const float*)d_in[23];
  p.shr_w_down = (const float*)d_in[24]; p.final_norm_g = (const float*)d_in[25];
  p.out = (float*)d_out; p.ws = (char*)d_ws;
  char* ws = (char*)d_ws;

#ifndef MEGA
#define MEGA 1
#endif
#if MEGA
  static int grid_blocks = 0;
  if (!grid_blocks) {
    (void)hipFuncSetAttribute((const void*)k_mega, hipFuncAttributeMaxDynamicSharedMemorySize, LDS_BYTES);
    int dev = 0, cus = 0, per_cu = 0;
    (void)hipGetDevice(&dev);
    (void)hipDeviceGetAttribute(&cus, hipDeviceAttributeMultiprocessorCount, dev);
    (void)hipOccupancyMaxActiveBlocksPerMultiprocessor(&per_cu, (const void*)k_mega, NTHR, LDS_BYTES);
    if (per_cu > 1) per_cu = 1;
    if (per_cu < 1) per_cu = 1;
    grid_blocks = cus * per_cu;
  }
  (void)hipMemsetAsync(ws + OFF_CTRL, 0, CTRL_BYTES, stream);
  void* args[] = {&p};
  hipError_t e = hipLaunchCooperativeKernel((const void*)k_mega, dim3(grid_blocks), dim3(NTHR), args, LDS_BYTES, stream);
  if (e != hipSuccess) fprintf(stderr, "cooperative launch failed: %s (grid %d)\n", hipGetErrorString(e), grid_blocks);
#endif
}
```

```cpp
#include <hip/hip_runtime.h>
#include <hip/hip_cooperative_groups.h>
#include <cstdio>
#include <stdint.h>
#include <stddef.h>

typedef unsigned short u16;
typedef short bf16x8 __attribute__((ext_vector_type(8)));
typedef float f32x4 __attribute__((ext_vector_type(4)));
typedef float f32x2_t __attribute__((ext_vector_type(2)));
typedef __bf16 bf16x2_t __attribute__((ext_vector_type(2)));
typedef unsigned u32x2_t __attribute__((ext_vector_type(2)));
typedef unsigned u32x4_t __attribute__((ext_vector_type(4)));
#define DI __device__ __forceinline__
#define LAS __attribute__((address_space(3)))

constexpr int B_ = 8, S_ = 4096, D_ = 1024, C_ = 256;
constexpr int NL = B_ * S_, NC = B_ * C_, NT = NL + NC;
constexpr int INW = 1696, INWP = 1792;
constexpr int NE = 16;
constexpr int MAXSLOT = NT * 2 + NE * 256;
constexpr float EPS = 1e-6f;
constexpr int NTHR = 512;
#define VTID ((int)(threadIdx.x & 255u))
#define VHALF (__builtin_amdgcn_readfirstlane((int)(threadIdx.x >> 8)))
#define VBID ((int)(blockIdx.x * 2u) + VHALF)
#define VGRID ((int)(gridDim.x * 2u))

DI float bf2f(u16 v) { return __uint_as_float(((unsigned)v) << 16); }
DI float bflo(unsigned u) { return __uint_as_float(u << 16); }
DI float bfhi(unsigned u) { return __uint_as_float(u & 0xffff0000u); }
DI unsigned cvtpk(float lo, float hi) { f32x2_t v = {lo, hi}; bf16x2_t b = __builtin_convertvector(v, bf16x2_t); return __builtin_bit_cast(unsigned, b); }
template <int CTRL> DI float dpp_mov(float v) { return __int_as_float(__builtin_amdgcn_update_dpp(0, __float_as_int(v), CTRL, 0xf, 0xf, false)); }
DI float wave_sum(float v) {
  v += dpp_mov<0xB1>(v);
  v += dpp_mov<0x4E>(v);
  v += dpp_mov<0x141>(v);
  v += dpp_mov<0x140>(v);
  { auto rr = __builtin_amdgcn_permlane16_swap(__float_as_uint(v), __float_as_uint(v), false, false); v = __uint_as_float(rr[0]) + __uint_as_float(rr[1]); }
  { auto rr = __builtin_amdgcn_permlane32_swap(__float_as_uint(v), __float_as_uint(v), false, false); v = __uint_as_float(rr[0]) + __uint_as_float(rr[1]); }
  return v;
}
DI float silu(float g) { return g * __builtin_amdgcn_rcpf(1.f + __builtin_amdgcn_exp2f(-1.4426950408889634f * g)); }
DI int opaque(int v) { asm volatile("" : "+v"(v)); return v; }
DI int g8_unit_base() { return (int)((blockIdx.x & 7) * (gridDim.x >> 3) + (blockIdx.x >> 3)); }

constexpr size_t al256(size_t x) { return (x + 255) & ~(size_t)255; }
constexpr size_t OFF_CTRL = 0;
constexpr size_t CTRL_BYTES = 65536;
constexpr size_t OFF_CTXR = OFF_CTRL + CTRL_BYTES;
constexpr size_t OFF_MOD = OFF_CTXR + 256;
constexpr size_t OFF_TOKE = OFF_MOD + al256((size_t)2 * 9 * 6144 * 4);
constexpr size_t OFF_TOKW = OFF_TOKE + al256((size_t)NT * 2 * 4);
constexpr size_t OFF_TOKP = OFF_TOKW + al256((size_t)NT * 2 * 4);
constexpr size_t OFF_LIST = OFF_TOKP + al256((size_t)NT * 2 * 4);
constexpr size_t OFF_WIN = OFF_LIST + al256((size_t)NE * NT * 4);
constexpr size_t OFF_WO = OFF_WIN + (size_t)2 * INWP * 1024 * 2;
constexpr size_t OFF_WUQ = OFF_WO + (size_t)2 * 1024 * 1024 * 2;
constexpr size_t OFF_WUKV = OFF_WUQ + (size_t)2 * 384 * 256 * 2;
constexpr size_t OFF_WGU = OFF_WUKV + (size_t)2 * 512 * 128 * 2;
constexpr size_t OFF_WD = OFF_WGU + (size_t)2 * 16 * 1024 * 1024 * 2;
constexpr size_t OFF_SGU = OFF_WD + (size_t)2 * 16 * 1024 * 512 * 2;
constexpr size_t OFF_SD = OFF_SGU + (size_t)2 * 1024 * 1024 * 2;
constexpr size_t OFF_H = OFF_SD + (size_t)2 * 1024 * 512 * 2;
constexpr size_t OFF_BIG = OFF_H + (size_t)NT * 1024 * 2;
constexpr size_t OFF_SWQ = OFF_BIG;
constexpr size_t OFF_SWK = OFF_SWQ + (size_t)NT * 384 * 2;
constexpr size_t OFF_SWV = OFF_SWK + (size_t)NT * 128 * 2;
constexpr size_t OFF_GLQ = OFF_SWV + (size_t)NT * 128 * 2;
constexpr size_t OFF_GLK = OFF_GLQ + (size_t)NT * 384 * 2;
constexpr size_t OFF_GLV = OFF_GLK + (size_t)NT * 128 * 2;
constexpr size_t OFF_MLQ = OFF_GLV + (size_t)NT * 128 * 2;
constexpr size_t OFF_MLK = OFF_MLQ + (size_t)NT * 384 * 2;
constexpr size_t OFF_MLKR = OFF_MLK + (size_t)NT * 256 * 2;
constexpr size_t OFF_MLV = OFF_MLKR + (size_t)NT * 32 * 2;
constexpr size_t OFF_QLAT = OFF_MLV + (size_t)NT * 256 * 2;
constexpr size_t OFF_KVLAT = OFF_QLAT + (size_t)NT * 256 * 2;
constexpr size_t OFF_Y = OFF_KVLAT + (size_t)NT * 128 * 2;
constexpr size_t END_A = OFF_Y + (size_t)NT * 1024 * 2;
constexpr size_t OFF_ACT = OFF_BIG;
constexpr size_t OFF_ACTS = OFF_ACT + (size_t)MAXSLOT * 512 * 2;
constexpr size_t OFF_YEXP = OFF_ACTS + (size_t)NT * 512 * 2;
constexpr size_t END_B = OFF_YEXP + (size_t)MAXSLOT * 1024 * 2;
constexpr size_t OFF_YSH = OFF_H;
constexpr size_t OFF_DELTA = OFF_SWQ;
static_assert(OFF_DELTA + (size_t)NT * 1024 * 2 <= OFF_MLQ, "DELTA must fit below MLQ");
constexpr size_t OFF_XB = al256(END_A > END_B ? END_A : END_B);
constexpr size_t OFF_ROWSS = OFF_XB + (size_t)NT * 1024 * 2;
constexpr size_t WS_NEED = OFF_ROWSS + (size_t)6 * NT * 4;
static_assert(WS_NEED <= (size_t)536870912, "workspace too large");

constexpr int CW_CTR = 0;
constexpr int CW_CNT = 8192;
constexpr int CW_Q = 10240;

struct Params {
  const float *x, *c, *ctx, *c_ctx, *w_mod, *b_mod, *norm_mix_g, *norm_ffn_g, *w_in, *w_out, *swa_sink, *glb_q_gain, *glb_k_gain,
      *mla_q_gain, *mla_w_uq, *mla_kv_gain, *mla_w_ukv, *router_w, *router_bias, *exp_w_gate, *exp_w_up, *exp_w_down, *shr_w_gate,
      *shr_w_up, *shr_w_down, *final_norm_g;
  float* out;
  char* ws;
  int never; int pad;
};

constexpr int LDS_MISC = 65536;
constexpr int LDS_HALF = 73728;
constexpr int LDS_ESTG = 131072;
constexpr int LDS_RMISC = 147456;
constexpr int LDS_BYTES = 159744;

DI int next_unit(unsigned* ctr, LAS char* lds) {
  volatile LAS int* slot = (volatile LAS int*)(lds + LDS_RMISC);
  __syncthreads();
  if (threadIdx.x == 0) *slot = (int)atomicAdd(ctr, 1u);
  __syncthreads();
  return *slot;
}

DI unsigned xcc_id_() { return (unsigned)__builtin_amdgcn_s_getreg((3 << 11) | 20) & 0x7u; }
DI int next_unit_xcd(unsigned* ctr8, int per_queue, LAS char* lds  ) {
  volatile LAS int* slot = (volatile LAS int*)(lds + LDS_RMISC);
  __syncthreads();
  if (threadIdx.x == 0) {
    const int q0 = (int)xcc_id_();
    int res = -1;
    for (int i = 0; i < 8; ++i) {
      const int q = (q0 + i) & 7;
      const int v = (int)atomicAdd(&ctr8[q * 64], 1u);
      if (v < per_queue) { res = q * per_queue + v; break; }
    }
    *slot = res;
  }
  __syncthreads();
  return *slot;
}
DI void cvt_job(const float* __restrict__ src, int ld, int N, int k0, int n0, u16* __restrict__ dst, int K, int mode  , LAS char* lds) {
  LAS float* T = (LAS float*)lds;
  const int tid = VTID;
  __syncthreads();
  {
    const int kk = tid >> 2, nq = (tid & 3) * 32;
    const float* s = src + (size_t)(k0 + kk) * ld + n0 + nq;
#pragma unroll
    for (int i = 0; i < 8; ++i) {
      float4 v = make_float4(0.f, 0.f, 0.f, 0.f);
      if (n0 + nq + i * 4 < N) v = *(const float4*)(s + i * 4);
      LAS float* t = T + kk * 129 + nq + i * 4;
      t[0] = v.x; t[1] = v.y; t[2] = v.z; t[3] = v.w;
    }
  }
  __syncthreads();
#pragma unroll
  for (int i = 0; i < 4; ++i) {
    const int chn = tid + i * 256;
    const int n = chn >> 3, kc = (chn & 7) * 8;
    if (n0 + n < N) {
      const LAS float* t = T + kc * 129 + n;
      uint4 o;
      o.x = cvtpk(t[0], t[129]); o.y = cvtpk(t[2 * 129], t[3 * 129]); o.z = cvtpk(t[4 * 129], t[5 * 129]); o.w = cvtpk(t[6 * 129], t[7 * 129]);
      const int gn = n0 + n;
      int drow = gn;
      if (mode) drow = (gn >> 5) * 64 + (gn & 31) + (mode == 2 ? 32 : 0);
      { u32x4_t ov; ov[0] = o.x; ov[1] = o.y; ov[2] = o.z; ov[3] = o.w; __builtin_nontemporal_store(ov, (u32x4_t*)(dst + (size_t)drow * K + k0 + kc)); }
    }
  }
}

DI void mod_job(const Params& p, int l, int j0, LAS char* lds) {
  LAS float* sc = (LAS float*)lds;
  LAS float* red = (LAS float*)(lds + 36864);
  const int tid = VTID;
  __syncthreads();
  for (int i = tid; i < 9 * 1024; i += 256) {
    int r = i >> 10, k = i & 1023;
    float v = r < 8 ? p.c[r * 1024 + k] : p.c_ctx[k];
    sc[i] = v / (1.f + __expf(-v));
  }
  __syncthreads();
  const int c4 = (tid & 31) * 4, kg = tid >> 5;
  f32x4 acc[9];
#pragma unroll
  for (int r = 0; r < 9; ++r) acc[r] = (f32x4){0.f, 0.f, 0.f, 0.f};
  const float* w = p.w_mod + (size_t)l * 1024 * 6144 + (size_t)(kg * 128) * 6144 + j0 + c4;
#pragma unroll 1
  for (int k0 = 0; k0 < 128; k0 += 16) {
    f32x4 wv[16];
#pragma unroll
    for (int u = 0; u < 16; ++u) wv[u] = __builtin_nontemporal_load((const f32x4*)(w + (size_t)(k0 + u) * 6144));
#pragma unroll
    for (int u = 0; u < 16; ++u)
#pragma unroll
      for (int r = 0; r < 9; ++r) acc[r] += sc[r * 1024 + kg * 128 + k0 + u] * wv[u];
  }
#pragma unroll
  for (int r = 0; r < 9; ++r) *(LAS f32x4*)(red + (kg * 9 + r) * 128 + c4) = acc[r];
  __syncthreads();
  float* MOD = (float*)(p.ws + OFF_MOD);
  for (int i = tid; i < 9 * 128; i += 256) {
    int r = i >> 7, cc = i & 127;
    float sum = 0.f;
#pragma unroll
    for (int g = 0; g < 8; ++g) sum += red[(g * 9 + r) * 128 + cc];
    MOD[(size_t)(l * 9 + r) * 6144 + j0 + cc] = sum + p.b_mod[l * 6144 + j0 + cc];
  }
}

constexpr int J_WIN = 16 * 14, J_WO = 16 * 8, J_UQ = 4 * 3, J_UKV = 2 * 4, J_EG = 16 * 4, J_ED = 8 * 8;
constexpr int J_DENSE = J_WIN + J_WO + J_UQ + J_UKV;
constexpr int J_EXP = 16 * (2 * J_EG + J_ED);
constexpr int J_SHR = 2 * J_EG + J_ED;
constexpr int J_LAYER = J_DENSE + J_EXP + J_SHR;
constexpr int J_MOD = 2 * 48;
constexpr int J_TOTAL = 2 * J_LAYER + J_MOD;

static_assert(J_MOD % 2 == 0 && J_TOTAL % 2 == 0, "job pairs (2i, 2i+1) must be of one kind and both valid");
DI void p0_prologue(const Params& p, LAS char* ldsr) {
  char* ws = p.ws;
  LAS char* lds = ldsr + VHALF * LDS_HALF;
  volatile LAS int* slot = (volatile LAS int*)(ldsr + LDS_RMISC);
  unsigned* qh = (unsigned*)(ws + OFF_CTRL) + 64;
  for (;;) {
    __syncthreads();
    if (threadIdx.x == 0) *slot = (int)atomicAdd(qh, 2u);
    __syncthreads();
    const int job = *slot + VHALF;
    if (job >= J_TOTAL) break;
    if (job < J_MOD) { mod_job(p, job / 48, (job % 48) * 128, lds); continue; }
    int r = job - J_MOD;
    const int l = r / J_LAYER; r -= l * J_LAYER;
    if (r < J_WIN) { cvt_job(p.w_in + (size_t)l * 1024 * INW, INW, INW, (r / 14) * 64, (r % 14) * 128, (u16*)(ws + OFF_WIN) + (size_t)l * INWP * 1024, 1024, 0, lds); continue; } r -= J_WIN;
    if (r < J_WO) { cvt_job(p.w_out + (size_t)l * 1024 * 1024, 1024, 1024, (r / 8) * 64, (r % 8) * 128, (u16*)(ws + OFF_WO) + (size_t)l * 1024 * 1024, 1024, 0, lds); continue; } r -= J_WO;
    if (r < J_UQ) { cvt_job(p.mla_w_uq + (size_t)l * 256 * 384, 384, 384, (r / 3) * 64, (r % 3) * 128, (u16*)(ws + OFF_WUQ) + (size_t)l * 384 * 256, 256, 0, lds); continue; } r -= J_UQ;
    if (r < J_UKV) { cvt_job(p.mla_w_ukv + (size_t)l * 128 * 512, 512, 512, (r / 4) * 64, (r % 4) * 128, (u16*)(ws + OFF_WUKV) + (size_t)l * 512 * 128, 128, 0, lds); continue; } r -= J_UKV;
    if (r < J_EXP) {
      const int e = r / (2 * J_EG + J_ED); int q = r % (2 * J_EG + J_ED);
      const size_t le = (size_t)l * NE + e;
      if (q < J_EG) { cvt_job(p.exp_w_gate + le * 1024 * 512, 512, 512, (q / 4) * 64, (q % 4) * 128, (u16*)(ws + OFF_WGU) + le * 1024 * 1024, 1024, 1, lds); continue; } q -= J_EG;
      if (q < J_EG) { cvt_job(p.exp_w_up + le * 1024 * 512, 512, 512, (q / 4) * 64, (q % 4) * 128, (u16*)(ws + OFF_WGU) + le * 1024 * 1024, 1024, 2, lds); continue; } q -= J_EG;
      cvt_job(p.exp_w_down + le * 512 * 1024, 1024, 1024, (q / 8) * 64, (q % 8) * 128, (u16*)(ws + OFF_WD) + le * 1024 * 512, 512, 0, lds); continue;
    }
    r -= J_EXP;
    if (r < J_EG) { cvt_job(p.shr_w_gate + (size_t)l * 1024 * 512, 512, 512, (r / 4) * 64, (r % 4) * 128, (u16*)(ws + OFF_SGU) + (size_t)l * 1024 * 1024, 1024, 1, lds); continue; } r -= J_EG;
    if (r < J_EG) { cvt_job(p.shr_w_up + (size_t)l * 1024 * 512, 512, 512, (r / 4) * 64, (r % 4) * 128, (u16*)(ws + OFF_SGU) + (size_t)l * 1024 * 1024, 1024, 2, lds); continue; } r -= J_EG;
    cvt_job(p.shr_w_down + (size_t)l * 512 * 1024, 1024, 1024, (r / 8) * 64, (r % 8) * 128, (u16*)(ws + OFF_SD) + (size_t)l * 1024 * 512, 512, 0, lds);
  }
}

DI const float* xrow_ptr(const Params& p, int layer_src  , int row) {
  if (layer_src == 0) return row < NL ? p.x + (size_t)row * 1024 : p.ctx + (size_t)(row - NL) * 1024;
  return row < NL ? p.out + (size_t)row * 1024 : (const float*)(p.ws + OFF_CTXR) + (size_t)(row - NL) * 1024;
}
DI float* xrow_out(const Params& p, int row) {
  return row < NL ? p.out + (size_t)row * 1024 : (float*)(p.ws + OFF_CTXR) + (size_t)(row - NL) * 1024;
}

DI void norm_mod_row(f32x4 (&v)[4], const float* __restrict__ g, const float* __restrict__ md  , int lane) {
  float ss = 0.f;
#pragma unroll
  for (int i = 0; i < 4; ++i) ss += v[i].x * v[i].x + v[i].y * v[i].y + v[i].z * v[i].z + v[i].w * v[i].w;
  ss = wave_sum(ss);
  const float rstd = rsqrtf(ss * (1.f / 1024.f) + EPS);
#pragma unroll
  for (int i = 0; i < 4; ++i) {
    const f32x4 gg = *(const f32x4*)(g + lane * 4 + i * 256);
    const f32x4 sh = *(const f32x4*)(md + lane * 4 + i * 256);
    const f32x4 sc = *(const f32x4*)(md + 1024 + lane * 4 + i * 256);
    v[i] = v[i] * rstd * gg * (sc + 1.f) + sh;
  }
}
template <bool NTS = false>
DI void store_h_row(const f32x4 (&v)[4], u16* __restrict__ hrow, int lane) {
#pragma unroll
  for (int i = 0; i < 4; ++i) {
    u32x2_t o; o[0] = cvtpk(v[i].x, v[i].y); o[1] = cvtpk(v[i].z, v[i].w);
    if (NTS) __builtin_nontemporal_store(o, (u32x2_t*)(hrow + lane * 4 + i * 256));
    else *(u32x2_t*)(hrow + lane * 4 + i * 256) = o;
  }
}

DI void p1_norm_mix(const Params& p, int layer) {
  const int tid_ = opaque((int)threadIdx.x); const int lane = tid_ & 63, gw = blockIdx.x * 8 + (tid_ >> 6), ngw = gridDim.x * 8;
  const float* MODl = (const float*)(p.ws + OFF_MOD) + (size_t)layer * 9 * 6144;
  u16* H = (u16*)(p.ws + OFF_H);
  const int chunk = (NT + ngw - 1) / ngw, r0 = gw * chunk, r1 = r0 + chunk < NT ? r0 + chunk : NT;
  const float* gn = p.norm_mix_g + layer * 1024;
  f32x4 vn[4], vm[4], ga[4], sh[4];
#pragma unroll
  for (int i = 0; i < 4; ++i) { ga[i] = (f32x4){0.f, 0.f, 0.f, 0.f}; sh[i] = ga[i]; vn[i] = ga[i]; vm[i] = ga[i]; }
  int mrc = -1;
  int row = r0;
  if (row < r1) { const float* xr = xrow_ptr(p, layer, row);
#pragma unroll
    for (int i = 0; i < 4; ++i) vn[i] = __builtin_nontemporal_load((const f32x4*)(xr + lane * 4 + i * 256)); }
  if (row + 1 < r1) { const float* xr = xrow_ptr(p, layer, row + 1);
#pragma unroll
    for (int i = 0; i < 4; ++i) vm[i] = __builtin_nontemporal_load((const f32x4*)(xr + lane * 4 + i * 256)); }
  for (; row < r1; ++row) {
    f32x4 v[4];
#pragma unroll
    for (int i = 0; i < 4; ++i) { v[i] = vn[i]; vn[i] = vm[i]; }
    if (row + 2 < r1) { const float* xr = xrow_ptr(p, layer, row + 2);
#pragma unroll
      for (int i = 0; i < 4; ++i) vm[i] = __builtin_nontemporal_load((const f32x4*)(xr + lane * 4 + i * 256)); }
    const int mr = row < NL ? row / S_ : 8;
    if (mr != mrc) {
      mrc = mr;
      const float* md = MODl + (size_t)mr * 6144;
#pragma unroll
      for (int i = 0; i < 4; ++i) {
        const f32x4 gg = *(const f32x4*)(gn + lane * 4 + i * 256);
        const f32x4 sc = *(const f32x4*)(md + 1024 + lane * 4 + i * 256);
        ga[i] = gg * (sc + 1.f); sh[i] = *(const f32x4*)(md + lane * 4 + i * 256);
      }
    }
    float ss = 0.f;
#pragma unroll
    for (int i = 0; i < 4; ++i) ss += v[i].x * v[i].x + v[i].y * v[i].y + v[i].z * v[i].z + v[i].w * v[i].w;
    ss = wave_sum(ss);
    const float rstd = rsqrtf(ss * (1.f / 1024.f) + EPS);
#pragma unroll
    for (int i = 0; i < 4; ++i) v[i] = v[i] * rstd * ga[i] + sh[i];
    store_h_row<true>(v, H + (size_t)row * 1024, lane);
  }
}

DI float max2nd4(float a, float b, float c, float d, float& m1) {
  const float ab = fmaxf(a, b), cd = fmaxf(c, d);
  m1 = fmaxf(ab, cd);
  return fmaxf(fmaxf(fminf(a, b), fminf(c, d)), fminf(ab, cd));
}
template <int CTRL> DI float dppz(float v) { return __int_as_float(__builtin_amdgcn_update_dpp(0, __float_as_int(v), CTRL, 0xf, 0xf, true)); }
DI float lane_xor4(float v, bool b2) { const float a = dppz<0x114>(v), b = dppz<0x104>(v); return b2 ? a : b; }
DI float lane_xor8(float v, bool b3) { const float a = dppz<0x118>(v), b = dppz<0x108>(v); return b3 ? a : b; }
DI bool beats(float a, int ia, float b, int ib) { return a > b || (a == b && ia < ib); }
DI void route_row(float bias_lane, const f32x4 (&v)[4], LAS char* lds, int lane, int& i0, int& i1, float& w0, float& w1) {
  const LAS f32x4* R = (const LAS f32x4*)lds;
  f32x4 pl4[4];
#pragma unroll
  for (int q = 0; q < 4; ++q) pl4[q] = (f32x4){0.f, 0.f, 0.f, 0.f};
#pragma unroll
  for (int i = 0; i < 4; ++i) {
    const int kq = i * 64 + lane;
    f32x4 wq[16];
#pragma unroll
    for (int j = 0; j < 16; ++j) wq[j] = R[j * 256 + kq];
    __builtin_amdgcn_sched_barrier(0);
#pragma unroll
    for (int kk = 0; kk < 4; ++kk) {
      const float hv = v[i][kk];
      const f32x4 hv4 = (f32x4){hv, hv, hv, hv};
#pragma unroll
      for (int q = 0; q < 4; ++q) pl4[q] = __builtin_elementwise_fma(hv4, wq[kk * 4 + q], pl4[q]);
    }
    __builtin_amdgcn_sched_barrier(0);
  }
  float pl[16];
#pragma unroll
  for (int q = 0; q < 4; ++q) { pl[q * 4 + 0] = pl4[q][0]; pl[q * 4 + 1] = pl4[q][1]; pl[q * 4 + 2] = pl4[q][2]; pl[q * 4 + 3] = pl4[q][3]; }
  const bool b0 = (lane & 1) != 0, b1 = (lane & 2) != 0, b2 = (lane & 4) != 0, b3 = (lane & 8) != 0;
  float r8[8], r4[4], r2[2];
#pragma unroll
  for (int i = 0; i < 8; ++i) { const float keep = b0 ? pl[i + 8] : pl[i], send = b0 ? pl[i] : pl[i + 8]; r8[i] = keep + dppz<0xB1>(send); }
#pragma unroll
  for (int i = 0; i < 4; ++i) { const float keep = b1 ? r8[i + 4] : r8[i], send = b1 ? r8[i] : r8[i + 4]; r4[i] = keep + dppz<0x4E>(send); }
#pragma unroll
  for (int i = 0; i < 2; ++i) { const float keep = b2 ? r4[i + 2] : r4[i], send = b2 ? r4[i] : r4[i + 2]; r2[i] = keep + lane_xor4(send, b2); }
  float lg;
  { const float keep = b3 ? r2[1] : r2[0], send = b3 ? r2[0] : r2[1]; lg = keep + lane_xor8(send, b3); }
  { auto rr = __builtin_amdgcn_permlane16_swap(__float_as_uint(lg), __float_as_uint(lg), false, false); lg = __uint_as_float(rr[0]) + __uint_as_float(rr[1]); }
  { auto rr = __builtin_amdgcn_permlane32_swap(__float_as_uint(lg), __float_as_uint(lg), false, false); lg = __uint_as_float(rr[0]) + __uint_as_float(rr[1]); }
  const float sg = __builtin_amdgcn_rcpf(1.f + __builtin_amdgcn_exp2f(-1.4426950408889634f * lg));
  const float bv = sg + bias_lane;
  const float m1v = lane_xor4(bv, b2), m2v = lane_xor8(bv, b3), m3v = lane_xor8(m1v, b3);
  float mtop; const float m2nd = max2nd4(bv, m1v, m2v, m3v, mtop);
  const float gs = mtop + m2nd;
  const float gA = dppz<0xB1>(gs), gB = dppz<0x4E>(gs), gC = dppz<0x1B>(gs);
  const int g = (b0 ? 2 : 0) + (b1 ? 1 : 0);
  const bool win = beats(gs, g, gA, g ^ 2) && beats(gs, g, gB, g ^ 1) && beats(gs, g, gC, g ^ 3);
  const int el = (b2 ? 2 : 0) + (b3 ? 1 : 0);
  const int rank = (beats(m1v, el ^ 2, bv, el) ? 1 : 0) + (beats(m2v, el ^ 1, bv, el) ? 1 : 0) + (beats(m3v, el ^ 3, bv, el) ? 1 : 0);
  const unsigned long long k0 = __ballot(win && rank == 0), k1 = __ballot(win && rank == 1);
  const int L0 = __builtin_ctzll(k0 | (1ull << 63)), L1 = __builtin_ctzll(k1 | (1ull << 63));
  const float s0 = __int_as_float(__builtin_amdgcn_readlane(__float_as_int(sg), L0));
  const float s1 = __int_as_float(__builtin_amdgcn_readlane(__float_as_int(sg), L1));
  i0 = 8 * (L0 & 1) + 4 * ((L0 >> 1) & 1) + 2 * ((L0 >> 2) & 1) + ((L0 >> 3) & 1);
  i1 = 8 * (L1 & 1) + 4 * ((L1 >> 1) & 1) + 2 * ((L1 >> 2) & 1) + ((L1 >> 3) & 1);
  const float inv = 1.f / (s0 + s1);
  w0 = s0 * inv; w1 = s1 * inv;
}

DI void load_router_lds(const Params& p, LAS char* lds) {
  LAS f32x4* R = (LAS f32x4*)lds;
  __syncthreads();
  for (int g = opaque((int)threadIdx.x); g < 4096; g += NTHR) {
    const int k = g >> 2, q = g & 3;
    R[((k & 3) * 4 + q) * 256 + (k >> 2)] = *(const f32x4*)(p.router_w + (size_t)g * 4);
  }
  __syncthreads();
}

constexpr int CNT_STRIDE = 64;
DI void p5_norm_ffn(const Params& p, int layer, int nrows, LAS char* lds) {
  load_router_lds(p, lds);
  const int tid = opaque((int)threadIdx.x), lane = tid & 63, wid = tid >> 6, gw = blockIdx.x * 8 + wid, ngw = gridDim.x * 8;
  const float* MODl = (const float*)(p.ws + OFF_MOD) + (size_t)layer * 9 * 6144;
  u16* H = (u16*)(p.ws + OFF_H);
  volatile LAS int* lcnt = (volatile LAS int*)(lds + LDS_RMISC + 128);
  volatile LAS int* lbase = lcnt + 16;
  volatile LAS int* stash = (volatile LAS int*)(lds + LDS_RMISC + 1024) + wid * 160;
  int* tok_e = (int*)(p.ws + OFF_TOKE); float* tok_w = (float*)(p.ws + OFF_TOKW); int* tok_p = (int*)(p.ws + OFF_TOKP);
  int* list = (int*)(p.ws + OFF_LIST);
  unsigned* cnt = (unsigned*)(p.ws + OFF_CTRL) + CW_CNT + layer * 16 * CNT_STRIDE;
  if (tid < 16) lcnt[tid] = 0;
  __syncthreads();
  const float bias = p.router_bias[8 * (lane & 1) + 4 * ((lane >> 1) & 1) + 2 * ((lane >> 2) & 1) + ((lane >> 3) & 1)];
  int nst = 0;
  u32x2_t dn[4], xbn[4]; f32x4 xfn[4];
  u16* XB = (u16*)(p.ws + OFF_XB);
  const u16* DELTA = (const u16*)(p.ws + OFF_DELTA);
#define P5_LOAD(r) do { const int _r = (r); _Pragma("unroll") for (int i = 0; i < 4; ++i) { const int _c = lane * 4 + i * 256; \
      dn[i] = __builtin_nontemporal_load((const u32x2_t*)(DELTA + (size_t)_r * 1024 + _c)); \
      if (layer == 0) xfn[i] = __builtin_nontemporal_load((const f32x4*)((_r < NL ? p.x + (size_t)_r * 1024 : p.ctx + (size_t)(_r - NL) * 1024) + _c)); \
      else xbn[i] = __builtin_nontemporal_load((const u32x2_t*)(XB + (size_t)_r * 1024 + _c)); } } while (0)
  if (gw < nrows) P5_LOAD(gw);
  for (int row = gw; row < nrows; row += ngw) {
    f32x4 v[4];
#pragma unroll
    for (int i = 0; i < 4; ++i) {
      if (layer == 0) v[i] = xfn[i]; else v[i] = (f32x4){bflo(xbn[i][0]), bfhi(xbn[i][0]), bflo(xbn[i][1]), bfhi(xbn[i][1])};
      v[i][0] += bflo(dn[i][0]); v[i][1] += bfhi(dn[i][0]); v[i][2] += bflo(dn[i][1]); v[i][3] += bfhi(dn[i][1]);
    }
    if (row + ngw < nrows) P5_LOAD(row + ngw);
#pragma unroll
    for (int i = 0; i < 4; ++i) { u32x2_t o; o[0] = cvtpk(v[i][0], v[i][1]); o[1] = cvtpk(v[i][2], v[i][3]); *(u32x2_t*)(XB + (size_t)row * 1024 + lane * 4 + i * 256) = o; }
    const int mr = row < NL ? row / S_ : 8;
    norm_mod_row(v, p.norm_ffn_g + layer * 1024, MODl + (size_t)mr * 6144 + 3 * 1024, lane);
    store_h_row(v, H + (size_t)row * 1024, lane);
    int i0, i1; float w0, w1;
    route_row(bias, v, lds, lane, i0, i1, w0, w1);
    if (lane == 0) {
      const int lp0 = __hip_atomic_fetch_add((LAS int*)&lcnt[i0], 1, __ATOMIC_RELAXED, __HIP_MEMORY_SCOPE_WORKGROUP);
      const int lp1 = __hip_atomic_fetch_add((LAS int*)&lcnt[i1], 1, __ATOMIC_RELAXED, __HIP_MEMORY_SCOPE_WORKGROUP);
      tok_e[row * 2] = i0; tok_e[row * 2 + 1] = i1;
      tok_w[row * 2] = w0; tok_w[row * 2 + 1] = w1;
      stash[nst * 4 + 0] = i0; stash[nst * 4 + 1] = lp0; stash[nst * 4 + 2] = i1; stash[nst * 4 + 3] = lp1;
    }
    ++nst;
  }
  __syncthreads();
  if (tid < 16) { const int c = lcnt[tid]; lbase[tid] = c > 0 ? (int)atomicAdd(&cnt[tid * CNT_STRIDE], (unsigned)c) : 0; }
  __syncthreads();
  if (lane == 0) {
    int k = 0;
    for (int row = gw; row < nrows; row += ngw, ++k) {
      const int e0 = stash[k * 4 + 0], e1 = stash[k * 4 + 2];
      const int p0 = lbase[e0] + stash[k * 4 + 1], p1 = lbase[e1] + stash[k * 4 + 3];
      tok_p[row * 2] = p0; tok_p[row * 2 + 1] = p1;
      list[(size_t)e0 * NT + p0] = row; list[(size_t)e1 * NT + p1] = row;
    }
  }
}


template <int CTRL> DI int dpp_movi(int v) { return __builtin_amdgcn_update_dpp(0, v, CTRL, 0xf, 0xf, false); }
DI void p5_norm_ffn8(const Params& p, int layer, int nrows, LAS char* lds) {
  const int tid = opaque((int)threadIdx.x), lane = tid & 63, wid = __builtin_amdgcn_readfirstlane(tid >> 6);
  const float* MODl = (const float*)(p.ws + OFF_MOD) + (size_t)layer * 9 * 6144;
  u16* H = (u16*)(p.ws + OFF_H);
  volatile LAS int* lcnt = (volatile LAS int*)(lds + LDS_RMISC + 128);
  volatile LAS int* lbase = lcnt + 16;
  volatile LAS int* stash = (volatile LAS int*)(lds + LDS_RMISC + 1024) + (wid & 1) * 288;
  int* tok_e = (int*)(p.ws + OFF_TOKE); float* tok_w = (float*)(p.ws + OFF_TOKW); int* tok_p = (int*)(p.ws + OFF_TOKP);
  int* list = (int*)(p.ws + OFF_LIST);
  unsigned* cnt = (unsigned*)(p.ws + OFF_CTRL) + CW_CNT + layer * 16 * CNT_STRIDE;
  constexpr int RS = 2064;
  LAS char* HH = lds; LAS char* HL = lds + 8 * RS; LAS float* PART = (LAS float*)(lds + 16 * RS);
  __syncthreads();
  if (tid < 16) lcnt[tid] = 0;
  bf16x8 whi[4], wlo[4];
  { const int e = lane & 15, kg = lane >> 4;
#pragma unroll
    for (int sx = 0; sx < 4; ++sx) {
      u32x4_t hp, lp;
#pragma unroll
      for (int jj = 0; jj < 4; ++jj) {
        const int k = 128 * wid + 32 * sx + 8 * kg + 2 * jj;
        const float a = p.router_w[(size_t)k * 16 + e], b = p.router_w[(size_t)(k + 1) * 16 + e];
        const unsigned hh = cvtpk(a, b);
        hp[jj] = hh; lp[jj] = cvtpk(a - bflo(hh), b - bfhi(hh));
      }
      whi[sx] = __builtin_bit_cast(bf16x8, hp); wlo[sx] = __builtin_bit_cast(bf16x8, lp);
    } }
  __syncthreads();
  const float bias = p.router_bias[lane & 15];
  const int G = (int)gridDim.x, nb = nrows >> 3;
  u32x2_t dn[4], xbn[4], dn2[4], xbn2[4]; f32x4 xfn[4], xfn2[4];
  u16* XB = (u16*)(p.ws + OFF_XB);
  const u16* DELTA = (const u16*)(p.ws + OFF_DELTA);
#define P5_LOAD(r, DN, XBN, XFN) do { const int _r = (r); _Pragma("unroll") for (int i = 0; i < 4; ++i) { const int _c = lane * 4 + i * 256; \
      DN[i] = __builtin_nontemporal_load((const u32x2_t*)(DELTA + (size_t)_r * 1024 + _c)); \
      if (layer == 0) XFN[i] = __builtin_nontemporal_load((const f32x4*)((_r < NL ? p.x + (size_t)_r * 1024 : p.ctx + (size_t)(_r - NL) * 1024) + _c)); \
      else XBN[i] = __builtin_nontemporal_load((const u32x2_t*)(XB + (size_t)_r * 1024 + _c)); } } while (0)
  const int per = (nb + G - 1) / G, b0 = (int)blockIdx.x * per, b1 = b0 + per < nb ? b0 + per : nb;
  f32x4 ga[4], sh[4];
#pragma unroll
  for (int i = 0; i < 4; ++i) { ga[i] = (f32x4){0.f, 0.f, 0.f, 0.f}; sh[i] = ga[i]; }
  int mrc = -1;
  int bt = b0;
  if (bt < b1) P5_LOAD(bt * 8 + wid, dn, xbn, xfn);
  if (bt + 1 < b1) P5_LOAD((bt + 1) * 8 + wid, dn2, xbn2, xfn2);
  int nst = 0;
  for (; bt < b1; ++bt) {
    const int row = bt * 8 + wid;
    f32x4 v[4];
#pragma unroll
    for (int i = 0; i < 4; ++i) {
      if (layer == 0) v[i] = xfn[i]; else v[i] = (f32x4){bflo(xbn[i][0]), bfhi(xbn[i][0]), bflo(xbn[i][1]), bfhi(xbn[i][1])};
      v[i][0] += bflo(dn[i][0]); v[i][1] += bfhi(dn[i][0]); v[i][2] += bflo(dn[i][1]); v[i][3] += bfhi(dn[i][1]);
      dn[i] = dn2[i]; xbn[i] = xbn2[i]; xfn[i] = xfn2[i];
    }
    if (bt + 2 < b1) P5_LOAD((bt + 2) * 8 + wid, dn2, xbn2, xfn2);
#pragma unroll
    for (int i = 0; i < 4; ++i) { u32x2_t o; o[0] = cvtpk(v[i][0], v[i][1]); o[1] = cvtpk(v[i][2], v[i][3]); *(u32x2_t*)(XB + (size_t)row * 1024 + lane * 4 + i * 256) = o; }
    const int mr = row < NL ? row / S_ : 8;
    if (mr != mrc) {
      mrc = mr;
      const float* md = MODl + (size_t)mr * 6144 + 3 * 1024;
#pragma unroll
      for (int i = 0; i < 4; ++i) {
        const f32x4 gg = *(const f32x4*)(p.norm_ffn_g + layer * 1024 + lane * 4 + i * 256);
        const f32x4 sc = *(const f32x4*)(md + 1024 + lane * 4 + i * 256);
        ga[i] = gg * (sc + 1.f); sh[i] = *(const f32x4*)(md + lane * 4 + i * 256);
      }
    }
    {
      float ss = 0.f;
#pragma unroll
      for (int i = 0; i < 4; ++i) ss += v[i].x * v[i].x + v[i].y * v[i].y + v[i].z * v[i].z + v[i].w * v[i].w;
      ss = wave_sum(ss);
      const float rstd = rsqrtf(ss * (1.f / 1024.f) + EPS);
#pragma unroll
      for (int i = 0; i < 4; ++i) v[i] = v[i] * rstd * ga[i] + sh[i];
    }
#pragma unroll
    for (int i = 0; i < 4; ++i) {
      u32x2_t hi, lo; hi[0] = cvtpk(v[i].x, v[i].y); hi[1] = cvtpk(v[i].z, v[i].w);
      lo[0] = cvtpk(v[i].x - bflo(hi[0]), v[i].y - bfhi(hi[0])); lo[1] = cvtpk(v[i].z - bflo(hi[1]), v[i].w - bfhi(hi[1]));
      *(u32x2_t*)(H + (size_t)row * 1024 + lane * 4 + i * 256) = hi;
      *(LAS u32x2_t*)(HH + wid * RS + (lane * 4 + i * 256) * 2) = hi;
      *(LAS u32x2_t*)(HL + wid * RS + (lane * 4 + i * 256) * 2) = lo;
    }
    __syncthreads();
    {
      const int m = lane & 15, kg = lane >> 4, irow = 2 * (m >> 2) + (m & 1);
      f32x4 acc = (f32x4){0.f, 0.f, 0.f, 0.f};
#pragma unroll
      for (int sx = 0; sx < 4; ++sx) {
        const int ko = (128 * wid + 32 * sx + 8 * kg) * 2;
        const bf16x8 ah = *(const LAS bf16x8*)(HH + irow * RS + ko), al = *(const LAS bf16x8*)(HL + irow * RS + ko);
        acc = __builtin_amdgcn_mfma_f32_16x16x32_bf16(ah, whi[sx], acc, 0, 0, 0);
        acc = __builtin_amdgcn_mfma_f32_16x16x32_bf16(ah, wlo[sx], acc, 0, 0, 0);
        acc = __builtin_amdgcn_mfma_f32_16x16x32_bf16(al, whi[sx], acc, 0, 0, 0);
      }
      *(LAS f32x4*)(PART + wid * 256 + lane * 4) = acc;
    }
    __syncthreads();
    if (wid < 2) {
      const int rg = lane >> 4;
      float lg = 0.f;
#pragma unroll
      for (int w = 0; w < 8; ++w) lg += PART[w * 256 + lane * 4 + wid];
      const float sg = __builtin_amdgcn_rcpf(1.f + __builtin_amdgcn_exp2f(-1.4426950408889634f * lg));
      const float bv = sg + bias;
      const float m1v = dpp_mov<0xB1>(bv), m2v = dpp_mov<0x4E>(bv), m3v = dpp_mov<0x1B>(bv);
      float mtop; const float m2nd = max2nd4(bv, m1v, m2v, m3v, mtop);
      const float gs = mtop + m2nd;
      const int g = (lane >> 2) & 3, el = lane & 3;
      const float gA = dpp_mov<0x124>(gs), gB = dpp_mov<0x128>(gs), gC = dpp_mov<0x12C>(gs);
      const int iA = dpp_movi<0x124>(g), iB = dpp_movi<0x128>(g), iC = dpp_movi<0x12C>(g);
      const bool win = beats(gs, g, gA, iA) && beats(gs, g, gB, iB) && beats(gs, g, gC, iC);
      const int rank = (beats(m1v, el ^ 1, bv, el) ? 1 : 0) + (beats(m2v, el ^ 2, bv, el) ? 1 : 0) + (beats(m3v, el ^ 3, bv, el) ? 1 : 0);
      const unsigned long long k0 = __ballot(win && rank == 0), k1 = __ballot(win && rank == 1);
      const int sh = 16 * rg;
      const int e0 = __builtin_ctz(((unsigned)(k0 >> sh) & 0xffffu) | 0x10000u) & 15, e1 = __builtin_ctz(((unsigned)(k1 >> sh) & 0xffffu) | 0x10000u) & 15;
      const float s0 = __int_as_float(__builtin_amdgcn_ds_bpermute((sh + e0) << 2, __float_as_int(sg)));
      const float s1 = __int_as_float(__builtin_amdgcn_ds_bpermute((sh + e1) << 2, __float_as_int(sg)));
      const float inv = 1.f / (s0 + s1);
      if ((lane & 15) == 0) {
        const int r2 = bt * 8 + 2 * rg + wid;
        const int lp0 = __hip_atomic_fetch_add((LAS int*)&lcnt[e0], 1, __ATOMIC_RELAXED, __HIP_MEMORY_SCOPE_WORKGROUP);
        const int lp1 = __hip_atomic_fetch_add((LAS int*)&lcnt[e1], 1, __ATOMIC_RELAXED, __HIP_MEMORY_SCOPE_WORKGROUP);
        tok_e[r2 * 2] = e0; tok_e[r2 * 2 + 1] = e1;
        tok_w[r2 * 2] = s0 * inv; tok_w[r2 * 2 + 1] = s1 * inv;
        volatile LAS int* st = stash + (nst * 4 + rg) * 4;
        st[0] = e0; st[1] = lp0; st[2] = e1; st[3] = lp1;
      }
    }
    ++nst;
  }
#undef P5_LOAD
  __syncthreads();
  if (tid < 16) { const int c = lcnt[tid]; lbase[tid] = c > 0 ? (int)atomicAdd(&cnt[tid * CNT_STRIDE], (unsigned)c) : 0; }
  __syncthreads();
  if (wid < 2 && (lane & 15) == 0) {
    const int rg = lane >> 4;
    int k = 0;
    for (int b2 = b0; b2 < b1; ++b2, ++k) {
      const int r2 = b2 * 8 + 2 * rg + wid;
      volatile LAS int* st = stash + (k * 4 + rg) * 4;
      const int e0 = st[0], e1 = st[2];
      const int p0 = lbase[e0] + st[1], p1 = lbase[e1] + st[3];
      tok_p[r2 * 2] = p0; tok_p[r2 * 2 + 1] = p1;
      list[(size_t)e0 * NT + p0] = r2; list[(size_t)e1 * NT + p1] = r2;
    }
  }
}

DI void seg_scan(const Params& p, int layer, int (&tb)[NE + 1]) {
  const unsigned* cnt = (const unsigned*)(p.ws + OFF_CTRL) + CW_CNT + layer * 16 * CNT_STRIDE;
  int acc = 0;
#pragma unroll
  for (int e = 0; e < NE; ++e) { tb[e] = acc; acc += ((int)cnt[e * CNT_STRIDE] + 255) >> 8; }
  tb[NE] = acc;
}

DI void p8_combine(const Params& p, int layer, int nrows) {
  const int tid_ = opaque((int)threadIdx.x); const int lane = tid_ & 63, gw = blockIdx.x * 8 + (tid_ >> 6), ngw = gridDim.x * 8;
  const float* MODl = (const float*)(p.ws + OFF_MOD) + (size_t)layer * 9 * 6144;
  const float* MODn = (const float*)(p.ws + OFF_MOD) + (size_t)(layer + 1) * 9 * 6144;
  u16* H = (u16*)(p.ws + OFF_H);
  const u16* YSH = (const u16*)(p.ws + OFF_YSH);
  const u16* YEXP = (const u16*)(p.ws + OFF_YEXP);
  u16* XB = (u16*)(p.ws + OFF_XB);
  const int* tok_e = (const int*)(p.ws + OFF_TOKE); const float* tok_w = (const float*)(p.ws + OFF_TOKW); const int* tok_p = (const int*)(p.ws + OFF_TOKP);
  int tb[NE + 1]; seg_scan(p, layer, tb);
  int me0 = 0, me1 = 0, mp0 = 0, mp1 = 0; float mw0 = 0.f, mw1 = 0.f;
  u32x2_t an[4], bn[4], cn[4], xn[4]; float nw0 = 0.f, nw1 = 0.f;
#define P8_META(r) do { me0 = tok_e[(r) * 2]; me1 = tok_e[(r) * 2 + 1]; mp0 = tok_p[(r) * 2]; mp1 = tok_p[(r) * 2 + 1]; mw0 = tok_w[(r) * 2]; mw1 = tok_w[(r) * 2 + 1]; } while (0)
#define P8_DATA(r) do { int ps0 = 0, ps1 = 0; _Pragma("unroll") for (int e = 0; e < NE; ++e) { if (e == me0) ps0 = tb[e]; if (e == me1) ps1 = tb[e]; } \
    const size_t s0 = (size_t)ps0 * 256 + mp0, s1 = (size_t)ps1 * 256 + mp1; nw0 = mw0; nw1 = mw1; const u16* xrn = XB + (size_t)(r) * 1024; \
    _Pragma("unroll") for (int i = 0; i < 4; ++i) { const int cidx = lane * 4 + i * 256; \
      an[i] = __builtin_nontemporal_load((const u32x2_t*)(YEXP + s0 * 1024 + cidx)); bn[i] = __builtin_nontemporal_load((const u32x2_t*)(YEXP + s1 * 1024 + cidx)); \
      cn[i] = __builtin_nontemporal_load((const u32x2_t*)(YSH + (size_t)(r) * 1024 + cidx)); xn[i] = __builtin_nontemporal_load((const u32x2_t*)(xrn + cidx)); } } while (0)
  const int chunk = (nrows + ngw - 1) / ngw, r0 = gw * chunk, r1 = r0 + chunk < nrows ? r0 + chunk : nrows;
  f32x4 gt[4], ga[4], sh[4];
#pragma unroll
  for (int i = 0; i < 4; ++i) { gt[i] = (f32x4){0.f, 0.f, 0.f, 0.f}; ga[i] = gt[i]; sh[i] = gt[i]; }
  if (layer != 0) {
#pragma unroll
    for (int i = 0; i < 4; ++i) ga[i] = *(const f32x4*)(p.final_norm_g + lane * 4 + i * 256);
  }
  int mrc = -1;
  if (r0 < r1) { P8_META(r0); P8_DATA(r0); }
  if (r0 + 1 < r1) P8_META(r0 + 1);
  for (int row = r0; row < r1; ++row) {
    u32x2_t a[4], b[4], c[4]; f32x4 v[4];
#pragma unroll
    for (int i = 0; i < 4; ++i) { a[i] = an[i]; b[i] = bn[i]; c[i] = cn[i]; v[i] = (f32x4){bflo(xn[i][0]), bfhi(xn[i][0]), bflo(xn[i][1]), bfhi(xn[i][1])}; }
    const float w0 = nw0, w1 = nw1;
    if (row + 1 < r1) P8_DATA(row + 1);
    if (row + 2 < r1) P8_META(row + 2);
    float* xr = xrow_out(p, row);
    const int mr = row < NL ? row / S_ : 8;
    if (mr != mrc) {
      mrc = mr;
#pragma unroll
      for (int i = 0; i < 4; ++i) {
        const int cidx = lane * 4 + i * 256;
        gt[i] = *(const f32x4*)(MODl + (size_t)mr * 6144 + 5 * 1024 + cidx);
        if (layer == 0) {
          const f32x4 gg = *(const f32x4*)(p.norm_mix_g + 1024 + cidx);
          const f32x4 sc = *(const f32x4*)(MODn + (size_t)mr * 6144 + 1024 + cidx);
          ga[i] = gg * (sc + 1.f); sh[i] = *(const f32x4*)(MODn + (size_t)mr * 6144 + cidx);
        }
      }
    }
#pragma unroll
    for (int i = 0; i < 4; ++i) {
      const f32x4 g = gt[i];
      f32x4 x = v[i];
      x.x += g.x * (w0 * bflo(a[i][0]) + w1 * bflo(b[i][0]) + bflo(c[i][0]));
      x.y += g.y * (w0 * bfhi(a[i][0]) + w1 * bfhi(b[i][0]) + bfhi(c[i][0]));
      x.z += g.z * (w0 * bflo(a[i][1]) + w1 * bflo(b[i][1]) + bflo(c[i][1]));
      x.w += g.w * (w0 * bfhi(a[i][1]) + w1 * bfhi(b[i][1]) + bfhi(c[i][1]));
      v[i] = x;
    }
    if (layer == 0) {
#pragma unroll
      for (int i = 0; i < 4; ++i) { u32x2_t o; o[0] = cvtpk(v[i].x, v[i].y); o[1] = cvtpk(v[i].z, v[i].w); *(u32x2_t*)(XB + (size_t)row * 1024 + lane * 4 + i * 256) = o; }
      float ss = 0.f;
#pragma unroll
      for (int i = 0; i < 4; ++i) ss += v[i].x * v[i].x + v[i].y * v[i].y + v[i].z * v[i].z + v[i].w * v[i].w;
      ss = wave_sum(ss);
      const float rstd = rsqrtf(ss * (1.f / 1024.f) + EPS);
#pragma unroll
      for (int i = 0; i < 4; ++i) v[i] = v[i] * rstd * ga[i] + sh[i];
      store_h_row<true>(v, H + (size_t)row * 1024, lane);
    } else {
      float ss = 0.f;
#pragma unroll
      for (int i = 0; i < 4; ++i) ss += v[i].x * v[i].x + v[i].y * v[i].y + v[i].z * v[i].z + v[i].w * v[i].w;
      ss = wave_sum(ss);
      const float rstd = rsqrtf(ss * (1.f / 1024.f) + EPS);
#pragma unroll
      for (int i = 0; i < 4; ++i) __builtin_nontemporal_store(v[i] * rstd * ga[i], (f32x4*)(xr + lane * 4 + i * 256));
    }
  }
#undef P8_META
#undef P8_DATA
}

DI void glds16(const u16* g, LAS char* l) {
  __builtin_amdgcn_global_load_lds((const void*)g, (LAS void*)l, 16, 0, 0);
}
struct TilePtrs { const u16 *a0, *a1, *a2, *a3, *b0; long ldb32; };
#define GT_ISSUE_P(T, kt, s) do { const int _ko = (kt) * 64; LAS char* _d = ldst + (s) * 32768; \
    glds16((T).a0 + _ko, _d); glds16((T).a1 + _ko, _d + 4096); glds16((T).a2 + _ko, _d + 8192); glds16((T).a3 + _ko, _d + 12288); \
    glds16((T).b0 + _ko, _d + 16384); glds16((T).b0 + (T).ldb32 + _ko, _d + 20480); glds16((T).b0 + 2 * (T).ldb32 + _ko, _d + 24576); glds16((T).b0 + 3 * (T).ldb32 + _ko, _d + 28672); } while (0)
template <bool HOIST = true>
DI void gemm_tile_s(LAS char* lds, const TilePtrs& cur, bool issued, const TilePtrs& nxt, bool has_next, int nk, f32x4 (&acc)[4][4]) {
  const int tid = opaque(VTID), lane = tid & 63, wid = tid >> 6, wr = wid >> 1, wc = wid & 1, fr = lane & 15, fq = lane >> 4;
  const int kx = (fr >> 1) & 7;
  const int aoff0 = (wr * 64 + fr) * 128 + ((fq ^ kx) * 16), aoff1 = (wr * 64 + fr) * 128 + (((4 + fq) ^ kx) * 16);
  const int boff0 = 16384 + (wc * 64 + fr) * 128 + ((fq ^ kx) * 16), boff1 = 16384 + (wc * 64 + fr) * 128 + (((4 + fq) ^ kx) * 16);
#pragma unroll
  for (int m = 0; m < 4; ++m)
#pragma unroll
    for (int n = 0; n < 4; ++n) acc[m][n] = (f32x4){0.f, 0.f, 0.f, 0.f};
  LAS char* ldst = lds + tid * 16;
  if (!issued) GT_ISSUE_P(cur, 0, 0);
#pragma unroll 1
  for (int kt = 0; kt < nk; ++kt) {
    asm volatile("s_waitcnt vmcnt(0)" ::: "memory");
    __syncthreads();
    if (kt + 1 < nk) GT_ISSUE_P(cur, kt + 1, (kt + 1) & 1);
    else if (has_next) GT_ISSUE_P(nxt, 0, 0);
    const LAS char* sb = lds + (kt & 1) * 32768;
    if (!HOIST) {
#pragma unroll
      for (int h = 0; h < 2; ++h) {
        bf16x8 af1[4], bf1[4];
#pragma unroll
        for (int m = 0; m < 4; ++m) af1[m] = *(const LAS bf16x8*)(sb + (h ? aoff1 : aoff0) + m * 2048);
#pragma unroll
        for (int n = 0; n < 4; ++n) bf1[n] = *(const LAS bf16x8*)(sb + (h ? boff1 : boff0) + n * 2048);
#pragma unroll
        for (int m = 0; m < 4; ++m)
#pragma unroll
          for (int n = 0; n < 4; ++n) acc[m][n] = __builtin_amdgcn_mfma_f32_16x16x32_bf16(bf1[n], af1[m], acc[m][n], 0, 0, 0);
      }
      continue;
    }
    bf16x8 af[2][4], bfr[2][4];
    const unsigned aad0 = (unsigned)(size_t)(sb + aoff0), aad1 = (unsigned)(size_t)(sb + aoff1), bad0 = (unsigned)(size_t)(sb + boff0), bad1 = (unsigned)(size_t)(sb + boff1);
#define GT_LDR(dst, ad, off) asm volatile("ds_read_b128 %0, %1 offset:%c2" : "=v"(dst) : "v"(ad), "i"(off))
    GT_LDR(af[0][0], aad0, 0); GT_LDR(af[0][1], aad0, 2048); GT_LDR(af[0][2], aad0, 4096); GT_LDR(af[0][3], aad0, 6144);
    GT_LDR(bfr[0][0], bad0, 0); GT_LDR(bfr[0][1], bad0, 2048); GT_LDR(bfr[0][2], bad0, 4096); GT_LDR(bfr[0][3], bad0, 6144);
    GT_LDR(af[1][0], aad1, 0); GT_LDR(af[1][1], aad1, 2048); GT_LDR(af[1][2], aad1, 4096); GT_LDR(af[1][3], aad1, 6144);
    GT_LDR(bfr[1][0], bad1, 0); GT_LDR(bfr[1][1], bad1, 2048); GT_LDR(bfr[1][2], bad1, 4096); GT_LDR(bfr[1][3], bad1, 6144);
#undef GT_LDR
    asm volatile("s_waitcnt lgkmcnt(8)" : "+v"(af[0][0]), "+v"(af[0][1]), "+v"(af[0][2]), "+v"(af[0][3]), "+v"(bfr[0][0]), "+v"(bfr[0][1]), "+v"(bfr[0][2]), "+v"(bfr[0][3]) :: "memory");
    __builtin_amdgcn_sched_barrier(0);
#pragma unroll
    for (int m = 0; m < 4; ++m)
#pragma unroll
      for (int n = 0; n < 4; ++n) acc[m][n] = __builtin_amdgcn_mfma_f32_16x16x32_bf16(bfr[0][n], af[0][m], acc[m][n], 0, 0, 0);
    __builtin_amdgcn_sched_barrier(0);
    asm volatile("s_waitcnt lgkmcnt(0)" : "+v"(af[1][0]), "+v"(af[1][1]), "+v"(af[1][2]), "+v"(af[1][3]), "+v"(bfr[1][0]), "+v"(bfr[1][1]), "+v"(bfr[1][2]), "+v"(bfr[1][3]) :: "memory");
    __builtin_amdgcn_sched_barrier(0);
#pragma unroll
    for (int m = 0; m < 4; ++m)
#pragma unroll
      for (int n = 0; n < 4; ++n) acc[m][n] = __builtin_amdgcn_mfma_f32_16x16x32_bf16(bfr[1][n], af[1][m], acc[m][n], 0, 0, 0);
    __builtin_amdgcn_sched_barrier(0);
  }
}
DI void gemm_tile(LAS char* lds, const u16* a0, long lda32, const u16* b0, long ldb32, int nk, f32x4 (&acc)[4][4]) {
  TilePtrs t; t.a0 = a0; t.a1 = a0 + lda32; t.a2 = a0 + 2 * lda32; t.a3 = a0 + 3 * lda32; t.b0 = b0; t.ldb32 = ldb32;
  gemm_tile_s<false>(lds, t, false, t, false, nk, acc);
  __syncthreads();
}
DI int gt_chunk(int tid) { return ((tid & 7) ^ ((tid >> 4) & 7)) * 8; }
DI int gt_row0(int tid) { return tid >> 3; }

DI void sincos_rev(float pos, float invf, float& sn, float& cs) {
  float rev = pos * invf * 0.15915494309189535f;
  rev -= rintf(rev);
  sn = __builtin_amdgcn_sinf(rev); cs = __builtin_amdgcn_cosf(rev);
}
DI void st_bf4(u16* dst, const f32x4& v) { uint2 o; o.x = cvtpk(v[0], v[1]); o.y = cvtpk(v[2], v[3]); *(uint2*)dst = o; }


DI void stage_put4(LAS char* st, int row, int c8, const f32x4& v) {
  u32x2_t o; o[0] = cvtpk(v[0], v[1]); o[1] = cvtpk(v[2], v[3]);
  *(LAS u32x2_t*)(st + row * 128 + ((c8 ^ (row & 15)) * 8)) = o;
}
DI u32x4_t stage_get16(const LAS char* st, int row, int u) {
  u32x4_t v = *(const LAS u32x4_t*)(st + row * 128 + ((u ^ ((row >> 1) & 7)) * 16));
  if (row & 1) v = __builtin_shufflevector(v, v, 2, 3, 0, 1);
  return v;
}
template <int NC>
DI void stage_flush(const LAS char* st, u16* dst, size_t ld, int lane) {
  constexpr int UPR = NC / 8;
  constexpr int RPI = 64 / UPR;
#pragma unroll
  for (int i = 0; i < 64 / RPI; ++i) {
    const int row = i * RPI + lane / UPR, u = lane % UPR;
    const u32x4_t v = stage_get16(st, row, u);
    *(u32x4_t*)(dst + (size_t)row * ld + u * 8) = v;
  }
}

template <bool F32SRC>
DI void stage_flush_resid(const LAS char* st, const float* __restrict__ xs, u16* xb, int lane) {
#pragma unroll
  for (int h = 0; h < 2; ++h) {
    f32x4 xa[4], xc[4]; u32x4_t xo[4];
#pragma unroll
    for (int i = 0; i < 4; ++i) {
      const int row = (h * 4 + i) * 8 + (lane >> 3), u = lane & 7;
      if (F32SRC) { xa[i] = __builtin_nontemporal_load((const f32x4*)(xs + (size_t)row * 1024 + u * 8)); xc[i] = __builtin_nontemporal_load((const f32x4*)(xs + (size_t)row * 1024 + u * 8 + 4)); }
      else xo[i] = __builtin_nontemporal_load((const u32x4_t*)(xb + (size_t)row * 1024 + u * 8));
    }
#pragma unroll
    for (int i = 0; i < 4; ++i) {
      const int row = (h * 4 + i) * 8 + (lane >> 3), u = lane & 7;
      const u32x4_t d = stage_get16(st, row, u);
      if (!F32SRC) { xa[i] = (f32x4){bflo(xo[i][0]), bfhi(xo[i][0]), bflo(xo[i][1]), bfhi(xo[i][1])}; xc[i] = (f32x4){bflo(xo[i][2]), bfhi(xo[i][2]), bflo(xo[i][3]), bfhi(xo[i][3])}; }
      u32x4_t o;
      o[0] = cvtpk(xa[i][0] + bflo(d[0]), xa[i][1] + bfhi(d[0])); o[1] = cvtpk(xa[i][2] + bflo(d[1]), xa[i][3] + bfhi(d[1]));
      o[2] = cvtpk(xc[i][0] + bflo(d[2]), xc[i][1] + bfhi(d[2])); o[3] = cvtpk(xc[i][2] + bflo(d[3]), xc[i][3] + bfhi(d[3]));
      *(u32x4_t*)(xb + (size_t)row * 1024 + u * 8) = o;
    }
  }
}

DI float quad_sum_x(float v) {
  { auto rr = __builtin_amdgcn_permlane16_swap(__float_as_uint(v), __float_as_uint(v), false, false); v = __uint_as_float(rr[0]) + __uint_as_float(rr[1]); }
  { auto rr = __builtin_amdgcn_permlane32_swap(__float_as_uint(v), __float_as_uint(v), false, false); v = __uint_as_float(rr[0]) + __uint_as_float(rr[1]); }
  return v;
}
template <int NC>
DI void flush16_nt(const LAS char* st, u16* dst, size_t ld, int lane) {
  constexpr int UPR = NC / 8, RPI = 64 / UPR;
#pragma unroll
  for (int i = 0; i < 16 / RPI; ++i) {
    const int row = i * RPI + lane / UPR, u = lane % UPR;
    __builtin_nontemporal_store(stage_get16(st, row, u), (u32x4_t*)(dst + (size_t)row * ld + u * 8));
  }
}
template <int NC>
DI void flush16(const LAS char* st, u16* dst, size_t ld, int lane) {
  constexpr int UPR = NC / 8, RPI = 64 / UPR;
#pragma unroll
  for (int i = 0; i < 16 / RPI; ++i) {
    const int row = i * RPI + lane / UPR, u = lane % UPR;
    *(u32x4_t*)(dst + (size_t)row * ld + u * 8) = stage_get16(st, row, u);
  }
}
template <bool G8>
DI void epi_inproj(const Params& p, int layer, f32x4 (&acc)[4][4], int m0, int seg, int wr, int fr, int fq, LAS float* rowss_slot, float* rowss_g, LAS char* stg, int lane) {
  char* ws = p.ws;
  const bool lat = m0 < NL;
  const int rbase = m0 + wr * 64 + fr;
  u16* dst; int ld, cb; int kind;
  if (seg < 6) { dst = (u16*)(ws + OFF_SWQ); ld = 384; cb = seg * 64; kind = 1; }
  else if (seg < 8) { dst = (u16*)(ws + OFF_SWK); ld = 128; cb = (seg - 6) * 64; kind = 1; }
  else if (seg < 10) { dst = (u16*)(ws + OFF_SWV); ld = 128; cb = (seg - 8) * 64; kind = 0; }
  else if (seg < 16) { dst = (u16*)(ws + OFF_GLQ); ld = 384; cb = (seg - 10) * 64; kind = 2; }
  else if (seg < 18) { dst = (u16*)(ws + OFF_GLK); ld = 128; cb = (seg - 16) * 64; kind = 3; }
  else if (seg < 20) { dst = (u16*)(ws + OFF_GLV); ld = 128; cb = (seg - 18) * 64; kind = 0; }
  else if (seg < 24) { dst = (u16*)(ws + OFF_QLAT); ld = 256; cb = (seg - 20) * 64; kind = 4; }
  else if (seg < 26) { dst = (u16*)(ws + OFF_KVLAT); ld = 128; cb = (seg - 24) * 64; kind = 5; }
  else if (seg == 26) { dst = (u16*)(ws + OFF_MLKR); ld = 32; cb = 0; kind = 6; }
  else return;
  if (kind == 2 || kind == 3) {
    const float* gain = (kind == 2 ? p.glb_q_gain : p.glb_k_gain) + layer * 64;
    f32x4 gv[4];
#pragma unroll
    for (int n = 0; n < 4; ++n) gv[n] = *(const f32x4*)(gain + n * 16 + fq * 4);
#pragma unroll
    for (int m = 0; m < 4; ++m) {
      float ss = 0.f;
#pragma unroll
      for (int n = 0; n < 4; ++n) ss += acc[m][n][0] * acc[m][n][0] + acc[m][n][1] * acc[m][n][1] + acc[m][n][2] * acc[m][n][2] + acc[m][n][3] * acc[m][n][3];
      ss = quad_sum_x(ss);
      const float r = rsqrtf(ss * (1.f / 64.f) + EPS);
#pragma unroll
      for (int n = 0; n < 4; ++n) acc[m][n] = acc[m][n] * r * gv[n];
    }
  }
  if (kind == 4 || kind == 5) {
    const float* gain = (kind == 4 ? p.mla_q_gain + layer * 256 : p.mla_kv_gain + layer * 128) + cb;
    f32x4 gv[4];
#pragma unroll
    for (int n = 0; n < 4; ++n) gv[n] = *(const f32x4*)(gain + n * 16 + fq * 4);
#pragma unroll
    for (int m = 0; m < 4; ++m) {
      float ss = 0.f;
#pragma unroll
      for (int n = 0; n < 4; ++n) ss += acc[m][n][0] * acc[m][n][0] + acc[m][n][1] * acc[m][n][1] + acc[m][n][2] * acc[m][n][2] + acc[m][n][3] * acc[m][n][3];
      ss = quad_sum_x(ss);
      if (fq == 0) { if (G8) rowss_g[(size_t)(seg - 20) * NT + m0 + wr * 64 + m * 16 + fr] = ss; else rowss_slot[wr * 64 + m * 16 + fr] = ss; }
#pragma unroll
      for (int n = 0; n < 4; ++n) acc[m][n] = acc[m][n] * gv[n];
    }
  }
  if (lat && (kind == 1 || kind == 2 || kind == 3)) {
    float invf[4];
#pragma unroll
    for (int j = 0; j < 4; ++j) invf[j] = __builtin_amdgcn_exp2f(-(float)(fq * 4 + j) * (13.287712379549449f / 16.f));
#pragma unroll
    for (int m = 0; m < 4; ++m) {
      const int t = (rbase + m * 16) & (S_ - 1);
      const float prow = (float)(t >> 6), pcol = (float)(t & 63);
#pragma unroll
      for (int j = 0; j < 4; ++j) {
        float sr, cr, sc, cc;
        sincos_rev(prow, invf[j], sr, cr); sincos_rev(pcol, invf[j], sc, cc);
        float x1 = acc[m][0][j], x2 = acc[m][1][j];
        acc[m][0][j] = x1 * cr - x2 * sr; acc[m][1][j] = x2 * cr + x1 * sr;
        x1 = acc[m][2][j]; x2 = acc[m][3][j];
        acc[m][2][j] = x1 * cc - x2 * sc; acc[m][3][j] = x2 * cc + x1 * sc;
      }
      if (G8) __builtin_amdgcn_sched_barrier(0);
    }
  }
  if (kind == 6) {
    if (lat) {
      float invf[4];
#pragma unroll
      for (int j = 0; j < 4; ++j) invf[j] = __builtin_amdgcn_exp2f(-(float)((fq & 1) * 4 + j) * (13.287712379549449f / 8.f));
#pragma unroll
      for (int m = 0; m < 4; ++m) {
        const int t = (rbase + m * 16) & (S_ - 1);
#pragma unroll
        for (int n = 0; n < 2; ++n) {
          const float pos = n == 0 ? (float)(t >> 6) : (float)(t & 63);
#pragma unroll
          for (int j = 0; j < 4; ++j) {
            float sn, cs; sincos_rev(pos, invf[j], sn, cs);
            const float v = acc[m][n][j]; float pr; { auto rr = __builtin_amdgcn_permlane32_swap(__float_as_uint(v), __float_as_uint(v), false, false); pr = __uint_as_float((fq & 2) ? rr[0] : rr[1]); }
            acc[m][n][j] = (fq & 2) ? v * cs + pr * sn : v * cs - pr * sn;
          }
        }
      }
    }
    if (G8) {
#pragma unroll
      for (int m = 0; m < 4; ++m) {
#pragma unroll
        for (int n = 0; n < 2; ++n) stage_put4(stg, fr, n * 4 + fq, acc[m][n]);
        flush16<32>(stg, dst + (size_t)(m0 + wr * 64 + m * 16) * ld, ld, lane);
      }
      return;
    }
#pragma unroll
    for (int m = 0; m < 4; ++m)
#pragma unroll
      for (int n = 0; n < 2; ++n) stage_put4(stg, m * 16 + fr, n * 4 + fq, acc[m][n]);
    stage_flush<32>(stg, dst + (size_t)(m0 + wr * 64) * ld, ld, lane);
    return;
  }
  if (G8) {
#pragma unroll
    for (int m = 0; m < 4; ++m) {
#pragma unroll
      for (int n = 0; n < 4; ++n) stage_put4(stg, fr, n * 4 + fq, acc[m][n]);
      flush16<64>(stg, dst + (size_t)(m0 + wr * 64 + m * 16) * ld + cb, ld, lane);
    }
    return;
  }
#pragma unroll
  for (int m = 0; m < 4; ++m)
#pragma unroll
    for (int n = 0; n < 4; ++n) stage_put4(stg, m * 16 + fr, n * 4 + fq, acc[m][n]);
  stage_flush<64>(stg, dst + (size_t)(m0 + wr * 64) * ld + cb, ld, lane);
}

DI void p2_inproj(const Params& p, int layer, LAS char* ldsr, int cs = 0) {
  char* ws = p.ws;
  LAS char* lds = ldsr + VHALF * LDS_HALF;
  unsigned* ctr = (unsigned*)(ws + OFF_CTRL) + CW_CTR + layer * 16 + 2 + cs;
  const u16* H = (const u16*)(ws + OFF_H);
  const u16* WinT = (const u16*)(ws + OFF_WIN) + (size_t)layer * INWP * 1024;
  const u16* WuqT = (const u16*)(ws + OFF_WUQ) + (size_t)layer * 384 * 256;
  const u16* WukvT = (const u16*)(ws + OFF_WUKV) + (size_t)layer * 512 * 128;
  const int tid = opaque(VTID), lane = tid & 63, wid = tid >> 6, wr = wid >> 1, wc = wid & 1;
  LAS float* rowss = (LAS float*)(lds + LDS_MISC);
  LAS float* rstd = (LAS float*)(lds + LDS_MISC + 2048);
  unsigned* ctr8 = (unsigned*)(ws + OFF_CTRL) + CW_Q + (layer * 2 + 1) * 512;
  f32x4 acc[4][4];
  for (;;) {
    const int u = next_unit_xcd(ctr8, (NT / 128 / 8 / 2) * 12, ldsr);
    if (u < 0) break;
    const int tid_o = opaque(tid), lane_o = tid_o & 63;
    const int fr = lane_o & 15, fq = lane_o >> 4, ch = gt_chunk(tid_o), r0 = gt_row0(tid_o);
    const int qx = u / 204, v = u % 204, hf = opaque(VHALF);
    int rt, k;
    if (v < 17) { rt = qx * 34 + 2 * v + hf; k = 10; } else if (v < 34) { rt = qx * 34 + 2 * (v - 17) + hf; k = 11; } else { rt = qx * 34 + 2 * ((v - 34) / 10) + hf; k = (v - 34) % 10; }
    const int m0 = rt * 128;
    const u16* a0 = H + (size_t)(m0 + r0) * 1024 + ch;
    if (k < 10) {
      const u16* b0 = WinT + (size_t)(k * 128 + r0) * 1024 + ch;
      gemm_tile(lds, a0, 32 * 1024, b0, 32 * 1024, 16, acc);
      epi_inproj<false>(p, layer, acc, m0, k * 2 + wc, wr, fr, fq, rowss, nullptr, lds + 32768 + wid * 8192, lane_o);
    } else if (k == 10) {
#pragma unroll 1
      for (int t = 0; t < 2; ++t) {
        const u16* b0 = WinT + (size_t)(1280 + t * 128 + r0) * 1024 + ch;
        gemm_tile(lds, a0, 32 * 1024, b0, 32 * 1024, 16, acc);
        epi_inproj<false>(p, layer, acc, m0, 20 + t * 2 + wc, wr, fr, fq, rowss + (t * 2 + wc) * 128, nullptr, lds + 32768 + wid * 8192, lane_o);
      }
      __syncthreads();
      if (tid < 128) rstd[tid] = rsqrtf((rowss[tid] + rowss[128 + tid] + rowss[256 + tid] + rowss[384 + tid]) * (1.f / 256.f) + EPS);
      __syncthreads();
      const u16* QL = (const u16*)(ws + OFF_QLAT);
      const u16* qa0 = QL + (size_t)(m0 + r0) * 256 + ch;
      u16* MLQ = (u16*)(ws + OFF_MLQ);
      const bool lat = m0 < NL;
#pragma unroll 1
      for (int t = 0; t < 3; ++t) {
        const u16* b0 = WuqT + (size_t)(t * 128 + r0) * 256 + ch;
        gemm_tile(lds, qa0, 32 * 256, b0, 32 * 256, 4, acc);
        const int c0 = t * 128 + wc * 64;
        float invf[4];
#pragma unroll
        for (int j = 0; j < 4; ++j) invf[j] = __builtin_amdgcn_exp2f(-(float)((fq & 1) * 4 + j) * (13.287712379549449f / 8.f));
#pragma unroll
        for (int m = 0; m < 4; ++m) {
          const int rl = wr * 64 + m * 16 + fr;
          const float rs = rstd[rl];
          const int tpos = (m0 + rl) & (S_ - 1);
#pragma unroll
          for (int n = 0; n < 4; ++n) {
            acc[m][n] = acc[m][n] * rs;
            const int w96 = (c0 + n * 16) % 96;
            if (lat && w96 >= 64) {
              const float pos = (w96 == 64) ? (float)(tpos >> 6) : (float)(tpos & 63);
#pragma unroll
              for (int j = 0; j < 4; ++j) {
                float sn, cs; sincos_rev(pos, invf[j], sn, cs);
                const float v = acc[m][n][j]; float pr; { auto rr = __builtin_amdgcn_permlane32_swap(__float_as_uint(v), __float_as_uint(v), false, false); pr = __uint_as_float((fq & 2) ? rr[0] : rr[1]); }
                acc[m][n][j] = (fq & 2) ? v * cs + pr * sn : v * cs - pr * sn;
              }
            }
            stage_put4(lds + 32768 + wid * 8192, m * 16 + fr, n * 4 + fq, acc[m][n]);
          }
        }
        stage_flush<64>(lds + 32768 + wid * 8192, MLQ + (size_t)(m0 + wr * 64) * 384 + c0, 384, lane_o);
      }
    } else {
      {
        const u16* b0 = WinT + (size_t)(1536 + r0) * 1024 + ch;
        gemm_tile(lds, a0, 32 * 1024, b0, 32 * 1024, 16, acc);
        epi_inproj<false>(p, layer, acc, m0, 24 + wc, wr, fr, fq, rowss + wc * 128, nullptr, lds + 32768 + wid * 8192, lane_o);
        const u16* b2 = WinT + (size_t)(1664 + r0) * 1024 + ch;
        gemm_tile(lds, a0, 32 * 1024, b2, 32 * 1024, 16, acc);
        epi_inproj<false>(p, layer, acc, m0, 26 + wc, wr, fr, fq, rowss, nullptr, lds + 32768 + wid * 8192, lane_o);
      }
      __syncthreads();
      if (tid < 128) rstd[tid] = rsqrtf((rowss[tid] + rowss[128 + tid]) * (1.f / 128.f) + EPS);
      __syncthreads();
      const u16* KL = (const u16*)(ws + OFF_KVLAT);
      const u16* ka0 = KL + (size_t)(m0 + r0) * 128 + ch;
#pragma unroll 1
      for (int t = 0; t < 4; ++t) {
        const u16* b0 = WukvT + (size_t)(t * 128 + r0) * 128 + ch;
        gemm_tile(lds, ka0, 32 * 128, b0, 32 * 128, 2, acc);
        u16* dst = (u16*)(ws + (wc == 0 ? OFF_MLK : OFF_MLV));
#pragma unroll
        for (int m = 0; m < 4; ++m) {
          const int rl = wr * 64 + m * 16 + fr;
          const float rs = rstd[rl];
#pragma unroll
          for (int n = 0; n < 4; ++n) { acc[m][n] = acc[m][n] * rs; stage_put4(lds + 32768 + wid * 8192, m * 16 + fr, n * 4 + fq, acc[m][n]); }
        }
        stage_flush<64>(lds + 32768 + wid * 8192, dst + (size_t)(m0 + wr * 64) * 256 + t * 64, 256, lane_o);
      }
    }
  }
}


namespace g8 {
constexpr int HTB = 16384;
DI int lds_byte(int r, int c) { const int st = (r >> 4) * 2 + (c >> 5), rr = r & 15, cc = c & 31, ob = rr * 64 + cc * 2; return st * 1024 + (ob ^ (((ob >> 9) & 1) << 5)); }
DI void stage_rc(int b, int& R, int& C) { const int st = b / 1024, sb = b % 1024, swz = sb ^ (((sb >> 9) & 1) << 5); R = (st >> 1) * 16 + swz / 64; C = (st & 1) * 32 + (swz % 64) / 2; }
struct Unit { const char* B; unsigned va[2][2]; int id; };
template <int K, class PH>
DI void gemm8(LAS char* lds, const PH& ph) {
  const int tid = opaque((int)threadIdx.x), wid = __builtin_amdgcn_readfirstlane(tid >> 6), lane = tid & 63, wr = wid >> 2, wc = wid & 3, fr = lane & 15, fq = lane >> 4;
  constexpr int nt = K / 64;
  int sr[2], sc[2]; unsigned voffB[2];
#pragma unroll
  for (int i = 0; i < 2; ++i) {
    const int c = tid + 512 * i; sr[i] = c >> 3; sc[i] = ((c & 7) ^ ((sr[i] >> 1) & 7)) * 8;
    const int Rb = 64 * (sr[i] >> 5) + (sr[i] & 31); voffB[i] = (unsigned)(Rb * K + sc[i]) * 2u; }
  constexpr int hstepB = 32 * K * 2;
  const unsigned ldsw = (unsigned)wid * 1024u;
  const int kx = (fr >> 1) & 7;
  const int aoff0 = (wr * 64 + fr) * 128 + ((fq ^ kx) * 16), aoff1 = (wr * 64 + fr) * 128 + (((4 + fq) ^ kx) * 16);
  const int boff0 = (wc * 32 + fr) * 128 + ((fq ^ kx) * 16), boff1 = (wc * 32 + fr) * 128 + (((4 + fq) ^ kx) * 16);
  const char* Ab = ph.abase();
#define G8_SA(b, h) (((b) * 2 + (h)) * g8::HTB)
#define G8_SB(b, h) ((4 + (b) * 2 + (h)) * g8::HTB)
#define G8_STAGE(bufoff, gbase, v0, v1) do { \
    __builtin_amdgcn_global_load_lds((const unsigned*)((gbase) + (v0)), (LAS unsigned*)(lds + (bufoff) + ldsw), 16, 0, 0); \
    __builtin_amdgcn_global_load_lds((const unsigned*)((gbase) + (v1)), (LAS unsigned*)(lds + (bufoff) + ldsw + 8192), 16, 0, 0); } while (0)
#define G8_STA(b, h, kt, V) G8_STAGE(G8_SA(b, h), Ab + (size_t)(kt) * 128, (V)[h][0], (V)[h][1])
#define G8_STB(b, h, Bp, kt) G8_STAGE(G8_SB(b, h), (Bp) + (size_t)(kt) * 128 + (h) * hstepB, voffB[0], voffB[1])
#define G8_LDA(dst, b, h) do { _Pragma("unroll") for (int m = 0; m < 4; ++m) _Pragma("unroll") for (int k = 0; k < 2; ++k) dst[m][k] = *(const LAS bf16x8*)(lds + G8_SA(b, h) + (k ? aoff1 : aoff0) + m * 2048); } while (0)
#define G8_LDB(dst, b, h) do { _Pragma("unroll") for (int n = 0; n < 2; ++n) _Pragma("unroll") for (int k = 0; k < 2; ++k) dst[n][k] = *(const LAS bf16x8*)(lds + G8_SB(b, h) + (k ? boff1 : boff0) + n * 2048); } while (0)
#define G8_MMA(ai, bj, At, Bt) do { __builtin_amdgcn_s_setprio(1); _Pragma("unroll") for (int m = 0; m < 4; ++m) _Pragma("unroll") for (int n = 0; n < 2; ++n) _Pragma("unroll") for (int k = 0; k < 2; ++k) \
    acc[ai][m][2 * (bj) + n] = __builtin_amdgcn_mfma_f32_16x16x32_bf16(Bt[n][k], At[m][k], acc[ai][m][2 * (bj) + n], 0, 0, 0); __builtin_amdgcn_s_setprio(0); } while (0)
#define G8_WAIT_V(n) asm volatile("s_waitcnt vmcnt(" #n ")" ::: "memory")
#define G8_WAIT_L(n) asm volatile("s_waitcnt lgkmcnt(" #n ")" ::: "memory")
#define G8_BAR __builtin_amdgcn_s_barrier()
#define G8_SCHED __builtin_amdgcn_sched_barrier(0)
  Unit cur, nxt; int ui = 0;
  f32x4 acc[2][4][4];
  bf16x8 At[4][2], B0[2][2], B1[2][2];
  if (ph.unit(0, cur, sr, sc)) {
#pragma unroll
  for (int a = 0; a < 2; ++a)
#pragma unroll
    for (int m = 0; m < 4; ++m)
#pragma unroll
      for (int n = 0; n < 4; ++n) acc[a][m][n] = (f32x4){0.f, 0.f, 0.f, 0.f};
  G8_STB(0, 0, cur.B, 0); G8_STA(0, 0, 0, cur.va); G8_STB(0, 1, cur.B, 0); G8_STA(0, 1, 0, cur.va);
  if (wr == 1) G8_BAR;
  G8_WAIT_V(4); G8_BAR;
  G8_STB(1, 0, cur.B, 1); G8_STA(1, 0, 1, cur.va); G8_STB(1, 1, cur.B, 1);
  G8_WAIT_V(6); G8_BAR;
  for (;;) {
    const bool has_next = ph.unit(ui + 1, nxt, sr, sc);
    if (!has_next) nxt = cur;
#pragma unroll 1
    for (int t = 0; t < nt; t += 2) {
      const bool last = (t == nt - 2);
      const char* B2 = last ? nxt.B : cur.B;
      const int k2 = last ? 0 : t + 2, k3 = k2 + 1;
      unsigned v2[2][2];
#pragma unroll
      for (int h = 0; h < 2; ++h)
#pragma unroll
        for (int i = 0; i < 2; ++i) v2[h][i] = last ? nxt.va[h][i] : cur.va[h][i];
      G8_LDB(B0, 0, 0); G8_SCHED; G8_LDA(At, 0, 0); G8_STA(1, 1, t + 1, cur.va);
      G8_WAIT_L(8); G8_BAR; G8_WAIT_L(0); G8_MMA(0, 0, At, B0); G8_BAR; G8_SCHED;
      G8_LDB(B1, 0, 1); G8_STB(0, 0, B2, k2);
      G8_BAR; G8_WAIT_L(0); G8_MMA(0, 1, At, B1); G8_BAR;
      G8_LDA(At, 0, 1); G8_STA(0, 0, k2, v2);
      G8_BAR; G8_WAIT_L(0); G8_MMA(1, 0, At, B0); G8_BAR; G8_SCHED;
      G8_STB(0, 1, B2, k2);
      G8_WAIT_V(6); G8_BAR; G8_MMA(1, 1, At, B1); G8_BAR;
      G8_LDB(B0, 1, 0); G8_SCHED; G8_LDA(At, 1, 0); G8_STA(0, 1, k2, v2);
      G8_WAIT_L(8); G8_BAR; G8_WAIT_L(0); G8_MMA(0, 0, At, B0); G8_BAR; G8_SCHED;
      G8_LDB(B1, 1, 1); G8_STB(1, 0, B2, k3);
      G8_BAR; G8_WAIT_L(0); G8_MMA(0, 1, At, B1); G8_BAR;
      G8_LDA(At, 1, 1); G8_STA(1, 0, k3, v2);
      G8_BAR; G8_WAIT_L(0); G8_MMA(1, 0, At, B0); G8_BAR; G8_SCHED;
      G8_STB(1, 1, B2, k3);
      G8_WAIT_V(6); G8_BAR; G8_MMA(1, 1, At, B1); G8_BAR;
    }
    ph.template epi<2>(acc, cur, wid, lane, 0);
    if (!has_next) break;
#pragma unroll
    for (int a = 0; a < 2; ++a)
#pragma unroll
      for (int m = 0; m < 4; ++m)
#pragma unroll
        for (int n = 0; n < 4; ++n) acc[a][m][n] = (f32x4){0.f, 0.f, 0.f, 0.f};
    cur = nxt; ++ui;
  }
  G8_WAIT_V(0);
  if (wr == 0) G8_BAR;
  G8_BAR;
  }
  if (ph.ntail > 0) {
    const int per = (2 * ph.ntail + 7) >> 3, wx = (int)(blockIdx.x >> 3);
    const int hb = wx < per ? (int)(blockIdx.x & 7) * per + wx : 2 * ph.ntail;
    if (hb < 2 * ph.ntail) {
      Unit tu; ph.desc(ph.nmain + (hb >> 1), tu, sr, sc);
      const int hm = hb & 1;
      unsigned vt[2][2]; vt[0][0] = hm ? tu.va[1][0] : tu.va[0][0]; vt[0][1] = hm ? tu.va[1][1] : tu.va[0][1]; vt[1][0] = vt[0][0]; vt[1][1] = vt[0][1];
#pragma unroll
      for (int m = 0; m < 4; ++m)
#pragma unroll
        for (int n = 0; n < 4; ++n) acc[0][m][n] = (f32x4){0.f, 0.f, 0.f, 0.f};
      G8_STA(0, 0, 0, vt); G8_STB(0, 0, tu.B, 0); G8_STB(0, 1, tu.B, 0);
#pragma unroll 1
      for (int t = 0; t < nt; ++t) {
        G8_WAIT_V(0); G8_BAR;
        const int b = t & 1;
        if (t + 1 < nt) { G8_STA(b ^ 1, 0, t + 1, vt); G8_STB(b ^ 1, 0, tu.B, t + 1); G8_STB(b ^ 1, 1, tu.B, t + 1); }
        G8_LDA(At, b, 0); G8_LDB(B0, b, 0); G8_LDB(B1, b, 1);
        G8_SCHED;
        G8_MMA(0, 0, At, B0); G8_MMA(0, 1, At, B1);
        G8_SCHED;
      }
      ph.template epi<1>(acc, tu, wid, lane, hm * 128);
    }
  }
#undef G8_SA
#undef G8_SB
#undef G8_STAGE
#undef G8_STA
#undef G8_STB
#undef G8_LDA
#undef G8_LDB
#undef G8_MMA
#undef G8_WAIT_V
#undef G8_WAIT_L
#undef G8_BAR
#undef G8_SCHED
}
DI int unit_id(int i) { return g8_unit_base() + i * (int)gridDim.x; }
}

DI void g8_split(int nunits, int& nmain, int& ntail) { const int G = (int)gridDim.x, rem = nunits % G; const bool sp = rem > 0 && 2 * rem <= G; nmain = sp ? nunits - rem : nunits; ntail = sp ? rem : 0; }
struct P4Phase {
  const u16* Y; const u16* WoT; const float* MODl; u16* DELTA; int nunits, nmain, ntail; LAS char* lds;
  DI const char* abase() const { return (const char*)Y; }
  DI bool unit(int i, g8::Unit& u, const int (&sr)[2], const int (&sc)[2]) const { const int id = g8::unit_id(i); if (id >= nmain) return false; return desc(id, u, sr, sc); }
  DI bool desc(int id, g8::Unit& u, const int (&sr)[2], const int (&sc)[2]) const {
    const int rt = id >> 2, pn = id & 3;
    u.id = id; u.B = (const char*)(WoT + (size_t)pn * 256 * 1024);
#pragma unroll
    for (int h = 0; h < 2; ++h)
#pragma unroll
      for (int j = 0; j < 2; ++j) u.va[h][j] = (unsigned)((rt * 256 + h * 128 + sr[j]) * 1024 + sc[j]) * 2u;
    return true;
  }
  template <int NAI> DI void epi(f32x4 (&acc)[2][4][4], const g8::Unit& u, int wid, int lane_, int rowoff) const {
    const int lane = opaque(lane_);
    const int wr = wid >> 2, wc = wid & 3, fr = lane & 15, fq = lane >> 4;
    const int rt = u.id >> 2, pn = u.id & 3, m0 = rt * 256;
    const int mr = m0 < NL ? m0 / S_ : 8;
    const float* gate = MODl + (size_t)mr * 6144 + 2 * 1024 + pn * 256 + wc * 64 + fq * 4;
    f32x4 g[4];
#pragma unroll
    for (int n = 0; n < 4; ++n) g[n] = *(const f32x4*)(gate + n * 16);
    LAS char* stg = lds + LDS_ESTG + wid * 2048;
#pragma unroll
    for (int ai = 0; ai < NAI; ++ai)
#pragma unroll
      for (int m = 0; m < 4; ++m) {
#pragma unroll
        for (int n = 0; n < 4; ++n) stage_put4(stg, fr, n * 4 + fq, g[n] * acc[ai][m][n]);
        flush16_nt<64>(stg, DELTA + (size_t)(m0 + rowoff + ai * 128 + wr * 64 + m * 16) * 1024 + pn * 256 + wc * 64, 1024, lane);
      }
  }
};
DI void p4_outproj8(const Params& p, int layer, int nrows, LAS char* lds) {
  P4Phase ph;
  ph.Y = (const u16*)(p.ws + OFF_Y); ph.WoT = (const u16*)(p.ws + OFF_WO) + (size_t)layer * 1024 * 1024;
  ph.MODl = (const float*)(p.ws + OFF_MOD) + (size_t)layer * 9 * 6144; ph.DELTA = (u16*)(p.ws + OFF_DELTA);
  ph.nunits = (nrows / 256) * 4; g8_split(ph.nunits, ph.nmain, ph.ntail); ph.lds = lds;
  __syncthreads();
  g8::gemm8<1024>(lds, ph);
  __syncthreads();
}


struct P6Phase {
  const u16 *H, *WguT, *SguT; const int* list; const unsigned* cnt; u16 *ACT, *ACTS; int tb[NE + 1]; int R, nunits, nmain, ntail; LAS char* lds;
  DI const char* abase() const { return (const char*)H; }
  DI bool unit(int i, g8::Unit& u, const int (&sr)[2], const int (&sc)[2]) const { const int id = g8::unit_id(i); if (id >= nmain) return false; return desc(id, u, sr, sc); }
  DI bool desc(int id, g8::Unit& u, const int (&sr)[2], const int (&sc)[2]) const {
    const int rt = id >> 2, pn = id & 3;
    u.id = id;
    if (rt < R) {
      int e = 0, tbe = 0;
#pragma unroll
      for (int q = 1; q < NE; ++q) if (rt >= tb[q]) { e = q; tbe = tb[q]; }
      const int i0 = (rt - tbe) * 256, ce = (int)cnt[e * CNT_STRIDE];
      const int* lp = list + (size_t)e * NT + i0;
#pragma unroll
      for (int h = 0; h < 2; ++h)
#pragma unroll
        for (int j = 0; j < 2; ++j) { const int ix = h * 128 + sr[j]; const int tok = i0 + ix < ce ? lp[ix] : 0; u.va[h][j] = (unsigned)(tok * 1024 + sc[j]) * 2u; }
      u.B = (const char*)(WguT + ((size_t)e * 1024 + pn * 256) * 1024);
    } else {
      const int m0 = (rt - R) * 256;
#pragma unroll
      for (int h = 0; h < 2; ++h)
#pragma unroll
        for (int j = 0; j < 2; ++j) u.va[h][j] = (unsigned)((m0 + h * 128 + sr[j]) * 1024 + sc[j]) * 2u;
      u.B = (const char*)(SguT + (size_t)pn * 256 * 1024);
    }
    return true;
  }
  template <int NAI> DI void epi(f32x4 (&acc)[2][4][4], const g8::Unit& u, int wid, int lane_, int rowoff) const {
    const int lane = opaque(lane_);
    const int wr = wid >> 2, wc = wid & 3, fr = lane & 15, fq = lane >> 4;
    const int rt = u.id >> 2, pn = u.id & 3;
    u16* dst; size_t orow;
    if (rt < R) { dst = ACT; orow = (size_t)rt * 256; } else { dst = ACTS; orow = (size_t)(rt - R) * 256; }
    LAS char* stg = lds + LDS_ESTG + wid * 2048;
#pragma unroll
    for (int ai = 0; ai < NAI; ++ai)
#pragma unroll
      for (int m = 0; m < 4; ++m) {
#pragma unroll
        for (int n = 0; n < 2; ++n) {
          f32x4 r;
#pragma unroll
          for (int j = 0; j < 4; ++j) r[j] = silu(acc[ai][m][n][j]) * acc[ai][m][n + 2][j];
          stage_put4(stg, fr, n * 4 + fq, r);
        }
        flush16<32>(stg, dst + (orow + rowoff + ai * 128 + wr * 64 + m * 16) * 512 + pn * 128 + wc * 32, 512, lane);
      }
  }
};
DI void p6_gateup8(const Params& p, int layer, int nrows, LAS char* lds) {
  P6Phase ph;
  ph.H = (const u16*)(p.ws + OFF_H); ph.WguT = (const u16*)(p.ws + OFF_WGU) + (size_t)layer * NE * 1024 * 1024; ph.SguT = (const u16*)(p.ws + OFF_SGU) + (size_t)layer * 1024 * 1024;
  ph.list = (const int*)(p.ws + OFF_LIST); ph.cnt = (const unsigned*)(p.ws + OFF_CTRL) + CW_CNT + layer * 16 * CNT_STRIDE;
  ph.ACT = (u16*)(p.ws + OFF_ACT); ph.ACTS = (u16*)(p.ws + OFF_ACTS);
  seg_scan(p, layer, ph.tb); ph.R = ph.tb[NE]; ph.nunits = (ph.R + nrows / 256) * 4; g8_split(ph.nunits, ph.nmain, ph.ntail); ph.lds = lds;
  __syncthreads();
  g8::gemm8<1024>(lds, ph);
  __syncthreads();
}
struct P7Phase {
  const u16 *ACT, *WdT, *SdT; u16 *YEXP, *YSH; int tb[NE + 1]; int R, nunits, nmain, ntail; LAS char* lds;
  DI const char* abase() const { return (const char*)ACT; }
  DI bool unit(int i, g8::Unit& u, const int (&sr)[2], const int (&sc)[2]) const { const int id = g8::unit_id(i); if (id >= nmain) return false; return desc(id, u, sr, sc); }
  DI bool desc(int id, g8::Unit& u, const int (&sr)[2], const int (&sc)[2]) const {
    const int rt = id >> 2, pn = id & 3;
    u.id = id;
    if (rt < R) {
      int e = 0;
#pragma unroll
      for (int q = 1; q < NE; ++q) if (rt >= tb[q]) e = q;
#pragma unroll
      for (int h = 0; h < 2; ++h)
#pragma unroll
        for (int j = 0; j < 2; ++j) u.va[h][j] = (unsigned)((rt * 256 + h * 128 + sr[j]) * 512 + sc[j]) * 2u;
      u.B = (const char*)(WdT + ((size_t)e * 1024 + pn * 256) * 512);
    } else {
      const int m0 = (rt - R) * 256;
#pragma unroll
      for (int h = 0; h < 2; ++h)
#pragma unroll
        for (int j = 0; j < 2; ++j) u.va[h][j] = (unsigned)(OFF_ACTS - OFF_ACT) + (unsigned)((m0 + h * 128 + sr[j]) * 512 + sc[j]) * 2u;
      u.B = (const char*)(SdT + (size_t)pn * 256 * 512);
    }
    return true;
  }
  template <int NAI> DI void epi(f32x4 (&acc)[2][4][4], const g8::Unit& u, int wid, int lane_, int rowoff) const {
    const int lane = opaque(lane_);
    const int wr = wid >> 2, wc = wid & 3, fr = lane & 15, fq = lane >> 4;
    const int rt = u.id >> 2, pn = u.id & 3;
    u16* dst; size_t orow;
    if (rt < R) { dst = YEXP; orow = (size_t)rt * 256; } else { dst = YSH; orow = (size_t)(rt - R) * 256; }
    LAS char* stg = lds + LDS_ESTG + wid * 2048;
#pragma unroll
    for (int ai = 0; ai < NAI; ++ai)
#pragma unroll
      for (int m = 0; m < 4; ++m) {
#pragma unroll
        for (int n = 0; n < 4; ++n) stage_put4(stg, fr, n * 4 + fq, acc[ai][m][n]);
        flush16_nt<64>(stg, dst + (orow + rowoff + ai * 128 + wr * 64 + m * 16) * 1024 + pn * 256 + wc * 64, 1024, lane);
      }
  }
};
DI void p7_down8(const Params& p, int layer, int nrows, LAS char* lds) {
  P7Phase ph;
  ph.ACT = (const u16*)(p.ws + OFF_ACT); ph.WdT = (const u16*)(p.ws + OFF_WD) + (size_t)layer * NE * 1024 * 512; ph.SdT = (const u16*)(p.ws + OFF_SD) + (size_t)layer * 1024 * 512;
  ph.YEXP = (u16*)(p.ws + OFF_YEXP); ph.YSH = (u16*)(p.ws + OFF_YSH);
  seg_scan(p, layer, ph.tb); ph.R = ph.tb[NE]; ph.nunits = (ph.R + nrows / 256) * 4; g8_split(ph.nunits, ph.nmain, ph.ntail); ph.lds = lds;
  __syncthreads();
  g8::gemm8<512>(lds, ph);
  __syncthreads();
}


struct P2Phase {
  const Params* pp; int layer; const u16 *H, *WinT; float* ROWSS; int nunits, nmain, ntail; LAS char* lds;
  DI const char* abase() const { return (const char*)H; }
  DI bool unit(int i, g8::Unit& u, const int (&sr)[2], const int (&sc)[2]) const { const int id = g8::unit_id(i); if (id >= nmain) return false; return desc(id, u, sr, sc); }
  DI bool desc(int id, g8::Unit& u, const int (&sr)[2], const int (&sc)[2]) const {
    const int rt = id / 7, pn = id - rt * 7;
    u.id = id; u.B = (const char*)(WinT + (size_t)pn * 256 * 1024);
#pragma unroll
    for (int h = 0; h < 2; ++h)
#pragma unroll
      for (int j = 0; j < 2; ++j) u.va[h][j] = (unsigned)((rt * 256 + h * 128 + sr[j]) * 1024 + sc[j]) * 2u;
    return true;
  }
  template <int NAI> DI void epi(f32x4 (&acc)[2][4][4], const g8::Unit& u, int wid, int lane_, int rowoff) const {
    const int lane = opaque(lane_);
    const int wr = wid >> 2, wc = wid & 3, fr = lane & 15, fq = lane >> 4;
    const int rt = u.id / 7, pn = u.id - rt * 7;
    LAS char* stg = lds + LDS_ESTG + wid * 2048;
#pragma unroll
    for (int ai = 0; ai < NAI; ++ai) { epi_inproj<true>(*pp, layer, acc[ai], rt * 256 + rowoff + ai * 128, pn * 4 + wc, wr, opaque(fr), opaque(fq), nullptr, ROWSS, stg, opaque(lane)); __builtin_amdgcn_sched_barrier(0); }
  }
};
DI void p2b_upproj(const Params& p, int layer, LAS char* ldsr) {
  char* ws = p.ws;
  LAS char* lds = ldsr + VHALF * LDS_HALF;
  const u16* WuqT = (const u16*)(ws + OFF_WUQ) + (size_t)layer * 384 * 256;
  const u16* WukvT = (const u16*)(ws + OFF_WUKV) + (size_t)layer * 512 * 128;
  const float* ROWSS = (const float*)(ws + OFF_ROWSS);
  const int tid = opaque(VTID), lane = tid & 63, wid = tid >> 6, wr = wid >> 1, wc = wid & 1;
  LAS float* rstd = (LAS float*)(lds + LDS_MISC + 2048);
  f32x4 acc[4][4];
  const int hf = opaque(VHALF);
  for (int pu = blockIdx.x; pu < (NT / 256) * 7; pu += gridDim.x) {
    const int tid_o = opaque(tid), lane_o = tid_o & 63;
    const int fr = lane_o & 15, fq = lane_o >> 4, ch = gt_chunk(tid_o), r0 = gt_row0(tid_o);
    const int pr = pu / 7, t = pu - pr * 7;
    const int m0 = (pr * 2 + hf) * 128;
    float rsv[4];
#pragma unroll
    for (int m = 0; m < 4; ++m) { const float* rp = ROWSS + m0 + wr * 64 + m * 16 + fr;
      rsv[m] = t < 3 ? (rp[0] + rp[NT] + rp[2 * NT] + rp[3 * NT]) * (1.f / 256.f) : (rp[4 * NT] + rp[5 * NT]) * (1.f / 128.f); }
    if (t < 3) {
      const u16* qa0 = (const u16*)(ws + OFF_QLAT) + (size_t)(m0 + r0) * 256 + ch;
      u16* MLQ = (u16*)(ws + OFF_MLQ);
      const bool lat = m0 < NL;
      const u16* b0 = WuqT + (size_t)(t * 128 + r0) * 256 + ch;
      gemm_tile(lds, qa0, 32 * 256, b0, 32 * 256, 4, acc);
      const int c0 = t * 128 + wc * 64;
      float invf[4];
#pragma unroll
      for (int j = 0; j < 4; ++j) invf[j] = __builtin_amdgcn_exp2f(-(float)((fq & 1) * 4 + j) * (13.287712379549449f / 8.f));
#pragma unroll
      for (int m = 0; m < 4; ++m) {
        const int rl = wr * 64 + m * 16 + fr;
        const float rs = rsqrtf(rsv[m] + EPS);
        const int tpos = (m0 + rl) & (S_ - 1);
#pragma unroll
        for (int n = 0; n < 4; ++n) {
          acc[m][n] = acc[m][n] * rs;
          const int w96 = (c0 + n * 16) % 96;
          if (lat && w96 >= 64) {
            const float pos = (w96 == 64) ? (float)(tpos >> 6) : (float)(tpos & 63);
#pragma unroll
            for (int j = 0; j < 4; ++j) {
              float sn, cs; sincos_rev(pos, invf[j], sn, cs);
              const float v = acc[m][n][j]; float prr; { auto rr = __builtin_amdgcn_permlane32_swap(__float_as_uint(v), __float_as_uint(v), false, false); prr = __uint_as_float((fq & 2) ? rr[0] : rr[1]); }
              acc[m][n][j] = (fq & 2) ? v * cs + prr * sn : v * cs - prr * sn;
            }
          }
          stage_put4(lds + 32768 + wid * 8192, m * 16 + fr, n * 4 + fq, acc[m][n]);
        }
      }
      stage_flush<64>(lds + 32768 + wid * 8192, MLQ + (size_t)(m0 + wr * 64) * 384 + c0, 384, lane_o);
    } else {
      const int tk = t - 3;
      const u16* ka0 = (const u16*)(ws + OFF_KVLAT) + (size_t)(m0 + r0) * 128 + ch;
      const u16* b0 = WukvT + (size_t)(tk * 128 + r0) * 128 + ch;
      gemm_tile(lds, ka0, 32 * 128, b0, 32 * 128, 2, acc);
      u16* dst = (u16*)(ws + (wc == 0 ? OFF_MLK : OFF_MLV));
#pragma unroll
      for (int m = 0; m < 4; ++m) {
        const int rl = wr * 64 + m * 16 + fr;
        const float rs = rsqrtf(rsv[m] + EPS);
#pragma unroll
        for (int n = 0; n < 4; ++n) { acc[m][n] = acc[m][n] * rs; stage_put4(lds + 32768 + wid * 8192, m * 16 + fr, n * 4 + fq, acc[m][n]); }
      }
      stage_flush<64>(lds + 32768 + wid * 8192, dst + (size_t)(m0 + wr * 64) * 256 + tk * 64, 256, lane_o);
    }
  }
  __syncthreads();
}
DI void p2_inproj8(const Params& p, int layer, LAS char* lds) {
  P2Phase ph;
  ph.pp = &p; ph.layer = layer; ph.H = (const u16*)(p.ws + OFF_H); ph.WinT = (const u16*)(p.ws + OFF_WIN) + (size_t)layer * INWP * 1024;
  ph.ROWSS = (float*)(p.ws + OFF_ROWSS); ph.nunits = (NT / 256) * 7; g8_split(ph.nunits, ph.nmain, ph.ntail); ph.lds = lds;
  __syncthreads();
  g8::gemm8<1024>(lds, ph);
  __syncthreads();
}

DI void p4_outproj(const Params& p, int layer, int nrows, LAS char* ldsr, int cs = 0) {
  char* ws = p.ws;
  LAS char* lds = ldsr + VHALF * LDS_HALF;
  const u16* Y = (const u16*)(ws + OFF_Y);
  const u16* WoT = (const u16*)(ws + OFF_WO) + (size_t)layer * 1024 * 1024;
  const float* MODl = (const float*)(ws + OFF_MOD) + (size_t)layer * 9 * 6144;
  const int tid = opaque(VTID), wid = tid >> 6, wr = wid >> 1, wc = wid & 1;
  const int nunits = (nrows / 128) * 8;
  f32x4 acc[4][4];
  __syncthreads();
  TilePtrs cur, nxt;
  const int vb = VBID, vg = VGRID;
  int u = ((vb >> 1) & 7) * (vg >> 3) + (vb >> 4) * 2 + (vb & 1);
  int uo = ((vb >> 1) & 7) * (vg >> 3) + (vb >> 4) * 2 + ((vb & 1) ^ 1);
#define P4_DESC(T, uu) do { const int _t = opaque(tid); const int _ch = gt_chunk(_t), _r0 = gt_row0(_t); const int _rt = (uu) >> 3, _ct = (uu) & 7; \
    (T).a0 = Y + (size_t)(_rt * 128 + _r0) * 1024 + _ch; (T).a1 = (T).a0 + 32 * 1024; (T).a2 = (T).a0 + 64 * 1024; (T).a3 = (T).a0 + 96 * 1024; \
    (T).b0 = WoT + (size_t)(_ct * 128 + _r0) * 1024 + _ch; (T).ldb32 = 32 * 1024; } while (0)
  bool issued = false;
  P4_DESC(cur, u < nunits ? u : 0);
  while (u < nunits || uo < nunits) {
    const bool act = u < nunits;
    const int un = u + vg;
    const bool hn = un < nunits;
    if (hn) P4_DESC(nxt, un); else nxt = cur;
    gemm_tile_s(lds, cur, issued, nxt, hn, 16, acc);
    issued = hn;
    const int tid_o = opaque(tid), lane_o = tid_o & 63;
    const int fr = lane_o & 15, fq = lane_o >> 4;
    const int rt = u >> 3, ct = u & 7, m0 = rt * 128;
    const int mr = m0 < NL ? m0 / S_ : 8;
    const float* gate = MODl + (size_t)mr * 6144 + 2 * 1024 + ct * 128 + wc * 64 + fq * 4;
    __syncthreads();
    LAS char* stg = lds + 32768 + wid * 8192;
#pragma unroll
    for (int n = 0; n < 4; ++n) {
      const f32x4 g = *(const f32x4*)(gate + n * 16);
#pragma unroll
      for (int m = 0; m < 4; ++m) stage_put4(stg, m * 16 + fr, n * 4 + fq, g * acc[m][n]);
    }
    if (act) { const int grow = m0 + wr * 64, gcol = ct * 128 + wc * 64;
      u16* xb = (u16*)(ws + OFF_XB) + (size_t)grow * 1024 + gcol;
      if (layer == 0) stage_flush_resid<true>(stg, (grow < NL ? p.x + (size_t)grow * 1024 : p.ctx + (size_t)(grow - NL) * 1024) + gcol, xb, lane_o);
      else stage_flush_resid<false>(stg, nullptr, xb, lane_o); }
    cur = nxt; u = un; uo += vg;
  }
#undef P4_DESC
  __syncthreads();
}

DI void p6_gateup(const Params& p, int layer, int nrows, LAS char* ldsr, int cs = 0) {
  char* ws = p.ws;
  LAS char* lds = ldsr + VHALF * LDS_HALF;
  const unsigned* cnt = (const unsigned*)(ws + OFF_CTRL) + CW_CNT + layer * 16 * CNT_STRIDE;
  const u16* H = (const u16*)(ws + OFF_H);
  const int* list = (const int*)(ws + OFF_LIST);
  const u16* WguT = (const u16*)(ws + OFF_WGU) + (size_t)layer * NE * 1024 * 1024;
  const u16* SguT = (const u16*)(ws + OFF_SGU) + (size_t)layer * 1024 * 1024;
  u16* ACT = (u16*)(ws + OFF_ACT); u16* ACTS = (u16*)(ws + OFF_ACTS);
  const int tid = opaque(VTID), wid = tid >> 6, wr = wid >> 1, wc = wid & 1;
  int tb[NE + 1]; seg_scan(p, layer, tb);
  const int R = tb[NE];
  const int nunits = (R + nrows / 128) * 8;
  f32x4 acc[4][4];
  __syncthreads();
  TilePtrs cur, nxt;
#define P6_DESC(T, uu) do { const int _t = opaque(tid); const int _ch = gt_chunk(_t), _r0 = gt_row0(_t); const int _rt = (uu) >> 3, _ct = (uu) & 7; \
    if (_rt < R) { int _e = 0, _tbe = 0; _Pragma("unroll") for (int q = 1; q < NE; ++q) if (_rt >= tb[q]) { _e = q; _tbe = tb[q]; } \
      const int _i = _rt - _tbe, _ce = (int)cnt[_e * CNT_STRIDE]; const int _i0 = _i * 128 + _r0; const int* _lp = list + (size_t)_e * NT + _i0; \
      const int _t0 = _i0 < _ce ? _lp[0] : 0, _t1 = _i0 + 32 < _ce ? _lp[32] : 0, _t2 = _i0 + 64 < _ce ? _lp[64] : 0, _t3 = _i0 + 96 < _ce ? _lp[96] : 0; \
      (T).a0 = H + (size_t)_t0 * 1024 + _ch; (T).a1 = H + (size_t)_t1 * 1024 + _ch; (T).a2 = H + (size_t)_t2 * 1024 + _ch; (T).a3 = H + (size_t)_t3 * 1024 + _ch; \
      (T).b0 = WguT + ((size_t)_e * 1024 + _ct * 128 + _r0) * 1024 + _ch; } \
    else { const int _m0 = (_rt - R) * 128; (T).a0 = H + (size_t)(_m0 + _r0) * 1024 + _ch; (T).a1 = (T).a0 + 32 * 1024; (T).a2 = (T).a0 + 64 * 1024; (T).a3 = (T).a0 + 96 * 1024; \
      (T).b0 = SguT + (size_t)(_ct * 128 + _r0) * 1024 + _ch; } \
    (T).ldb32 = 32 * 1024; } while (0)
  const int vb = VBID, vg = VGRID;
  int u = ((vb >> 1) & 7) * (vg >> 3) + (vb >> 4) * 2 + (vb & 1);
  int uo = ((vb >> 1) & 7) * (vg >> 3) + (vb >> 4) * 2 + ((vb & 1) ^ 1);
  bool issued = false;
  P6_DESC(cur, u < nunits ? u : 0);
  while (u < nunits || uo < nunits) {
    const bool act = u < nunits;
    const int un = u + vg;
    const bool hn = un < nunits;
    if (hn) P6_DESC(nxt, un); else nxt = cur;
    gemm_tile_s(lds, cur, issued, nxt, hn, 16, acc);
    issued = hn;
    const int tid_o = opaque(tid), lane_o = tid_o & 63;
    const int fr = lane_o & 15, fq = lane_o >> 4;
    const int rt = u >> 3, ct = u & 7;
    u16* dst; size_t orow;
    if (rt < R) { dst = ACT; orow = (size_t)rt * 128; } else { dst = ACTS; orow = (size_t)(rt - R) * 128; }
    __syncthreads();
    LAS char* stg = lds + 32768 + wid * 8192;
#pragma unroll
    for (int m = 0; m < 4; ++m)
#pragma unroll
      for (int n = 0; n < 2; ++n) {
        f32x4 r;
#pragma unroll
        for (int j = 0; j < 4; ++j) r[j] = silu(acc[m][n][j]) * acc[m][n + 2][j];
        stage_put4(stg, m * 16 + fr, n * 4 + fq, r);
      }
    if (act) stage_flush<32>(stg, dst + (orow + wr * 64) * 512 + ct * 64 + wc * 32, 512, lane_o);
    cur = nxt; u = un; uo += vg;
  }
#undef P6_DESC
  __syncthreads();
}

DI void p7_down(const Params& p, int layer, int nrows, LAS char* ldsr, int cs = 0) {
  char* ws = p.ws;
  LAS char* lds = ldsr + VHALF * LDS_HALF;
  const u16* WdT = (const u16*)(ws + OFF_WD) + (size_t)layer * NE * 1024 * 512;
  const u16* SdT = (const u16*)(ws + OFF_SD) + (size_t)layer * 1024 * 512;
  const u16* ACT = (const u16*)(ws + OFF_ACT); const u16* ACTS = (const u16*)(ws + OFF_ACTS);
  u16* YEXP = (u16*)(ws + OFF_YEXP); u16* YSH = (u16*)(ws + OFF_YSH);
  const int tid = opaque(VTID), wid = tid >> 6, wr = wid >> 1, wc = wid & 1;
  int tb[NE + 1]; seg_scan(p, layer, tb);
  const int R = tb[NE];
  const int nunits = (R + nrows / 128) * 8;
  f32x4 acc[4][4];
  __syncthreads();
  TilePtrs cur, nxt;
#define P7_DESC(T, uu) do { const int _t = opaque(tid); const int _ch = gt_chunk(_t), _r0 = gt_row0(_t); const int _rt = (uu) >> 3, _ct = (uu) & 7; \
    if (_rt < R) { int _e = 0; _Pragma("unroll") for (int q = 1; q < NE; ++q) if (_rt >= tb[q]) _e = q; \
      (T).a0 = ACT + ((size_t)_rt * 128 + _r0) * 512 + _ch; (T).b0 = WdT + ((size_t)_e * 1024 + _ct * 128 + _r0) * 512 + _ch; } \
    else { const int _m0 = (_rt - R) * 128; (T).a0 = ACTS + (size_t)(_m0 + _r0) * 512 + _ch; (T).b0 = SdT + (size_t)(_ct * 128 + _r0) * 512 + _ch; } \
    (T).a1 = (T).a0 + 32 * 512; (T).a2 = (T).a0 + 64 * 512; (T).a3 = (T).a0 + 96 * 512; (T).ldb32 = 32 * 512; } while (0)
  const int vb = VBID, vg = VGRID;
  int u = ((vb >> 1) & 7) * (vg >> 3) + (vb >> 4) * 2 + (vb & 1);
  int uo = ((vb >> 1) & 7) * (vg >> 3) + (vb >> 4) * 2 + ((vb & 1) ^ 1);
  bool issued = false;
  P7_DESC(cur, u < nunits ? u : 0);
  while (u < nunits || uo < nunits) {
    const bool act = u < nunits;
    const int un = u + vg;
    const bool hn = un < nunits;
    if (hn) P7_DESC(nxt, un); else nxt = cur;
    gemm_tile_s(lds, cur, issued, nxt, hn, 8, acc);
    issued = hn;
    const int tid_o = opaque(tid), lane_o = tid_o & 63;
    const int fr = lane_o & 15, fq = lane_o >> 4;
    const int rt = u >> 3, ct = u & 7;
    u16* dst; size_t orow;
    if (rt < R) { dst = YEXP; orow = (size_t)rt * 128; } else { dst = YSH; orow = (size_t)(rt - R) * 128; }
    __syncthreads();
    LAS char* stg = lds + 32768 + wid * 8192;
#pragma unroll
    for (int m = 0; m < 4; ++m)
#pragma unroll
      for (int n = 0; n < 4; ++n) stage_put4(stg, m * 16 + fr, n * 4 + fq, acc[m][n]);
    if (act) stage_flush<64>(stg, dst + (orow + wr * 64) * 1024 + ct * 128 + wc * 64, 1024, lane_o);
    cur = nxt; u = un; uo += vg;
  }
#undef P7_DESC
  __syncthreads();
}

typedef float f32x16 __attribute__((ext_vector_type(16)));
typedef short s16x4 __attribute__((ext_vector_type(4)));
DI s16x4 tr_read(const LAS char* a) { return __builtin_bit_cast(s16x4, __builtin_amdgcn_ds_read_tr16_b64_v4i16((LAS s16x4*)a)); }
DI float half_max(float m) { auto rr = __builtin_amdgcn_permlane32_swap(__float_as_uint(m), __float_as_uint(m), false, false); return fmaxf(__uint_as_float(rr[0]), __uint_as_float(rr[1])); }
DI float half_sum(float m) { auto rr = __builtin_amdgcn_permlane32_swap(__float_as_uint(m), __float_as_uint(m), false, false); return __uint_as_float(rr[0]) + __uint_as_float(rr[1]); }
DI bf16x8 pack8(const f32x16& x, int s8) {
  typedef unsigned u32x4 __attribute__((ext_vector_type(4)));
  u32x4 r;
  r[0] = cvtpk(x[s8 + 0], x[s8 + 1]); r[1] = cvtpk(x[s8 + 2], x[s8 + 3]); r[2] = cvtpk(x[s8 + 4], x[s8 + 5]); r[3] = cvtpk(x[s8 + 6], x[s8 + 7]);
  return __builtin_bit_cast(bf16x8, r);
}
constexpr int AT_STAGE = 20480;

DI float max3f(float a, float b, float c) { float r; asm("v_max3_f32 %0, %1, %2, %3" : "=v"(r) : "v"(a), "v"(b), "v"(c)); return r; }
template <bool MLA, bool SWA>
DI void attn_unit(const Params& p, int layer, int isctx, int b, int h, int qb, LAS char* lds) {
  char* ws = p.ws;
  const int tid = opaque((int)threadIdx.x), lane = tid & 63, wid = tid >> 6, r32 = lane & 31, hi = lane >> 5;
  const u16 *Qg, *Kg, *Vg; int ldq, ldk, qoff, koff, ycol; float cs;
  if (MLA) { Qg = (const u16*)(ws + OFF_MLQ); Kg = (const u16*)(ws + OFF_MLK); Vg = (const u16*)(ws + OFF_MLV); ldq = 384; ldk = 256; qoff = h * 96; koff = h * 64; ycol = 768 + h * 64; cs = 0.10206207261596575f * 1.4426950408889634f; }
  else if (!SWA) { Qg = (const u16*)(ws + OFF_GLQ); Kg = (const u16*)(ws + OFF_GLK); Vg = (const u16*)(ws + OFF_GLV); ldq = 384; ldk = 128; qoff = h * 64; koff = (h / 3) * 64; ycol = 384 + h * 64; cs = 0.125f * 1.4426950408889634f; }
  else { Qg = (const u16*)(ws + OFF_SWQ); Kg = (const u16*)(ws + OFF_SWK); Vg = (const u16*)(ws + OFF_SWV); ldq = 384; ldk = 128; qoff = h * 64; koff = (h / 3) * 64; ycol = h * 64; cs = 0.125f * 1.4426950408889634f; }
  const u16* Rg = (const u16*)(ws + OFF_MLKR);
  const int q0 = qb * 128;
  const int qrow0 = (isctx ? NL + b * C_ : b * S_) + q0;
  const int qw = q0 + wid * 32;
  int lat_first = 0, nlat = 0;
  if (!isctx) { if (SWA) { lat_first = 2 * qb - 2; if (lat_first < 0) lat_first = 0; int lat_last = 2 * qb + 3; if (lat_last > 63) lat_last = 63; nlat = lat_last - lat_first + 1; } else nlat = 64; }
  const int T = 4 + nlat;
  constexpr int NQ = MLA ? 6 : 4;
  bf16x8 qf[NQ];
  {
    const u16* qp = Qg + (size_t)(qrow0 + wid * 32 + r32) * ldq + qoff + hi * 8;
#pragma unroll
    for (int d0 = 0; d0 < NQ; ++d0) {
      const u32x4_t raw = *(const u32x4_t*)(qp + d0 * 16);
      u32x4_t sc;
#pragma unroll
      for (int i = 0; i < 4; ++i) sc[i] = cvtpk(bflo(raw[i]) * cs, bfhi(raw[i]) * cs);
      qf[d0] = __builtin_bit_cast(bf16x8, sc);
    }
  }
  int kaddr[4];
#pragma unroll
  for (int d0 = 0; d0 < 4; ++d0) kaddr[d0] = r32 * 128 + (((d0 * 2 + hi) ^ ((r32 >> 1) & 7)) * 16);
  int kraddr[2];
#pragma unroll
  for (int e = 0; e < 2; ++e) kraddr[e] = 16384 + r32 * 64 + (((e * 2 + hi) ^ ((r32 >> 3) & 3)) * 16);
  int vbo[2];
  {
    const int i16 = lane & 15, sw = (lane >> 3) & 1;
    const int x = ((lane >> 4) & 1) * 32 + (lane & 3) * 8;
    const int rowpart = ((i16 >> 2) + 4 * hi) * 128;
    vbo[0] = 8192 + rowpart + x + (sw * 64);
    vbo[1] = 8192 + rowpart + x + ((1 - sw) * 64);
  }
  const int skey = tid >> 3;
  const int kch = ((tid & 7) ^ ((tid >> 4) & 7)) * 8;
  const int vch = ((tid & 7) ^ (((tid >> 4) & 1) << 2)) * 8;
  const int rkey = tid >> 2, rch = ((tid & 3) ^ ((tid >> 5) & 3)) * 8;
  LAS char* ldst = lds + tid * 16;
#define AT_ISSUE(j, st) do { const int _j = (j); const int _kr = _j < 4 ? NL + b * C_ + 64 * _j : b * S_ + 64 * (lat_first + _j - 4); \
    LAS char* _d = ldst + (st) * AT_STAGE; \
    const u16* _k = Kg + (size_t)(_kr + skey) * ldk + koff + kch; glds16(_k, _d); glds16(_k + (size_t)32 * ldk, _d + 4096); \
    const u16* _v = Vg + (size_t)(_kr + skey) * ldk + koff + vch; glds16(_v, _d + 8192); glds16(_v + (size_t)32 * ldk, _d + 8192 + 4096); \
    if (MLA) glds16(Rg + (size_t)(_kr + rkey) * 32 + rch, _d + 16384); } while (0)
#define AT_QK(sb, P0, P1) do { \
    bf16x8 kk0[MLA ? 6 : 4], kk1[MLA ? 6 : 4]; \
    _Pragma("unroll") for (int d0 = 0; d0 < 4; ++d0) { kk0[d0] = *(const LAS bf16x8*)((sb) + kaddr[d0]); kk1[d0] = *(const LAS bf16x8*)((sb) + kaddr[d0] + 4096); } \
    if (MLA) { _Pragma("unroll") for (int e = 0; e < 2; ++e) { kk0[MLA ? 4 + e : 0] = *(const LAS bf16x8*)((sb) + kraddr[e]); kk1[MLA ? 4 + e : 0] = *(const LAS bf16x8*)((sb) + kraddr[e] + 2048); } } \
    __builtin_amdgcn_sched_barrier(0);     \
    P0 = __builtin_amdgcn_mfma_f32_32x32x16_bf16(kk0[0], qf[0], negm, 0, 0, 0); P1 = __builtin_amdgcn_mfma_f32_32x32x16_bf16(kk1[0], qf[0], negm, 0, 0, 0); \
    _Pragma("unroll") for (int d0 = 1; d0 < (MLA ? 6 : 4); ++d0) { \
      P0 = __builtin_amdgcn_mfma_f32_32x32x16_bf16(kk0[d0], qf[d0], P0, 0, 0, 0); P1 = __builtin_amdgcn_mfma_f32_32x32x16_bf16(kk1[d0], qf[d0], P1, 0, 0, 0); } \
  } while (0)
#define AT_WSTATE(jj, pos0v, st) do { st = 0; pos0v = 64 * (lat_first + (jj) - 4); if (SWA && (jj) >= 4) { \
      if (pos0v + 63 < qw - 128 || pos0v > qw + 31 + 128) st = 2; else if (qw + 31 - pos0v > 128 || pos0v + 63 - qw > 128) st = 1; } } while (0)
#define AT_SOFTMAX(P0, P1, PA, wst, pos0v, FIRST) do { \
    if (SWA && wst == 1) { const int dq = qw + r32 - pos0v - 4 * hi + 128; \
      _Pragma("unroll") for (int r = 0; r < 16; ++r) { const int cr = (r & 3) + 8 * (r >> 2); \
        if ((unsigned)(dq - cr) > 256u) P0[r] = -1e30f; if ((unsigned)(dq - cr - 32) > 256u) P1[r] = -1e30f; } } \
    asm volatile("s_nop 15\n\ts_nop 15" : "+v"(P0), "+v"(P1));     \
    float mx = max3f(P0[0], P0[1], P1[0]); mx = max3f(mx, P1[1], P0[2]); \
    _Pragma("unroll") for (int r = 3; r < 16; r += 2) { mx = max3f(mx, P0[r], P0[(r + 1) & 15]); } \
    _Pragma("unroll") for (int r = 2; r < 16; r += 2) { mx = max3f(mx, P1[r], P1[r + 1]); } \
    mx = half_max(mx); \
    if ((FIRST) || __ballot(mx > 8.0f) != 0ull) { \
      const float delta = (FIRST) ? mx : fmaxf(mx, 0.f); \
      const float al = __builtin_amdgcn_exp2f(-delta); \
      m_run += delta; \
      _Pragma("unroll") for (int i = 0; i < 16; ++i) { o[0][i] *= al; o[1][i] *= al; P0[i] -= delta; P1[i] -= delta; negm[i] = -m_run; } \
      osum[0] *= al; \
    } \
    _Pragma("unroll") for (int r = 0; r < 16; ++r) { P0[r] = __builtin_amdgcn_exp2f(P0[r]); P1[r] = __builtin_amdgcn_exp2f(P1[r]); } \
    PA[0] = pack8(P0, 0); PA[1] = pack8(P0, 8); PA[2] = pack8(P1, 0); PA[3] = pack8(P1, 8); \
  } while (0)
#define AT_PV(sb, PA) do { \
    bf16x8 vf[2][4]; \
    _Pragma("unroll") for (int db = 0; db < 2; ++db) { _Pragma("unroll") for (int ts = 0; ts < 4; ++ts) { \
      const LAS char* va = (sb) + vbo[db] + ts * 2048; const s16x4 lo = tr_read(va), hh = tr_read(va + 1024); \
      vf[db][ts] = __builtin_shufflevector(lo, hh, 0, 1, 2, 3, 4, 5, 6, 7); } } \
    __builtin_amdgcn_sched_barrier(0);     \
    _Pragma("unroll") for (int ts = 0; ts < 4; ++ts) osum = __builtin_amdgcn_mfma_f32_32x32x16_bf16(ones, PA[ts], osum, 0, 0, 0); \
    _Pragma("unroll") for (int db = 0; db < 2; ++db) { _Pragma("unroll") for (int ts = 0; ts < 4; ++ts) \
      o[db] = __builtin_amdgcn_mfma_f32_32x32x16_bf16(vf[db][ts], PA[ts], o[db], 0, 0, 0); } } while (0)

  float m_run = SWA ? p.swa_sink[layer * 6 + h] * 1.4426950408889634f : 0.f;
  f32x16 o[2], osum, negm;
#pragma unroll
  for (int i = 0; i < 16; ++i) { o[0][i] = 0.f; o[1][i] = 0.f; osum[i] = SWA ? 1.f : 0.f; negm[i] = -m_run; }
  bf16x8 ones;
#pragma unroll
  for (int i = 0; i < 8; ++i) ones[i] = (short)0x3F80;
  bf16x8 pa[4];
  f32x16 s0, s1;
  AT_ISSUE(0, 0);
  asm volatile("s_waitcnt vmcnt(0)" ::: "memory");
  __syncthreads();
  AT_ISSUE(1, 1);
  AT_QK(lds, s0, s1);
  { int wst = 0, pos0v = 0; AT_SOFTMAX(s0, s1, pa, wst, pos0v, !SWA); }
  bool cur_skip = false;
#pragma unroll 1
  for (int j = 0; j < T - 1; ++j) {
    asm volatile("s_waitcnt vmcnt(0)" ::: "memory");
    __syncthreads();
    const int st_cur = j % 3, st_nxt = (j + 1) % 3;
    if (j + 2 < T) AT_ISSUE(j + 2, (j + 2) % 3);
    const LAS char* sbn = lds + st_nxt * AT_STAGE;
    const LAS char* sbc = lds + st_cur * AT_STAGE;
    int wst, pos0v; AT_WSTATE(j + 1, pos0v, wst);
    if (!SWA || wst != 2) AT_QK(sbn, s0, s1);
    if (!SWA || !cur_skip) AT_PV(sbc, pa);
    if (!SWA || wst != 2) {
      bf16x8 pn[4];
      AT_SOFTMAX(s0, s1, pn, wst, pos0v, false);
      pa[0] = pn[0]; pa[1] = pn[1]; pa[2] = pn[2]; pa[3] = pn[3];
      cur_skip = false;
    } else cur_skip = true;
  }
  if (!SWA || !cur_skip) { const LAS char* sbc = lds + ((T - 1) % 3) * AT_STAGE; AT_PV(sbc, pa); }
#undef AT_ISSUE
#undef AT_QK
#undef AT_WSTATE
#undef AT_SOFTMAX
#undef AT_PV
  const float inv = 1.f / osum[0];
  u16* yp = (u16*)(ws + OFF_Y) + (size_t)(qrow0 + wid * 32 + r32) * 1024 + ycol + 4 * hi;
#pragma unroll
  for (int db = 0; db < 2; ++db)
#pragma unroll
    for (int g = 0; g < 4; ++g) {
      uint2 w; w.x = cvtpk(o[db][4 * g] * inv, o[db][4 * g + 1] * inv); w.y = cvtpk(o[db][4 * g + 2] * inv, o[db][4 * g + 3] * inv);
      *(uint2*)(yp + db * 32 + 8 * g) = w;
    }
  __syncthreads();
}


typedef float f32x4v __attribute__((ext_vector_type(4)));
#define MFMA16(a, b, c) __builtin_amdgcn_mfma_f32_16x16x32_bf16((a), (b), (c), 0, 0, 0)
DI float quad_max_x(float m) {
  { auto rr = __builtin_amdgcn_permlane16_swap(__float_as_uint(m), __float_as_uint(m), false, false); m = fmaxf(__uint_as_float(rr[0]), __uint_as_float(rr[1])); }
  { auto rr = __builtin_amdgcn_permlane32_swap(__float_as_uint(m), __float_as_uint(m), false, false); m = fmaxf(__uint_as_float(rr[0]), __uint_as_float(rr[1])); }
  return m;
}
template <bool MLA, bool SWA>
DI void attn_unit16(const Params& p, int layer, int isctx, int b, int h, int qb, LAS char* lds) {
  char* ws = p.ws;
  const int tid = opaque((int)threadIdx.x), lane = tid & 63, wid = tid >> 6, c16 = lane & 15, g = lane >> 4;
  const u16 *Qg, *Kg, *Vg; int ldq, ldk, qoff, koff, ycol; float cs;
  if (MLA) { Qg = (const u16*)(ws + OFF_MLQ); Kg = (const u16*)(ws + OFF_MLK); Vg = (const u16*)(ws + OFF_MLV); ldq = 384; ldk = 256; qoff = h * 96; koff = h * 64; ycol = 768 + h * 64; cs = 0.10206207261596575f * 1.4426950408889634f; }
  else if (!SWA) { Qg = (const u16*)(ws + OFF_GLQ); Kg = (const u16*)(ws + OFF_GLK); Vg = (const u16*)(ws + OFF_GLV); ldq = 384; ldk = 128; qoff = h * 64; koff = (h / 3) * 64; ycol = 384 + h * 64; cs = 0.125f * 1.4426950408889634f; }
  else { Qg = (const u16*)(ws + OFF_SWQ); Kg = (const u16*)(ws + OFF_SWK); Vg = (const u16*)(ws + OFF_SWV); ldq = 384; ldk = 128; qoff = h * 64; koff = (h / 3) * 64; ycol = h * 64; cs = 0.125f * 1.4426950408889634f; }
  const u16* Rg = (const u16*)(ws + OFF_MLKR);
  const int q0 = qb * 256;
  const int qrow0 = (isctx ? NL + b * C_ : b * S_) + q0;
  const int qw = q0 + wid * 32;
  int lat_first = 0, nlat = 0;
  if (!isctx) { if (SWA) { lat_first = 4 * qb - 2; if (lat_first < 0) lat_first = 0; int lat_last = 4 * qb + 5; if (lat_last > 63) lat_last = 63; nlat = lat_last - lat_first + 1; } else nlat = 64; }
  const int T = 4 + nlat;
  constexpr int NS = MLA ? 3 : 2;
  bf16x8 qf[2][NS];
#pragma unroll
  for (int bq = 0; bq < 2; ++bq) {
    const u16* qp = Qg + (size_t)(qrow0 + wid * 32 + bq * 16 + c16) * ldq + qoff + g * 8;
#pragma unroll
    for (int s = 0; s < NS; ++s) {
      const u32x4_t raw = *(const u32x4_t*)(qp + s * 32);
      u32x4_t sc;
#pragma unroll
      for (int i = 0; i < 4; ++i) sc[i] = cvtpk(bflo(raw[i]) * cs, bfhi(raw[i]) * cs);
      qf[bq][s] = __builtin_bit_cast(bf16x8, sc);
    }
  }
  int kaddr[2];
#pragma unroll
  for (int s = 0; s < 2; ++s) kaddr[s] = c16 * 128 + (((4 * s + g) ^ ((c16 >> 1) & 7)) * 16);
  const int kraddr = 16384 + c16 * 64 + ((g ^ ((0 - (c16 >> 2)) & 3)) * 16);
  int vbo[4];
#pragma unroll
  for (int d = 0; d < 4; ++d) vbo[d] = 8192 + (4 * g + (c16 >> 2)) * 128 + ((d ^ ((lane >> 3) & 3)) * 32) + (lane & 3) * 8;
  const int skey = tid >> 3;
  const int kch = ((tid & 7) ^ ((tid >> 4) & 7)) * 8;
  const int vch = ((tid & 7) ^ (((tid >> 4) & 3) << 1)) * 8;
  const int rkey = tid >> 2, rch = ((tid & 3) ^ ((0 - (tid >> 4)) & 3)) * 8;
  LAS char* ldst = lds + tid * 16;
#define A6_ISSUE(j, st) do { const int _j = (j); const int _kr = _j < 4 ? NL + b * C_ + 64 * _j : b * S_ + 64 * (lat_first + _j - 4); \
    LAS char* _d = ldst + (st) * AT_STAGE; \
    glds16(Kg + (size_t)(_kr + skey) * ldk + koff + kch, _d); \
    glds16(Vg + (size_t)(_kr + skey) * ldk + koff + vch, _d + 8192); \
    if (MLA && tid < 256) glds16(Rg + (size_t)(_kr + rkey) * 32 + rch, _d + 16384); } while (0)
#define A6_QK(sb) do { \
    bf16x8 kk[4][NS]; \
    _Pragma("unroll") for (int a = 0; a < 4; ++a) { kk[a][0] = *(const LAS bf16x8*)((sb) + kaddr[0] + a * 2048); kk[a][1] = *(const LAS bf16x8*)((sb) + kaddr[1] + a * 2048); \
      if (MLA) kk[a][MLA ? 2 : 0] = *(const LAS bf16x8*)((sb) + kraddr + a * 1024); } \
    __builtin_amdgcn_sched_barrier(0); \
    _Pragma("unroll") for (int a = 0; a < 4; ++a) { _Pragma("unroll") for (int bq = 0; bq < 2; ++bq) { \
      S[a][bq] = MFMA16(kk[a][0], qf[bq][0], negm[bq]); \
      _Pragma("unroll") for (int s = 1; s < NS; ++s) S[a][bq] = MFMA16(kk[a][s], qf[bq][s], S[a][bq]); } } \
  } while (0)
#define A6_WSTATE(jj, pos0v, st) do { st = 0; pos0v = 64 * (lat_first + (jj) - 4); if (SWA && (jj) >= 4) { \
      if (pos0v + 63 < qw - 128 || pos0v > qw + 31 + 128) st = 2; else if (qw + 31 - pos0v > 128 || pos0v + 63 - qw > 128) st = 1; } } while (0)
#define A6_SOFTMAX(PA, wst, pos0v, FIRST, CHECK) do { \
    if (SWA && wst == 1) { _Pragma("unroll") for (int bq = 0; bq < 2; ++bq) { const int dq = qw + 16 * bq + c16 - pos0v - 4 * g + 128; \
      _Pragma("unroll") for (int a = 0; a < 4; ++a) { _Pragma("unroll") for (int r = 0; r < 4; ++r) { if ((unsigned)(dq - (16 * a + r)) > 256u) S[a][bq][r] = -1e30f; } } } } \
    float mx[2] = {0.f, 0.f}; \
    if (CHECK) { \
    asm volatile("s_nop 15\n\ts_nop 15" : "+v"(S[0][0]), "+v"(S[0][1]), "+v"(S[1][0]), "+v"(S[1][1]), "+v"(S[2][0]), "+v"(S[2][1]), "+v"(S[3][0]), "+v"(S[3][1])); \
    _Pragma("unroll") for (int bq = 0; bq < 2; ++bq) { \
      float m_ = max3f(S[0][bq][0], S[0][bq][1], S[0][bq][2]); m_ = max3f(m_, S[0][bq][3], S[1][bq][0]); \
      m_ = max3f(m_, S[1][bq][1], S[1][bq][2]); m_ = max3f(m_, S[1][bq][3], S[2][bq][0]); m_ = max3f(m_, S[2][bq][1], S[2][bq][2]); \
      m_ = max3f(m_, S[2][bq][3], S[3][bq][0]); m_ = max3f(m_, S[3][bq][1], S[3][bq][2]); m_ = fmaxf(m_, S[3][bq][3]); \
      mx[bq] = quad_max_x(m_); } } \
    if ((FIRST) || ((CHECK) && __ballot(fmaxf(mx[0], mx[1]) > 8.0f) != 0ull)) { \
      _Pragma("unroll") for (int bq = 0; bq < 2; ++bq) { \
        const float delta = (FIRST) ? mx[bq] : fmaxf(mx[bq], 0.f); \
        const float al = __builtin_amdgcn_exp2f(-delta); \
        m_run[bq] += delta; \
        _Pragma("unroll") for (int a = 0; a < 4; ++a) { S[a][bq] = S[a][bq] - delta; o[a][bq] = o[a][bq] * al; } \
        negm[bq] = (f32x4v){-m_run[bq], -m_run[bq], -m_run[bq], -m_run[bq]}; \
        osum[bq] = osum[bq] * al; } \
    } \
    _Pragma("unroll") for (int a = 0; a < 4; ++a) { _Pragma("unroll") for (int bq = 0; bq < 2; ++bq) { _Pragma("unroll") for (int r = 0; r < 4; ++r) S[a][bq][r] = __builtin_amdgcn_exp2f(S[a][bq][r]); } } \
    _Pragma("unroll") for (int ks = 0; ks < 2; ++ks) { _Pragma("unroll") for (int bq = 0; bq < 2; ++bq) { u32x4_t w_; \
      w_[0] = cvtpk(S[2 * ks][bq][0], S[2 * ks][bq][1]); w_[1] = cvtpk(S[2 * ks][bq][2], S[2 * ks][bq][3]); \
      w_[2] = cvtpk(S[2 * ks + 1][bq][0], S[2 * ks + 1][bq][1]); w_[3] = cvtpk(S[2 * ks + 1][bq][2], S[2 * ks + 1][bq][3]); \
      PA[ks][bq] = __builtin_bit_cast(bf16x8, w_); } } \
  } while (0)
#define A6_PV(sb, PA) do { \
    bf16x8 vf[2][4]; \
    _Pragma("unroll") for (int ks = 0; ks < 2; ++ks) { _Pragma("unroll") for (int d = 0; d < 4; ++d) { \
      const LAS char* va = (sb) + vbo[d] + ks * 4096; const s16x4 lo = tr_read(va), hh = tr_read(va + 2048); \
      vf[ks][d] = __builtin_shufflevector(lo, hh, 0, 1, 2, 3, 4, 5, 6, 7); } } \
    __builtin_amdgcn_sched_barrier(0); \
    _Pragma("unroll") for (int ks = 0; ks < 2; ++ks) { _Pragma("unroll") for (int bq = 0; bq < 2; ++bq) osum[bq] = MFMA16(ones, PA[ks][bq], osum[bq]); } \
    _Pragma("unroll") for (int d = 0; d < 4; ++d) { _Pragma("unroll") for (int bq = 0; bq < 2; ++bq) { _Pragma("unroll") for (int ks = 0; ks < 2; ++ks) \
      o[d][bq] = MFMA16(vf[ks][d], PA[ks][bq], o[d][bq]); } } } while (0)

  float m_run[2];
  m_run[0] = m_run[1] = SWA ? p.swa_sink[layer * 6 + h] * 1.4426950408889634f : 0.f;
  f32x4v S[4][2], o[4][2], osum[2], negm[2];
#pragma unroll
  for (int bq = 0; bq < 2; ++bq) {
    const float i1 = SWA ? 1.f : 0.f;
    osum[bq] = (f32x4v){i1, i1, i1, i1}; negm[bq] = (f32x4v){-m_run[bq], -m_run[bq], -m_run[bq], -m_run[bq]};
#pragma unroll
    for (int d = 0; d < 4; ++d) o[d][bq] = (f32x4v){0.f, 0.f, 0.f, 0.f};
  }
  bf16x8 ones;
#pragma unroll
  for (int i = 0; i < 8; ++i) ones[i] = (short)0x3F80;
  bf16x8 pa[2][2];
  A6_ISSUE(0, 0); A6_ISSUE(1, 1); A6_ISSUE(2, 2); A6_ISSUE(3, 3);
  asm volatile("s_waitcnt vmcnt(0)" ::: "memory");
  __syncthreads();
  if (4 < T) A6_ISSUE(4, 4); if (5 < T) A6_ISSUE(5, 5); if (6 < T) A6_ISSUE(6, 6);
  A6_QK(lds);
  { int wst = 0, pos0v = 0; A6_SOFTMAX(pa, wst, pos0v, !SWA, true); }
  bool cur_skip = false;
  int jm = 0;
#pragma unroll 1
  for (int j = 0; j < T - 1; ++j) {
    if (j > 0 && jm == 0) {
      asm volatile("s_waitcnt vmcnt(0)" ::: "memory");
      __syncthreads();
      if (j + 4 < T) A6_ISSUE(j + 4, (j + 4) % 7);
      if (j + 5 < T) A6_ISSUE(j + 5, (j + 5) % 7);
      if (j + 6 < T) A6_ISSUE(j + 6, (j + 6) % 7);
    }
    jm = jm == 2 ? 0 : jm + 1;
    const LAS char* sbn = lds + ((j + 1) % 7) * AT_STAGE;
    const LAS char* sbc = lds + (j % 7) * AT_STAGE;
    int wst, pos0v; A6_WSTATE(j + 1, pos0v, wst);
    if (!SWA || wst != 2) A6_QK(sbn);
    if (!SWA || !cur_skip) A6_PV(sbc, pa);
    if (!SWA || wst != 2) {
      bf16x8 pn[2][2];
      A6_SOFTMAX(pn, wst, pos0v, false, (SWA || (j & 7) == 7));
      pa[0][0] = pn[0][0]; pa[0][1] = pn[0][1]; pa[1][0] = pn[1][0]; pa[1][1] = pn[1][1];
      cur_skip = false;
    } else cur_skip = true;
  }
  if (!SWA || !cur_skip) { const LAS char* sbc = lds + ((T - 1) % 7) * AT_STAGE; A6_PV(sbc, pa); }
#undef A6_ISSUE
#undef A6_QK
#undef A6_WSTATE
#undef A6_SOFTMAX
#undef A6_PV
  __syncthreads();
  { LAS char* ystg = lds + 6 * AT_STAGE + wid * 2048;
#pragma unroll
    for (int bq = 0; bq < 2; ++bq) {
      const float inv = 1.f / osum[bq][0];
#pragma unroll
      for (int d = 0; d < 4; ++d) stage_put4(ystg, c16, d * 4 + g, o[d][bq] * inv);
      flush16<64>(ystg, (u16*)(ws + OFF_Y) + (size_t)(qrow0 + wid * 32 + bq * 16) * 1024 + ycol, 1024, lane);
    } }
}

DI int next_unit_xcd1(unsigned* ctr8, int per_queue, LAS char* lds) {
  volatile LAS int* slot = (volatile LAS int*)(lds + LDS_RMISC);
  if (threadIdx.x == 0) {
    const int q0 = (int)xcc_id_();
    int res = -1;
    for (int i = 0; i < 8; ++i) { const int q = (q0 + i) & 7; const int v = (int)atomicAdd(&ctr8[q * 64], 1u); if (v < per_queue) { res = q * per_queue + v; break; } }
    *slot = res;
  }
  __syncthreads();
  return *slot;
}
DI void p3_attention(const Params& p, int layer, LAS char* lds, int cs = 0) {
  unsigned* ctr8 = (unsigned*)(p.ws + OFF_CTRL) + CW_Q + (layer * 2 + 0) * 512;
  const int per_q = 256 + (layer == 0 ? 16 : 0);
  bool first = true;
  for (;;) {
    const int u = first ? next_unit_xcd(ctr8, per_q, lds) : next_unit_xcd1(ctr8, per_q, lds);
    first = false;
    if (u < 0) break;
    const int b = u / per_q, v = u % per_q;
    if (v < 64) { attn_unit16<true, false>(p, layer, 0, b, v >> 4, v & 15, lds); }
    else if (v < 160) { const int w = v - 64; attn_unit16<false, false>(p, layer, 0, b, w >> 4, w & 15, lds); }
    else if (v < 256) { const int w = v - 160; attn_unit16<false, true>(p, layer, 0, b, w >> 4, w & 15, lds); }
    else {
      const int w = v - 256;
      if (w < 4) attn_unit16<true, false>(p, layer, 1, b, w, 0, lds);
      else if (w < 10) attn_unit16<false, false>(p, layer, 1, b, w - 4, 0, lds);
      else attn_unit16<false, true>(p, layer, 1, b, w - 10, 0, lds);
    }
  }
}

struct AttnArgs {
  const u16* Q; const u16* K; const u16* K2; const u16* V; u16* Y; const float* sink;
  int ldq, ldk, ldk2, ldv, ldy, ycol, G, window, q_is_ctx; float scale;
};
static_assert(sizeof(AttnArgs) == 88, "no padding");
template <int DK1, int DK2>
__global__ __launch_bounds__(64) void k_attn(AttnArgs a) {
  const int qt = blockIdx.x * 64 + threadIdx.x, b = blockIdx.y, h = blockIdx.z, kvh = h / a.G;
  const int qrow = a.q_is_ctx ? NL + b * C_ + qt : b * S_ + qt;
  float q[DK1 + DK2];
  {
    const uint4* qp = (const uint4*)(a.Q + (size_t)qrow * a.ldq + h * (DK1 + DK2));
#pragma unroll
    for (int i = 0; i < (DK1 + DK2) / 8; ++i) {
      uint4 u = qp[i];
      q[i * 8 + 0] = bflo(u.x) * a.scale; q[i * 8 + 1] = bfhi(u.x) * a.scale; q[i * 8 + 2] = bflo(u.y) * a.scale; q[i * 8 + 3] = bfhi(u.y) * a.scale;
      q[i * 8 + 4] = bflo(u.z) * a.scale; q[i * 8 + 5] = bfhi(u.z) * a.scale; q[i * 8 + 6] = bflo(u.w) * a.scale; q[i * 8 + 7] = bfhi(u.w) * a.scale;
    }
  }
  float m, l, o[64];
  if (a.sink) { m = a.sink[h]; l = 1.f; } else { m = -1e30f; l = 0.f; }
#pragma unroll
  for (int d = 0; d < 64; ++d) o[d] = 0.f;
  const int nseg = a.q_is_ctx ? 1 : 2;
  for (int seg = 0; seg < nseg; ++seg) {
    int lo, hi, rbase; bool masked = false;
    if (seg == 0) { lo = 0; hi = C_; rbase = NL + b * C_; }
    else {
      lo = 0; hi = S_; rbase = b * S_;
      if (a.window) { int t0 = blockIdx.x * 64; lo = t0 - a.window; if (lo < 0) lo = 0; hi = t0 + 64 + a.window; if (hi > S_) hi = S_; masked = true; }
    }
    for (int s = lo; s < hi; s += 4) {
      float sc[4];
#pragma unroll
      for (int i = 0; i < 4; ++i) {
        const uint4* kp = (const uint4*)(a.K + (size_t)(rbase + s + i) * a.ldk + kvh * DK1);
        float dot = 0.f;
#pragma unroll
        for (int c = 0; c < DK1 / 8; ++c) {
          uint4 u = kp[c];
          dot += q[c * 8 + 0] * bflo(u.x) + q[c * 8 + 1] * bfhi(u.x) + q[c * 8 + 2] * bflo(u.y) + q[c * 8 + 3] * bfhi(u.y)
               + q[c * 8 + 4] * bflo(u.z) + q[c * 8 + 5] * bfhi(u.z) + q[c * 8 + 6] * bflo(u.w) + q[c * 8 + 7] * bfhi(u.w);
        }
        if (DK2 > 0) {
          const uint4* kp2 = (const uint4*)(a.K2 + (size_t)(rbase + s + i) * a.ldk2);
#pragma unroll
          for (int c = 0; c < DK2 / 8; ++c) {
            uint4 u = kp2[c];
            dot += q[DK1 + c * 8 + 0] * bflo(u.x) + q[DK1 + c * 8 + 1] * bfhi(u.x) + q[DK1 + c * 8 + 2] * bflo(u.y) + q[DK1 + c * 8 + 3] * bfhi(u.y)
                 + q[DK1 + c * 8 + 4] * bflo(u.z) + q[DK1 + c * 8 + 5] * bfhi(u.z) + q[DK1 + c * 8 + 6] * bflo(u.w) + q[DK1 + c * 8 + 7] * bfhi(u.w);
          }
        }
        if (masked) { int dlt = qt - (s + i); if (dlt < 0) dlt = -dlt; if (dlt > a.window) dot = -1e30f; }
        sc[i] = dot;
      }
      float mx = fmaxf(fmaxf(fmaxf(sc[0], sc[1]), fmaxf(sc[2], sc[3])), m);
      const float alpha = __expf(m - mx);
      float pr[4];
#pragma unroll
      for (int i = 0; i < 4; ++i) pr[i] = __expf(sc[i] - mx);
      l = l * alpha + (pr[0] + pr[1]) + (pr[2] + pr[3]);
      m = mx;
#pragma unroll
      for (int d = 0; d < 64; ++d) o[d] *= alpha;
#pragma unroll
      for (int i = 0; i < 4; ++i) {
        const uint4* vp = (const uint4*)(a.V + (size_t)(rbase + s + i) * a.ldv + kvh * 64);
#pragma unroll
        for (int c = 0; c < 8; ++c) {
          uint4 u = vp[c];
          o[c * 8 + 0] += pr[i] * bflo(u.x); o[c * 8 + 1] += pr[i] * bfhi(u.x); o[c * 8 + 2] += pr[i] * bflo(u.y); o[c * 8 + 3] += pr[i] * bfhi(u.y);
          o[c * 8 + 4] += pr[i] * bflo(u.z); o[c * 8 + 5] += pr[i] * bfhi(u.z); o[c * 8 + 6] += pr[i] * bflo(u.w); o[c * 8 + 7] += pr[i] * bfhi(u.w);
        }
      }
    }
  }
  const float inv = 1.f / l;
  uint4* yp = (uint4*)(a.Y + (size_t)qrow * a.ldy + a.ycol + h * 64);
#pragma unroll
  for (int c = 0; c < 8; ++c) {
    uint4 u;
    u.x = cvtpk(o[c * 8 + 0] * inv, o[c * 8 + 1] * inv); u.y = cvtpk(o[c * 8 + 2] * inv, o[c * 8 + 3] * inv);
    u.z = cvtpk(o[c * 8 + 4] * inv, o[c * 8 + 5] * inv); u.w = cvtpk(o[c * 8 + 6] * inv, o[c * 8 + 7] * inv);
    yp[c] = u;
  }
}


constexpr int CW_BAR = 1024;
#define XB_TMO      128
#define XB_XCNT(j)  (256  + 64 * (j))
#define XB_XSUB(j)  (1280 + 64 * (j))
#define XB_XGEN(j)  (2304 + 64 * (j))
#define XB_TOP      3328
#define XB_TOPGEN   3392
#define XCD_BAR_WORDS 3456
#define XB_SPIN_CAP (1u << 22)
DI unsigned xb_ld(unsigned* p) { return __hip_atomic_load(p, __ATOMIC_RELAXED, __HIP_MEMORY_SCOPE_AGENT); }
DI unsigned xb_add(unsigned* p, unsigned v) { return __hip_atomic_fetch_add(p, v, __ATOMIC_RELAXED, __HIP_MEMORY_SCOPE_AGENT); }
DI unsigned xb_xcc_id() { return (unsigned)__builtin_amdgcn_s_getreg((3 << 11) | 20) & 0xFu; }
#define XB_SPIN(cond, bar) do { unsigned _sp = 0; while (cond) { __builtin_amdgcn_s_sleep(1); \
    if ((++_sp & 255u) == 0u) { if (xb_ld(&(bar)[XB_TMO])) break; if (_sp > XB_SPIN_CAP) { atomicAdd(&(bar)[XB_TMO], 1u); break; } } } } while (0)
struct XcdBarrier { unsigned* bar; unsigned x; volatile LAS unsigned* st; };
DI XcdBarrier xcd_barrier_post(unsigned* bar, volatile LAS unsigned* st) {
  XcdBarrier b; b.bar = bar; b.x = xb_xcc_id(); b.st = st;
  if (threadIdx.x == 0) (void)xb_add(&bar[XB_XCNT(b.x)], 1u);
  return b;
}
DI void xcd_barrier_complete(unsigned* bar, unsigned x, unsigned& nloc, unsigned& nx) {
  const unsigned G = gridDim.x * gridDim.y * gridDim.z;
  unsigned sum, cnt, mine, sp = 0u;
  for (;;) {
    sum = 0u; cnt = 0u; mine = 0u;
#pragma unroll
    for (unsigned j = 0; j < 16; ++j) { const unsigned c = xb_ld(&bar[XB_XCNT(j)]); sum += c; cnt += (c > 0u) ? 1u : 0u; mine = (j == x) ? c : mine; }
    if (sum == G) break;
    __builtin_amdgcn_s_sleep(1);
    if ((++sp & 255u) == 0u) { if (xb_ld(&bar[XB_TMO])) break; if (sp > XB_SPIN_CAP) { atomicAdd(&bar[XB_TMO], 1u); break; } }
  }
  nloc = mine > 0u ? mine : 1u; nx = cnt > 0u ? cnt : 1u;
}
DI void xcd_barrier(const XcdBarrier& b) {
  asm volatile("s_waitcnt vmcnt(0)" ::: "memory");
  __syncthreads();
  if (threadIdx.x == 0) {
    unsigned* bar = b.bar;
    const unsigned bx_ = (unsigned)opaque((int)b.x);
    __builtin_amdgcn_s_waitcnt(0);
    unsigned nloc = b.st[0], nx = b.st[1];
    if (nloc == 0u) { xcd_barrier_complete(bar, bx_, nloc, nx); b.st[0] = nloc; b.st[1] = nx; }
    const unsigned old = xb_add(&bar[XB_XSUB(bx_)], 1u);
    const unsigned gen = old / nloc;
    if (old + 1u == (gen + 1u) * nloc) {
      __builtin_amdgcn_fence(__ATOMIC_RELEASE, "agent");
      asm volatile("s_waitcnt vmcnt(0)" ::: "memory");
      const unsigned og = xb_add(&bar[XB_TOP], 1u);
      const unsigned tg = og / nx;
      if (og + 1u == (tg + 1u) * nx) xb_add(&bar[XB_TOPGEN], 1u);
      else XB_SPIN(xb_ld(&bar[XB_TOPGEN]) == tg, bar);
      __builtin_amdgcn_fence(__ATOMIC_ACQUIRE, "agent");
      asm volatile("s_waitcnt vmcnt(0)" ::: "memory");
    } else {
      XB_SPIN(xb_ld(&bar[XB_TOPGEN]) == gen, bar);
      __builtin_amdgcn_fence(__ATOMIC_ACQUIRE, "agent");
      asm volatile("s_waitcnt vmcnt(0)" ::: "memory");
    }
  }
  __syncthreads();
}

__global__ __launch_bounds__(NTHR, 1) void k_mega(Params p) {
  extern __shared__ __attribute__((aligned(16))) unsigned char smem[];
  LAS char* lds = (LAS char*)smem;
  if (p.never) cooperative_groups::this_grid().sync();
  volatile LAS unsigned* st = (volatile LAS unsigned*)(lds + LDS_RMISC + 64);
  if (threadIdx.x < 4) st[threadIdx.x] = 0u;
  __syncthreads();
  XcdBarrier bar = xcd_barrier_post((unsigned*)(p.ws + OFF_CTRL) + CW_BAR, st);
#ifdef PROBE_SEG
  volatile LAS unsigned long long* pt = (volatile LAS unsigned long long*)(lds + LDS_RMISC + 256);
  if (threadIdx.x == 0) { pt[0] = 0ull; pt[1] = 0ull; }
#define SEG_BEGIN(id) do { if ((id) == PROBE_SEG && blockIdx.x == 0 && opaque((int)threadIdx.x) == 0) pt[0] = __builtin_amdgcn_s_memrealtime(); } while (0)
#define SEG_END(id) do { if ((id) == PROBE_SEG && blockIdx.x == 0 && opaque((int)threadIdx.x) == 0) pt[1] = pt[1] + (__builtin_amdgcn_s_memrealtime() - pt[0]); } while (0)
#else
#define SEG_BEGIN(id) do {} while (0)
#define SEG_END(id) do {} while (0)
#endif
  SEG_BEGIN(0); p0_prologue(p, lds); xcd_barrier(bar); SEG_END(0);
  SEG_BEGIN(1); p1_norm_mix(p, 0); xcd_barrier(bar); SEG_END(1);
#pragma unroll 1
  for (int l = 0; l < 2; ++l) {
    const int nrows = l == 0 ? NT : NL;
    SEG_BEGIN(2 + 10 * l); p2_inproj8(p, l, lds); xcd_barrier(bar); p2b_upproj(p, l, lds); xcd_barrier(bar); SEG_END(2 + 10 * l);
    SEG_BEGIN(3 + 10 * l); p3_attention(p, l, lds); xcd_barrier(bar); SEG_END(3 + 10 * l);
    SEG_BEGIN(4 + 10 * l); p4_outproj8(p, l, nrows, lds); xcd_barrier(bar); SEG_END(4 + 10 * l);
    SEG_BEGIN(5 + 10 * l); p5_norm_ffn8(p, l, nrows, lds); xcd_barrier(bar); SEG_END(5 + 10 * l);
    SEG_BEGIN(6 + 10 * l); p6_gateup8(p, l, nrows, lds); xcd_barrier(bar); SEG_END(6 + 10 * l);
    SEG_BEGIN(7 + 10 * l); p7_down8(p, l, nrows, lds); xcd_barrier(bar); SEG_END(7 + 10 * l);
    SEG_BEGIN(8 + 10 * l); p8_combine(p, l, nrows); if (l == 0) xcd_barrier(bar); SEG_END(8 + 10 * l);
  }
#ifdef PROBE_SEG
  if (blockIdx.x == 0 && opaque((int)threadIdx.x) == 0) {
    const unsigned long long t0 = __builtin_amdgcn_s_memrealtime(), t_acc = pt[1];
    while (__builtin_amdgcn_s_memrealtime() - t0 < 9ull * t_acc) __builtin_amdgcn_s_sleep(8);
  }
#endif
}

extern "C" void kernel_launch(void* const* d_in, const int* in_sizes, int n_in, void* d_out, int out_size, void* d_ws, size_t ws_size, hipStream_t stream) {
  Params p{};
  p.x = (const float*)d_in[0]; p.c = (const float*)d_in[1]; p.ctx = (const float*)d_in[2]; p.c_ctx = (const float*)d_in[3];
  p.w_mod = (const float*)d_in[4]; p.b_mod = (const float*)d_in[5]; p.norm_mix_g = (const float*)d_in[6]; p.norm_ffn_g = (const float*)d_in[7];
  p.w_in = (const float*)d_in[8]; p.w_out = (const float*)d_in[9]; p.swa_sink = (const float*)d_in[10]; p.glb_q_gain = (const float*)d_in[11];
  p.glb_k_gain = (const float*)d_in[12]; p.mla_q_gain = (const float*)d_in[13]; p.mla_w_uq = (const float*)d_in[14]; p.mla_kv_gain = (const float*)d_in[15];
  p.mla_w_ukv = (const float*)d_in[16]; p.router_w = (const float*)d_in[17]; p.router_bias = (const float*)d_in[18]; p.exp_w_gate = (const float*)d_in[19];
  p.exp_w_up = (const float*)d_in[20]; p.exp_w_down = (const float*)d_in[21]; p.shr_w_gate = (const float*)d_in[22]; p.shr_w_up = (const float*)d_in[23];
  p.shr_w_down = (const float*)d_in[24]; p.final_norm_g = (const float*)d_in[25];
  p.out = (float*)d_out; p.ws = (char*)d_ws;
  char* ws = (char*)d_ws;

#ifndef MEGA
#define MEGA 1
#endif
#if MEGA
  static int grid_blocks = 0;
  if (!grid_blocks) {
    (void)hipFuncSetAttribute((const void*)k_mega, hipFuncAttributeMaxDynamicSharedMemorySize, LDS_BYTES);
    int dev = 0, cus = 0, per_cu = 0;
    (void)hipGetDevice(&dev);
    (void)hipDeviceGetAttribute(&cus, hipDeviceAttributeMultiprocessorCount, dev);
    (void)hipOccupancyMaxActiveBlocksPerMultiprocessor(&per_cu, (const void*)k_mega, NTHR, LDS_BYTES);
    if (per_cu > 1) per_cu = 1;
    if (per_cu < 1) per_cu = 1;
    grid_blocks = cus * per_cu;
  }
  (void)hipMemsetAsync(ws + OFF_CTRL, 0, CTRL_BYTES, stream);
  void* args[] = {&p};
  hipError_t e = hipLaunchCooperativeKernel((const void*)k_mega, dim3(grid_blocks), dim3(NTHR), args, LDS_BYTES, stream);
  if (e != hipSuccess) fprintf(stderr, "cooperative launch failed: %s (grid %d)\n", hipGetErrorString(e), grid_blocks);
#endif
}
```
